# Optimizing an MI355X kernel written in HIP

```python
import math
import jax, jax.numpy as jnp
from jax import lax
import numpy as np

D_MODEL = 1024
BATCH = 8
SEQ = 2048
DEPTH = 2
DEC_BATCH = 128
DEC_SEQ = 8
PAST_LEN = 16384
PAGE_SIZE = 128

N_EVEN = (DEPTH + 1) // 2
N_ODD = DEPTH // 2

H_RET = 4
DK_RET = 128
DV_RET = 128
ROPE_BASE = 10000.0
H_HG = 4
DK_HG = 128
DV_HG = 128
IN_EVEN = 2 * H_RET * DK_RET + 2 * H_RET * DV_RET + 2 * H_HG * DK_HG + 2 * H_HG * DV_HG
MIX_EVEN = H_RET * DV_RET + H_HG * DV_HG
H_SSD = 16
P_SSD = 64
N_SSD = 128
G_SSD = 2
D_INNER = H_SSD * P_SSD
CONV_W = 4
CONV_DIM = D_INNER + 2 * G_SSD * N_SSD
S5_GS = 16
S5_WIDTH = D_MODEL // 2
S5_G = S5_WIDTH // S5_GS
S5_P = 64
IN_ODD = D_INNER + CONV_DIM + H_SSD + S5_WIDTH
MIX_ODD = D_INNER + S5_WIDTH
D_FF = 4 * D_MODEL
CHUNK = 128
CHUNK_VEC = 64
EPS = 1e-6

kernel_name = 'hybrid_retention_hgrn2_ssd_s5_decode_step'


def _rmsnorm(x, w):
    xf = x.astype(jnp.float32)
    y = xf * lax.rsqrt(jnp.mean(xf * xf, axis=-1, keepdims=True) + EPS)
    return (y * w.astype(jnp.float32)).astype(x.dtype)


def _split(x, sizes):
    out, start = [], 0
    for s in sizes:
        out.append(x[..., start:start + s])
        start += s
    return out


def _rope(x, pos):
    half = x.shape[-1] // 2
    inv_freq = ROPE_BASE ** (-jnp.arange(half, dtype=jnp.float32) / half)
    ang = pos[:, None] * inv_freq[None, :]
    cos = jnp.cos(ang)[None, :, None, :]
    sin = jnp.sin(ang)[None, :, None, :]
    x1, x2 = x[..., :half], x[..., half:]
    return jnp.concatenate([x1 * cos - x2 * sin, x1 * sin + x2 * cos], axis=-1)


def _pick_chunk(t, c):
    return c if t % c == 0 else t


def _to_chunks(a, c):
    b, t = a.shape[:2]
    return jnp.moveaxis(a.reshape((b, t // c, c) + a.shape[2:]), 1, 0)


def _from_chunks(a):
    n, b, c = a.shape[:3]
    return jnp.moveaxis(a, 0, 1).reshape((b, n * c) + a.shape[3:])


def _scalar_decay_recurrence(q, k, v, log_a, s0, chunk):
    c = _pick_chunk(q.shape[1], chunk)
    causal = jnp.tril(jnp.ones((c, c), dtype=bool))

    def step(s, blk):
        qc, kc, vc, lc = blk
        cum = jnp.cumsum(lc, axis=1)
        diff = cum[:, :, None, :] - cum[:, None, :, :]
        decay = jnp.exp(jnp.where(causal[None, :, :, None], diff, -jnp.inf))
        scores = jnp.einsum('bthn,bshn->btsh', qc, kc) * decay
        o = (jnp.einsum('btsh,bshp->bthp', scores, vc)
             + jnp.einsum('bthn,bhnp->bthp', qc, s) * jnp.exp(cum)[..., None])
        to_end = jnp.exp(cum[:, -1:, :] - cum)
        s_new = (s * jnp.exp(cum[:, -1, :])[:, :, None, None]
                 + jnp.einsum('bshn,bshp->bhnp', kc * to_end[..., None], vc))
        return s_new, o

    blocks = (_to_chunks(q, c), _to_chunks(k, c), _to_chunks(v, c), _to_chunks(log_a, c))
    s_t, o = lax.scan(step, s0, blocks)
    return _from_chunks(o), s_t


def _vector_decay_recurrence(q, k, v, log_f, s0, chunk):
    c = _pick_chunk(q.shape[1], chunk)
    causal = jnp.tril(jnp.ones((c, c), dtype=bool))

    def step(s, blk):
        qc, kc, vc, lc = blk
        cum = jnp.cumsum(lc, axis=1)
        diff = cum[:, :, None] - cum[:, None]
        decay = jnp.exp(jnp.where(causal[None, :, :, None, None], diff, -jnp.inf))
        scores = jnp.einsum('btshk,bshk->btsh', qc[:, :, None] * decay, kc)
        o = (jnp.einsum('btsh,bshv->bthv', scores, vc)
             + jnp.einsum('bthk,bhkv->bthv', qc * jnp.exp(cum), s))
        s_new = (s * jnp.exp(cum[:, -1])[..., None]
                 + jnp.einsum('bshk,bshv->bhkv', kc * jnp.exp(cum[:, -1:] - cum), vc))
        return s_new, o

    blocks = (_to_chunks(q, c), _to_chunks(k, c), _to_chunks(v, c), _to_chunks(log_f, c))
    s_t, o = lax.scan(step, s0, blocks)
    return _from_chunks(o), s_t


def _linear_combine(e1, e2):
    a1, b1 = e1
    a2, b2 = e2
    return a1 * a2, a2 * b1 + b2


def _s5(u, h0_re, h0_im, lam_re, lam_im, log_step, b_re, b_im, c_re, c_im, d):
    f32 = jnp.float32
    lam = lax.complex(lam_re.astype(f32), lam_im.astype(f32))
    dt = jnp.exp(log_step.astype(f32))[:, None]
    lam_bar = jnp.exp(lam * dt)
    b_bar = ((lam_bar - 1.0) / lam)[..., None] * lax.complex(b_re.astype(f32), b_im.astype(f32))
    bu = jnp.einsum('btgc,gpc->btgp', u.astype(jnp.complex64), b_bar)
    h0 = lax.complex(h0_re.astype(f32), h0_im.astype(f32))
    bu = bu.at[:, 0].add(lam_bar * h0)
    a = jnp.broadcast_to(lam_bar, bu.shape)
    _, hs = lax.associative_scan(_linear_combine, (a, bu), axis=1)
    c = lax.complex(c_re.astype(f32), c_im.astype(f32))
    y = jnp.einsum('btgp,gcp->btgc', hs, c).real + d.astype(f32).reshape(S5_G, S5_GS) * u
    h_last = hs[:, -1]
    return y, h_last.real, h_last.imag


def _even_mixer(h, pos, s_ret, s_hg, w_in, w_out, ret_norm_w, hg_norm_w, lb):
    f32 = jnp.float32
    bsz, t, _ = h.shape
    proj = jnp.einsum('btd,de->bte', h, w_in)
    q_r, k_r, v_r, g_r, q_h, f_h, i_h, g_h = _split(
        proj, [H_RET * DK_RET] * 2 + [H_RET * DV_RET] * 2 + [H_HG * DK_HG] * 2 + [H_HG * DV_HG] * 2)
    q_r = _rope(q_r.astype(f32).reshape(bsz, t, H_RET, DK_RET), pos)
    k_r = _rope(k_r.astype(f32).reshape(bsz, t, H_RET, DK_RET), pos) * (DK_RET ** -0.5)
    v_r = v_r.astype(f32).reshape(bsz, t, H_RET, DV_RET)
    log_gamma = jnp.log1p(-jnp.exp2(-5.0 - jnp.arange(H_RET, dtype=f32)))
    o_r, s_ret_new = _scalar_decay_recurrence(
        q_r, k_r, v_r, jnp.broadcast_to(log_gamma, (bsz, t, H_RET)), s_ret.astype(f32), CHUNK)
    mu = jnp.mean(o_r, axis=-1, keepdims=True)
    var = jnp.mean(jnp.square(o_r - mu), axis=-1, keepdims=True)
    o_r = (o_r - mu) * lax.rsqrt(var + EPS) * ret_norm_w.astype(f32)
    o_r = o_r.reshape(bsz, t, H_RET * DV_RET) * jax.nn.silu(g_r.astype(f32))
    f = lb + (1.0 - lb) * jax.nn.sigmoid(f_h.astype(f32))
    f = f.reshape(bsz, t, H_HG, DK_HG)
    q_h = q_h.astype(f32).reshape(bsz, t, H_HG, DK_HG)
    i_h = i_h.astype(f32).reshape(bsz, t, H_HG, DV_HG)
    o_h, s_hg_new = _vector_decay_recurrence(q_h, 1.0 - f, i_h, jnp.log(f), s_hg.astype(f32), CHUNK_VEC)
    o_h = o_h * lax.rsqrt(jnp.mean(o_h * o_h, axis=-1, keepdims=True) + EPS) * hg_norm_w.astype(f32)
    o_h = o_h.reshape(bsz, t, H_HG * DV_HG) * jax.nn.silu(g_h.astype(f32))
    mix = jnp.concatenate([o_r, o_h], axis=-1).astype(h.dtype)
    out = jnp.einsum('bte,ed->btd', mix, w_out)
    return out, s_ret_new.astype(s_ret.dtype), s_hg_new.astype(s_hg.dtype)


def _odd_mixer(h, s_ssm, s_conv, s_re, s_im, w_in, w_out, conv_w, conv_b, dt_bias, a_log, d_ssm,
               ssm_norm_w, lam_re, lam_im, log_step, b_re, b_im, c_re, c_im, s5_d, w_glu, b_glu):
    f32 = jnp.float32
    bsz, t, _ = h.shape
    proj = jnp.einsum('btd,de->bte', h, w_in)
    z, xbc, dt, u = _split(proj, [D_INNER, CONV_DIM, H_SSD, S5_WIDTH])
    xbc_in = jnp.concatenate([s_conv.astype(f32), xbc.astype(f32)], axis=1)
    conv = lax.conv_general_dilated(
        xbc_in, conv_w.astype(f32)[:, None, :], window_strides=(1,), padding='VALID',
        dimension_numbers=('NWC', 'WIO', 'NWC'), feature_group_count=CONV_DIM)
    conv_new = xbc_in[:, -(CONV_W - 1):]
    xbc = jax.nn.silu(conv + conv_b.astype(f32))
    xs, bm, cm = _split(xbc, [D_INNER, G_SSD * N_SSD, G_SSD * N_SSD])
    xs = xs.reshape(bsz, t, H_SSD, P_SSD)
    bm = jnp.repeat(bm.reshape(bsz, t, G_SSD, N_SSD), H_SSD // G_SSD, axis=2)
    cm = jnp.repeat(cm.reshape(bsz, t, G_SSD, N_SSD), H_SSD // G_SSD, axis=2)
    dt = jax.nn.softplus(dt.astype(f32) + dt_bias.astype(f32))
    a = -jnp.exp(a_log.astype(f32))
    y, s_ssm_new = _scalar_decay_recurrence(cm, bm, xs * dt[..., None], dt * a, s_ssm.astype(f32), CHUNK)
    y = y + d_ssm.astype(f32)[:, None] * xs
    y = y.reshape(bsz, t, D_INNER) * jax.nn.silu(z.astype(f32))
    yg = y.reshape(bsz, t, G_SSD, D_INNER // G_SSD)
    yg = yg * lax.rsqrt(jnp.mean(yg * yg, axis=-1, keepdims=True) + EPS)
    y = yg.reshape(bsz, t, D_INNER) * ssm_norm_w.astype(f32)
    yd, re_new, im_new = _s5(u.astype(f32).reshape(bsz, t, S5_G, S5_GS), s_re, s_im, lam_re, lam_im,
                             log_step, b_re, b_im, c_re, c_im, s5_d)
    g = jax.nn.gelu(yd.reshape(bsz, t, S5_WIDTH))
    yd = g * jax.nn.sigmoid(jnp.einsum('bte,ef->btf', g, w_glu.astype(f32)) + b_glu.astype(f32))
    mix = jnp.concatenate([y, yd], axis=-1).astype(h.dtype)
    out = jnp.einsum('bte,ed->btd', mix, w_out)
    return (out, s_ssm_new.astype(s_ssm.dtype), conv_new.astype(s_conv.dtype),
            re_new.astype(s_re.dtype), im_new.astype(s_im.dtype))


def _ffn(h, w_up, w_down):
    return jnp.einsum('btf,fd->btd', jnp.square(jax.nn.relu(jnp.einsum('btd,df->btf', h, w_up))), w_down)


def _forward(x, pos_offset, s_ret, s_hg, s_ssm, s_conv, s_re, s_im, p):
    t = x.shape[1]
    pos = jnp.arange(pos_offset, pos_offset + t, dtype=jnp.float32)
    lb_all = jnp.cumsum(jax.nn.softmax(p['hgrn_lower_bounds'].astype(jnp.float32), axis=0), axis=0)
    ret_l, hg_l, ssm_l, conv_l, re_l, im_l = [], [], [], [], [], []
    h = x
    for layer in range(DEPTH):
        i = layer // 2
        hn = _rmsnorm(h, p['norm_mix_pre'][layer])
        if layer % 2 == 0:
            mix, sr, sh = _even_mixer(hn, pos, s_ret[i], s_hg[i], p['w_in_even'][i], p['w_out_even'][i],
                                      p['ret_norm_w'][i], p['hgrn_norm_w'][i], lb_all[i])
            ret_l.append(sr)
            hg_l.append(sh)
        else:
            mix, ss, sc, sre, sim = _odd_mixer(
                hn, s_ssm[i], s_conv[i], s_re[i], s_im[i], p['w_in_odd'][i], p['w_out_odd'][i],
                p['conv_w'][i], p['conv_b'][i], p['dt_bias'][i], p['a_log'][i], p['d_ssm'][i],
                p['ssm_norm_w'][i], p['s5_lam_re'][i], p['s5_lam_im'][i], p['s5_log_step'][i],
                p['s5_b_re'][i], p['s5_b_im'][i], p['s5_c_re'][i], p['s5_c_im'][i], p['s5_d'][i],
                p['w_glu'][i], p['b_glu'][i])
            ssm_l.append(ss)
            conv_l.append(sc)
            re_l.append(sre)
            im_l.append(sim)
        h = h + _rmsnorm(mix, p['norm_mix_post'][layer])
        ff = _ffn(_rmsnorm(h, p['norm_ffn_pre'][layer]), p['w_ffn_up'][layer], p['w_ffn_down'][layer])
        h = h + _rmsnorm(ff, p['norm_ffn_post'][layer])
    return (h, jnp.stack(ret_l), jnp.stack(hg_l), jnp.stack(ssm_l), jnp.stack(conv_l),
            jnp.stack(re_l), jnp.stack(im_l))


def setup_inputs(seed: int = 0) -> dict:
    key = jax.random.key(seed)
    ks = iter(jax.random.split(key, 48))
    f32 = jnp.float32

    def nrm(shape, scale):
        return jax.random.normal(next(ks), shape, f32) * scale

    def unif(shape, lo, hi):
        return jax.random.uniform(next(ks), shape, f32, lo, hi)

    dt0 = jnp.exp(unif((N_ODD, H_SSD), math.log(1e-3), math.log(1e-1)))
    return {
        'x_prompt': nrm((BATCH, SEQ, D_MODEL), 1.0),
        'x_sample': nrm((DEC_BATCH, DEC_SEQ, D_MODEL), 1.0),
        'state_ret': nrm((N_EVEN, DEC_BATCH, H_RET, DK_RET, DV_RET), 0.5),
        'state_hgrn': nrm((N_EVEN, DEC_BATCH, H_HG, DK_HG, DV_HG), 0.5),
        'state_ssm': nrm((N_ODD, DEC_BATCH, H_SSD, N_SSD, P_SSD), 0.5),
        'state_conv': nrm((N_ODD, DEC_BATCH, CONV_W - 1, CONV_DIM), 1.0),
        'state_s5_re': nrm((N_ODD, DEC_BATCH, S5_G, S5_P), 0.5),
        'state_s5_im': nrm((N_ODD, DEC_BATCH, S5_G, S5_P), 0.5),
        'norm_mix_pre': 1.0 + nrm((DEPTH, D_MODEL), 0.05),
        'norm_mix_post': 1.0 + nrm((DEPTH, D_MODEL), 0.05),
        'norm_ffn_pre': 1.0 + nrm((DEPTH, D_MODEL), 0.05),
        'norm_ffn_post': 1.0 + nrm((DEPTH, D_MODEL), 0.05),
        'w_in_even': nrm((N_EVEN, D_MODEL, IN_EVEN), D_MODEL ** -0.5),
        'w_out_even': nrm((N_EVEN, MIX_EVEN, D_MODEL), MIX_EVEN ** -0.5),
        'ret_norm_w': 1.0 + nrm((N_EVEN, H_RET, DV_RET), 0.05),
        'hgrn_lower_bounds': nrm((N_EVEN + 1, H_HG * DK_HG), 0.1),
        'hgrn_norm_w': 1.0 + nrm((N_EVEN, H_HG, DV_HG), 0.05),
        'w_in_odd': nrm((N_ODD, D_MODEL, IN_ODD), D_MODEL ** -0.5),
        'conv_w': nrm((N_ODD, CONV_W, CONV_DIM), CONV_W ** -0.5),
        'conv_b': nrm((N_ODD, CONV_DIM), 0.02),
        'dt_bias': dt0 + jnp.log(-jnp.expm1(-dt0)),
        'a_log': jnp.log(unif((N_ODD, H_SSD), 1.0, 16.0)),
        'd_ssm': 1.0 + nrm((N_ODD, H_SSD), 0.05),
        'ssm_norm_w': 1.0 + nrm((N_ODD, D_INNER), 0.05),
        's5_lam_re': -0.5 + nrm((N_ODD, S5_G, S5_P), 0.01),
        's5_lam_im': math.pi * jnp.arange(S5_P, dtype=f32) + nrm((N_ODD, S5_G, S5_P), 0.01),
        's5_log_step': unif((N_ODD, S5_G), math.log(1e-3), math.log(1e-1)),
        's5_b_re': nrm((N_ODD, S5_G, S5_P, S5_GS), (2 * S5_GS) ** -0.5),
        's5_b_im': nrm((N_ODD, S5_G, S5_P, S5_GS), (2 * S5_GS) ** -0.5),
        's5_c_re': nrm((N_ODD, S5_G, S5_GS, S5_P), (2 * S5_P) ** -0.5),
        's5_c_im': nrm((N_ODD, S5_G, S5_GS, S5_P), (2 * S5_P) ** -0.5),
        's5_d': nrm((N_ODD, S5_WIDTH), 0.5),
        'w_glu': nrm((N_ODD, S5_WIDTH, S5_WIDTH), S5_WIDTH ** -0.5),
        'b_glu': nrm((N_ODD, S5_WIDTH), 0.02),
        'w_out_odd': nrm((N_ODD, MIX_ODD, D_MODEL), MIX_ODD ** -0.5),
        'w_ffn_up': nrm((DEPTH, D_MODEL, D_FF), D_MODEL ** -0.5),
        'w_ffn_down': nrm((DEPTH, D_FF, D_MODEL), D_FF ** -0.5),
    }


def reference(x_prompt, x_sample, state_ret, state_hgrn, state_ssm, state_conv, state_s5_re, state_s5_im,
              norm_mix_pre, norm_mix_post, norm_ffn_pre, norm_ffn_post, w_in_even, w_out_even, ret_norm_w,
              hgrn_lower_bounds, hgrn_norm_w, w_in_odd, conv_w, conv_b, dt_bias, a_log, d_ssm, ssm_norm_w,
              s5_lam_re, s5_lam_im, s5_log_step, s5_b_re, s5_b_im, s5_c_re, s5_c_im, s5_d, w_glu, b_glu,
              w_out_odd, w_ffn_up, w_ffn_down):
    p = dict(norm_mix_pre=norm_mix_pre, norm_mix_post=norm_mix_post, norm_ffn_pre=norm_ffn_pre,
             norm_ffn_post=norm_ffn_post, w_in_even=w_in_even, w_out_even=w_out_even, ret_norm_w=ret_norm_w,
             hgrn_lower_bounds=hgrn_lower_bounds, hgrn_norm_w=hgrn_norm_w, w_in_odd=w_in_odd, conv_w=conv_w,
             conv_b=conv_b, dt_bias=dt_bias, a_log=a_log, d_ssm=d_ssm, ssm_norm_w=ssm_norm_w,
             s5_lam_re=s5_lam_re, s5_lam_im=s5_lam_im, s5_log_step=s5_log_step, s5_b_re=s5_b_re,
             s5_b_im=s5_b_im, s5_c_re=s5_c_re, s5_c_im=s5_c_im, s5_d=s5_d, w_glu=w_glu, b_glu=b_glu,
             w_out_odd=w_out_odd, w_ffn_up=w_ffn_up, w_ffn_down=w_ffn_down)
    bp = x_prompt.shape[0]
    z_ret = jnp.zeros((N_EVEN, bp, H_RET, DK_RET, DV_RET), state_ret.dtype)
    z_hg = jnp.zeros((N_EVEN, bp, H_HG, DK_HG, DV_HG), state_hgrn.dtype)
    z_ssm = jnp.zeros((N_ODD, bp, H_SSD, N_SSD, P_SSD), state_ssm.dtype)
    z_conv = jnp.zeros((N_ODD, bp, CONV_W - 1, CONV_DIM), state_conv.dtype)
    z_re = jnp.zeros((N_ODD, bp, S5_G, S5_P), state_s5_re.dtype)
    z_im = jnp.zeros((N_ODD, bp, S5_G, S5_P), state_s5_im.dtype)
    y_prompt, ret_p, hgrn_p, ssm_p, conv_p, s5re_p, s5im_p = _forward(
        x_prompt, 0, z_ret, z_hg, z_ssm, z_conv, z_re, z_im, p)
    y_sample, ret_s, hgrn_s, ssm_s, conv_s, s5re_s, s5im_s = _forward(
        x_sample, PAST_LEN, state_ret, state_hgrn, state_ssm, state_conv, state_s5_re, state_s5_im, p)
    return (y_prompt, y_sample, ret_p, ret_s, hgrn_p, hgrn_s, ssm_p, ssm_s, conv_p, conv_s,
            s5re_p, s5re_s, s5im_p, s5im_s)
```

```cpp
#include <hip/hip_runtime.h>
#include <hip/hip_cooperative_groups.h>
#include <cstdio>
namespace cg = cooperative_groups;

typedef unsigned short bf16_t;
typedef short bf16x8 __attribute__((ext_vector_type(8)));
typedef float f32x4 __attribute__((ext_vector_type(4)));

#define NTHR 256
#define ROWS 17408
#define EPSV 1e-6f

constexpr size_t W_IN = 0;
constexpr size_t W_OUT0 = 8388608;
constexpr size_t W_GLU = 6553600;
constexpr size_t W_OUT1 = 7077888;
constexpr size_t W_UP = 10485760;
constexpr size_t W_DOWN = 18874368;
constexpr size_t OFF_A = 29360128;
constexpr size_t OFF_GBUF = OFF_A + 111411200;
constexpr size_t OFF_ST = OFF_A + 142606336;
constexpr size_t OFF_H = OFF_ST + 67108864;
constexpr size_t OFF_SM = OFF_H + 53477376;
constexpr size_t OFF_ROPE = OFF_SM;
constexpr size_t OFF_ROWSS = OFF_SM + 1052672;
constexpr size_t OFF_SSDST = OFF_SM + 1331200;
constexpr size_t OFF_DTBUF = OFF_SM + 1470464;
constexpr size_t OFF_LB = OFF_SM + 2584576;
constexpr size_t OFF_S5TAB = OFF_SM + 2586624;
constexpr size_t OFF_S5E = OFF_SM + 2897920;
constexpr size_t OFF_S5H = OFF_SM + 9189376;

constexpr size_t O_RET = 17825792, O_HG = 26738688, O_SSM = 35651584, O_CONV = 53477376, O_S5RE = 54104064, O_S5IM = 54382592;

struct Params {
  const float *x_prompt, *x_sample, *state_ret, *state_hgrn, *state_ssm, *state_conv, *state_s5_re, *state_s5_im;
  const float *norm_mix_pre, *norm_mix_post, *norm_ffn_pre, *norm_ffn_post;
  const float *w_in_even, *w_out_even, *ret_norm_w, *hgrn_lb, *hgrn_norm_w, *w_in_odd, *conv_w, *conv_b, *dt_bias, *a_log, *d_ssm, *ssm_norm_w;
  const float *s5_lam_re, *s5_lam_im, *s5_log_step, *s5_b_re, *s5_b_im, *s5_c_re, *s5_c_im, *s5_d, *w_glu, *b_glu, *w_out_odd, *w_ffn_up, *w_ffn_down;
  float* out;
  char* ws;
};

__device__ __forceinline__ bf16_t f2bf(float f) { unsigned u = __float_as_uint(f); u += 0x7fffu + ((u >> 16) & 1u); return (bf16_t)(u >> 16); }
__device__ __forceinline__ float bf2f(bf16_t h) { return __uint_as_float(((unsigned)h) << 16); }
__device__ __forceinline__ unsigned pack2(float a, float b) { return (unsigned)f2bf(a) | ((unsigned)f2bf(b) << 16); }
__device__ __forceinline__ float lo2f(unsigned u) { return __uint_as_float(u << 16); }
__device__ __forceinline__ float hi2f(unsigned u) { return __uint_as_float(u & 0xffff0000u); }
__device__ __forceinline__ float sigm(float x) { return 1.f / (1.f + __expf(-x)); }
__device__ __forceinline__ float siluf(float x) { return x / (1.f + __expf(-x)); }
__device__ __forceinline__ void store4bf(bf16_t* p, float a, float b, float c, float d) { uint2 v; v.x = pack2(a, b); v.y = pack2(c, d); *(uint2*)p = v; }

template <int MT, int NT>
__device__ __forceinline__ void wmma_sw(f32x4 (&acc)[MT][NT], const bf16_t* A, int lda, const bf16_t* B, int ldb, int K, int lane) {
  const int r = lane & 15, kq = (lane >> 4) * 8;
  for (int k0 = 0; k0 < K; k0 += 32) {
    bf16x8 af[MT], bfr[NT];
#pragma unroll
    for (int mt = 0; mt < MT; ++mt) af[mt] = *(const bf16x8*)(A + (mt * 16 + r) * lda + k0 + kq);
#pragma unroll
    for (int nt = 0; nt < NT; ++nt) bfr[nt] = *(const bf16x8*)(B + (nt * 16 + r) * ldb + k0 + kq);
#pragma unroll
    for (int mt = 0; mt < MT; ++mt)
#pragma unroll
      for (int nt = 0; nt < NT; ++nt) acc[mt][nt] = __builtin_amdgcn_mfma_f32_16x16x32_bf16(bfr[nt], af[mt], acc[mt][nt], 0, 0, 0);
  }
}
template <int MT, int NT>
__device__ __forceinline__ void wmma_ns(f32x4 (&acc)[MT][NT], const bf16_t* A, int lda, const bf16_t* B, int ldb, int K, int lane) {
  const int r = lane & 15, kq = (lane >> 4) * 8;
  for (int k0 = 0; k0 < K; k0 += 32) {
    bf16x8 af[MT], bfr[NT];
#pragma unroll
    for (int mt = 0; mt < MT; ++mt) af[mt] = *(const bf16x8*)(A + (mt * 16 + r) * lda + k0 + kq);
#pragma unroll
    for (int nt = 0; nt < NT; ++nt) bfr[nt] = *(const bf16x8*)(B + (nt * 16 + r) * ldb + k0 + kq);
#pragma unroll
    for (int mt = 0; mt < MT; ++mt)
#pragma unroll
      for (int nt = 0; nt < NT; ++nt) acc[mt][nt] = __builtin_amdgcn_mfma_f32_16x16x32_bf16(af[mt], bfr[nt], acc[mt][nt], 0, 0, 0);
  }
}

template <class Epi>
__device__ __forceinline__ void gemm_phase(const bf16_t* __restrict__ A, int lda, const bf16_t* __restrict__ Bt, int ldb, int nMt, int nNt, int K, const Epi& epi, char* smem) {
  bf16_t* As = (bf16_t*)smem;
  bf16_t* Bs = As + 2 * 128 * 72;
  const int tid = threadIdx.x, lane = tid & 63, wave = tid >> 6;
  const int ntiles = nMt * nNt, nk = K >> 6;
  const int lrow = tid >> 3, lcc = (tid & 7) * 8;
  for (int tile = blockIdx.x; tile < ntiles; tile += gridDim.x) {
    const int pm = tile / nNt, pn = tile - pm * nNt;
    const bf16_t* Ag = A + (size_t)(pm * 128 + lrow) * lda + lcc;
    const bf16_t* Bg = Bt + (size_t)(pn * 128 + lrow) * ldb + lcc;
    f32x4 acc[2][8];
#pragma unroll
    for (int i = 0; i < 2; ++i)
#pragma unroll
      for (int j = 0; j < 8; ++j) acc[i][j] = (f32x4){0.f, 0.f, 0.f, 0.f};
    uint4 ra[4], rb[4];
#pragma unroll
    for (int i = 0; i < 4; ++i) { ra[i] = *(const uint4*)(Ag + (size_t)(i * 32) * lda); rb[i] = *(const uint4*)(Bg + (size_t)(i * 32) * ldb); }
#pragma unroll
    for (int i = 0; i < 4; ++i) { *(uint4*)(As + (lrow + i * 32) * 72 + lcc) = ra[i]; *(uint4*)(Bs + (lrow + i * 32) * 72 + lcc) = rb[i]; }
    __syncthreads();
    for (int kt = 0; kt < nk; ++kt) {
      const int cur = kt & 1;
      if (kt + 1 < nk) {
#pragma unroll
        for (int i = 0; i < 4; ++i) { ra[i] = *(const uint4*)(Ag + (size_t)(i * 32) * lda + (kt + 1) * 64); rb[i] = *(const uint4*)(Bg + (size_t)(i * 32) * ldb + (kt + 1) * 64); }
      }
      wmma_sw<2, 8>(acc, As + cur * 128 * 72 + wave * 32 * 72, 72, Bs + cur * 128 * 72, 72, 64, lane);
      if (kt + 1 < nk) {
        bf16_t* Ad = As + (cur ^ 1) * 128 * 72; bf16_t* Bd = Bs + (cur ^ 1) * 128 * 72;
#pragma unroll
        for (int i = 0; i < 4; ++i) { *(uint4*)(Ad + (lrow + i * 32) * 72 + lcc) = ra[i]; *(uint4*)(Bd + (lrow + i * 32) * 72 + lcc) = rb[i]; }
      }
      __syncthreads();
    }
    epi(acc, pm * 128 + wave * 32, pn * 128, lane);
  }
}

struct EpiInEven {
  bf16_t* proj; const float* rope; const float* lb;
  __device__ __forceinline__ void operator()(f32x4 (&acc)[2][8], int rbase, int cbase, int lane) const {
    const int sec = cbase >> 9, head = (cbase >> 7) & 3, r = lane & 15, cq = (lane >> 4) * 4;
#pragma unroll
    for (int mt = 0; mt < 2; ++mt) {
      const int row = rbase + mt * 16 + r;
      bf16_t* dst = proj + (size_t)row * 4096 + cbase + cq;
      if (sec < 2) {
        const int pidx = row < 16384 ? (row & 2047) : 2048 + ((row - 16384) & 7);
        const float* ct = rope + pidx * 128 + cq;
        const float sc = sec == 1 ? 0.08838834764831845f : 1.f;
#pragma unroll
        for (int nt = 0; nt < 4; ++nt) {
          const float4 c4 = *(const float4*)(ct + nt * 16), s4 = *(const float4*)(ct + 64 + nt * 16);
          const f32x4 x1 = acc[mt][nt], x2 = acc[mt][nt + 4];
          store4bf(dst + nt * 16, (x1[0] * c4.x - x2[0] * s4.x) * sc, (x1[1] * c4.y - x2[1] * s4.y) * sc, (x1[2] * c4.z - x2[2] * s4.z) * sc, (x1[3] * c4.w - x2[3] * s4.w) * sc);
          store4bf(dst + 64 + nt * 16, (x1[0] * s4.x + x2[0] * c4.x) * sc, (x1[1] * s4.y + x2[1] * c4.y) * sc, (x1[2] * s4.z + x2[2] * c4.z) * sc, (x1[3] * s4.w + x2[3] * c4.w) * sc);
        }
      } else if (sec == 5) {
#pragma unroll
        for (int nt = 0; nt < 8; ++nt) {
          const float4 l4 = *(const float4*)(lb + head * 128 + nt * 16 + cq);
          const f32x4 x = acc[mt][nt];
          store4bf(dst + nt * 16, __logf(l4.x + (1.f - l4.x) * sigm(x[0])), __logf(l4.y + (1.f - l4.y) * sigm(x[1])), __logf(l4.z + (1.f - l4.z) * sigm(x[2])), __logf(l4.w + (1.f - l4.w) * sigm(x[3])));
        }
      } else {
#pragma unroll
        for (int nt = 0; nt < 8; ++nt) { const f32x4 x = acc[mt][nt]; store4bf(dst + nt * 16, x[0], x[1], x[2], x[3]); }
      }
    }
  }
};
struct EpiOut {
  bf16_t* t0; float* rowss;
  __device__ __forceinline__ void operator()(f32x4 (&acc)[2][8], int rbase, int cbase, int lane) const {
    const int r = lane & 15, cq = (lane >> 4) * 4;
#pragma unroll
    for (int mt = 0; mt < 2; ++mt) {
      const int row = rbase + mt * 16 + r;
      bf16_t* dst = t0 + (size_t)row * 1024 + cbase + cq;
      float ss = 0.f;
#pragma unroll
      for (int nt = 0; nt < 8; ++nt) { const f32x4 x = acc[mt][nt]; ss += x[0] * x[0] + x[1] * x[1] + x[2] * x[2] + x[3] * x[3]; store4bf(dst + nt * 16, x[0], x[1], x[2], x[3]); }
      ss += __shfl_xor(ss, 16); ss += __shfl_xor(ss, 32);
      if (lane < 16) atomicAdd(rowss + row, ss);
    }
  }
};
struct EpiUp {
  bf16_t* act;
  __device__ __forceinline__ void operator()(f32x4 (&acc)[2][8], int rbase, int cbase, int lane) const {
    const int r = lane & 15, cq = (lane >> 4) * 4;
#pragma unroll
    for (int mt = 0; mt < 2; ++mt) {
      bf16_t* dst = act + (size_t)(rbase + mt * 16 + r) * 4096 + cbase + cq;
#pragma unroll
      for (int nt = 0; nt < 8; ++nt) { f32x4 x = acc[mt][nt];
#pragma unroll
        for (int j = 0; j < 4; ++j) { float v = fmaxf(x[j], 0.f); x[j] = v * v; }
        store4bf(dst + nt * 16, x[0], x[1], x[2], x[3]); }
    }
  }
};
struct EpiInOdd {
  bf16_t* proj; float* dtbuf;
  __device__ __forceinline__ void operator()(f32x4 (&acc)[2][8], int rbase, int cbase, int lane) const {
    const int r = lane & 15, cq = (lane >> 4) * 4;
#pragma unroll
    for (int mt = 0; mt < 2; ++mt) {
      const int row = rbase + mt * 16 + r;
      bf16_t* dst = proj + (size_t)row * 3200 + cbase + cq;
#pragma unroll
      for (int nt = 0; nt < 8; ++nt) { const f32x4 x = acc[mt][nt]; store4bf(dst + nt * 16, x[0], x[1], x[2], x[3]); }
      if (cbase == 2560) { const f32x4 x = acc[mt][0]; *(float4*)(dtbuf + (size_t)row * 16 + cq) = make_float4(x[0], x[1], x[2], x[3]); }
    }
  }
};
struct EpiGlu {
  const bf16_t* gbuf; const float* bglu; bf16_t* mix;
  __device__ __forceinline__ void operator()(f32x4 (&acc)[2][8], int rbase, int cbase, int lane) const {
    const int r = lane & 15, cq = (lane >> 4) * 4;
#pragma unroll
    for (int mt = 0; mt < 2; ++mt) {
      const int row = rbase + mt * 16 + r;
#pragma unroll
      for (int nt = 0; nt < 8; ++nt) {
        const int col = cbase + nt * 16 + cq;
        const f32x4 x = acc[mt][nt];
        const uint2 g2 = *(const uint2*)(gbuf + (size_t)row * 512 + col);
        const float4 b4 = *(const float4*)(bglu + col);
        store4bf(mix + (size_t)row * 1536 + 1024 + col, lo2f(g2.x) * sigm(x[0] + b4.x), hi2f(g2.x) * sigm(x[1] + b4.y), lo2f(g2.y) * sigm(x[2] + b4.z), hi2f(g2.y) * sigm(x[3] + b4.w));
      }
    }
  }
};

__device__ __forceinline__ void rowpass_phase(const bf16_t* t0, const float* rowss, const float* wpost, const float* hin_a, const float* hin_b, float* hout, const float* wnext, bf16_t* hn) {
  const int lane = threadIdx.x & 63, gw = blockIdx.x * 4 + (threadIdx.x >> 6), nw = gridDim.x * 4;
  for (int row = gw; row < ROWS; row += nw) {
    const float* hin = row < 16384 ? hin_a + (size_t)row * 1024 : hin_b + (size_t)(row - 16384) * 1024;
    float r0 = 0.f;
    if (t0) r0 = rsqrtf(rowss[row] * (1.f / 1024.f) + EPSV);
    float4 v[4]; float ss = 0.f;
#pragma unroll
    for (int i = 0; i < 4; ++i) {
      const int col = (i * 64 + lane) * 4;
      float4 hv = *(const float4*)(hin + col);
      if (t0) {
        const uint2 t2 = *(const uint2*)(t0 + (size_t)row * 1024 + col);
        const float4 w4 = *(const float4*)(wpost + col);
        hv.x += lo2f(t2.x) * r0 * w4.x; hv.y += hi2f(t2.x) * r0 * w4.y; hv.z += lo2f(t2.y) * r0 * w4.z; hv.w += hi2f(t2.y) * r0 * w4.w;
      }
      v[i] = hv; ss += hv.x * hv.x + hv.y * hv.y + hv.z * hv.z + hv.w * hv.w;
      if (hout) *(float4*)(hout + (size_t)row * 1024 + col) = hv;
    }
    if (hn) {
#pragma unroll
      for (int o = 32; o >= 1; o >>= 1) ss += __shfl_xor(ss, o);
      const float r1 = rsqrtf(ss * (1.f / 1024.f) + EPSV);
#pragma unroll
      for (int i = 0; i < 4; ++i) {
        const int col = (i * 64 + lane) * 4;
        const float4 w4 = *(const float4*)(wnext + col);
        store4bf(hn + (size_t)row * 1024 + col, v[i].x * r1 * w4.x, v[i].y * r1 * w4.y, v[i].z * r1 * w4.z, v[i].w * r1 * w4.w);
      }
    }
  }
}

__device__ __forceinline__ void wconv(const float* __restrict__ W, int K, int N, int Npad, bf16_t* __restrict__ Wt, char* smem) {
  float* tile = (float*)smem;
  const int tid = threadIdx.x;
  const int nNt = Npad >> 6, nunits = (K >> 6) * nNt;
  for (int u = blockIdx.x; u < nunits; u += gridDim.x) {
    const int k0 = (u / nNt) * 64, n0 = (u % nNt) * 64;
#pragma unroll
    for (int ps = 0; ps < 4; ++ps) {
      const int i = ps * 16 + (tid >> 4), j = (tid & 15) * 4, n = n0 + j;
      float4 v = make_float4(0.f, 0.f, 0.f, 0.f);
      if (n < N) v = *(const float4*)(W + (size_t)(k0 + i) * N + n);
      tile[i * 65 + j] = v.x; tile[i * 65 + j + 1] = v.y; tile[i * 65 + j + 2] = v.z; tile[i * 65 + j + 3] = v.w;
    }
    __syncthreads();
    {
      const int n = tid >> 2, kq = (tid & 3) * 16;
      uint4 o0, o1;
      o0.x = pack2(tile[(kq + 0) * 65 + n], tile[(kq + 1) * 65 + n]); o0.y = pack2(tile[(kq + 2) * 65 + n], tile[(kq + 3) * 65 + n]);
      o0.z = pack2(tile[(kq + 4) * 65 + n], tile[(kq + 5) * 65 + n]); o0.w = pack2(tile[(kq + 6) * 65 + n], tile[(kq + 7) * 65 + n]);
      o1.x = pack2(tile[(kq + 8) * 65 + n], tile[(kq + 9) * 65 + n]); o1.y = pack2(tile[(kq + 10) * 65 + n], tile[(kq + 11) * 65 + n]);
      o1.z = pack2(tile[(kq + 12) * 65 + n], tile[(kq + 13) * 65 + n]); o1.w = pack2(tile[(kq + 14) * 65 + n], tile[(kq + 15) * 65 + n]);
      bf16_t* d = Wt + (size_t)(n0 + n) * K + k0 + kq;
      *(uint4*)d = o0; *(uint4*)(d + 8) = o1;
    }
    __syncthreads();
  }
}

__device__ __forceinline__ void prep_tables(const Params& p) {
  const int gt = blockIdx.x * NTHR + threadIdx.x, nt = gridDim.x * NTHR;
  float* rope = (float*)(p.ws + OFF_ROPE);
  for (int i = gt; i < 2056 * 64; i += nt) {
    const int pi = i >> 6, f = i & 63;
    const double pos = pi < 2048 ? (double)pi : (double)(16384 + pi - 2048);
    const double invf = exp(-(double)f * (9.210340371976184 / 64.0));
    double ang = pos * invf;
    ang -= 6.283185307179586 * floor(ang * 0.15915494309189535);
    const float a = (float)ang;
    rope[pi * 128 + f] = cosf(a); rope[pi * 128 + 64 + f] = sinf(a);
  }
  float* z = (float*)(p.ws + OFF_ROWSS);
  for (int i = gt; i < ROWS * 6; i += nt) z[i] = 0.f;
  float* lb = (float*)(p.ws + OFF_LB);
  for (int i = gt; i < 512; i += nt) lb[i] = 1.f / (1.f + expf(p.hgrn_lb[512 + i] - p.hgrn_lb[i]));
  float* tab = (float*)(p.ws + OFF_S5TAB);
  for (int i = gt; i < 2048; i += nt) {
    const int g = i >> 6;
    const float lr = p.s5_lam_re[i], li = p.s5_lam_im[i], dt = expf(p.s5_log_step[g]);
    const float m1 = expf(lr * dt), br = m1 * cosf(li * dt), bi = m1 * sinf(li * dt);
    tab[i] = br; tab[2048 + i] = bi;
    const float m64 = expf(lr * dt * 64.f); tab[69632 + i] = m64 * cosf(li * dt * 64.f); tab[71680 + i] = m64 * sinf(li * dt * 64.f);
    const float m8 = expf(lr * dt * 8.f); tab[73728 + i] = m8 * cosf(li * dt * 8.f); tab[75776 + i] = m8 * sinf(li * dt * 8.f);
    const float x = br - 1.f, y = bi, den = 1.f / (lr * lr + li * li);
    const float qr = (x * lr + y * li) * den, qi = (y * lr - x * li) * den;
    for (int c = 0; c < 16; ++c) {
      const float b_r = p.s5_b_re[i * 16 + c], b_i = p.s5_b_im[i * 16 + c];
      tab[4096 + i * 16 + c] = qr * b_r - qi * b_i;
      tab[4096 + 32768 + i * 16 + c] = qr * b_i + qi * b_r;
    }
  }
}

__device__ __forceinline__ void chunk_geom(int c, int& row0, int& L) { if (c < 256) { row0 = c * 64; L = 64; } else { row0 = 16384 + (c - 256) * 8; L = 8; } }

template <int MODE>
__device__ __forceinline__ void st_load(uint4 (&kr)[4], uint4 (&vr)[(MODE == 2) ? 2 : 1], float& dtr, const bf16_t* src, const float* dtbuf, int row0, int L, int ld, int kcol, int vcol, int h, int tid) {
  constexpr int PW = (MODE == 2) ? 64 : 32, NVC = PW / 32, VCR = PW / 8;
  const uint4 z4 = make_uint4(0, 0, 0, 0);
#pragma unroll
  for (int i = 0; i < 4; ++i) { const int id = tid + i * 256, s = id >> 4, c8 = id & 15; uint4 t_ = z4; if (s < L) t_ = *(const uint4*)(src + (size_t)(row0 + s) * ld + kcol + c8 * 8); kr[i] = t_; }
#pragma unroll
  for (int i = 0; i < NVC; ++i) { const int id = tid + i * 256, s = id / VCR, c8 = id % VCR; uint4 t_ = z4; if (s < L) t_ = *(const uint4*)(src + (size_t)(row0 + s) * ld + vcol + c8 * 8); vr[i] = t_; }
  if (MODE == 2 && tid < 64) dtr = tid < L ? dtbuf[(size_t)(row0 + tid) * 16 + h] : 0.f;
}

template <int MODE>
__device__ __forceinline__ void state_unit(const Params& p, int sq, int h, int ps, char* smem) {
  constexpr int PW = (MODE == 2) ? 64 : 32, NT = PW / 16, PF = (MODE == 2) ? 64 : 128, HH = (MODE == 2) ? 16 : 4, NVC = PW / 32, VCR = PW / 8;
  bf16_t* KT = (bf16_t*)smem;
  bf16_t* VT = KT + 128 * 72;
  bf16_t* KR = VT + 64 * 72;
  float* tot = (float*)(KR + 64 * 136);
  float* dec = tot + 256;
  float* av = dec + 64;
  float* dtv = av + 64;
  const int tid = threadIdx.x, lane = tid & 63, wave = tid >> 6;
  const bool prompt = sq < 8;
  const int nch = prompt ? 32 : 1, L = prompt ? 64 : 8;
  const int ld = (MODE == 2) ? 1536 : 4096;
  const bf16_t* src = (MODE == 2) ? (const bf16_t*)(p.ws + OFF_H) : (const bf16_t*)(p.ws + OFF_A);
  const int kcol = MODE == 0 ? 512 + h * 128 : MODE == 1 ? 2560 + h * 128 : 1024 + (h >> 3) * 128;
  const int vcol = MODE == 0 ? 1024 + h * 128 + ps * 32 : MODE == 1 ? 3072 + h * 128 + ps * 32 : h * 64;
  const float* sin_ = MODE == 0 ? p.state_ret : MODE == 1 ? p.state_hgrn : p.state_ssm;
  float* sout = p.out + (MODE == 0 ? O_RET : MODE == 1 ? O_HG : O_SSM) + (size_t)(sq * HH + h) * 128 * PF;
  bf16_t* stb = (bf16_t*)(p.ws + OFF_ST) + (MODE == 1 ? (size_t)256 * 4 * 128 * 128 : 0);
  const float* dtbuf = (const float*)(p.ws + OFF_DTBUF);
  const float l2g = MODE == 0 ? log2f(1.f - exp2f(-5.f - (float)h)) : 0.f;
  float Ah = 0.f, dtb = 0.f;
  if (MODE == 2) { Ah = -expf(p.a_log[h]); dtb = p.dt_bias[h]; }

  f32x4 acc[2][NT];
  const int nb = wave * 32 + (lane >> 4) * 4, pc = ps * PW + (lane & 15);
#pragma unroll
  for (int mt = 0; mt < 2; ++mt)
#pragma unroll
    for (int nt = 0; nt < NT; ++nt)
#pragma unroll
      for (int j = 0; j < 4; ++j)
        acc[mt][nt][j] = prompt ? 0.f : sin_[((size_t)((sq - 8) * HH + h) * 128 + nb + mt * 16 + j) * PF + pc + nt * 16];

  uint4 kr[4], vr[NVC]; float dtr = 0.f;
  const uint4 z4 = make_uint4(0, 0, 0, 0);
  st_load<MODE>(kr, vr, dtr, src, dtbuf, prompt ? sq * 2048 : 16384 + (sq - 8) * 8, L, ld, kcol, vcol, h, tid);
  for (int n = 0; n < nch; ++n) {
    if (prompt) {
      bf16_t* d = stb + ((size_t)((sq * 32 + n) * HH + h) * PF) * 128;
#pragma unroll
      for (int mt = 0; mt < 2; ++mt)
#pragma unroll
        for (int nt = 0; nt < NT; ++nt) store4bf(d + (size_t)(pc + nt * 16) * 128 + nb + mt * 16, acc[mt][nt][0], acc[mt][nt][1], acc[mt][nt][2], acc[mt][nt][3]);
    }
#pragma unroll
    for (int i = 0; i < 4; ++i) { const int id = tid + i * 256, s = id >> 4, c8 = id & 15; *(uint4*)(KR + s * 136 + c8 * 8) = kr[i]; }
#pragma unroll
    for (int i = 0; i < NVC; ++i) {
      const int id = tid + i * 256, s = id / VCR, c8 = id % VCR; const uint4 v = vr[i];
      bf16_t* d = VT + (c8 * 8) * 72 + s;
      d[0] = (bf16_t)(v.x & 0xffff); d[72] = (bf16_t)(v.x >> 16); d[144] = (bf16_t)(v.y & 0xffff); d[216] = (bf16_t)(v.y >> 16);
      d[288] = (bf16_t)(v.z & 0xffff); d[360] = (bf16_t)(v.z >> 16); d[432] = (bf16_t)(v.w & 0xffff); d[504] = (bf16_t)(v.w >> 16);
    }
    if (MODE == 2 && tid < 64) {
      float dt = 0.f;
      if (tid < L) { const float x = dtr + dtb; dt = x > 20.f ? x : log1pf(__expf(x)); }
      dtv[tid] = dt; av[tid] = dt * Ah;
    }
    if (n + 1 < nch) st_load<MODE>(kr, vr, dtr, src, dtbuf, sq * 2048 + (n + 1) * 64, L, ld, kcol, vcol, h, tid);
    __syncthreads();
    const int kn = tid & 127, half = tid >> 7;
    if (MODE == 1) {
      float s_ = 0.f;
      for (int s = half * 32; s < half * 32 + 32; ++s) s_ += bf2f(KR[s * 136 + kn]);
      tot[half * 128 + kn] = s_;
    }
    if (MODE == 2 && tid < 64) {
      float suf = 0.f;
      for (int r = tid + 1; r < 64; ++r) suf += av[r];
      dec[tid] = __expf(suf) * dtv[tid];
      if (tid == 0) tot[0] = suf + av[0];
    }
    if (MODE != 0) __syncthreads();
    {
      float suf = 0.f;
      if (MODE == 1) suf = half == 0 ? tot[128 + kn] : 0.f;
      for (int g = 3; g >= 0; --g) {
        const int s0 = half * 32 + g * 8;
        float v[8];
#pragma unroll
        for (int e = 7; e >= 0; --e) {
          const int s = s0 + e;
          const float raw = bf2f(KR[s * 136 + kn]);
          if (MODE == 0) v[e] = raw * exp2f((float)(L - 1 - s) * l2g);
          else if (MODE == 1) { v[e] = (1.f - __expf(raw)) * __expf(suf); suf += raw; }
          else v[e] = raw * dec[s];
        }
        uint4 o; o.x = pack2(v[0], v[1]); o.y = pack2(v[2], v[3]); o.z = pack2(v[4], v[5]); o.w = pack2(v[6], v[7]);
        *(uint4*)(KT + kn * 72 + s0) = o;
      }
    }
    __syncthreads();
#pragma unroll
    for (int mt = 0; mt < 2; ++mt) {
      float dk[4];
      if (MODE == 0) { const float d = exp2f((float)L * l2g); dk[0] = dk[1] = dk[2] = dk[3] = d; }
      else if (MODE == 2) { const float d = __expf(tot[0]); dk[0] = dk[1] = dk[2] = dk[3] = d; }
      else {
#pragma unroll
        for (int j = 0; j < 4; ++j) { const int nn = nb + mt * 16 + j; dk[j] = __expf(tot[nn] + tot[128 + nn]); }
      }
#pragma unroll
      for (int nt = 0; nt < NT; ++nt)
#pragma unroll
        for (int j = 0; j < 4; ++j) acc[mt][nt][j] *= dk[j];
    }
    wmma_ns<2, NT>(acc, KT + wave * 32 * 72, 72, VT, 72, 64, lane);
    __syncthreads();
  }
#pragma unroll
  for (int mt = 0; mt < 2; ++mt)
#pragma unroll
    for (int nt = 0; nt < NT; ++nt)
#pragma unroll
      for (int j = 0; j < 4; ++j) sout[(size_t)(nb + mt * 16 + j) * PF + pc + nt * 16] = acc[mt][nt][j];
}

template <int MODE>
__device__ __forceinline__ void out_unit(const Params& p, int c, int h, char* smem) {
  constexpr int PF = (MODE == 2) ? 64 : 128, NTP = PF / 16, HH = (MODE == 2) ? 16 : 4, NVC = PF / 32, VCR = PF / 8;
  bf16_t* Q = (bf16_t*)smem;
  bf16_t* Kb = Q + 64 * 136;
  bf16_t* STb = Kb + 128 * 72;
  float* cumv = (float*)(STb + 128 * 136);
  float* dtv = cumv + 64;
  float* av = dtv + 64;
  float* tot = av + 64;
  const int tid = threadIdx.x, lane = tid & 63, wave = tid >> 6;
  int row0, L; chunk_geom(c, row0, L);
  const int ld = (MODE == 2) ? 1536 : 4096;
  const bf16_t* src = (MODE == 2) ? (const bf16_t*)(p.ws + OFF_H) : (const bf16_t*)(p.ws + OFF_A);
  const int qcol = MODE == 0 ? h * 128 : MODE == 1 ? 2048 + h * 128 : 1280 + (h >> 3) * 128;
  const int kcol = MODE == 0 ? 512 + h * 128 : MODE == 1 ? 2560 + h * 128 : 1024 + (h >> 3) * 128;
  const int vcol = MODE == 0 ? 1024 + h * 128 : MODE == 1 ? 3072 + h * 128 : h * 64;
  const float l2g = MODE == 0 ? log2f(1.f - exp2f(-5.f - (float)h)) : 0.f;
  const uint4 z4 = make_uint4(0, 0, 0, 0);
#pragma unroll
  for (int i = 0; i < 4; ++i) {
    const int id = tid + i * 256, s = id >> 4, c8 = id & 15;
    uint4 q4 = z4, k4 = z4;
    if (s < L) { q4 = *(const uint4*)(src + (size_t)(row0 + s) * ld + qcol + c8 * 8); k4 = *(const uint4*)(src + (size_t)(row0 + s) * ld + kcol + c8 * 8); }
    *(uint4*)(Q + s * 136 + c8 * 8) = q4; *(uint4*)(Kb + s * 136 + c8 * 8) = k4;
  }
  uint4 vr[NVC];
#pragma unroll
  for (int i = 0; i < NVC; ++i) { const int id = tid + i * 256, s = id / VCR, c8 = id % VCR; uint4 t_ = z4; if (s < L) t_ = *(const uint4*)(src + (size_t)(row0 + s) * ld + vcol + c8 * 8); vr[i] = t_; }
  if (c < 256) {
    const bf16_t* stg = (const bf16_t*)(p.ws + OFF_ST) + (MODE == 1 ? (size_t)256 * 4 * 128 * 128 : 0) + ((size_t)(c * HH + h) * PF) * 128;
#pragma unroll
    for (int i = 0; i < PF / 16; ++i) { const int id = tid + i * 256, pr = id >> 4, c8 = id & 15; *(uint4*)(STb + pr * 136 + c8 * 8) = *(const uint4*)(stg + (size_t)pr * 128 + c8 * 8); }
  } else {
    const float* sg = (MODE == 0 ? p.state_ret : MODE == 1 ? p.state_hgrn : p.state_ssm) + (size_t)((c - 256) * HH + h) * 128 * PF;
    for (int id = tid; id < 128 * (PF / 4); id += 256) {
      const int n = id / (PF / 4), p4 = (id % (PF / 4)) * 4;
      const float4 v = *(const float4*)(sg + (size_t)n * PF + p4);
      STb[(p4 + 0) * 136 + n] = f2bf(v.x); STb[(p4 + 1) * 136 + n] = f2bf(v.y); STb[(p4 + 2) * 136 + n] = f2bf(v.z); STb[(p4 + 3) * 136 + n] = f2bf(v.w);
    }
  }
  if (MODE == 2 && tid < 64) {
    float dt = 0.f;
    if (tid < L) { const float x = ((const float*)(p.ws + OFF_DTBUF))[(size_t)(row0 + tid) * 16 + h] + p.dt_bias[h]; dt = x > 20.f ? x : log1pf(__expf(x)); }
    dtv[tid] = dt; av[tid] = -expf(p.a_log[h]) * dt;
  }
  __syncthreads();
  if (MODE == 1) {
    const int kn = tid & 127, half = tid >> 7;
    float s_ = 0.f;
    for (int s = half * 32; s < half * 32 + 32; ++s) s_ += bf2f(Kb[s * 136 + kn]);
    tot[half * 128 + kn] = s_;
    __syncthreads();
    float cum = half == 1 ? tot[kn] : 0.f;
    for (int s = half * 32; s < half * 32 + 32; ++s) {
      const float lf = bf2f(Kb[s * 136 + kn]);
      cum += lf;
      Q[s * 136 + kn] = f2bf(bf2f(Q[s * 136 + kn]) * __expf(cum));
      Kb[s * 136 + kn] = f2bf((1.f - __expf(lf)) * __expf(-cum));
    }
    __syncthreads();
  }
  if (MODE == 2) {
    if (tid < 64) { float cs = 0.f; for (int r = 0; r <= tid; ++r) cs += av[r]; cumv[tid] = cs; }
    __syncthreads();
  }
  f32x4 ai[1][NTP], asc[1][4];
#pragma unroll
  for (int j = 0; j < NTP; ++j) ai[0][j] = (f32x4){0.f, 0.f, 0.f, 0.f};
#pragma unroll
  for (int j = 0; j < 4; ++j) asc[0][j] = (f32x4){0.f, 0.f, 0.f, 0.f};
  wmma_sw<1, NTP>(ai, Q + wave * 16 * 136, 136, STb, 136, 128, lane);
  wmma_sw<1, 4>(asc, Q + wave * 16 * 136, 136, Kb, 136, 128, lane);
  const int t = wave * 16 + (lane & 15), sq4 = (lane >> 4) * 4;
  float ct = 0.f;
  if (MODE == 2) ct = cumv[t];
#pragma unroll
  for (int nt = 0; nt < 4; ++nt)
#pragma unroll
    for (int j = 0; j < 4; ++j) {
      const int s = nt * 16 + sq4 + j;
      float v = asc[0][nt][j];
      if (s > t) v = 0.f;
      else if (MODE == 0) v *= exp2f((float)(t - s) * l2g);
      else if (MODE == 2) v *= __expf(ct - cumv[s]) * dtv[s];
      asc[0][nt][j] = v;
    }
  __syncthreads();
  bf16_t* Pb = STb; bf16_t* VT = Kb;
#pragma unroll
  for (int nt = 0; nt < 4; ++nt) store4bf(Pb + t * 72 + nt * 16 + sq4, asc[0][nt][0], asc[0][nt][1], asc[0][nt][2], asc[0][nt][3]);
#pragma unroll
  for (int i = 0; i < NVC; ++i) {
    const int id = tid + i * 256, s = id / VCR, c8 = id % VCR; const uint4 v = vr[i];
    bf16_t* d = VT + (c8 * 8) * 72 + s;
    d[0] = (bf16_t)(v.x & 0xffff); d[72] = (bf16_t)(v.x >> 16); d[144] = (bf16_t)(v.y & 0xffff); d[216] = (bf16_t)(v.y >> 16);
    d[288] = (bf16_t)(v.z & 0xffff); d[360] = (bf16_t)(v.z >> 16); d[432] = (bf16_t)(v.w & 0xffff); d[504] = (bf16_t)(v.w >> 16);
  }
  __syncthreads();
  f32x4 ao[1][NTP];
#pragma unroll
  for (int j = 0; j < NTP; ++j) ao[0][j] = (f32x4){0.f, 0.f, 0.f, 0.f};
  wmma_sw<1, NTP>(ao, Pb + wave * 16 * 72, 72, VT, 72, 64, lane);
  float fi = 1.f;
  if (MODE == 0) fi = exp2f((float)(t + 1) * l2g);
  if (MODE == 2) fi = __expf(ct);
  const int row = row0 + t;
  const bool valid = t < L;
  if (MODE == 0 || MODE == 1) {
    float s1 = 0.f, s2 = 0.f;
#pragma unroll
    for (int nt = 0; nt < NTP; ++nt)
#pragma unroll
      for (int j = 0; j < 4; ++j) { const float o = ao[0][nt][j] + fi * ai[0][nt][j]; ao[0][nt][j] = o; s1 += o; s2 += o * o; }
    s1 += __shfl_xor(s1, 16); s1 += __shfl_xor(s1, 32); s2 += __shfl_xor(s2, 16); s2 += __shfl_xor(s2, 32);
    float mu = 0.f, rs;
    if (MODE == 0) { mu = s1 * (1.f / 128.f); const float var = fmaxf(s2 * (1.f / 128.f) - mu * mu, 0.f); rs = rsqrtf(var + EPSV); }
    else rs = rsqrtf(s2 * (1.f / 128.f) + EPSV);
    if (valid) {
      const float* nw = (MODE == 0 ? p.ret_norm_w : p.hgrn_norm_w) + h * 128;
      const int gcol = (MODE == 0 ? 1536 : 3584) + h * 128;
      bf16_t* mix = (bf16_t*)(p.ws + OFF_H) + (size_t)row * 1024 + (MODE == 0 ? 0 : 512) + h * 128;
#pragma unroll
      for (int nt = 0; nt < NTP; ++nt) {
        const int pp = nt * 16 + sq4;
        const float4 w4 = *(const float4*)(nw + pp);
        const uint2 g2 = *(const uint2*)(src + (size_t)row * ld + gcol + pp);
        store4bf(mix + pp, (ao[0][nt][0] - mu) * rs * w4.x * siluf(lo2f(g2.x)), (ao[0][nt][1] - mu) * rs * w4.y * siluf(hi2f(g2.x)),
                 (ao[0][nt][2] - mu) * rs * w4.z * siluf(lo2f(g2.y)), (ao[0][nt][3] - mu) * rs * w4.w * siluf(hi2f(g2.y)));
      }
    }
  } else {
    const float Dh = p.d_ssm[h];
    bf16_t* zy = (bf16_t*)(p.ws + OFF_A) + (size_t)row * 3200 + h * 64;
    float s2 = 0.f;
    if (valid) {
#pragma unroll
      for (int nt = 0; nt < NTP; ++nt) {
        const int pp = nt * 16 + sq4;
        const uint2 x2 = *(const uint2*)(src + (size_t)row * ld + vcol + pp);
        const uint2 z2 = *(const uint2*)(zy + pp);
        const float y0 = (ao[0][nt][0] + fi * ai[0][nt][0] + Dh * lo2f(x2.x)) * siluf(lo2f(z2.x));
        const float y1 = (ao[0][nt][1] + fi * ai[0][nt][1] + Dh * hi2f(x2.x)) * siluf(hi2f(z2.x));
        const float y2 = (ao[0][nt][2] + fi * ai[0][nt][2] + Dh * lo2f(x2.y)) * siluf(lo2f(z2.y));
        const float y3 = (ao[0][nt][3] + fi * ai[0][nt][3] + Dh * hi2f(x2.y)) * siluf(hi2f(z2.y));
        s2 += y0 * y0 + y1 * y1 + y2 * y2 + y3 * y3;
        store4bf(zy + pp, y0, y1, y2, y3);
      }
    }
    s2 += __shfl_xor(s2, 16); s2 += __shfl_xor(s2, 32);
    if (valid && lane < 16) atomicAdd((float*)(p.ws + OFF_SSDST) + (size_t)row * 2 + (h >> 3), s2);
  }
  __syncthreads();
}

template <int OUT>
__device__ __forceinline__ void s5_unit(const Params& p, int c, int gq, char* smem) {
  float* Uf = (float*)smem;
  bf16_t* HSall = (bf16_t*)(smem + 16384);
  bf16_t* CMall = (bf16_t*)(smem + 16384 + 34816);
  const int tid = threadIdx.x, lane = tid & 63, wave = tid >> 6;
  int row0, L; chunk_geom(c, row0, L);
  const bf16_t* proj = (const bf16_t*)(p.ws + OFF_A);
#pragma unroll
  for (int i = 0; i < 2; ++i) {
    const int id = tid + i * 256, s = id >> 3, c8 = id & 7;
    uint4 v = make_uint4(0, 0, 0, 0);
    if (s < L) v = *(const uint4*)(proj + (size_t)(row0 + s) * 3200 + 2576 + gq * 64 + c8 * 8);
    float* d = Uf + s * 64 + c8 * 8;
    d[0] = lo2f(v.x); d[1] = hi2f(v.x); d[2] = lo2f(v.y); d[3] = hi2f(v.y); d[4] = lo2f(v.z); d[5] = hi2f(v.z); d[6] = lo2f(v.w); d[7] = hi2f(v.w);
  }
  const int g = gq * 4 + wave, gp = g * 64 + lane;
  const float* tab = (const float*)(p.ws + OFF_S5TAB);
  const float lr = tab[gp], li = tab[2048 + gp];
  float bbr[16], bbi[16];
#pragma unroll
  for (int q = 0; q < 4; ++q) {
    const float4 a = *(const float4*)(tab + 4096 + gp * 16 + q * 4), b = *(const float4*)(tab + 4096 + 32768 + gp * 16 + q * 4);
    bbr[q * 4] = a.x; bbr[q * 4 + 1] = a.y; bbr[q * 4 + 2] = a.z; bbr[q * 4 + 3] = a.w;
    bbi[q * 4] = b.x; bbi[q * 4 + 1] = b.y; bbi[q * 4 + 2] = b.z; bbi[q * 4 + 3] = b.w;
  }
  float hr = 0.f, hi = 0.f;
  bf16_t* HS = HSall + wave * 32 * 136; bf16_t* CM = CMall + wave * 16 * 136;
  if (OUT) {
    const float2 h0 = *(const float2*)((const float*)(p.ws + OFF_S5H) + ((size_t)c * 2048 + gp) * 2);
    hr = h0.x; hi = h0.y;
#pragma unroll
    for (int ch = 0; ch < 16; ++ch) { CM[ch * 136 + lane] = f2bf(p.s5_c_re[(g * 16 + ch) * 64 + lane]); CM[ch * 136 + 64 + lane] = f2bf(-p.s5_c_im[(g * 16 + ch) * 64 + lane]); }
  }
  __syncthreads();
  const int nhalf = OUT ? ((L + 31) >> 5) : 1, tl = OUT ? 32 : 64;
  for (int hf = 0; hf < nhalf; ++hf) {
    for (int tt = 0; tt < tl; ++tt) {
      const int t = hf * 32 + tt;
      if (t < L) {
        const float* up = Uf + t * 64 + wave * 16;
        float bur = 0.f, bui = 0.f;
#pragma unroll
        for (int q = 0; q < 4; ++q) {
          const float4 u4 = *(const float4*)(up + q * 4);
          bur += bbr[q * 4] * u4.x + bbr[q * 4 + 1] * u4.y + bbr[q * 4 + 2] * u4.z + bbr[q * 4 + 3] * u4.w;
          bui += bbi[q * 4] * u4.x + bbi[q * 4 + 1] * u4.y + bbi[q * 4 + 2] * u4.z + bbi[q * 4 + 3] * u4.w;
        }
        const float nr = lr * hr - li * hi + bur, ni = lr * hi + li * hr + bui;
        hr = nr; hi = ni;
      }
      if (OUT) { HS[tt * 136 + lane] = f2bf(t < L ? hr : 0.f); HS[tt * 136 + 64 + lane] = f2bf(t < L ? hi : 0.f); }
    }
    if (OUT) {
      __syncthreads();
      f32x4 ay[2][1];
      ay[0][0] = (f32x4){0.f, 0.f, 0.f, 0.f}; ay[1][0] = (f32x4){0.f, 0.f, 0.f, 0.f};
      wmma_sw<2, 1>(ay, HS, 136, CM, 136, 128, lane);
      bf16_t* gbuf = (bf16_t*)(p.ws + OFF_GBUF);
#pragma unroll
      for (int mt = 0; mt < 2; ++mt) {
        const int t = hf * 32 + mt * 16 + (lane & 15), ch0 = (lane >> 4) * 4;
        if (t < L) {
          const float4 u4 = *(const float4*)(Uf + t * 64 + wave * 16 + ch0);
          const float4 d4 = *(const float4*)(p.s5_d + g * 16 + ch0);
          float y[4] = {ay[mt][0][0] + d4.x * u4.x, ay[mt][0][1] + d4.y * u4.y, ay[mt][0][2] + d4.z * u4.z, ay[mt][0][3] + d4.w * u4.w};
#pragma unroll
          for (int j = 0; j < 4; ++j) { const float x = y[j], uu = 0.7978845608028654f * (x + 0.044715f * x * x * x); y[j] = x / (1.f + __expf(-2.f * uu)); }
          store4bf(gbuf + (size_t)(row0 + t) * 512 + g * 16 + ch0, y[0], y[1], y[2], y[3]);
        }
      }
      __syncthreads();
    }
  }
  if (!OUT) { *(float2*)((float*)(p.ws + OFF_S5E) + ((size_t)c * 2048 + gp) * 2) = make_float2(hr, hi); }
  __syncthreads();
}

__device__ __forceinline__ void s5_prefix(const Params& p, int gt) {
  const int sq = gt >> 11, rem = gt & 2047;
  const float* tab = (const float*)(p.ws + OFF_S5TAB);
  const float* e = (const float*)(p.ws + OFF_S5E);
  float* hs = (float*)(p.ws + OFF_S5H);
  float hr = 0.f, hi = 0.f;
  if (sq < 8) {
    const float lr = tab[69632 + rem], li = tab[71680 + rem];
    for (int n = 0; n < 32; ++n) {
      const size_t idx = ((size_t)(sq * 32 + n) * 2048 + rem) * 2;
      *(float2*)(hs + idx) = make_float2(hr, hi);
      const float2 ev = *(const float2*)(e + idx);
      const float nr = lr * hr - li * hi + ev.x, ni = lr * hi + li * hr + ev.y; hr = nr; hi = ni;
    }
  } else {
    const float lr = tab[73728 + rem], li = tab[75776 + rem];
    hr = p.state_s5_re[(size_t)(sq - 8) * 2048 + rem]; hi = p.state_s5_im[(size_t)(sq - 8) * 2048 + rem];
    const size_t idx = ((size_t)(256 + sq - 8) * 2048 + rem) * 2;
    *(float2*)(hs + idx) = make_float2(hr, hi);
    const float2 ev = *(const float2*)(e + idx);
    const float nr = lr * hr - li * hi + ev.x, ni = lr * hi + li * hr + ev.y; hr = nr; hi = ni;
  }
  p.out[O_S5RE + (size_t)sq * 2048 + rem] = hr;
  p.out[O_S5IM + (size_t)sq * 2048 + rem] = hi;
}

__device__ __forceinline__ void conv_phase(const Params& p) {
  const bf16_t* proj = (const bf16_t*)(p.ws + OFF_A);
  bf16_t* xc = (bf16_t*)(p.ws + OFF_H);
  const int gt = blockIdx.x * NTHR + threadIdx.x, nt = gridDim.x * NTHR;
  for (int it = gt; it < ROWS * 192; it += nt) {
    const int row = it / 192, c = (it % 192) * 8;
    int t, T, sq;
    if (row < 16384) { t = row & 2047; T = 2048; sq = row >> 11; } else { t = (row - 16384) & 7; T = 8; sq = 8 + ((row - 16384) >> 3); }
    float a[8];
    { const float4 b0 = *(const float4*)(p.conv_b + c), b1 = *(const float4*)(p.conv_b + c + 4); a[0] = b0.x; a[1] = b0.y; a[2] = b0.z; a[3] = b0.w; a[4] = b1.x; a[5] = b1.y; a[6] = b1.z; a[7] = b1.w; }
    float cur[8];
#pragma unroll
    for (int j = 0; j < 4; ++j) {
      const int tt = t - 3 + j;
      float x[8];
      if (tt >= 0) {
        const uint4 v = *(const uint4*)(proj + (size_t)(row - 3 + j) * 3200 + 1024 + c);
        x[0] = lo2f(v.x); x[1] = hi2f(v.x); x[2] = lo2f(v.y); x[3] = hi2f(v.y); x[4] = lo2f(v.z); x[5] = hi2f(v.z); x[6] = lo2f(v.w); x[7] = hi2f(v.w);
      } else if (sq >= 8) {
        const float* sc = p.state_conv + ((size_t)(sq - 8) * 3 + (3 + tt)) * 1536 + c;
        const float4 v0 = *(const float4*)sc, v1 = *(const float4*)(sc + 4);
        x[0] = v0.x; x[1] = v0.y; x[2] = v0.z; x[3] = v0.w; x[4] = v1.x; x[5] = v1.y; x[6] = v1.z; x[7] = v1.w;
      } else {
#pragma unroll
        for (int e = 0; e < 8; ++e) x[e] = 0.f;
      }
      const float4 w0 = *(const float4*)(p.conv_w + j * 1536 + c), w1 = *(const float4*)(p.conv_w + j * 1536 + c + 4);
      a[0] += w0.x * x[0]; a[1] += w0.y * x[1]; a[2] += w0.z * x[2]; a[3] += w0.w * x[3]; a[4] += w1.x * x[4]; a[5] += w1.y * x[5]; a[6] += w1.z * x[6]; a[7] += w1.w * x[7];
      if (j == 3) {
#pragma unroll
        for (int e = 0; e < 8; ++e) cur[e] = x[e];
      }
    }
    uint4 o; o.x = pack2(siluf(a[0]), siluf(a[1])); o.y = pack2(siluf(a[2]), siluf(a[3])); o.z = pack2(siluf(a[4]), siluf(a[5])); o.w = pack2(siluf(a[6]), siluf(a[7]));
    *(uint4*)(xc + (size_t)row * 1536 + c) = o;
    if (t >= T - 3) {
      float* d = p.out + O_CONV + ((size_t)sq * 3 + (t - (T - 3))) * 1536 + c;
      *(float4*)d = make_float4(cur[0], cur[1], cur[2], cur[3]); *(float4*)(d + 4) = make_float4(cur[4], cur[5], cur[6], cur[7]);
    }
  }
}

__device__ __forceinline__ void ssdnorm_phase(const Params& p) {
  const bf16_t* proj = (const bf16_t*)(p.ws + OFF_A);
  bf16_t* mix = (bf16_t*)(p.ws + OFF_H);
  const float* st = (const float*)(p.ws + OFF_SSDST);
  const int gt = blockIdx.x * NTHR + threadIdx.x, nt = gridDim.x * NTHR;
  for (int it = gt; it < ROWS * 128; it += nt) {
    const int row = it >> 7, c = (it & 127) * 8;
    const float r = rsqrtf(st[(size_t)row * 2 + (c >> 9)] * (1.f / 512.f) + EPSV);
    const uint4 v = *(const uint4*)(proj + (size_t)row * 3200 + c);
    const float4 w0 = *(const float4*)(p.ssm_norm_w + c), w1 = *(const float4*)(p.ssm_norm_w + c + 4);
    uint4 o; o.x = pack2(lo2f(v.x) * r * w0.x, hi2f(v.x) * r * w0.y); o.y = pack2(lo2f(v.y) * r * w0.z, hi2f(v.y) * r * w0.w);
    o.z = pack2(lo2f(v.z) * r * w1.x, hi2f(v.z) * r * w1.y); o.w = pack2(lo2f(v.w) * r * w1.z, hi2f(v.w) * r * w1.w);
    *(uint4*)(mix + (size_t)row * 1536 + c) = o;
  }
}

__global__ void __launch_bounds__(NTHR, 2) fwd_megakernel(Params p) {
  extern __shared__ __attribute__((aligned(16))) char smem[];
  cg::grid_group grid = cg::this_grid();
  const int G = gridDim.x, bid = blockIdx.x;
  bf16_t* W = (bf16_t*)p.ws;
  bf16_t* bufA = (bf16_t*)(p.ws + OFF_A);
  bf16_t* bufH = (bf16_t*)(p.ws + OFF_H);
  bf16_t* t0 = (bf16_t*)(p.ws + OFF_ST);
  float* rowss = (float*)(p.ws + OFF_ROWSS);
  float* hbuf = p.out;

  prep_tables(p);
  wconv(p.w_in_even, 1024, 4096, 4096, (bf16_t*)(p.ws + W_IN), smem);
  wconv(p.w_out_even, 1024, 1024, 1024, (bf16_t*)(p.ws + W_OUT0), smem);
  wconv(p.w_ffn_up, 1024, 4096, 4096, (bf16_t*)(p.ws + W_UP), smem);
  wconv(p.w_ffn_down, 4096, 1024, 1024, (bf16_t*)(p.ws + W_DOWN), smem);
  rowpass_phase(nullptr, nullptr, nullptr, p.x_prompt, p.x_sample, nullptr, p.norm_mix_pre, bufH);
  grid.sync();
  { EpiInEven e{bufA, (const float*)(p.ws + OFF_ROPE), (const float*)(p.ws + OFF_LB)};
    gemm_phase(bufH, 1024, (const bf16_t*)(p.ws + W_IN), 1024, 136, 32, 1024, e, smem); }
  grid.sync();
  for (int u = bid; u < 256 + 4096; u += G) {
    int v = u < 256 ? u : u - 256;
    const int m = v & 1; v >>= 1;
    const int ps = v & 3, h = (v >> 2) & 3, sq = (u < 256 ? 0 : 8) + (v >> 4);
    if (m == 0) state_unit<0>(p, sq, h, ps, smem); else state_unit<1>(p, sq, h, ps, smem);
  }
  grid.sync();
  for (int u = bid; u < 384 * 8; u += G) {
    const int m = u & 1, h = (u >> 1) & 3, c = u >> 3;
    if (m == 0) out_unit<0>(p, c, h, smem); else out_unit<1>(p, c, h, smem);
  }
  grid.sync();
  { EpiOut e{t0, rowss};
    gemm_phase(bufH, 1024, (const bf16_t*)(p.ws + W_OUT0), 1024, 136, 8, 1024, e, smem); }
  grid.sync();
  rowpass_phase(t0, rowss, p.norm_mix_post, p.x_prompt, p.x_sample, hbuf, p.norm_ffn_pre, bufH);
  grid.sync();
  { EpiUp e{bufA}; gemm_phase(bufH, 1024, (const bf16_t*)(p.ws + W_UP), 1024, 136, 32, 1024, e, smem); }
  grid.sync();
  { EpiOut e{t0, rowss + ROWS}; gemm_phase(bufA, 4096, (const bf16_t*)(p.ws + W_DOWN), 4096, 136, 8, 4096, e, smem); }
  grid.sync();
  rowpass_phase(t0, rowss + ROWS, p.norm_ffn_post, hbuf, hbuf + (size_t)16384 * 1024, hbuf, p.norm_mix_pre + 1024, bufH);
  wconv(p.w_in_odd, 1024, 3088, 3200, (bf16_t*)(p.ws + W_IN), smem);
  wconv(p.w_glu, 512, 512, 512, (bf16_t*)(p.ws + W_GLU), smem);
  wconv(p.w_out_odd, 1536, 1024, 1024, (bf16_t*)(p.ws + W_OUT1), smem);
  wconv(p.w_ffn_up + (size_t)1024 * 4096, 1024, 4096, 4096, (bf16_t*)(p.ws + W_UP), smem);
  wconv(p.w_ffn_down + (size_t)4096 * 1024, 4096, 1024, 1024, (bf16_t*)(p.ws + W_DOWN), smem);
  grid.sync();
  { EpiInOdd e{bufA, (float*)(p.ws + OFF_DTBUF)};
    gemm_phase(bufH, 1024, (const bf16_t*)(p.ws + W_IN), 1024, 136, 25, 1024, e, smem); }
  grid.sync();
  conv_phase(p);
  for (int u = bid; u < 384 * 8; u += G) s5_unit<0>(p, u >> 3, u & 7, smem);
  grid.sync();
  for (int u = bid; u < 128 + 1088 + 2048; u += G) {
    if (u < 128) state_unit<2>(p, u >> 4, u & 15, 0, smem);
    else if (u < 128 + 1088) s5_prefix(p, (u - 128) * NTHR + threadIdx.x);
    else { const int v = u - 128 - 1088; state_unit<2>(p, 8 + (v >> 4), v & 15, 0, smem); }
  }
  grid.sync();
  for (int u = bid; u < 384 * 16 + 384 * 8; u += G) {
    if (u < 384 * 16) out_unit<2>(p, u >> 4, u & 15, smem);
    else { const int v = u - 384 * 16; s5_unit<1>(p, v >> 3, v & 7, smem); }
  }
  grid.sync();
  ssdnorm_phase(p);
  { EpiGlu e{(const bf16_t*)(p.ws + OFF_GBUF), p.b_glu, bufH};
    gemm_phase((const bf16_t*)(p.ws + OFF_GBUF), 512, (const bf16_t*)(p.ws + W_GLU), 512, 136, 4, 512, e, smem); }
  grid.sync();
  { EpiOut e{t0, rowss + 2 * ROWS}; gemm_phase(bufH, 1536, (const bf16_t*)(p.ws + W_OUT1), 1536, 136, 8, 1536, e, smem); }
  grid.sync();
  rowpass_phase(t0, rowss + 2 * ROWS, p.norm_mix_post + 1024, hbuf, hbuf + (size_t)16384 * 1024, hbuf, p.norm_ffn_pre + 1024, bufH);
  grid.sync();
  { EpiUp e{bufA}; gemm_phase(bufH, 1024, (const bf16_t*)(p.ws + W_UP), 1024, 136, 32, 1024, e, smem); }
  grid.sync();
  { EpiOut e{t0, rowss + 3 * ROWS}; gemm_phase(bufA, 4096, (const bf16_t*)(p.ws + W_DOWN), 4096, 136, 8, 4096, e, smem); }
  grid.sync();
  rowpass_phase(t0, rowss + 3 * ROWS, p.norm_ffn_post + 1024, hbuf, hbuf + (size_t)16384 * 1024, hbuf, nullptr, nullptr);
}

extern "C" void kernel_launch(void* const* d_in, const int* in_sizes, int n_in, void* d_out, int out_size, void* d_ws, size_t ws_size, hipStream_t stream) {
  constexpr size_t kDynLds = 81920;
  static int grid_blocks = 0;
  if (!grid_blocks) {
    int dev = 0, cus = 0, per_cu = 0;
    hipGetDevice(&dev);
    hipDeviceGetAttribute(&cus, hipDeviceAttributeMultiprocessorCount, dev);
    hipFuncSetAttribute((const void*)fwd_megakernel, hipFuncAttributeMaxDynamicSharedMemorySize, (int)kDynLds);
    hipOccupancyMaxActiveBlocksPerMultiprocessor(&per_cu, fwd_megakernel, NTHR, kDynLds);
    if (per_cu > 2) per_cu = 2;
    if (per_cu < 1) per_cu = 1;
    grid_blocks = cus * per_cu;
  }
  Params p{};
  const float** pf = (const float**)&p;
  for (int i = 0; i < 37; ++i) pf[i] = (const float*)d_in[i];
  p.out = (float*)d_out;
  p.ws = (char*)d_ws;
  void* args[] = {&p};
  hipError_t e = hipLaunchCooperativeKernel((void*)fwd_megakernel, dim3(grid_blocks), dim3(NTHR), args, kDynLds, stream);
  if (e != hipSuccess) fprintf(stderr, "cooperative launch failed: %s (grid %d)\n", hipGetErrorString(e), grid_blocks);
}
```

```cpp
#include <hip/hip_runtime.h>
#include <hip/hip_cooperative_groups.h>
#include <cstdio>
namespace cg = cooperative_groups;

typedef unsigned short bf16_t;
typedef short bf16x8 __attribute__((ext_vector_type(8)));
typedef float f32x4 __attribute__((ext_vector_type(4)));
typedef unsigned u32x4 __attribute__((ext_vector_type(4)));

#define NTHR 256
#ifndef REP0
#define REP0 1
#endif
#ifndef REPS
#define REPS 1
#endif
#ifndef REPO
#define REPO 1
#endif
#ifndef REPC
#define REPC 1
#endif
#ifndef REPY
#define REPY 21
#endif
#define ROWS 17408
#define EPSV 1e-6f

constexpr size_t W_IN = 0;
constexpr size_t W_OUT0 = 8388608;
constexpr size_t W_GLU = 6553600;
constexpr size_t W_OUT1 = 7077888;
constexpr size_t W_UP = 10485760;
constexpr size_t W_DOWN = 18874368;
constexpr size_t OFF_A = 29360128;
constexpr size_t OFF_GBUF = OFF_A + 111411200;
constexpr size_t OFF_ST = OFF_A + 142606336;
constexpr size_t OFF_H = OFF_ST + 67108864;
constexpr size_t OFF_SM = OFF_H + 53477376;
constexpr size_t OFF_ROPE = OFF_SM;
constexpr size_t OFF_ROWSS = OFF_SM + 1052672;
constexpr size_t OFF_SSDST = OFF_SM + 1331200;
constexpr size_t OFF_DTBUF = OFF_SM + 1470464;
constexpr size_t OFF_LB = OFF_SM + 2584576;
constexpr size_t OFF_S5TAB = OFF_SM + 2586624;
constexpr size_t OFF_S5E = OFF_SM + 2897920;
constexpr size_t OFF_S5H = OFF_SM + 9189376;
constexpr size_t OFF_BAR = OFF_SM + 15480832;

constexpr size_t O_RET = 17825792, O_HG = 26738688, O_SSM = 35651584, O_CONV = 53477376, O_S5RE = 54104064, O_S5IM = 54382592;

struct Params {
  const float *x_prompt, *x_sample, *state_ret, *state_hgrn, *state_ssm, *state_conv, *state_s5_re, *state_s5_im;
  const float *norm_mix_pre, *norm_mix_post, *norm_ffn_pre, *norm_ffn_post;
  const float *w_in_even, *w_out_even, *ret_norm_w, *hgrn_lb, *hgrn_norm_w, *w_in_odd, *conv_w, *conv_b, *dt_bias, *a_log, *d_ssm, *ssm_norm_w;
  const float *s5_lam_re, *s5_lam_im, *s5_log_step, *s5_b_re, *s5_b_im, *s5_c_re, *s5_c_im, *s5_d, *w_glu, *b_glu, *w_out_odd, *w_ffn_up, *w_ffn_down;
  float* out;
  char* ws;
};

__device__ __forceinline__ bf16_t f2bf(float f) { unsigned u = __float_as_uint(f); u += 0x7fffu + ((u >> 16) & 1u); return (bf16_t)(u >> 16); }
__device__ __forceinline__ float bf2f(bf16_t h) { return __uint_as_float(((unsigned)h) << 16); }
__device__ __forceinline__ unsigned pack2(float a, float b) { return (unsigned)f2bf(a) | ((unsigned)f2bf(b) << 16); }
__device__ __forceinline__ float lo2f(unsigned u) { return __uint_as_float(u << 16); }
__device__ __forceinline__ float hi2f(unsigned u) { return __uint_as_float(u & 0xffff0000u); }
__device__ __forceinline__ float sigm(float x) { return 1.f / (1.f + __expf(-x)); }
__device__ __forceinline__ float siluf(float x) { return x / (1.f + __expf(-x)); }
__device__ __forceinline__ void store4bf(bf16_t* p, float a, float b, float c, float d) { uint2 v; v.x = pack2(a, b); v.y = pack2(c, d); *(uint2*)p = v; }

template <int MT, int NT>
__device__ __forceinline__ void wmma_sw(f32x4 (&acc)[MT][NT], const bf16_t* A, int lda, const bf16_t* B, int ldb, int K, int lane) {
  const int r = lane & 15, kq = (lane >> 4) * 8;
  for (int k0 = 0; k0 < K; k0 += 32) {
    bf16x8 af[MT], bfr[NT];
#pragma unroll
    for (int mt = 0; mt < MT; ++mt) af[mt] = *(const bf16x8*)(A + (mt * 16 + r) * lda + k0 + kq);
#pragma unroll
    for (int nt = 0; nt < NT; ++nt) bfr[nt] = *(const bf16x8*)(B + (nt * 16 + r) * ldb + k0 + kq);
#pragma unroll
    for (int mt = 0; mt < MT; ++mt)
#pragma unroll
      for (int nt = 0; nt < NT; ++nt) acc[mt][nt] = __builtin_amdgcn_mfma_f32_16x16x32_bf16(bfr[nt], af[mt], acc[mt][nt], 0, 0, 0);
  }
}
template <int MT, int NT>
__device__ __forceinline__ void wmma_ns(f32x4 (&acc)[MT][NT], const bf16_t* A, int lda, const bf16_t* B, int ldb, int K, int lane) {
  const int r = lane & 15, kq = (lane >> 4) * 8;
  for (int k0 = 0; k0 < K; k0 += 32) {
    bf16x8 af[MT], bfr[NT];
#pragma unroll
    for (int mt = 0; mt < MT; ++mt) af[mt] = *(const bf16x8*)(A + (mt * 16 + r) * lda + k0 + kq);
#pragma unroll
    for (int nt = 0; nt < NT; ++nt) bfr[nt] = *(const bf16x8*)(B + (nt * 16 + r) * ldb + k0 + kq);
#pragma unroll
    for (int mt = 0; mt < MT; ++mt)
#pragma unroll
      for (int nt = 0; nt < NT; ++nt) acc[mt][nt] = __builtin_amdgcn_mfma_f32_16x16x32_bf16(af[mt], bfr[nt], acc[mt][nt], 0, 0, 0);
  }
}

template <class Epi>
__device__ __forceinline__ void gemm_phase(const bf16_t* A, int lda, const bf16_t* Bt, int ldb, int nMt, int nNt, int K, const Epi& epi, char* smem) {
  bf16_t* As = (bf16_t*)smem;
  bf16_t* Bs = As + 2 * 128 * 72;
  const int tid = threadIdx.x, lane = tid & 63, wave = tid >> 6;
  const int ntiles = nMt * nNt, nk = K >> 6;
  const int lrow = tid >> 3, lcc = (tid & 7) * 8;
  for (int tile = blockIdx.x; tile < ntiles; tile += gridDim.x) {
    const int pm = tile / nNt, pn = tile - pm * nNt;
    const bf16_t* Ag = A + (size_t)(pm * 128 + lrow) * lda + lcc;
    const bf16_t* Bg = Bt + (size_t)(pn * 128 + lrow) * ldb + lcc;
    f32x4 acc[2][8];
#pragma unroll
    for (int i = 0; i < 2; ++i)
#pragma unroll
      for (int j = 0; j < 8; ++j) acc[i][j] = (f32x4){0.f, 0.f, 0.f, 0.f};
    u32x4 ra[4], rb[4];
#pragma unroll
    for (int i = 0; i < 4; ++i) { ra[i] = *(const u32x4*)(Ag + (size_t)(i * 32) * lda); rb[i] = *(const u32x4*)(Bg + (size_t)(i * 32) * ldb); }
#pragma unroll
    for (int i = 0; i < 4; ++i) { *(u32x4*)(As + (lrow + i * 32) * 72 + lcc) = ra[i]; *(u32x4*)(Bs + (lrow + i * 32) * 72 + lcc) = rb[i]; }
    __syncthreads();
    for (int kt = 0; kt < nk; ++kt) {
      const int cur = kt & 1;
      const int kn = (kt + 1 < nk ? kt + 1 : kt) * 64;
#pragma unroll
      for (int i = 0; i < 4; ++i) { ra[i] = *(const u32x4*)(Ag + (size_t)(i * 32) * lda + kn); rb[i] = *(const u32x4*)(Bg + (size_t)(i * 32) * ldb + kn); }
      __builtin_amdgcn_sched_barrier(0);
      wmma_sw<2, 8>(acc, As + cur * 128 * 72 + wave * 32 * 72, 72, Bs + cur * 128 * 72, 72, 64, lane);
      __builtin_amdgcn_sched_barrier(0);
      {
        bf16_t* Ad = As + (cur ^ 1) * 128 * 72; bf16_t* Bd = Bs + (cur ^ 1) * 128 * 72;
#pragma unroll
        for (int i = 0; i < 4; ++i) { *(u32x4*)(Ad + (lrow + i * 32) * 72 + lcc) = ra[i]; *(u32x4*)(Bd + (lrow + i * 32) * 72 + lcc) = rb[i]; }
      }
      __syncthreads();
    }
    epi(acc, pm * 128 + wave * 32, pn * 128, lane);
  }
}

struct EpiInEven {
  bf16_t* proj; const float* rope; const float* lb;
  __device__ __forceinline__ void operator()(f32x4 (&acc)[2][8], int rbase, int cbase, int lane) const {
    const int sec = cbase >> 9, head = (cbase >> 7) & 3, r = lane & 15, cq = (lane >> 4) * 4;
#pragma unroll
    for (int mt = 0; mt < 2; ++mt) {
      const int row = rbase + mt * 16 + r;
      bf16_t* dst = proj + (size_t)row * 4096 + cbase + cq;
      if (sec < 2) {
        const int pidx = row < 16384 ? (row & 2047) : 2048 + ((row - 16384) & 7);
        const float* ct = rope + pidx * 128 + cq;
        const float sc = sec == 1 ? 0.08838834764831845f : 1.f;
#pragma unroll
        for (int nt = 0; nt < 4; ++nt) {
          const float4 c4 = *(const float4*)(ct + nt * 16), s4 = *(const float4*)(ct + 64 + nt * 16);
          const f32x4 x1 = acc[mt][nt], x2 = acc[mt][nt + 4];
          store4bf(dst + nt * 16, (x1[0] * c4.x - x2[0] * s4.x) * sc, (x1[1] * c4.y - x2[1] * s4.y) * sc, (x1[2] * c4.z - x2[2] * s4.z) * sc, (x1[3] * c4.w - x2[3] * s4.w) * sc);
          store4bf(dst + 64 + nt * 16, (x1[0] * s4.x + x2[0] * c4.x) * sc, (x1[1] * s4.y + x2[1] * c4.y) * sc, (x1[2] * s4.z + x2[2] * c4.z) * sc, (x1[3] * s4.w + x2[3] * c4.w) * sc);
        }
      } else if (sec == 5) {
#pragma unroll
        for (int nt = 0; nt < 8; ++nt) {
          const float4 l4 = *(const float4*)(lb + head * 128 + nt * 16 + cq);
          const f32x4 x = acc[mt][nt];
          store4bf(dst + nt * 16, __logf(l4.x + (1.f - l4.x) * sigm(x[0])), __logf(l4.y + (1.f - l4.y) * sigm(x[1])), __logf(l4.z + (1.f - l4.z) * sigm(x[2])), __logf(l4.w + (1.f - l4.w) * sigm(x[3])));
        }
      } else {
#pragma unroll
        for (int nt = 0; nt < 8; ++nt) { const f32x4 x = acc[mt][nt]; store4bf(dst + nt * 16, x[0], x[1], x[2], x[3]); }
      }
    }
  }
};
struct EpiOut {
  bf16_t* t0; float* rowss;
  __device__ __forceinline__ void operator()(f32x4 (&acc)[2][8], int rbase, int cbase, int lane) const {
    const int r = lane & 15, cq = (lane >> 4) * 4;
#pragma unroll
    for (int mt = 0; mt < 2; ++mt) {
      const int row = rbase + mt * 16 + r;
      bf16_t* dst = t0 + (size_t)row * 1024 + cbase + cq;
      float ss = 0.f;
#pragma unroll
      for (int nt = 0; nt < 8; ++nt) { const f32x4 x = acc[mt][nt]; ss += x[0] * x[0] + x[1] * x[1] + x[2] * x[2] + x[3] * x[3]; store4bf(dst + nt * 16, x[0], x[1], x[2], x[3]); }
      ss += __shfl_xor(ss, 16); ss += __shfl_xor(ss, 32);
      if (lane < 16) atomicAdd(rowss + row, ss);
    }
  }
};
struct EpiUp {
  bf16_t* act;
  __device__ __forceinline__ void operator()(f32x4 (&acc)[2][8], int rbase, int cbase, int lane) const {
    const int r = lane & 15, cq = (lane >> 4) * 4;
#pragma unroll
    for (int mt = 0; mt < 2; ++mt) {
      bf16_t* dst = act + (size_t)(rbase + mt * 16 + r) * 4096 + cbase + cq;
#pragma unroll
      for (int nt = 0; nt < 8; ++nt) { f32x4 x = acc[mt][nt];
#pragma unroll
        for (int j = 0; j < 4; ++j) { float v = fmaxf(x[j], 0.f); x[j] = v * v; }
        store4bf(dst + nt * 16, x[0], x[1], x[2], x[3]); }
    }
  }
};
struct EpiInOdd {
  bf16_t* proj; float* dtbuf;
  __device__ __forceinline__ void operator()(f32x4 (&acc)[2][8], int rbase, int cbase, int lane) const {
    const int r = lane & 15, cq = (lane >> 4) * 4;
#pragma unroll
    for (int mt = 0; mt < 2; ++mt) {
      const int row = rbase + mt * 16 + r;
      bf16_t* dst = proj + (size_t)row * 3200 + cbase + cq;
#pragma unroll
      for (int nt = 0; nt < 8; ++nt) { const f32x4 x = acc[mt][nt]; store4bf(dst + nt * 16, x[0], x[1], x[2], x[3]); }
      if (cbase == 2560) { const f32x4 x = acc[mt][0]; *(float4*)(dtbuf + (size_t)row * 16 + cq) = make_float4(x[0], x[1], x[2], x[3]); }
    }
  }
};
struct EpiGlu {
  const bf16_t* gbuf; const float* bglu; bf16_t* mix;
  __device__ __forceinline__ void operator()(f32x4 (&acc)[2][8], int rbase, int cbase, int lane) const {
    const int r = lane & 15, cq = (lane >> 4) * 4;
#pragma unroll
    for (int mt = 0; mt < 2; ++mt) {
      const int row = rbase + mt * 16 + r;
#pragma unroll
      for (int nt = 0; nt < 8; ++nt) {
        const int col = cbase + nt * 16 + cq;
        const f32x4 x = acc[mt][nt];
        const uint2 g2 = *(const uint2*)(gbuf + (size_t)row * 512 + col);
        const float4 b4 = *(const float4*)(bglu + col);
        store4bf(mix + (size_t)row * 1536 + 1024 + col, lo2f(g2.x) * sigm(x[0] + b4.x), hi2f(g2.x) * sigm(x[1] + b4.y), lo2f(g2.y) * sigm(x[2] + b4.z), hi2f(g2.y) * sigm(x[3] + b4.w));
      }
    }
  }
};

__device__ __forceinline__ void rowpass_phase(const bf16_t* t0, const float* rowss, const float* wpost, const float* hin_a, const float* hin_b, float* hout, const float* wnext, bf16_t* hn) {
  const int lane = threadIdx.x & 63, gw = blockIdx.x * 4 + (threadIdx.x >> 6), nw = gridDim.x * 4;
  for (int row = gw; row < ROWS; row += nw) {
    const float* hin = row < 16384 ? hin_a + (size_t)row * 1024 : hin_b + (size_t)(row - 16384) * 1024;
    float r0 = 0.f;
    if (t0) r0 = rsqrtf(rowss[row] * (1.f / 1024.f) + EPSV);
    float4 v[4]; float ss = 0.f;
#pragma unroll
    for (int i = 0; i < 4; ++i) {
      const int col = (i * 64 + lane) * 4;
      float4 hv = *(const float4*)(hin + col);
      if (t0) {
        const uint2 t2 = *(const uint2*)(t0 + (size_t)row * 1024 + col);
        const float4 w4 = *(const float4*)(wpost + col);
        hv.x += lo2f(t2.x) * r0 * w4.x; hv.y += hi2f(t2.x) * r0 * w4.y; hv.z += lo2f(t2.y) * r0 * w4.z; hv.w += hi2f(t2.y) * r0 * w4.w;
      }
      v[i] = hv; ss += hv.x * hv.x + hv.y * hv.y + hv.z * hv.z + hv.w * hv.w;
      if (hout) *(float4*)(hout + (size_t)row * 1024 + col) = hv;
    }
    if (hn) {
#pragma unroll
      for (int o = 32; o >= 1; o >>= 1) ss += __shfl_xor(ss, o);
      const float r1 = rsqrtf(ss * (1.f / 1024.f) + EPSV);
#pragma unroll
      for (int i = 0; i < 4; ++i) {
        const int col = (i * 64 + lane) * 4;
        const float4 w4 = *(const float4*)(wnext + col);
        store4bf(hn + (size_t)row * 1024 + col, v[i].x * r1 * w4.x, v[i].y * r1 * w4.y, v[i].z * r1 * w4.z, v[i].w * r1 * w4.w);
      }
    }
  }
}

__device__ __forceinline__ void wconv(const float* __restrict__ W, int K, int N, int Npad, bf16_t* __restrict__ Wt, char* smem) {
  float* tile = (float*)smem;
  const int tid = threadIdx.x;
  const int nNt = Npad >> 6, nunits = (K >> 6) * nNt;
  for (int u = blockIdx.x; u < nunits; u += gridDim.x) {
    const int k0 = (u / nNt) * 64, n0 = (u % nNt) * 64;
#pragma unroll
    for (int ps = 0; ps < 4; ++ps) {
      const int i = ps * 16 + (tid >> 4), j = (tid & 15) * 4, n = n0 + j;
      float4 v = make_float4(0.f, 0.f, 0.f, 0.f);
      if (n < N) v = *(const float4*)(W + (size_t)(k0 + i) * N + n);
      tile[i * 65 + j] = v.x; tile[i * 65 + j + 1] = v.y; tile[i * 65 + j + 2] = v.z; tile[i * 65 + j + 3] = v.w;
    }
    __syncthreads();
    {
      const int n = tid >> 2, kq = (tid & 3) * 16;
      uint4 o0, o1;
      o0.x = pack2(tile[(kq + 0) * 65 + n], tile[(kq + 1) * 65 + n]); o0.y = pack2(tile[(kq + 2) * 65 + n], tile[(kq + 3) * 65 + n]);
      o0.z = pack2(tile[(kq + 4) * 65 + n], tile[(kq + 5) * 65 + n]); o0.w = pack2(tile[(kq + 6) * 65 + n], tile[(kq + 7) * 65 + n]);
      o1.x = pack2(tile[(kq + 8) * 65 + n], tile[(kq + 9) * 65 + n]); o1.y = pack2(tile[(kq + 10) * 65 + n], tile[(kq + 11) * 65 + n]);
      o1.z = pack2(tile[(kq + 12) * 65 + n], tile[(kq + 13) * 65 + n]); o1.w = pack2(tile[(kq + 14) * 65 + n], tile[(kq + 15) * 65 + n]);
      bf16_t* d = Wt + (size_t)(n0 + n) * K + k0 + kq;
      *(uint4*)d = o0; *(uint4*)(d + 8) = o1;
    }
    __syncthreads();
  }
}

__device__ __forceinline__ void prep_tables(const Params& p) {
  const int gt = blockIdx.x * NTHR + threadIdx.x, nt = gridDim.x * NTHR;
  float* rope = (float*)(p.ws + OFF_ROPE);
  for (int i = gt; i < 2056 * 64; i += nt) {
    const int pi = i >> 6, f = i & 63;
    const double pos = pi < 2048 ? (double)pi : (double)(16384 + pi - 2048);
    const double invf = exp(-(double)f * (9.210340371976184 / 64.0));
    double ang = pos * invf;
    ang -= 6.283185307179586 * floor(ang * 0.15915494309189535);
    const float a = (float)ang;
    rope[pi * 128 + f] = cosf(a); rope[pi * 128 + 64 + f] = sinf(a);
  }
  float* z = (float*)(p.ws + OFF_ROWSS);
  for (int i = gt; i < ROWS * 6; i += nt) z[i] = 0.f;
  float* lb = (float*)(p.ws + OFF_LB);
  for (int i = gt; i < 512; i += nt) lb[i] = 1.f / (1.f + expf(p.hgrn_lb[512 + i] - p.hgrn_lb[i]));
  float* tab = (float*)(p.ws + OFF_S5TAB);
  for (int i = gt; i < 2048; i += nt) {
    const int g = i >> 6;
    const float lr = p.s5_lam_re[i], li = p.s5_lam_im[i], dt = expf(p.s5_log_step[g]);
    const float m1 = expf(lr * dt), br = m1 * cosf(li * dt), bi = m1 * sinf(li * dt);
    tab[i] = br; tab[2048 + i] = bi;
    const float m64 = expf(lr * dt * 64.f); tab[69632 + i] = m64 * cosf(li * dt * 64.f); tab[71680 + i] = m64 * sinf(li * dt * 64.f);
    const float m8 = expf(lr * dt * 8.f); tab[73728 + i] = m8 * cosf(li * dt * 8.f); tab[75776 + i] = m8 * sinf(li * dt * 8.f);
    const float x = br - 1.f, y = bi, den = 1.f / (lr * lr + li * li);
    const float qr = (x * lr + y * li) * den, qi = (y * lr - x * li) * den;
    for (int c = 0; c < 16; ++c) {
      const float b_r = p.s5_b_re[i * 16 + c], b_i = p.s5_b_im[i * 16 + c];
      tab[4096 + i * 16 + c] = qr * b_r - qi * b_i;
      tab[4096 + 32768 + i * 16 + c] = qr * b_i + qi * b_r;
    }
  }
}

__device__ __forceinline__ void chunk_geom(int c, int& row0, int& L) { if (c < 256) { row0 = c * 64; L = 64; } else { row0 = 16384 + (c - 256) * 8; L = 8; } }

template <int MODE>
__device__ __forceinline__ void st_load(uint4 (&kr)[4], uint4 (&vr)[(MODE == 2) ? 2 : 1], float& dtr, const bf16_t* src, const float* dtbuf, int row0, int L, int ld, int kcol, int vcol, int h, int tid) {
  constexpr int PW = (MODE == 2) ? 64 : 32, NVC = PW / 32, VCR = PW / 8;
  const uint4 z4 = make_uint4(0, 0, 0, 0);
#pragma unroll
  for (int i = 0; i < 4; ++i) { const int id = tid + i * 256, s = id >> 4, c8 = id & 15; uint4 t_ = z4; if (s < L) t_ = *(const uint4*)(src + (size_t)(row0 + s) * ld + kcol + c8 * 8); kr[i] = t_; }
#pragma unroll
  for (int i = 0; i < NVC; ++i) { const int id = tid + i * 256, s = id / VCR, c8 = id % VCR; uint4 t_ = z4; if (s < L) t_ = *(const uint4*)(src + (size_t)(row0 + s) * ld + vcol + c8 * 8); vr[i] = t_; }
  if (MODE == 2 && tid < 64) dtr = tid < L ? dtbuf[(size_t)(row0 + tid) * 16 + h] : 0.f;
}

template <int MODE>
__device__ __forceinline__ void state_unit(const Params& p, int sq, int h, int ps, char* smem) {
  constexpr int PW = (MODE == 2) ? 64 : 32, NT = PW / 16, PF = (MODE == 2) ? 64 : 128, HH = (MODE == 2) ? 16 : 4, NVC = PW / 32, VCR = PW / 8;
  bf16_t* KT = (bf16_t*)smem;
  bf16_t* VT = KT + 128 * 72;
  bf16_t* KR = VT + 64 * 72;
  float* tot = (float*)(KR + 64 * 136);
  float* dec = tot + 256;
  float* av = dec + 64;
  float* dtv = av + 64;
  const int tid = threadIdx.x, lane = tid & 63, wave = tid >> 6;
  const bool prompt = sq < 8;
  const int nch = prompt ? 32 : 1, L = prompt ? 64 : 8;
  const int ld = (MODE == 2) ? 1536 : 4096;
  const bf16_t* src = (MODE == 2) ? (const bf16_t*)(p.ws + OFF_H) : (const bf16_t*)(p.ws + OFF_A);
  const int kcol = MODE == 0 ? 512 + h * 128 : MODE == 1 ? 2560 + h * 128 : 1024 + (h >> 3) * 128;
  const int vcol = MODE == 0 ? 1024 + h * 128 + ps * 32 : MODE == 1 ? 3072 + h * 128 + ps * 32 : h * 64;
  const float* sin_ = MODE == 0 ? p.state_ret : MODE == 1 ? p.state_hgrn : p.state_ssm;
  float* sout = p.out + (MODE == 0 ? O_RET : MODE == 1 ? O_HG : O_SSM) + (size_t)(sq * HH + h) * 128 * PF;
  bf16_t* stb = (bf16_t*)(p.ws + OFF_ST) + (MODE == 1 ? (size_t)256 * 4 * 128 * 128 : 0);
  const float* dtbuf = (const float*)(p.ws + OFF_DTBUF);
  const float l2g = MODE == 0 ? log2f(1.f - exp2f(-5.f - (float)h)) : 0.f;
  float Ah = 0.f, dtb = 0.f;
  if (MODE == 2) { Ah = -expf(p.a_log[h]); dtb = p.dt_bias[h]; }

  f32x4 acc[2][NT];
  const int nb = wave * 32 + (lane >> 4) * 4, pc = ps * PW + (lane & 15);
#pragma unroll
  for (int mt = 0; mt < 2; ++mt)
#pragma unroll
    for (int nt = 0; nt < NT; ++nt)
#pragma unroll
      for (int j = 0; j < 4; ++j)
        acc[mt][nt][j] = prompt ? 0.f : sin_[((size_t)((sq - 8) * HH + h) * 128 + nb + mt * 16 + j) * PF + pc + nt * 16];

  uint4 kr[4], vr[NVC]; float dtr = 0.f;
  const uint4 z4 = make_uint4(0, 0, 0, 0);
  st_load<MODE>(kr, vr, dtr, src, dtbuf, prompt ? sq * 2048 : 16384 + (sq - 8) * 8, L, ld, kcol, vcol, h, tid);
  for (int n = 0; n < nch; ++n) {
    if (prompt) {
      bf16_t* d = stb + ((size_t)((sq * 32 + n) * HH + h) * PF) * 128;
#pragma unroll
      for (int mt = 0; mt < 2; ++mt)
#pragma unroll
        for (int nt = 0; nt < NT; ++nt) store4bf(d + (size_t)(pc + nt * 16) * 128 + nb + mt * 16, acc[mt][nt][0], acc[mt][nt][1], acc[mt][nt][2], acc[mt][nt][3]);
    }
#pragma unroll
    for (int i = 0; i < 4; ++i) { const int id = tid + i * 256, s = id >> 4, c8 = id & 15; *(uint4*)(KR + s * 136 + c8 * 8) = kr[i]; }
#pragma unroll
    for (int i = 0; i < NVC; ++i) {
      const int id = tid + i * 256, s = id / VCR, c8 = id % VCR; const uint4 v = vr[i];
      bf16_t* d = VT + (c8 * 8) * 72 + s;
      d[0] = (bf16_t)(v.x & 0xffff); d[72] = (bf16_t)(v.x >> 16); d[144] = (bf16_t)(v.y & 0xffff); d[216] = (bf16_t)(v.y >> 16);
      d[288] = (bf16_t)(v.z & 0xffff); d[360] = (bf16_t)(v.z >> 16); d[432] = (bf16_t)(v.w & 0xffff); d[504] = (bf16_t)(v.w >> 16);
    }
    if (MODE == 2 && tid < 64) {
      float dt = 0.f;
      if (tid < L) { const float x = dtr + dtb; dt = x > 20.f ? x : log1pf(__expf(x)); }
      dtv[tid] = dt; av[tid] = dt * Ah;
    }
    if (n + 1 < nch) st_load<MODE>(kr, vr, dtr, src, dtbuf, sq * 2048 + (n + 1) * 64, L, ld, kcol, vcol, h, tid);
    __syncthreads();
    const int kn = tid & 127, half = tid >> 7;
    if (MODE == 1) {
      float s_ = 0.f;
      for (int s = half * 32; s < half * 32 + 32; ++s) s_ += bf2f(KR[s * 136 + kn]);
      tot[half * 128 + kn] = s_;
    }
    if (MODE == 2 && tid < 64) {
      float suf = 0.f;
      for (int r = tid + 1; r < 64; ++r) suf += av[r];
      dec[tid] = __expf(suf) * dtv[tid];
      if (tid == 0) tot[0] = suf + av[0];
    }
    if (MODE != 0) __syncthreads();
    {
      float suf = 0.f;
      if (MODE == 1) suf = half == 0 ? tot[128 + kn] : 0.f;
      for (int g = 3; g >= 0; --g) {
        const int s0 = half * 32 + g * 8;
        float v[8];
#pragma unroll
        for (int e = 7; e >= 0; --e) {
          const int s = s0 + e;
          const float raw = bf2f(KR[s * 136 + kn]);
          if (MODE == 0) v[e] = raw * exp2f((float)(L - 1 - s) * l2g);
          else if (MODE == 1) { v[e] = (1.f - __expf(raw)) * __expf(suf); suf += raw; }
          else v[e] = raw * dec[s];
        }
        uint4 o; o.x = pack2(v[0], v[1]); o.y = pack2(v[2], v[3]); o.z = pack2(v[4], v[5]); o.w = pack2(v[6], v[7]);
        *(uint4*)(KT + kn * 72 + s0) = o;
      }
    }
    __syncthreads();
#pragma unroll
    for (int mt = 0; mt < 2; ++mt) {
      float dk[4];
      if (MODE == 0) { const float d = exp2f((float)L * l2g); dk[0] = dk[1] = dk[2] = dk[3] = d; }
      else if (MODE == 2) { const float d = __expf(tot[0]); dk[0] = dk[1] = dk[2] = dk[3] = d; }
      else {
#pragma unroll
        for (int j = 0; j < 4; ++j) { const int nn = nb + mt * 16 + j; dk[j] = __expf(tot[nn] + tot[128 + nn]); }
      }
#pragma unroll
      for (int nt = 0; nt < NT; ++nt)
#pragma unroll
        for (int j = 0; j < 4; ++j) acc[mt][nt][j] *= dk[j];
    }
    wmma_ns<2, NT>(acc, KT + wave * 32 * 72, 72, VT, 72, 64, lane);
    __syncthreads();
  }
#pragma unroll
  for (int mt = 0; mt < 2; ++mt)
#pragma unroll
    for (int nt = 0; nt < NT; ++nt)
#pragma unroll
      for (int j = 0; j < 4; ++j) sout[(size_t)(nb + mt * 16 + j) * PF + pc + nt * 16] = acc[mt][nt][j];
}

template <int MODE>
__device__ __forceinline__ void out_unit(const Params& p, int c, int h, char* smem) {
  constexpr int PF = (MODE == 2) ? 64 : 128, NTP = PF / 16, HH = (MODE == 2) ? 16 : 4, NVC = PF / 32, VCR = PF / 8;
  bf16_t* Q = (bf16_t*)smem;
  bf16_t* Kb = Q + 64 * 136;
  bf16_t* STb = Kb + 128 * 72;
  float* cumv = (float*)(STb + 128 * 136);
  float* dtv = cumv + 64;
  float* av = dtv + 64;
  float* tot = av + 64;
  const int tid = threadIdx.x, lane = tid & 63, wave = tid >> 6;
  int row0, L; chunk_geom(c, row0, L);
  const int ld = (MODE == 2) ? 1536 : 4096;
  const bf16_t* src = (MODE == 2) ? (const bf16_t*)(p.ws + OFF_H) : (const bf16_t*)(p.ws + OFF_A);
  const int qcol = MODE == 0 ? h * 128 : MODE == 1 ? 2048 + h * 128 : 1280 + (h >> 3) * 128;
  const int kcol = MODE == 0 ? 512 + h * 128 : MODE == 1 ? 2560 + h * 128 : 1024 + (h >> 3) * 128;
  const int vcol = MODE == 0 ? 1024 + h * 128 : MODE == 1 ? 3072 + h * 128 : h * 64;
  const float l2g = MODE == 0 ? log2f(1.f - exp2f(-5.f - (float)h)) : 0.f;
  const uint4 z4 = make_uint4(0, 0, 0, 0);
#pragma unroll
  for (int i = 0; i < 4; ++i) {
    const int id = tid + i * 256, s = id >> 4, c8 = id & 15;
    uint4 q4 = z4, k4 = z4;
    if (s < L) { q4 = *(const uint4*)(src + (size_t)(row0 + s) * ld + qcol + c8 * 8); k4 = *(const uint4*)(src + (size_t)(row0 + s) * ld + kcol + c8 * 8); }
    *(uint4*)(Q + s * 136 + c8 * 8) = q4; *(uint4*)(Kb + s * 136 + c8 * 8) = k4;
  }
  uint4 vr[NVC];
#pragma unroll
  for (int i = 0; i < NVC; ++i) { const int id = tid + i * 256, s = id / VCR, c8 = id % VCR; uint4 t_ = z4; if (s < L) t_ = *(const uint4*)(src + (size_t)(row0 + s) * ld + vcol + c8 * 8); vr[i] = t_; }
  if (c < 256) {
    const bf16_t* stg = (const bf16_t*)(p.ws + OFF_ST) + (MODE == 1 ? (size_t)256 * 4 * 128 * 128 : 0) + ((size_t)(c * HH + h) * PF) * 128;
#pragma unroll
    for (int i = 0; i < PF / 16; ++i) { const int id = tid + i * 256, pr = id >> 4, c8 = id & 15; *(uint4*)(STb + pr * 136 + c8 * 8) = *(const uint4*)(stg + (size_t)pr * 128 + c8 * 8); }
  } else {
    const float* sg = (MODE == 0 ? p.state_ret : MODE == 1 ? p.state_hgrn : p.state_ssm) + (size_t)((c - 256) * HH + h) * 128 * PF;
    for (int id = tid; id < 128 * (PF / 4); id += 256) {
      const int n = id / (PF / 4), p4 = (id % (PF / 4)) * 4;
      const float4 v = *(const float4*)(sg + (size_t)n * PF + p4);
      STb[(p4 + 0) * 136 + n] = f2bf(v.x); STb[(p4 + 1) * 136 + n] = f2bf(v.y); STb[(p4 + 2) * 136 + n] = f2bf(v.z); STb[(p4 + 3) * 136 + n] = f2bf(v.w);
    }
  }
  if (MODE == 2 && tid < 64) {
    float dt = 0.f;
    if (tid < L) { const float x = ((const float*)(p.ws + OFF_DTBUF))[(size_t)(row0 + tid) * 16 + h] + p.dt_bias[h]; dt = x > 20.f ? x : log1pf(__expf(x)); }
    dtv[tid] = dt; av[tid] = -expf(p.a_log[h]) * dt;
  }
  __syncthreads();
  if (MODE == 1) {
    const int kn = tid & 127, half = tid >> 7;
    float s_ = 0.f;
    for (int s = half * 32; s < half * 32 + 32; ++s) s_ += bf2f(Kb[s * 136 + kn]);
    tot[half * 128 + kn] = s_;
    __syncthreads();
    float cum = half == 1 ? tot[kn] : 0.f;
    for (int s = half * 32; s < half * 32 + 32; ++s) {
      const float lf = bf2f(Kb[s * 136 + kn]);
      cum += lf;
      Q[s * 136 + kn] = f2bf(bf2f(Q[s * 136 + kn]) * __expf(cum));
      Kb[s * 136 + kn] = f2bf((1.f - __expf(lf)) * __expf(-cum));
    }
    __syncthreads();
  }
  if (MODE == 2) {
    if (tid < 64) { float cs = 0.f; for (int r = 0; r <= tid; ++r) cs += av[r]; cumv[tid] = cs; }
    __syncthreads();
  }
  f32x4 ai[1][NTP], asc[1][4];
#pragma unroll
  for (int j = 0; j < NTP; ++j) ai[0][j] = (f32x4){0.f, 0.f, 0.f, 0.f};
#pragma unroll
  for (int j = 0; j < 4; ++j) asc[0][j] = (f32x4){0.f, 0.f, 0.f, 0.f};
  wmma_sw<1, NTP>(ai, Q + wave * 16 * 136, 136, STb, 136, 128, lane);
  wmma_sw<1, 4>(asc, Q + wave * 16 * 136, 136, Kb, 136, 128, lane);
  const int t = wave * 16 + (lane & 15), sq4 = (lane >> 4) * 4;
  float ct = 0.f;
  if (MODE == 2) ct = cumv[t];
#pragma unroll
  for (int nt = 0; nt < 4; ++nt)
#pragma unroll
    for (int j = 0; j < 4; ++j) {
      const int s = nt * 16 + sq4 + j;
      float v = asc[0][nt][j];
      if (s > t) v = 0.f;
      else if (MODE == 0) v *= exp2f((float)(t - s) * l2g);
      else if (MODE == 2) v *= __expf(ct - cumv[s]) * dtv[s];
      asc[0][nt][j] = v;
    }
  __syncthreads();
  bf16_t* Pb = STb; bf16_t* VT = Kb;
#pragma unroll
  for (int nt = 0; nt < 4; ++nt) store4bf(Pb + t * 72 + nt * 16 + sq4, asc[0][nt][0], asc[0][nt][1], asc[0][nt][2], asc[0][nt][3]);
#pragma unroll
  for (int i = 0; i < NVC; ++i) {
    const int id = tid + i * 256, s = id / VCR, c8 = id % VCR; const uint4 v = vr[i];
    bf16_t* d = VT + (c8 * 8) * 72 + s;
    d[0] = (bf16_t)(v.x & 0xffff); d[72] = (bf16_t)(v.x >> 16); d[144] = (bf16_t)(v.y & 0xffff); d[216] = (bf16_t)(v.y >> 16);
    d[288] = (bf16_t)(v.z & 0xffff); d[360] = (bf16_t)(v.z >> 16); d[432] = (bf16_t)(v.w & 0xffff); d[504] = (bf16_t)(v.w >> 16);
  }
  __syncthreads();
  f32x4 ao[1][NTP];
#pragma unroll
  for (int j = 0; j < NTP; ++j) ao[0][j] = (f32x4){0.f, 0.f, 0.f, 0.f};
  wmma_sw<1, NTP>(ao, Pb + wave * 16 * 72, 72, VT, 72, 64, lane);
  float fi = 1.f;
  if (MODE == 0) fi = exp2f((float)(t + 1) * l2g);
  if (MODE == 2) fi = __expf(ct);
  const int row = row0 + t;
  const bool valid = t < L;
  if (MODE == 0 || MODE == 1) {
    float s1 = 0.f, s2 = 0.f;
#pragma unroll
    for (int nt = 0; nt < NTP; ++nt)
#pragma unroll
      for (int j = 0; j < 4; ++j) { const float o = ao[0][nt][j] + fi * ai[0][nt][j]; ao[0][nt][j] = o; s1 += o; s2 += o * o; }
    s1 += __shfl_xor(s1, 16); s1 += __shfl_xor(s1, 32); s2 += __shfl_xor(s2, 16); s2 += __shfl_xor(s2, 32);
    float mu = 0.f, rs;
    if (MODE == 0) { mu = s1 * (1.f / 128.f); const float var = fmaxf(s2 * (1.f / 128.f) - mu * mu, 0.f); rs = rsqrtf(var + EPSV); }
    else rs = rsqrtf(s2 * (1.f / 128.f) + EPSV);
    if (valid) {
      const float* nw = (MODE == 0 ? p.ret_norm_w : p.hgrn_norm_w) + h * 128;
      const int gcol = (MODE == 0 ? 1536 : 3584) + h * 128;
      bf16_t* mix = (bf16_t*)(p.ws + OFF_H) + (size_t)row * 1024 + (MODE == 0 ? 0 : 512) + h * 128;
#pragma unroll
      for (int nt = 0; nt < NTP; ++nt) {
        const int pp = nt * 16 + sq4;
        const float4 w4 = *(const float4*)(nw + pp);
        const uint2 g2 = *(const uint2*)(src + (size_t)row * ld + gcol + pp);
        store4bf(mix + pp, (ao[0][nt][0] - mu) * rs * w4.x * siluf(lo2f(g2.x)), (ao[0][nt][1] - mu) * rs * w4.y * siluf(hi2f(g2.x)),
                 (ao[0][nt][2] - mu) * rs * w4.z * siluf(lo2f(g2.y)), (ao[0][nt][3] - mu) * rs * w4.w * siluf(hi2f(g2.y)));
      }
    }
  } else {
    const float Dh = p.d_ssm[h];
    bf16_t* zy = (bf16_t*)(p.ws + OFF_A) + (size_t)row * 3200 + h * 64;
    float s2 = 0.f;
    if (valid) {
#pragma unroll
      for (int nt = 0; nt < NTP; ++nt) {
        const int pp = nt * 16 + sq4;
        const uint2 x2 = *(const uint2*)(src + (size_t)row * ld + vcol + pp);
        const uint2 z2 = *(const uint2*)(zy + pp);
        const float y0 = (ao[0][nt][0] + fi * ai[0][nt][0] + Dh * lo2f(x2.x)) * siluf(lo2f(z2.x));
        const float y1 = (ao[0][nt][1] + fi * ai[0][nt][1] + Dh * hi2f(x2.x)) * siluf(hi2f(z2.x));
        const float y2 = (ao[0][nt][2] + fi * ai[0][nt][2] + Dh * lo2f(x2.y)) * siluf(lo2f(z2.y));
        const float y3 = (ao[0][nt][3] + fi * ai[0][nt][3] + Dh * hi2f(x2.y)) * siluf(hi2f(z2.y));
        s2 += y0 * y0 + y1 * y1 + y2 * y2 + y3 * y3;
        store4bf(zy + pp, y0, y1, y2, y3);
      }
    }
    s2 += __shfl_xor(s2, 16); s2 += __shfl_xor(s2, 32);
    if (valid && lane < 16) atomicAdd((float*)(p.ws + OFF_SSDST) + (size_t)row * 2 + (h >> 3), s2);
  }
  __syncthreads();
}

template <int OUT>
__device__ __forceinline__ void s5_unit(const Params& p, int c, int gq, char* smem) {
  float* Uf = (float*)smem;
  bf16_t* HSall = (bf16_t*)(smem + 16384);
  bf16_t* CMall = (bf16_t*)(smem + 16384 + 34816);
  const int tid = threadIdx.x, lane = tid & 63, wave = tid >> 6;
  int row0, L; chunk_geom(c, row0, L);
  const bf16_t* proj = (const bf16_t*)(p.ws + OFF_A);
#pragma unroll
  for (int i = 0; i < 2; ++i) {
    const int id = tid + i * 256, s = id >> 3, c8 = id & 7;
    uint4 v = make_uint4(0, 0, 0, 0);
    if (s < L) v = *(const uint4*)(proj + (size_t)(row0 + s) * 3200 + 2576 + gq * 64 + c8 * 8);
    float* d = Uf + s * 64 + c8 * 8;
    d[0] = lo2f(v.x); d[1] = hi2f(v.x); d[2] = lo2f(v.y); d[3] = hi2f(v.y); d[4] = lo2f(v.z); d[5] = hi2f(v.z); d[6] = lo2f(v.w); d[7] = hi2f(v.w);
  }
  const int g = gq * 4 + wave, gp = g * 64 + lane;
  const float* tab = (const float*)(p.ws + OFF_S5TAB);
  const float lr = tab[gp], li = tab[2048 + gp];
  float bbr[16], bbi[16];
#pragma unroll
  for (int q = 0; q < 4; ++q) {
    const float4 a = *(const float4*)(tab + 4096 + gp * 16 + q * 4), b = *(const float4*)(tab + 4096 + 32768 + gp * 16 + q * 4);
    bbr[q * 4] = a.x; bbr[q * 4 + 1] = a.y; bbr[q * 4 + 2] = a.z; bbr[q * 4 + 3] = a.w;
    bbi[q * 4] = b.x; bbi[q * 4 + 1] = b.y; bbi[q * 4 + 2] = b.z; bbi[q * 4 + 3] = b.w;
  }
  float hr = 0.f, hi = 0.f;
  bf16_t* HS = HSall + wave * 32 * 136; bf16_t* CM = CMall + wave * 16 * 136;
  if (OUT) {
    const float2 h0 = *(const float2*)((const float*)(p.ws + OFF_S5H) + ((size_t)c * 2048 + gp) * 2);
    hr = h0.x; hi = h0.y;
#pragma unroll
    for (int ch = 0; ch < 16; ++ch) { CM[ch * 136 + lane] = f2bf(p.s5_c_re[(g * 16 + ch) * 64 + lane]); CM[ch * 136 + 64 + lane] = f2bf(-p.s5_c_im[(g * 16 + ch) * 64 + lane]); }
  }
  __syncthreads();
  const int nhalf = OUT ? ((L + 31) >> 5) : 1, tl = OUT ? 32 : 64;
  for (int hf = 0; hf < nhalf; ++hf) {
    for (int tt = 0; tt < tl; ++tt) {
      const int t = hf * 32 + tt;
      if (t < L) {
        const float* up = Uf + t * 64 + wave * 16;
        float bur = 0.f, bui = 0.f;
#pragma unroll
        for (int q = 0; q < 4; ++q) {
          const float4 u4 = *(const float4*)(up + q * 4);
          bur += bbr[q * 4] * u4.x + bbr[q * 4 + 1] * u4.y + bbr[q * 4 + 2] * u4.z + bbr[q * 4 + 3] * u4.w;
          bui += bbi[q * 4] * u4.x + bbi[q * 4 + 1] * u4.y + bbi[q * 4 + 2] * u4.z + bbi[q * 4 + 3] * u4.w;
        }
        const float nr = lr * hr - li * hi + bur, ni = lr * hi + li * hr + bui;
        hr = nr; hi = ni;
      }
      if (OUT) { HS[tt * 136 + lane] = f2bf(t < L ? hr : 0.f); HS[tt * 136 + 64 + lane] = f2bf(t < L ? hi : 0.f); }
    }
    if (OUT) {
      __syncthreads();
      f32x4 ay[2][1];
      ay[0][0] = (f32x4){0.f, 0.f, 0.f, 0.f}; ay[1][0] = (f32x4){0.f, 0.f, 0.f, 0.f};
      wmma_sw<2, 1>(ay, HS, 136, CM, 136, 128, lane);
      bf16_t* gbuf = (bf16_t*)(p.ws + OFF_GBUF);
#pragma unroll
      for (int mt = 0; mt < 2; ++mt) {
        const int t = hf * 32 + mt * 16 + (lane & 15), ch0 = (lane >> 4) * 4;
        if (t < L) {
          const float4 u4 = *(const float4*)(Uf + t * 64 + wave * 16 + ch0);
          const float4 d4 = *(const float4*)(p.s5_d + g * 16 + ch0);
          float y[4] = {ay[mt][0][0] + d4.x * u4.x, ay[mt][0][1] + d4.y * u4.y, ay[mt][0][2] + d4.z * u4.z, ay[mt][0][3] + d4.w * u4.w};
#pragma unroll
          for (int j = 0; j < 4; ++j) { const float x = y[j], uu = 0.7978845608028654f * (x + 0.044715f * x * x * x); y[j] = x / (1.f + __expf(-2.f * uu)); }
          store4bf(gbuf + (size_t)(row0 + t) * 512 + g * 16 + ch0, y[0], y[1], y[2], y[3]);
        }
      }
      __syncthreads();
    }
  }
  if (!OUT) { *(float2*)((float*)(p.ws + OFF_S5E) + ((size_t)c * 2048 + gp) * 2) = make_float2(hr, hi); }
  __syncthreads();
}

__device__ __forceinline__ void s5_prefix(const Params& p, int gt) {
  const int sq = gt >> 11, rem = gt & 2047;
  const float* tab = (const float*)(p.ws + OFF_S5TAB);
  const float* e = (const float*)(p.ws + OFF_S5E);
  float* hs = (float*)(p.ws + OFF_S5H);
  float hr = 0.f, hi = 0.f;
  if (sq < 8) {
    const float lr = tab[69632 + rem], li = tab[71680 + rem];
    for (int n = 0; n < 32; ++n) {
      const size_t idx = ((size_t)(sq * 32 + n) * 2048 + rem) * 2;
      *(float2*)(hs + idx) = make_float2(hr, hi);
      const float2 ev = *(const float2*)(e + idx);
      const float nr = lr * hr - li * hi + ev.x, ni = lr * hi + li * hr + ev.y; hr = nr; hi = ni;
    }
  } else {
    const float lr = tab[73728 + rem], li = tab[75776 + rem];
    hr = p.state_s5_re[(size_t)(sq - 8) * 2048 + rem]; hi = p.state_s5_im[(size_t)(sq - 8) * 2048 + rem];
    const size_t idx = ((size_t)(256 + sq - 8) * 2048 + rem) * 2;
    *(float2*)(hs + idx) = make_float2(hr, hi);
    const float2 ev = *(const float2*)(e + idx);
    const float nr = lr * hr - li * hi + ev.x, ni = lr * hi + li * hr + ev.y; hr = nr; hi = ni;
  }
  p.out[O_S5RE + (size_t)sq * 2048 + rem] = hr;
  p.out[O_S5IM + (size_t)sq * 2048 + rem] = hi;
}

__device__ __forceinline__ void conv_phase(const Params& p) {
  const bf16_t* proj = (const bf16_t*)(p.ws + OFF_A);
  bf16_t* xc = (bf16_t*)(p.ws + OFF_H);
  const int gt = blockIdx.x * NTHR + threadIdx.x, nt = gridDim.x * NTHR;
  for (int it = gt; it < ROWS * 192; it += nt) {
    const int row = it / 192, c = (it % 192) * 8;
    int t, T, sq;
    if (row < 16384) { t = row & 2047; T = 2048; sq = row >> 11; } else { t = (row - 16384) & 7; T = 8; sq = 8 + ((row - 16384) >> 3); }
    float a[8];
    { const float4 b0 = *(const float4*)(p.conv_b + c), b1 = *(const float4*)(p.conv_b + c + 4); a[0] = b0.x; a[1] = b0.y; a[2] = b0.z; a[3] = b0.w; a[4] = b1.x; a[5] = b1.y; a[6] = b1.z; a[7] = b1.w; }
    float cur[8];
#pragma unroll
    for (int j = 0; j < 4; ++j) {
      const int tt = t - 3 + j;
      float x[8];
      if (tt >= 0) {
        const uint4 v = *(const uint4*)(proj + (size_t)(row - 3 + j) * 3200 + 1024 + c);
        x[0] = lo2f(v.x); x[1] = hi2f(v.x); x[2] = lo2f(v.y); x[3] = hi2f(v.y); x[4] = lo2f(v.z); x[5] = hi2f(v.z); x[6] = lo2f(v.w); x[7] = hi2f(v.w);
      } else if (sq >= 8) {
        const float* sc = p.state_conv + ((size_t)(sq - 8) * 3 + (3 + tt)) * 1536 + c;
        const float4 v0 = *(const float4*)sc, v1 = *(const float4*)(sc + 4);
        x[0] = v0.x; x[1] = v0.y; x[2] = v0.z; x[3] = v0.w; x[4] = v1.x; x[5] = v1.y; x[6] = v1.z; x[7] = v1.w;
      } else {
#pragma unroll
        for (int e = 0; e < 8; ++e) x[e] = 0.f;
      }
      const float4 w0 = *(const float4*)(p.conv_w + j * 1536 + c), w1 = *(const float4*)(p.conv_w + j * 1536 + c + 4);
      a[0] += w0.x * x[0]; a[1] += w0.y * x[1]; a[2] += w0.z * x[2]; a[3] += w0.w * x[3]; a[4] += w1.x * x[4]; a[5] += w1.y * x[5]; a[6] += w1.z * x[6]; a[7] += w1.w * x[7];
      if (j == 3) {
#pragma unroll
        for (int e = 0; e < 8; ++e) cur[e] = x[e];
      }
    }
    uint4 o; o.x = pack2(siluf(a[0]), siluf(a[1])); o.y = pack2(siluf(a[2]), siluf(a[3])); o.z = pack2(siluf(a[4]), siluf(a[5])); o.w = pack2(siluf(a[6]), siluf(a[7]));
    *(uint4*)(xc + (size_t)row * 1536 + c) = o;
    if (t >= T - 3) {
      float* d = p.out + O_CONV + ((size_t)sq * 3 + (t - (T - 3))) * 1536 + c;
      *(float4*)d = make_float4(cur[0], cur[1], cur[2], cur[3]); *(float4*)(d + 4) = make_float4(cur[4], cur[5], cur[6], cur[7]);
    }
  }
}

__device__ __forceinline__ void ssdnorm_phase(const Params& p) {
  const bf16_t* proj = (const bf16_t*)(p.ws + OFF_A);
  bf16_t* mix = (bf16_t*)(p.ws + OFF_H);
  const float* st = (const float*)(p.ws + OFF_SSDST);
  const int gt = blockIdx.x * NTHR + threadIdx.x, nt = gridDim.x * NTHR;
  for (int it = gt; it < ROWS * 128; it += nt) {
    const int row = it >> 7, c = (it & 127) * 8;
    const float r = rsqrtf(st[(size_t)row * 2 + (c >> 9)] * (1.f / 512.f) + EPSV);
    const uint4 v = *(const uint4*)(proj + (size_t)row * 3200 + c);
    const float4 w0 = *(const float4*)(p.ssm_norm_w + c), w1 = *(const float4*)(p.ssm_norm_w + c + 4);
    uint4 o; o.x = pack2(lo2f(v.x) * r * w0.x, hi2f(v.x) * r * w0.y); o.y = pack2(lo2f(v.y) * r * w0.z, hi2f(v.y) * r * w0.w);
    o.z = pack2(lo2f(v.z) * r * w1.x, hi2f(v.z) * r * w1.y); o.w = pack2(lo2f(v.w) * r * w1.z, hi2f(v.w) * r * w1.w);
    *(uint4*)(mix + (size_t)row * 1536 + c) = o;
  }
}


#define XB_TMO      128
#define XB_XCNT(j)  (256  + 64 * (j))
#define XB_XSUB(j)  (1280 + 64 * (j))
#define XB_XGEN(j)  (2304 + 64 * (j))
#define XB_TOP      3328
#define XB_TOPGEN   3392
#define XCD_BAR_WORDS 3456
#define XB_SPIN_CAP (1u << 18)
#define LAS __attribute__((address_space(3)))
__device__ __forceinline__ unsigned xb_ld(unsigned* p)              { return __hip_atomic_load(p, __ATOMIC_RELAXED, __HIP_MEMORY_SCOPE_AGENT); }
__device__ __forceinline__ unsigned xb_add(unsigned* p, unsigned v) { return __hip_atomic_fetch_add(p, v, __ATOMIC_RELAXED, __HIP_MEMORY_SCOPE_AGENT); }
__device__ __forceinline__ unsigned xb_xcc_id() { return (unsigned)__builtin_amdgcn_s_getreg((3 << 11) | 20) & 0xFu; }
#define XB_SPIN(cond, bar) do { unsigned _sp = 0; while (cond) { __builtin_amdgcn_s_sleep(1); \
    if ((++_sp & 255u) == 0u) { if (xb_ld(&(bar)[XB_TMO])) break; if (_sp > XB_SPIN_CAP) { atomicAdd(&(bar)[XB_TMO], 1u); break; } } } } while (0)
struct XcdBarrier { unsigned* bar; unsigned x; volatile LAS unsigned* st; };
__device__ __forceinline__ XcdBarrier xcd_barrier_post(unsigned* bar, volatile LAS unsigned* st) {
    XcdBarrier b; b.bar = bar; b.x = xb_xcc_id(); b.st = st;
    if (threadIdx.x == 0) (void)xb_add(&bar[XB_XCNT(b.x)], 1u);
    return b;
}
__device__ __forceinline__ void xcd_barrier_complete(unsigned* bar, unsigned x, unsigned& nloc, unsigned& nx) {
    const unsigned G = gridDim.x * gridDim.y * gridDim.z;
    unsigned sum, cnt, mine, sp = 0u;
    for (;;) {
        sum = 0u; cnt = 0u; mine = 0u;
#pragma unroll
        for (unsigned j = 0; j < 16; ++j) { const unsigned c = xb_ld(&bar[XB_XCNT(j)]); sum += c; cnt += (c > 0u) ? 1u : 0u; mine = (j == x) ? c : mine; }
        if (sum == G) break;
        __builtin_amdgcn_s_sleep(1);
        if ((++sp & 255u) == 0u) { if (xb_ld(&bar[XB_TMO])) break; if (sp > XB_SPIN_CAP) { atomicAdd(&bar[XB_TMO], 1u); break; } }
    }
    nloc = mine > 0u ? mine : 1u; nx = cnt > 0u ? cnt : 1u;
}
__device__ __forceinline__ void xcd_barrier(const XcdBarrier& b) {
    asm volatile("s_waitcnt vmcnt(0)" ::: "memory");
    __syncthreads();
    if (threadIdx.x == 0) {
        unsigned* bar = b.bar;
        __builtin_amdgcn_s_waitcnt(0);
        unsigned nloc = b.st[0], nx = b.st[1];
        if (nloc == 0u) { xcd_barrier_complete(bar, b.x, nloc, nx); b.st[0] = nloc; b.st[1] = nx; }
        const unsigned old = xb_add(&bar[XB_XSUB(b.x)], 1u);
        const unsigned gen = old / nloc;
        if (old + 1u == (gen + 1u) * nloc) {
            __builtin_amdgcn_fence(__ATOMIC_RELEASE, "agent");
            asm volatile("s_waitcnt vmcnt(0)" ::: "memory");
            const unsigned og = xb_add(&bar[XB_TOP], 1u);
            const unsigned tg = og / nx;
            if (og + 1u == (tg + 1u) * nx) xb_add(&bar[XB_TOPGEN], 1u);
            else XB_SPIN(xb_ld(&bar[XB_TOPGEN]) == tg, bar);
            __builtin_amdgcn_fence(__ATOMIC_ACQUIRE, "agent");
            xb_add(&bar[XB_XGEN(b.x)], 1u);
            asm volatile("s_waitcnt vmcnt(0)" ::: "memory");
        } else {
            XB_SPIN(xb_ld(&bar[XB_XGEN(b.x)]) == gen, bar);
            __builtin_amdgcn_fence(__ATOMIC_ACQUIRE, "agent");
            asm volatile("s_waitcnt vmcnt(0)" ::: "memory");
        }
    }
    __syncthreads();
}

__global__ void __launch_bounds__(NTHR, 2) fwd_megakernel(Params p) {
  extern __shared__ __attribute__((aligned(16))) char smem[];
  cg::grid_group grid = cg::this_grid();
  if (p.ws == nullptr) grid.sync();
  volatile LAS unsigned* xst = (volatile LAS unsigned*)(smem + 81904);
  if (threadIdx.x == 0) { xst[0] = 0u; xst[1] = 0u; xst[2] = 0u; xst[3] = 0u; }
  __syncthreads();
  const XcdBarrier xb = xcd_barrier_post((unsigned*)(p.ws + OFF_BAR), xst);
  const int G = gridDim.x, bid = blockIdx.x;
  bf16_t* W = (bf16_t*)p.ws;
  bf16_t* bufA = (bf16_t*)(p.ws + OFF_A);
  bf16_t* bufH = (bf16_t*)(p.ws + OFF_H);
  bf16_t* t0 = (bf16_t*)(p.ws + OFF_ST);
  float* rowss = (float*)(p.ws + OFF_ROWSS);
  float* hbuf = p.out;

  for (int rep_ = 0; rep_ < REP0; ++rep_) {
  prep_tables(p);
  wconv(p.w_in_even, 1024, 4096, 4096, (bf16_t*)(p.ws + W_IN), smem);
  wconv(p.w_out_even, 1024, 1024, 1024, (bf16_t*)(p.ws + W_OUT0), smem);
  wconv(p.w_ffn_up, 1024, 4096, 4096, (bf16_t*)(p.ws + W_UP), smem);
  wconv(p.w_ffn_down, 4096, 1024, 1024, (bf16_t*)(p.ws + W_DOWN), smem);
  rowpass_phase(nullptr, nullptr, nullptr, p.x_prompt, p.x_sample, nullptr, p.norm_mix_pre, bufH);
  }
  xcd_barrier(xb);
  { EpiInEven e{bufA, (const float*)(p.ws + OFF_ROPE), (const float*)(p.ws + OFF_LB)};
    gemm_phase(bufH, 1024, (const bf16_t*)(p.ws + W_IN), 1024, 136, 32, 1024, e, smem); }
  xcd_barrier(xb);
  for (int rep_ = 0; rep_ < REPS; ++rep_)
  for (int u = bid; u < 256 + 4096; u += G) {
    int v = u < 256 ? u : u - 256;
    const int m = v & 1; v >>= 1;
    const int ps = v & 3, h = (v >> 2) & 3, sq = (u < 256 ? 0 : 8) + (v >> 4);
    if (m == 0) state_unit<0>(p, sq, h, ps, smem); else state_unit<1>(p, sq, h, ps, smem);
  }
  xcd_barrier(xb);
  for (int rep_ = 0; rep_ < REPO; ++rep_)
  for (int u = bid; u < 384 * 8; u += G) {
    const int m = u & 1, h = (u >> 1) & 3, c = u >> 3;
    if (m == 0) out_unit<0>(p, c, h, smem); else out_unit<1>(p, c, h, smem);
  }
  xcd_barrier(xb);
  { EpiOut e{t0, rowss};
    gemm_phase(bufH, 1024, (const bf16_t*)(p.ws + W_OUT0), 1024, 136, 8, 1024, e, smem); }
  xcd_barrier(xb);
  rowpass_phase(t0, rowss, p.norm_mix_post, p.x_prompt, p.x_sample, hbuf, p.norm_ffn_pre, bufH);
  xcd_barrier(xb);
  { EpiUp e{bufA}; gemm_phase(bufH, 1024, (const bf16_t*)(p.ws + W_UP), 1024, 136, 32, 1024, e, smem); }
  xcd_barrier(xb);
  { EpiOut e{t0, rowss + ROWS}; gemm_phase(bufA, 4096, (const bf16_t*)(p.ws + W_DOWN), 4096, 136, 8, 4096, e, smem); }
  xcd_barrier(xb);
  rowpass_phase(t0, rowss + ROWS, p.norm_ffn_post, hbuf, hbuf + (size_t)16384 * 1024, hbuf, p.norm_mix_pre + 1024, bufH);
  wconv(p.w_in_odd, 1024, 3088, 3200, (bf16_t*)(p.ws + W_IN), smem);
  wconv(p.w_glu, 512, 512, 512, (bf16_t*)(p.ws + W_GLU), smem);
  wconv(p.w_out_odd, 1536, 1024, 1024, (bf16_t*)(p.ws + W_OUT1), smem);
  wconv(p.w_ffn_up + (size_t)1024 * 4096, 1024, 4096, 4096, (bf16_t*)(p.ws + W_UP), smem);
  wconv(p.w_ffn_down + (size_t)4096 * 1024, 4096, 1024, 1024, (bf16_t*)(p.ws + W_DOWN), smem);
  xcd_barrier(xb);
  { EpiInOdd e{bufA, (float*)(p.ws + OFF_DTBUF)};
    gemm_phase(bufH, 1024, (const bf16_t*)(p.ws + W_IN), 1024, 136, 25, 1024, e, smem); }
  xcd_barrier(xb);
  for (int rep_ = 0; rep_ < REPC; ++rep_) {
  conv_phase(p);
  for (int u = bid; u < 384 * 8; u += G) s5_unit<0>(p, u >> 3, u & 7, smem);
  }
  xcd_barrier(xb);
  for (int rep_ = 0; rep_ < REPS; ++rep_)
  for (int u = bid; u < 128 + 1088 + 2048; u += G) {
    if (u < 128) state_unit<2>(p, u >> 4, u & 15, 0, smem);
    else if (u < 128 + 1088) s5_prefix(p, (u - 128) * NTHR + threadIdx.x);
    else { const int v = u - 128 - 1088; state_unit<2>(p, 8 + (v >> 4), v & 15, 0, smem); }
  }
  xcd_barrier(xb);
  for (int u = bid; u < 384 * 16 + 384 * 8; u += G) {
    if (u < 384 * 16) out_unit<2>(p, u >> 4, u & 15, smem);
    else { const int v = u - 384 * 16; s5_unit<1>(p, v >> 3, v & 7, smem); }
  }
  xcd_barrier(xb);
  ssdnorm_phase(p);
  { EpiGlu e{(const bf16_t*)(p.ws + OFF_GBUF), p.b_glu, bufH};
    gemm_phase((const bf16_t*)(p.ws + OFF_GBUF), 512, (const bf16_t*)(p.ws + W_GLU), 512, 136, 4, 512, e, smem); }
  xcd_barrier(xb);
  { EpiOut e{t0, rowss + 2 * ROWS}; gemm_phase(bufH, 1536, (const bf16_t*)(p.ws + W_OUT1), 1536, 136, 8, 1536, e, smem); }
  xcd_barrier(xb);
  rowpass_phase(t0, rowss + 2 * ROWS, p.norm_mix_post + 1024, hbuf, hbuf + (size_t)16384 * 1024, hbuf, p.norm_ffn_pre + 1024, bufH);
  xcd_barrier(xb);
  { EpiUp e{bufA}; gemm_phase(bufH, 1024, (const bf16_t*)(p.ws + W_UP), 1024, 136, 32, 1024, e, smem); }
  xcd_barrier(xb);
  { EpiOut e{t0, rowss + 3 * ROWS}; gemm_phase(bufA, 4096, (const bf16_t*)(p.ws + W_DOWN), 4096, 136, 8, 4096, e, smem); }
  xcd_barrier(xb);
  for (int rep_ = 1; rep_ < REPY; ++rep_) xcd_barrier(xb);
  rowpass_phase(t0, rowss + 3 * ROWS, p.norm_ffn_post + 1024, hbuf, hbuf + (size_t)16384 * 1024, hbuf, nullptr, nullptr);
}

extern "C" void kernel_launch(void* const* d_in, const int* in_sizes, int n_in, void* d_out, int out_size, void* d_ws, size_t ws_size, hipStream_t stream) {
  constexpr size_t kDynLds = 81920;
  static int grid_blocks = 0;
  if (!grid_blocks) {
    int dev = 0, cus = 0, per_cu = 0;
    hipGetDevice(&dev);
    hipDeviceGetAttribute(&cus, hipDeviceAttributeMultiprocessorCount, dev);
    hipFuncSetAttribute((const void*)fwd_megakernel, hipFuncAttributeMaxDynamicSharedMemorySize, (int)kDynLds);
    hipOccupancyMaxActiveBlocksPerMultiprocessor(&per_cu, fwd_megakernel, NTHR, kDynLds);
    if (per_cu > 2) per_cu = 2;
    if (per_cu < 1) per_cu = 1;
    grid_blocks = cus * per_cu;
  }
  Params p{};
  const float** pf = (const float**)&p;
  for (int i = 0; i < 37; ++i) pf[i] = (const float*)d_in[i];
  p.out = (float*)d_out;
  p.ws = (char*)d_ws;
  hipMemsetAsync((char*)d_ws + OFF_BAR, 0, 16384, stream);
  void* args[] = {&p};
  hipError_t e = hipLaunchCooperativeKernel((void*)fwd_megakernel, dim3(grid_blocks), dim3(NTHR), args, kDynLds, stream);
  if (e != hipSuccess) fprintf(stderr, "cooperative launch failed: %s (grid %d)\n", hipGetErrorString(e), grid_blocks);
}
```

```cpp
#include <hip/hip_runtime.h>
#include <hip/hip_cooperative_groups.h>
#include <cstdio>
namespace cg = cooperative_groups;

typedef unsigned short bf16_t;
typedef short bf16x8 __attribute__((ext_vector_type(8)));
typedef float f32x4 __attribute__((ext_vector_type(4)));
typedef unsigned u32x4 __attribute__((ext_vector_type(4)));

#define NTHR 256
#ifndef REP0
#define REP0 1
#endif
#ifndef REPS
#define REPS 1
#endif
#ifndef REPO
#define REPO 1
#endif
#ifndef REPC
#define REPC 1
#endif
#ifndef REPY
#define REPY 21
#endif
#define ROWS 17408
#define EPSV 1e-6f

constexpr size_t W_IN = 0;
constexpr size_t W_OUT0 = 8388608;
constexpr size_t W_GLU = 6553600;
constexpr size_t W_OUT1 = 7077888;
constexpr size_t W_UP = 10485760;
constexpr size_t W_DOWN = 18874368;
constexpr size_t OFF_A = 29360128;
constexpr size_t OFF_GBUF = OFF_A + 111411200;
constexpr size_t OFF_ST = OFF_A + 142606336;
constexpr size_t OFF_H = OFF_ST + 67108864;
constexpr size_t OFF_SM = OFF_H + 53477376;
constexpr size_t OFF_ROPE = OFF_SM;
constexpr size_t OFF_ROWSS = OFF_SM + 1052672;
constexpr size_t OFF_SSDST = OFF_SM + 1331200;
constexpr size_t OFF_DTBUF = OFF_SM + 1470464;
constexpr size_t OFF_LB = OFF_SM + 2584576;
constexpr size_t OFF_S5TAB = OFF_SM + 2586624;
constexpr size_t OFF_S5E = OFF_SM + 2897920;
constexpr size_t OFF_S5H = OFF_SM + 9189376;
constexpr size_t OFF_BAR = OFF_SM + 15480832;

constexpr size_t O_RET = 17825792, O_HG = 26738688, O_SSM = 35651584, O_CONV = 53477376, O_S5RE = 54104064, O_S5IM = 54382592;

struct Params {
  const float *x_prompt, *x_sample, *state_ret, *state_hgrn, *state_ssm, *state_conv, *state_s5_re, *state_s5_im;
  const float *norm_mix_pre, *norm_mix_post, *norm_ffn_pre, *norm_ffn_post;
  const float *w_in_even, *w_out_even, *ret_norm_w, *hgrn_lb, *hgrn_norm_w, *w_in_odd, *conv_w, *conv_b, *dt_bias, *a_log, *d_ssm, *ssm_norm_w;
  const float *s5_lam_re, *s5_lam_im, *s5_log_step, *s5_b_re, *s5_b_im, *s5_c_re, *s5_c_im, *s5_d, *w_glu, *b_glu, *w_out_odd, *w_ffn_up, *w_ffn_down;
  float* out;
  char* ws;
};

__device__ __forceinline__ bf16_t f2bf(float f) { unsigned u = __float_as_uint(f); u += 0x7fffu + ((u >> 16) & 1u); return (bf16_t)(u >> 16); }
__device__ __forceinline__ float bf2f(bf16_t h) { return __uint_as_float(((unsigned)h) << 16); }
__device__ __forceinline__ unsigned pack2(float a, float b) { return (unsigned)f2bf(a) | ((unsigned)f2bf(b) << 16); }
__device__ __forceinline__ float lo2f(unsigned u) { return __uint_as_float(u << 16); }
__device__ __forceinline__ float hi2f(unsigned u) { return __uint_as_float(u & 0xffff0000u); }
__device__ __forceinline__ float sigm(float x) { return 1.f / (1.f + __expf(-x)); }
__device__ __forceinline__ float siluf(float x) { return x / (1.f + __expf(-x)); }
__device__ __forceinline__ void store4bf(bf16_t* p, float a, float b, float c, float d) { uint2 v; v.x = pack2(a, b); v.y = pack2(c, d); *(uint2*)p = v; }

template <int MT, int NT>
__device__ __forceinline__ void wmma_sw(f32x4 (&acc)[MT][NT], const bf16_t* A, int lda, const bf16_t* B, int ldb, int K, int lane) {
  const int r = lane & 15, kq = (lane >> 4) * 8;
  for (int k0 = 0; k0 < K; k0 += 32) {
    bf16x8 af[MT], bfr[NT];
#pragma unroll
    for (int mt = 0; mt < MT; ++mt) af[mt] = *(const bf16x8*)(A + (mt * 16 + r) * lda + k0 + kq);
#pragma unroll
    for (int nt = 0; nt < NT; ++nt) bfr[nt] = *(const bf16x8*)(B + (nt * 16 + r) * ldb + k0 + kq);
#pragma unroll
    for (int mt = 0; mt < MT; ++mt)
#pragma unroll
      for (int nt = 0; nt < NT; ++nt) acc[mt][nt] = __builtin_amdgcn_mfma_f32_16x16x32_bf16(bfr[nt], af[mt], acc[mt][nt], 0, 0, 0);
  }
}
template <int MT, int NT>
__device__ __forceinline__ void wmma_ns(f32x4 (&acc)[MT][NT], const bf16_t* A, int lda, const bf16_t* B, int ldb, int K, int lane) {
  const int r = lane & 15, kq = (lane >> 4) * 8;
  for (int k0 = 0; k0 < K; k0 += 32) {
    bf16x8 af[MT], bfr[NT];
#pragma unroll
    for (int mt = 0; mt < MT; ++mt) af[mt] = *(const bf16x8*)(A + (mt * 16 + r) * lda + k0 + kq);
#pragma unroll
    for (int nt = 0; nt < NT; ++nt) bfr[nt] = *(const bf16x8*)(B + (nt * 16 + r) * ldb + k0 + kq);
#pragma unroll
    for (int mt = 0; mt < MT; ++mt)
#pragma unroll
      for (int nt = 0; nt < NT; ++nt) acc[mt][nt] = __builtin_amdgcn_mfma_f32_16x16x32_bf16(af[mt], bfr[nt], acc[mt][nt], 0, 0, 0);
  }
}

__device__ __forceinline__ void gemm_step(f32x4 (&acc)[2][8], const bf16_t* A, const bf16_t* B, int lane) {
  const int r = lane & 15, kq = (lane >> 4) * 8;
#pragma unroll
  for (int k0 = 0; k0 < 64; k0 += 32) {
    bf16x8 af[2];
#pragma unroll
    for (int mt = 0; mt < 2; ++mt) af[mt] = *(const bf16x8*)(A + (mt * 16 + r) * 72 + k0 + kq);
#pragma unroll
    for (int nh = 0; nh < 2; ++nh) {
      bf16x8 bfr[4];
#pragma unroll
      for (int nt = 0; nt < 4; ++nt) bfr[nt] = *(const bf16x8*)(B + ((nh * 4 + nt) * 16 + r) * 72 + k0 + kq);
#pragma unroll
      for (int nt = 0; nt < 4; ++nt)
#pragma unroll
        for (int mt = 0; mt < 2; ++mt) acc[mt][nh * 4 + nt] = __builtin_amdgcn_mfma_f32_16x16x32_bf16(bfr[nt], af[mt], acc[mt][nh * 4 + nt], 0, 0, 0);
    }
  }
}

template <class Epi>
__device__ __forceinline__ void gemm_phase(const bf16_t* A, int lda, const bf16_t* Bt, int ldb, int nMt, int nNt, int K, const Epi& epi, char* smem) {
  bf16_t* As = (bf16_t*)smem;
  bf16_t* Bs = As + 2 * 128 * 72;
  int tid_ = threadIdx.x; asm volatile("" : "+v"(tid_)); const int tid = tid_, lane = tid & 63, wave = tid >> 6;
  const int ntiles = nMt * nNt, nk = K >> 6, G = gridDim.x;
  const int lrow = tid >> 3, lcc = (tid & 7) * 8;
  const int first = blockIdx.x;
  if (first < ntiles) {
    const int total = ((ntiles - first + G - 1) / G) * nk;
    int ptile = first, pk = 0;
    const bf16_t* pa = A + (size_t)((ptile / nNt) * 128 + lrow) * lda + lcc;
    const bf16_t* pb = Bt + (size_t)((ptile % nNt) * 128 + lrow) * ldb + lcc;
    u32x4 r0a[4], r0b[4], r1a[4], r1b[4];
#define G_ISSUE(RA, RB) { \
    _Pragma("unroll") for (int i = 0; i < 4; ++i) { RA[i] = *(const u32x4*)(pa + (size_t)(i * 32) * lda + pk * 64); RB[i] = *(const u32x4*)(pb + (size_t)(i * 32) * ldb + pk * 64); } \
    if (++pk == nk) { if (ptile + G < ntiles) { pk = 0; ptile += G; pa = A + (size_t)((ptile / nNt) * 128 + lrow) * lda + lcc; pb = Bt + (size_t)((ptile % nNt) * 128 + lrow) * ldb + lcc; } else pk = nk - 1; } }
#define G_STORE(RA, RB, BUF) { bf16_t* Ad = As + (BUF) * 128 * 72; bf16_t* Bd = Bs + (BUF) * 128 * 72; \
    _Pragma("unroll") for (int i = 0; i < 4; ++i) { *(u32x4*)(Ad + (lrow + i * 32) * 72 + lcc) = RA[i]; *(u32x4*)(Bd + (lrow + i * 32) * 72 + lcc) = RB[i]; } }
    G_ISSUE(r0a, r0b)
    G_ISSUE(r1a, r1b)
    f32x4 acc[2][8];
#pragma unroll
    for (int i = 0; i < 2; ++i)
#pragma unroll
      for (int j = 0; j < 8; ++j) acc[i][j] = (f32x4){0.f, 0.f, 0.f, 0.f};
    G_STORE(r0a, r0b, 0)
    __syncthreads();
    int ctile = first, ck = 0;
    for (int it = 0; it < total; it += 2) {
      G_ISSUE(r0a, r0b)
      __builtin_amdgcn_sched_barrier(0);
      gemm_step(acc, As + wave * 32 * 72, Bs, lane);
      __builtin_amdgcn_sched_barrier(0);
      G_STORE(r1a, r1b, 1)
      __syncthreads();
      G_ISSUE(r1a, r1b)
      __builtin_amdgcn_sched_barrier(0);
      gemm_step(acc, As + 128 * 72 + wave * 32 * 72, Bs + 128 * 72, lane);
      __builtin_amdgcn_sched_barrier(0);
      ck += 2;
      if (ck == nk) {
        epi(acc, (ctile / nNt) * 128 + wave * 32, (ctile % nNt) * 128, lane);
#pragma unroll
        for (int i = 0; i < 2; ++i)
#pragma unroll
          for (int j = 0; j < 8; ++j) acc[i][j] = (f32x4){0.f, 0.f, 0.f, 0.f};
        ck = 0; ctile += G;
      }
      G_STORE(r0a, r0b, 0)
      __syncthreads();
    }
#undef G_ISSUE
#undef G_STORE
  }
}

struct EpiInEven {
  bf16_t* proj; const float* rope; const float* lb;
  __device__ __forceinline__ void operator()(f32x4 (&acc)[2][8], int rbase, int cbase, int lane) const {
    const int sec = cbase >> 9, head = (cbase >> 7) & 3, r = lane & 15, cq = (lane >> 4) * 4;
#pragma unroll
    for (int mt = 0; mt < 2; ++mt) {
      const int row = rbase + mt * 16 + r;
      bf16_t* dst = proj + (size_t)row * 4096 + cbase + cq;
      if (sec < 2) {
        const int pidx = row < 16384 ? (row & 2047) : 2048 + ((row - 16384) & 7);
        const float* ct = rope + pidx * 128 + cq;
        const float sc = sec == 1 ? 0.08838834764831845f : 1.f;
#pragma unroll
        for (int nt = 0; nt < 4; ++nt) {
          const float4 c4 = *(const float4*)(ct + nt * 16), s4 = *(const float4*)(ct + 64 + nt * 16);
          const f32x4 x1 = acc[mt][nt], x2 = acc[mt][nt + 4];
          store4bf(dst + nt * 16, (x1[0] * c4.x - x2[0] * s4.x) * sc, (x1[1] * c4.y - x2[1] * s4.y) * sc, (x1[2] * c4.z - x2[2] * s4.z) * sc, (x1[3] * c4.w - x2[3] * s4.w) * sc);
          store4bf(dst + 64 + nt * 16, (x1[0] * s4.x + x2[0] * c4.x) * sc, (x1[1] * s4.y + x2[1] * c4.y) * sc, (x1[2] * s4.z + x2[2] * c4.z) * sc, (x1[3] * s4.w + x2[3] * c4.w) * sc);
        }
      } else if (sec == 5) {
#pragma unroll
        for (int nt = 0; nt < 8; ++nt) {
          const float4 l4 = *(const float4*)(lb + head * 128 + nt * 16 + cq);
          const f32x4 x = acc[mt][nt];
          store4bf(dst + nt * 16, __logf(l4.x + (1.f - l4.x) * sigm(x[0])), __logf(l4.y + (1.f - l4.y) * sigm(x[1])), __logf(l4.z + (1.f - l4.z) * sigm(x[2])), __logf(l4.w + (1.f - l4.w) * sigm(x[3])));
        }
      } else {
#pragma unroll
        for (int nt = 0; nt < 8; ++nt) { const f32x4 x = acc[mt][nt]; store4bf(dst + nt * 16, x[0], x[1], x[2], x[3]); }
      }
    }
  }
};
struct EpiOut {
  bf16_t* t0; float* rowss;
  __device__ __forceinline__ void operator()(f32x4 (&acc)[2][8], int rbase, int cbase, int lane) const {
    const int r = lane & 15, cq = (lane >> 4) * 4;
#pragma unroll
    for (int mt = 0; mt < 2; ++mt) {
      const int row = rbase + mt * 16 + r;
      bf16_t* dst = t0 + (size_t)row * 1024 + cbase + cq;
      float ss = 0.f;
#pragma unroll
      for (int nt = 0; nt < 8; ++nt) { const f32x4 x = acc[mt][nt]; ss += x[0] * x[0] + x[1] * x[1] + x[2] * x[2] + x[3] * x[3]; store4bf(dst + nt * 16, x[0], x[1], x[2], x[3]); }
      ss += __shfl_xor(ss, 16); ss += __shfl_xor(ss, 32);
      if (lane < 16) atomicAdd(rowss + row, ss);
    }
  }
};
struct EpiUp {
  bf16_t* act;
  __device__ __forceinline__ void operator()(f32x4 (&acc)[2][8], int rbase, int cbase, int lane) const {
    const int r = lane & 15, cq = (lane >> 4) * 4;
#pragma unroll
    for (int mt = 0; mt < 2; ++mt) {
      bf16_t* dst = act + (size_t)(rbase + mt * 16 + r) * 4096 + cbase + cq;
#pragma unroll
      for (int nt = 0; nt < 8; ++nt) { f32x4 x = acc[mt][nt];
#pragma unroll
        for (int j = 0; j < 4; ++j) { float v = fmaxf(x[j], 0.f); x[j] = v * v; }
        store4bf(dst + nt * 16, x[0], x[1], x[2], x[3]); }
    }
  }
};
struct EpiInOdd {
  bf16_t* proj; float* dtbuf;
  __device__ __forceinline__ void operator()(f32x4 (&acc)[2][8], int rbase, int cbase, int lane) const {
    const int r = lane & 15, cq = (lane >> 4) * 4;
#pragma unroll
    for (int mt = 0; mt < 2; ++mt) {
      const int row = rbase + mt * 16 + r;
      bf16_t* dst = proj + (size_t)row * 3200 + cbase + cq;
#pragma unroll
      for (int nt = 0; nt < 8; ++nt) { const f32x4 x = acc[mt][nt]; store4bf(dst + nt * 16, x[0], x[1], x[2], x[3]); }
      if (cbase == 2560) { const f32x4 x = acc[mt][0]; *(float4*)(dtbuf + (size_t)row * 16 + cq) = make_float4(x[0], x[1], x[2], x[3]); }
    }
  }
};
struct EpiGlu {
  const bf16_t* gbuf; const float* bglu; bf16_t* mix;
  __device__ __forceinline__ void operator()(f32x4 (&acc)[2][8], int rbase, int cbase, int lane) const {
    const int r = lane & 15, cq = (lane >> 4) * 4;
#pragma unroll
    for (int mt = 0; mt < 2; ++mt) {
      const int row = rbase + mt * 16 + r;
#pragma unroll
      for (int nt = 0; nt < 8; ++nt) {
        const int col = cbase + nt * 16 + cq;
        const f32x4 x = acc[mt][nt];
        const uint2 g2 = *(const uint2*)(gbuf + (size_t)row * 512 + col);
        const float4 b4 = *(const float4*)(bglu + col);
        store4bf(mix + (size_t)row * 1536 + 1024 + col, lo2f(g2.x) * sigm(x[0] + b4.x), hi2f(g2.x) * sigm(x[1] + b4.y), lo2f(g2.y) * sigm(x[2] + b4.z), hi2f(g2.y) * sigm(x[3] + b4.w));
      }
    }
  }
};

__device__ __forceinline__ void rowpass_phase(const bf16_t* t0, const float* rowss, const float* wpost, const float* hin_a, const float* hin_b, float* hout, const float* wnext, bf16_t* hn) {
  const int lane = threadIdx.x & 63, gw = blockIdx.x * 4 + (threadIdx.x >> 6), nw = gridDim.x * 4;
  for (int row = gw; row < ROWS; row += nw) {
    const float* hin = row < 16384 ? hin_a + (size_t)row * 1024 : hin_b + (size_t)(row - 16384) * 1024;
    float r0 = 0.f;
    if (t0) r0 = rsqrtf(rowss[row] * (1.f / 1024.f) + EPSV);
    float4 v[4]; float ss = 0.f;
#pragma unroll
    for (int i = 0; i < 4; ++i) {
      const int col = (i * 64 + lane) * 4;
      float4 hv = *(const float4*)(hin + col);
      if (t0) {
        const uint2 t2 = *(const uint2*)(t0 + (size_t)row * 1024 + col);
        const float4 w4 = *(const float4*)(wpost + col);
        hv.x += lo2f(t2.x) * r0 * w4.x; hv.y += hi2f(t2.x) * r0 * w4.y; hv.z += lo2f(t2.y) * r0 * w4.z; hv.w += hi2f(t2.y) * r0 * w4.w;
      }
      v[i] = hv; ss += hv.x * hv.x + hv.y * hv.y + hv.z * hv.z + hv.w * hv.w;
      if (hout) *(float4*)(hout + (size_t)row * 1024 + col) = hv;
    }
    if (hn) {
#pragma unroll
      for (int o = 32; o >= 1; o >>= 1) ss += __shfl_xor(ss, o);
      const float r1 = rsqrtf(ss * (1.f / 1024.f) + EPSV);
#pragma unroll
      for (int i = 0; i < 4; ++i) {
        const int col = (i * 64 + lane) * 4;
        const float4 w4 = *(const float4*)(wnext + col);
        store4bf(hn + (size_t)row * 1024 + col, v[i].x * r1 * w4.x, v[i].y * r1 * w4.y, v[i].z * r1 * w4.z, v[i].w * r1 * w4.w);
      }
    }
  }
}

__device__ __forceinline__ void wconv(const float* __restrict__ W, int K, int N, int Npad, bf16_t* __restrict__ Wt, char* smem) {
  float* tile = (float*)smem;
  const int tid = threadIdx.x;
  const int nNt = Npad >> 6, nunits = (K >> 6) * nNt;
  for (int u = blockIdx.x; u < nunits; u += gridDim.x) {
    const int k0 = (u / nNt) * 64, n0 = (u % nNt) * 64;
#pragma unroll
    for (int ps = 0; ps < 4; ++ps) {
      const int i = ps * 16 + (tid >> 4), j = (tid & 15) * 4, n = n0 + j;
      float4 v = make_float4(0.f, 0.f, 0.f, 0.f);
      if (n < N) v = *(const float4*)(W + (size_t)(k0 + i) * N + n);
      tile[i * 65 + j] = v.x; tile[i * 65 + j + 1] = v.y; tile[i * 65 + j + 2] = v.z; tile[i * 65 + j + 3] = v.w;
    }
    __syncthreads();
    {
      const int n = tid >> 2, kq = (tid & 3) * 16;
      uint4 o0, o1;
      o0.x = pack2(tile[(kq + 0) * 65 + n], tile[(kq + 1) * 65 + n]); o0.y = pack2(tile[(kq + 2) * 65 + n], tile[(kq + 3) * 65 + n]);
      o0.z = pack2(tile[(kq + 4) * 65 + n], tile[(kq + 5) * 65 + n]); o0.w = pack2(tile[(kq + 6) * 65 + n], tile[(kq + 7) * 65 + n]);
      o1.x = pack2(tile[(kq + 8) * 65 + n], tile[(kq + 9) * 65 + n]); o1.y = pack2(tile[(kq + 10) * 65 + n], tile[(kq + 11) * 65 + n]);
      o1.z = pack2(tile[(kq + 12) * 65 + n], tile[(kq + 13) * 65 + n]); o1.w = pack2(tile[(kq + 14) * 65 + n], tile[(kq + 15) * 65 + n]);
      bf16_t* d = Wt + (size_t)(n0 + n) * K + k0 + kq;
      *(uint4*)d = o0; *(uint4*)(d + 8) = o1;
    }
    __syncthreads();
  }
}

__device__ __forceinline__ void prep_tables(const Params& p) {
  const int gt = blockIdx.x * NTHR + threadIdx.x, nt = gridDim.x * NTHR;
  float* rope = (float*)(p.ws + OFF_ROPE);
  for (int i = gt; i < 2056 * 64; i += nt) {
    const int pi = i >> 6, f = i & 63;
    const double pos = pi < 2048 ? (double)pi : (double)(16384 + pi - 2048);
    const double invf = exp(-(double)f * (9.210340371976184 / 64.0));
    double ang = pos * invf;
    ang -= 6.283185307179586 * floor(ang * 0.15915494309189535);
    const float a = (float)ang;
    rope[pi * 128 + f] = cosf(a); rope[pi * 128 + 64 + f] = sinf(a);
  }
  float* z = (float*)(p.ws + OFF_ROWSS);
  for (int i = gt; i < ROWS * 6; i += nt) z[i] = 0.f;
  float* lb = (float*)(p.ws + OFF_LB);
  for (int i = gt; i < 512; i += nt) lb[i] = 1.f / (1.f + expf(p.hgrn_lb[512 + i] - p.hgrn_lb[i]));
  float* tab = (float*)(p.ws + OFF_S5TAB);
  for (int i = gt; i < 2048; i += nt) {
    const int g = i >> 6;
    const float lr = p.s5_lam_re[i], li = p.s5_lam_im[i], dt = expf(p.s5_log_step[g]);
    const float m1 = expf(lr * dt), br = m1 * cosf(li * dt), bi = m1 * sinf(li * dt);
    tab[i] = br; tab[2048 + i] = bi;
    const float m64 = expf(lr * dt * 64.f); tab[69632 + i] = m64 * cosf(li * dt * 64.f); tab[71680 + i] = m64 * sinf(li * dt * 64.f);
    const float m8 = expf(lr * dt * 8.f); tab[73728 + i] = m8 * cosf(li * dt * 8.f); tab[75776 + i] = m8 * sinf(li * dt * 8.f);
    const float x = br - 1.f, y = bi, den = 1.f / (lr * lr + li * li);
    const float qr = (x * lr + y * li) * den, qi = (y * lr - x * li) * den;
    for (int c = 0; c < 16; ++c) {
      const float b_r = p.s5_b_re[i * 16 + c], b_i = p.s5_b_im[i * 16 + c];
      tab[4096 + i * 16 + c] = qr * b_r - qi * b_i;
      tab[4096 + 32768 + i * 16 + c] = qr * b_i + qi * b_r;
    }
  }
}

__device__ __forceinline__ void chunk_geom(int c, int& row0, int& L) { if (c < 256) { row0 = c * 64; L = 64; } else { row0 = 16384 + (c - 256) * 8; L = 8; } }

template <int MODE>
__device__ __forceinline__ void st_load(uint4 (&kr)[4], uint4 (&vr)[(MODE == 2) ? 2 : 1], float& dtr, const bf16_t* src, const float* dtbuf, int row0, int L, int ld, int kcol, int vcol, int h, int tid) {
  constexpr int PW = (MODE == 2) ? 64 : 32, NVC = PW / 32, VCR = PW / 8;
  const uint4 z4 = make_uint4(0, 0, 0, 0);
#pragma unroll
  for (int i = 0; i < 4; ++i) { const int id = tid + i * 256, s = id >> 4, c8 = id & 15; uint4 t_ = z4; if (s < L) t_ = *(const uint4*)(src + (size_t)(row0 + s) * ld + kcol + c8 * 8); kr[i] = t_; }
#pragma unroll
  for (int i = 0; i < NVC; ++i) { const int id = tid + i * 256, s = id / VCR, c8 = id % VCR; uint4 t_ = z4; if (s < L) t_ = *(const uint4*)(src + (size_t)(row0 + s) * ld + vcol + c8 * 8); vr[i] = t_; }
  if (MODE == 2 && tid < 64) dtr = tid < L ? dtbuf[(size_t)(row0 + tid) * 16 + h] : 0.f;
}

template <int MODE>
__device__ __forceinline__ void state_unit(const Params& p, int sq, int h, int ps, char* smem) {
  constexpr int PW = (MODE == 2) ? 64 : 32, NT = PW / 16, PF = (MODE == 2) ? 64 : 128, HH = (MODE == 2) ? 16 : 4, NVC = PW / 32, VCR = PW / 8;
  bf16_t* KT = (bf16_t*)smem;
  bf16_t* VT = KT + 128 * 72;
  bf16_t* KR = VT + 64 * 72;
  float* tot = (float*)(KR + 64 * 136);
  float* dec = tot + 256;
  float* av = dec + 64;
  float* dtv = av + 64;
  int tid_ = threadIdx.x; asm volatile("" : "+v"(tid_)); const int tid = tid_, lane = tid & 63, wave = tid >> 6;
  const bool prompt = sq < 8;
  const int nch = prompt ? 32 : 1, L = prompt ? 64 : 8;
  const int ld = (MODE == 2) ? 1536 : 4096;
  const bf16_t* src = (MODE == 2) ? (const bf16_t*)(p.ws + OFF_H) : (const bf16_t*)(p.ws + OFF_A);
  const int kcol = MODE == 0 ? 512 + h * 128 : MODE == 1 ? 2560 + h * 128 : 1024 + (h >> 3) * 128;
  const int vcol = MODE == 0 ? 1024 + h * 128 + ps * 32 : MODE == 1 ? 3072 + h * 128 + ps * 32 : h * 64;
  const float* sin_ = MODE == 0 ? p.state_ret : MODE == 1 ? p.state_hgrn : p.state_ssm;
  float* sout = p.out + (MODE == 0 ? O_RET : MODE == 1 ? O_HG : O_SSM) + (size_t)(sq * HH + h) * 128 * PF;
  bf16_t* stb = (bf16_t*)(p.ws + OFF_ST) + (MODE == 1 ? (size_t)256 * 4 * 128 * 128 : 0);
  const float* dtbuf = (const float*)(p.ws + OFF_DTBUF);
  const float l2g = MODE == 0 ? log2f(1.f - exp2f(-5.f - (float)h)) : 0.f;
  float Ah = 0.f, dtb = 0.f;
  if (MODE == 2) { Ah = -expf(p.a_log[h]); dtb = p.dt_bias[h]; }

  f32x4 acc[2][NT];
  const int nb = wave * 32 + (lane >> 4) * 4, pc = ps * PW + (lane & 15);
#pragma unroll
  for (int mt = 0; mt < 2; ++mt)
#pragma unroll
    for (int nt = 0; nt < NT; ++nt)
#pragma unroll
      for (int j = 0; j < 4; ++j)
        acc[mt][nt][j] = prompt ? 0.f : sin_[((size_t)((sq - 8) * HH + h) * 128 + nb + mt * 16 + j) * PF + pc + nt * 16];

  uint4 kr[4], vr[NVC]; float dtr = 0.f;
  const uint4 z4 = make_uint4(0, 0, 0, 0);
  st_load<MODE>(kr, vr, dtr, src, dtbuf, prompt ? sq * 2048 : 16384 + (sq - 8) * 8, L, ld, kcol, vcol, h, tid);
  for (int n = 0; n < nch; ++n) {
    if (prompt) {
      bf16_t* d = stb + ((size_t)((sq * 32 + n) * HH + h) * PF) * 128;
#pragma unroll
      for (int mt = 0; mt < 2; ++mt)
#pragma unroll
        for (int nt = 0; nt < NT; ++nt) store4bf(d + (size_t)(pc + nt * 16) * 128 + nb + mt * 16, acc[mt][nt][0], acc[mt][nt][1], acc[mt][nt][2], acc[mt][nt][3]);
    }
#pragma unroll
    for (int i = 0; i < 4; ++i) { const int id = tid + i * 256, s = id >> 4, c8 = id & 15; *(uint4*)(KR + s * 136 + c8 * 8) = kr[i]; }
#pragma unroll
    for (int i = 0; i < NVC; ++i) {
      const int id = tid + i * 256, s = id / VCR, c8 = id % VCR; const uint4 v = vr[i];
      bf16_t* d = VT + (c8 * 8) * 72 + s;
      d[0] = (bf16_t)(v.x & 0xffff); d[72] = (bf16_t)(v.x >> 16); d[144] = (bf16_t)(v.y & 0xffff); d[216] = (bf16_t)(v.y >> 16);
      d[288] = (bf16_t)(v.z & 0xffff); d[360] = (bf16_t)(v.z >> 16); d[432] = (bf16_t)(v.w & 0xffff); d[504] = (bf16_t)(v.w >> 16);
    }
    if (MODE == 2 && tid < 64) {
      float dt = 0.f;
      if (tid < L) { const float x = dtr + dtb; dt = x > 20.f ? x : log1pf(__expf(x)); }
      dtv[tid] = dt; av[tid] = dt * Ah;
    }
    if (n + 1 < nch) st_load<MODE>(kr, vr, dtr, src, dtbuf, sq * 2048 + (n + 1) * 64, L, ld, kcol, vcol, h, tid);
    __syncthreads();
    const int kn = tid & 127, half = tid >> 7;
    if (MODE == 1) {
      float s_ = 0.f;
      for (int s = half * 32; s < half * 32 + 32; ++s) s_ += bf2f(KR[s * 136 + kn]);
      tot[half * 128 + kn] = s_;
    }
    if (MODE == 2 && tid < 64) {
      float suf = 0.f;
      for (int r = tid + 1; r < 64; ++r) suf += av[r];
      dec[tid] = __expf(suf) * dtv[tid];
      if (tid == 0) tot[0] = suf + av[0];
    }
    if (MODE != 0) __syncthreads();
    {
      float suf = 0.f;
      if (MODE == 1) suf = half == 0 ? tot[128 + kn] : 0.f;
      for (int g = 3; g >= 0; --g) {
        const int s0 = half * 32 + g * 8;
        float v[8];
#pragma unroll
        for (int e = 7; e >= 0; --e) {
          const int s = s0 + e;
          const float raw = bf2f(KR[s * 136 + kn]);
          if (MODE == 0) v[e] = raw * exp2f((float)(L - 1 - s) * l2g);
          else if (MODE == 1) { v[e] = (1.f - __expf(raw)) * __expf(suf); suf += raw; }
          else v[e] = raw * dec[s];
        }
        uint4 o; o.x = pack2(v[0], v[1]); o.y = pack2(v[2], v[3]); o.z = pack2(v[4], v[5]); o.w = pack2(v[6], v[7]);
        *(uint4*)(KT + kn * 72 + s0) = o;
      }
    }
    __syncthreads();
#pragma unroll
    for (int mt = 0; mt < 2; ++mt) {
      float dk[4];
      if (MODE == 0) { const float d = exp2f((float)L * l2g); dk[0] = dk[1] = dk[2] = dk[3] = d; }
      else if (MODE == 2) { const float d = __expf(tot[0]); dk[0] = dk[1] = dk[2] = dk[3] = d; }
      else {
#pragma unroll
        for (int j = 0; j < 4; ++j) { const int nn = nb + mt * 16 + j; dk[j] = __expf(tot[nn] + tot[128 + nn]); }
      }
#pragma unroll
      for (int nt = 0; nt < NT; ++nt)
#pragma unroll
        for (int j = 0; j < 4; ++j) acc[mt][nt][j] *= dk[j];
    }
    wmma_ns<2, NT>(acc, KT + wave * 32 * 72, 72, VT, 72, 64, lane);
    __syncthreads();
  }
#pragma unroll
  for (int mt = 0; mt < 2; ++mt)
#pragma unroll
    for (int nt = 0; nt < NT; ++nt)
#pragma unroll
      for (int j = 0; j < 4; ++j) sout[(size_t)(nb + mt * 16 + j) * PF + pc + nt * 16] = acc[mt][nt][j];
}

template <int MODE>
__device__ __forceinline__ void out_unit(const Params& p, int c, int h, char* smem) {
  constexpr int PF = (MODE == 2) ? 64 : 128, NTP = PF / 16, HH = (MODE == 2) ? 16 : 4, NVC = PF / 32, VCR = PF / 8;
  bf16_t* Q = (bf16_t*)smem;
  bf16_t* Kb = Q + 64 * 136;
  bf16_t* STb = Kb + 128 * 72;
  float* cumv = (float*)(STb + 128 * 136);
  float* dtv = cumv + 64;
  float* av = dtv + 64;
  float* tot = av + 64;
  int tid_ = threadIdx.x; asm volatile("" : "+v"(tid_)); const int tid = tid_, lane = tid & 63, wave = tid >> 6;
  int row0, L; chunk_geom(c, row0, L);
  const int ld = (MODE == 2) ? 1536 : 4096;
  const bf16_t* src = (MODE == 2) ? (const bf16_t*)(p.ws + OFF_H) : (const bf16_t*)(p.ws + OFF_A);
  const int qcol = MODE == 0 ? h * 128 : MODE == 1 ? 2048 + h * 128 : 1280 + (h >> 3) * 128;
  const int kcol = MODE == 0 ? 512 + h * 128 : MODE == 1 ? 2560 + h * 128 : 1024 + (h >> 3) * 128;
  const int vcol = MODE == 0 ? 1024 + h * 128 : MODE == 1 ? 3072 + h * 128 : h * 64;
  const float l2g = MODE == 0 ? log2f(1.f - exp2f(-5.f - (float)h)) : 0.f;
  const uint4 z4 = make_uint4(0, 0, 0, 0);
#pragma unroll
  for (int i = 0; i < 4; ++i) {
    const int id = tid + i * 256, s = id >> 4, c8 = id & 15;
    uint4 q4 = z4, k4 = z4;
    if (s < L) { q4 = *(const uint4*)(src + (size_t)(row0 + s) * ld + qcol + c8 * 8); k4 = *(const uint4*)(src + (size_t)(row0 + s) * ld + kcol + c8 * 8); }
    *(uint4*)(Q + s * 136 + c8 * 8) = q4; *(uint4*)(Kb + s * 136 + c8 * 8) = k4;
  }
  uint4 vr[NVC];
#pragma unroll
  for (int i = 0; i < NVC; ++i) { const int id = tid + i * 256, s = id / VCR, c8 = id % VCR; uint4 t_ = z4; if (s < L) t_ = *(const uint4*)(src + (size_t)(row0 + s) * ld + vcol + c8 * 8); vr[i] = t_; }
  if (c < 256) {
    const bf16_t* stg = (const bf16_t*)(p.ws + OFF_ST) + (MODE == 1 ? (size_t)256 * 4 * 128 * 128 : 0) + ((size_t)(c * HH + h) * PF) * 128;
#pragma unroll
    for (int i = 0; i < PF / 16; ++i) { const int id = tid + i * 256, pr = id >> 4, c8 = id & 15; *(uint4*)(STb + pr * 136 + c8 * 8) = *(const uint4*)(stg + (size_t)pr * 128 + c8 * 8); }
  } else {
    const float* sg = (MODE == 0 ? p.state_ret : MODE == 1 ? p.state_hgrn : p.state_ssm) + (size_t)((c - 256) * HH + h) * 128 * PF;
    for (int id = tid; id < 128 * (PF / 4); id += 256) {
      const int n = id / (PF / 4), p4 = (id % (PF / 4)) * 4;
      const float4 v = *(const float4*)(sg + (size_t)n * PF + p4);
      STb[(p4 + 0) * 136 + n] = f2bf(v.x); STb[(p4 + 1) * 136 + n] = f2bf(v.y); STb[(p4 + 2) * 136 + n] = f2bf(v.z); STb[(p4 + 3) * 136 + n] = f2bf(v.w);
    }
  }
  if (MODE == 2 && tid < 64) {
    float dt = 0.f;
    if (tid < L) { const float x = ((const float*)(p.ws + OFF_DTBUF))[(size_t)(row0 + tid) * 16 + h] + p.dt_bias[h]; dt = x > 20.f ? x : log1pf(__expf(x)); }
    dtv[tid] = dt; av[tid] = -expf(p.a_log[h]) * dt;
  }
  __syncthreads();
  if (MODE == 1) {
    const int kn = tid & 127, half = tid >> 7;
    float s_ = 0.f;
    for (int s = half * 32; s < half * 32 + 32; ++s) s_ += bf2f(Kb[s * 136 + kn]);
    tot[half * 128 + kn] = s_;
    __syncthreads();
    float cum = half == 1 ? tot[kn] : 0.f;
    for (int s = half * 32; s < half * 32 + 32; ++s) {
      const float lf = bf2f(Kb[s * 136 + kn]);
      cum += lf;
      Q[s * 136 + kn] = f2bf(bf2f(Q[s * 136 + kn]) * __expf(cum));
      Kb[s * 136 + kn] = f2bf((1.f - __expf(lf)) * __expf(-cum));
    }
    __syncthreads();
  }
  if (MODE == 2) {
    if (tid < 64) { float cs = 0.f; for (int r = 0; r <= tid; ++r) cs += av[r]; cumv[tid] = cs; }
    __syncthreads();
  }
  f32x4 ai[1][NTP], asc[1][4];
#pragma unroll
  for (int j = 0; j < NTP; ++j) ai[0][j] = (f32x4){0.f, 0.f, 0.f, 0.f};
#pragma unroll
  for (int j = 0; j < 4; ++j) asc[0][j] = (f32x4){0.f, 0.f, 0.f, 0.f};
  wmma_sw<1, NTP>(ai, Q + wave * 16 * 136, 136, STb, 136, 128, lane);
  wmma_sw<1, 4>(asc, Q + wave * 16 * 136, 136, Kb, 136, 128, lane);
  const int t = wave * 16 + (lane & 15), sq4 = (lane >> 4) * 4;
  float ct = 0.f;
  if (MODE == 2) ct = cumv[t];
#pragma unroll
  for (int nt = 0; nt < 4; ++nt)
#pragma unroll
    for (int j = 0; j < 4; ++j) {
      const int s = nt * 16 + sq4 + j;
      float v = asc[0][nt][j];
      if (s > t) v = 0.f;
      else if (MODE == 0) v *= exp2f((float)(t - s) * l2g);
      else if (MODE == 2) v *= __expf(ct - cumv[s]) * dtv[s];
      asc[0][nt][j] = v;
    }
  __syncthreads();
  bf16_t* Pb = STb; bf16_t* VT = Kb;
#pragma unroll
  for (int nt = 0; nt < 4; ++nt) store4bf(Pb + t * 72 + nt * 16 + sq4, asc[0][nt][0], asc[0][nt][1], asc[0][nt][2], asc[0][nt][3]);
#pragma unroll
  for (int i = 0; i < NVC; ++i) {
    const int id = tid + i * 256, s = id / VCR, c8 = id % VCR; const uint4 v = vr[i];
    bf16_t* d = VT + (c8 * 8) * 72 + s;
    d[0] = (bf16_t)(v.x & 0xffff); d[72] = (bf16_t)(v.x >> 16); d[144] = (bf16_t)(v.y & 0xffff); d[216] = (bf16_t)(v.y >> 16);
    d[288] = (bf16_t)(v.z & 0xffff); d[360] = (bf16_t)(v.z >> 16); d[432] = (bf16_t)(v.w & 0xffff); d[504] = (bf16_t)(v.w >> 16);
  }
  __syncthreads();
  f32x4 ao[1][NTP];
#pragma unroll
  for (int j = 0; j < NTP; ++j) ao[0][j] = (f32x4){0.f, 0.f, 0.f, 0.f};
  wmma_sw<1, NTP>(ao, Pb + wave * 16 * 72, 72, VT, 72, 64, lane);
  float fi = 1.f;
  if (MODE == 0) fi = exp2f((float)(t + 1) * l2g);
  if (MODE == 2) fi = __expf(ct);
  const int row = row0 + t;
  const bool valid = t < L;
  if (MODE == 0 || MODE == 1) {
    float s1 = 0.f, s2 = 0.f;
#pragma unroll
    for (int nt = 0; nt < NTP; ++nt)
#pragma unroll
      for (int j = 0; j < 4; ++j) { const float o = ao[0][nt][j] + fi * ai[0][nt][j]; ao[0][nt][j] = o; s1 += o; s2 += o * o; }
    s1 += __shfl_xor(s1, 16); s1 += __shfl_xor(s1, 32); s2 += __shfl_xor(s2, 16); s2 += __shfl_xor(s2, 32);
    float mu = 0.f, rs;
    if (MODE == 0) { mu = s1 * (1.f / 128.f); const float var = fmaxf(s2 * (1.f / 128.f) - mu * mu, 0.f); rs = rsqrtf(var + EPSV); }
    else rs = rsqrtf(s2 * (1.f / 128.f) + EPSV);
    if (valid) {
      const float* nw = (MODE == 0 ? p.ret_norm_w : p.hgrn_norm_w) + h * 128;
      const int gcol = (MODE == 0 ? 1536 : 3584) + h * 128;
      bf16_t* mix = (bf16_t*)(p.ws + OFF_H) + (size_t)row * 1024 + (MODE == 0 ? 0 : 512) + h * 128;
#pragma unroll
      for (int nt = 0; nt < NTP; ++nt) {
        const int pp = nt * 16 + sq4;
        const float4 w4 = *(const float4*)(nw + pp);
        const uint2 g2 = *(const uint2*)(src + (size_t)row * ld + gcol + pp);
        store4bf(mix + pp, (ao[0][nt][0] - mu) * rs * w4.x * siluf(lo2f(g2.x)), (ao[0][nt][1] - mu) * rs * w4.y * siluf(hi2f(g2.x)),
                 (ao[0][nt][2] - mu) * rs * w4.z * siluf(lo2f(g2.y)), (ao[0][nt][3] - mu) * rs * w4.w * siluf(hi2f(g2.y)));
      }
    }
  } else {
    const float Dh = p.d_ssm[h];
    bf16_t* zy = (bf16_t*)(p.ws + OFF_A) + (size_t)row * 3200 + h * 64;
    float s2 = 0.f;
    if (valid) {
#pragma unroll
      for (int nt = 0; nt < NTP; ++nt) {
        const int pp = nt * 16 + sq4;
        const uint2 x2 = *(const uint2*)(src + (size_t)row * ld + vcol + pp);
        const uint2 z2 = *(const uint2*)(zy + pp);
        const float y0 = (ao[0][nt][0] + fi * ai[0][nt][0] + Dh * lo2f(x2.x)) * siluf(lo2f(z2.x));
        const float y1 = (ao[0][nt][1] + fi * ai[0][nt][1] + Dh * hi2f(x2.x)) * siluf(hi2f(z2.x));
        const float y2 = (ao[0][nt][2] + fi * ai[0][nt][2] + Dh * lo2f(x2.y)) * siluf(lo2f(z2.y));
        const float y3 = (ao[0][nt][3] + fi * ai[0][nt][3] + Dh * hi2f(x2.y)) * siluf(hi2f(z2.y));
        s2 += y0 * y0 + y1 * y1 + y2 * y2 + y3 * y3;
        store4bf(zy + pp, y0, y1, y2, y3);
      }
    }
    s2 += __shfl_xor(s2, 16); s2 += __shfl_xor(s2, 32);
    if (valid && lane < 16) atomicAdd((float*)(p.ws + OFF_SSDST) + (size_t)row * 2 + (h >> 3), s2);
  }
  __syncthreads();
}

template <int OUT>
__device__ __forceinline__ void s5_unit(const Params& p, int c, int gq, char* smem) {
  float* Uf = (float*)smem;
  bf16_t* HSall = (bf16_t*)(smem + 16384);
  bf16_t* CMall = (bf16_t*)(smem + 16384 + 34816);
  int tid_ = threadIdx.x; asm volatile("" : "+v"(tid_)); const int tid = tid_, lane = tid & 63, wave = tid >> 6;
  int row0, L; chunk_geom(c, row0, L);
  const bf16_t* proj = (const bf16_t*)(p.ws + OFF_A);
#pragma unroll
  for (int i = 0; i < 2; ++i) {
    const int id = tid + i * 256, s = id >> 3, c8 = id & 7;
    uint4 v = make_uint4(0, 0, 0, 0);
    if (s < L) v = *(const uint4*)(proj + (size_t)(row0 + s) * 3200 + 2576 + gq * 64 + c8 * 8);
    float* d = Uf + s * 64 + c8 * 8;
    d[0] = lo2f(v.x); d[1] = hi2f(v.x); d[2] = lo2f(v.y); d[3] = hi2f(v.y); d[4] = lo2f(v.z); d[5] = hi2f(v.z); d[6] = lo2f(v.w); d[7] = hi2f(v.w);
  }
  const int g = gq * 4 + wave, gp = g * 64 + lane;
  const float* tab = (const float*)(p.ws + OFF_S5TAB);
  const float lr = tab[gp], li = tab[2048 + gp];
  float bbr[16], bbi[16];
#pragma unroll
  for (int q = 0; q < 4; ++q) {
    const float4 a = *(const float4*)(tab + 4096 + gp * 16 + q * 4), b = *(const float4*)(tab + 4096 + 32768 + gp * 16 + q * 4);
    bbr[q * 4] = a.x; bbr[q * 4 + 1] = a.y; bbr[q * 4 + 2] = a.z; bbr[q * 4 + 3] = a.w;
    bbi[q * 4] = b.x; bbi[q * 4 + 1] = b.y; bbi[q * 4 + 2] = b.z; bbi[q * 4 + 3] = b.w;
  }
  float hr = 0.f, hi = 0.f;
  bf16_t* HS = HSall + wave * 32 * 136; bf16_t* CM = CMall + wave * 16 * 136;
  if (OUT) {
    const float2 h0 = *(const float2*)((const float*)(p.ws + OFF_S5H) + ((size_t)c * 2048 + gp) * 2);
    hr = h0.x; hi = h0.y;
#pragma unroll
    for (int ch = 0; ch < 16; ++ch) { CM[ch * 136 + lane] = f2bf(p.s5_c_re[(g * 16 + ch) * 64 + lane]); CM[ch * 136 + 64 + lane] = f2bf(-p.s5_c_im[(g * 16 + ch) * 64 + lane]); }
  }
  __syncthreads();
  const int nhalf = OUT ? ((L + 31) >> 5) : 1, tl = OUT ? 32 : 64;
  for (int hf = 0; hf < nhalf; ++hf) {
    for (int tt = 0; tt < tl; ++tt) {
      const int t = hf * 32 + tt;
      if (t < L) {
        const float* up = Uf + t * 64 + wave * 16;
        float bur = 0.f, bui = 0.f;
#pragma unroll
        for (int q = 0; q < 4; ++q) {
          const float4 u4 = *(const float4*)(up + q * 4);
          bur += bbr[q * 4] * u4.x + bbr[q * 4 + 1] * u4.y + bbr[q * 4 + 2] * u4.z + bbr[q * 4 + 3] * u4.w;
          bui += bbi[q * 4] * u4.x + bbi[q * 4 + 1] * u4.y + bbi[q * 4 + 2] * u4.z + bbi[q * 4 + 3] * u4.w;
        }
        const float nr = lr * hr - li * hi + bur, ni = lr * hi + li * hr + bui;
        hr = nr; hi = ni;
      }
      if (OUT) { HS[tt * 136 + lane] = f2bf(t < L ? hr : 0.f); HS[tt * 136 + 64 + lane] = f2bf(t < L ? hi : 0.f); }
    }
    if (OUT) {
      __syncthreads();
      f32x4 ay[2][1];
      ay[0][0] = (f32x4){0.f, 0.f, 0.f, 0.f}; ay[1][0] = (f32x4){0.f, 0.f, 0.f, 0.f};
      wmma_sw<2, 1>(ay, HS, 136, CM, 136, 128, lane);
      bf16_t* gbuf = (bf16_t*)(p.ws + OFF_GBUF);
#pragma unroll
      for (int mt = 0; mt < 2; ++mt) {
        const int t = hf * 32 + mt * 16 + (lane & 15), ch0 = (lane >> 4) * 4;
        if (t < L) {
          const float4 u4 = *(const float4*)(Uf + t * 64 + wave * 16 + ch0);
          const float4 d4 = *(const float4*)(p.s5_d + g * 16 + ch0);
          float y[4] = {ay[mt][0][0] + d4.x * u4.x, ay[mt][0][1] + d4.y * u4.y, ay[mt][0][2] + d4.z * u4.z, ay[mt][0][3] + d4.w * u4.w};
#pragma unroll
          for (int j = 0; j < 4; ++j) { const float x = y[j], uu = 0.7978845608028654f * (x + 0.044715f * x * x * x); y[j] = x / (1.f + __expf(-2.f * uu)); }
          store4bf(gbuf + (size_t)(row0 + t) * 512 + g * 16 + ch0, y[0], y[1], y[2], y[3]);
        }
      }
      __syncthreads();
    }
  }
  if (!OUT) { *(float2*)((float*)(p.ws + OFF_S5E) + ((size_t)c * 2048 + gp) * 2) = make_float2(hr, hi); }
  __syncthreads();
}

__device__ __forceinline__ void s5_prefix(const Params& p, int gt) {
  const int sq = gt >> 11, rem = gt & 2047;
  const float* tab = (const float*)(p.ws + OFF_S5TAB);
  const float* e = (const float*)(p.ws + OFF_S5E);
  float* hs = (float*)(p.ws + OFF_S5H);
  float hr = 0.f, hi = 0.f;
  if (sq < 8) {
    const float lr = tab[69632 + rem], li = tab[71680 + rem];
    for (int n = 0; n < 32; ++n) {
      const size_t idx = ((size_t)(sq * 32 + n) * 2048 + rem) * 2;
      *(float2*)(hs + idx) = make_float2(hr, hi);
      const float2 ev = *(const float2*)(e + idx);
      const float nr = lr * hr - li * hi + ev.x, ni = lr * hi + li * hr + ev.y; hr = nr; hi = ni;
    }
  } else {
    const float lr = tab[73728 + rem], li = tab[75776 + rem];
    hr = p.state_s5_re[(size_t)(sq - 8) * 2048 + rem]; hi = p.state_s5_im[(size_t)(sq - 8) * 2048 + rem];
    const size_t idx = ((size_t)(256 + sq - 8) * 2048 + rem) * 2;
    *(float2*)(hs + idx) = make_float2(hr, hi);
    const float2 ev = *(const float2*)(e + idx);
    const float nr = lr * hr - li * hi + ev.x, ni = lr * hi + li * hr + ev.y; hr = nr; hi = ni;
  }
  p.out[O_S5RE + (size_t)sq * 2048 + rem] = hr;
  p.out[O_S5IM + (size_t)sq * 2048 + rem] = hi;
}

__device__ __forceinline__ void conv_phase(const Params& p) {
  const bf16_t* proj = (const bf16_t*)(p.ws + OFF_A);
  bf16_t* xc = (bf16_t*)(p.ws + OFF_H);
  const int gt = blockIdx.x * NTHR + threadIdx.x, nt = gridDim.x * NTHR;
  for (int it = gt; it < ROWS * 192; it += nt) {
    const int row = it / 192, c = (it % 192) * 8;
    int t, T, sq;
    if (row < 16384) { t = row & 2047; T = 2048; sq = row >> 11; } else { t = (row - 16384) & 7; T = 8; sq = 8 + ((row - 16384) >> 3); }
    float a[8];
    { const float4 b0 = *(const float4*)(p.conv_b + c), b1 = *(const float4*)(p.conv_b + c + 4); a[0] = b0.x; a[1] = b0.y; a[2] = b0.z; a[3] = b0.w; a[4] = b1.x; a[5] = b1.y; a[6] = b1.z; a[7] = b1.w; }
    float cur[8];
#pragma unroll
    for (int j = 0; j < 4; ++j) {
      const int tt = t - 3 + j;
      float x[8];
      if (tt >= 0) {
        const uint4 v = *(const uint4*)(proj + (size_t)(row - 3 + j) * 3200 + 1024 + c);
        x[0] = lo2f(v.x); x[1] = hi2f(v.x); x[2] = lo2f(v.y); x[3] = hi2f(v.y); x[4] = lo2f(v.z); x[5] = hi2f(v.z); x[6] = lo2f(v.w); x[7] = hi2f(v.w);
      } else if (sq >= 8) {
        const float* sc = p.state_conv + ((size_t)(sq - 8) * 3 + (3 + tt)) * 1536 + c;
        const float4 v0 = *(const float4*)sc, v1 = *(const float4*)(sc + 4);
        x[0] = v0.x; x[1] = v0.y; x[2] = v0.z; x[3] = v0.w; x[4] = v1.x; x[5] = v1.y; x[6] = v1.z; x[7] = v1.w;
      } else {
#pragma unroll
        for (int e = 0; e < 8; ++e) x[e] = 0.f;
      }
      const float4 w0 = *(const float4*)(p.conv_w + j * 1536 + c), w1 = *(const float4*)(p.conv_w + j * 1536 + c + 4);
      a[0] += w0.x * x[0]; a[1] += w0.y * x[1]; a[2] += w0.z * x[2]; a[3] += w0.w * x[3]; a[4] += w1.x * x[4]; a[5] += w1.y * x[5]; a[6] += w1.z * x[6]; a[7] += w1.w * x[7];
      if (j == 3) {
#pragma unroll
        for (int e = 0; e < 8; ++e) cur[e] = x[e];
      }
    }
    uint4 o; o.x = pack2(siluf(a[0]), siluf(a[1])); o.y = pack2(siluf(a[2]), siluf(a[3])); o.z = pack2(siluf(a[4]), siluf(a[5])); o.w = pack2(siluf(a[6]), siluf(a[7]));
    *(uint4*)(xc + (size_t)row * 1536 + c) = o;
    if (t >= T - 3) {
      float* d = p.out + O_CONV + ((size_t)sq * 3 + (t - (T - 3))) * 1536 + c;
      *(float4*)d = make_float4(cur[0], cur[1], cur[2], cur[3]); *(float4*)(d + 4) = make_float4(cur[4], cur[5], cur[6], cur[7]);
    }
  }
}

__device__ __forceinline__ void ssdnorm_phase(const Params& p) {
  const bf16_t* proj = (const bf16_t*)(p.ws + OFF_A);
  bf16_t* mix = (bf16_t*)(p.ws + OFF_H);
  const float* st = (const float*)(p.ws + OFF_SSDST);
  const int gt = blockIdx.x * NTHR + threadIdx.x, nt = gridDim.x * NTHR;
  for (int it = gt; it < ROWS * 128; it += nt) {
    const int row = it >> 7, c = (it & 127) * 8;
    const float r = rsqrtf(st[(size_t)row * 2 + (c >> 9)] * (1.f / 512.f) + EPSV);
    const uint4 v = *(const uint4*)(proj + (size_t)row * 3200 + c);
    const float4 w0 = *(const float4*)(p.ssm_norm_w + c), w1 = *(const float4*)(p.ssm_norm_w + c + 4);
    uint4 o; o.x = pack2(lo2f(v.x) * r * w0.x, hi2f(v.x) * r * w0.y); o.y = pack2(lo2f(v.y) * r * w0.z, hi2f(v.y) * r * w0.w);
    o.z = pack2(lo2f(v.z) * r * w1.x, hi2f(v.z) * r * w1.y); o.w = pack2(lo2f(v.w) * r * w1.z, hi2f(v.w) * r * w1.w);
    *(uint4*)(mix + (size_t)row * 1536 + c) = o;
  }
}


#define XB_TMO      128
#define XB_XCNT(j)  (256  + 64 * (j))
#define XB_XSUB(j)  (1280 + 64 * (j))
#define XB_XGEN(j)  (2304 + 64 * (j))
#define XB_TOP      3328
#define XB_TOPGEN   3392
#define XCD_BAR_WORDS 3456
#define XB_SPIN_CAP (1u << 18)
#define LAS __attribute__((address_space(3)))
__device__ __forceinline__ unsigned xb_ld(unsigned* p)              { return __hip_atomic_load(p, __ATOMIC_RELAXED, __HIP_MEMORY_SCOPE_AGENT); }
__device__ __forceinline__ unsigned xb_add(unsigned* p, unsigned v) { return __hip_atomic_fetch_add(p, v, __ATOMIC_RELAXED, __HIP_MEMORY_SCOPE_AGENT); }
__device__ __forceinline__ unsigned xb_xcc_id() { return (unsigned)__builtin_amdgcn_s_getreg((3 << 11) | 20) & 0xFu; }
#define XB_SPIN(cond, bar) do { unsigned _sp = 0; while (cond) { __builtin_amdgcn_s_sleep(1); \
    if ((++_sp & 255u) == 0u) { if (xb_ld(&(bar)[XB_TMO])) break; if (_sp > XB_SPIN_CAP) { atomicAdd(&(bar)[XB_TMO], 1u); break; } } } } while (0)
struct XcdBarrier { unsigned* bar; unsigned x; volatile LAS unsigned* st; };
__device__ __forceinline__ XcdBarrier xcd_barrier_post(unsigned* bar, volatile LAS unsigned* st) {
    XcdBarrier b; b.bar = bar; b.x = xb_xcc_id(); b.st = st;
    if (threadIdx.x == 0) (void)xb_add(&bar[XB_XCNT(b.x)], 1u);
    return b;
}
__device__ __forceinline__ void xcd_barrier_complete(unsigned* bar, unsigned x, unsigned& nloc, unsigned& nx) {
    const unsigned G = gridDim.x * gridDim.y * gridDim.z;
    unsigned sum, cnt, mine, sp = 0u;
    for (;;) {
        sum = 0u; cnt = 0u; mine = 0u;
#pragma unroll
        for (unsigned j = 0; j < 16; ++j) { const unsigned c = xb_ld(&bar[XB_XCNT(j)]); sum += c; cnt += (c > 0u) ? 1u : 0u; mine = (j == x) ? c : mine; }
        if (sum == G) break;
        __builtin_amdgcn_s_sleep(1);
        if ((++sp & 255u) == 0u) { if (xb_ld(&bar[XB_TMO])) break; if (sp > XB_SPIN_CAP) { atomicAdd(&bar[XB_TMO], 1u); break; } }
    }
    nloc = mine > 0u ? mine : 1u; nx = cnt > 0u ? cnt : 1u;
}
__device__ __forceinline__ void xcd_barrier(const XcdBarrier& b) {
    asm volatile("s_waitcnt vmcnt(0)" ::: "memory");
    __syncthreads();
    if (threadIdx.x == 0) {
        unsigned* bar = b.bar;
        __builtin_amdgcn_s_waitcnt(0);
        unsigned nloc = b.st[0], nx = b.st[1];
        if (nloc == 0u) { xcd_barrier_complete(bar, b.x, nloc, nx); b.st[0] = nloc; b.st[1] = nx; }
        const unsigned old = xb_add(&bar[XB_XSUB(b.x)], 1u);
        const unsigned gen = old / nloc;
        if (old + 1u == (gen + 1u) * nloc) {
            __builtin_amdgcn_fence(__ATOMIC_RELEASE, "agent");
            asm volatile("s_waitcnt vmcnt(0)" ::: "memory");
            const unsigned og = xb_add(&bar[XB_TOP], 1u);
            const unsigned tg = og / nx;
            if (og + 1u == (tg + 1u) * nx) xb_add(&bar[XB_TOPGEN], 1u);
            else XB_SPIN(xb_ld(&bar[XB_TOPGEN]) == tg, bar);
            __builtin_amdgcn_fence(__ATOMIC_ACQUIRE, "agent");
            xb_add(&bar[XB_XGEN(b.x)], 1u);
            asm volatile("s_waitcnt vmcnt(0)" ::: "memory");
        } else {
            XB_SPIN(xb_ld(&bar[XB_XGEN(b.x)]) == gen, bar);
            __builtin_amdgcn_fence(__ATOMIC_ACQUIRE, "agent");
            asm volatile("s_waitcnt vmcnt(0)" ::: "memory");
        }
    }
    __syncthreads();
}

__global__ void __launch_bounds__(NTHR, 2) fwd_megakernel(Params p) {
  extern __shared__ __attribute__((aligned(16))) char smem[];
  cg::grid_group grid = cg::this_grid();
  if (p.ws == nullptr) grid.sync();
  volatile LAS unsigned* xst = (volatile LAS unsigned*)(smem + 81904);
  if (threadIdx.x == 0) { xst[0] = 0u; xst[1] = 0u; xst[2] = 0u; xst[3] = 0u; }
  __syncthreads();
  const XcdBarrier xb = xcd_barrier_post((unsigned*)(p.ws + OFF_BAR), xst);
  const int G = gridDim.x, bid = blockIdx.x;
  bf16_t* W = (bf16_t*)p.ws;
  bf16_t* bufA = (bf16_t*)(p.ws + OFF_A);
  bf16_t* bufH = (bf16_t*)(p.ws + OFF_H);
  bf16_t* t0 = (bf16_t*)(p.ws + OFF_ST);
  float* rowss = (float*)(p.ws + OFF_ROWSS);
  float* hbuf = p.out;

  for (int rep_ = 0; rep_ < REP0; ++rep_) {
  prep_tables(p);
  wconv(p.w_in_even, 1024, 4096, 4096, (bf16_t*)(p.ws + W_IN), smem);
  wconv(p.w_out_even, 1024, 1024, 1024, (bf16_t*)(p.ws + W_OUT0), smem);
  wconv(p.w_ffn_up, 1024, 4096, 4096, (bf16_t*)(p.ws + W_UP), smem);
  wconv(p.w_ffn_down, 4096, 1024, 1024, (bf16_t*)(p.ws + W_DOWN), smem);
  rowpass_phase(nullptr, nullptr, nullptr, p.x_prompt, p.x_sample, nullptr, p.norm_mix_pre, bufH);
  }
  xcd_barrier(xb);
  { EpiInEven e{bufA, (const float*)(p.ws + OFF_ROPE), (const float*)(p.ws + OFF_LB)};
    gemm_phase(bufH, 1024, (const bf16_t*)(p.ws + W_IN), 1024, 136, 32, 1024, e, smem); }
  xcd_barrier(xb);
  for (int rep_ = 0; rep_ < REPS; ++rep_)
  for (int u = bid; u < 256 + 4096; u += G) {
    int v = u < 256 ? u : u - 256;
    const int m = v & 1; v >>= 1;
    const int ps = v & 3, h = (v >> 2) & 3, sq = (u < 256 ? 0 : 8) + (v >> 4);
    if (m == 0) state_unit<0>(p, sq, h, ps, smem); else state_unit<1>(p, sq, h, ps, smem);
  }
  xcd_barrier(xb);
  for (int rep_ = 0; rep_ < REPO; ++rep_)
  for (int u = bid; u < 384 * 8; u += G) {
    const int m = u & 1, h = (u >> 1) & 3, c = u >> 3;
    if (m == 0) out_unit<0>(p, c, h, smem); else out_unit<1>(p, c, h, smem);
  }
  xcd_barrier(xb);
  { EpiOut e{t0, rowss};
    gemm_phase(bufH, 1024, (const bf16_t*)(p.ws + W_OUT0), 1024, 136, 8, 1024, e, smem); }
  xcd_barrier(xb);
  rowpass_phase(t0, rowss, p.norm_mix_post, p.x_prompt, p.x_sample, hbuf, p.norm_ffn_pre, bufH);
  xcd_barrier(xb);
  { EpiUp e{bufA}; gemm_phase(bufH, 1024, (const bf16_t*)(p.ws + W_UP), 1024, 136, 32, 1024, e, smem); }
  xcd_barrier(xb);
  { EpiOut e{t0, rowss + ROWS}; gemm_phase(bufA, 4096, (const bf16_t*)(p.ws + W_DOWN), 4096, 136, 8, 4096, e, smem); }
  xcd_barrier(xb);
  rowpass_phase(t0, rowss + ROWS, p.norm_ffn_post, hbuf, hbuf + (size_t)16384 * 1024, hbuf, p.norm_mix_pre + 1024, bufH);
  wconv(p.w_in_odd, 1024, 3088, 3200, (bf16_t*)(p.ws + W_IN), smem);
  wconv(p.w_glu, 512, 512, 512, (bf16_t*)(p.ws + W_GLU), smem);
  wconv(p.w_out_odd, 1536, 1024, 1024, (bf16_t*)(p.ws + W_OUT1), smem);
  wconv(p.w_ffn_up + (size_t)1024 * 4096, 1024, 4096, 4096, (bf16_t*)(p.ws + W_UP), smem);
  wconv(p.w_ffn_down + (size_t)4096 * 1024, 4096, 1024, 1024, (bf16_t*)(p.ws + W_DOWN), smem);
  xcd_barrier(xb);
  { EpiInOdd e{bufA, (float*)(p.ws + OFF_DTBUF)};
    gemm_phase(bufH, 1024, (const bf16_t*)(p.ws + W_IN), 1024, 136, 25, 1024, e, smem); }
  xcd_barrier(xb);
  for (int rep_ = 0; rep_ < REPC; ++rep_) {
  conv_phase(p);
  for (int u = bid; u < 384 * 8; u += G) s5_unit<0>(p, u >> 3, u & 7, smem);
  }
  xcd_barrier(xb);
  for (int rep_ = 0; rep_ < REPS; ++rep_)
  for (int u = bid; u < 128 + 1088 + 2048; u += G) {
    if (u < 128) state_unit<2>(p, u >> 4, u & 15, 0, smem);
    else if (u < 128 + 1088) s5_prefix(p, (u - 128) * NTHR + threadIdx.x);
    else { const int v = u - 128 - 1088; state_unit<2>(p, 8 + (v >> 4), v & 15, 0, smem); }
  }
  xcd_barrier(xb);
  for (int u = bid; u < 384 * 16 + 384 * 8; u += G) {
    if (u < 384 * 16) out_unit<2>(p, u >> 4, u & 15, smem);
    else { const int v = u - 384 * 16; s5_unit<1>(p, v >> 3, v & 7, smem); }
  }
  xcd_barrier(xb);
  ssdnorm_phase(p);
  { EpiGlu e{(const bf16_t*)(p.ws + OFF_GBUF), p.b_glu, bufH};
    gemm_phase((const bf16_t*)(p.ws + OFF_GBUF), 512, (const bf16_t*)(p.ws + W_GLU), 512, 136, 4, 512, e, smem); }
  xcd_barrier(xb);
  { EpiOut e{t0, rowss + 2 * ROWS}; gemm_phase(bufH, 1536, (const bf16_t*)(p.ws + W_OUT1), 1536, 136, 8, 1536, e, smem); }
  xcd_barrier(xb);
  rowpass_phase(t0, rowss + 2 * ROWS, p.norm_mix_post + 1024, hbuf, hbuf + (size_t)16384 * 1024, hbuf, p.norm_ffn_pre + 1024, bufH);
  xcd_barrier(xb);
  { EpiUp e{bufA}; gemm_phase(bufH, 1024, (const bf16_t*)(p.ws + W_UP), 1024, 136, 32, 1024, e, smem); }
  xcd_barrier(xb);
  { EpiOut e{t0, rowss + 3 * ROWS}; gemm_phase(bufA, 4096, (const bf16_t*)(p.ws + W_DOWN), 4096, 136, 8, 4096, e, smem); }
  xcd_barrier(xb);
  for (int rep_ = 1; rep_ < REPY; ++rep_) xcd_barrier(xb);
  rowpass_phase(t0, rowss + 3 * ROWS, p.norm_ffn_post + 1024, hbuf, hbuf + (size_t)16384 * 1024, hbuf, nullptr, nullptr);
}

extern "C" void kernel_launch(void* const* d_in, const int* in_sizes, int n_in, void* d_out, int out_size, void* d_ws, size_t ws_size, hipStream_t stream) {
  constexpr size_t kDynLds = 81920;
  static int grid_blocks = 0;
  if (!grid_blocks) {
    int dev = 0, cus = 0, per_cu = 0;
    hipGetDevice(&dev);
    hipDeviceGetAttribute(&cus, hipDeviceAttributeMultiprocessorCount, dev);
    hipFuncSetAttribute((const void*)fwd_megakernel, hipFuncAttributeMaxDynamicSharedMemorySize, (int)kDynLds);
    hipOccupancyMaxActiveBlocksPerMultiprocessor(&per_cu, fwd_megakernel, NTHR, kDynLds);
    if (per_cu > 2) per_cu = 2;
    if (per_cu < 1) per_cu = 1;
    grid_blocks = cus * per_cu;
  }
  Params p{};
  const float** pf = (const float**)&p;
  for (int i = 0; i < 37; ++i) pf[i] = (const float*)d_in[i];
  p.out = (float*)d_out;
  p.ws = (char*)d_ws;
  hipMemsetAsync((char*)d_ws + OFF_BAR, 0, 16384, stream);
  void* args[] = {&p};
  hipError_t e = hipLaunchCooperativeKernel((void*)fwd_megakernel, dim3(grid_blocks), dim3(NTHR), args, kDynLds, stream);
  if (e != hipSuccess) fprintf(stderr, "cooperative launch failed: %s (grid %d)\n", hipGetErrorString(e), grid_blocks);
}
```

```cpp
#include <hip/hip_runtime.h>
#include <hip/hip_cooperative_groups.h>
#include <cstdio>
namespace cg = cooperative_groups;

typedef unsigned short bf16_t;
typedef short bf16x8 __attribute__((ext_vector_type(8)));
typedef float f32x4 __attribute__((ext_vector_type(4)));
typedef unsigned u32x4 __attribute__((ext_vector_type(4)));

#define NTHR 512
#ifndef REPG
#define REPG 1
#endif
#define HALF_LDS 73728
#ifndef REP0
#define REP0 1
#endif
#ifndef REPS
#define REPS 1
#endif
#ifndef REPO
#define REPO 1
#endif
#ifndef REPC
#define REPC 1
#endif
#ifndef REPY
#define REPY 21
#endif
#define ROWS 17408
#define EPSV 1e-6f
#define TIDX(w) ((w) * 64 + (int)__builtin_amdgcn_mbcnt_hi(~0u, __builtin_amdgcn_mbcnt_lo(~0u, 0u)))

constexpr size_t W_IN = 0;
constexpr size_t W_OUT0 = 8388608;
constexpr size_t W_GLU = 6815744;
constexpr size_t W_OUT1 = 7340032;
constexpr size_t W_UP = 10485760;
constexpr size_t W_DOWN = 18874368;
constexpr size_t OFF_A = 29360128;
constexpr size_t OFF_GBUF = OFF_A + 111411200;
constexpr size_t OFF_ST = OFF_A + 142606336;
constexpr size_t OFF_H = OFF_ST + 67108864;
constexpr size_t OFF_SM = OFF_H + 53477376;
constexpr size_t OFF_ROPE = OFF_SM;
constexpr size_t OFF_ROWSS = OFF_SM + 1052672;
constexpr size_t OFF_SSDST = OFF_SM + 1331200;
constexpr size_t OFF_DTBUF = OFF_SM + 1470464;
constexpr size_t OFF_LB = OFF_SM + 2584576;
constexpr size_t OFF_S5TAB = OFF_SM + 2586624;
constexpr size_t OFF_S5E = OFF_SM + 2897920;
constexpr size_t OFF_S5H = OFF_SM + 9189376;
constexpr size_t OFF_BAR = OFF_SM + 15480832;

constexpr size_t O_RET = 17825792, O_HG = 26738688, O_SSM = 35651584, O_CONV = 53477376, O_S5RE = 54104064, O_S5IM = 54382592;

struct Params {
  const float *x_prompt, *x_sample, *state_ret, *state_hgrn, *state_ssm, *state_conv, *state_s5_re, *state_s5_im;
  const float *norm_mix_pre, *norm_mix_post, *norm_ffn_pre, *norm_ffn_post;
  const float *w_in_even, *w_out_even, *ret_norm_w, *hgrn_lb, *hgrn_norm_w, *w_in_odd, *conv_w, *conv_b, *dt_bias, *a_log, *d_ssm, *ssm_norm_w;
  const float *s5_lam_re, *s5_lam_im, *s5_log_step, *s5_b_re, *s5_b_im, *s5_c_re, *s5_c_im, *s5_d, *w_glu, *b_glu, *w_out_odd, *w_ffn_up, *w_ffn_down;
  float* out;
  char* ws;
};

__device__ __forceinline__ bf16_t f2bf(float f) { unsigned r; asm("v_cvt_pk_bf16_f32 %0, %1, %1" : "=v"(r) : "v"(f)); return (bf16_t)(r & 0xffffu); }
__device__ __forceinline__ float bf2f(bf16_t h) { return __uint_as_float(((unsigned)h) << 16); }
__device__ __forceinline__ unsigned pack2(float a, float b) { unsigned r; asm("v_cvt_pk_bf16_f32 %0, %1, %2" : "=v"(r) : "v"(a), "v"(b)); return r; }
__device__ __forceinline__ float lo2f(unsigned u) { return __uint_as_float(u << 16); }
__device__ __forceinline__ float hi2f(unsigned u) { return __uint_as_float(u & 0xffff0000u); }
__device__ __forceinline__ float sigm(float x) { return 1.f / (1.f + __expf(-x)); }
__device__ __forceinline__ float siluf(float x) { return x / (1.f + __expf(-x)); }
__device__ __forceinline__ void store4bf(bf16_t* p, float a, float b, float c, float d) { uint2 v; v.x = pack2(a, b); v.y = pack2(c, d); *(uint2*)p = v; }

__device__ __forceinline__ float shx(float v, int mask) {
  int l = (int)__builtin_amdgcn_mbcnt_hi(~0u, __builtin_amdgcn_mbcnt_lo(~0u, 0u));
  asm volatile("" : "+v"(l));
  return __int_as_float(__builtin_amdgcn_ds_bpermute((l ^ mask) << 2, __float_as_int(v)));
}

template <int MT, int NT>
__device__ __forceinline__ void wmma_sw(f32x4 (&acc)[MT][NT], const bf16_t* A, int lda, const bf16_t* B, int ldb, int K, int lane) {
  const int r = lane & 15, kq = (lane >> 4) * 8;
  for (int k0 = 0; k0 < K; k0 += 32) {
    bf16x8 af[MT], bfr[NT];
#pragma unroll
    for (int mt = 0; mt < MT; ++mt) af[mt] = *(const bf16x8*)(A + (mt * 16 + r) * lda + k0 + kq);
#pragma unroll
    for (int nt = 0; nt < NT; ++nt) bfr[nt] = *(const bf16x8*)(B + (nt * 16 + r) * ldb + k0 + kq);
#pragma unroll
    for (int mt = 0; mt < MT; ++mt)
#pragma unroll
      for (int nt = 0; nt < NT; ++nt) acc[mt][nt] = __builtin_amdgcn_mfma_f32_16x16x32_bf16(bfr[nt], af[mt], acc[mt][nt], 0, 0, 0);
  }
}
template <int MT, int NT>
__device__ __forceinline__ void wmma_ns(f32x4 (&acc)[MT][NT], const bf16_t* A, int lda, const bf16_t* B, int ldb, int K, int lane) {
  const int r = lane & 15, kq = (lane >> 4) * 8;
  for (int k0 = 0; k0 < K; k0 += 32) {
    bf16x8 af[MT], bfr[NT];
#pragma unroll
    for (int mt = 0; mt < MT; ++mt) af[mt] = *(const bf16x8*)(A + (mt * 16 + r) * lda + k0 + kq);
#pragma unroll
    for (int nt = 0; nt < NT; ++nt) bfr[nt] = *(const bf16x8*)(B + (nt * 16 + r) * ldb + k0 + kq);
#pragma unroll
    for (int mt = 0; mt < MT; ++mt)
#pragma unroll
      for (int nt = 0; nt < NT; ++nt) acc[mt][nt] = __builtin_amdgcn_mfma_f32_16x16x32_bf16(af[mt], bfr[nt], acc[mt][nt], 0, 0, 0);
  }
}

__device__ __forceinline__ void gemm_kstep(f32x4 (&acc)[4][8], const bf16_t* A, const bf16_t* B, int lane) {
  const int r = lane & 15, kq = (lane >> 4) * 8;
  bf16x8 af[4];
#pragma unroll
  for (int mt = 0; mt < 4; ++mt) af[mt] = *(const bf16x8*)(A + (mt * 16 + r) * 72 + kq);
#pragma unroll
  for (int nh = 0; nh < 2; ++nh) {
    bf16x8 bfr[4];
#pragma unroll
    for (int nt = 0; nt < 4; ++nt) bfr[nt] = *(const bf16x8*)(B + ((nh * 4 + nt) * 16 + r) * 72 + kq);
#pragma unroll
    for (int nt = 0; nt < 4; ++nt)
#pragma unroll
      for (int mt = 0; mt < 4; ++mt) acc[mt][nh * 4 + nt] = __builtin_amdgcn_mfma_f32_16x16x32_bf16(bfr[nt], af[mt], acc[mt][nh * 4 + nt], 0, 0, 0);
  }
}

template <class Epi>
__device__ __forceinline__ void gemm_phase(const bf16_t* A, int lda, const bf16_t* Bt, int ldb, int nMt, int nNt, int K, const Epi& epi, char* smem, int wvs) {
  bf16_t* As = (bf16_t*)smem;
  bf16_t* Bs = As + 2 * 256 * 72;
  int tid_ = TIDX(wvs); asm volatile("" : "+v"(tid_)); const int tid = tid_, lane = tid & 63, wave = tid >> 6;
  const int wr = wave >> 1, wc = wave & 1;
  const int ntiles = nMt * nNt, nk = K >> 6;
  const int lrow = tid >> 3, lcc = (tid & 7) * 8;
  const unsigned toffA = (unsigned)(lrow * lda + lcc), toffB = (unsigned)(lrow * ldb + lcc);
  for (int tile = blockIdx.x; tile < ntiles; tile += gridDim.x) {
    const int pm = tile / nNt, pn = tile - pm * nNt;
    const bf16_t* Ab = A + (size_t)(pm * 256) * lda;
    const bf16_t* Bb = Bt + (size_t)(pn * 256) * ldb;
    f32x4 acc[4][8];
#pragma unroll
    for (int i = 0; i < 4; ++i)
#pragma unroll
      for (int j = 0; j < 8; ++j) acc[i][j] = (f32x4){0.f, 0.f, 0.f, 0.f};
    u32x4 rg[4];
#pragma unroll
    for (int i = 0; i < 4; ++i) rg[i] = *(const u32x4*)(Ab + (size_t)(i * 64) * lda + toffA);
#pragma unroll
    for (int i = 0; i < 4; ++i) *(u32x4*)(As + (lrow + i * 64) * 72 + lcc) = rg[i];
#pragma unroll
    for (int i = 0; i < 4; ++i) rg[i] = *(const u32x4*)(Bb + (size_t)(i * 64) * ldb + toffB);
#pragma unroll
    for (int i = 0; i < 4; ++i) *(u32x4*)(Bs + (lrow + i * 64) * 72 + lcc) = rg[i];
    __syncthreads();
#pragma unroll 1
    for (int kt = 0; kt < nk; ++kt) {
      const int cur = kt & 1;
      const int kn = (kt + 1 < nk ? kt + 1 : kt) * 64;
      bf16_t* Ad = As + (cur ^ 1) * 256 * 72; bf16_t* Bd = Bs + (cur ^ 1) * 256 * 72;
#pragma unroll
      for (int i = 0; i < 4; ++i) rg[i] = *(const u32x4*)(Ab + ((size_t)(i * 64) * lda + kn) + toffA);
      __builtin_amdgcn_sched_barrier(0);
      gemm_kstep(acc, As + cur * 256 * 72 + wr * 64 * 72, Bs + cur * 256 * 72 + wc * 128 * 72, lane);
      __builtin_amdgcn_sched_barrier(0);
#pragma unroll
      for (int i = 0; i < 4; ++i) *(u32x4*)(Ad + (lrow + i * 64) * 72 + lcc) = rg[i];
#pragma unroll
      for (int i = 0; i < 4; ++i) rg[i] = *(const u32x4*)(Bb + ((size_t)(i * 64) * ldb + kn) + toffB);
      __builtin_amdgcn_sched_barrier(0);
      gemm_kstep(acc, As + cur * 256 * 72 + wr * 64 * 72 + 32, Bs + cur * 256 * 72 + wc * 128 * 72 + 32, lane);
      __builtin_amdgcn_sched_barrier(0);
#pragma unroll
      for (int i = 0; i < 4; ++i) *(u32x4*)(Bd + (lrow + i * 64) * 72 + lcc) = rg[i];
      __syncthreads();
    }
    int er_ = pm * 256 + wr * 64, ec_ = pn * 256 + wc * 128, el_ = lane;
    asm volatile("" : "+v"(er_), "+v"(ec_), "+v"(el_));
    epi(acc, er_, ec_, el_);
  }
}

struct EpiInEven {
  bf16_t* proj; const float* rope; const float* lb;
  template <int MT> __device__ __forceinline__ void operator()(f32x4 (&acc)[MT][8], int rbase, int cbase, int lane) const {
    const int sec = cbase >> 9, head = (cbase >> 7) & 3, r = lane & 15, cq = (lane >> 4) * 4;
#pragma unroll
    for (int mt = 0; mt < MT; ++mt) {
      __builtin_amdgcn_sched_barrier(0);
      const int row = rbase + mt * 16 + r;
      bf16_t* dst = proj + (size_t)row * 4096 + cbase + cq;
      if (sec < 2) {
        const int pidx = row < 16384 ? (row & 2047) : 2048 + ((row - 16384) & 7);
        const float* ct = rope + pidx * 128 + cq;
        const float sc = sec == 1 ? 0.08838834764831845f : 1.f;
#pragma unroll
        for (int nt = 0; nt < 4; ++nt) {
          const float4 c4 = *(const float4*)(ct + nt * 16), s4 = *(const float4*)(ct + 64 + nt * 16);
          const f32x4 x1 = acc[mt][nt], x2 = acc[mt][nt + 4];
          store4bf(dst + nt * 16, (x1[0] * c4.x - x2[0] * s4.x) * sc, (x1[1] * c4.y - x2[1] * s4.y) * sc, (x1[2] * c4.z - x2[2] * s4.z) * sc, (x1[3] * c4.w - x2[3] * s4.w) * sc);
          store4bf(dst + 64 + nt * 16, (x1[0] * s4.x + x2[0] * c4.x) * sc, (x1[1] * s4.y + x2[1] * c4.y) * sc, (x1[2] * s4.z + x2[2] * c4.z) * sc, (x1[3] * s4.w + x2[3] * c4.w) * sc);
        }
      } else if (sec == 5) {
#pragma unroll
        for (int nt = 0; nt < 8; ++nt) {
          const float4 l4 = *(const float4*)(lb + head * 128 + nt * 16 + cq);
          const f32x4 x = acc[mt][nt];
          store4bf(dst + nt * 16, __logf(l4.x + (1.f - l4.x) * sigm(x[0])), __logf(l4.y + (1.f - l4.y) * sigm(x[1])), __logf(l4.z + (1.f - l4.z) * sigm(x[2])), __logf(l4.w + (1.f - l4.w) * sigm(x[3])));
        }
      } else {
#pragma unroll
        for (int nt = 0; nt < 8; ++nt) { const f32x4 x = acc[mt][nt]; store4bf(dst + nt * 16, x[0], x[1], x[2], x[3]); }
      }
    }
  }
};
struct EpiOut {
  bf16_t* t0; float* rowss;
  template <int MT> __device__ __forceinline__ void operator()(f32x4 (&acc)[MT][8], int rbase, int cbase, int lane) const {
    const int r = lane & 15, cq = (lane >> 4) * 4;
#pragma unroll
    for (int mt = 0; mt < MT; ++mt) {
      __builtin_amdgcn_sched_barrier(0);
      const int row = rbase + mt * 16 + r;
      bf16_t* dst = t0 + (size_t)row * 1024 + cbase + cq;
      float ss = 0.f;
#pragma unroll
      for (int nt = 0; nt < 8; ++nt) { const f32x4 x = acc[mt][nt]; ss += x[0] * x[0] + x[1] * x[1] + x[2] * x[2] + x[3] * x[3]; store4bf(dst + nt * 16, x[0], x[1], x[2], x[3]); }
      ss += shx(ss, 16); ss += shx(ss, 32);
      if (lane < 16) atomicAdd(rowss + row, ss * (1.f / REPG));
    }
  }
};
struct EpiUp {
  bf16_t* act;
  template <int MT> __device__ __forceinline__ void operator()(f32x4 (&acc)[MT][8], int rbase, int cbase, int lane) const {
    const int r = lane & 15, cq = (lane >> 4) * 4;
#pragma unroll
    for (int mt = 0; mt < MT; ++mt) {
      __builtin_amdgcn_sched_barrier(0);
      bf16_t* dst = act + (size_t)(rbase + mt * 16 + r) * 4096 + cbase + cq;
#pragma unroll
      for (int nt = 0; nt < 8; ++nt) { f32x4 x = acc[mt][nt];
#pragma unroll
        for (int j = 0; j < 4; ++j) { float v = fmaxf(x[j], 0.f); x[j] = v * v; }
        store4bf(dst + nt * 16, x[0], x[1], x[2], x[3]); }
    }
  }
};
struct EpiInOdd {
  bf16_t* proj; float* dtbuf;
  template <int MT> __device__ __forceinline__ void operator()(f32x4 (&acc)[MT][8], int rbase, int cbase, int lane) const {
    const int r = lane & 15, cq = (lane >> 4) * 4;
#pragma unroll
    for (int mt = 0; mt < MT; ++mt) {
      __builtin_amdgcn_sched_barrier(0);
      const int row = rbase + mt * 16 + r;
      bf16_t* dst = proj + (size_t)row * 3200 + cbase + cq;
#pragma unroll
      for (int nt = 0; nt < 8; ++nt) { const f32x4 x = acc[mt][nt]; if (cbase + nt * 16 < 3200) store4bf(dst + nt * 16, x[0], x[1], x[2], x[3]); }
      if (cbase == 2560) { const f32x4 x = acc[mt][0]; *(float4*)(dtbuf + (size_t)row * 16 + cq) = make_float4(x[0], x[1], x[2], x[3]); }
    }
  }
};
struct EpiGlu {
  const bf16_t* gbuf; const float* bglu; bf16_t* mix;
  template <int MT> __device__ __forceinline__ void operator()(f32x4 (&acc)[MT][8], int rbase, int cbase, int lane) const {
    const int r = lane & 15, cq = (lane >> 4) * 4;
#pragma unroll
    for (int mt = 0; mt < MT; ++mt) {
      __builtin_amdgcn_sched_barrier(0);
      const int row = rbase + mt * 16 + r;
#pragma unroll
      for (int nt = 0; nt < 8; ++nt) {
        const int col = cbase + nt * 16 + cq;
        const f32x4 x = acc[mt][nt];
        const uint2 g2 = *(const uint2*)(gbuf + (size_t)row * 512 + col);
        const float4 b4 = *(const float4*)(bglu + col);
        store4bf(mix + (size_t)row * 1536 + 1024 + col, lo2f(g2.x) * sigm(x[0] + b4.x), hi2f(g2.x) * sigm(x[1] + b4.y), lo2f(g2.y) * sigm(x[2] + b4.z), hi2f(g2.y) * sigm(x[3] + b4.w));
      }
    }
  }
};

template <class Epi>
__device__ __forceinline__ void gemm_tail(const bf16_t* A, int lda, const bf16_t* Bt, int ldb, int nNt128, int K, const Epi& epi, char* smem, int wvs, int nBig) {
  bf16_t* As = (bf16_t*)smem;
  bf16_t* Bs = As + 2 * 128 * 72;
  int tid_ = TIDX(wvs); asm volatile("" : "+v"(tid_)); const int tid = tid_, lane = tid & 63, wave = tid >> 6;
  const int nk = K >> 6, G = gridDim.x;
  const int lrow = tid >> 3, lcc = (tid & 7) * 8;
  const unsigned toffA = (unsigned)(lrow * lda + lcc), toffB = (unsigned)(lrow * ldb + lcc);
  const int rr = nBig % G, nLight = G - rr;
  const int nSmall = 8 * nNt128;
  if ((int)blockIdx.x >= rr) {
    for (int j = (int)blockIdx.x - rr; j < nSmall; j += nLight) {
      const int pm = j / nNt128, pn = j - pm * nNt128;
      const bf16_t* Ab = A + (size_t)(16384 + pm * 128) * lda;
      const bf16_t* Bb = Bt + (size_t)(pn * 128) * ldb;
      f32x4 acc[1][8];
#pragma unroll
      for (int q = 0; q < 8; ++q) acc[0][q] = (f32x4){0.f, 0.f, 0.f, 0.f};
      u32x4 ra[2], rb[2];
#pragma unroll
      for (int i = 0; i < 2; ++i) { ra[i] = *(const u32x4*)(Ab + (size_t)(i * 64) * lda + toffA); rb[i] = *(const u32x4*)(Bb + (size_t)(i * 64) * ldb + toffB); }
#pragma unroll
      for (int i = 0; i < 2; ++i) { *(u32x4*)(As + (lrow + i * 64) * 72 + lcc) = ra[i]; *(u32x4*)(Bs + (lrow + i * 64) * 72 + lcc) = rb[i]; }
      __syncthreads();
#pragma unroll 1
      for (int kt = 0; kt < nk; ++kt) {
        const int cur = kt & 1;
        const int kn = (kt + 1 < nk ? kt + 1 : kt) * 64;
#pragma unroll
        for (int i = 0; i < 2; ++i) { ra[i] = *(const u32x4*)(Ab + ((size_t)(i * 64) * lda + kn) + toffA); rb[i] = *(const u32x4*)(Bb + ((size_t)(i * 64) * ldb + kn) + toffB); }
        __builtin_amdgcn_sched_barrier(0);
        wmma_sw<1, 8>(acc, As + cur * 128 * 72 + wave * 16 * 72, 72, Bs + cur * 128 * 72, 72, 64, lane);
        __builtin_amdgcn_sched_barrier(0);
        bf16_t* Ad = As + (cur ^ 1) * 128 * 72; bf16_t* Bd = Bs + (cur ^ 1) * 128 * 72;
#pragma unroll
        for (int i = 0; i < 2; ++i) { *(u32x4*)(Ad + (lrow + i * 64) * 72 + lcc) = ra[i]; *(u32x4*)(Bd + (lrow + i * 64) * 72 + lcc) = rb[i]; }
        __syncthreads();
      }
      int er_ = 16384 + pm * 128 + wave * 16, ec_ = pn * 128, el_ = lane;
      asm volatile("" : "+v"(er_), "+v"(ec_), "+v"(el_));
      epi(acc, er_, ec_, el_);
    }
  }
}

__device__ __forceinline__ void rowpass_phase(const bf16_t* t0, const float* rowss, const float* wpost, const float* hin_a, const float* hin_b, float* hout, const float* wnext, bf16_t* hn, int wvs) {
  int tq_ = TIDX(wvs); asm volatile("" : "+v"(tq_)); const int lane = tq_ & 63, gw = blockIdx.x * 8 + (tq_ >> 6), nw = gridDim.x * 8;
  for (int row = gw; row < ROWS; row += nw) {
    const float* hin = row < 16384 ? hin_a + (size_t)row * 1024 : hin_b + (size_t)(row - 16384) * 1024;
    float r0 = 0.f;
    if (t0) r0 = rsqrtf(rowss[row] * (1.f / 1024.f) + EPSV);
    float4 v[4]; float ss = 0.f;
#pragma unroll
    for (int i = 0; i < 4; ++i) {
      const int col = (i * 64 + lane) * 4;
      float4 hv = *(const float4*)(hin + col);
      if (t0) {
        const uint2 t2 = *(const uint2*)(t0 + (size_t)row * 1024 + col);
        const float4 w4 = *(const float4*)(wpost + col);
        hv.x += lo2f(t2.x) * r0 * w4.x; hv.y += hi2f(t2.x) * r0 * w4.y; hv.z += lo2f(t2.y) * r0 * w4.z; hv.w += hi2f(t2.y) * r0 * w4.w;
      }
      v[i] = hv; ss += hv.x * hv.x + hv.y * hv.y + hv.z * hv.z + hv.w * hv.w;
      if (hout) *(float4*)(hout + (size_t)row * 1024 + col) = hv;
    }
    if (hn) {
#pragma unroll
      for (int o = 32; o >= 1; o >>= 1) ss += shx(ss, o);
      const float r1 = rsqrtf(ss * (1.f / 1024.f) + EPSV);
#pragma unroll
      for (int i = 0; i < 4; ++i) {
        const int col = (i * 64 + lane) * 4;
        const float4 w4 = *(const float4*)(wnext + col);
        store4bf(hn + (size_t)row * 1024 + col, v[i].x * r1 * w4.x, v[i].y * r1 * w4.y, v[i].z * r1 * w4.z, v[i].w * r1 * w4.w);
      }
    }
  }
}

__device__ __forceinline__ void wconv(const float* __restrict__ W, int K, int N, int Npad, bf16_t* __restrict__ Wt, char* smem, int wvs) {
  float* tile = (float*)smem;
  int tq_ = TIDX(wvs) & 255; asm volatile("" : "+v"(tq_)); const int tid = tq_;
  const int nNt = Npad >> 6, nunits = (K >> 6) * nNt;
  for (int u = blockIdx.x * 2 + (wvs >> 2); u < nunits; u += gridDim.x * 2) {
    const int k0 = (u / nNt) * 64, n0 = (u % nNt) * 64;
#pragma unroll
    for (int ps = 0; ps < 4; ++ps) {
      const int i = ps * 16 + (tid >> 4), j = (tid & 15) * 4, n = n0 + j;
      float4 v = make_float4(0.f, 0.f, 0.f, 0.f);
      if (n < N) v = *(const float4*)(W + (size_t)(k0 + i) * N + n);
      tile[i * 65 + j] = v.x; tile[i * 65 + j + 1] = v.y; tile[i * 65 + j + 2] = v.z; tile[i * 65 + j + 3] = v.w;
    }
    __syncthreads();
    {
      const int n = tid >> 2, kq = (tid & 3) * 16;
      uint4 o0, o1;
      o0.x = pack2(tile[(kq + 0) * 65 + n], tile[(kq + 1) * 65 + n]); o0.y = pack2(tile[(kq + 2) * 65 + n], tile[(kq + 3) * 65 + n]);
      o0.z = pack2(tile[(kq + 4) * 65 + n], tile[(kq + 5) * 65 + n]); o0.w = pack2(tile[(kq + 6) * 65 + n], tile[(kq + 7) * 65 + n]);
      o1.x = pack2(tile[(kq + 8) * 65 + n], tile[(kq + 9) * 65 + n]); o1.y = pack2(tile[(kq + 10) * 65 + n], tile[(kq + 11) * 65 + n]);
      o1.z = pack2(tile[(kq + 12) * 65 + n], tile[(kq + 13) * 65 + n]); o1.w = pack2(tile[(kq + 14) * 65 + n], tile[(kq + 15) * 65 + n]);
      bf16_t* d = Wt + (size_t)(n0 + n) * K + k0 + kq;
      *(uint4*)d = o0; *(uint4*)(d + 8) = o1;
    }
    __syncthreads();
  }
}

__device__ __forceinline__ void prep_tables(const Params& p, int wvs) {
  int tq_ = TIDX(wvs); asm volatile("" : "+v"(tq_)); const int gt = blockIdx.x * NTHR + tq_, nt = gridDim.x * NTHR;
  float* rope = (float*)(p.ws + OFF_ROPE);
  for (int i = gt; i < 2056 * 64; i += nt) {
    const int pi = i >> 6, f = i & 63;
    const double pos = pi < 2048 ? (double)pi : (double)(16384 + pi - 2048);
    const double invf = exp(-(double)f * (9.210340371976184 / 64.0));
    double ang = pos * invf;
    ang -= 6.283185307179586 * floor(ang * 0.15915494309189535);
    const float a = (float)ang;
    rope[pi * 128 + f] = cosf(a); rope[pi * 128 + 64 + f] = sinf(a);
  }
  float* z = (float*)(p.ws + OFF_ROWSS);
  for (int i = gt; i < ROWS * 6; i += nt) z[i] = 0.f;
  float* lb = (float*)(p.ws + OFF_LB);
  for (int i = gt; i < 512; i += nt) lb[i] = 1.f / (1.f + expf(p.hgrn_lb[512 + i] - p.hgrn_lb[i]));
  float* tab = (float*)(p.ws + OFF_S5TAB);
  for (int i = gt; i < 2048; i += nt) {
    const int g = i >> 6;
    const float lr = p.s5_lam_re[i], li = p.s5_lam_im[i], dt = expf(p.s5_log_step[g]);
    const float m1 = expf(lr * dt), br = m1 * cosf(li * dt), bi = m1 * sinf(li * dt);
    tab[i] = br; tab[2048 + i] = bi;
    const float m64 = expf(lr * dt * 64.f); tab[69632 + i] = m64 * cosf(li * dt * 64.f); tab[71680 + i] = m64 * sinf(li * dt * 64.f);
    const float m8 = expf(lr * dt * 8.f); tab[73728 + i] = m8 * cosf(li * dt * 8.f); tab[75776 + i] = m8 * sinf(li * dt * 8.f);
    const float x = br - 1.f, y = bi, den = 1.f / (lr * lr + li * li);
    const float qr = (x * lr + y * li) * den, qi = (y * lr - x * li) * den;
    for (int c = 0; c < 16; ++c) {
      const float b_r = p.s5_b_re[i * 16 + c], b_i = p.s5_b_im[i * 16 + c];
      tab[4096 + i * 16 + c] = qr * b_r - qi * b_i;
      tab[4096 + 32768 + i * 16 + c] = qr * b_i + qi * b_r;
    }
  }
}

__device__ __forceinline__ void chunk_geom(int c, int& row0, int& L) { if (c < 256) { row0 = c * 64; L = 64; } else { row0 = 16384 + (c - 256) * 8; L = 8; } }

template <int MODE>
__device__ __forceinline__ void st_load(uint4 (&kr)[4], uint4 (&vr)[(MODE == 2) ? 2 : 1], float& dtr, const bf16_t* src, const float* dtbuf, int row0, int L, int ld, int kcol, int vcol, int h, int tid) {
  constexpr int PW = (MODE == 2) ? 64 : 32, NVC = PW / 32, VCR = PW / 8;
  const uint4 z4 = make_uint4(0, 0, 0, 0);
#pragma unroll
  for (int i = 0; i < 4; ++i) { const int id = tid + i * 256, s = id >> 4, c8 = id & 15; uint4 t_ = z4; if (s < L) t_ = *(const uint4*)(src + (size_t)(row0 + s) * ld + kcol + c8 * 8); kr[i] = t_; }
#pragma unroll
  for (int i = 0; i < NVC; ++i) { const int id = tid + i * 256, s = id / VCR, c8 = id % VCR; uint4 t_ = z4; if (s < L) t_ = *(const uint4*)(src + (size_t)(row0 + s) * ld + vcol + c8 * 8); vr[i] = t_; }
  if (MODE == 2 && tid < 64) dtr = tid < L ? dtbuf[(size_t)(row0 + tid) * 16 + h] : 0.f;
}

template <int MODE>
__device__ __forceinline__ void state_unit(const Params& p, int sq, int h, int ps, char* smem, int wvs) {
  constexpr int PW = (MODE == 2) ? 64 : 32, NT = PW / 16, PF = (MODE == 2) ? 64 : 128, HH = (MODE == 2) ? 16 : 4, NVC = PW / 32, VCR = PW / 8;
  bf16_t* KT = (bf16_t*)smem;
  bf16_t* VT = KT + 128 * 72;
  bf16_t* KR = VT + 64 * 72;
  float* tot = (float*)(KR + 64 * 136);
  float* dec = tot + 256;
  float* av = dec + 64;
  float* dtv = av + 64;
  int tid_ = TIDX(wvs) & 255; asm volatile("" : "+v"(tid_)); const int tid = tid_, lane = tid & 63, wave = tid >> 6;
  const bool prompt = sq < 8;
  const int nch = prompt ? 32 : 1, L = prompt ? 64 : 8;
  const int ld = (MODE == 2) ? 1536 : 4096;
  const bf16_t* src = (MODE == 2) ? (const bf16_t*)(p.ws + OFF_H) : (const bf16_t*)(p.ws + OFF_A);
  const int kcol = MODE == 0 ? 512 + h * 128 : MODE == 1 ? 2560 + h * 128 : 1024 + (h >> 3) * 128;
  const int vcol = MODE == 0 ? 1024 + h * 128 + ps * 32 : MODE == 1 ? 3072 + h * 128 + ps * 32 : h * 64;
  const float* sin_ = MODE == 0 ? p.state_ret : MODE == 1 ? p.state_hgrn : p.state_ssm;
  float* sout = p.out + (MODE == 0 ? O_RET : MODE == 1 ? O_HG : O_SSM) + (size_t)(sq * HH + h) * 128 * PF;
  bf16_t* stb = (bf16_t*)(p.ws + OFF_ST) + (MODE == 1 ? (size_t)256 * 4 * 128 * 128 : 0);
  const float* dtbuf = (const float*)(p.ws + OFF_DTBUF);
  const float l2g = MODE == 0 ? log2f(1.f - exp2f(-5.f - (float)h)) : 0.f;
  float Ah = 0.f, dtb = 0.f;
  if (MODE == 2) { Ah = -expf(p.a_log[h]); dtb = p.dt_bias[h]; }

  f32x4 acc[2][NT];
  const int nb = wave * 32 + (lane >> 4) * 4, pc = ps * PW + (lane & 15);
#pragma unroll
  for (int mt = 0; mt < 2; ++mt)
#pragma unroll
    for (int nt = 0; nt < NT; ++nt)
#pragma unroll
      for (int j = 0; j < 4; ++j)
        acc[mt][nt][j] = prompt ? 0.f : sin_[((size_t)((sq - 8) * HH + h) * 128 + nb + mt * 16 + j) * PF + pc + nt * 16];

  uint4 kr[4], vr[NVC]; float dtr = 0.f;
  const uint4 z4 = make_uint4(0, 0, 0, 0);
  st_load<MODE>(kr, vr, dtr, src, dtbuf, prompt ? sq * 2048 : 16384 + (sq - 8) * 8, L, ld, kcol, vcol, h, tid);
  for (int n = 0; n < nch; ++n) {
    if (prompt) {
      bf16_t* d = stb + ((size_t)((sq * 32 + n) * HH + h) * PF) * 128;
#pragma unroll
      for (int mt = 0; mt < 2; ++mt)
#pragma unroll
        for (int nt = 0; nt < NT; ++nt) store4bf(d + (size_t)(pc + nt * 16) * 128 + nb + mt * 16, acc[mt][nt][0], acc[mt][nt][1], acc[mt][nt][2], acc[mt][nt][3]);
    }
#pragma unroll
    for (int i = 0; i < 4; ++i) { const int id = tid + i * 256, s = id >> 4, c8 = id & 15; *(uint4*)(KR + s * 136 + c8 * 8) = kr[i]; }
#pragma unroll
    for (int i = 0; i < NVC; ++i) {
      const int id = tid + i * 256, s = id / VCR, c8 = id % VCR; const uint4 v = vr[i];
      bf16_t* d = VT + (c8 * 8) * 72 + s;
      d[0] = (bf16_t)(v.x & 0xffff); d[72] = (bf16_t)(v.x >> 16); d[144] = (bf16_t)(v.y & 0xffff); d[216] = (bf16_t)(v.y >> 16);
      d[288] = (bf16_t)(v.z & 0xffff); d[360] = (bf16_t)(v.z >> 16); d[432] = (bf16_t)(v.w & 0xffff); d[504] = (bf16_t)(v.w >> 16);
    }
    if (MODE == 2 && tid < 64) {
      float dt = 0.f;
      if (tid < L) { const float x = dtr + dtb; dt = x > 20.f ? x : log1pf(__expf(x)); }
      dtv[tid] = dt; av[tid] = dt * Ah;
    }
    if (n + 1 < nch) st_load<MODE>(kr, vr, dtr, src, dtbuf, sq * 2048 + (n + 1) * 64, L, ld, kcol, vcol, h, tid);
    __syncthreads();
    const int kn = tid & 127, half = tid >> 7;
    if (MODE == 1) {
      float s_ = 0.f;
      for (int s = half * 32; s < half * 32 + 32; ++s) s_ += bf2f(KR[s * 136 + kn]);
      tot[half * 128 + kn] = s_;
    }
    if (MODE == 2 && tid < 64) {
      float suf = 0.f;
      for (int r = tid + 1; r < 64; ++r) suf += av[r];
      dec[tid] = __expf(suf) * dtv[tid];
      if (tid == 0) tot[0] = suf + av[0];
    }
    if (MODE != 0) __syncthreads();
    {
      float suf = 0.f;
      if (MODE == 1) suf = half == 0 ? tot[128 + kn] : 0.f;
      for (int g = 3; g >= 0; --g) {
        const int s0 = half * 32 + g * 8;
        float v[8];
#pragma unroll
        for (int e = 7; e >= 0; --e) {
          const int s = s0 + e;
          const float raw = bf2f(KR[s * 136 + kn]);
          if (MODE == 0) v[e] = raw * exp2f((float)(L - 1 - s) * l2g);
          else if (MODE == 1) { v[e] = (1.f - __expf(raw)) * __expf(suf); suf += raw; }
          else v[e] = raw * dec[s];
        }
        uint4 o; o.x = pack2(v[0], v[1]); o.y = pack2(v[2], v[3]); o.z = pack2(v[4], v[5]); o.w = pack2(v[6], v[7]);
        *(uint4*)(KT + kn * 72 + s0) = o;
      }
    }
    __syncthreads();
#pragma unroll
    for (int mt = 0; mt < 2; ++mt) {
      float dk[4];
      if (MODE == 0) { const float d = exp2f((float)L * l2g); dk[0] = dk[1] = dk[2] = dk[3] = d; }
      else if (MODE == 2) { const float d = __expf(tot[0]); dk[0] = dk[1] = dk[2] = dk[3] = d; }
      else {
#pragma unroll
        for (int j = 0; j < 4; ++j) { const int nn = nb + mt * 16 + j; dk[j] = __expf(tot[nn] + tot[128 + nn]); }
      }
#pragma unroll
      for (int nt = 0; nt < NT; ++nt)
#pragma unroll
        for (int j = 0; j < 4; ++j) acc[mt][nt][j] *= dk[j];
    }
    wmma_ns<2, NT>(acc, KT + wave * 32 * 72, 72, VT, 72, 64, lane);
    __syncthreads();
  }
#pragma unroll
  for (int mt = 0; mt < 2; ++mt)
#pragma unroll
    for (int nt = 0; nt < NT; ++nt)
#pragma unroll
      for (int j = 0; j < 4; ++j) sout[(size_t)(nb + mt * 16 + j) * PF + pc + nt * 16] = acc[mt][nt][j];
}

template <int MODE>
__device__ __forceinline__ void out_unit(const Params& p, int c, int h, char* smem, int wvs) {
  constexpr int PF = (MODE == 2) ? 64 : 128, NTP = PF / 16, HH = (MODE == 2) ? 16 : 4, NVC = PF / 32, VCR = PF / 8;
  bf16_t* Q = (bf16_t*)smem;
  bf16_t* Kb = Q + 64 * 136;
  bf16_t* STb = Kb + 128 * 72;
  float* cumv = (float*)(STb + 128 * 136);
  float* dtv = cumv + 64;
  float* av = dtv + 64;
  float* tot = av + 64;
  int tid_ = TIDX(wvs) & 255; asm volatile("" : "+v"(tid_)); const int tid = tid_, lane = tid & 63, wave = tid >> 6;
  int row0, L; chunk_geom(c, row0, L);
  const int ld = (MODE == 2) ? 1536 : 4096;
  const bf16_t* src = (MODE == 2) ? (const bf16_t*)(p.ws + OFF_H) : (const bf16_t*)(p.ws + OFF_A);
  const int qcol = MODE == 0 ? h * 128 : MODE == 1 ? 2048 + h * 128 : 1280 + (h >> 3) * 128;
  const int kcol = MODE == 0 ? 512 + h * 128 : MODE == 1 ? 2560 + h * 128 : 1024 + (h >> 3) * 128;
  const int vcol = MODE == 0 ? 1024 + h * 128 : MODE == 1 ? 3072 + h * 128 : h * 64;
  const float l2g = MODE == 0 ? log2f(1.f - exp2f(-5.f - (float)h)) : 0.f;
  const uint4 z4 = make_uint4(0, 0, 0, 0);
#pragma unroll
  for (int i = 0; i < 4; ++i) {
    const int id = tid + i * 256, s = id >> 4, c8 = id & 15;
    uint4 q4 = z4, k4 = z4;
    if (s < L) { q4 = *(const uint4*)(src + (size_t)(row0 + s) * ld + qcol + c8 * 8); k4 = *(const uint4*)(src + (size_t)(row0 + s) * ld + kcol + c8 * 8); }
    *(uint4*)(Q + s * 136 + c8 * 8) = q4; *(uint4*)(Kb + s * 136 + c8 * 8) = k4;
  }
  uint4 vr[NVC];
#pragma unroll
  for (int i = 0; i < NVC; ++i) { const int id = tid + i * 256, s = id / VCR, c8 = id % VCR; uint4 t_ = z4; if (s < L) t_ = *(const uint4*)(src + (size_t)(row0 + s) * ld + vcol + c8 * 8); vr[i] = t_; }
  if (c < 256) {
    const bf16_t* stg = (const bf16_t*)(p.ws + OFF_ST) + (MODE == 1 ? (size_t)256 * 4 * 128 * 128 : 0) + ((size_t)(c * HH + h) * PF) * 128;
#pragma unroll
    for (int i = 0; i < PF / 16; ++i) { const int id = tid + i * 256, pr = id >> 4, c8 = id & 15; *(uint4*)(STb + pr * 136 + c8 * 8) = *(const uint4*)(stg + (size_t)pr * 128 + c8 * 8); }
  } else {
    const float* sg = (MODE == 0 ? p.state_ret : MODE == 1 ? p.state_hgrn : p.state_ssm) + (size_t)((c - 256) * HH + h) * 128 * PF;
    for (int id = tid; id < 128 * (PF / 4); id += 256) {
      const int n = id / (PF / 4), p4 = (id % (PF / 4)) * 4;
      const float4 v = *(const float4*)(sg + (size_t)n * PF + p4);
      STb[(p4 + 0) * 136 + n] = f2bf(v.x); STb[(p4 + 1) * 136 + n] = f2bf(v.y); STb[(p4 + 2) * 136 + n] = f2bf(v.z); STb[(p4 + 3) * 136 + n] = f2bf(v.w);
    }
  }
  if (MODE == 2 && tid < 64) {
    float dt = 0.f;
    if (tid < L) { const float x = ((const float*)(p.ws + OFF_DTBUF))[(size_t)(row0 + tid) * 16 + h] + p.dt_bias[h]; dt = x > 20.f ? x : log1pf(__expf(x)); }
    dtv[tid] = dt; av[tid] = -expf(p.a_log[h]) * dt;
  }
  __syncthreads();
  if (MODE == 1) {
    const int kn = tid & 127, half = tid >> 7;
    float s_ = 0.f;
    for (int s = half * 32; s < half * 32 + 32; ++s) s_ += bf2f(Kb[s * 136 + kn]);
    tot[half * 128 + kn] = s_;
    __syncthreads();
    float cum = half == 1 ? tot[kn] : 0.f;
    for (int s = half * 32; s < half * 32 + 32; ++s) {
      const float lf = bf2f(Kb[s * 136 + kn]);
      cum += lf;
      Q[s * 136 + kn] = f2bf(bf2f(Q[s * 136 + kn]) * __expf(cum));
      Kb[s * 136 + kn] = f2bf((1.f - __expf(lf)) * __expf(-cum));
    }
    __syncthreads();
  }
  if (MODE == 2) {
    if (tid < 64) { float cs = 0.f; for (int r = 0; r <= tid; ++r) cs += av[r]; cumv[tid] = cs; }
    __syncthreads();
  }
  f32x4 ai[1][NTP], asc[1][4];
#pragma unroll
  for (int j = 0; j < NTP; ++j) ai[0][j] = (f32x4){0.f, 0.f, 0.f, 0.f};
#pragma unroll
  for (int j = 0; j < 4; ++j) asc[0][j] = (f32x4){0.f, 0.f, 0.f, 0.f};
  wmma_sw<1, NTP>(ai, Q + wave * 16 * 136, 136, STb, 136, 128, lane);
  wmma_sw<1, 4>(asc, Q + wave * 16 * 136, 136, Kb, 136, 128, lane);
  const int t = wave * 16 + (lane & 15), sq4 = (lane >> 4) * 4;
  float ct = 0.f;
  if (MODE == 2) ct = cumv[t];
#pragma unroll
  for (int nt = 0; nt < 4; ++nt)
#pragma unroll
    for (int j = 0; j < 4; ++j) {
      const int s = nt * 16 + sq4 + j;
      float v = asc[0][nt][j];
      if (s > t) v = 0.f;
      else if (MODE == 0) v *= exp2f((float)(t - s) * l2g);
      else if (MODE == 2) v *= __expf(ct - cumv[s]) * dtv[s];
      asc[0][nt][j] = v;
    }
  __syncthreads();
  bf16_t* Pb = STb; bf16_t* VT = Kb;
#pragma unroll
  for (int nt = 0; nt < 4; ++nt) store4bf(Pb + t * 72 + nt * 16 + sq4, asc[0][nt][0], asc[0][nt][1], asc[0][nt][2], asc[0][nt][3]);
#pragma unroll
  for (int i = 0; i < NVC; ++i) {
    const int id = tid + i * 256, s = id / VCR, c8 = id % VCR; const uint4 v = vr[i];
    bf16_t* d = VT + (c8 * 8) * 72 + s;
    d[0] = (bf16_t)(v.x & 0xffff); d[72] = (bf16_t)(v.x >> 16); d[144] = (bf16_t)(v.y & 0xffff); d[216] = (bf16_t)(v.y >> 16);
    d[288] = (bf16_t)(v.z & 0xffff); d[360] = (bf16_t)(v.z >> 16); d[432] = (bf16_t)(v.w & 0xffff); d[504] = (bf16_t)(v.w >> 16);
  }
  __syncthreads();
  f32x4 ao[1][NTP];
#pragma unroll
  for (int j = 0; j < NTP; ++j) ao[0][j] = (f32x4){0.f, 0.f, 0.f, 0.f};
  wmma_sw<1, NTP>(ao, Pb + wave * 16 * 72, 72, VT, 72, 64, lane);
  float fi = 1.f;
  if (MODE == 0) fi = exp2f((float)(t + 1) * l2g);
  if (MODE == 2) fi = __expf(ct);
  const int row = row0 + t;
  const bool valid = t < L;
  if (MODE == 0 || MODE == 1) {
    float s1 = 0.f, s2 = 0.f;
#pragma unroll
    for (int nt = 0; nt < NTP; ++nt)
#pragma unroll
      for (int j = 0; j < 4; ++j) { const float o = ao[0][nt][j] + fi * ai[0][nt][j]; ao[0][nt][j] = o; s1 += o; s2 += o * o; }
    s1 += shx(s1, 16); s1 += shx(s1, 32); s2 += shx(s2, 16); s2 += shx(s2, 32);
    float mu = 0.f, rs;
    if (MODE == 0) { mu = s1 * (1.f / 128.f); const float var = fmaxf(s2 * (1.f / 128.f) - mu * mu, 0.f); rs = rsqrtf(var + EPSV); }
    else rs = rsqrtf(s2 * (1.f / 128.f) + EPSV);
    if (valid) {
      const float* nw = (MODE == 0 ? p.ret_norm_w : p.hgrn_norm_w) + h * 128;
      const int gcol = (MODE == 0 ? 1536 : 3584) + h * 128;
      bf16_t* mix = (bf16_t*)(p.ws + OFF_H) + (size_t)row * 1024 + (MODE == 0 ? 0 : 512) + h * 128;
#pragma unroll
      for (int nt = 0; nt < NTP; ++nt) {
        const int pp = nt * 16 + sq4;
        const float4 w4 = *(const float4*)(nw + pp);
        const uint2 g2 = *(const uint2*)(src + (size_t)row * ld + gcol + pp);
        store4bf(mix + pp, (ao[0][nt][0] - mu) * rs * w4.x * siluf(lo2f(g2.x)), (ao[0][nt][1] - mu) * rs * w4.y * siluf(hi2f(g2.x)),
                 (ao[0][nt][2] - mu) * rs * w4.z * siluf(lo2f(g2.y)), (ao[0][nt][3] - mu) * rs * w4.w * siluf(hi2f(g2.y)));
      }
    }
  } else {
    const float Dh = p.d_ssm[h];
    bf16_t* zy = (bf16_t*)(p.ws + OFF_A) + (size_t)row * 3200 + h * 64;
    float s2 = 0.f;
    if (valid) {
#pragma unroll
      for (int nt = 0; nt < NTP; ++nt) {
        const int pp = nt * 16 + sq4;
        const uint2 x2 = *(const uint2*)(src + (size_t)row * ld + vcol + pp);
        const uint2 z2 = *(const uint2*)(zy + pp);
        const float y0 = (ao[0][nt][0] + fi * ai[0][nt][0] + Dh * lo2f(x2.x)) * siluf(lo2f(z2.x));
        const float y1 = (ao[0][nt][1] + fi * ai[0][nt][1] + Dh * hi2f(x2.x)) * siluf(hi2f(z2.x));
        const float y2 = (ao[0][nt][2] + fi * ai[0][nt][2] + Dh * lo2f(x2.y)) * siluf(lo2f(z2.y));
        const float y3 = (ao[0][nt][3] + fi * ai[0][nt][3] + Dh * hi2f(x2.y)) * siluf(hi2f(z2.y));
        s2 += y0 * y0 + y1 * y1 + y2 * y2 + y3 * y3;
        store4bf(zy + pp, y0, y1, y2, y3);
      }
    }
    s2 += shx(s2, 16); s2 += shx(s2, 32);
    if (valid && lane < 16) atomicAdd((float*)(p.ws + OFF_SSDST) + (size_t)row * 2 + (h >> 3), s2);
  }
  __syncthreads();
}

template <int OUT>
__device__ __forceinline__ void s5_unit(const Params& p, int c, int gq, char* smem, int wvs) {
  float* Uf = (float*)smem;
  bf16_t* HSall = (bf16_t*)(smem + 16384);
  bf16_t* CMall = (bf16_t*)(smem + 16384 + 34816);
  int tid_ = TIDX(wvs) & 255; asm volatile("" : "+v"(tid_)); const int tid = tid_, lane = tid & 63, wave = tid >> 6;
  int row0, L; chunk_geom(c, row0, L);
  const bf16_t* proj = (const bf16_t*)(p.ws + OFF_A);
#pragma unroll
  for (int i = 0; i < 2; ++i) {
    const int id = tid + i * 256, s = id >> 3, c8 = id & 7;
    uint4 v = make_uint4(0, 0, 0, 0);
    if (s < L) v = *(const uint4*)(proj + (size_t)(row0 + s) * 3200 + 2576 + gq * 64 + c8 * 8);
    float* d = Uf + s * 64 + c8 * 8;
    d[0] = lo2f(v.x); d[1] = hi2f(v.x); d[2] = lo2f(v.y); d[3] = hi2f(v.y); d[4] = lo2f(v.z); d[5] = hi2f(v.z); d[6] = lo2f(v.w); d[7] = hi2f(v.w);
  }
  const int g = gq * 4 + wave, gp = g * 64 + lane;
  const float* tab = (const float*)(p.ws + OFF_S5TAB);
  const float lr = tab[gp], li = tab[2048 + gp];
  float bbr[16], bbi[16];
#pragma unroll
  for (int q = 0; q < 4; ++q) {
    const float4 a = *(const float4*)(tab + 4096 + gp * 16 + q * 4), b = *(const float4*)(tab + 4096 + 32768 + gp * 16 + q * 4);
    bbr[q * 4] = a.x; bbr[q * 4 + 1] = a.y; bbr[q * 4 + 2] = a.z; bbr[q * 4 + 3] = a.w;
    bbi[q * 4] = b.x; bbi[q * 4 + 1] = b.y; bbi[q * 4 + 2] = b.z; bbi[q * 4 + 3] = b.w;
  }
  float hr = 0.f, hi = 0.f;
  bf16_t* HS = HSall + wave * 32 * 136; bf16_t* CM = CMall + wave * 16 * 136;
  if (OUT) {
    const float2 h0 = *(const float2*)((const float*)(p.ws + OFF_S5H) + ((size_t)c * 2048 + gp) * 2);
    hr = h0.x; hi = h0.y;
#pragma unroll
    for (int ch = 0; ch < 16; ++ch) { CM[ch * 136 + lane] = f2bf(p.s5_c_re[(g * 16 + ch) * 64 + lane]); CM[ch * 136 + 64 + lane] = f2bf(-p.s5_c_im[(g * 16 + ch) * 64 + lane]); }
  }
  __syncthreads();
  const int nhalf = OUT ? ((L + 31) >> 5) : 1, tl = OUT ? 32 : 64;
  for (int hf = 0; hf < nhalf; ++hf) {
    for (int tt = 0; tt < tl; ++tt) {
      const int t = hf * 32 + tt;
      if (t < L) {
        const float* up = Uf + t * 64 + wave * 16;
        float bur = 0.f, bui = 0.f;
#pragma unroll
        for (int q = 0; q < 4; ++q) {
          const float4 u4 = *(const float4*)(up + q * 4);
          bur += bbr[q * 4] * u4.x + bbr[q * 4 + 1] * u4.y + bbr[q * 4 + 2] * u4.z + bbr[q * 4 + 3] * u4.w;
          bui += bbi[q * 4] * u4.x + bbi[q * 4 + 1] * u4.y + bbi[q * 4 + 2] * u4.z + bbi[q * 4 + 3] * u4.w;
        }
        const float nr = lr * hr - li * hi + bur, ni = lr * hi + li * hr + bui;
        hr = nr; hi = ni;
      }
      if (OUT) { HS[tt * 136 + lane] = f2bf(t < L ? hr : 0.f); HS[tt * 136 + 64 + lane] = f2bf(t < L ? hi : 0.f); }
    }
    if (OUT) {
      __syncthreads();
      f32x4 ay[2][1];
      ay[0][0] = (f32x4){0.f, 0.f, 0.f, 0.f}; ay[1][0] = (f32x4){0.f, 0.f, 0.f, 0.f};
      wmma_sw<2, 1>(ay, HS, 136, CM, 136, 128, lane);
      bf16_t* gbuf = (bf16_t*)(p.ws + OFF_GBUF);
#pragma unroll
      for (int mt = 0; mt < 2; ++mt) {
        const int t = hf * 32 + mt * 16 + (lane & 15), ch0 = (lane >> 4) * 4;
        if (t < L) {
          const float4 u4 = *(const float4*)(Uf + t * 64 + wave * 16 + ch0);
          const float4 d4 = *(const float4*)(p.s5_d + g * 16 + ch0);
          float y[4] = {ay[mt][0][0] + d4.x * u4.x, ay[mt][0][1] + d4.y * u4.y, ay[mt][0][2] + d4.z * u4.z, ay[mt][0][3] + d4.w * u4.w};
#pragma unroll
          for (int j = 0; j < 4; ++j) { const float x = y[j], uu = 0.7978845608028654f * (x + 0.044715f * x * x * x); y[j] = x / (1.f + __expf(-2.f * uu)); }
          store4bf(gbuf + (size_t)(row0 + t) * 512 + g * 16 + ch0, y[0], y[1], y[2], y[3]);
        }
      }
      __syncthreads();
    }
  }
  if (!OUT) { *(float2*)((float*)(p.ws + OFF_S5E) + ((size_t)c * 2048 + gp) * 2) = make_float2(hr, hi); }
  __syncthreads();
}

__device__ __forceinline__ void s5_prefix(const Params& p, int gt) {
  const int sq = gt >> 11, rem = gt & 2047;
  const float* tab = (const float*)(p.ws + OFF_S5TAB);
  const float* e = (const float*)(p.ws + OFF_S5E);
  float* hs = (float*)(p.ws + OFF_S5H);
  float hr = 0.f, hi = 0.f;
  if (sq < 8) {
    const float lr = tab[69632 + rem], li = tab[71680 + rem];
    for (int n = 0; n < 32; ++n) {
      const size_t idx = ((size_t)(sq * 32 + n) * 2048 + rem) * 2;
      *(float2*)(hs + idx) = make_float2(hr, hi);
      const float2 ev = *(const float2*)(e + idx);
      const float nr = lr * hr - li * hi + ev.x, ni = lr * hi + li * hr + ev.y; hr = nr; hi = ni;
    }
  } else {
    const float lr = tab[73728 + rem], li = tab[75776 + rem];
    hr = p.state_s5_re[(size_t)(sq - 8) * 2048 + rem]; hi = p.state_s5_im[(size_t)(sq - 8) * 2048 + rem];
    const size_t idx = ((size_t)(256 + sq - 8) * 2048 + rem) * 2;
    *(float2*)(hs + idx) = make_float2(hr, hi);
    const float2 ev = *(const float2*)(e + idx);
    const float nr = lr * hr - li * hi + ev.x, ni = lr * hi + li * hr + ev.y; hr = nr; hi = ni;
  }
  p.out[O_S5RE + (size_t)sq * 2048 + rem] = hr;
  p.out[O_S5IM + (size_t)sq * 2048 + rem] = hi;
}

__device__ __forceinline__ void conv_phase(const Params& p, int wvs) {
  const bf16_t* proj = (const bf16_t*)(p.ws + OFF_A);
  bf16_t* xc = (bf16_t*)(p.ws + OFF_H);
  int tq_ = TIDX(wvs); asm volatile("" : "+v"(tq_)); const int gt = blockIdx.x * NTHR + tq_, nt = gridDim.x * NTHR;
  for (int it = gt; it < ROWS * 192; it += nt) {
    const int row = it / 192, c = (it % 192) * 8;
    int t, T, sq;
    if (row < 16384) { t = row & 2047; T = 2048; sq = row >> 11; } else { t = (row - 16384) & 7; T = 8; sq = 8 + ((row - 16384) >> 3); }
    float a[8];
    { const float4 b0 = *(const float4*)(p.conv_b + c), b1 = *(const float4*)(p.conv_b + c + 4); a[0] = b0.x; a[1] = b0.y; a[2] = b0.z; a[3] = b0.w; a[4] = b1.x; a[5] = b1.y; a[6] = b1.z; a[7] = b1.w; }
    float cur[8];
#pragma unroll
    for (int j = 0; j < 4; ++j) {
      const int tt = t - 3 + j;
      float x[8];
      if (tt >= 0) {
        const uint4 v = *(const uint4*)(proj + (size_t)(row - 3 + j) * 3200 + 1024 + c);
        x[0] = lo2f(v.x); x[1] = hi2f(v.x); x[2] = lo2f(v.y); x[3] = hi2f(v.y); x[4] = lo2f(v.z); x[5] = hi2f(v.z); x[6] = lo2f(v.w); x[7] = hi2f(v.w);
      } else if (sq >= 8) {
        const float* sc = p.state_conv + ((size_t)(sq - 8) * 3 + (3 + tt)) * 1536 + c;
        const float4 v0 = *(const float4*)sc, v1 = *(const float4*)(sc + 4);
        x[0] = v0.x; x[1] = v0.y; x[2] = v0.z; x[3] = v0.w; x[4] = v1.x; x[5] = v1.y; x[6] = v1.z; x[7] = v1.w;
      } else {
#pragma unroll
        for (int e = 0; e < 8; ++e) x[e] = 0.f;
      }
      const float4 w0 = *(const float4*)(p.conv_w + j * 1536 + c), w1 = *(const float4*)(p.conv_w + j * 1536 + c + 4);
      a[0] += w0.x * x[0]; a[1] += w0.y * x[1]; a[2] += w0.z * x[2]; a[3] += w0.w * x[3]; a[4] += w1.x * x[4]; a[5] += w1.y * x[5]; a[6] += w1.z * x[6]; a[7] += w1.w * x[7];
      if (j == 3) {
#pragma unroll
        for (int e = 0; e < 8; ++e) cur[e] = x[e];
      }
    }
    uint4 o; o.x = pack2(siluf(a[0]), siluf(a[1])); o.y = pack2(siluf(a[2]), siluf(a[3])); o.z = pack2(siluf(a[4]), siluf(a[5])); o.w = pack2(siluf(a[6]), siluf(a[7]));
    *(uint4*)(xc + (size_t)row * 1536 + c) = o;
    if (t >= T - 3) {
      float* d = p.out + O_CONV + ((size_t)sq * 3 + (t - (T - 3))) * 1536 + c;
      *(float4*)d = make_float4(cur[0], cur[1], cur[2], cur[3]); *(float4*)(d + 4) = make_float4(cur[4], cur[5], cur[6], cur[7]);
    }
  }
}

__device__ __forceinline__ void ssdnorm_phase(const Params& p, int wvs) {
  const bf16_t* proj = (const bf16_t*)(p.ws + OFF_A);
  bf16_t* mix = (bf16_t*)(p.ws + OFF_H);
  const float* st = (const float*)(p.ws + OFF_SSDST);
  int tq_ = TIDX(wvs); asm volatile("" : "+v"(tq_)); const int gt = blockIdx.x * NTHR + tq_, nt = gridDim.x * NTHR;
  for (int it = gt; it < ROWS * 128; it += nt) {
    const int row = it >> 7, c = (it & 127) * 8;
    const float r = rsqrtf(st[(size_t)row * 2 + (c >> 9)] * (1.f / 512.f) + EPSV);
    const uint4 v = *(const uint4*)(proj + (size_t)row * 3200 + c);
    const float4 w0 = *(const float4*)(p.ssm_norm_w + c), w1 = *(const float4*)(p.ssm_norm_w + c + 4);
    uint4 o; o.x = pack2(lo2f(v.x) * r * w0.x, hi2f(v.x) * r * w0.y); o.y = pack2(lo2f(v.y) * r * w0.z, hi2f(v.y) * r * w0.w);
    o.z = pack2(lo2f(v.z) * r * w1.x, hi2f(v.z) * r * w1.y); o.w = pack2(lo2f(v.w) * r * w1.z, hi2f(v.w) * r * w1.w);
    *(uint4*)(mix + (size_t)row * 1536 + c) = o;
  }
}


#define XB_TMO      128
#define XB_XCNT(j)  (256  + 64 * (j))
#define XB_XSUB(j)  (1280 + 64 * (j))
#define XB_XGEN(j)  (2304 + 64 * (j))
#define XB_TOP      3328
#define XB_TOPGEN   3392
#define XCD_BAR_WORDS 3456
#define XB_SPIN_CAP (1u << 18)
#define LAS __attribute__((address_space(3)))
__device__ __forceinline__ unsigned xb_ld(unsigned* p)              { return __hip_atomic_load(p, __ATOMIC_RELAXED, __HIP_MEMORY_SCOPE_AGENT); }
__device__ __forceinline__ unsigned xb_add(unsigned* p, unsigned v) { return __hip_atomic_fetch_add(p, v, __ATOMIC_RELAXED, __HIP_MEMORY_SCOPE_AGENT); }
__device__ __forceinline__ unsigned xb_xcc_id() { return (unsigned)__builtin_amdgcn_s_getreg((3 << 11) | 20) & 0xFu; }
#define XB_SPIN(cond, bar) do { unsigned _sp = 0; while (cond) { __builtin_amdgcn_s_sleep(1); \
    if ((++_sp & 255u) == 0u) { if (xb_ld(&(bar)[XB_TMO])) break; if (_sp > XB_SPIN_CAP) { atomicAdd(&(bar)[XB_TMO], 1u); break; } } } } while (0)
struct XcdBarrier { unsigned* bar; unsigned x; volatile LAS unsigned* st; };
__device__ __forceinline__ XcdBarrier xcd_barrier_post(unsigned* bar, volatile LAS unsigned* st, int wvs) {
    XcdBarrier b; b.bar = bar; b.x = xb_xcc_id(); b.st = st;
    if (TIDX(wvs) == 0) (void)xb_add(&bar[XB_XCNT(b.x)], 1u);
    return b;
}
__device__ __forceinline__ void xcd_barrier_complete(unsigned* bar, unsigned x, unsigned& nloc, unsigned& nx) {
    const unsigned G = gridDim.x * gridDim.y * gridDim.z;
    unsigned sum, cnt, mine, sp = 0u;
    for (;;) {
        sum = 0u; cnt = 0u; mine = 0u;
#pragma unroll
        for (unsigned j = 0; j < 16; ++j) { const unsigned c = xb_ld(&bar[XB_XCNT(j)]); sum += c; cnt += (c > 0u) ? 1u : 0u; mine = (j == x) ? c : mine; }
        if (sum == G) break;
        __builtin_amdgcn_s_sleep(1);
        if ((++sp & 255u) == 0u) { if (xb_ld(&bar[XB_TMO])) break; if (sp > XB_SPIN_CAP) { atomicAdd(&bar[XB_TMO], 1u); break; } }
    }
    nloc = mine > 0u ? mine : 1u; nx = cnt > 0u ? cnt : 1u;
}
__device__ __forceinline__ void xcd_barrier(const XcdBarrier& b, int wvs) {
    asm volatile("s_waitcnt vmcnt(0)" ::: "memory");
    __syncthreads();
    if (TIDX(wvs) == 0) {
        unsigned* bar = b.bar;
        __builtin_amdgcn_s_waitcnt(0);
        unsigned nloc = b.st[0], nx = b.st[1];
        if (nloc == 0u) { xcd_barrier_complete(bar, b.x, nloc, nx); b.st[0] = nloc; b.st[1] = nx; }
        const unsigned old = xb_add(&bar[XB_XSUB(b.x)], 1u);
        const unsigned gen = old / nloc;
        if (old + 1u == (gen + 1u) * nloc) {
            __builtin_amdgcn_fence(__ATOMIC_RELEASE, "agent");
            asm volatile("s_waitcnt vmcnt(0)" ::: "memory");
            const unsigned og = xb_add(&bar[XB_TOP], 1u);
            const unsigned tg = og / nx;
            if (og + 1u == (tg + 1u) * nx) xb_add(&bar[XB_TOPGEN], 1u);
            else XB_SPIN(xb_ld(&bar[XB_TOPGEN]) == tg, bar);
            __builtin_amdgcn_fence(__ATOMIC_ACQUIRE, "agent");
            xb_add(&bar[XB_XGEN(b.x)], 1u);
            asm volatile("s_waitcnt vmcnt(0)" ::: "memory");
        } else {
            XB_SPIN(xb_ld(&bar[XB_XGEN(b.x)]) == gen, bar);
            __builtin_amdgcn_fence(__ATOMIC_ACQUIRE, "agent");
            asm volatile("s_waitcnt vmcnt(0)" ::: "memory");
        }
    }
    __syncthreads();
}


__device__ __forceinline__ Params ldp() {
  auto kp = __builtin_amdgcn_kernarg_segment_ptr();
  asm volatile("" : "+s"(kp));
  Params q;
  __builtin_memcpy(&q, (const void*)kp, sizeof(Params));
  return q;
}

__global__ void __launch_bounds__(NTHR, 2) fwd_megakernel(Params p_) {
  extern __shared__ __attribute__((aligned(16))) char smem[];
  cg::grid_group grid = cg::this_grid();
  if (p_.ws == nullptr) grid.sync();
  volatile LAS unsigned* xst = (volatile LAS unsigned*)(smem + 2 * HALF_LDS);
  const int wvs = __builtin_amdgcn_readfirstlane(threadIdx.x >> 6);
  if (TIDX(wvs) == 0) { xst[0] = 0u; xst[1] = 0u; xst[2] = 0u; xst[3] = 0u; }
  __syncthreads();
  const XcdBarrier xb = xcd_barrier_post((unsigned*)(p_.ws + OFF_BAR), xst, wvs);
  const int half = wvs >> 2;
  const int G = gridDim.x * 2, bid = blockIdx.x * 2 + half;
  char* hs = smem + half * HALF_LDS;
#define PH_BEGIN const Params p = ldp(); bf16_t* bufA = (bf16_t*)(p.ws + OFF_A); bf16_t* bufH = (bf16_t*)(p.ws + OFF_H); bf16_t* t0 = (bf16_t*)(p.ws + OFF_ST); \
    float* rowss = (float*)(p.ws + OFF_ROWSS); float* hbuf = p.out; (void)bufA; (void)bufH; (void)t0; (void)rowss; (void)hbuf;

  {
  PH_BEGIN
  prep_tables(p, wvs);
  wconv(p.w_in_even, 1024, 4096, 4096, (bf16_t*)(p.ws + W_IN), hs, wvs);
  wconv(p.w_out_even, 1024, 1024, 1024, (bf16_t*)(p.ws + W_OUT0), hs, wvs);
  wconv(p.w_ffn_up, 1024, 4096, 4096, (bf16_t*)(p.ws + W_UP), hs, wvs);
  wconv(p.w_ffn_down, 4096, 1024, 1024, (bf16_t*)(p.ws + W_DOWN), hs, wvs);
  rowpass_phase(nullptr, nullptr, nullptr, p.x_prompt, p.x_sample, nullptr, p.norm_mix_pre, bufH, wvs);
  }
  xcd_barrier(xb, wvs);
  {
  PH_BEGIN
  { EpiInEven e{bufA, (const float*)(p.ws + OFF_ROPE), (const float*)(p.ws + OFF_LB)};
    for (int rep_ = 0; rep_ < REPG; ++rep_) { gemm_phase(bufH, 1024, (const bf16_t*)(p.ws + W_IN), 1024, 64, 16, 1024, e, smem, wvs); gemm_tail(bufH, 1024, (const bf16_t*)(p.ws + W_IN), 1024, 32, 1024, e, smem, wvs, 64 * 16); } }
  }
  xcd_barrier(xb, wvs);
  {
  PH_BEGIN
  for (int u = bid; u < 256 + 4096; u += G) {
    const int v = u < 256 ? u : u - 256;
    const int ps = v & 3, m = (v >> 2) & 1, h = (v >> 3) & 3, sq = (u < 256 ? 0 : 8) + (v >> 5);
    if (m == 0) state_unit<0>(p, sq, h, ps, hs, wvs); else state_unit<1>(p, sq, h, ps, hs, wvs);
  }
  }
  xcd_barrier(xb, wvs);
  {
  PH_BEGIN
  for (int u = bid; u < 384 * 8; u += G) {
    const int h = u & 3, m = (u >> 2) & 1, c = u >> 3;
    if (m == 0) out_unit<0>(p, c, h, hs, wvs); else out_unit<1>(p, c, h, hs, wvs);
  }
  }
  xcd_barrier(xb, wvs);
  {
  PH_BEGIN
  { EpiOut e{t0, rowss};
    for (int rep_ = 0; rep_ < REPG; ++rep_) { gemm_phase(bufH, 1024, (const bf16_t*)(p.ws + W_OUT0), 1024, 64, 4, 1024, e, smem, wvs); gemm_tail(bufH, 1024, (const bf16_t*)(p.ws + W_OUT0), 1024, 8, 1024, e, smem, wvs, 64 * 4); } }
  }
  xcd_barrier(xb, wvs);
  {
  PH_BEGIN
  rowpass_phase(t0, rowss, p.norm_mix_post, p.x_prompt, p.x_sample, hbuf, p.norm_ffn_pre, bufH, wvs);
  }
  xcd_barrier(xb, wvs);
  {
  PH_BEGIN
  { EpiUp e{bufA}; for (int rep_ = 0; rep_ < REPG; ++rep_) { gemm_phase(bufH, 1024, (const bf16_t*)(p.ws + W_UP), 1024, 64, 16, 1024, e, smem, wvs); gemm_tail(bufH, 1024, (const bf16_t*)(p.ws + W_UP), 1024, 32, 1024, e, smem, wvs, 64 * 16); } }
  }
  xcd_barrier(xb, wvs);
  {
  PH_BEGIN
  { EpiOut e{t0, rowss + ROWS}; for (int rep_ = 0; rep_ < REPG; ++rep_) { gemm_phase(bufA, 4096, (const bf16_t*)(p.ws + W_DOWN), 4096, 64, 4, 4096, e, smem, wvs); gemm_tail(bufA, 4096, (const bf16_t*)(p.ws + W_DOWN), 4096, 8, 4096, e, smem, wvs, 64 * 4); } }
  }
  xcd_barrier(xb, wvs);
  {
  PH_BEGIN
  rowpass_phase(t0, rowss + ROWS, p.norm_ffn_post, hbuf, hbuf + (size_t)16384 * 1024, hbuf, p.norm_mix_pre + 1024, bufH, wvs);
  wconv(p.w_in_odd, 1024, 3088, 3328, (bf16_t*)(p.ws + W_IN), hs, wvs);
  wconv(p.w_glu, 512, 512, 512, (bf16_t*)(p.ws + W_GLU), hs, wvs);
  wconv(p.w_out_odd, 1536, 1024, 1024, (bf16_t*)(p.ws + W_OUT1), hs, wvs);
  wconv(p.w_ffn_up + (size_t)1024 * 4096, 1024, 4096, 4096, (bf16_t*)(p.ws + W_UP), hs, wvs);
  wconv(p.w_ffn_down + (size_t)4096 * 1024, 4096, 1024, 1024, (bf16_t*)(p.ws + W_DOWN), hs, wvs);
  }
  xcd_barrier(xb, wvs);
  {
  PH_BEGIN
  { EpiInOdd e{bufA, (float*)(p.ws + OFF_DTBUF)};
    for (int rep_ = 0; rep_ < REPG; ++rep_) { gemm_phase(bufH, 1024, (const bf16_t*)(p.ws + W_IN), 1024, 64, 13, 1024, e, smem, wvs); gemm_tail(bufH, 1024, (const bf16_t*)(p.ws + W_IN), 1024, 26, 1024, e, smem, wvs, 64 * 13); } }
  }
  xcd_barrier(xb, wvs);
  {
  PH_BEGIN
  conv_phase(p, wvs);
  for (int u = bid; u < 384 * 8; u += G) s5_unit<0>(p, u >> 3, u & 7, hs, wvs);
  }
  xcd_barrier(xb, wvs);
  {
  PH_BEGIN
  for (int u = bid; u < 128 + 1088 + 2048; u += G) {
    if (u < 128) state_unit<2>(p, u >> 4, u & 15, 0, hs, wvs);
    else if (u < 128 + 1088) { int tq_ = TIDX(wvs) & 255; asm volatile("" : "+v"(tq_)); s5_prefix(p, (u - 128) * 256 + tq_); }
    else { const int v = u - 128 - 1088; state_unit<2>(p, 8 + (v >> 4), v & 15, 0, hs, wvs); }
  }
  }
  xcd_barrier(xb, wvs);
  {
  PH_BEGIN
  for (int u = bid; u < 384 * 16 + 384 * 8; u += G) {
    if (u < 384 * 16) out_unit<2>(p, u >> 4, u & 15, hs, wvs);
    else { const int v = u - 384 * 16; s5_unit<1>(p, v >> 3, v & 7, hs, wvs); }
  }
  }
  xcd_barrier(xb, wvs);
  {
  PH_BEGIN
  ssdnorm_phase(p, wvs);
  { EpiGlu e{(const bf16_t*)(p.ws + OFF_GBUF), p.b_glu, bufH};
    for (int rep_ = 0; rep_ < REPG; ++rep_) { gemm_phase((const bf16_t*)(p.ws + OFF_GBUF), 512, (const bf16_t*)(p.ws + W_GLU), 512, 64, 2, 512, e, smem, wvs); gemm_tail((const bf16_t*)(p.ws + OFF_GBUF), 512, (const bf16_t*)(p.ws + W_GLU), 512, 4, 512, e, smem, wvs, 64 * 2); } }
  }
  xcd_barrier(xb, wvs);
  {
  PH_BEGIN
  { EpiOut e{t0, rowss + 2 * ROWS}; for (int rep_ = 0; rep_ < REPG; ++rep_) { gemm_phase(bufH, 1536, (const bf16_t*)(p.ws + W_OUT1), 1536, 64, 4, 1536, e, smem, wvs); gemm_tail(bufH, 1536, (const bf16_t*)(p.ws + W_OUT1), 1536, 8, 1536, e, smem, wvs, 64 * 4); } }
  }
  xcd_barrier(xb, wvs);
  {
  PH_BEGIN
  rowpass_phase(t0, rowss + 2 * ROWS, p.norm_mix_post + 1024, hbuf, hbuf + (size_t)16384 * 1024, hbuf, p.norm_ffn_pre + 1024, bufH, wvs);
  }
  xcd_barrier(xb, wvs);
  {
  PH_BEGIN
  { EpiUp e{bufA}; for (int rep_ = 0; rep_ < REPG; ++rep_) { gemm_phase(bufH, 1024, (const bf16_t*)(p.ws + W_UP), 1024, 64, 16, 1024, e, smem, wvs); gemm_tail(bufH, 1024, (const bf16_t*)(p.ws + W_UP), 1024, 32, 1024, e, smem, wvs, 64 * 16); } }
  }
  xcd_barrier(xb, wvs);
  {
  PH_BEGIN
  { EpiOut e{t0, rowss + 3 * ROWS}; for (int rep_ = 0; rep_ < REPG; ++rep_) { gemm_phase(bufA, 4096, (const bf16_t*)(p.ws + W_DOWN), 4096, 64, 4, 4096, e, smem, wvs); gemm_tail(bufA, 4096, (const bf16_t*)(p.ws + W_DOWN), 4096, 8, 4096, e, smem, wvs, 64 * 4); } }
  }
  xcd_barrier(xb, wvs);
  {
  PH_BEGIN
  rowpass_phase(t0, rowss + 3 * ROWS, p.norm_ffn_post + 1024, hbuf, hbuf + (size_t)16384 * 1024, hbuf, nullptr, nullptr, wvs);
  }
}

extern "C" void kernel_launch(void* const* d_in, const int* in_sizes, int n_in, void* d_out, int out_size, void* d_ws, size_t ws_size, hipStream_t stream) {
  constexpr size_t kDynLds = 2 * HALF_LDS + 64;
  static int grid_blocks = 0;
  if (!grid_blocks) {
    int dev = 0, cus = 0, per_cu = 0;
    (void)hipGetDevice(&dev);
    (void)hipDeviceGetAttribute(&cus, hipDeviceAttributeMultiprocessorCount, dev);
    (void)hipFuncSetAttribute((const void*)fwd_megakernel, hipFuncAttributeMaxDynamicSharedMemorySize, (int)kDynLds);
    (void)hipOccupancyMaxActiveBlocksPerMultiprocessor(&per_cu, fwd_megakernel, NTHR, kDynLds);
    if (per_cu > 1) per_cu = 1;
    if (per_cu < 1) per_cu = 1;
    grid_blocks = cus * per_cu;
  }
  Params p{};
  const float** pf = (const float**)&p;
  for (int i = 0; i < 37; ++i) pf[i] = (const float*)d_in[i];
  p.out = (float*)d_out;
  p.ws = (char*)d_ws;
  (void)hipMemsetAsync((char*)d_ws + OFF_BAR, 0, 16384, stream);
  void* args[] = {&p};
  hipError_t e = hipLaunchCooperativeKernel((void*)fwd_megakernel, dim3(grid_blocks), dim3(NTHR), args, kDynLds, stream);
  if (e != hipSuccess) fprintf(stderr, "cooperative launch failed: %s (grid %d)\n", hipGetErrorString(e), grid_blocks);
}
```

```cpp
#include <hip/hip_runtime.h>
#include <hip/hip_cooperative_groups.h>
#include <cstdio>
namespace cg = cooperative_groups;

typedef unsigned short bf16_t;
typedef short bf16x8 __attribute__((ext_vector_type(8)));
typedef float f32x4 __attribute__((ext_vector_type(4)));
typedef unsigned u32x4 __attribute__((ext_vector_type(4)));

#define NTHR 512
#ifndef REPS
#define REPS 1
#endif
#ifndef REPO
#define REPO 1
#endif
#ifndef REPC
#define REPC 1
#endif
#ifndef REPR
#define REPR 1
#endif
#ifndef REPG
#define REPG 1
#endif
#define HALF_LDS 73728
#ifndef REP0
#define REP0 1
#endif
#ifndef REPS
#define REPS 1
#endif
#ifndef REPO
#define REPO 1
#endif
#ifndef REPC
#define REPC 1
#endif
#ifndef REPY
#define REPY 21
#endif
#define ROWS 17408
#define EPSV 1e-6f
#define TIDX(w) ((w) * 64 + (int)__builtin_amdgcn_mbcnt_hi(~0u, __builtin_amdgcn_mbcnt_lo(~0u, 0u)))

constexpr size_t W_IN = 0;
constexpr size_t W_OUT0 = 8388608;
constexpr size_t W_GLU = 6815744;
constexpr size_t W_OUT1 = 7340032;
constexpr size_t W_UP = 10485760;
constexpr size_t W_DOWN = 18874368;
constexpr size_t OFF_A = 29360128;
constexpr size_t OFF_GBUF = OFF_A + 111411200;
constexpr size_t OFF_ST = OFF_A + 142606336;
constexpr size_t OFF_H = OFF_ST + 67108864;
constexpr size_t OFF_SM = OFF_H + 53477376;
constexpr size_t OFF_ROPE = OFF_SM;
constexpr size_t OFF_ROWSS = OFF_SM + 1052672;
constexpr size_t OFF_SSDST = OFF_SM + 1331200;
constexpr size_t OFF_DTBUF = OFF_SM + 1470464;
constexpr size_t OFF_LB = OFF_SM + 2584576;
constexpr size_t OFF_S5TAB = OFF_SM + 2586624;
constexpr size_t OFF_S5E = OFF_SM + 2897920;
constexpr size_t OFF_S5H = OFF_SM + 9189376;
constexpr size_t OFF_BAR = OFF_SM + 15480832;

constexpr size_t O_RET = 17825792, O_HG = 26738688, O_SSM = 35651584, O_CONV = 53477376, O_S5RE = 54104064, O_S5IM = 54382592;

struct Params {
  const float *x_prompt, *x_sample, *state_ret, *state_hgrn, *state_ssm, *state_conv, *state_s5_re, *state_s5_im;
  const float *norm_mix_pre, *norm_mix_post, *norm_ffn_pre, *norm_ffn_post;
  const float *w_in_even, *w_out_even, *ret_norm_w, *hgrn_lb, *hgrn_norm_w, *w_in_odd, *conv_w, *conv_b, *dt_bias, *a_log, *d_ssm, *ssm_norm_w;
  const float *s5_lam_re, *s5_lam_im, *s5_log_step, *s5_b_re, *s5_b_im, *s5_c_re, *s5_c_im, *s5_d, *w_glu, *b_glu, *w_out_odd, *w_ffn_up, *w_ffn_down;
  float* out;
  char* ws;
};

__device__ __forceinline__ bf16_t f2bf(float f) { unsigned r; asm("v_cvt_pk_bf16_f32 %0, %1, %1" : "=v"(r) : "v"(f)); return (bf16_t)(r & 0xffffu); }
__device__ __forceinline__ float bf2f(bf16_t h) { return __uint_as_float(((unsigned)h) << 16); }
__device__ __forceinline__ unsigned pack2(float a, float b) { unsigned r; asm("v_cvt_pk_bf16_f32 %0, %1, %2" : "=v"(r) : "v"(a), "v"(b)); return r; }
__device__ __forceinline__ float lo2f(unsigned u) { return __uint_as_float(u << 16); }
__device__ __forceinline__ float hi2f(unsigned u) { return __uint_as_float(u & 0xffff0000u); }
__device__ __forceinline__ float sigm(float x) { return 1.f / (1.f + __expf(-x)); }
__device__ __forceinline__ float siluf(float x) { return x / (1.f + __expf(-x)); }
__device__ __forceinline__ void store4bf(bf16_t* p, float a, float b, float c, float d) { uint2 v; v.x = pack2(a, b); v.y = pack2(c, d); *(uint2*)p = v; }

__device__ __forceinline__ float shx(float v, int mask) {
  int l = (int)__builtin_amdgcn_mbcnt_hi(~0u, __builtin_amdgcn_mbcnt_lo(~0u, 0u));
  asm volatile("" : "+v"(l));
  return __int_as_float(__builtin_amdgcn_ds_bpermute((l ^ mask) << 2, __float_as_int(v)));
}

template <int MT, int NT>
__device__ __forceinline__ void wmma_sw(f32x4 (&acc)[MT][NT], const bf16_t* A, int lda, const bf16_t* B, int ldb, int K, int lane) {
  const int r = lane & 15, kq = (lane >> 4) * 8;
  for (int k0 = 0; k0 < K; k0 += 32) {
    bf16x8 af[MT], bfr[NT];
#pragma unroll
    for (int mt = 0; mt < MT; ++mt) af[mt] = *(const bf16x8*)(A + (mt * 16 + r) * lda + k0 + kq);
#pragma unroll
    for (int nt = 0; nt < NT; ++nt) bfr[nt] = *(const bf16x8*)(B + (nt * 16 + r) * ldb + k0 + kq);
#pragma unroll
    for (int mt = 0; mt < MT; ++mt)
#pragma unroll
      for (int nt = 0; nt < NT; ++nt) acc[mt][nt] = __builtin_amdgcn_mfma_f32_16x16x32_bf16(bfr[nt], af[mt], acc[mt][nt], 0, 0, 0);
  }
}
template <int MT, int NT>
__device__ __forceinline__ void wmma_ns(f32x4 (&acc)[MT][NT], const bf16_t* A, int lda, const bf16_t* B, int ldb, int K, int lane) {
  const int r = lane & 15, kq = (lane >> 4) * 8;
  for (int k0 = 0; k0 < K; k0 += 32) {
    bf16x8 af[MT], bfr[NT];
#pragma unroll
    for (int mt = 0; mt < MT; ++mt) af[mt] = *(const bf16x8*)(A + (mt * 16 + r) * lda + k0 + kq);
#pragma unroll
    for (int nt = 0; nt < NT; ++nt) bfr[nt] = *(const bf16x8*)(B + (nt * 16 + r) * ldb + k0 + kq);
#pragma unroll
    for (int mt = 0; mt < MT; ++mt)
#pragma unroll
      for (int nt = 0; nt < NT; ++nt) acc[mt][nt] = __builtin_amdgcn_mfma_f32_16x16x32_bf16(af[mt], bfr[nt], acc[mt][nt], 0, 0, 0);
  }
}

__device__ __forceinline__ void gemm_kstep(f32x4 (&acc)[4][8], const bf16_t* A, const bf16_t* B, int lane) {
  const int r = lane & 15, kq = (lane >> 4) * 8;
  bf16x8 af[4];
#pragma unroll
  for (int mt = 0; mt < 4; ++mt) af[mt] = *(const bf16x8*)(A + (mt * 16 + r) * 72 + kq);
#pragma unroll
  for (int nh = 0; nh < 2; ++nh) {
    bf16x8 bfr[4];
#pragma unroll
    for (int nt = 0; nt < 4; ++nt) bfr[nt] = *(const bf16x8*)(B + ((nh * 4 + nt) * 16 + r) * 72 + kq);
#pragma unroll
    for (int nt = 0; nt < 4; ++nt)
#pragma unroll
      for (int mt = 0; mt < 4; ++mt) acc[mt][nh * 4 + nt] = __builtin_amdgcn_mfma_f32_16x16x32_bf16(bfr[nt], af[mt], acc[mt][nh * 4 + nt], 0, 0, 0);
  }
}

template <class Epi>
__device__ __forceinline__ void gemm_phase(const bf16_t* A, int lda, const bf16_t* Bt, int ldb, int nMt, int nNt, int K, const Epi& epi, char* smem, int wvs) {
  bf16_t* As = (bf16_t*)smem;
  bf16_t* Bs = As + 2 * 256 * 72;
  int tid_ = TIDX(wvs); asm volatile("" : "+v"(tid_)); const int tid = tid_, lane = tid & 63, wave = tid >> 6;
  const int wr = wave >> 1, wc = wave & 1;
  const int ntiles = nMt * nNt, nk = K >> 6;
  const int lrow = tid >> 3, lcc = (tid & 7) * 8;
  const unsigned toffA = (unsigned)(lrow * lda + lcc), toffB = (unsigned)(lrow * ldb + lcc);
  for (int tile = blockIdx.x; tile < ntiles; tile += gridDim.x) {
    const int pm = tile / nNt, pn = tile - pm * nNt;
    const bf16_t* Ab = A + (size_t)(pm * 256) * lda;
    const bf16_t* Bb = Bt + (size_t)(pn * 256) * ldb;
    f32x4 acc[4][8];
#pragma unroll
    for (int i = 0; i < 4; ++i)
#pragma unroll
      for (int j = 0; j < 8; ++j) acc[i][j] = (f32x4){0.f, 0.f, 0.f, 0.f};
    u32x4 rg[4];
#pragma unroll
    for (int i = 0; i < 4; ++i) rg[i] = *(const u32x4*)(Ab + (size_t)(i * 64) * lda + toffA);
#pragma unroll
    for (int i = 0; i < 4; ++i) *(u32x4*)(As + (lrow + i * 64) * 72 + lcc) = rg[i];
#pragma unroll
    for (int i = 0; i < 4; ++i) rg[i] = *(const u32x4*)(Bb + (size_t)(i * 64) * ldb + toffB);
#pragma unroll
    for (int i = 0; i < 4; ++i) *(u32x4*)(Bs + (lrow + i * 64) * 72 + lcc) = rg[i];
    __syncthreads();
#pragma unroll 1
    for (int kt = 0; kt < nk; ++kt) {
      const int cur = kt & 1;
      const int kn = (kt + 1 < nk ? kt + 1 : kt) * 64;
      bf16_t* Ad = As + (cur ^ 1) * 256 * 72; bf16_t* Bd = Bs + (cur ^ 1) * 256 * 72;
#pragma unroll
      for (int i = 0; i < 4; ++i) rg[i] = *(const u32x4*)(Ab + ((size_t)(i * 64) * lda + kn) + toffA);
      __builtin_amdgcn_sched_barrier(0);
      gemm_kstep(acc, As + cur * 256 * 72 + wr * 64 * 72, Bs + cur * 256 * 72 + wc * 128 * 72, lane);
      __builtin_amdgcn_sched_barrier(0);
#pragma unroll
      for (int i = 0; i < 4; ++i) *(u32x4*)(Ad + (lrow + i * 64) * 72 + lcc) = rg[i];
#pragma unroll
      for (int i = 0; i < 4; ++i) rg[i] = *(const u32x4*)(Bb + ((size_t)(i * 64) * ldb + kn) + toffB);
      __builtin_amdgcn_sched_barrier(0);
      gemm_kstep(acc, As + cur * 256 * 72 + wr * 64 * 72 + 32, Bs + cur * 256 * 72 + wc * 128 * 72 + 32, lane);
      __builtin_amdgcn_sched_barrier(0);
#pragma unroll
      for (int i = 0; i < 4; ++i) *(u32x4*)(Bd + (lrow + i * 64) * 72 + lcc) = rg[i];
      __syncthreads();
    }
    int er_ = pm * 256 + wr * 64, ec_ = pn * 256 + wc * 128, el_ = lane;
    asm volatile("" : "+v"(er_), "+v"(ec_), "+v"(el_));
    epi(acc, er_, ec_, el_);
  }
}

struct EpiInEven {
  bf16_t* proj; const float* rope; const float* lb;
  template <int MT> __device__ __forceinline__ void operator()(f32x4 (&acc)[MT][8], int rbase, int cbase, int lane) const {
    const int sec = cbase >> 9, head = (cbase >> 7) & 3, r = lane & 15, cq = (lane >> 4) * 4;
#pragma unroll
    for (int mt = 0; mt < MT; ++mt) {
      __builtin_amdgcn_sched_barrier(0);
      const int row = rbase + mt * 16 + r;
      bf16_t* dst = proj + (size_t)row * 4096 + cbase + cq;
      if (sec < 2) {
        const int pidx = row < 16384 ? (row & 2047) : 2048 + ((row - 16384) & 7);
        const float* ct = rope + pidx * 128 + cq;
        const float sc = sec == 1 ? 0.08838834764831845f : 1.f;
#pragma unroll
        for (int nt = 0; nt < 4; ++nt) {
          const float4 c4 = *(const float4*)(ct + nt * 16), s4 = *(const float4*)(ct + 64 + nt * 16);
          const f32x4 x1 = acc[mt][nt], x2 = acc[mt][nt + 4];
          store4bf(dst + nt * 16, (x1[0] * c4.x - x2[0] * s4.x) * sc, (x1[1] * c4.y - x2[1] * s4.y) * sc, (x1[2] * c4.z - x2[2] * s4.z) * sc, (x1[3] * c4.w - x2[3] * s4.w) * sc);
          store4bf(dst + 64 + nt * 16, (x1[0] * s4.x + x2[0] * c4.x) * sc, (x1[1] * s4.y + x2[1] * c4.y) * sc, (x1[2] * s4.z + x2[2] * c4.z) * sc, (x1[3] * s4.w + x2[3] * c4.w) * sc);
        }
      } else if (sec == 5) {
#pragma unroll
        for (int nt = 0; nt < 8; ++nt) {
          const float4 l4 = *(const float4*)(lb + head * 128 + nt * 16 + cq);
          const f32x4 x = acc[mt][nt];
          store4bf(dst + nt * 16, __logf(l4.x + (1.f - l4.x) * sigm(x[0])), __logf(l4.y + (1.f - l4.y) * sigm(x[1])), __logf(l4.z + (1.f - l4.z) * sigm(x[2])), __logf(l4.w + (1.f - l4.w) * sigm(x[3])));
        }
      } else {
#pragma unroll
        for (int nt = 0; nt < 8; ++nt) { const f32x4 x = acc[mt][nt]; store4bf(dst + nt * 16, x[0], x[1], x[2], x[3]); }
      }
    }
  }
};
struct EpiOut {
  bf16_t* t0; float* rowss;
  template <int MT> __device__ __forceinline__ void operator()(f32x4 (&acc)[MT][8], int rbase, int cbase, int lane) const {
    const int r = lane & 15, cq = (lane >> 4) * 4;
#pragma unroll
    for (int mt = 0; mt < MT; ++mt) {
      __builtin_amdgcn_sched_barrier(0);
      const int row = rbase + mt * 16 + r;
      bf16_t* dst = t0 + (size_t)row * 1024 + cbase + cq;
      float ss = 0.f;
#pragma unroll
      for (int nt = 0; nt < 8; ++nt) { const f32x4 x = acc[mt][nt]; ss += x[0] * x[0] + x[1] * x[1] + x[2] * x[2] + x[3] * x[3]; store4bf(dst + nt * 16, x[0], x[1], x[2], x[3]); }
      ss += shx(ss, 16); ss += shx(ss, 32);
      if (lane < 16) atomicAdd(rowss + row, ss * (1.f / REPG));
    }
  }
};
struct EpiUp {
  bf16_t* act;
  template <int MT> __device__ __forceinline__ void operator()(f32x4 (&acc)[MT][8], int rbase, int cbase, int lane) const {
    const int r = lane & 15, cq = (lane >> 4) * 4;
#pragma unroll
    for (int mt = 0; mt < MT; ++mt) {
      __builtin_amdgcn_sched_barrier(0);
      bf16_t* dst = act + (size_t)(rbase + mt * 16 + r) * 4096 + cbase + cq;
#pragma unroll
      for (int nt = 0; nt < 8; ++nt) { f32x4 x = acc[mt][nt];
#pragma unroll
        for (int j = 0; j < 4; ++j) { float v = fmaxf(x[j], 0.f); x[j] = v * v; }
        store4bf(dst + nt * 16, x[0], x[1], x[2], x[3]); }
    }
  }
};
struct EpiInOdd {
  bf16_t* proj; float* dtbuf;
  template <int MT> __device__ __forceinline__ void operator()(f32x4 (&acc)[MT][8], int rbase, int cbase, int lane) const {
    const int r = lane & 15, cq = (lane >> 4) * 4;
#pragma unroll
    for (int mt = 0; mt < MT; ++mt) {
      __builtin_amdgcn_sched_barrier(0);
      const int row = rbase + mt * 16 + r;
      bf16_t* dst = proj + (size_t)row * 3200 + cbase + cq;
#pragma unroll
      for (int nt = 0; nt < 8; ++nt) { const f32x4 x = acc[mt][nt]; if (cbase + nt * 16 < 3200) store4bf(dst + nt * 16, x[0], x[1], x[2], x[3]); }
      if (cbase == 2560) { const f32x4 x = acc[mt][0]; *(float4*)(dtbuf + (size_t)row * 16 + cq) = make_float4(x[0], x[1], x[2], x[3]); }
    }
  }
};
struct EpiGlu {
  const bf16_t* gbuf; const float* bglu; bf16_t* mix;
  template <int MT> __device__ __forceinline__ void operator()(f32x4 (&acc)[MT][8], int rbase, int cbase, int lane) const {
    const int r = lane & 15, cq = (lane >> 4) * 4;
#pragma unroll
    for (int mt = 0; mt < MT; ++mt) {
      __builtin_amdgcn_sched_barrier(0);
      const int row = rbase + mt * 16 + r;
#pragma unroll
      for (int nt = 0; nt < 8; ++nt) {
        const int col = cbase + nt * 16 + cq;
        const f32x4 x = acc[mt][nt];
        const uint2 g2 = *(const uint2*)(gbuf + (size_t)row * 512 + col);
        const float4 b4 = *(const float4*)(bglu + col);
        store4bf(mix + (size_t)row * 1536 + 1024 + col, lo2f(g2.x) * sigm(x[0] + b4.x), hi2f(g2.x) * sigm(x[1] + b4.y), lo2f(g2.y) * sigm(x[2] + b4.z), hi2f(g2.y) * sigm(x[3] + b4.w));
      }
    }
  }
};

template <class Epi>
__device__ __forceinline__ void gemm_tail(const bf16_t* A, int lda, const bf16_t* Bt, int ldb, int nNt128, int K, const Epi& epi, char* smem, int wvs, int nBig) {
  bf16_t* As = (bf16_t*)smem;
  bf16_t* Bs = As + 2 * 128 * 72;
  int tid_ = TIDX(wvs); asm volatile("" : "+v"(tid_)); const int tid = tid_, lane = tid & 63, wave = tid >> 6;
  const int nk = K >> 6, G = gridDim.x;
  const int lrow = tid >> 3, lcc = (tid & 7) * 8;
  const unsigned toffA = (unsigned)(lrow * lda + lcc), toffB = (unsigned)(lrow * ldb + lcc);
  const int rr = nBig % G, nLight = G - rr;
  const int nSmall = 8 * nNt128;
  if ((int)blockIdx.x >= rr) {
    for (int j = (int)blockIdx.x - rr; j < nSmall; j += nLight) {
      const int pm = j / nNt128, pn = j - pm * nNt128;
      const bf16_t* Ab = A + (size_t)(16384 + pm * 128) * lda;
      const bf16_t* Bb = Bt + (size_t)(pn * 128) * ldb;
      f32x4 acc[1][8];
#pragma unroll
      for (int q = 0; q < 8; ++q) acc[0][q] = (f32x4){0.f, 0.f, 0.f, 0.f};
      u32x4 ra[2], rb[2];
#pragma unroll
      for (int i = 0; i < 2; ++i) { ra[i] = *(const u32x4*)(Ab + (size_t)(i * 64) * lda + toffA); rb[i] = *(const u32x4*)(Bb + (size_t)(i * 64) * ldb + toffB); }
#pragma unroll
      for (int i = 0; i < 2; ++i) { *(u32x4*)(As + (lrow + i * 64) * 72 + lcc) = ra[i]; *(u32x4*)(Bs + (lrow + i * 64) * 72 + lcc) = rb[i]; }
      __syncthreads();
#pragma unroll 1
      for (int kt = 0; kt < nk; ++kt) {
        const int cur = kt & 1;
        const int kn = (kt + 1 < nk ? kt + 1 : kt) * 64;
#pragma unroll
        for (int i = 0; i < 2; ++i) { ra[i] = *(const u32x4*)(Ab + ((size_t)(i * 64) * lda + kn) + toffA); rb[i] = *(const u32x4*)(Bb + ((size_t)(i * 64) * ldb + kn) + toffB); }
        __builtin_amdgcn_sched_barrier(0);
        wmma_sw<1, 8>(acc, As + cur * 128 * 72 + wave * 16 * 72, 72, Bs + cur * 128 * 72, 72, 64, lane);
        __builtin_amdgcn_sched_barrier(0);
        bf16_t* Ad = As + (cur ^ 1) * 128 * 72; bf16_t* Bd = Bs + (cur ^ 1) * 128 * 72;
#pragma unroll
        for (int i = 0; i < 2; ++i) { *(u32x4*)(Ad + (lrow + i * 64) * 72 + lcc) = ra[i]; *(u32x4*)(Bd + (lrow + i * 64) * 72 + lcc) = rb[i]; }
        __syncthreads();
      }
      int er_ = 16384 + pm * 128 + wave * 16, ec_ = pn * 128, el_ = lane;
      asm volatile("" : "+v"(er_), "+v"(ec_), "+v"(el_));
      epi(acc, er_, ec_, el_);
    }
  }
}

__device__ __forceinline__ void rowpass_phase(const bf16_t* t0, const float* rowss, const float* wpost, const float* hin_a, const float* hin_b, float* hout, const float* wnext, bf16_t* hn, int wvs) {
  int tq_ = TIDX(wvs); asm volatile("" : "+v"(tq_)); const int lane = tq_ & 63, gw = blockIdx.x * 8 + (tq_ >> 6), nw = gridDim.x * 8;
  for (int row = gw; row < ROWS; row += nw) {
    const float* hin = row < 16384 ? hin_a + (size_t)row * 1024 : hin_b + (size_t)(row - 16384) * 1024;
    float r0 = 0.f;
    if (t0) r0 = rsqrtf(rowss[row] * (1.f / 1024.f) + EPSV);
    float4 v[4]; float ss = 0.f;
#pragma unroll
    for (int i = 0; i < 4; ++i) {
      const int col = (i * 64 + lane) * 4;
      float4 hv = *(const float4*)(hin + col);
      if (t0) {
        const uint2 t2 = *(const uint2*)(t0 + (size_t)row * 1024 + col);
        const float4 w4 = *(const float4*)(wpost + col);
        hv.x += lo2f(t2.x) * r0 * w4.x; hv.y += hi2f(t2.x) * r0 * w4.y; hv.z += lo2f(t2.y) * r0 * w4.z; hv.w += hi2f(t2.y) * r0 * w4.w;
      }
      v[i] = hv; ss += hv.x * hv.x + hv.y * hv.y + hv.z * hv.z + hv.w * hv.w;
      if (hout) *(float4*)(hout + (size_t)row * 1024 + col) = hv;
    }
    if (hn) {
#pragma unroll
      for (int o = 32; o >= 1; o >>= 1) ss += shx(ss, o);
      const float r1 = rsqrtf(ss * (1.f / 1024.f) + EPSV);
#pragma unroll
      for (int i = 0; i < 4; ++i) {
        const int col = (i * 64 + lane) * 4;
        const float4 w4 = *(const float4*)(wnext + col);
        store4bf(hn + (size_t)row * 1024 + col, v[i].x * r1 * w4.x, v[i].y * r1 * w4.y, v[i].z * r1 * w4.z, v[i].w * r1 * w4.w);
      }
    }
  }
}

__device__ __forceinline__ void wconv(const float* __restrict__ W, int K, int N, int Npad, bf16_t* __restrict__ Wt, char* smem, int wvs) {
  float* tile = (float*)smem;
  int tq_ = TIDX(wvs) & 255; asm volatile("" : "+v"(tq_)); const int tid = tq_;
  const int nNt = Npad >> 6, nunits = (K >> 6) * nNt;
  for (int u = blockIdx.x * 2 + (wvs >> 2); u < nunits; u += gridDim.x * 2) {
    const int k0 = (u / nNt) * 64, n0 = (u % nNt) * 64;
#pragma unroll
    for (int ps = 0; ps < 4; ++ps) {
      const int i = ps * 16 + (tid >> 4), j = (tid & 15) * 4, n = n0 + j;
      float4 v = make_float4(0.f, 0.f, 0.f, 0.f);
      if (n < N) v = *(const float4*)(W + (size_t)(k0 + i) * N + n);
      tile[i * 65 + j] = v.x; tile[i * 65 + j + 1] = v.y; tile[i * 65 + j + 2] = v.z; tile[i * 65 + j + 3] = v.w;
    }
    __syncthreads();
    {
      const int n = tid >> 2, kq = (tid & 3) * 16;
      uint4 o0, o1;
      o0.x = pack2(tile[(kq + 0) * 65 + n], tile[(kq + 1) * 65 + n]); o0.y = pack2(tile[(kq + 2) * 65 + n], tile[(kq + 3) * 65 + n]);
      o0.z = pack2(tile[(kq + 4) * 65 + n], tile[(kq + 5) * 65 + n]); o0.w = pack2(tile[(kq + 6) * 65 + n], tile[(kq + 7) * 65 + n]);
      o1.x = pack2(tile[(kq + 8) * 65 + n], tile[(kq + 9) * 65 + n]); o1.y = pack2(tile[(kq + 10) * 65 + n], tile[(kq + 11) * 65 + n]);
      o1.z = pack2(tile[(kq + 12) * 65 + n], tile[(kq + 13) * 65 + n]); o1.w = pack2(tile[(kq + 14) * 65 + n], tile[(kq + 15) * 65 + n]);
      bf16_t* d = Wt + (size_t)(n0 + n) * K + k0 + kq;
      *(uint4*)d = o0; *(uint4*)(d + 8) = o1;
    }
    __syncthreads();
  }
}

__device__ __forceinline__ void prep_tables(const Params& p, int wvs) {
  int tq_ = TIDX(wvs); asm volatile("" : "+v"(tq_)); const int gt = blockIdx.x * NTHR + tq_, nt = gridDim.x * NTHR;
  float* rope = (float*)(p.ws + OFF_ROPE);
  for (int i = gt; i < 2056 * 64; i += nt) {
    const int pi = i >> 6, f = i & 63;
    const double pos = pi < 2048 ? (double)pi : (double)(16384 + pi - 2048);
    const double invf = exp(-(double)f * (9.210340371976184 / 64.0));
    double ang = pos * invf;
    ang -= 6.283185307179586 * floor(ang * 0.15915494309189535);
    const float a = (float)ang;
    rope[pi * 128 + f] = cosf(a); rope[pi * 128 + 64 + f] = sinf(a);
  }
  float* z = (float*)(p.ws + OFF_ROWSS);
  for (int i = gt; i < ROWS * 6; i += nt) z[i] = 0.f;
  float* lb = (float*)(p.ws + OFF_LB);
  for (int i = gt; i < 512; i += nt) lb[i] = 1.f / (1.f + expf(p.hgrn_lb[512 + i] - p.hgrn_lb[i]));
  float* tab = (float*)(p.ws + OFF_S5TAB);
  for (int i = gt; i < 2048; i += nt) {
    const int g = i >> 6;
    const float lr = p.s5_lam_re[i], li = p.s5_lam_im[i], dt = expf(p.s5_log_step[g]);
    const float m1 = expf(lr * dt), br = m1 * cosf(li * dt), bi = m1 * sinf(li * dt);
    tab[i] = br; tab[2048 + i] = bi;
    const float m64 = expf(lr * dt * 64.f); tab[69632 + i] = m64 * cosf(li * dt * 64.f); tab[71680 + i] = m64 * sinf(li * dt * 64.f);
    const float m8 = expf(lr * dt * 8.f); tab[73728 + i] = m8 * cosf(li * dt * 8.f); tab[75776 + i] = m8 * sinf(li * dt * 8.f);
    const float x = br - 1.f, y = bi, den = 1.f / (lr * lr + li * li);
    const float qr = (x * lr + y * li) * den, qi = (y * lr - x * li) * den;
    for (int c = 0; c < 16; ++c) {
      const float b_r = p.s5_b_re[i * 16 + c], b_i = p.s5_b_im[i * 16 + c];
      tab[4096 + i * 16 + c] = qr * b_r - qi * b_i;
      tab[4096 + 32768 + i * 16 + c] = qr * b_i + qi * b_r;
    }
  }
}

__device__ __forceinline__ void chunk_geom(int c, int& row0, int& L) { if (c < 256) { row0 = c * 64; L = 64; } else { row0 = 16384 + (c - 256) * 8; L = 8; } }

template <int MODE>
__device__ __forceinline__ void st_load(uint4 (&kr)[4], uint4 (&vr)[(MODE == 2) ? 2 : 1], float& dtr, const bf16_t* src, const float* dtbuf, int row0, int L, int ld, int kcol, int vcol, int h, int tid) {
  constexpr int PW = (MODE == 2) ? 64 : 32, NVC = PW / 32, VCR = PW / 8;
  const uint4 z4 = make_uint4(0, 0, 0, 0);
#pragma unroll
  for (int i = 0; i < 4; ++i) { const int id = tid + i * 256, s = id >> 4, c8 = id & 15; uint4 t_ = z4; if (s < L) t_ = *(const uint4*)(src + (size_t)(row0 + s) * ld + kcol + c8 * 8); kr[i] = t_; }
#pragma unroll
  for (int i = 0; i < NVC; ++i) { const int id = tid + i * 256, s = id / VCR, c8 = id % VCR; uint4 t_ = z4; if (s < L) t_ = *(const uint4*)(src + (size_t)(row0 + s) * ld + vcol + c8 * 8); vr[i] = t_; }
  if (MODE == 2 && tid < 64) dtr = tid < L ? dtbuf[(size_t)(row0 + tid) * 16 + h] : 0.f;
}

template <int MODE>
__device__ __forceinline__ void state_unit(const Params& p, int sq, int h, int ps, char* smem, int wvs) {
  constexpr int PW = (MODE == 2) ? 64 : 32, NT = PW / 16, PF = (MODE == 2) ? 64 : 128, HH = (MODE == 2) ? 16 : 4, NVC = PW / 32, VCR = PW / 8;
  bf16_t* KT = (bf16_t*)smem;
  bf16_t* VT = KT + 128 * 72;
  bf16_t* KR = VT + 64 * 72;
  float* tot = (float*)(KR + 64 * 136);
  float* dec = tot + 256;
  float* av = dec + 64;
  float* dtv = av + 64;
  int tid_ = TIDX(wvs) & 255; asm volatile("" : "+v"(tid_)); const int tid = tid_, lane = tid & 63, wave = tid >> 6;
  const bool prompt = sq < 8;
  const int nch = prompt ? 32 : 1, L = prompt ? 64 : 8;
  const int ld = (MODE == 2) ? 1536 : 4096;
  const bf16_t* src = (MODE == 2) ? (const bf16_t*)(p.ws + OFF_H) : (const bf16_t*)(p.ws + OFF_A);
  const int kcol = MODE == 0 ? 512 + h * 128 : MODE == 1 ? 2560 + h * 128 : 1024 + (h >> 3) * 128;
  const int vcol = MODE == 0 ? 1024 + h * 128 + ps * 32 : MODE == 1 ? 3072 + h * 128 + ps * 32 : h * 64;
  const float* sin_ = MODE == 0 ? p.state_ret : MODE == 1 ? p.state_hgrn : p.state_ssm;
  float* sout = p.out + (MODE == 0 ? O_RET : MODE == 1 ? O_HG : O_SSM) + (size_t)(sq * HH + h) * 128 * PF;
  bf16_t* stb = (bf16_t*)(p.ws + OFF_ST) + (MODE == 1 ? (size_t)256 * 4 * 128 * 128 : 0);
  const float* dtbuf = (const float*)(p.ws + OFF_DTBUF);
  const float l2g = MODE == 0 ? log2f(1.f - exp2f(-5.f - (float)h)) : 0.f;
  float Ah = 0.f, dtb = 0.f;
  if (MODE == 2) { Ah = -expf(p.a_log[h]); dtb = p.dt_bias[h]; }

  f32x4 acc[2][NT];
  const int nb = wave * 32 + (lane >> 4) * 4, pc = ps * PW + (lane & 15);
#pragma unroll
  for (int mt = 0; mt < 2; ++mt)
#pragma unroll
    for (int nt = 0; nt < NT; ++nt)
#pragma unroll
      for (int j = 0; j < 4; ++j)
        acc[mt][nt][j] = prompt ? 0.f : sin_[((size_t)((sq - 8) * HH + h) * 128 + nb + mt * 16 + j) * PF + pc + nt * 16];

  uint4 kr[4], vr[NVC]; float dtr = 0.f;
  const uint4 z4 = make_uint4(0, 0, 0, 0);
  st_load<MODE>(kr, vr, dtr, src, dtbuf, prompt ? sq * 2048 : 16384 + (sq - 8) * 8, L, ld, kcol, vcol, h, tid);
  for (int n = 0; n < nch; ++n) {
    if (prompt) {
      bf16_t* d = stb + ((size_t)((sq * 32 + n) * HH + h) * PF) * 128;
#pragma unroll
      for (int mt = 0; mt < 2; ++mt)
#pragma unroll
        for (int nt = 0; nt < NT; ++nt) store4bf(d + (size_t)(pc + nt * 16) * 128 + nb + mt * 16, acc[mt][nt][0], acc[mt][nt][1], acc[mt][nt][2], acc[mt][nt][3]);
    }
#pragma unroll
    for (int i = 0; i < 4; ++i) { const int id = tid + i * 256, s = id >> 4, c8 = id & 15; *(uint4*)(KR + s * 136 + c8 * 8) = kr[i]; }
#pragma unroll
    for (int i = 0; i < NVC; ++i) {
      const int id = tid + i * 256, s = id / VCR, c8 = id % VCR; const uint4 v = vr[i];
      bf16_t* d = VT + (c8 * 8) * 72 + s;
      d[0] = (bf16_t)(v.x & 0xffff); d[72] = (bf16_t)(v.x >> 16); d[144] = (bf16_t)(v.y & 0xffff); d[216] = (bf16_t)(v.y >> 16);
      d[288] = (bf16_t)(v.z & 0xffff); d[360] = (bf16_t)(v.z >> 16); d[432] = (bf16_t)(v.w & 0xffff); d[504] = (bf16_t)(v.w >> 16);
    }
    if (MODE == 2 && tid < 64) {
      float dt = 0.f;
      if (tid < L) { const float x = dtr + dtb; dt = x > 20.f ? x : log1pf(__expf(x)); }
      dtv[tid] = dt; av[tid] = dt * Ah;
    }
    if (n + 1 < nch) st_load<MODE>(kr, vr, dtr, src, dtbuf, sq * 2048 + (n + 1) * 64, L, ld, kcol, vcol, h, tid);
    __syncthreads();
    const int kn = tid & 127, half = tid >> 7;
    if (MODE == 1) {
      float s_ = 0.f;
      for (int s = half * 32; s < half * 32 + 32; ++s) s_ += bf2f(KR[s * 136 + kn]);
      tot[half * 128 + kn] = s_;
    }
    if (MODE == 2 && tid < 64) {
      float suf = 0.f;
      for (int r = tid + 1; r < 64; ++r) suf += av[r];
      dec[tid] = __expf(suf) * dtv[tid];
      if (tid == 0) tot[0] = suf + av[0];
    }
    if (MODE != 0) __syncthreads();
    {
      float suf = 0.f;
      if (MODE == 1) suf = half == 0 ? tot[128 + kn] : 0.f;
      for (int g = 3; g >= 0; --g) {
        const int s0 = half * 32 + g * 8;
        float v[8];
#pragma unroll
        for (int e = 7; e >= 0; --e) {
          const int s = s0 + e;
          const float raw = bf2f(KR[s * 136 + kn]);
          if (MODE == 0) v[e] = raw * exp2f((float)(L - 1 - s) * l2g);
          else if (MODE == 1) { v[e] = (1.f - __expf(raw)) * __expf(suf); suf += raw; }
          else v[e] = raw * dec[s];
        }
        uint4 o; o.x = pack2(v[0], v[1]); o.y = pack2(v[2], v[3]); o.z = pack2(v[4], v[5]); o.w = pack2(v[6], v[7]);
        *(uint4*)(KT + kn * 72 + s0) = o;
      }
    }
    __syncthreads();
#pragma unroll
    for (int mt = 0; mt < 2; ++mt) {
      float dk[4];
      if (MODE == 0) { const float d = exp2f((float)L * l2g); dk[0] = dk[1] = dk[2] = dk[3] = d; }
      else if (MODE == 2) { const float d = __expf(tot[0]); dk[0] = dk[1] = dk[2] = dk[3] = d; }
      else {
#pragma unroll
        for (int j = 0; j < 4; ++j) { const int nn = nb + mt * 16 + j; dk[j] = __expf(tot[nn] + tot[128 + nn]); }
      }
#pragma unroll
      for (int nt = 0; nt < NT; ++nt)
#pragma unroll
        for (int j = 0; j < 4; ++j) acc[mt][nt][j] *= dk[j];
    }
    wmma_ns<2, NT>(acc, KT + wave * 32 * 72, 72, VT, 72, 64, lane);
    __syncthreads();
  }
#pragma unroll
  for (int mt = 0; mt < 2; ++mt)
#pragma unroll
    for (int nt = 0; nt < NT; ++nt)
#pragma unroll
      for (int j = 0; j < 4; ++j) sout[(size_t)(nb + mt * 16 + j) * PF + pc + nt * 16] = acc[mt][nt][j];
}

template <int MODE>
__device__ __forceinline__ void out_unit(const Params& p, int c, int h, char* smem, int wvs) {
  constexpr int PF = (MODE == 2) ? 64 : 128, NTP = PF / 16, HH = (MODE == 2) ? 16 : 4, NVC = PF / 32, VCR = PF / 8;
  bf16_t* Q = (bf16_t*)smem;
  bf16_t* Kb = Q + 64 * 136;
  bf16_t* STb = Kb + 128 * 72;
  float* cumv = (float*)(STb + 128 * 136);
  float* dtv = cumv + 64;
  float* av = dtv + 64;
  float* tot = av + 64;
  int tid_ = TIDX(wvs) & 255; asm volatile("" : "+v"(tid_)); const int tid = tid_, lane = tid & 63, wave = tid >> 6;
  int row0, L; chunk_geom(c, row0, L);
  const int ld = (MODE == 2) ? 1536 : 4096;
  const bf16_t* src = (MODE == 2) ? (const bf16_t*)(p.ws + OFF_H) : (const bf16_t*)(p.ws + OFF_A);
  const int qcol = MODE == 0 ? h * 128 : MODE == 1 ? 2048 + h * 128 : 1280 + (h >> 3) * 128;
  const int kcol = MODE == 0 ? 512 + h * 128 : MODE == 1 ? 2560 + h * 128 : 1024 + (h >> 3) * 128;
  const int vcol = MODE == 0 ? 1024 + h * 128 : MODE == 1 ? 3072 + h * 128 : h * 64;
  const float l2g = MODE == 0 ? log2f(1.f - exp2f(-5.f - (float)h)) : 0.f;
  const uint4 z4 = make_uint4(0, 0, 0, 0);
#pragma unroll
  for (int i = 0; i < 4; ++i) {
    const int id = tid + i * 256, s = id >> 4, c8 = id & 15;
    uint4 q4 = z4, k4 = z4;
    if (s < L) { q4 = *(const uint4*)(src + (size_t)(row0 + s) * ld + qcol + c8 * 8); k4 = *(const uint4*)(src + (size_t)(row0 + s) * ld + kcol + c8 * 8); }
    *(uint4*)(Q + s * 136 + c8 * 8) = q4; *(uint4*)(Kb + s * 136 + c8 * 8) = k4;
  }
  uint4 vr[NVC];
#pragma unroll
  for (int i = 0; i < NVC; ++i) { const int id = tid + i * 256, s = id / VCR, c8 = id % VCR; uint4 t_ = z4; if (s < L) t_ = *(const uint4*)(src + (size_t)(row0 + s) * ld + vcol + c8 * 8); vr[i] = t_; }
  if (c < 256) {
    const bf16_t* stg = (const bf16_t*)(p.ws + OFF_ST) + (MODE == 1 ? (size_t)256 * 4 * 128 * 128 : 0) + ((size_t)(c * HH + h) * PF) * 128;
#pragma unroll
    for (int i = 0; i < PF / 16; ++i) { const int id = tid + i * 256, pr = id >> 4, c8 = id & 15; *(uint4*)(STb + pr * 136 + c8 * 8) = *(const uint4*)(stg + (size_t)pr * 128 + c8 * 8); }
  } else {
    const float* sg = (MODE == 0 ? p.state_ret : MODE == 1 ? p.state_hgrn : p.state_ssm) + (size_t)((c - 256) * HH + h) * 128 * PF;
    for (int id = tid; id < 128 * (PF / 4); id += 256) {
      const int n = id / (PF / 4), p4 = (id % (PF / 4)) * 4;
      const float4 v = *(const float4*)(sg + (size_t)n * PF + p4);
      STb[(p4 + 0) * 136 + n] = f2bf(v.x); STb[(p4 + 1) * 136 + n] = f2bf(v.y); STb[(p4 + 2) * 136 + n] = f2bf(v.z); STb[(p4 + 3) * 136 + n] = f2bf(v.w);
    }
  }
  if (MODE == 2 && tid < 64) {
    float dt = 0.f;
    if (tid < L) { const float x = ((const float*)(p.ws + OFF_DTBUF))[(size_t)(row0 + tid) * 16 + h] + p.dt_bias[h]; dt = x > 20.f ? x : log1pf(__expf(x)); }
    dtv[tid] = dt; av[tid] = -expf(p.a_log[h]) * dt;
  }
  __syncthreads();
  if (MODE == 1) {
    const int kn = tid & 127, half = tid >> 7;
    float s_ = 0.f;
    for (int s = half * 32; s < half * 32 + 32; ++s) s_ += bf2f(Kb[s * 136 + kn]);
    tot[half * 128 + kn] = s_;
    __syncthreads();
    float cum = half == 1 ? tot[kn] : 0.f;
    for (int s = half * 32; s < half * 32 + 32; ++s) {
      const float lf = bf2f(Kb[s * 136 + kn]);
      cum += lf;
      Q[s * 136 + kn] = f2bf(bf2f(Q[s * 136 + kn]) * __expf(cum));
      Kb[s * 136 + kn] = f2bf((1.f - __expf(lf)) * __expf(-cum));
    }
    __syncthreads();
  }
  if (MODE == 2) {
    if (tid < 64) { float cs = 0.f; for (int r = 0; r <= tid; ++r) cs += av[r]; cumv[tid] = cs; }
    __syncthreads();
  }
  f32x4 ai[1][NTP], asc[1][4];
#pragma unroll
  for (int j = 0; j < NTP; ++j) ai[0][j] = (f32x4){0.f, 0.f, 0.f, 0.f};
#pragma unroll
  for (int j = 0; j < 4; ++j) asc[0][j] = (f32x4){0.f, 0.f, 0.f, 0.f};
  wmma_sw<1, NTP>(ai, Q + wave * 16 * 136, 136, STb, 136, 128, lane);
  wmma_sw<1, 4>(asc, Q + wave * 16 * 136, 136, Kb, 136, 128, lane);
  const int t = wave * 16 + (lane & 15), sq4 = (lane >> 4) * 4;
  float ct = 0.f;
  if (MODE == 2) ct = cumv[t];
#pragma unroll
  for (int nt = 0; nt < 4; ++nt)
#pragma unroll
    for (int j = 0; j < 4; ++j) {
      const int s = nt * 16 + sq4 + j;
      float v = asc[0][nt][j];
      if (s > t) v = 0.f;
      else if (MODE == 0) v *= exp2f((float)(t - s) * l2g);
      else if (MODE == 2) v *= __expf(ct - cumv[s]) * dtv[s];
      asc[0][nt][j] = v;
    }
  __syncthreads();
  bf16_t* Pb = STb; bf16_t* VT = Kb;
#pragma unroll
  for (int nt = 0; nt < 4; ++nt) store4bf(Pb + t * 72 + nt * 16 + sq4, asc[0][nt][0], asc[0][nt][1], asc[0][nt][2], asc[0][nt][3]);
#pragma unroll
  for (int i = 0; i < NVC; ++i) {
    const int id = tid + i * 256, s = id / VCR, c8 = id % VCR; const uint4 v = vr[i];
    bf16_t* d = VT + (c8 * 8) * 72 + s;
    d[0] = (bf16_t)(v.x & 0xffff); d[72] = (bf16_t)(v.x >> 16); d[144] = (bf16_t)(v.y & 0xffff); d[216] = (bf16_t)(v.y >> 16);
    d[288] = (bf16_t)(v.z & 0xffff); d[360] = (bf16_t)(v.z >> 16); d[432] = (bf16_t)(v.w & 0xffff); d[504] = (bf16_t)(v.w >> 16);
  }
  __syncthreads();
  f32x4 ao[1][NTP];
#pragma unroll
  for (int j = 0; j < NTP; ++j) ao[0][j] = (f32x4){0.f, 0.f, 0.f, 0.f};
  wmma_sw<1, NTP>(ao, Pb + wave * 16 * 72, 72, VT, 72, 64, lane);
  float fi = 1.f;
  if (MODE == 0) fi = exp2f((float)(t + 1) * l2g);
  if (MODE == 2) fi = __expf(ct);
  const int row = row0 + t;
  const bool valid = t < L;
  if (MODE == 0 || MODE == 1) {
    float s1 = 0.f, s2 = 0.f;
#pragma unroll
    for (int nt = 0; nt < NTP; ++nt)
#pragma unroll
      for (int j = 0; j < 4; ++j) { const float o = ao[0][nt][j] + fi * ai[0][nt][j]; ao[0][nt][j] = o; s1 += o; s2 += o * o; }
    s1 += shx(s1, 16); s1 += shx(s1, 32); s2 += shx(s2, 16); s2 += shx(s2, 32);
    float mu = 0.f, rs;
    if (MODE == 0) { mu = s1 * (1.f / 128.f); const float var = fmaxf(s2 * (1.f / 128.f) - mu * mu, 0.f); rs = rsqrtf(var + EPSV); }
    else rs = rsqrtf(s2 * (1.f / 128.f) + EPSV);
    if (valid) {
      const float* nw = (MODE == 0 ? p.ret_norm_w : p.hgrn_norm_w) + h * 128;
      const int gcol = (MODE == 0 ? 1536 : 3584) + h * 128;
      bf16_t* mix = (bf16_t*)(p.ws + OFF_H) + (size_t)row * 1024 + (MODE == 0 ? 0 : 512) + h * 128;
#pragma unroll
      for (int nt = 0; nt < NTP; ++nt) {
        const int pp = nt * 16 + sq4;
        const float4 w4 = *(const float4*)(nw + pp);
        const uint2 g2 = *(const uint2*)(src + (size_t)row * ld + gcol + pp);
        store4bf(mix + pp, (ao[0][nt][0] - mu) * rs * w4.x * siluf(lo2f(g2.x)), (ao[0][nt][1] - mu) * rs * w4.y * siluf(hi2f(g2.x)),
                 (ao[0][nt][2] - mu) * rs * w4.z * siluf(lo2f(g2.y)), (ao[0][nt][3] - mu) * rs * w4.w * siluf(hi2f(g2.y)));
      }
    }
  } else {
    const float Dh = p.d_ssm[h];
    bf16_t* zy = (bf16_t*)(p.ws + OFF_A) + (size_t)row * 3200 + h * 64;
    float s2 = 0.f;
    if (valid) {
#pragma unroll
      for (int nt = 0; nt < NTP; ++nt) {
        const int pp = nt * 16 + sq4;
        const uint2 x2 = *(const uint2*)(src + (size_t)row * ld + vcol + pp);
        const uint2 z2 = *(const uint2*)(zy + pp);
        const float y0 = (ao[0][nt][0] + fi * ai[0][nt][0] + Dh * lo2f(x2.x)) * siluf(lo2f(z2.x));
        const float y1 = (ao[0][nt][1] + fi * ai[0][nt][1] + Dh * hi2f(x2.x)) * siluf(hi2f(z2.x));
        const float y2 = (ao[0][nt][2] + fi * ai[0][nt][2] + Dh * lo2f(x2.y)) * siluf(lo2f(z2.y));
        const float y3 = (ao[0][nt][3] + fi * ai[0][nt][3] + Dh * hi2f(x2.y)) * siluf(hi2f(z2.y));
        s2 += y0 * y0 + y1 * y1 + y2 * y2 + y3 * y3;
        store4bf(zy + pp, y0, y1, y2, y3);
      }
    }
    s2 += shx(s2, 16); s2 += shx(s2, 32);
    if (valid && lane < 16) atomicAdd((float*)(p.ws + OFF_SSDST) + (size_t)row * 2 + (h >> 3), s2);
  }
  __syncthreads();
}

template <int OUT>
__device__ __forceinline__ void s5_unit(const Params& p, int c, int gq, char* smem, int wvs) {
  float* Uf = (float*)smem;
  bf16_t* HSall = (bf16_t*)(smem + 16384);
  bf16_t* CMall = (bf16_t*)(smem + 16384 + 34816);
  int tid_ = TIDX(wvs) & 255; asm volatile("" : "+v"(tid_)); const int tid = tid_, lane = tid & 63, wave = tid >> 6;
  int row0, L; chunk_geom(c, row0, L);
  const bf16_t* proj = (const bf16_t*)(p.ws + OFF_A);
#pragma unroll
  for (int i = 0; i < 2; ++i) {
    const int id = tid + i * 256, s = id >> 3, c8 = id & 7;
    uint4 v = make_uint4(0, 0, 0, 0);
    if (s < L) v = *(const uint4*)(proj + (size_t)(row0 + s) * 3200 + 2576 + gq * 64 + c8 * 8);
    float* d = Uf + s * 64 + c8 * 8;
    d[0] = lo2f(v.x); d[1] = hi2f(v.x); d[2] = lo2f(v.y); d[3] = hi2f(v.y); d[4] = lo2f(v.z); d[5] = hi2f(v.z); d[6] = lo2f(v.w); d[7] = hi2f(v.w);
  }
  const int g = gq * 4 + wave, gp = g * 64 + lane;
  const float* tab = (const float*)(p.ws + OFF_S5TAB);
  const float lr = tab[gp], li = tab[2048 + gp];
  float bbr[16], bbi[16];
#pragma unroll
  for (int q = 0; q < 4; ++q) {
    const float4 a = *(const float4*)(tab + 4096 + gp * 16 + q * 4), b = *(const float4*)(tab + 4096 + 32768 + gp * 16 + q * 4);
    bbr[q * 4] = a.x; bbr[q * 4 + 1] = a.y; bbr[q * 4 + 2] = a.z; bbr[q * 4 + 3] = a.w;
    bbi[q * 4] = b.x; bbi[q * 4 + 1] = b.y; bbi[q * 4 + 2] = b.z; bbi[q * 4 + 3] = b.w;
  }
  float hr = 0.f, hi = 0.f;
  bf16_t* HS = HSall + wave * 32 * 136; bf16_t* CM = CMall + wave * 16 * 136;
  if (OUT) {
    const float2 h0 = *(const float2*)((const float*)(p.ws + OFF_S5H) + ((size_t)c * 2048 + gp) * 2);
    hr = h0.x; hi = h0.y;
#pragma unroll
    for (int ch = 0; ch < 16; ++ch) { CM[ch * 136 + lane] = f2bf(p.s5_c_re[(g * 16 + ch) * 64 + lane]); CM[ch * 136 + 64 + lane] = f2bf(-p.s5_c_im[(g * 16 + ch) * 64 + lane]); }
  }
  __syncthreads();
  const int nhalf = OUT ? ((L + 31) >> 5) : 1, tl = OUT ? 32 : 64;
  for (int hf = 0; hf < nhalf; ++hf) {
    for (int tt = 0; tt < tl; ++tt) {
      const int t = hf * 32 + tt;
      if (t < L) {
        const float* up = Uf + t * 64 + wave * 16;
        float bur = 0.f, bui = 0.f;
#pragma unroll
        for (int q = 0; q < 4; ++q) {
          const float4 u4 = *(const float4*)(up + q * 4);
          bur += bbr[q * 4] * u4.x + bbr[q * 4 + 1] * u4.y + bbr[q * 4 + 2] * u4.z + bbr[q * 4 + 3] * u4.w;
          bui += bbi[q * 4] * u4.x + bbi[q * 4 + 1] * u4.y + bbi[q * 4 + 2] * u4.z + bbi[q * 4 + 3] * u4.w;
        }
        const float nr = lr * hr - li * hi + bur, ni = lr * hi + li * hr + bui;
        hr = nr; hi = ni;
      }
      if (OUT) { HS[tt * 136 + lane] = f2bf(t < L ? hr : 0.f); HS[tt * 136 + 64 + lane] = f2bf(t < L ? hi : 0.f); }
    }
    if (OUT) {
      __syncthreads();
      f32x4 ay[2][1];
      ay[0][0] = (f32x4){0.f, 0.f, 0.f, 0.f}; ay[1][0] = (f32x4){0.f, 0.f, 0.f, 0.f};
      wmma_sw<2, 1>(ay, HS, 136, CM, 136, 128, lane);
      bf16_t* gbuf = (bf16_t*)(p.ws + OFF_GBUF);
#pragma unroll
      for (int mt = 0; mt < 2; ++mt) {
        const int t = hf * 32 + mt * 16 + (lane & 15), ch0 = (lane >> 4) * 4;
        if (t < L) {
          const float4 u4 = *(const float4*)(Uf + t * 64 + wave * 16 + ch0);
          const float4 d4 = *(const float4*)(p.s5_d + g * 16 + ch0);
          float y[4] = {ay[mt][0][0] + d4.x * u4.x, ay[mt][0][1] + d4.y * u4.y, ay[mt][0][2] + d4.z * u4.z, ay[mt][0][3] + d4.w * u4.w};
#pragma unroll
          for (int j = 0; j < 4; ++j) { const float x = y[j], uu = 0.7978845608028654f * (x + 0.044715f * x * x * x); y[j] = x / (1.f + __expf(-2.f * uu)); }
          store4bf(gbuf + (size_t)(row0 + t) * 512 + g * 16 + ch0, y[0], y[1], y[2], y[3]);
        }
      }
      __syncthreads();
    }
  }
  if (!OUT) { *(float2*)((float*)(p.ws + OFF_S5E) + ((size_t)c * 2048 + gp) * 2) = make_float2(hr, hi); }
  __syncthreads();
}

__device__ __forceinline__ void s5_prefix(const Params& p, int gt) {
  const int sq = gt >> 11, rem = gt & 2047;
  const float* tab = (const float*)(p.ws + OFF_S5TAB);
  const float* e = (const float*)(p.ws + OFF_S5E);
  float* hs = (float*)(p.ws + OFF_S5H);
  float hr = 0.f, hi = 0.f;
  if (sq < 8) {
    const float lr = tab[69632 + rem], li = tab[71680 + rem];
    for (int n = 0; n < 32; ++n) {
      const size_t idx = ((size_t)(sq * 32 + n) * 2048 + rem) * 2;
      *(float2*)(hs + idx) = make_float2(hr, hi);
      const float2 ev = *(const float2*)(e + idx);
      const float nr = lr * hr - li * hi + ev.x, ni = lr * hi + li * hr + ev.y; hr = nr; hi = ni;
    }
  } else {
    const float lr = tab[73728 + rem], li = tab[75776 + rem];
    hr = p.state_s5_re[(size_t)(sq - 8) * 2048 + rem]; hi = p.state_s5_im[(size_t)(sq - 8) * 2048 + rem];
    const size_t idx = ((size_t)(256 + sq - 8) * 2048 + rem) * 2;
    *(float2*)(hs + idx) = make_float2(hr, hi);
    const float2 ev = *(const float2*)(e + idx);
    const float nr = lr * hr - li * hi + ev.x, ni = lr * hi + li * hr + ev.y; hr = nr; hi = ni;
  }
  p.out[O_S5RE + (size_t)sq * 2048 + rem] = hr;
  p.out[O_S5IM + (size_t)sq * 2048 + rem] = hi;
}

__device__ __forceinline__ void conv_phase(const Params& p, int wvs) {
  const bf16_t* proj = (const bf16_t*)(p.ws + OFF_A);
  bf16_t* xc = (bf16_t*)(p.ws + OFF_H);
  int tq_ = TIDX(wvs); asm volatile("" : "+v"(tq_)); const int gt = blockIdx.x * NTHR + tq_, nt = gridDim.x * NTHR;
  for (int it = gt; it < ROWS * 192; it += nt) {
    const int row = it / 192, c = (it % 192) * 8;
    int t, T, sq;
    if (row < 16384) { t = row & 2047; T = 2048; sq = row >> 11; } else { t = (row - 16384) & 7; T = 8; sq = 8 + ((row - 16384) >> 3); }
    float a[8];
    { const float4 b0 = *(const float4*)(p.conv_b + c), b1 = *(const float4*)(p.conv_b + c + 4); a[0] = b0.x; a[1] = b0.y; a[2] = b0.z; a[3] = b0.w; a[4] = b1.x; a[5] = b1.y; a[6] = b1.z; a[7] = b1.w; }
    float cur[8];
#pragma unroll
    for (int j = 0; j < 4; ++j) {
      const int tt = t - 3 + j;
      float x[8];
      if (tt >= 0) {
        const uint4 v = *(const uint4*)(proj + (size_t)(row - 3 + j) * 3200 + 1024 + c);
        x[0] = lo2f(v.x); x[1] = hi2f(v.x); x[2] = lo2f(v.y); x[3] = hi2f(v.y); x[4] = lo2f(v.z); x[5] = hi2f(v.z); x[6] = lo2f(v.w); x[7] = hi2f(v.w);
      } else if (sq >= 8) {
        const float* sc = p.state_conv + ((size_t)(sq - 8) * 3 + (3 + tt)) * 1536 + c;
        const float4 v0 = *(const float4*)sc, v1 = *(const float4*)(sc + 4);
        x[0] = v0.x; x[1] = v0.y; x[2] = v0.z; x[3] = v0.w; x[4] = v1.x; x[5] = v1.y; x[6] = v1.z; x[7] = v1.w;
      } else {
#pragma unroll
        for (int e = 0; e < 8; ++e) x[e] = 0.f;
      }
      const float4 w0 = *(const float4*)(p.conv_w + j * 1536 + c), w1 = *(const float4*)(p.conv_w + j * 1536 + c + 4);
      a[0] += w0.x * x[0]; a[1] += w0.y * x[1]; a[2] += w0.z * x[2]; a[3] += w0.w * x[3]; a[4] += w1.x * x[4]; a[5] += w1.y * x[5]; a[6] += w1.z * x[6]; a[7] += w1.w * x[7];
      if (j == 3) {
#pragma unroll
        for (int e = 0; e < 8; ++e) cur[e] = x[e];
      }
    }
    uint4 o; o.x = pack2(siluf(a[0]), siluf(a[1])); o.y = pack2(siluf(a[2]), siluf(a[3])); o.z = pack2(siluf(a[4]), siluf(a[5])); o.w = pack2(siluf(a[6]), siluf(a[7]));
    *(uint4*)(xc + (size_t)row * 1536 + c) = o;
    if (t >= T - 3) {
      float* d = p.out + O_CONV + ((size_t)sq * 3 + (t - (T - 3))) * 1536 + c;
      *(float4*)d = make_float4(cur[0], cur[1], cur[2], cur[3]); *(float4*)(d + 4) = make_float4(cur[4], cur[5], cur[6], cur[7]);
    }
  }
}

__device__ __forceinline__ void ssdnorm_phase(const Params& p, int wvs) {
  const bf16_t* proj = (const bf16_t*)(p.ws + OFF_A);
  bf16_t* mix = (bf16_t*)(p.ws + OFF_H);
  const float* st = (const float*)(p.ws + OFF_SSDST);
  int tq_ = TIDX(wvs); asm volatile("" : "+v"(tq_)); const int gt = blockIdx.x * NTHR + tq_, nt = gridDim.x * NTHR;
  for (int it = gt; it < ROWS * 128; it += nt) {
    const int row = it >> 7, c = (it & 127) * 8;
    const float r = rsqrtf(st[(size_t)row * 2 + (c >> 9)] * (1.f / 512.f) + EPSV);
    const uint4 v = *(const uint4*)(proj + (size_t)row * 3200 + c);
    const float4 w0 = *(const float4*)(p.ssm_norm_w + c), w1 = *(const float4*)(p.ssm_norm_w + c + 4);
    uint4 o; o.x = pack2(lo2f(v.x) * r * w0.x, hi2f(v.x) * r * w0.y); o.y = pack2(lo2f(v.y) * r * w0.z, hi2f(v.y) * r * w0.w);
    o.z = pack2(lo2f(v.z) * r * w1.x, hi2f(v.z) * r * w1.y); o.w = pack2(lo2f(v.w) * r * w1.z, hi2f(v.w) * r * w1.w);
    *(uint4*)(mix + (size_t)row * 1536 + c) = o;
  }
}


#define XB_TMO      128
#define XB_XCNT(j)  (256  + 64 * (j))
#define XB_XSUB(j)  (1280 + 64 * (j))
#define XB_XGEN(j)  (2304 + 64 * (j))
#define XB_TOP      3328
#define XB_TOPGEN   3392
#define XCD_BAR_WORDS 3456
#define XB_SPIN_CAP (1u << 18)
#define LAS __attribute__((address_space(3)))
__device__ __forceinline__ unsigned xb_ld(unsigned* p)              { return __hip_atomic_load(p, __ATOMIC_RELAXED, __HIP_MEMORY_SCOPE_AGENT); }
__device__ __forceinline__ unsigned xb_add(unsigned* p, unsigned v) { return __hip_atomic_fetch_add(p, v, __ATOMIC_RELAXED, __HIP_MEMORY_SCOPE_AGENT); }
__device__ __forceinline__ unsigned xb_xcc_id() { return (unsigned)__builtin_amdgcn_s_getreg((3 << 11) | 20) & 0xFu; }
#define XB_SPIN(cond, bar) do { unsigned _sp = 0; while (cond) { __builtin_amdgcn_s_sleep(1); \
    if ((++_sp & 255u) == 0u) { if (xb_ld(&(bar)[XB_TMO])) break; if (_sp > XB_SPIN_CAP) { atomicAdd(&(bar)[XB_TMO], 1u); break; } } } } while (0)
struct XcdBarrier { unsigned* bar; unsigned x; volatile LAS unsigned* st; };
__device__ __forceinline__ XcdBarrier xcd_barrier_post(unsigned* bar, volatile LAS unsigned* st, int wvs) {
    XcdBarrier b; b.bar = bar; b.x = xb_xcc_id(); b.st = st;
    if (TIDX(wvs) == 0) (void)xb_add(&bar[XB_XCNT(b.x)], 1u);
    return b;
}
__device__ __forceinline__ void xcd_barrier_complete(unsigned* bar, unsigned x, unsigned& nloc, unsigned& nx) {
    const unsigned G = gridDim.x * gridDim.y * gridDim.z;
    unsigned sum, cnt, mine, sp = 0u;
    for (;;) {
        sum = 0u; cnt = 0u; mine = 0u;
#pragma unroll
        for (unsigned j = 0; j < 16; ++j) { const unsigned c = xb_ld(&bar[XB_XCNT(j)]); sum += c; cnt += (c > 0u) ? 1u : 0u; mine = (j == x) ? c : mine; }
        if (sum == G) break;
        __builtin_amdgcn_s_sleep(1);
        if ((++sp & 255u) == 0u) { if (xb_ld(&bar[XB_TMO])) break; if (sp > XB_SPIN_CAP) { atomicAdd(&bar[XB_TMO], 1u); break; } }
    }
    nloc = mine > 0u ? mine : 1u; nx = cnt > 0u ? cnt : 1u;
}
__device__ __forceinline__ void xcd_barrier(const XcdBarrier& b, int wvs) {
    asm volatile("s_waitcnt vmcnt(0)" ::: "memory");
    __syncthreads();
    if (TIDX(wvs) == 0) {
        unsigned* bar = b.bar;
        __builtin_amdgcn_s_waitcnt(0);
        unsigned nloc = b.st[0], nx = b.st[1];
        if (nloc == 0u) { xcd_barrier_complete(bar, b.x, nloc, nx); b.st[0] = nloc; b.st[1] = nx; }
        const unsigned old = xb_add(&bar[XB_XSUB(b.x)], 1u);
        const unsigned gen = old / nloc;
        if (old + 1u == (gen + 1u) * nloc) {
            __builtin_amdgcn_fence(__ATOMIC_RELEASE, "agent");
            asm volatile("s_waitcnt vmcnt(0)" ::: "memory");
            const unsigned og = xb_add(&bar[XB_TOP], 1u);
            const unsigned tg = og / nx;
            if (og + 1u == (tg + 1u) * nx) xb_add(&bar[XB_TOPGEN], 1u);
            else XB_SPIN(xb_ld(&bar[XB_TOPGEN]) == tg, bar);
            __builtin_amdgcn_fence(__ATOMIC_ACQUIRE, "agent");
            xb_add(&bar[XB_XGEN(b.x)], 1u);
            asm volatile("s_waitcnt vmcnt(0)" ::: "memory");
        } else {
            XB_SPIN(xb_ld(&bar[XB_XGEN(b.x)]) == gen, bar);
            __builtin_amdgcn_fence(__ATOMIC_ACQUIRE, "agent");
            asm volatile("s_waitcnt vmcnt(0)" ::: "memory");
        }
    }
    __syncthreads();
}


__device__ __forceinline__ Params ldp() {
  auto kp = __builtin_amdgcn_kernarg_segment_ptr();
  asm volatile("" : "+s"(kp));
  Params q;
  __builtin_memcpy(&q, (const void*)kp, sizeof(Params));
  return q;
}

__global__ void __launch_bounds__(NTHR, 2) fwd_megakernel(Params p_) {
  extern __shared__ __attribute__((aligned(16))) char smem[];
  cg::grid_group grid = cg::this_grid();
  if (p_.ws == nullptr) grid.sync();
  volatile LAS unsigned* xst = (volatile LAS unsigned*)(smem + 2 * HALF_LDS);
  const int wvs = __builtin_amdgcn_readfirstlane(threadIdx.x >> 6);
  if (TIDX(wvs) == 0) { xst[0] = 0u; xst[1] = 0u; xst[2] = 0u; xst[3] = 0u; }
  __syncthreads();
  const XcdBarrier xb = xcd_barrier_post((unsigned*)(p_.ws + OFF_BAR), xst, wvs);
  const int half = wvs >> 2;
  const int G = gridDim.x * 2, bid = blockIdx.x * 2 + half;
  char* hs = smem + half * HALF_LDS;
#define PH_BEGIN const Params p = ldp(); bf16_t* bufA = (bf16_t*)(p.ws + OFF_A); bf16_t* bufH = (bf16_t*)(p.ws + OFF_H); bf16_t* t0 = (bf16_t*)(p.ws + OFF_ST); \
    float* rowss = (float*)(p.ws + OFF_ROWSS); float* hbuf = p.out; (void)bufA; (void)bufH; (void)t0; (void)rowss; (void)hbuf;

  {
  PH_BEGIN
  prep_tables(p, wvs);
  wconv(p.w_in_even, 1024, 4096, 4096, (bf16_t*)(p.ws + W_IN), hs, wvs);
  wconv(p.w_out_even, 1024, 1024, 1024, (bf16_t*)(p.ws + W_OUT0), hs, wvs);
  wconv(p.w_ffn_up, 1024, 4096, 4096, (bf16_t*)(p.ws + W_UP), hs, wvs);
  wconv(p.w_ffn_down, 4096, 1024, 1024, (bf16_t*)(p.ws + W_DOWN), hs, wvs);
  rowpass_phase(nullptr, nullptr, nullptr, p.x_prompt, p.x_sample, nullptr, p.norm_mix_pre, bufH, wvs);
  }
  xcd_barrier(xb, wvs);
  {
  PH_BEGIN
  { EpiInEven e{bufA, (const float*)(p.ws + OFF_ROPE), (const float*)(p.ws + OFF_LB)};
    for (int rep_ = 0; rep_ < REPG; ++rep_) { gemm_phase(bufH, 1024, (const bf16_t*)(p.ws + W_IN), 1024, 64, 16, 1024, e, smem, wvs); gemm_tail(bufH, 1024, (const bf16_t*)(p.ws + W_IN), 1024, 32, 1024, e, smem, wvs, 64 * 16); } }
  }
  xcd_barrier(xb, wvs);
  {
  PH_BEGIN
  for (int rep_ = 0; rep_ < REPS; ++rep_) {
    if (bid < 256) {
      const int v = bid;
      const int ps = v & 3, m = (v >> 2) & 1, h = (v >> 3) & 3, sq = v >> 5;
      if (m == 0) state_unit<0>(p, sq, h, ps, hs, wvs); else state_unit<1>(p, sq, h, ps, hs, wvs);
    }
    const int nsh = bid < 256 ? 2 : 14, j0 = bid < 256 ? bid : 512 + (bid - 256);
    for (int i = 0; i < nsh; ++i) {
      const int v = j0 + 256 * i;
      const int ps = v & 3, m = (v >> 2) & 1, h = (v >> 3) & 3, sq = 8 + (v >> 5);
      if (m == 0) state_unit<0>(p, sq, h, ps, hs, wvs); else state_unit<1>(p, sq, h, ps, hs, wvs);
    }
  }
  }
  xcd_barrier(xb, wvs);
  {
  PH_BEGIN
  for (int rep_ = 0; rep_ < REPO; ++rep_)
  for (int u = bid; u < 384 * 8; u += G) {
    const int h = u & 3, m = (u >> 2) & 1, c = u >> 3;
    if (m == 0) out_unit<0>(p, c, h, hs, wvs); else out_unit<1>(p, c, h, hs, wvs);
  }
  }
  xcd_barrier(xb, wvs);
  {
  PH_BEGIN
  { EpiOut e{t0, rowss};
    for (int rep_ = 0; rep_ < REPG; ++rep_) { gemm_phase(bufH, 1024, (const bf16_t*)(p.ws + W_OUT0), 1024, 64, 4, 1024, e, smem, wvs); gemm_tail(bufH, 1024, (const bf16_t*)(p.ws + W_OUT0), 1024, 8, 1024, e, smem, wvs, 64 * 4); } }
  }
  xcd_barrier(xb, wvs);
  {
  PH_BEGIN
  for (int rep_ = 0; rep_ < REPR; ++rep_)
  rowpass_phase(t0, rowss, p.norm_mix_post, p.x_prompt, p.x_sample, hbuf, p.norm_ffn_pre, bufH, wvs);
  }
  xcd_barrier(xb, wvs);
  {
  PH_BEGIN
  { EpiUp e{bufA}; for (int rep_ = 0; rep_ < REPG; ++rep_) { gemm_phase(bufH, 1024, (const bf16_t*)(p.ws + W_UP), 1024, 64, 16, 1024, e, smem, wvs); gemm_tail(bufH, 1024, (const bf16_t*)(p.ws + W_UP), 1024, 32, 1024, e, smem, wvs, 64 * 16); } }
  }
  xcd_barrier(xb, wvs);
  {
  PH_BEGIN
  { EpiOut e{t0, rowss + ROWS}; for (int rep_ = 0; rep_ < REPG; ++rep_) { gemm_phase(bufA, 4096, (const bf16_t*)(p.ws + W_DOWN), 4096, 64, 4, 4096, e, smem, wvs); gemm_tail(bufA, 4096, (const bf16_t*)(p.ws + W_DOWN), 4096, 8, 4096, e, smem, wvs, 64 * 4); } }
  }
  xcd_barrier(xb, wvs);
  {
  PH_BEGIN
  rowpass_phase(t0, rowss + ROWS, p.norm_ffn_post, hbuf, hbuf + (size_t)16384 * 1024, hbuf, p.norm_mix_pre + 1024, bufH, wvs);
  wconv(p.w_in_odd, 1024, 3088, 3328, (bf16_t*)(p.ws + W_IN), hs, wvs);
  wconv(p.w_glu, 512, 512, 512, (bf16_t*)(p.ws + W_GLU), hs, wvs);
  wconv(p.w_out_odd, 1536, 1024, 1024, (bf16_t*)(p.ws + W_OUT1), hs, wvs);
  wconv(p.w_ffn_up + (size_t)1024 * 4096, 1024, 4096, 4096, (bf16_t*)(p.ws + W_UP), hs, wvs);
  wconv(p.w_ffn_down + (size_t)4096 * 1024, 4096, 1024, 1024, (bf16_t*)(p.ws + W_DOWN), hs, wvs);
  }
  xcd_barrier(xb, wvs);
  {
  PH_BEGIN
  { EpiInOdd e{bufA, (float*)(p.ws + OFF_DTBUF)};
    for (int rep_ = 0; rep_ < REPG; ++rep_) { gemm_phase(bufH, 1024, (const bf16_t*)(p.ws + W_IN), 1024, 64, 13, 1024, e, smem, wvs); gemm_tail(bufH, 1024, (const bf16_t*)(p.ws + W_IN), 1024, 26, 1024, e, smem, wvs, 64 * 13); } }
  }
  xcd_barrier(xb, wvs);
  {
  PH_BEGIN
  for (int rep_ = 0; rep_ < REPC; ++rep_) {
  conv_phase(p, wvs);
  for (int u = bid; u < 384 * 8; u += G) s5_unit<0>(p, u >> 3, u & 7, hs, wvs);
  }
  }
  xcd_barrier(xb, wvs);
  {
  PH_BEGIN
  for (int rep_ = 0; rep_ < REPS; ++rep_) {
    if (bid < 128) state_unit<2>(p, bid >> 4, bid & 15, 0, hs, wvs);
    for (int j = bid < 128 ? bid : 256 + (bid - 128); j < 3136; j += (bid < 128 ? 128 : 384)) {
      if (bid < 128 && j >= 256) break;
      if (j < 1088) { int tq_ = TIDX(wvs) & 255; asm volatile("" : "+v"(tq_)); s5_prefix(p, j * 256 + tq_); }
      else { const int v = j - 1088; state_unit<2>(p, 8 + (v >> 4), v & 15, 0, hs, wvs); }
    }
  }
  }
  xcd_barrier(xb, wvs);
  {
  PH_BEGIN
  for (int u = bid; u < 384 * 16 + 384 * 8; u += G) {
    if (u < 384 * 16) out_unit<2>(p, u >> 4, u & 15, hs, wvs);
    else { const int v = u - 384 * 16; s5_unit<1>(p, v >> 3, v & 7, hs, wvs); }
  }
  }
  xcd_barrier(xb, wvs);
  {
  PH_BEGIN
  ssdnorm_phase(p, wvs);
  { EpiGlu e{(const bf16_t*)(p.ws + OFF_GBUF), p.b_glu, bufH};
    for (int rep_ = 0; rep_ < REPG; ++rep_) { gemm_phase((const bf16_t*)(p.ws + OFF_GBUF), 512, (const bf16_t*)(p.ws + W_GLU), 512, 64, 2, 512, e, smem, wvs); gemm_tail((const bf16_t*)(p.ws + OFF_GBUF), 512, (const bf16_t*)(p.ws + W_GLU), 512, 4, 512, e, smem, wvs, 64 * 2); } }
  }
  xcd_barrier(xb, wvs);
  {
  PH_BEGIN
  { EpiOut e{t0, rowss + 2 * ROWS}; for (int rep_ = 0; rep_ < REPG; ++rep_) { gemm_phase(bufH, 1536, (const bf16_t*)(p.ws + W_OUT1), 1536, 64, 4, 1536, e, smem, wvs); gemm_tail(bufH, 1536, (const bf16_t*)(p.ws + W_OUT1), 1536, 8, 1536, e, smem, wvs, 64 * 4); } }
  }
  xcd_barrier(xb, wvs);
  {
  PH_BEGIN
  rowpass_phase(t0, rowss + 2 * ROWS, p.norm_mix_post + 1024, hbuf, hbuf + (size_t)16384 * 1024, hbuf, p.norm_ffn_pre + 1024, bufH, wvs);
  }
  xcd_barrier(xb, wvs);
  {
  PH_BEGIN
  { EpiUp e{bufA}; for (int rep_ = 0; rep_ < REPG; ++rep_) { gemm_phase(bufH, 1024, (const bf16_t*)(p.ws + W_UP), 1024, 64, 16, 1024, e, smem, wvs); gemm_tail(bufH, 1024, (const bf16_t*)(p.ws + W_UP), 1024, 32, 1024, e, smem, wvs, 64 * 16); } }
  }
  xcd_barrier(xb, wvs);
  {
  PH_BEGIN
  { EpiOut e{t0, rowss + 3 * ROWS}; for (int rep_ = 0; rep_ < REPG; ++rep_) { gemm_phase(bufA, 4096, (const bf16_t*)(p.ws + W_DOWN), 4096, 64, 4, 4096, e, smem, wvs); gemm_tail(bufA, 4096, (const bf16_t*)(p.ws + W_DOWN), 4096, 8, 4096, e, smem, wvs, 64 * 4); } }
  }
  xcd_barrier(xb, wvs);
  {
  PH_BEGIN
  rowpass_phase(t0, rowss + 3 * ROWS, p.norm_ffn_post + 1024, hbuf, hbuf + (size_t)16384 * 1024, hbuf, nullptr, nullptr, wvs);
  }
}

extern "C" void kernel_launch(void* const* d_in, const int* in_sizes, int n_in, void* d_out, int out_size, void* d_ws, size_t ws_size, hipStream_t stream) {
  constexpr size_t kDynLds = 2 * HALF_LDS + 64;
  static int grid_blocks = 0;
  if (!grid_blocks) {
    int dev = 0, cus = 0, per_cu = 0;
    (void)hipGetDevice(&dev);
    (void)hipDeviceGetAttribute(&cus, hipDeviceAttributeMultiprocessorCount, dev);
    (void)hipFuncSetAttribute((const void*)fwd_megakernel, hipFuncAttributeMaxDynamicSharedMemorySize, (int)kDynLds);
    (void)hipOccupancyMaxActiveBlocksPerMultiprocessor(&per_cu, fwd_megakernel, NTHR, kDynLds);
    if (per_cu > 1) per_cu = 1;
    if (per_cu < 1) per_cu = 1;
    grid_blocks = cus * per_cu;
  }
  Params p{};
  const float** pf = (const float**)&p;
  for (int i = 0; i < 37; ++i) pf[i] = (const float*)d_in[i];
  p.out = (float*)d_out;
  p.ws = (char*)d_ws;
  (void)hipMemsetAsync((char*)d_ws + OFF_BAR, 0, 16384, stream);
  void* args[] = {&p};
  hipError_t e = hipLaunchCooperativeKernel((void*)fwd_megakernel, dim3(grid_blocks), dim3(NTHR), args, kDynLds, stream);
  if (e != hipSuccess) fprintf(stderr, "cooperative launch failed: %s (grid %d)\n", hipGetErrorString(e), grid_blocks);
}
```

```cpp
#include <hip/hip_runtime.h>
#include <hip/hip_cooperative_groups.h>
#include <cstdio>
namespace cg = cooperative_groups;

typedef unsigned short bf16_t;
typedef short bf16x8 __attribute__((ext_vector_type(8)));
typedef float f32x4 __attribute__((ext_vector_type(4)));
typedef unsigned u32x4 __attribute__((ext_vector_type(4)));
typedef float f32x2 __attribute__((ext_vector_type(2)));

#define NTHR 512
#ifndef REPS
#define REPS 1
#endif
#ifndef REPO
#define REPO 1
#endif
#ifndef REPC
#define REPC 1
#endif
#ifndef REPR
#define REPR 1
#endif
#ifndef REPG
#define REPG 1
#endif
#define HALF_LDS 73728
#ifndef REP0
#define REP0 1
#endif
#ifndef REPS
#define REPS 1
#endif
#ifndef REPO
#define REPO 1
#endif
#ifndef REPC
#define REPC 1
#endif
#ifndef REPY
#define REPY 21
#endif
#define ROWS 17408
#define EPSV 1e-6f
#define TIDX(w) ((w) * 64 + (int)__builtin_amdgcn_mbcnt_hi(~0u, __builtin_amdgcn_mbcnt_lo(~0u, 0u)))

constexpr size_t W_IN = 0;
constexpr size_t W_OUT0 = 8388608;
constexpr size_t W_GLU = 6815744;
constexpr size_t W_OUT1 = 7340032;
constexpr size_t W_UP = 10485760;
constexpr size_t W_DOWN = 18874368;
constexpr size_t OFF_A = 29360128;
constexpr size_t OFF_GBUF = OFF_A + 111411200;
constexpr size_t OFF_ST = OFF_A + 142606336;
constexpr size_t OFF_H = OFF_ST + 67108864;
constexpr size_t OFF_SM = OFF_H + 53477376;
constexpr size_t OFF_ROPE = OFF_SM;
constexpr size_t OFF_ROWSS = OFF_SM + 1052672;
constexpr size_t OFF_SSDST = OFF_SM + 1331200;
constexpr size_t OFF_DTBUF = OFF_SM + 1470464;
constexpr size_t OFF_LB = OFF_SM + 2584576;
constexpr size_t OFF_S5TAB = OFF_SM + 2586624;
constexpr size_t OFF_S5E = OFF_SM + 2897920;
constexpr size_t OFF_S5H = OFF_SM + 9189376;
constexpr size_t OFF_BAR = OFF_SM + 15480832;

constexpr size_t O_RET = 17825792, O_HG = 26738688, O_SSM = 35651584, O_CONV = 53477376, O_S5RE = 54104064, O_S5IM = 54382592;

struct Params {
  const float *x_prompt, *x_sample, *state_ret, *state_hgrn, *state_ssm, *state_conv, *state_s5_re, *state_s5_im;
  const float *norm_mix_pre, *norm_mix_post, *norm_ffn_pre, *norm_ffn_post;
  const float *w_in_even, *w_out_even, *ret_norm_w, *hgrn_lb, *hgrn_norm_w, *w_in_odd, *conv_w, *conv_b, *dt_bias, *a_log, *d_ssm, *ssm_norm_w;
  const float *s5_lam_re, *s5_lam_im, *s5_log_step, *s5_b_re, *s5_b_im, *s5_c_re, *s5_c_im, *s5_d, *w_glu, *b_glu, *w_out_odd, *w_ffn_up, *w_ffn_down;
  float* out;
  char* ws;
};

__device__ __forceinline__ bf16_t f2bf(float f) { unsigned r; asm("v_cvt_pk_bf16_f32 %0, %1, %1" : "=v"(r) : "v"(f)); return (bf16_t)(r & 0xffffu); }
__device__ __forceinline__ float bf2f(bf16_t h) { return __uint_as_float(((unsigned)h) << 16); }
__device__ __forceinline__ unsigned pack2(float a, float b) { unsigned r; asm("v_cvt_pk_bf16_f32 %0, %1, %2" : "=v"(r) : "v"(a), "v"(b)); return r; }
__device__ __forceinline__ float lo2f(unsigned u) { return __uint_as_float(u << 16); }
__device__ __forceinline__ float hi2f(unsigned u) { return __uint_as_float(u & 0xffff0000u); }
__device__ __forceinline__ float sigm(float x) { return 1.f / (1.f + __expf(-x)); }
__device__ __forceinline__ float siluf(float x) { return x / (1.f + __expf(-x)); }
__device__ __forceinline__ void store4bf(bf16_t* p, float a, float b, float c, float d) { uint2 v; v.x = pack2(a, b); v.y = pack2(c, d); *(uint2*)p = v; }

__device__ __forceinline__ float shx(float v, int mask) {
  int l = (int)__builtin_amdgcn_mbcnt_hi(~0u, __builtin_amdgcn_mbcnt_lo(~0u, 0u));
  asm volatile("" : "+v"(l));
  return __int_as_float(__builtin_amdgcn_ds_bpermute((l ^ mask) << 2, __float_as_int(v)));
}

template <int MT, int NT>
__device__ __forceinline__ void wmma_sw(f32x4 (&acc)[MT][NT], const bf16_t* A, int lda, const bf16_t* B, int ldb, int K, int lane) {
  const int r = lane & 15, kq = (lane >> 4) * 8;
  for (int k0 = 0; k0 < K; k0 += 32) {
    bf16x8 af[MT], bfr[NT];
#pragma unroll
    for (int mt = 0; mt < MT; ++mt) af[mt] = *(const bf16x8*)(A + (mt * 16 + r) * lda + k0 + kq);
#pragma unroll
    for (int nt = 0; nt < NT; ++nt) bfr[nt] = *(const bf16x8*)(B + (nt * 16 + r) * ldb + k0 + kq);
#pragma unroll
    for (int mt = 0; mt < MT; ++mt)
#pragma unroll
      for (int nt = 0; nt < NT; ++nt) acc[mt][nt] = __builtin_amdgcn_mfma_f32_16x16x32_bf16(bfr[nt], af[mt], acc[mt][nt], 0, 0, 0);
  }
}
template <int MT, int NT>
__device__ __forceinline__ void wmma_ns(f32x4 (&acc)[MT][NT], const bf16_t* A, int lda, const bf16_t* B, int ldb, int K, int lane) {
  const int r = lane & 15, kq = (lane >> 4) * 8;
  for (int k0 = 0; k0 < K; k0 += 32) {
    bf16x8 af[MT], bfr[NT];
#pragma unroll
    for (int mt = 0; mt < MT; ++mt) af[mt] = *(const bf16x8*)(A + (mt * 16 + r) * lda + k0 + kq);
#pragma unroll
    for (int nt = 0; nt < NT; ++nt) bfr[nt] = *(const bf16x8*)(B + (nt * 16 + r) * ldb + k0 + kq);
#pragma unroll
    for (int mt = 0; mt < MT; ++mt)
#pragma unroll
      for (int nt = 0; nt < NT; ++nt) acc[mt][nt] = __builtin_amdgcn_mfma_f32_16x16x32_bf16(af[mt], bfr[nt], acc[mt][nt], 0, 0, 0);
  }
}

__device__ __forceinline__ void gemm_kstep(f32x4 (&acc)[4][8], const bf16_t* A, const bf16_t* B, int lane) {
  const int r = lane & 15, kq = (lane >> 4) * 8;
  bf16x8 af[4], bfr[8];
#pragma unroll
  for (int mt = 0; mt < 4; ++mt) af[mt] = *(const bf16x8*)(A + (mt * 16 + r) * 72 + kq);
#pragma unroll
  for (int nt = 0; nt < 8; ++nt) bfr[nt] = *(const bf16x8*)(B + (nt * 16 + r) * 72 + kq);
  __builtin_amdgcn_sched_barrier(0);
#pragma unroll
  for (int nt = 0; nt < 8; ++nt)
#pragma unroll
    for (int mt = 0; mt < 4; ++mt) acc[mt][nt] = __builtin_amdgcn_mfma_f32_16x16x32_bf16(bfr[nt], af[mt], acc[mt][nt], 0, 0, 0);
}

template <class Epi>
__device__ __forceinline__ void gemm_phase(const bf16_t* A, int lda, const bf16_t* Bt, int ldb, int nMt, int nNt, int K, const Epi& epi, char* smem, int wvs) {
  bf16_t* As = (bf16_t*)smem;
  bf16_t* Bs = As + 2 * 256 * 72;
  int tid_ = TIDX(wvs); asm volatile("" : "+v"(tid_)); const int tid = tid_, lane = tid & 63, wave = tid >> 6;
  const int wr = wave >> 1, wc = wave & 1;
  const int ntiles = nMt * nNt, nk = K >> 6;
  const int lrow = tid >> 3, lcc = (tid & 7) * 8;
  const unsigned toffA = (unsigned)(lrow * lda + lcc), toffB = (unsigned)(lrow * ldb + lcc);
  for (int tile = blockIdx.x; tile < ntiles; tile += gridDim.x) {
    const int pm = tile / nNt, pn = tile - pm * nNt;
    const bf16_t* Ab = A + (size_t)(pm * 256) * lda;
    const bf16_t* Bb = Bt + (size_t)(pn * 256) * ldb;
    f32x4 acc[4][8];
#pragma unroll
    for (int i = 0; i < 4; ++i)
#pragma unroll
      for (int j = 0; j < 8; ++j) acc[i][j] = (f32x4){0.f, 0.f, 0.f, 0.f};
    u32x4 rg[4];
#pragma unroll
    for (int i = 0; i < 4; ++i) rg[i] = *(const u32x4*)(Ab + (size_t)(i * 64) * lda + toffA);
#pragma unroll
    for (int i = 0; i < 4; ++i) *(u32x4*)(As + (lrow + i * 64) * 72 + lcc) = rg[i];
#pragma unroll
    for (int i = 0; i < 4; ++i) rg[i] = *(const u32x4*)(Bb + (size_t)(i * 64) * ldb + toffB);
#pragma unroll
    for (int i = 0; i < 4; ++i) *(u32x4*)(Bs + (lrow + i * 64) * 72 + lcc) = rg[i];
    __syncthreads();
#pragma unroll 1
    for (int kt = 0; kt < nk; ++kt) {
      const int cur = kt & 1;
      const int kn = (kt + 1 < nk ? kt + 1 : kt) * 64;
      bf16_t* Ad = As + (cur ^ 1) * 256 * 72; bf16_t* Bd = Bs + (cur ^ 1) * 256 * 72;
#pragma unroll
      for (int i = 0; i < 4; ++i) rg[i] = *(const u32x4*)(Ab + ((size_t)(i * 64) * lda + kn) + toffA);
      __builtin_amdgcn_sched_barrier(0);
      gemm_kstep(acc, As + cur * 256 * 72 + wr * 64 * 72, Bs + cur * 256 * 72 + wc * 128 * 72, lane);
      __builtin_amdgcn_sched_barrier(0);
#pragma unroll
      for (int i = 0; i < 4; ++i) *(u32x4*)(Ad + (lrow + i * 64) * 72 + lcc) = rg[i];
#pragma unroll
      for (int i = 0; i < 4; ++i) rg[i] = *(const u32x4*)(Bb + ((size_t)(i * 64) * ldb + kn) + toffB);
      __builtin_amdgcn_sched_barrier(0);
      gemm_kstep(acc, As + cur * 256 * 72 + wr * 64 * 72 + 32, Bs + cur * 256 * 72 + wc * 128 * 72 + 32, lane);
      __builtin_amdgcn_sched_barrier(0);
#pragma unroll
      for (int i = 0; i < 4; ++i) *(u32x4*)(Bd + (lrow + i * 64) * 72 + lcc) = rg[i];
      __syncthreads();
    }
    int er_ = pm * 256 + wr * 64, ec_ = pn * 256 + wc * 128, el_ = lane;
    asm volatile("" : "+v"(er_), "+v"(ec_), "+v"(el_));
    epi(acc, er_, ec_, el_);
  }
}

struct EpiInEven {
  bf16_t* proj; const float* rope; const float* lb;
  template <int MT> __device__ __forceinline__ void operator()(f32x4 (&acc)[MT][8], int rbase, int cbase, int lane) const {
    const int sec = cbase >> 9, head = (cbase >> 7) & 3, r = lane & 15, cq = (lane >> 4) * 4;
#pragma unroll
    for (int mt = 0; mt < MT; ++mt) {
      __builtin_amdgcn_sched_barrier(0);
      const int row = rbase + mt * 16 + r;
      bf16_t* dst = proj + (size_t)row * 4096 + cbase + cq;
      if (sec < 2) {
        const int pidx = row < 16384 ? (row & 2047) : 2048 + ((row - 16384) & 7);
        const float* ct = rope + pidx * 128 + cq;
        const float sc = sec == 1 ? 0.08838834764831845f : 1.f;
#pragma unroll
        for (int nt = 0; nt < 4; ++nt) {
          const float4 c4 = *(const float4*)(ct + nt * 16), s4 = *(const float4*)(ct + 64 + nt * 16);
          const f32x4 x1 = acc[mt][nt], x2 = acc[mt][nt + 4];
          store4bf(dst + nt * 16, (x1[0] * c4.x - x2[0] * s4.x) * sc, (x1[1] * c4.y - x2[1] * s4.y) * sc, (x1[2] * c4.z - x2[2] * s4.z) * sc, (x1[3] * c4.w - x2[3] * s4.w) * sc);
          store4bf(dst + 64 + nt * 16, (x1[0] * s4.x + x2[0] * c4.x) * sc, (x1[1] * s4.y + x2[1] * c4.y) * sc, (x1[2] * s4.z + x2[2] * c4.z) * sc, (x1[3] * s4.w + x2[3] * c4.w) * sc);
        }
      } else if (sec == 5) {
#pragma unroll
        for (int nt = 0; nt < 8; ++nt) {
          const float4 l4 = *(const float4*)(lb + head * 128 + nt * 16 + cq);
          const f32x4 x = acc[mt][nt];
          store4bf(dst + nt * 16, __logf(l4.x + (1.f - l4.x) * sigm(x[0])), __logf(l4.y + (1.f - l4.y) * sigm(x[1])), __logf(l4.z + (1.f - l4.z) * sigm(x[2])), __logf(l4.w + (1.f - l4.w) * sigm(x[3])));
        }
      } else {
#pragma unroll
        for (int nt = 0; nt < 8; ++nt) { const f32x4 x = acc[mt][nt]; store4bf(dst + nt * 16, x[0], x[1], x[2], x[3]); }
      }
    }
  }
};
struct EpiOut {
  bf16_t* t0; float* rowss;
  template <int MT> __device__ __forceinline__ void operator()(f32x4 (&acc)[MT][8], int rbase, int cbase, int lane) const {
    const int r = lane & 15, cq = (lane >> 4) * 4;
#pragma unroll
    for (int mt = 0; mt < MT; ++mt) {
      __builtin_amdgcn_sched_barrier(0);
      const int row = rbase + mt * 16 + r;
      bf16_t* dst = t0 + (size_t)row * 1024 + cbase + cq;
      float ss = 0.f;
#pragma unroll
      for (int nt = 0; nt < 8; ++nt) { const f32x4 x = acc[mt][nt]; ss += x[0] * x[0] + x[1] * x[1] + x[2] * x[2] + x[3] * x[3]; store4bf(dst + nt * 16, x[0], x[1], x[2], x[3]); }
      ss += shx(ss, 16); ss += shx(ss, 32);
      if (lane < 16) atomicAdd(rowss + row, ss * (1.f / REPG));
    }
  }
};
struct EpiUp {
  bf16_t* act;
  template <int MT> __device__ __forceinline__ void operator()(f32x4 (&acc)[MT][8], int rbase, int cbase, int lane) const {
    const int r = lane & 15, cq = (lane >> 4) * 4;
#pragma unroll
    for (int mt = 0; mt < MT; ++mt) {
      __builtin_amdgcn_sched_barrier(0);
      bf16_t* dst = act + (size_t)(rbase + mt * 16 + r) * 4096 + cbase + cq;
#pragma unroll
      for (int nt = 0; nt < 8; ++nt) { f32x4 x = acc[mt][nt];
#pragma unroll
        for (int j = 0; j < 4; ++j) { float v = fmaxf(x[j], 0.f); x[j] = v * v; }
        store4bf(dst + nt * 16, x[0], x[1], x[2], x[3]); }
    }
  }
};
struct EpiInOdd {
  bf16_t* proj; float* dtbuf;
  template <int MT> __device__ __forceinline__ void operator()(f32x4 (&acc)[MT][8], int rbase, int cbase, int lane) const {
    const int r = lane & 15, cq = (lane >> 4) * 4;
#pragma unroll
    for (int mt = 0; mt < MT; ++mt) {
      __builtin_amdgcn_sched_barrier(0);
      const int row = rbase + mt * 16 + r;
      bf16_t* dst = proj + (size_t)row * 3200 + cbase + cq;
#pragma unroll
      for (int nt = 0; nt < 8; ++nt) { const f32x4 x = acc[mt][nt]; if (cbase + nt * 16 < 3200) store4bf(dst + nt * 16, x[0], x[1], x[2], x[3]); }
      if (cbase == 2560) { const f32x4 x = acc[mt][0]; *(float4*)(dtbuf + (size_t)row * 16 + cq) = make_float4(x[0], x[1], x[2], x[3]); }
    }
  }
};
struct EpiGlu {
  const bf16_t* gbuf; const float* bglu; bf16_t* mix;
  template <int MT> __device__ __forceinline__ void operator()(f32x4 (&acc)[MT][8], int rbase, int cbase, int lane) const {
    const int r = lane & 15, cq = (lane >> 4) * 4;
#pragma unroll
    for (int mt = 0; mt < MT; ++mt) {
      __builtin_amdgcn_sched_barrier(0);
      const int row = rbase + mt * 16 + r;
#pragma unroll
      for (int nt = 0; nt < 8; ++nt) {
        const int col = cbase + nt * 16 + cq;
        const f32x4 x = acc[mt][nt];
        const uint2 g2 = *(const uint2*)(gbuf + (size_t)row * 512 + col);
        const float4 b4 = *(const float4*)(bglu + col);
        store4bf(mix + (size_t)row * 1536 + 1024 + col, lo2f(g2.x) * sigm(x[0] + b4.x), hi2f(g2.x) * sigm(x[1] + b4.y), lo2f(g2.y) * sigm(x[2] + b4.z), hi2f(g2.y) * sigm(x[3] + b4.w));
      }
    }
  }
};

template <class Epi>
__device__ __forceinline__ void gemm_tail(const bf16_t* A, int lda, const bf16_t* Bt, int ldb, int nNt128, int K, const Epi& epi, char* smem, int wvs, int nBig) {
  bf16_t* As = (bf16_t*)smem;
  bf16_t* Bs = As + 2 * 128 * 72;
  int tid_ = TIDX(wvs); asm volatile("" : "+v"(tid_)); const int tid = tid_, lane = tid & 63, wave = tid >> 6;
  const int nk = K >> 6, G = gridDim.x;
  const int lrow = tid >> 3, lcc = (tid & 7) * 8;
  const unsigned toffA = (unsigned)(lrow * lda + lcc), toffB = (unsigned)(lrow * ldb + lcc);
  const int rr = nBig % G, nLight = G - rr;
  const int nSmall = 8 * nNt128;
  if ((int)blockIdx.x >= rr) {
    for (int j = (int)blockIdx.x - rr; j < nSmall; j += nLight) {
      const int pm = j / nNt128, pn = j - pm * nNt128;
      const bf16_t* Ab = A + (size_t)(16384 + pm * 128) * lda;
      const bf16_t* Bb = Bt + (size_t)(pn * 128) * ldb;
      f32x4 acc[1][8];
#pragma unroll
      for (int q = 0; q < 8; ++q) acc[0][q] = (f32x4){0.f, 0.f, 0.f, 0.f};
      u32x4 ra[2], rb[2];
#pragma unroll
      for (int i = 0; i < 2; ++i) { ra[i] = *(const u32x4*)(Ab + (size_t)(i * 64) * lda + toffA); rb[i] = *(const u32x4*)(Bb + (size_t)(i * 64) * ldb + toffB); }
#pragma unroll
      for (int i = 0; i < 2; ++i) { *(u32x4*)(As + (lrow + i * 64) * 72 + lcc) = ra[i]; *(u32x4*)(Bs + (lrow + i * 64) * 72 + lcc) = rb[i]; }
      __syncthreads();
#pragma unroll 1
      for (int kt = 0; kt < nk; ++kt) {
        const int cur = kt & 1;
        const int kn = (kt + 1 < nk ? kt + 1 : kt) * 64;
#pragma unroll
        for (int i = 0; i < 2; ++i) { ra[i] = *(const u32x4*)(Ab + ((size_t)(i * 64) * lda + kn) + toffA); rb[i] = *(const u32x4*)(Bb + ((size_t)(i * 64) * ldb + kn) + toffB); }
        __builtin_amdgcn_sched_barrier(0);
        wmma_sw<1, 8>(acc, As + cur * 128 * 72 + wave * 16 * 72, 72, Bs + cur * 128 * 72, 72, 64, lane);
        __builtin_amdgcn_sched_barrier(0);
        bf16_t* Ad = As + (cur ^ 1) * 128 * 72; bf16_t* Bd = Bs + (cur ^ 1) * 128 * 72;
#pragma unroll
        for (int i = 0; i < 2; ++i) { *(u32x4*)(Ad + (lrow + i * 64) * 72 + lcc) = ra[i]; *(u32x4*)(Bd + (lrow + i * 64) * 72 + lcc) = rb[i]; }
        __syncthreads();
      }
      int er_ = 16384 + pm * 128 + wave * 16, ec_ = pn * 128, el_ = lane;
      asm volatile("" : "+v"(er_), "+v"(ec_), "+v"(el_));
      epi(acc, er_, ec_, el_);
    }
  }
}

__device__ __forceinline__ void rowpass_phase(const bf16_t* t0, const float* rowss, const float* wpost, const float* hin_a, const float* hin_b, float* hout, const float* wnext, bf16_t* hn, int wvs) {
  int tq_ = TIDX(wvs); asm volatile("" : "+v"(tq_)); const int lane = tq_ & 63, gw = blockIdx.x * 8 + (tq_ >> 6), nw = gridDim.x * 8;
  for (int row = gw; row < ROWS; row += nw) {
    const float* hin = row < 16384 ? hin_a + (size_t)row * 1024 : hin_b + (size_t)(row - 16384) * 1024;
    float r0 = 0.f;
    if (t0) r0 = rsqrtf(rowss[row] * (1.f / 1024.f) + EPSV);
    float4 v[4]; float ss = 0.f;
#pragma unroll
    for (int i = 0; i < 4; ++i) {
      const int col = (i * 64 + lane) * 4;
      float4 hv = *(const float4*)(hin + col);
      if (t0) {
        const uint2 t2 = *(const uint2*)(t0 + (size_t)row * 1024 + col);
        const float4 w4 = *(const float4*)(wpost + col);
        hv.x += lo2f(t2.x) * r0 * w4.x; hv.y += hi2f(t2.x) * r0 * w4.y; hv.z += lo2f(t2.y) * r0 * w4.z; hv.w += hi2f(t2.y) * r0 * w4.w;
      }
      v[i] = hv; ss += hv.x * hv.x + hv.y * hv.y + hv.z * hv.z + hv.w * hv.w;
      if (hout) *(float4*)(hout + (size_t)row * 1024 + col) = hv;
    }
    if (hn) {
#pragma unroll
      for (int o = 32; o >= 1; o >>= 1) ss += shx(ss, o);
      const float r1 = rsqrtf(ss * (1.f / 1024.f) + EPSV);
#pragma unroll
      for (int i = 0; i < 4; ++i) {
        const int col = (i * 64 + lane) * 4;
        const float4 w4 = *(const float4*)(wnext + col);
        store4bf(hn + (size_t)row * 1024 + col, v[i].x * r1 * w4.x, v[i].y * r1 * w4.y, v[i].z * r1 * w4.z, v[i].w * r1 * w4.w);
      }
    }
  }
}

__device__ __forceinline__ void wconv(const float* __restrict__ W, int K, int N, int Npad, bf16_t* __restrict__ Wt, char* smem, int wvs) {
  float* tile = (float*)smem;
  int tq_ = TIDX(wvs) & 255; asm volatile("" : "+v"(tq_)); const int tid = tq_;
  const int nNt = Npad >> 6, nunits = (K >> 6) * nNt;
  for (int u = blockIdx.x * 2 + (wvs >> 2); u < nunits; u += gridDim.x * 2) {
    const int k0 = (u / nNt) * 64, n0 = (u % nNt) * 64;
#pragma unroll
    for (int ps = 0; ps < 4; ++ps) {
      const int i = ps * 16 + (tid >> 4), j = (tid & 15) * 4, n = n0 + j;
      float4 v = make_float4(0.f, 0.f, 0.f, 0.f);
      if (n < N) v = *(const float4*)(W + (size_t)(k0 + i) * N + n);
      tile[i * 65 + j] = v.x; tile[i * 65 + j + 1] = v.y; tile[i * 65 + j + 2] = v.z; tile[i * 65 + j + 3] = v.w;
    }
    __syncthreads();
    {
      const int n = tid >> 2, kq = (tid & 3) * 16;
      uint4 o0, o1;
      o0.x = pack2(tile[(kq + 0) * 65 + n], tile[(kq + 1) * 65 + n]); o0.y = pack2(tile[(kq + 2) * 65 + n], tile[(kq + 3) * 65 + n]);
      o0.z = pack2(tile[(kq + 4) * 65 + n], tile[(kq + 5) * 65 + n]); o0.w = pack2(tile[(kq + 6) * 65 + n], tile[(kq + 7) * 65 + n]);
      o1.x = pack2(tile[(kq + 8) * 65 + n], tile[(kq + 9) * 65 + n]); o1.y = pack2(tile[(kq + 10) * 65 + n], tile[(kq + 11) * 65 + n]);
      o1.z = pack2(tile[(kq + 12) * 65 + n], tile[(kq + 13) * 65 + n]); o1.w = pack2(tile[(kq + 14) * 65 + n], tile[(kq + 15) * 65 + n]);
      bf16_t* d = Wt + (size_t)(n0 + n) * K + k0 + kq;
      *(uint4*)d = o0; *(uint4*)(d + 8) = o1;
    }
    __syncthreads();
  }
}

__device__ __forceinline__ void prep_tables(const Params& p, int wvs) {
  int tq_ = TIDX(wvs); asm volatile("" : "+v"(tq_)); const int gt = blockIdx.x * NTHR + tq_, nt = gridDim.x * NTHR;
  float* rope = (float*)(p.ws + OFF_ROPE);
  for (int i = gt; i < 2056 * 64; i += nt) {
    const int pi = i >> 6, f = i & 63;
    const double pos = pi < 2048 ? (double)pi : (double)(16384 + pi - 2048);
    const double invf = exp(-(double)f * (9.210340371976184 / 64.0));
    double ang = pos * invf;
    ang -= 6.283185307179586 * floor(ang * 0.15915494309189535);
    const float a = (float)ang;
    rope[pi * 128 + f] = cosf(a); rope[pi * 128 + 64 + f] = sinf(a);
  }
  float* z = (float*)(p.ws + OFF_ROWSS);
  for (int i = gt; i < ROWS * 6; i += nt) z[i] = 0.f;
  float* lb = (float*)(p.ws + OFF_LB);
  for (int i = gt; i < 512; i += nt) lb[i] = 1.f / (1.f + expf(p.hgrn_lb[512 + i] - p.hgrn_lb[i]));
  float* tab = (float*)(p.ws + OFF_S5TAB);
  for (int i = gt; i < 2048; i += nt) {
    const int g = i >> 6;
    const float lr = p.s5_lam_re[i], li = p.s5_lam_im[i], dt = expf(p.s5_log_step[g]);
    const float m1 = expf(lr * dt), br = m1 * cosf(li * dt), bi = m1 * sinf(li * dt);
    tab[i] = br; tab[2048 + i] = bi;
    const float m64 = expf(lr * dt * 64.f); tab[69632 + i] = m64 * cosf(li * dt * 64.f); tab[71680 + i] = m64 * sinf(li * dt * 64.f);
    const float m8 = expf(lr * dt * 8.f); tab[73728 + i] = m8 * cosf(li * dt * 8.f); tab[75776 + i] = m8 * sinf(li * dt * 8.f);
    const float x = br - 1.f, y = bi, den = 1.f / (lr * lr + li * li);
    const float qr = (x * lr + y * li) * den, qi = (y * lr - x * li) * den;
    for (int c = 0; c < 16; ++c) {
      const float b_r = p.s5_b_re[i * 16 + c], b_i = p.s5_b_im[i * 16 + c];
      tab[4096 + i * 16 + c] = qr * b_r - qi * b_i;
      tab[4096 + 32768 + i * 16 + c] = qr * b_i + qi * b_r;
    }
  }
}

__device__ __forceinline__ void chunk_geom(int c, int& row0, int& L) { if (c < 256) { row0 = c * 64; L = 64; } else { row0 = 16384 + (c - 256) * 8; L = 8; } }

template <int MODE>
__device__ __forceinline__ void st_load(uint4 (&kr)[4], uint4 (&vr)[(MODE == 2) ? 2 : 1], float& dtr, const bf16_t* src, const float* dtbuf, int row0, int L, int ld, int kcol, int vcol, int h, int tid) {
  constexpr int PW = (MODE == 2) ? 64 : 32, NVC = PW / 32, VCR = PW / 8;
  const uint4 z4 = make_uint4(0, 0, 0, 0);
#pragma unroll
  for (int i = 0; i < 4; ++i) { const int id = tid + i * 256, s = id >> 4, c8 = id & 15; uint4 t_ = z4; if (s < L) t_ = *(const uint4*)(src + (size_t)(row0 + s) * ld + kcol + c8 * 8); kr[i] = t_; }
#pragma unroll
  for (int i = 0; i < NVC; ++i) { const int id = tid + i * 256, s = id / VCR, c8 = id % VCR; uint4 t_ = z4; if (s < L) t_ = *(const uint4*)(src + (size_t)(row0 + s) * ld + vcol + c8 * 8); vr[i] = t_; }
  if (MODE == 2 && tid < 64) dtr = tid < L ? dtbuf[(size_t)(row0 + tid) * 16 + h] : 0.f;
}

template <int MODE>
__device__ __forceinline__ void state_unit(const Params& p, int sq, int h, int ps, char* smem, int wvs) {
  constexpr int PW = (MODE == 2) ? 64 : 32, NT = PW / 16, PF = (MODE == 2) ? 64 : 128, HH = (MODE == 2) ? 16 : 4, NVC = PW / 32, VCR = PW / 8;
  bf16_t* KT = (bf16_t*)smem;
  bf16_t* VT = KT + 128 * 72;
  bf16_t* KR = VT + 64 * 72;
  float* tot = (float*)(KR + 64 * 136);
  float* dec = tot + 256;
  float* av = dec + 64;
  float* dtv = av + 64;
  int tid_ = TIDX(wvs) & 255; asm volatile("" : "+v"(tid_)); const int tid = tid_, lane = tid & 63, wave = tid >> 6;
  const bool prompt = sq < 8;
  const int nch = prompt ? 32 : 1, L = prompt ? 64 : 8;
  const int ld = (MODE == 2) ? 1536 : 4096;
  const bf16_t* src = (MODE == 2) ? (const bf16_t*)(p.ws + OFF_H) : (const bf16_t*)(p.ws + OFF_A);
  const int kcol = MODE == 0 ? 512 + h * 128 : MODE == 1 ? 2560 + h * 128 : 1024 + (h >> 3) * 128;
  const int vcol = MODE == 0 ? 1024 + h * 128 + ps * 32 : MODE == 1 ? 3072 + h * 128 + ps * 32 : h * 64;
  const float* sin_ = MODE == 0 ? p.state_ret : MODE == 1 ? p.state_hgrn : p.state_ssm;
  float* sout = p.out + (MODE == 0 ? O_RET : MODE == 1 ? O_HG : O_SSM) + (size_t)(sq * HH + h) * 128 * PF;
  bf16_t* stb = (bf16_t*)(p.ws + OFF_ST) + (MODE == 1 ? (size_t)256 * 4 * 128 * 128 : 0);
  const float* dtbuf = (const float*)(p.ws + OFF_DTBUF);
  const float l2g = MODE == 0 ? log2f(1.f - exp2f(-5.f - (float)h)) : 0.f;
  float Ah = 0.f, dtb = 0.f;
  if (MODE == 2) { Ah = -expf(p.a_log[h]); dtb = p.dt_bias[h]; }

  f32x4 acc[2][NT];
  const int nb = wave * 32 + (lane >> 4) * 4, pc = ps * PW + (lane & 15);
#pragma unroll
  for (int mt = 0; mt < 2; ++mt)
#pragma unroll
    for (int nt = 0; nt < NT; ++nt)
#pragma unroll
      for (int j = 0; j < 4; ++j)
        acc[mt][nt][j] = prompt ? 0.f : sin_[((size_t)((sq - 8) * HH + h) * 128 + nb + mt * 16 + j) * PF + pc + nt * 16];

  uint4 kr[4], vr[NVC]; float dtr = 0.f;
  const uint4 z4 = make_uint4(0, 0, 0, 0);
  st_load<MODE>(kr, vr, dtr, src, dtbuf, prompt ? sq * 2048 : 16384 + (sq - 8) * 8, L, ld, kcol, vcol, h, tid);
  for (int n = 0; n < nch; ++n) {
    if (prompt) {
      bf16_t* d = stb + ((size_t)((sq * 32 + n) * HH + h) * PF) * 128;
#pragma unroll
      for (int mt = 0; mt < 2; ++mt)
#pragma unroll
        for (int nt = 0; nt < NT; ++nt) store4bf(d + (size_t)(pc + nt * 16) * 128 + nb + mt * 16, acc[mt][nt][0], acc[mt][nt][1], acc[mt][nt][2], acc[mt][nt][3]);
    }
#pragma unroll
    for (int i = 0; i < 4; ++i) { const int id = tid + i * 256, s = id >> 4, c8 = id & 15; *(uint4*)(KR + s * 136 + c8 * 8) = kr[i]; }
#pragma unroll
    for (int i = 0; i < NVC; ++i) {
      const int id = tid + i * 256, s = id / VCR, c8 = id % VCR; const uint4 v = vr[i];
      bf16_t* d = VT + (c8 * 8) * 72 + s;
      d[0] = (bf16_t)(v.x & 0xffff); d[72] = (bf16_t)(v.x >> 16); d[144] = (bf16_t)(v.y & 0xffff); d[216] = (bf16_t)(v.y >> 16);
      d[288] = (bf16_t)(v.z & 0xffff); d[360] = (bf16_t)(v.z >> 16); d[432] = (bf16_t)(v.w & 0xffff); d[504] = (bf16_t)(v.w >> 16);
    }
    if (MODE == 2 && tid < 64) {
      float dt = 0.f;
      if (tid < L) { const float x = dtr + dtb; dt = x > 20.f ? x : log1pf(__expf(x)); }
      dtv[tid] = dt; av[tid] = dt * Ah;
    }
    if (n + 1 < nch) st_load<MODE>(kr, vr, dtr, src, dtbuf, sq * 2048 + (n + 1) * 64, L, ld, kcol, vcol, h, tid);
    __syncthreads();
    const int kn = tid & 127, half = tid >> 7;
    if (MODE == 1) {
      float s_ = 0.f;
      for (int s = half * 32; s < half * 32 + 32; ++s) s_ += bf2f(KR[s * 136 + kn]);
      tot[half * 128 + kn] = s_;
    }
    if (MODE == 2 && tid < 64) {
      float suf = 0.f;
      for (int r = tid + 1; r < 64; ++r) suf += av[r];
      dec[tid] = __expf(suf) * dtv[tid];
      if (tid == 0) tot[0] = suf + av[0];
    }
    if (MODE != 0) __syncthreads();
    {
      float suf = 0.f;
      if (MODE == 1) suf = half == 0 ? tot[128 + kn] : 0.f;
      for (int g = 3; g >= 0; --g) {
        const int s0 = half * 32 + g * 8;
        float v[8];
#pragma unroll
        for (int e = 7; e >= 0; --e) {
          const int s = s0 + e;
          const float raw = bf2f(KR[s * 136 + kn]);
          if (MODE == 0) v[e] = raw * exp2f((float)(L - 1 - s) * l2g);
          else if (MODE == 1) { v[e] = (1.f - __expf(raw)) * __expf(suf); suf += raw; }
          else v[e] = raw * dec[s];
        }
        uint4 o; o.x = pack2(v[0], v[1]); o.y = pack2(v[2], v[3]); o.z = pack2(v[4], v[5]); o.w = pack2(v[6], v[7]);
        *(uint4*)(KT + kn * 72 + s0) = o;
      }
    }
    __syncthreads();
#pragma unroll
    for (int mt = 0; mt < 2; ++mt) {
      float dk[4];
      if (MODE == 0) { const float d = exp2f((float)L * l2g); dk[0] = dk[1] = dk[2] = dk[3] = d; }
      else if (MODE == 2) { const float d = __expf(tot[0]); dk[0] = dk[1] = dk[2] = dk[3] = d; }
      else {
#pragma unroll
        for (int j = 0; j < 4; ++j) { const int nn = nb + mt * 16 + j; dk[j] = __expf(tot[nn] + tot[128 + nn]); }
      }
#pragma unroll
      for (int nt = 0; nt < NT; ++nt)
#pragma unroll
        for (int j = 0; j < 4; ++j) acc[mt][nt][j] *= dk[j];
    }
    wmma_ns<2, NT>(acc, KT + wave * 32 * 72, 72, VT, 72, 64, lane);
    __syncthreads();
  }
#pragma unroll
  for (int mt = 0; mt < 2; ++mt)
#pragma unroll
    for (int nt = 0; nt < NT; ++nt)
#pragma unroll
      for (int j = 0; j < 4; ++j) sout[(size_t)(nb + mt * 16 + j) * PF + pc + nt * 16] = acc[mt][nt][j];
}

template <int MODE>
__device__ __forceinline__ void out_unit(const Params& p, int c, int h, char* smem, int wvs) {
  constexpr int PF = (MODE == 2) ? 64 : 128, NTP = PF / 16, HH = (MODE == 2) ? 16 : 4, NVC = PF / 32, VCR = PF / 8;
  bf16_t* Q = (bf16_t*)smem;
  bf16_t* Kb = Q + 64 * 136;
  bf16_t* STb = Kb + 128 * 72;
  float* cumv = (float*)(STb + 128 * 136);
  float* dtv = cumv + 64;
  float* av = dtv + 64;
  float* tot = av + 64;
  int tid_ = TIDX(wvs) & 255; asm volatile("" : "+v"(tid_)); const int tid = tid_, lane = tid & 63, wave = tid >> 6;
  int row0, L; chunk_geom(c, row0, L);
  const int ld = (MODE == 2) ? 1536 : 4096;
  const bf16_t* src = (MODE == 2) ? (const bf16_t*)(p.ws + OFF_H) : (const bf16_t*)(p.ws + OFF_A);
  const int qcol = MODE == 0 ? h * 128 : MODE == 1 ? 2048 + h * 128 : 1280 + (h >> 3) * 128;
  const int kcol = MODE == 0 ? 512 + h * 128 : MODE == 1 ? 2560 + h * 128 : 1024 + (h >> 3) * 128;
  const int vcol = MODE == 0 ? 1024 + h * 128 : MODE == 1 ? 3072 + h * 128 : h * 64;
  const float l2g = MODE == 0 ? log2f(1.f - exp2f(-5.f - (float)h)) : 0.f;
  const uint4 z4 = make_uint4(0, 0, 0, 0);
#pragma unroll
  for (int i = 0; i < 4; ++i) {
    const int id = tid + i * 256, s = id >> 4, c8 = id & 15;
    uint4 q4 = z4, k4 = z4;
    if (s < L) { q4 = *(const uint4*)(src + (size_t)(row0 + s) * ld + qcol + c8 * 8); k4 = *(const uint4*)(src + (size_t)(row0 + s) * ld + kcol + c8 * 8); }
    *(uint4*)(Q + s * 136 + c8 * 8) = q4; *(uint4*)(Kb + s * 136 + c8 * 8) = k4;
  }
  uint4 vr[NVC];
#pragma unroll
  for (int i = 0; i < NVC; ++i) { const int id = tid + i * 256, s = id / VCR, c8 = id % VCR; uint4 t_ = z4; if (s < L) t_ = *(const uint4*)(src + (size_t)(row0 + s) * ld + vcol + c8 * 8); vr[i] = t_; }
  if (c < 256) {
    const bf16_t* stg = (const bf16_t*)(p.ws + OFF_ST) + (MODE == 1 ? (size_t)256 * 4 * 128 * 128 : 0) + ((size_t)(c * HH + h) * PF) * 128;
#pragma unroll
    for (int i = 0; i < PF / 16; ++i) { const int id = tid + i * 256, pr = id >> 4, c8 = id & 15; *(uint4*)(STb + pr * 136 + c8 * 8) = *(const uint4*)(stg + (size_t)pr * 128 + c8 * 8); }
  } else {
    const float* sg = (MODE == 0 ? p.state_ret : MODE == 1 ? p.state_hgrn : p.state_ssm) + (size_t)((c - 256) * HH + h) * 128 * PF;
    for (int id = tid; id < 128 * (PF / 4); id += 256) {
      const int n = id / (PF / 4), p4 = (id % (PF / 4)) * 4;
      const float4 v = *(const float4*)(sg + (size_t)n * PF + p4);
      STb[(p4 + 0) * 136 + n] = f2bf(v.x); STb[(p4 + 1) * 136 + n] = f2bf(v.y); STb[(p4 + 2) * 136 + n] = f2bf(v.z); STb[(p4 + 3) * 136 + n] = f2bf(v.w);
    }
  }
  if (MODE == 2 && tid < 64) {
    float dt = 0.f;
    if (tid < L) { const float x = ((const float*)(p.ws + OFF_DTBUF))[(size_t)(row0 + tid) * 16 + h] + p.dt_bias[h]; dt = x > 20.f ? x : log1pf(__expf(x)); }
    dtv[tid] = dt; av[tid] = -expf(p.a_log[h]) * dt;
  }
  __syncthreads();
  if (MODE == 1) {
    const int kn = tid & 127, half = tid >> 7;
    float s_ = 0.f;
    for (int s = half * 32; s < half * 32 + 32; ++s) s_ += bf2f(Kb[s * 136 + kn]);
    tot[half * 128 + kn] = s_;
    __syncthreads();
    float cum = half == 1 ? tot[kn] : 0.f;
    for (int s = half * 32; s < half * 32 + 32; ++s) {
      const float lf = bf2f(Kb[s * 136 + kn]);
      cum += lf;
      Q[s * 136 + kn] = f2bf(bf2f(Q[s * 136 + kn]) * __expf(cum));
      Kb[s * 136 + kn] = f2bf((1.f - __expf(lf)) * __expf(-cum));
    }
    __syncthreads();
  }
  if (MODE == 2) {
    if (tid < 64) { float cs = 0.f; for (int r = 0; r <= tid; ++r) cs += av[r]; cumv[tid] = cs; }
    __syncthreads();
  }
  f32x4 ai[1][NTP], asc[1][4];
#pragma unroll
  for (int j = 0; j < NTP; ++j) ai[0][j] = (f32x4){0.f, 0.f, 0.f, 0.f};
#pragma unroll
  for (int j = 0; j < 4; ++j) asc[0][j] = (f32x4){0.f, 0.f, 0.f, 0.f};
  wmma_sw<1, NTP>(ai, Q + wave * 16 * 136, 136, STb, 136, 128, lane);
  wmma_sw<1, 4>(asc, Q + wave * 16 * 136, 136, Kb, 136, 128, lane);
  const int t = wave * 16 + (lane & 15), sq4 = (lane >> 4) * 4;
  float ct = 0.f;
  if (MODE == 2) ct = cumv[t];
#pragma unroll
  for (int nt = 0; nt < 4; ++nt)
#pragma unroll
    for (int j = 0; j < 4; ++j) {
      const int s = nt * 16 + sq4 + j;
      float v = asc[0][nt][j];
      if (s > t) v = 0.f;
      else if (MODE == 0) v *= exp2f((float)(t - s) * l2g);
      else if (MODE == 2) v *= __expf(ct - cumv[s]) * dtv[s];
      asc[0][nt][j] = v;
    }
  __syncthreads();
  bf16_t* Pb = STb; bf16_t* VT = Kb;
#pragma unroll
  for (int nt = 0; nt < 4; ++nt) store4bf(Pb + t * 72 + nt * 16 + sq4, asc[0][nt][0], asc[0][nt][1], asc[0][nt][2], asc[0][nt][3]);
#pragma unroll
  for (int i = 0; i < NVC; ++i) {
    const int id = tid + i * 256, s = id / VCR, c8 = id % VCR; const uint4 v = vr[i];
    bf16_t* d = VT + (c8 * 8) * 72 + s;
    d[0] = (bf16_t)(v.x & 0xffff); d[72] = (bf16_t)(v.x >> 16); d[144] = (bf16_t)(v.y & 0xffff); d[216] = (bf16_t)(v.y >> 16);
    d[288] = (bf16_t)(v.z & 0xffff); d[360] = (bf16_t)(v.z >> 16); d[432] = (bf16_t)(v.w & 0xffff); d[504] = (bf16_t)(v.w >> 16);
  }
  __syncthreads();
  f32x4 ao[1][NTP];
#pragma unroll
  for (int j = 0; j < NTP; ++j) ao[0][j] = (f32x4){0.f, 0.f, 0.f, 0.f};
  wmma_sw<1, NTP>(ao, Pb + wave * 16 * 72, 72, VT, 72, 64, lane);
  float fi = 1.f;
  if (MODE == 0) fi = exp2f((float)(t + 1) * l2g);
  if (MODE == 2) fi = __expf(ct);
  const int row = row0 + t;
  const bool valid = t < L;
  if (MODE == 0 || MODE == 1) {
    float s1 = 0.f, s2 = 0.f;
#pragma unroll
    for (int nt = 0; nt < NTP; ++nt)
#pragma unroll
      for (int j = 0; j < 4; ++j) { const float o = ao[0][nt][j] + fi * ai[0][nt][j]; ao[0][nt][j] = o; s1 += o; s2 += o * o; }
    s1 += shx(s1, 16); s1 += shx(s1, 32); s2 += shx(s2, 16); s2 += shx(s2, 32);
    float mu = 0.f, rs;
    if (MODE == 0) { mu = s1 * (1.f / 128.f); const float var = fmaxf(s2 * (1.f / 128.f) - mu * mu, 0.f); rs = rsqrtf(var + EPSV); }
    else rs = rsqrtf(s2 * (1.f / 128.f) + EPSV);
    if (valid) {
      const float* nw = (MODE == 0 ? p.ret_norm_w : p.hgrn_norm_w) + h * 128;
      const int gcol = (MODE == 0 ? 1536 : 3584) + h * 128;
      bf16_t* mix = (bf16_t*)(p.ws + OFF_H) + (size_t)row * 1024 + (MODE == 0 ? 0 : 512) + h * 128;
#pragma unroll
      for (int nt = 0; nt < NTP; ++nt) {
        const int pp = nt * 16 + sq4;
        const float4 w4 = *(const float4*)(nw + pp);
        const uint2 g2 = *(const uint2*)(src + (size_t)row * ld + gcol + pp);
        store4bf(mix + pp, (ao[0][nt][0] - mu) * rs * w4.x * siluf(lo2f(g2.x)), (ao[0][nt][1] - mu) * rs * w4.y * siluf(hi2f(g2.x)),
                 (ao[0][nt][2] - mu) * rs * w4.z * siluf(lo2f(g2.y)), (ao[0][nt][3] - mu) * rs * w4.w * siluf(hi2f(g2.y)));
      }
    }
  } else {
    const float Dh = p.d_ssm[h];
    bf16_t* zy = (bf16_t*)(p.ws + OFF_A) + (size_t)row * 3200 + h * 64;
    float s2 = 0.f;
    if (valid) {
#pragma unroll
      for (int nt = 0; nt < NTP; ++nt) {
        const int pp = nt * 16 + sq4;
        const uint2 x2 = *(const uint2*)(src + (size_t)row * ld + vcol + pp);
        const uint2 z2 = *(const uint2*)(zy + pp);
        const float y0 = (ao[0][nt][0] + fi * ai[0][nt][0] + Dh * lo2f(x2.x)) * siluf(lo2f(z2.x));
        const float y1 = (ao[0][nt][1] + fi * ai[0][nt][1] + Dh * hi2f(x2.x)) * siluf(hi2f(z2.x));
        const float y2 = (ao[0][nt][2] + fi * ai[0][nt][2] + Dh * lo2f(x2.y)) * siluf(lo2f(z2.y));
        const float y3 = (ao[0][nt][3] + fi * ai[0][nt][3] + Dh * hi2f(x2.y)) * siluf(hi2f(z2.y));
        s2 += y0 * y0 + y1 * y1 + y2 * y2 + y3 * y3;
        store4bf(zy + pp, y0, y1, y2, y3);
      }
    }
    s2 += shx(s2, 16); s2 += shx(s2, 32);
    if (valid && lane < 16) atomicAdd((float*)(p.ws + OFF_SSDST) + (size_t)row * 2 + (h >> 3), s2);
  }
  __syncthreads();
}

template <int OUT>
__device__ __forceinline__ void s5_unit(const Params& p, int c, int gq, char* smem, int wvs) {
  float* Uf = (float*)smem;
  bf16_t* HSall = (bf16_t*)(smem + 16384);
  bf16_t* CMall = (bf16_t*)(smem + 16384 + 34816);
  int tid_ = TIDX(wvs) & 255; asm volatile("" : "+v"(tid_)); const int tid = tid_, lane = tid & 63, wave = tid >> 6;
  int row0, L; chunk_geom(c, row0, L);
  const bf16_t* proj = (const bf16_t*)(p.ws + OFF_A);
#pragma unroll
  for (int i = 0; i < 2; ++i) {
    const int id = tid + i * 256, s = id >> 3, c8 = id & 7;
    uint4 v = make_uint4(0, 0, 0, 0);
    if (s < L) v = *(const uint4*)(proj + (size_t)(row0 + s) * 3200 + 2576 + gq * 64 + c8 * 8);
    float* d = Uf + s * 64 + c8 * 8;
    d[0] = lo2f(v.x); d[1] = hi2f(v.x); d[2] = lo2f(v.y); d[3] = hi2f(v.y); d[4] = lo2f(v.z); d[5] = hi2f(v.z); d[6] = lo2f(v.w); d[7] = hi2f(v.w);
  }
  const int g = gq * 4 + wave, gp = g * 64 + lane;
  const float* tab = (const float*)(p.ws + OFF_S5TAB);
  const float lr = tab[gp], li = tab[2048 + gp];
  f32x2 bb2[16];
#pragma unroll
  for (int q = 0; q < 4; ++q) {
    const float4 a = *(const float4*)(tab + 4096 + gp * 16 + q * 4), b = *(const float4*)(tab + 4096 + 32768 + gp * 16 + q * 4);
    bb2[q * 4] = (f32x2){a.x, b.x}; bb2[q * 4 + 1] = (f32x2){a.y, b.y}; bb2[q * 4 + 2] = (f32x2){a.z, b.z}; bb2[q * 4 + 3] = (f32x2){a.w, b.w};
  }
  float hr = 0.f, hi = 0.f;
  bf16_t* HS = HSall + wave * 32 * 136; bf16_t* CM = CMall + wave * 16 * 136;
  if (OUT) {
    const float2 h0 = *(const float2*)((const float*)(p.ws + OFF_S5H) + ((size_t)c * 2048 + gp) * 2);
    hr = h0.x; hi = h0.y;
#pragma unroll
    for (int ch = 0; ch < 16; ++ch) { CM[ch * 136 + lane] = f2bf(p.s5_c_re[(g * 16 + ch) * 64 + lane]); CM[ch * 136 + 64 + lane] = f2bf(-p.s5_c_im[(g * 16 + ch) * 64 + lane]); }
  }
  __syncthreads();
  const int nhalf = OUT ? ((L + 31) >> 5) : 1, tl = OUT ? 32 : L;
  for (int hf = 0; hf < nhalf; ++hf) {
#pragma unroll 4
    for (int tt = 0; tt < tl; ++tt) {
      const int t = hf * 32 + tt;
      {
        const float* up = Uf + t * 64 + wave * 16;
        f32x2 b0 = (f32x2){0.f, 0.f}, b1 = (f32x2){0.f, 0.f};
#pragma unroll
        for (int q = 0; q < 4; ++q) {
          const f32x4 u4 = *(const f32x4*)(up + q * 4);
          b0 += bb2[q * 4] * u4[0]; b1 += bb2[q * 4 + 1] * u4[1]; b0 += bb2[q * 4 + 2] * u4[2]; b1 += bb2[q * 4 + 3] * u4[3];
        }
        b0 += b1;
        const float nr = lr * hr - li * hi + b0[0], ni = lr * hi + li * hr + b0[1];
        if (t < L) { hr = nr; hi = ni; }
      }
      if (OUT) { HS[tt * 136 + lane] = f2bf(t < L ? hr : 0.f); HS[tt * 136 + 64 + lane] = f2bf(t < L ? hi : 0.f); }
    }
    if (OUT) {
      __syncthreads();
      f32x4 ay[2][1];
      ay[0][0] = (f32x4){0.f, 0.f, 0.f, 0.f}; ay[1][0] = (f32x4){0.f, 0.f, 0.f, 0.f};
      wmma_sw<2, 1>(ay, HS, 136, CM, 136, 128, lane);
      bf16_t* gbuf = (bf16_t*)(p.ws + OFF_GBUF);
#pragma unroll
      for (int mt = 0; mt < 2; ++mt) {
        const int t = hf * 32 + mt * 16 + (lane & 15), ch0 = (lane >> 4) * 4;
        if (t < L) {
          const float4 u4 = *(const float4*)(Uf + t * 64 + wave * 16 + ch0);
          const float4 d4 = *(const float4*)(p.s5_d + g * 16 + ch0);
          float y[4] = {ay[mt][0][0] + d4.x * u4.x, ay[mt][0][1] + d4.y * u4.y, ay[mt][0][2] + d4.z * u4.z, ay[mt][0][3] + d4.w * u4.w};
#pragma unroll
          for (int j = 0; j < 4; ++j) { const float x = y[j], uu = 0.7978845608028654f * (x + 0.044715f * x * x * x); y[j] = x / (1.f + __expf(-2.f * uu)); }
          store4bf(gbuf + (size_t)(row0 + t) * 512 + g * 16 + ch0, y[0], y[1], y[2], y[3]);
        }
      }
      __syncthreads();
    }
  }
  if (!OUT) { *(float2*)((float*)(p.ws + OFF_S5E) + ((size_t)c * 2048 + gp) * 2) = make_float2(hr, hi); }
  __syncthreads();
}

__device__ __forceinline__ void s5_prefix(const Params& p, int gt) {
  const int sq = gt >> 11, rem = gt & 2047;
  const float* tab = (const float*)(p.ws + OFF_S5TAB);
  const float* e = (const float*)(p.ws + OFF_S5E);
  float* hs = (float*)(p.ws + OFF_S5H);
  float hr = 0.f, hi = 0.f;
  if (sq < 8) {
    const float lr = tab[69632 + rem], li = tab[71680 + rem];
    for (int n = 0; n < 32; ++n) {
      const size_t idx = ((size_t)(sq * 32 + n) * 2048 + rem) * 2;
      *(float2*)(hs + idx) = make_float2(hr, hi);
      const float2 ev = *(const float2*)(e + idx);
      const float nr = lr * hr - li * hi + ev.x, ni = lr * hi + li * hr + ev.y; hr = nr; hi = ni;
    }
  } else {
    const float lr = tab[73728 + rem], li = tab[75776 + rem];
    hr = p.state_s5_re[(size_t)(sq - 8) * 2048 + rem]; hi = p.state_s5_im[(size_t)(sq - 8) * 2048 + rem];
    const size_t idx = ((size_t)(256 + sq - 8) * 2048 + rem) * 2;
    *(float2*)(hs + idx) = make_float2(hr, hi);
    const float2 ev = *(const float2*)(e + idx);
    const float nr = lr * hr - li * hi + ev.x, ni = lr * hi + li * hr + ev.y; hr = nr; hi = ni;
  }
  p.out[O_S5RE + (size_t)sq * 2048 + rem] = hr;
  p.out[O_S5IM + (size_t)sq * 2048 + rem] = hi;
}

__device__ __forceinline__ void conv_phase(const Params& p, int wvs) {
  const bf16_t* proj = (const bf16_t*)(p.ws + OFF_A);
  bf16_t* xc = (bf16_t*)(p.ws + OFF_H);
  int tq_ = TIDX(wvs); asm volatile("" : "+v"(tq_)); const int gt = blockIdx.x * NTHR + tq_, nt = gridDim.x * NTHR;
  for (int task = gt; task < 544 * 192; task += nt) {
    const int seg = task / 192, c = (task - seg * 192) * 8, rowb = seg * 32;
    float w[4][8], bia[8];
#pragma unroll
    for (int j = 0; j < 4; ++j) {
      const float4 w0 = *(const float4*)(p.conv_w + j * 1536 + c), w1 = *(const float4*)(p.conv_w + j * 1536 + c + 4);
      w[j][0] = w0.x; w[j][1] = w0.y; w[j][2] = w0.z; w[j][3] = w0.w; w[j][4] = w1.x; w[j][5] = w1.y; w[j][6] = w1.z; w[j][7] = w1.w;
    }
    { const float4 b0 = *(const float4*)(p.conv_b + c), b1 = *(const float4*)(p.conv_b + c + 4); bia[0] = b0.x; bia[1] = b0.y; bia[2] = b0.z; bia[3] = b0.w; bia[4] = b1.x; bia[5] = b1.y; bia[6] = b1.z; bia[7] = b1.w; }
    float x0[8], x1[8], x2[8];
    if (rowb < 16384 && (rowb & 2047) != 0) {
      const u32x4 v0 = *(const u32x4*)(proj + (size_t)(rowb - 3) * 3200 + 1024 + c), v1 = *(const u32x4*)(proj + (size_t)(rowb - 2) * 3200 + 1024 + c), v2 = *(const u32x4*)(proj + (size_t)(rowb - 1) * 3200 + 1024 + c);
#pragma unroll
      for (int e = 0; e < 4; ++e) { x0[2 * e] = lo2f(v0[e]); x0[2 * e + 1] = hi2f(v0[e]); x1[2 * e] = lo2f(v1[e]); x1[2 * e + 1] = hi2f(v1[e]); x2[2 * e] = lo2f(v2[e]); x2[2 * e + 1] = hi2f(v2[e]); }
    } else {
#pragma unroll
      for (int e = 0; e < 8; ++e) { x0[e] = 0.f; x1[e] = 0.f; x2[e] = 0.f; }
    }
    u32x4 nxt = *(const u32x4*)(proj + (size_t)rowb * 3200 + 1024 + c);
    for (int r = 0; r < 32; ++r) {
      const int row = rowb + r;
      const u32x4 cv = nxt;
      if (r + 1 < 32) nxt = *(const u32x4*)(proj + (size_t)(row + 1) * 3200 + 1024 + c);
      int t, T, sq;
      if (row < 16384) { t = row & 2047; T = 2048; sq = row >> 11; } else { t = (row - 16384) & 7; T = 8; sq = 8 + ((row - 16384) >> 3); }
      if (t == 0) {
        if (sq >= 8) {
          const float* sc = p.state_conv + (size_t)(sq - 8) * 3 * 1536 + c;
          const float4 a0 = *(const float4*)sc, a1 = *(const float4*)(sc + 4), b0 = *(const float4*)(sc + 1536), b1 = *(const float4*)(sc + 1540), c0 = *(const float4*)(sc + 3072), c1 = *(const float4*)(sc + 3076);
          x0[0] = a0.x; x0[1] = a0.y; x0[2] = a0.z; x0[3] = a0.w; x0[4] = a1.x; x0[5] = a1.y; x0[6] = a1.z; x0[7] = a1.w;
          x1[0] = b0.x; x1[1] = b0.y; x1[2] = b0.z; x1[3] = b0.w; x1[4] = b1.x; x1[5] = b1.y; x1[6] = b1.z; x1[7] = b1.w;
          x2[0] = c0.x; x2[1] = c0.y; x2[2] = c0.z; x2[3] = c0.w; x2[4] = c1.x; x2[5] = c1.y; x2[6] = c1.z; x2[7] = c1.w;
        } else {
#pragma unroll
          for (int e = 0; e < 8; ++e) { x0[e] = 0.f; x1[e] = 0.f; x2[e] = 0.f; }
        }
      }
      float cur[8], o[8];
#pragma unroll
      for (int e = 0; e < 4; ++e) { cur[2 * e] = lo2f(cv[e]); cur[2 * e + 1] = hi2f(cv[e]); }
#pragma unroll
      for (int e = 0; e < 8; ++e) { o[e] = siluf(bia[e] + w[0][e] * x0[e] + w[1][e] * x1[e] + w[2][e] * x2[e] + w[3][e] * cur[e]); x0[e] = x1[e]; x1[e] = x2[e]; x2[e] = cur[e]; }
      u32x4 ov; ov[0] = pack2(o[0], o[1]); ov[1] = pack2(o[2], o[3]); ov[2] = pack2(o[4], o[5]); ov[3] = pack2(o[6], o[7]);
      *(u32x4*)(xc + (size_t)row * 1536 + c) = ov;
      if (t >= T - 3) {
        float* d = p.out + O_CONV + ((size_t)sq * 3 + (t - (T - 3))) * 1536 + c;
        *(float4*)d = make_float4(cur[0], cur[1], cur[2], cur[3]); *(float4*)(d + 4) = make_float4(cur[4], cur[5], cur[6], cur[7]);
      }
    }
  }
}

__device__ __forceinline__ void ssdnorm_phase(const Params& p, int wvs) {
  const bf16_t* proj = (const bf16_t*)(p.ws + OFF_A);
  bf16_t* mix = (bf16_t*)(p.ws + OFF_H);
  const float* st = (const float*)(p.ws + OFF_SSDST);
  int tq_ = TIDX(wvs); asm volatile("" : "+v"(tq_)); const int gt = blockIdx.x * NTHR + tq_, nt = gridDim.x * NTHR;
  for (int it = gt; it < ROWS * 128; it += nt) {
    const int row = it >> 7, c = (it & 127) * 8;
    const float r = rsqrtf(st[(size_t)row * 2 + (c >> 9)] * (1.f / 512.f) + EPSV);
    const uint4 v = *(const uint4*)(proj + (size_t)row * 3200 + c);
    const float4 w0 = *(const float4*)(p.ssm_norm_w + c), w1 = *(const float4*)(p.ssm_norm_w + c + 4);
    uint4 o; o.x = pack2(lo2f(v.x) * r * w0.x, hi2f(v.x) * r * w0.y); o.y = pack2(lo2f(v.y) * r * w0.z, hi2f(v.y) * r * w0.w);
    o.z = pack2(lo2f(v.z) * r * w1.x, hi2f(v.z) * r * w1.y); o.w = pack2(lo2f(v.w) * r * w1.z, hi2f(v.w) * r * w1.w);
    *(uint4*)(mix + (size_t)row * 1536 + c) = o;
  }
}


#define XB_TMO      128
#define XB_XCNT(j)  (256  + 64 * (j))
#define XB_XSUB(j)  (1280 + 64 * (j))
#define XB_XGEN(j)  (2304 + 64 * (j))
#define XB_TOP      3328
#define XB_TOPGEN   3392
#define XCD_BAR_WORDS 3456
#define XB_SPIN_CAP (1u << 18)
#define LAS __attribute__((address_space(3)))
__device__ __forceinline__ unsigned xb_ld(unsigned* p)              { return __hip_atomic_load(p, __ATOMIC_RELAXED, __HIP_MEMORY_SCOPE_AGENT); }
__device__ __forceinline__ unsigned xb_add(unsigned* p, unsigned v) { return __hip_atomic_fetch_add(p, v, __ATOMIC_RELAXED, __HIP_MEMORY_SCOPE_AGENT); }
__device__ __forceinline__ unsigned xb_xcc_id() { return (unsigned)__builtin_amdgcn_s_getreg((3 << 11) | 20) & 0xFu; }
#define XB_SPIN(cond, bar) do { unsigned _sp = 0; while (cond) { __builtin_amdgcn_s_sleep(1); \
    if ((++_sp & 255u) == 0u) { if (xb_ld(&(bar)[XB_TMO])) break; if (_sp > XB_SPIN_CAP) { atomicAdd(&(bar)[XB_TMO], 1u); break; } } } } while (0)
struct XcdBarrier { unsigned* bar; unsigned x; volatile LAS unsigned* st; };
__device__ __forceinline__ XcdBarrier xcd_barrier_post(unsigned* bar, volatile LAS unsigned* st, int wvs) {
    XcdBarrier b; b.bar = bar; b.x = xb_xcc_id(); b.st = st;
    if (TIDX(wvs) == 0) (void)xb_add(&bar[XB_XCNT(b.x)], 1u);
    return b;
}
__device__ __forceinline__ void xcd_barrier_complete(unsigned* bar, unsigned x, unsigned& nloc, unsigned& nx) {
    const unsigned G = gridDim.x * gridDim.y * gridDim.z;
    unsigned sum, cnt, mine, sp = 0u;
    for (;;) {
        sum = 0u; cnt = 0u; mine = 0u;
#pragma unroll
        for (unsigned j = 0; j < 16; ++j) { const unsigned c = xb_ld(&bar[XB_XCNT(j)]); sum += c; cnt += (c > 0u) ? 1u : 0u; mine = (j == x) ? c : mine; }
        if (sum == G) break;
        __builtin_amdgcn_s_sleep(1);
        if ((++sp & 255u) == 0u) { if (xb_ld(&bar[XB_TMO])) break; if (sp > XB_SPIN_CAP) { atomicAdd(&bar[XB_TMO], 1u); break; } }
    }
    nloc = mine > 0u ? mine : 1u; nx = cnt > 0u ? cnt : 1u;
}
__device__ __forceinline__ void xcd_barrier(const XcdBarrier& b, int wvs) {
    asm volatile("s_waitcnt vmcnt(0)" ::: "memory");
    __syncthreads();
    if (TIDX(wvs) == 0) {
        unsigned* bar = b.bar;
        __builtin_amdgcn_s_waitcnt(0);
        unsigned nloc = b.st[0], nx = b.st[1];
        if (nloc == 0u) { xcd_barrier_complete(bar, b.x, nloc, nx); b.st[0] = nloc; b.st[1] = nx; }
        const unsigned old = xb_add(&bar[XB_XSUB(b.x)], 1u);
        const unsigned gen = old / nloc;
        if (old + 1u == (gen + 1u) * nloc) {
            __builtin_amdgcn_fence(__ATOMIC_RELEASE, "agent");
            asm volatile("s_waitcnt vmcnt(0)" ::: "memory");
            const unsigned og = xb_add(&bar[XB_TOP], 1u);
            const unsigned tg = og / nx;
            if (og + 1u == (tg + 1u) * nx) xb_add(&bar[XB_TOPGEN], 1u);
            else XB_SPIN(xb_ld(&bar[XB_TOPGEN]) == tg, bar);
            __builtin_amdgcn_fence(__ATOMIC_ACQUIRE, "agent");
            xb_add(&bar[XB_XGEN(b.x)], 1u);
            asm volatile("s_waitcnt vmcnt(0)" ::: "memory");
        } else {
            XB_SPIN(xb_ld(&bar[XB_XGEN(b.x)]) == gen, bar);
            __builtin_amdgcn_fence(__ATOMIC_ACQUIRE, "agent");
            asm volatile("s_waitcnt vmcnt(0)" ::: "memory");
        }
    }
    __syncthreads();
}


__device__ __forceinline__ Params ldp() {
  auto kp = __builtin_amdgcn_kernarg_segment_ptr();
  asm volatile("" : "+s"(kp));
  Params q;
  __builtin_memcpy(&q, (const void*)kp, sizeof(Params));
  return q;
}

__global__ void __launch_bounds__(NTHR, 2) fwd_megakernel(Params p_) {
  extern __shared__ __attribute__((aligned(16))) char smem[];
  cg::grid_group grid = cg::this_grid();
  if (p_.ws == nullptr) grid.sync();
  volatile LAS unsigned* xst = (volatile LAS unsigned*)(smem + 2 * HALF_LDS);
  const int wvs = __builtin_amdgcn_readfirstlane(threadIdx.x >> 6);
  if (TIDX(wvs) == 0) { xst[0] = 0u; xst[1] = 0u; xst[2] = 0u; xst[3] = 0u; }
  __syncthreads();
  const XcdBarrier xb = xcd_barrier_post((unsigned*)(p_.ws + OFF_BAR), xst, wvs);
  const int half = wvs >> 2;
  const int G = gridDim.x * 2, bid = blockIdx.x * 2 + half;
  char* hs = smem + half * HALF_LDS;
#define PH_BEGIN const Params p = ldp(); bf16_t* bufA = (bf16_t*)(p.ws + OFF_A); bf16_t* bufH = (bf16_t*)(p.ws + OFF_H); bf16_t* t0 = (bf16_t*)(p.ws + OFF_ST); \
    float* rowss = (float*)(p.ws + OFF_ROWSS); float* hbuf = p.out; (void)bufA; (void)bufH; (void)t0; (void)rowss; (void)hbuf;

  {
  PH_BEGIN
  prep_tables(p, wvs);
  wconv(p.w_in_even, 1024, 4096, 4096, (bf16_t*)(p.ws + W_IN), hs, wvs);
  wconv(p.w_out_even, 1024, 1024, 1024, (bf16_t*)(p.ws + W_OUT0), hs, wvs);
  wconv(p.w_ffn_up, 1024, 4096, 4096, (bf16_t*)(p.ws + W_UP), hs, wvs);
  wconv(p.w_ffn_down, 4096, 1024, 1024, (bf16_t*)(p.ws + W_DOWN), hs, wvs);
  rowpass_phase(nullptr, nullptr, nullptr, p.x_prompt, p.x_sample, nullptr, p.norm_mix_pre, bufH, wvs);
  }
  xcd_barrier(xb, wvs);
  {
  PH_BEGIN
  { EpiInEven e{bufA, (const float*)(p.ws + OFF_ROPE), (const float*)(p.ws + OFF_LB)};
    for (int rep_ = 0; rep_ < REPG; ++rep_) { gemm_phase(bufH, 1024, (const bf16_t*)(p.ws + W_IN), 1024, 64, 16, 1024, e, smem, wvs); gemm_tail(bufH, 1024, (const bf16_t*)(p.ws + W_IN), 1024, 32, 1024, e, smem, wvs, 64 * 16); } }
  }
  xcd_barrier(xb, wvs);
  {
  PH_BEGIN
  for (int rep_ = 0; rep_ < REPS; ++rep_) {
    if (bid < 256) {
      const int v = bid;
      const int ps = v & 3, m = (v >> 2) & 1, h = (v >> 3) & 3, sq = v >> 5;
      if (m == 0) state_unit<0>(p, sq, h, ps, hs, wvs); else state_unit<1>(p, sq, h, ps, hs, wvs);
    }
    const int nsh = bid < 256 ? 2 : 14, j0 = bid < 256 ? bid : 512 + (bid - 256);
    for (int i = 0; i < nsh; ++i) {
      const int v = j0 + 256 * i;
      const int ps = v & 3, m = (v >> 2) & 1, h = (v >> 3) & 3, sq = 8 + (v >> 5);
      if (m == 0) state_unit<0>(p, sq, h, ps, hs, wvs); else state_unit<1>(p, sq, h, ps, hs, wvs);
    }
  }
  }
  xcd_barrier(xb, wvs);
  {
  PH_BEGIN
  for (int rep_ = 0; rep_ < REPO; ++rep_)
  for (int u = bid; u < 384 * 8; u += G) {
    const int h = u & 3, m = (u >> 2) & 1, c = u >> 3;
    if (m == 0) out_unit<0>(p, c, h, hs, wvs); else out_unit<1>(p, c, h, hs, wvs);
  }
  }
  xcd_barrier(xb, wvs);
  {
  PH_BEGIN
  { EpiOut e{t0, rowss};
    for (int rep_ = 0; rep_ < REPG; ++rep_) { gemm_phase(bufH, 1024, (const bf16_t*)(p.ws + W_OUT0), 1024, 64, 4, 1024, e, smem, wvs); gemm_tail(bufH, 1024, (const bf16_t*)(p.ws + W_OUT0), 1024, 8, 1024, e, smem, wvs, 64 * 4); } }
  }
  xcd_barrier(xb, wvs);
  {
  PH_BEGIN
  for (int rep_ = 0; rep_ < REPR; ++rep_)
  rowpass_phase(t0, rowss, p.norm_mix_post, p.x_prompt, p.x_sample, hbuf, p.norm_ffn_pre, bufH, wvs);
  }
  xcd_barrier(xb, wvs);
  {
  PH_BEGIN
  { EpiUp e{bufA}; for (int rep_ = 0; rep_ < REPG; ++rep_) { gemm_phase(bufH, 1024, (const bf16_t*)(p.ws + W_UP), 1024, 64, 16, 1024, e, smem, wvs); gemm_tail(bufH, 1024, (const bf16_t*)(p.ws + W_UP), 1024, 32, 1024, e, smem, wvs, 64 * 16); } }
  }
  xcd_barrier(xb, wvs);
  {
  PH_BEGIN
  { EpiOut e{t0, rowss + ROWS}; for (int rep_ = 0; rep_ < REPG; ++rep_) { gemm_phase(bufA, 4096, (const bf16_t*)(p.ws + W_DOWN), 4096, 64, 4, 4096, e, smem, wvs); gemm_tail(bufA, 4096, (const bf16_t*)(p.ws + W_DOWN), 4096, 8, 4096, e, smem, wvs, 64 * 4); } }
  }
  xcd_barrier(xb, wvs);
  {
  PH_BEGIN
  rowpass_phase(t0, rowss + ROWS, p.norm_ffn_post, hbuf, hbuf + (size_t)16384 * 1024, hbuf, p.norm_mix_pre + 1024, bufH, wvs);
  wconv(p.w_in_odd, 1024, 3088, 3328, (bf16_t*)(p.ws + W_IN), hs, wvs);
  wconv(p.w_glu, 512, 512, 512, (bf16_t*)(p.ws + W_GLU), hs, wvs);
  wconv(p.w_out_odd, 1536, 1024, 1024, (bf16_t*)(p.ws + W_OUT1), hs, wvs);
  wconv(p.w_ffn_up + (size_t)1024 * 4096, 1024, 4096, 4096, (bf16_t*)(p.ws + W_UP), hs, wvs);
  wconv(p.w_ffn_down + (size_t)4096 * 1024, 4096, 1024, 1024, (bf16_t*)(p.ws + W_DOWN), hs, wvs);
  }
  xcd_barrier(xb, wvs);
  {
  PH_BEGIN
  { EpiInOdd e{bufA, (float*)(p.ws + OFF_DTBUF)};
    for (int rep_ = 0; rep_ < REPG; ++rep_) { gemm_phase(bufH, 1024, (const bf16_t*)(p.ws + W_IN), 1024, 64, 13, 1024, e, smem, wvs); gemm_tail(bufH, 1024, (const bf16_t*)(p.ws + W_IN), 1024, 26, 1024, e, smem, wvs, 64 * 13); } }
  }
  xcd_barrier(xb, wvs);
  {
  PH_BEGIN
  for (int rep_ = 0; rep_ < REPC; ++rep_) {
  conv_phase(p, wvs);
  for (int u = bid; u < 384 * 8; u += G) s5_unit<0>(p, u >> 3, u & 7, hs, wvs);
  }
  }
  xcd_barrier(xb, wvs);
  {
  PH_BEGIN
  for (int rep_ = 0; rep_ < REPS; ++rep_) {
    if (bid < 128) state_unit<2>(p, bid >> 4, bid & 15, 0, hs, wvs);
    for (int j = bid < 128 ? bid : 256 + (bid - 128); j < 3136; j += (bid < 128 ? 128 : 384)) {
      if (bid < 128 && j >= 256) break;
      if (j < 1088) { int tq_ = TIDX(wvs) & 255; asm volatile("" : "+v"(tq_)); s5_prefix(p, j * 256 + tq_); }
      else { const int v = j - 1088; state_unit<2>(p, 8 + (v >> 4), v & 15, 0, hs, wvs); }
    }
  }
  }
  xcd_barrier(xb, wvs);
  {
  PH_BEGIN
  for (int u = bid; u < 384 * 16 + 384 * 8; u += G) {
    if (u < 384 * 16) out_unit<2>(p, u >> 4, u & 15, hs, wvs);
    else { const int v = u - 384 * 16; s5_unit<1>(p, v >> 3, v & 7, hs, wvs); }
  }
  }
  xcd_barrier(xb, wvs);
  {
  PH_BEGIN
  ssdnorm_phase(p, wvs);
  { EpiGlu e{(const bf16_t*)(p.ws + OFF_GBUF), p.b_glu, bufH};
    for (int rep_ = 0; rep_ < REPG; ++rep_) { gemm_phase((const bf16_t*)(p.ws + OFF_GBUF), 512, (const bf16_t*)(p.ws + W_GLU), 512, 64, 2, 512, e, smem, wvs); gemm_tail((const bf16_t*)(p.ws + OFF_GBUF), 512, (const bf16_t*)(p.ws + W_GLU), 512, 4, 512, e, smem, wvs, 64 * 2); } }
  }
  xcd_barrier(xb, wvs);
  {
  PH_BEGIN
  { EpiOut e{t0, rowss + 2 * ROWS}; for (int rep_ = 0; rep_ < REPG; ++rep_) { gemm_phase(bufH, 1536, (const bf16_t*)(p.ws + W_OUT1), 1536, 64, 4, 1536, e, smem, wvs); gemm_tail(bufH, 1536, (const bf16_t*)(p.ws + W_OUT1), 1536, 8, 1536, e, smem, wvs, 64 * 4); } }
  }
  xcd_barrier(xb, wvs);
  {
  PH_BEGIN
  rowpass_phase(t0, rowss + 2 * ROWS, p.norm_mix_post + 1024, hbuf, hbuf + (size_t)16384 * 1024, hbuf, p.norm_ffn_pre + 1024, bufH, wvs);
  }
  xcd_barrier(xb, wvs);
  {
  PH_BEGIN
  { EpiUp e{bufA}; for (int rep_ = 0; rep_ < REPG; ++rep_) { gemm_phase(bufH, 1024, (const bf16_t*)(p.ws + W_UP), 1024, 64, 16, 1024, e, smem, wvs); gemm_tail(bufH, 1024, (const bf16_t*)(p.ws + W_UP), 1024, 32, 1024, e, smem, wvs, 64 * 16); } }
  }
  xcd_barrier(xb, wvs);
  {
  PH_BEGIN
  { EpiOut e{t0, rowss + 3 * ROWS}; for (int rep_ = 0; rep_ < REPG; ++rep_) { gemm_phase(bufA, 4096, (const bf16_t*)(p.ws + W_DOWN), 4096, 64, 4, 4096, e, smem, wvs); gemm_tail(bufA, 4096, (const bf16_t*)(p.ws + W_DOWN), 4096, 8, 4096, e, smem, wvs, 64 * 4); } }
  }
  xcd_barrier(xb, wvs);
  {
  PH_BEGIN
  rowpass_phase(t0, rowss + 3 * ROWS, p.norm_ffn_post + 1024, hbuf, hbuf + (size_t)16384 * 1024, hbuf, nullptr, nullptr, wvs);
  }
}

extern "C" void kernel_launch(void* const* d_in, const int* in_sizes, int n_in, void* d_out, int out_size, void* d_ws, size_t ws_size, hipStream_t stream) {
  constexpr size_t kDynLds = 2 * HALF_LDS + 64;
  static int grid_blocks = 0;
  if (!grid_blocks) {
    int dev = 0, cus = 0, per_cu = 0;
    (void)hipGetDevice(&dev);
    (void)hipDeviceGetAttribute(&cus, hipDeviceAttributeMultiprocessorCount, dev);
    (void)hipFuncSetAttribute((const void*)fwd_megakernel, hipFuncAttributeMaxDynamicSharedMemorySize, (int)kDynLds);
    (void)hipOccupancyMaxActiveBlocksPerMultiprocessor(&per_cu, fwd_megakernel, NTHR, kDynLds);
    if (per_cu > 1) per_cu = 1;
    if (per_cu < 1) per_cu = 1;
    grid_blocks = cus * per_cu;
  }
  Params p{};
  const float** pf = (const float**)&p;
  for (int i = 0; i < 37; ++i) pf[i] = (const float*)d_in[i];
  p.out = (float*)d_out;
  p.ws = (char*)d_ws;
  (void)hipMemsetAsync((char*)d_ws + OFF_BAR, 0, 16384, stream);
  void* args[] = {&p};
  hipError_t e = hipLaunchCooperativeKernel((void*)fwd_megakernel, dim3(grid_blocks), dim3(NTHR), args, kDynLds, stream);
  if (e != hipSuccess) fprintf(stderr, "cooperative launch failed: %s (grid %d)\n", hipGetErrorString(e), grid_blocks);
}
```

```cpp
#include <hip/hip_runtime.h>
#include <hip/hip_cooperative_groups.h>
#include <cstdio>
namespace cg = cooperative_groups;

typedef unsigned short bf16_t;
typedef short bf16x8 __attribute__((ext_vector_type(8)));
typedef float f32x4 __attribute__((ext_vector_type(4)));
typedef unsigned u32x4 __attribute__((ext_vector_type(4)));
typedef float f32x2 __attribute__((ext_vector_type(2)));

#define NTHR 512
#ifndef REPS
#define REPS 1
#endif
#ifndef REPO
#define REPO 1
#endif
#ifndef REPC
#define REPC 1
#endif
#ifndef REPR
#define REPR 1
#endif
#ifndef REPG
#define REPG 1
#endif
#define HALF_LDS 73728
#ifndef REP0
#define REP0 1
#endif
#ifndef REPS
#define REPS 1
#endif
#ifndef REPO
#define REPO 1
#endif
#ifndef REPC
#define REPC 1
#endif
#ifndef REPY
#define REPY 21
#endif
#define ROWS 17408
#define EPSV 1e-6f
#define TIDX(w) ((w) * 64 + (int)__builtin_amdgcn_mbcnt_hi(~0u, __builtin_amdgcn_mbcnt_lo(~0u, 0u)))

constexpr size_t W_IN = 0;
constexpr size_t W_OUT0 = 8388608;
constexpr size_t W_GLU = 6815744;
constexpr size_t W_OUT1 = 7340032;
constexpr size_t W_UP = 10485760;
constexpr size_t W_DOWN = 18874368;
constexpr size_t OFF_A = 29360128;
constexpr size_t OFF_GBUF = OFF_A + 111411200;
constexpr size_t OFF_ST = OFF_A + 142606336;
constexpr size_t OFF_H = OFF_ST + 67108864;
constexpr size_t OFF_SM = OFF_H + 53477376;
constexpr size_t OFF_ROPE = OFF_SM;
constexpr size_t OFF_ROWSS = OFF_SM + 1052672;
constexpr size_t OFF_SSDST = OFF_SM + 1331200;
constexpr size_t OFF_DTBUF = OFF_SM + 1470464;
constexpr size_t OFF_LB = OFF_SM + 2584576;
constexpr size_t OFF_S5TAB = OFF_SM + 2586624;
constexpr size_t OFF_S5E = OFF_SM + 2897920;
constexpr size_t OFF_S5H = OFF_SM + 9189376;
constexpr size_t OFF_BAR = OFF_SM + 15480832;

constexpr size_t O_RET = 17825792, O_HG = 26738688, O_SSM = 35651584, O_CONV = 53477376, O_S5RE = 54104064, O_S5IM = 54382592;

struct Params {
  const float *x_prompt, *x_sample, *state_ret, *state_hgrn, *state_ssm, *state_conv, *state_s5_re, *state_s5_im;
  const float *norm_mix_pre, *norm_mix_post, *norm_ffn_pre, *norm_ffn_post;
  const float *w_in_even, *w_out_even, *ret_norm_w, *hgrn_lb, *hgrn_norm_w, *w_in_odd, *conv_w, *conv_b, *dt_bias, *a_log, *d_ssm, *ssm_norm_w;
  const float *s5_lam_re, *s5_lam_im, *s5_log_step, *s5_b_re, *s5_b_im, *s5_c_re, *s5_c_im, *s5_d, *w_glu, *b_glu, *w_out_odd, *w_ffn_up, *w_ffn_down;
  float* out;
  char* ws;
};

__device__ __forceinline__ bf16_t f2bf(float f) { unsigned r; asm("v_cvt_pk_bf16_f32 %0, %1, %1" : "=v"(r) : "v"(f)); return (bf16_t)(r & 0xffffu); }
__device__ __forceinline__ float bf2f(bf16_t h) { return __uint_as_float(((unsigned)h) << 16); }
__device__ __forceinline__ unsigned pack2(float a, float b) { unsigned r; asm("v_cvt_pk_bf16_f32 %0, %1, %2" : "=v"(r) : "v"(a), "v"(b)); return r; }
__device__ __forceinline__ float lo2f(unsigned u) { return __uint_as_float(u << 16); }
__device__ __forceinline__ float hi2f(unsigned u) { return __uint_as_float(u & 0xffff0000u); }
__device__ __forceinline__ float sigm(float x) { return 1.f / (1.f + __expf(-x)); }
__device__ __forceinline__ float siluf(float x) { return x / (1.f + __expf(-x)); }
__device__ __forceinline__ void store4bf(bf16_t* p, float a, float b, float c, float d) { uint2 v; v.x = pack2(a, b); v.y = pack2(c, d); *(uint2*)p = v; }

__device__ __forceinline__ float shx(float v, int mask) {
  int l = (int)__builtin_amdgcn_mbcnt_hi(~0u, __builtin_amdgcn_mbcnt_lo(~0u, 0u));
  asm volatile("" : "+v"(l));
  return __int_as_float(__builtin_amdgcn_ds_bpermute((l ^ mask) << 2, __float_as_int(v)));
}

template <int MT, int NT>
__device__ __forceinline__ void wmma_sw(f32x4 (&acc)[MT][NT], const bf16_t* A, int lda, const bf16_t* B, int ldb, int K, int lane) {
  const int r = lane & 15, kq = (lane >> 4) * 8;
  for (int k0 = 0; k0 < K; k0 += 32) {
    bf16x8 af[MT], bfr[NT];
#pragma unroll
    for (int mt = 0; mt < MT; ++mt) af[mt] = *(const bf16x8*)(A + (mt * 16 + r) * lda + k0 + kq);
#pragma unroll
    for (int nt = 0; nt < NT; ++nt) bfr[nt] = *(const bf16x8*)(B + (nt * 16 + r) * ldb + k0 + kq);
#pragma unroll
    for (int mt = 0; mt < MT; ++mt)
#pragma unroll
      for (int nt = 0; nt < NT; ++nt) acc[mt][nt] = __builtin_amdgcn_mfma_f32_16x16x32_bf16(bfr[nt], af[mt], acc[mt][nt], 0, 0, 0);
  }
}
template <int MT, int NT>
__device__ __forceinline__ void wmma_ns(f32x4 (&acc)[MT][NT], const bf16_t* A, int lda, const bf16_t* B, int ldb, int K, int lane) {
  const int r = lane & 15, kq = (lane >> 4) * 8;
  for (int k0 = 0; k0 < K; k0 += 32) {
    bf16x8 af[MT], bfr[NT];
#pragma unroll
    for (int mt = 0; mt < MT; ++mt) af[mt] = *(const bf16x8*)(A + (mt * 16 + r) * lda + k0 + kq);
#pragma unroll
    for (int nt = 0; nt < NT; ++nt) bfr[nt] = *(const bf16x8*)(B + (nt * 16 + r) * ldb + k0 + kq);
#pragma unroll
    for (int mt = 0; mt < MT; ++mt)
#pragma unroll
      for (int nt = 0; nt < NT; ++nt) acc[mt][nt] = __builtin_amdgcn_mfma_f32_16x16x32_bf16(af[mt], bfr[nt], acc[mt][nt], 0, 0, 0);
  }
}

__device__ __forceinline__ void gemm_kstep(f32x4 (&acc)[4][8], const bf16_t* A, const bf16_t* B, int lane) {
  const int r = lane & 15, kq = (lane >> 4) * 8;
  bf16x8 af[4], bfr[8];
#pragma unroll
  for (int mt = 0; mt < 4; ++mt) af[mt] = *(const bf16x8*)(A + (mt * 16 + r) * 72 + kq);
#pragma unroll
  for (int nt = 0; nt < 8; ++nt) bfr[nt] = *(const bf16x8*)(B + (nt * 16 + r) * 72 + kq);
  __builtin_amdgcn_sched_barrier(0);
#pragma unroll
  for (int nt = 0; nt < 8; ++nt)
#pragma unroll
    for (int mt = 0; mt < 4; ++mt) acc[mt][nt] = __builtin_amdgcn_mfma_f32_16x16x32_bf16(bfr[nt], af[mt], acc[mt][nt], 0, 0, 0);
}

template <class Epi>
__device__ __forceinline__ void gemm_phase(const bf16_t* A, int lda, const bf16_t* Bt, int ldb, int nMt, int nNt, int K, const Epi& epi, char* smem, int wvs) {
  bf16_t* As = (bf16_t*)smem;
  bf16_t* Bs = As + 2 * 256 * 72;
  int tid_ = TIDX(wvs); asm volatile("" : "+v"(tid_)); const int tid = tid_, lane = tid & 63, wave = tid >> 6;
  const int wr = wave >> 1, wc = wave & 1;
  const int ntiles = nMt * nNt, nk = K >> 6;
  const int lrow = tid >> 3, lcc = (tid & 7) * 8;
  const unsigned toffA = (unsigned)(lrow * lda + lcc), toffB = (unsigned)(lrow * ldb + lcc);
  for (int tile = blockIdx.x; tile < ntiles; tile += gridDim.x) {
    const int pn = tile / nMt, pm = tile - pn * nMt;
    const bf16_t* Ab = A + (size_t)(pm * 256) * lda;
    const bf16_t* Bb = Bt + (size_t)(pn * 256) * ldb;
    f32x4 acc[4][8];
#pragma unroll
    for (int i = 0; i < 4; ++i)
#pragma unroll
      for (int j = 0; j < 8; ++j) acc[i][j] = (f32x4){0.f, 0.f, 0.f, 0.f};
    u32x4 rg[4];
#pragma unroll
    for (int i = 0; i < 4; ++i) rg[i] = *(const u32x4*)(Ab + (size_t)(i * 64) * lda + toffA);
#pragma unroll
    for (int i = 0; i < 4; ++i) *(u32x4*)(As + (lrow + i * 64) * 72 + lcc) = rg[i];
#pragma unroll
    for (int i = 0; i < 4; ++i) rg[i] = *(const u32x4*)(Bb + (size_t)(i * 64) * ldb + toffB);
#pragma unroll
    for (int i = 0; i < 4; ++i) *(u32x4*)(Bs + (lrow + i * 64) * 72 + lcc) = rg[i];
    __syncthreads();
#pragma unroll 1
    for (int kt = 0; kt < nk; ++kt) {
      const int cur = kt & 1;
      const int kn = (kt + 1 < nk ? kt + 1 : kt) * 64;
      bf16_t* Ad = As + (cur ^ 1) * 256 * 72; bf16_t* Bd = Bs + (cur ^ 1) * 256 * 72;
#pragma unroll
      for (int i = 0; i < 4; ++i) rg[i] = *(const u32x4*)(Ab + ((size_t)(i * 64) * lda + kn) + toffA);
      __builtin_amdgcn_sched_barrier(0);
      gemm_kstep(acc, As + cur * 256 * 72 + wr * 64 * 72, Bs + cur * 256 * 72 + wc * 128 * 72, lane);
      __builtin_amdgcn_sched_barrier(0);
#pragma unroll
      for (int i = 0; i < 4; ++i) *(u32x4*)(Ad + (lrow + i * 64) * 72 + lcc) = rg[i];
#pragma unroll
      for (int i = 0; i < 4; ++i) rg[i] = *(const u32x4*)(Bb + ((size_t)(i * 64) * ldb + kn) + toffB);
      __builtin_amdgcn_sched_barrier(0);
      gemm_kstep(acc, As + cur * 256 * 72 + wr * 64 * 72 + 32, Bs + cur * 256 * 72 + wc * 128 * 72 + 32, lane);
      __builtin_amdgcn_sched_barrier(0);
#pragma unroll
      for (int i = 0; i < 4; ++i) *(u32x4*)(Bd + (lrow + i * 64) * 72 + lcc) = rg[i];
      __syncthreads();
    }
    int er_ = pm * 256 + wr * 64, ec_ = pn * 256 + wc * 128, el_ = lane;
    asm volatile("" : "+v"(er_), "+v"(ec_), "+v"(el_));
    epi(acc, er_, ec_, el_);
  }
}

struct EpiInEven {
  bf16_t* proj; const float* rope; const float* lb;
  template <int MT> __device__ __forceinline__ void operator()(f32x4 (&acc)[MT][8], int rbase, int cbase, int lane) const {
    const int sec = cbase >> 9, head = (cbase >> 7) & 3, r = lane & 15, cq = (lane >> 4) * 4;
#pragma unroll
    for (int mt = 0; mt < MT; ++mt) {
      __builtin_amdgcn_sched_barrier(0);
      const int row = rbase + mt * 16 + r;
      bf16_t* dst = proj + (size_t)row * 4096 + cbase + cq;
      if (sec < 2) {
        const int pidx = row < 16384 ? (row & 2047) : 2048 + ((row - 16384) & 7);
        const float* ct = rope + pidx * 128 + cq;
        const float sc = sec == 1 ? 0.08838834764831845f : 1.f;
#pragma unroll
        for (int nt = 0; nt < 4; ++nt) {
          const float4 c4 = *(const float4*)(ct + nt * 16), s4 = *(const float4*)(ct + 64 + nt * 16);
          const f32x4 x1 = acc[mt][nt], x2 = acc[mt][nt + 4];
          store4bf(dst + nt * 16, (x1[0] * c4.x - x2[0] * s4.x) * sc, (x1[1] * c4.y - x2[1] * s4.y) * sc, (x1[2] * c4.z - x2[2] * s4.z) * sc, (x1[3] * c4.w - x2[3] * s4.w) * sc);
          store4bf(dst + 64 + nt * 16, (x1[0] * s4.x + x2[0] * c4.x) * sc, (x1[1] * s4.y + x2[1] * c4.y) * sc, (x1[2] * s4.z + x2[2] * c4.z) * sc, (x1[3] * s4.w + x2[3] * c4.w) * sc);
        }
      } else if (sec == 5) {
#pragma unroll
        for (int nt = 0; nt < 8; ++nt) {
          const float4 l4 = *(const float4*)(lb + head * 128 + nt * 16 + cq);
          const f32x4 x = acc[mt][nt];
          store4bf(dst + nt * 16, __logf(l4.x + (1.f - l4.x) * sigm(x[0])), __logf(l4.y + (1.f - l4.y) * sigm(x[1])), __logf(l4.z + (1.f - l4.z) * sigm(x[2])), __logf(l4.w + (1.f - l4.w) * sigm(x[3])));
        }
      } else {
#pragma unroll
        for (int nt = 0; nt < 8; ++nt) { const f32x4 x = acc[mt][nt]; store4bf(dst + nt * 16, x[0], x[1], x[2], x[3]); }
      }
    }
  }
};
struct EpiOut {
  bf16_t* t0; float* rowss;
  template <int MT> __device__ __forceinline__ void operator()(f32x4 (&acc)[MT][8], int rbase, int cbase, int lane) const {
    const int r = lane & 15, cq = (lane >> 4) * 4;
#pragma unroll
    for (int mt = 0; mt < MT; ++mt) {
      __builtin_amdgcn_sched_barrier(0);
      const int row = rbase + mt * 16 + r;
      bf16_t* dst = t0 + (size_t)row * 1024 + cbase + cq;
      float ss = 0.f;
#pragma unroll
      for (int nt = 0; nt < 8; ++nt) { const f32x4 x = acc[mt][nt]; ss += x[0] * x[0] + x[1] * x[1] + x[2] * x[2] + x[3] * x[3]; store4bf(dst + nt * 16, x[0], x[1], x[2], x[3]); }
      ss += shx(ss, 16); ss += shx(ss, 32);
      if (lane < 16) atomicAdd(rowss + row, ss * (1.f / REPG));
    }
  }
};
struct EpiUp {
  bf16_t* act;
  template <int MT> __device__ __forceinline__ void operator()(f32x4 (&acc)[MT][8], int rbase, int cbase, int lane) const {
    const int r = lane & 15, cq = (lane >> 4) * 4;
#pragma unroll
    for (int mt = 0; mt < MT; ++mt) {
      __builtin_amdgcn_sched_barrier(0);
      bf16_t* dst = act + (size_t)(rbase + mt * 16 + r) * 4096 + cbase + cq;
#pragma unroll
      for (int nt = 0; nt < 8; ++nt) { f32x4 x = acc[mt][nt];
#pragma unroll
        for (int j = 0; j < 4; ++j) { float v = fmaxf(x[j], 0.f); x[j] = v * v; }
        store4bf(dst + nt * 16, x[0], x[1], x[2], x[3]); }
    }
  }
};
struct EpiInOdd {
  bf16_t* proj; float* dtbuf;
  template <int MT> __device__ __forceinline__ void operator()(f32x4 (&acc)[MT][8], int rbase, int cbase, int lane) const {
    const int r = lane & 15, cq = (lane >> 4) * 4;
#pragma unroll
    for (int mt = 0; mt < MT; ++mt) {
      __builtin_amdgcn_sched_barrier(0);
      const int row = rbase + mt * 16 + r;
      bf16_t* dst = proj + (size_t)row * 3200 + cbase + cq;
#pragma unroll
      for (int nt = 0; nt < 8; ++nt) { const f32x4 x = acc[mt][nt]; if (cbase + nt * 16 < 3200) store4bf(dst + nt * 16, x[0], x[1], x[2], x[3]); }
      if (cbase == 2560) { const f32x4 x = acc[mt][0]; *(float4*)(dtbuf + (size_t)row * 16 + cq) = make_float4(x[0], x[1], x[2], x[3]); }
    }
  }
};
struct EpiGlu {
  const bf16_t* gbuf; const float* bglu; bf16_t* mix;
  template <int MT> __device__ __forceinline__ void operator()(f32x4 (&acc)[MT][8], int rbase, int cbase, int lane) const {
    const int r = lane & 15, cq = (lane >> 4) * 4;
#pragma unroll
    for (int mt = 0; mt < MT; ++mt) {
      __builtin_amdgcn_sched_barrier(0);
      const int row = rbase + mt * 16 + r;
#pragma unroll
      for (int nt = 0; nt < 8; ++nt) {
        const int col = cbase + nt * 16 + cq;
        const f32x4 x = acc[mt][nt];
        const uint2 g2 = *(const uint2*)(gbuf + (size_t)row * 512 + col);
        const float4 b4 = *(const float4*)(bglu + col);
        store4bf(mix + (size_t)row * 1536 + 1024 + col, lo2f(g2.x) * sigm(x[0] + b4.x), hi2f(g2.x) * sigm(x[1] + b4.y), lo2f(g2.y) * sigm(x[2] + b4.z), hi2f(g2.y) * sigm(x[3] + b4.w));
      }
    }
  }
};

template <class Epi>
__device__ __forceinline__ void gemm_tail(const bf16_t* A, int lda, const bf16_t* Bt, int ldb, int nNt128, int K, const Epi& epi, char* smem, int wvs, int nBig) {
  bf16_t* As = (bf16_t*)smem;
  bf16_t* Bs = As + 2 * 128 * 72;
  int tid_ = TIDX(wvs); asm volatile("" : "+v"(tid_)); const int tid = tid_, lane = tid & 63, wave = tid >> 6;
  const int nk = K >> 6, G = gridDim.x;
  const int lrow = tid >> 3, lcc = (tid & 7) * 8;
  const unsigned toffA = (unsigned)(lrow * lda + lcc), toffB = (unsigned)(lrow * ldb + lcc);
  const int rr = nBig % G, nLight = G - rr;
  const int nSmall = 8 * nNt128;
  if ((int)blockIdx.x >= rr) {
    for (int j = (int)blockIdx.x - rr; j < nSmall; j += nLight) {
      const int pm = j / nNt128, pn = j - pm * nNt128;
      const bf16_t* Ab = A + (size_t)(16384 + pm * 128) * lda;
      const bf16_t* Bb = Bt + (size_t)(pn * 128) * ldb;
      f32x4 acc[1][8];
#pragma unroll
      for (int q = 0; q < 8; ++q) acc[0][q] = (f32x4){0.f, 0.f, 0.f, 0.f};
      u32x4 ra[2], rb[2];
#pragma unroll
      for (int i = 0; i < 2; ++i) { ra[i] = *(const u32x4*)(Ab + (size_t)(i * 64) * lda + toffA); rb[i] = *(const u32x4*)(Bb + (size_t)(i * 64) * ldb + toffB); }
#pragma unroll
      for (int i = 0; i < 2; ++i) { *(u32x4*)(As + (lrow + i * 64) * 72 + lcc) = ra[i]; *(u32x4*)(Bs + (lrow + i * 64) * 72 + lcc) = rb[i]; }
      __syncthreads();
#pragma unroll 1
      for (int kt = 0; kt < nk; ++kt) {
        const int cur = kt & 1;
        const int kn = (kt + 1 < nk ? kt + 1 : kt) * 64;
#pragma unroll
        for (int i = 0; i < 2; ++i) { ra[i] = *(const u32x4*)(Ab + ((size_t)(i * 64) * lda + kn) + toffA); rb[i] = *(const u32x4*)(Bb + ((size_t)(i * 64) * ldb + kn) + toffB); }
        __builtin_amdgcn_sched_barrier(0);
        wmma_sw<1, 8>(acc, As + cur * 128 * 72 + wave * 16 * 72, 72, Bs + cur * 128 * 72, 72, 64, lane);
        __builtin_amdgcn_sched_barrier(0);
        bf16_t* Ad = As + (cur ^ 1) * 128 * 72; bf16_t* Bd = Bs + (cur ^ 1) * 128 * 72;
#pragma unroll
        for (int i = 0; i < 2; ++i) { *(u32x4*)(Ad + (lrow + i * 64) * 72 + lcc) = ra[i]; *(u32x4*)(Bd + (lrow + i * 64) * 72 + lcc) = rb[i]; }
        __syncthreads();
      }
      int er_ = 16384 + pm * 128 + wave * 16, ec_ = pn * 128, el_ = lane;
      asm volatile("" : "+v"(er_), "+v"(ec_), "+v"(el_));
      epi(acc, er_, ec_, el_);
    }
  }
}

__device__ __forceinline__ void rowpass_phase(const bf16_t* t0, const float* rowss, const float* wpost, const float* hin_a, const float* hin_b, float* hout, const float* wnext, bf16_t* hn, int wvs) {
  int tq_ = TIDX(wvs); asm volatile("" : "+v"(tq_)); const int lane = tq_ & 63, gw = blockIdx.x * 8 + (tq_ >> 6), nw = gridDim.x * 8;
  for (int row = gw; row < ROWS; row += nw) {
    const float* hin = row < 16384 ? hin_a + (size_t)row * 1024 : hin_b + (size_t)(row - 16384) * 1024;
    float r0 = 0.f;
    if (t0) r0 = rsqrtf(rowss[row] * (1.f / 1024.f) + EPSV);
    float4 v[4]; float ss = 0.f;
#pragma unroll
    for (int i = 0; i < 4; ++i) {
      const int col = (i * 64 + lane) * 4;
      float4 hv = *(const float4*)(hin + col);
      if (t0) {
        const uint2 t2 = *(const uint2*)(t0 + (size_t)row * 1024 + col);
        const float4 w4 = *(const float4*)(wpost + col);
        hv.x += lo2f(t2.x) * r0 * w4.x; hv.y += hi2f(t2.x) * r0 * w4.y; hv.z += lo2f(t2.y) * r0 * w4.z; hv.w += hi2f(t2.y) * r0 * w4.w;
      }
      v[i] = hv; ss += hv.x * hv.x + hv.y * hv.y + hv.z * hv.z + hv.w * hv.w;
      if (hout) *(float4*)(hout + (size_t)row * 1024 + col) = hv;
    }
    if (hn) {
#pragma unroll
      for (int o = 32; o >= 1; o >>= 1) ss += shx(ss, o);
      const float r1 = rsqrtf(ss * (1.f / 1024.f) + EPSV);
#pragma unroll
      for (int i = 0; i < 4; ++i) {
        const int col = (i * 64 + lane) * 4;
        const float4 w4 = *(const float4*)(wnext + col);
        store4bf(hn + (size_t)row * 1024 + col, v[i].x * r1 * w4.x, v[i].y * r1 * w4.y, v[i].z * r1 * w4.z, v[i].w * r1 * w4.w);
      }
    }
  }
}

__device__ __forceinline__ void wconv(const float* __restrict__ W, int K, int N, int Npad, bf16_t* __restrict__ Wt, char* smem, int wvs) {
  float* tile = (float*)smem;
  int tq_ = TIDX(wvs) & 255; asm volatile("" : "+v"(tq_)); const int tid = tq_;
  const int nNt = Npad >> 6, nunits = (K >> 6) * nNt;
  for (int u = blockIdx.x * 2 + (wvs >> 2); u < nunits; u += gridDim.x * 2) {
    const int k0 = (u / nNt) * 64, n0 = (u % nNt) * 64;
#pragma unroll
    for (int ps = 0; ps < 4; ++ps) {
      const int i = ps * 16 + (tid >> 4), j = (tid & 15) * 4, n = n0 + j;
      float4 v = make_float4(0.f, 0.f, 0.f, 0.f);
      if (n < N) v = *(const float4*)(W + (size_t)(k0 + i) * N + n);
      tile[i * 65 + j] = v.x; tile[i * 65 + j + 1] = v.y; tile[i * 65 + j + 2] = v.z; tile[i * 65 + j + 3] = v.w;
    }
    __syncthreads();
    {
      const int n = tid >> 2, kq = (tid & 3) * 16;
      uint4 o0, o1;
      o0.x = pack2(tile[(kq + 0) * 65 + n], tile[(kq + 1) * 65 + n]); o0.y = pack2(tile[(kq + 2) * 65 + n], tile[(kq + 3) * 65 + n]);
      o0.z = pack2(tile[(kq + 4) * 65 + n], tile[(kq + 5) * 65 + n]); o0.w = pack2(tile[(kq + 6) * 65 + n], tile[(kq + 7) * 65 + n]);
      o1.x = pack2(tile[(kq + 8) * 65 + n], tile[(kq + 9) * 65 + n]); o1.y = pack2(tile[(kq + 10) * 65 + n], tile[(kq + 11) * 65 + n]);
      o1.z = pack2(tile[(kq + 12) * 65 + n], tile[(kq + 13) * 65 + n]); o1.w = pack2(tile[(kq + 14) * 65 + n], tile[(kq + 15) * 65 + n]);
      bf16_t* d = Wt + (size_t)(n0 + n) * K + k0 + kq;
      *(uint4*)d = o0; *(uint4*)(d + 8) = o1;
    }
    __syncthreads();
  }
}

__device__ __forceinline__ void prep_tables(const Params& p, int wvs) {
  int tq_ = TIDX(wvs); asm volatile("" : "+v"(tq_)); const int gt = blockIdx.x * NTHR + tq_, nt = gridDim.x * NTHR;
  float* rope = (float*)(p.ws + OFF_ROPE);
  for (int i = gt; i < 2056 * 64; i += nt) {
    const int pi = i >> 6, f = i & 63;
    const double pos = pi < 2048 ? (double)pi : (double)(16384 + pi - 2048);
    const double invf = exp(-(double)f * (9.210340371976184 / 64.0));
    double ang = pos * invf;
    ang -= 6.283185307179586 * floor(ang * 0.15915494309189535);
    const float a = (float)ang;
    rope[pi * 128 + f] = cosf(a); rope[pi * 128 + 64 + f] = sinf(a);
  }
  float* z = (float*)(p.ws + OFF_ROWSS);
  for (int i = gt; i < ROWS * 6; i += nt) z[i] = 0.f;
  float* lb = (float*)(p.ws + OFF_LB);
  for (int i = gt; i < 512; i += nt) lb[i] = 1.f / (1.f + expf(p.hgrn_lb[512 + i] - p.hgrn_lb[i]));
  float* tab = (float*)(p.ws + OFF_S5TAB);
  for (int i = gt; i < 2048; i += nt) {
    const int g = i >> 6;
    const float lr = p.s5_lam_re[i], li = p.s5_lam_im[i], dt = expf(p.s5_log_step[g]);
    const float m1 = expf(lr * dt), br = m1 * cosf(li * dt), bi = m1 * sinf(li * dt);
    tab[i] = br; tab[2048 + i] = bi;
    const float m64 = expf(lr * dt * 64.f); tab[69632 + i] = m64 * cosf(li * dt * 64.f); tab[71680 + i] = m64 * sinf(li * dt * 64.f);
    const float m8 = expf(lr * dt * 8.f); tab[73728 + i] = m8 * cosf(li * dt * 8.f); tab[75776 + i] = m8 * sinf(li * dt * 8.f);
    const float x = br - 1.f, y = bi, den = 1.f / (lr * lr + li * li);
    const float qr = (x * lr + y * li) * den, qi = (y * lr - x * li) * den;
    for (int c = 0; c < 16; ++c) {
      const float b_r = p.s5_b_re[i * 16 + c], b_i = p.s5_b_im[i * 16 + c];
      tab[4096 + i * 16 + c] = qr * b_r - qi * b_i;
      tab[4096 + 32768 + i * 16 + c] = qr * b_i + qi * b_r;
    }
  }
}

__device__ __forceinline__ void chunk_geom(int c, int& row0, int& L) { if (c < 256) { row0 = c * 64; L = 64; } else { row0 = 16384 + (c - 256) * 8; L = 8; } }

template <int MODE>
__device__ __forceinline__ void st_load(uint4 (&kr)[4], uint4 (&vr)[(MODE == 2) ? 2 : 1], float& dtr, const bf16_t* src, const float* dtbuf, int row0, int L, int ld, int kcol, int vcol, int h, int tid) {
  constexpr int PW = (MODE == 2) ? 64 : 32, NVC = PW / 32, VCR = PW / 8;
  const uint4 z4 = make_uint4(0, 0, 0, 0);
#pragma unroll
  for (int i = 0; i < 4; ++i) { const int id = tid + i * 256, s = id >> 4, c8 = id & 15; uint4 t_ = z4; if (s < L) t_ = *(const uint4*)(src + (size_t)(row0 + s) * ld + kcol + c8 * 8); kr[i] = t_; }
#pragma unroll
  for (int i = 0; i < NVC; ++i) { const int id = tid + i * 256, s = id / VCR, c8 = id % VCR; uint4 t_ = z4; if (s < L) t_ = *(const uint4*)(src + (size_t)(row0 + s) * ld + vcol + c8 * 8); vr[i] = t_; }
  if (MODE == 2 && tid < 64) dtr = tid < L ? dtbuf[(size_t)(row0 + tid) * 16 + h] : 0.f;
}

template <int MODE>
__device__ __forceinline__ void state_unit(const Params& p, int sq, int h, int ps, char* smem, int wvs) {
  constexpr int PW = (MODE == 2) ? 64 : 32, NT = PW / 16, PF = (MODE == 2) ? 64 : 128, HH = (MODE == 2) ? 16 : 4, NVC = PW / 32, VCR = PW / 8;
  bf16_t* KT = (bf16_t*)smem;
  bf16_t* VT = KT + 128 * 72;
  bf16_t* KR = VT + 64 * 72;
  float* tot = (float*)(KR + 64 * 136);
  float* dec = tot + 256;
  float* av = dec + 64;
  float* dtv = av + 64;
  int tid_ = TIDX(wvs) & 255; asm volatile("" : "+v"(tid_)); const int tid = tid_, lane = tid & 63, wave = tid >> 6;
  const bool prompt = sq < 8;
  const int nch = prompt ? 32 : 1, L = prompt ? 64 : 8;
  const int ld = (MODE == 2) ? 1536 : 4096;
  const bf16_t* src = (MODE == 2) ? (const bf16_t*)(p.ws + OFF_H) : (const bf16_t*)(p.ws + OFF_A);
  const int kcol = MODE == 0 ? 512 + h * 128 : MODE == 1 ? 2560 + h * 128 : 1024 + (h >> 3) * 128;
  const int vcol = MODE == 0 ? 1024 + h * 128 + ps * 32 : MODE == 1 ? 3072 + h * 128 + ps * 32 : h * 64;
  const float* sin_ = MODE == 0 ? p.state_ret : MODE == 1 ? p.state_hgrn : p.state_ssm;
  float* sout = p.out + (MODE == 0 ? O_RET : MODE == 1 ? O_HG : O_SSM) + (size_t)(sq * HH + h) * 128 * PF;
  bf16_t* stb = (bf16_t*)(p.ws + OFF_ST) + (MODE == 1 ? (size_t)256 * 4 * 128 * 128 : 0);
  const float* dtbuf = (const float*)(p.ws + OFF_DTBUF);
  const float l2g = MODE == 0 ? log2f(1.f - exp2f(-5.f - (float)h)) : 0.f;
  float Ah = 0.f, dtb = 0.f;
  if (MODE == 2) { Ah = -expf(p.a_log[h]); dtb = p.dt_bias[h]; }

  f32x4 acc[2][NT];
  const int nb = wave * 32 + (lane >> 4) * 4, pc = ps * PW + (lane & 15);
#pragma unroll
  for (int mt = 0; mt < 2; ++mt)
#pragma unroll
    for (int nt = 0; nt < NT; ++nt)
#pragma unroll
      for (int j = 0; j < 4; ++j)
        acc[mt][nt][j] = prompt ? 0.f : sin_[((size_t)((sq - 8) * HH + h) * 128 + nb + mt * 16 + j) * PF + pc + nt * 16];

  uint4 kr[4], vr[NVC]; float dtr = 0.f;
  const uint4 z4 = make_uint4(0, 0, 0, 0);
  st_load<MODE>(kr, vr, dtr, src, dtbuf, prompt ? sq * 2048 : 16384 + (sq - 8) * 8, L, ld, kcol, vcol, h, tid);
  for (int n = 0; n < nch; ++n) {
    if (prompt) {
      bf16_t* d = stb + ((size_t)((sq * 32 + n) * HH + h) * PF) * 128;
#pragma unroll
      for (int mt = 0; mt < 2; ++mt)
#pragma unroll
        for (int nt = 0; nt < NT; ++nt) store4bf(d + (size_t)(pc + nt * 16) * 128 + nb + mt * 16, acc[mt][nt][0], acc[mt][nt][1], acc[mt][nt][2], acc[mt][nt][3]);
    }
#pragma unroll
    for (int i = 0; i < 4; ++i) { const int id = tid + i * 256, s = id >> 4, c8 = id & 15; *(uint4*)(KR + s * 136 + c8 * 8) = kr[i]; }
#pragma unroll
    for (int i = 0; i < NVC; ++i) {
      const int id = tid + i * 256, s = id / VCR, c8 = id % VCR; const uint4 v = vr[i];
      bf16_t* d = VT + (c8 * 8) * 72 + s;
      d[0] = (bf16_t)(v.x & 0xffff); d[72] = (bf16_t)(v.x >> 16); d[144] = (bf16_t)(v.y & 0xffff); d[216] = (bf16_t)(v.y >> 16);
      d[288] = (bf16_t)(v.z & 0xffff); d[360] = (bf16_t)(v.z >> 16); d[432] = (bf16_t)(v.w & 0xffff); d[504] = (bf16_t)(v.w >> 16);
    }
    if (MODE == 2 && tid < 64) {
      float dt = 0.f;
      if (tid < L) { const float x = dtr + dtb; dt = x > 20.f ? x : log1pf(__expf(x)); }
      dtv[tid] = dt; av[tid] = dt * Ah;
    }
    if (n + 1 < nch) st_load<MODE>(kr, vr, dtr, src, dtbuf, sq * 2048 + (n + 1) * 64, L, ld, kcol, vcol, h, tid);
    __syncthreads();
    const int kn = tid & 127, half = tid >> 7;
    if (MODE == 1) {
      float s_ = 0.f;
      for (int s = half * 32; s < half * 32 + 32; ++s) s_ += bf2f(KR[s * 136 + kn]);
      tot[half * 128 + kn] = s_;
    }
    if (MODE == 2 && tid < 64) {
      float suf = 0.f;
      for (int r = tid + 1; r < 64; ++r) suf += av[r];
      dec[tid] = __expf(suf) * dtv[tid];
      if (tid == 0) tot[0] = suf + av[0];
    }
    if (MODE != 0) __syncthreads();
    {
      float suf = 0.f;
      if (MODE == 1) suf = half == 0 ? tot[128 + kn] : 0.f;
      for (int g = 3; g >= 0; --g) {
        const int s0 = half * 32 + g * 8;
        float v[8];
#pragma unroll
        for (int e = 7; e >= 0; --e) {
          const int s = s0 + e;
          const float raw = bf2f(KR[s * 136 + kn]);
          if (MODE == 0) v[e] = raw * exp2f((float)(L - 1 - s) * l2g);
          else if (MODE == 1) { v[e] = (1.f - __expf(raw)) * __expf(suf); suf += raw; }
          else v[e] = raw * dec[s];
        }
        uint4 o; o.x = pack2(v[0], v[1]); o.y = pack2(v[2], v[3]); o.z = pack2(v[4], v[5]); o.w = pack2(v[6], v[7]);
        *(uint4*)(KT + kn * 72 + s0) = o;
      }
    }
    __syncthreads();
#pragma unroll
    for (int mt = 0; mt < 2; ++mt) {
      float dk[4];
      if (MODE == 0) { const float d = exp2f((float)L * l2g); dk[0] = dk[1] = dk[2] = dk[3] = d; }
      else if (MODE == 2) { const float d = __expf(tot[0]); dk[0] = dk[1] = dk[2] = dk[3] = d; }
      else {
#pragma unroll
        for (int j = 0; j < 4; ++j) { const int nn = nb + mt * 16 + j; dk[j] = __expf(tot[nn] + tot[128 + nn]); }
      }
#pragma unroll
      for (int nt = 0; nt < NT; ++nt)
#pragma unroll
        for (int j = 0; j < 4; ++j) acc[mt][nt][j] *= dk[j];
    }
    wmma_ns<2, NT>(acc, KT + wave * 32 * 72, 72, VT, 72, 64, lane);
    __syncthreads();
  }
#pragma unroll
  for (int mt = 0; mt < 2; ++mt)
#pragma unroll
    for (int nt = 0; nt < NT; ++nt)
#pragma unroll
      for (int j = 0; j < 4; ++j) sout[(size_t)(nb + mt * 16 + j) * PF + pc + nt * 16] = acc[mt][nt][j];
}

template <int MODE>
__device__ __forceinline__ void out_unit(const Params& p, int c, int h, char* smem, int wvs) {
  constexpr int PF = (MODE == 2) ? 64 : 128, NTP = PF / 16, HH = (MODE == 2) ? 16 : 4, NVC = PF / 32, VCR = PF / 8;
  bf16_t* Q = (bf16_t*)smem;
  bf16_t* Kb = Q + 64 * 136;
  bf16_t* STb = Kb + 128 * 72;
  float* cumv = (float*)(STb + 128 * 136);
  float* dtv = cumv + 64;
  float* av = dtv + 64;
  float* tot = av + 64;
  int tid_ = TIDX(wvs) & 255; asm volatile("" : "+v"(tid_)); const int tid = tid_, lane = tid & 63, wave = tid >> 6;
  int row0, L; chunk_geom(c, row0, L);
  const int ld = (MODE == 2) ? 1536 : 4096;
  const bf16_t* src = (MODE == 2) ? (const bf16_t*)(p.ws + OFF_H) : (const bf16_t*)(p.ws + OFF_A);
  const int qcol = MODE == 0 ? h * 128 : MODE == 1 ? 2048 + h * 128 : 1280 + (h >> 3) * 128;
  const int kcol = MODE == 0 ? 512 + h * 128 : MODE == 1 ? 2560 + h * 128 : 1024 + (h >> 3) * 128;
  const int vcol = MODE == 0 ? 1024 + h * 128 : MODE == 1 ? 3072 + h * 128 : h * 64;
  const float l2g = MODE == 0 ? log2f(1.f - exp2f(-5.f - (float)h)) : 0.f;
  const uint4 z4 = make_uint4(0, 0, 0, 0);
#pragma unroll
  for (int i = 0; i < 4; ++i) {
    const int id = tid + i * 256, s = id >> 4, c8 = id & 15;
    uint4 q4 = z4, k4 = z4;
    if (s < L) { q4 = *(const uint4*)(src + (size_t)(row0 + s) * ld + qcol + c8 * 8); k4 = *(const uint4*)(src + (size_t)(row0 + s) * ld + kcol + c8 * 8); }
    *(uint4*)(Q + s * 136 + c8 * 8) = q4; *(uint4*)(Kb + s * 136 + c8 * 8) = k4;
  }
  uint4 vr[NVC];
#pragma unroll
  for (int i = 0; i < NVC; ++i) { const int id = tid + i * 256, s = id / VCR, c8 = id % VCR; uint4 t_ = z4; if (s < L) t_ = *(const uint4*)(src + (size_t)(row0 + s) * ld + vcol + c8 * 8); vr[i] = t_; }
  if (c < 256) {
    const bf16_t* stg = (const bf16_t*)(p.ws + OFF_ST) + (MODE == 1 ? (size_t)256 * 4 * 128 * 128 : 0) + ((size_t)(c * HH + h) * PF) * 128;
#pragma unroll
    for (int i = 0; i < PF / 16; ++i) { const int id = tid + i * 256, pr = id >> 4, c8 = id & 15; *(uint4*)(STb + pr * 136 + c8 * 8) = *(const uint4*)(stg + (size_t)pr * 128 + c8 * 8); }
  } else {
    const float* sg = (MODE == 0 ? p.state_ret : MODE == 1 ? p.state_hgrn : p.state_ssm) + (size_t)((c - 256) * HH + h) * 128 * PF;
    for (int id = tid; id < 128 * (PF / 4); id += 256) {
      const int n = id / (PF / 4), p4 = (id % (PF / 4)) * 4;
      const float4 v = *(const float4*)(sg + (size_t)n * PF + p4);
      STb[(p4 + 0) * 136 + n] = f2bf(v.x); STb[(p4 + 1) * 136 + n] = f2bf(v.y); STb[(p4 + 2) * 136 + n] = f2bf(v.z); STb[(p4 + 3) * 136 + n] = f2bf(v.w);
    }
  }
  if (MODE == 2 && tid < 64) {
    float dt = 0.f;
    if (tid < L) { const float x = ((const float*)(p.ws + OFF_DTBUF))[(size_t)(row0 + tid) * 16 + h] + p.dt_bias[h]; dt = x > 20.f ? x : log1pf(__expf(x)); }
    dtv[tid] = dt; av[tid] = -expf(p.a_log[h]) * dt;
  }
  __syncthreads();
  if (MODE == 1) {
    const int kn = tid & 127, half = tid >> 7;
    float s_ = 0.f;
    for (int s = half * 32; s < half * 32 + 32; ++s) s_ += bf2f(Kb[s * 136 + kn]);
    tot[half * 128 + kn] = s_;
    __syncthreads();
    float cum = half == 1 ? tot[kn] : 0.f;
    for (int s = half * 32; s < half * 32 + 32; ++s) {
      const float lf = bf2f(Kb[s * 136 + kn]);
      cum += lf;
      Q[s * 136 + kn] = f2bf(bf2f(Q[s * 136 + kn]) * __expf(cum));
      Kb[s * 136 + kn] = f2bf((1.f - __expf(lf)) * __expf(-cum));
    }
    __syncthreads();
  }
  if (MODE == 2) {
    if (tid < 64) { float cs = 0.f; for (int r = 0; r <= tid; ++r) cs += av[r]; cumv[tid] = cs; }
    __syncthreads();
  }
  f32x4 ai[1][NTP], asc[1][4];
#pragma unroll
  for (int j = 0; j < NTP; ++j) ai[0][j] = (f32x4){0.f, 0.f, 0.f, 0.f};
#pragma unroll
  for (int j = 0; j < 4; ++j) asc[0][j] = (f32x4){0.f, 0.f, 0.f, 0.f};
  wmma_sw<1, NTP>(ai, Q + wave * 16 * 136, 136, STb, 136, 128, lane);
  wmma_sw<1, 4>(asc, Q + wave * 16 * 136, 136, Kb, 136, 128, lane);
  const int t = wave * 16 + (lane & 15), sq4 = (lane >> 4) * 4;
  float ct = 0.f;
  if (MODE == 2) ct = cumv[t];
#pragma unroll
  for (int nt = 0; nt < 4; ++nt)
#pragma unroll
    for (int j = 0; j < 4; ++j) {
      const int s = nt * 16 + sq4 + j;
      float v = asc[0][nt][j];
      if (s > t) v = 0.f;
      else if (MODE == 0) v *= exp2f((float)(t - s) * l2g);
      else if (MODE == 2) v *= __expf(ct - cumv[s]) * dtv[s];
      asc[0][nt][j] = v;
    }
  __syncthreads();
  bf16_t* Pb = STb; bf16_t* VT = Kb;
#pragma unroll
  for (int nt = 0; nt < 4; ++nt) store4bf(Pb + t * 72 + nt * 16 + sq4, asc[0][nt][0], asc[0][nt][1], asc[0][nt][2], asc[0][nt][3]);
#pragma unroll
  for (int i = 0; i < NVC; ++i) {
    const int id = tid + i * 256, s = id / VCR, c8 = id % VCR; const uint4 v = vr[i];
    bf16_t* d = VT + (c8 * 8) * 72 + s;
    d[0] = (bf16_t)(v.x & 0xffff); d[72] = (bf16_t)(v.x >> 16); d[144] = (bf16_t)(v.y & 0xffff); d[216] = (bf16_t)(v.y >> 16);
    d[288] = (bf16_t)(v.z & 0xffff); d[360] = (bf16_t)(v.z >> 16); d[432] = (bf16_t)(v.w & 0xffff); d[504] = (bf16_t)(v.w >> 16);
  }
  __syncthreads();
  f32x4 ao[1][NTP];
#pragma unroll
  for (int j = 0; j < NTP; ++j) ao[0][j] = (f32x4){0.f, 0.f, 0.f, 0.f};
  wmma_sw<1, NTP>(ao, Pb + wave * 16 * 72, 72, VT, 72, 64, lane);
  float fi = 1.f;
  if (MODE == 0) fi = exp2f((float)(t + 1) * l2g);
  if (MODE == 2) fi = __expf(ct);
  const int row = row0 + t;
  const bool valid = t < L;
  if (MODE == 0 || MODE == 1) {
    float s1 = 0.f, s2 = 0.f;
#pragma unroll
    for (int nt = 0; nt < NTP; ++nt)
#pragma unroll
      for (int j = 0; j < 4; ++j) { const float o = ao[0][nt][j] + fi * ai[0][nt][j]; ao[0][nt][j] = o; s1 += o; s2 += o * o; }
    s1 += shx(s1, 16); s1 += shx(s1, 32); s2 += shx(s2, 16); s2 += shx(s2, 32);
    float mu = 0.f, rs;
    if (MODE == 0) { mu = s1 * (1.f / 128.f); const float var = fmaxf(s2 * (1.f / 128.f) - mu * mu, 0.f); rs = rsqrtf(var + EPSV); }
    else rs = rsqrtf(s2 * (1.f / 128.f) + EPSV);
    if (valid) {
      const float* nw = (MODE == 0 ? p.ret_norm_w : p.hgrn_norm_w) + h * 128;
      const int gcol = (MODE == 0 ? 1536 : 3584) + h * 128;
      bf16_t* mix = (bf16_t*)(p.ws + OFF_H) + (size_t)row * 1024 + (MODE == 0 ? 0 : 512) + h * 128;
#pragma unroll
      for (int nt = 0; nt < NTP; ++nt) {
        const int pp = nt * 16 + sq4;
        const float4 w4 = *(const float4*)(nw + pp);
        const uint2 g2 = *(const uint2*)(src + (size_t)row * ld + gcol + pp);
        store4bf(mix + pp, (ao[0][nt][0] - mu) * rs * w4.x * siluf(lo2f(g2.x)), (ao[0][nt][1] - mu) * rs * w4.y * siluf(hi2f(g2.x)),
                 (ao[0][nt][2] - mu) * rs * w4.z * siluf(lo2f(g2.y)), (ao[0][nt][3] - mu) * rs * w4.w * siluf(hi2f(g2.y)));
      }
    }
  } else {
    const float Dh = p.d_ssm[h];
    bf16_t* zy = (bf16_t*)(p.ws + OFF_A) + (size_t)row * 3200 + h * 64;
    float s2 = 0.f;
    if (valid) {
#pragma unroll
      for (int nt = 0; nt < NTP; ++nt) {
        const int pp = nt * 16 + sq4;
        const uint2 x2 = *(const uint2*)(src + (size_t)row * ld + vcol + pp);
        const uint2 z2 = *(const uint2*)(zy + pp);
        const float y0 = (ao[0][nt][0] + fi * ai[0][nt][0] + Dh * lo2f(x2.x)) * siluf(lo2f(z2.x));
        const float y1 = (ao[0][nt][1] + fi * ai[0][nt][1] + Dh * hi2f(x2.x)) * siluf(hi2f(z2.x));
        const float y2 = (ao[0][nt][2] + fi * ai[0][nt][2] + Dh * lo2f(x2.y)) * siluf(lo2f(z2.y));
        const float y3 = (ao[0][nt][3] + fi * ai[0][nt][3] + Dh * hi2f(x2.y)) * siluf(hi2f(z2.y));
        s2 += y0 * y0 + y1 * y1 + y2 * y2 + y3 * y3;
        store4bf(zy + pp, y0, y1, y2, y3);
      }
    }
    s2 += shx(s2, 16); s2 += shx(s2, 32);
    if (valid && lane < 16) atomicAdd((float*)(p.ws + OFF_SSDST) + (size_t)row * 2 + (h >> 3), s2);
  }
  __syncthreads();
}

template <int OUT>
__device__ __forceinline__ void s5_unit(const Params& p, int c, int gq, char* smem, int wvs) {
  float* Uf = (float*)smem;
  bf16_t* HSall = (bf16_t*)(smem + 16384);
  bf16_t* CMall = (bf16_t*)(smem + 16384 + 34816);
  int tid_ = TIDX(wvs) & 255; asm volatile("" : "+v"(tid_)); const int tid = tid_, lane = tid & 63, wave = tid >> 6;
  int row0, L; chunk_geom(c, row0, L);
  const bf16_t* proj = (const bf16_t*)(p.ws + OFF_A);
#pragma unroll
  for (int i = 0; i < 2; ++i) {
    const int id = tid + i * 256, s = id >> 3, c8 = id & 7;
    uint4 v = make_uint4(0, 0, 0, 0);
    if (s < L) v = *(const uint4*)(proj + (size_t)(row0 + s) * 3200 + 2576 + gq * 64 + c8 * 8);
    float* d = Uf + s * 64 + c8 * 8;
    d[0] = lo2f(v.x); d[1] = hi2f(v.x); d[2] = lo2f(v.y); d[3] = hi2f(v.y); d[4] = lo2f(v.z); d[5] = hi2f(v.z); d[6] = lo2f(v.w); d[7] = hi2f(v.w);
  }
  const int g = gq * 4 + wave, gp = g * 64 + lane;
  const float* tab = (const float*)(p.ws + OFF_S5TAB);
  const float lr = tab[gp], li = tab[2048 + gp];
  f32x2 bb2[16];
#pragma unroll
  for (int q = 0; q < 4; ++q) {
    const float4 a = *(const float4*)(tab + 4096 + gp * 16 + q * 4), b = *(const float4*)(tab + 4096 + 32768 + gp * 16 + q * 4);
    bb2[q * 4] = (f32x2){a.x, b.x}; bb2[q * 4 + 1] = (f32x2){a.y, b.y}; bb2[q * 4 + 2] = (f32x2){a.z, b.z}; bb2[q * 4 + 3] = (f32x2){a.w, b.w};
  }
  float hr = 0.f, hi = 0.f;
  bf16_t* HS = HSall + wave * 32 * 136; bf16_t* CM = CMall + wave * 16 * 136;
  if (OUT) {
    const float2 h0 = *(const float2*)((const float*)(p.ws + OFF_S5H) + ((size_t)c * 2048 + gp) * 2);
    hr = h0.x; hi = h0.y;
#pragma unroll
    for (int ch = 0; ch < 16; ++ch) { CM[ch * 136 + lane] = f2bf(p.s5_c_re[(g * 16 + ch) * 64 + lane]); CM[ch * 136 + 64 + lane] = f2bf(-p.s5_c_im[(g * 16 + ch) * 64 + lane]); }
  }
  __syncthreads();
  const int nhalf = OUT ? ((L + 31) >> 5) : 1, tl = OUT ? 32 : L;
  for (int hf = 0; hf < nhalf; ++hf) {
#pragma unroll 4
    for (int tt = 0; tt < tl; ++tt) {
      const int t = hf * 32 + tt;
      {
        const float* up = Uf + t * 64 + wave * 16;
        f32x2 b0 = (f32x2){0.f, 0.f}, b1 = (f32x2){0.f, 0.f};
#pragma unroll
        for (int q = 0; q < 4; ++q) {
          const f32x4 u4 = *(const f32x4*)(up + q * 4);
          b0 += bb2[q * 4] * u4[0]; b1 += bb2[q * 4 + 1] * u4[1]; b0 += bb2[q * 4 + 2] * u4[2]; b1 += bb2[q * 4 + 3] * u4[3];
        }
        b0 += b1;
        const float nr = lr * hr - li * hi + b0[0], ni = lr * hi + li * hr + b0[1];
        if (t < L) { hr = nr; hi = ni; }
      }
      if (OUT) { HS[tt * 136 + lane] = f2bf(t < L ? hr : 0.f); HS[tt * 136 + 64 + lane] = f2bf(t < L ? hi : 0.f); }
    }
    if (OUT) {
      __syncthreads();
      f32x4 ay[2][1];
      ay[0][0] = (f32x4){0.f, 0.f, 0.f, 0.f}; ay[1][0] = (f32x4){0.f, 0.f, 0.f, 0.f};
      wmma_sw<2, 1>(ay, HS, 136, CM, 136, 128, lane);
      bf16_t* gbuf = (bf16_t*)(p.ws + OFF_GBUF);
#pragma unroll
      for (int mt = 0; mt < 2; ++mt) {
        const int t = hf * 32 + mt * 16 + (lane & 15), ch0 = (lane >> 4) * 4;
        if (t < L) {
          const float4 u4 = *(const float4*)(Uf + t * 64 + wave * 16 + ch0);
          const float4 d4 = *(const float4*)(p.s5_d + g * 16 + ch0);
          float y[4] = {ay[mt][0][0] + d4.x * u4.x, ay[mt][0][1] + d4.y * u4.y, ay[mt][0][2] + d4.z * u4.z, ay[mt][0][3] + d4.w * u4.w};
#pragma unroll
          for (int j = 0; j < 4; ++j) { const float x = y[j], uu = 0.7978845608028654f * (x + 0.044715f * x * x * x); y[j] = x / (1.f + __expf(-2.f * uu)); }
          store4bf(gbuf + (size_t)(row0 + t) * 512 + g * 16 + ch0, y[0], y[1], y[2], y[3]);
        }
      }
      __syncthreads();
    }
  }
  if (!OUT) { *(float2*)((float*)(p.ws + OFF_S5E) + ((size_t)c * 2048 + gp) * 2) = make_float2(hr, hi); }
  __syncthreads();
}

__device__ __forceinline__ void s5_prefix(const Params& p, int gt) {
  const int sq = gt >> 11, rem = gt & 2047;
  const float* tab = (const float*)(p.ws + OFF_S5TAB);
  const float* e = (const float*)(p.ws + OFF_S5E);
  float* hs = (float*)(p.ws + OFF_S5H);
  float hr = 0.f, hi = 0.f;
  if (sq < 8) {
    const float lr = tab[69632 + rem], li = tab[71680 + rem];
    for (int n = 0; n < 32; ++n) {
      const size_t idx = ((size_t)(sq * 32 + n) * 2048 + rem) * 2;
      *(float2*)(hs + idx) = make_float2(hr, hi);
      const float2 ev = *(const float2*)(e + idx);
      const float nr = lr * hr - li * hi + ev.x, ni = lr * hi + li * hr + ev.y; hr = nr; hi = ni;
    }
  } else {
    const float lr = tab[73728 + rem], li = tab[75776 + rem];
    hr = p.state_s5_re[(size_t)(sq - 8) * 2048 + rem]; hi = p.state_s5_im[(size_t)(sq - 8) * 2048 + rem];
    const size_t idx = ((size_t)(256 + sq - 8) * 2048 + rem) * 2;
    *(float2*)(hs + idx) = make_float2(hr, hi);
    const float2 ev = *(const float2*)(e + idx);
    const float nr = lr * hr - li * hi + ev.x, ni = lr * hi + li * hr + ev.y; hr = nr; hi = ni;
  }
  p.out[O_S5RE + (size_t)sq * 2048 + rem] = hr;
  p.out[O_S5IM + (size_t)sq * 2048 + rem] = hi;
}

__device__ __forceinline__ void conv_phase(const Params& p, int wvs) {
  const bf16_t* proj = (const bf16_t*)(p.ws + OFF_A);
  bf16_t* xc = (bf16_t*)(p.ws + OFF_H);
  int tq_ = TIDX(wvs); asm volatile("" : "+v"(tq_)); const int gt = blockIdx.x * NTHR + tq_, nt = gridDim.x * NTHR;
  for (int task = gt; task < 544 * 192; task += nt) {
    const int seg = task / 192, c = (task - seg * 192) * 8, rowb = seg * 32;
    float w[4][8], bia[8];
#pragma unroll
    for (int j = 0; j < 4; ++j) {
      const float4 w0 = *(const float4*)(p.conv_w + j * 1536 + c), w1 = *(const float4*)(p.conv_w + j * 1536 + c + 4);
      w[j][0] = w0.x; w[j][1] = w0.y; w[j][2] = w0.z; w[j][3] = w0.w; w[j][4] = w1.x; w[j][5] = w1.y; w[j][6] = w1.z; w[j][7] = w1.w;
    }
    { const float4 b0 = *(const float4*)(p.conv_b + c), b1 = *(const float4*)(p.conv_b + c + 4); bia[0] = b0.x; bia[1] = b0.y; bia[2] = b0.z; bia[3] = b0.w; bia[4] = b1.x; bia[5] = b1.y; bia[6] = b1.z; bia[7] = b1.w; }
    float x0[8], x1[8], x2[8];
    if (rowb < 16384 && (rowb & 2047) != 0) {
      const u32x4 v0 = *(const u32x4*)(proj + (size_t)(rowb - 3) * 3200 + 1024 + c), v1 = *(const u32x4*)(proj + (size_t)(rowb - 2) * 3200 + 1024 + c), v2 = *(const u32x4*)(proj + (size_t)(rowb - 1) * 3200 + 1024 + c);
#pragma unroll
      for (int e = 0; e < 4; ++e) { x0[2 * e] = lo2f(v0[e]); x0[2 * e + 1] = hi2f(v0[e]); x1[2 * e] = lo2f(v1[e]); x1[2 * e + 1] = hi2f(v1[e]); x2[2 * e] = lo2f(v2[e]); x2[2 * e + 1] = hi2f(v2[e]); }
    } else {
#pragma unroll
      for (int e = 0; e < 8; ++e) { x0[e] = 0.f; x1[e] = 0.f; x2[e] = 0.f; }
    }
    u32x4 nxt = *(const u32x4*)(proj + (size_t)rowb * 3200 + 1024 + c);
    for (int r = 0; r < 32; ++r) {
      const int row = rowb + r;
      const u32x4 cv = nxt;
      if (r + 1 < 32) nxt = *(const u32x4*)(proj + (size_t)(row + 1) * 3200 + 1024 + c);
      int t, T, sq;
      if (row < 16384) { t = row & 2047; T = 2048; sq = row >> 11; } else { t = (row - 16384) & 7; T = 8; sq = 8 + ((row - 16384) >> 3); }
      if (t == 0) {
        if (sq >= 8) {
          const float* sc = p.state_conv + (size_t)(sq - 8) * 3 * 1536 + c;
          const float4 a0 = *(const float4*)sc, a1 = *(const float4*)(sc + 4), b0 = *(const float4*)(sc + 1536), b1 = *(const float4*)(sc + 1540), c0 = *(const float4*)(sc + 3072), c1 = *(const float4*)(sc + 3076);
          x0[0] = a0.x; x0[1] = a0.y; x0[2] = a0.z; x0[3] = a0.w; x0[4] = a1.x; x0[5] = a1.y; x0[6] = a1.z; x0[7] = a1.w;
          x1[0] = b0.x; x1[1] = b0.y; x1[2] = b0.z; x1[3] = b0.w; x1[4] = b1.x; x1[5] = b1.y; x1[6] = b1.z; x1[7] = b1.w;
          x2[0] = c0.x; x2[1] = c0.y; x2[2] = c0.z; x2[3] = c0.w; x2[4] = c1.x; x2[5] = c1.y; x2[6] = c1.z; x2[7] = c1.w;
        } else {
#pragma unroll
          for (int e = 0; e < 8; ++e) { x0[e] = 0.f; x1[e] = 0.f; x2[e] = 0.f; }
        }
      }
      float cur[8], o[8];
#pragma unroll
      for (int e = 0; e < 4; ++e) { cur[2 * e] = lo2f(cv[e]); cur[2 * e + 1] = hi2f(cv[e]); }
#pragma unroll
      for (int e = 0; e < 8; ++e) { o[e] = siluf(bia[e] + w[0][e] * x0[e] + w[1][e] * x1[e] + w[2][e] * x2[e] + w[3][e] * cur[e]); x0[e] = x1[e]; x1[e] = x2[e]; x2[e] = cur[e]; }
      u32x4 ov; ov[0] = pack2(o[0], o[1]); ov[1] = pack2(o[2], o[3]); ov[2] = pack2(o[4], o[5]); ov[3] = pack2(o[6], o[7]);
      *(u32x4*)(xc + (size_t)row * 1536 + c) = ov;
      if (t >= T - 3) {
        float* d = p.out + O_CONV + ((size_t)sq * 3 + (t - (T - 3))) * 1536 + c;
        *(float4*)d = make_float4(cur[0], cur[1], cur[2], cur[3]); *(float4*)(d + 4) = make_float4(cur[4], cur[5], cur[6], cur[7]);
      }
    }
  }
}

__device__ __forceinline__ void ssdnorm_phase(const Params& p, int wvs) {
  const bf16_t* proj = (const bf16_t*)(p.ws + OFF_A);
  bf16_t* mix = (bf16_t*)(p.ws + OFF_H);
  const float* st = (const float*)(p.ws + OFF_SSDST);
  int tq_ = TIDX(wvs); asm volatile("" : "+v"(tq_)); const int gt = blockIdx.x * NTHR + tq_, nt = gridDim.x * NTHR;
  for (int it = gt; it < ROWS * 128; it += nt) {
    const int row = it >> 7, c = (it & 127) * 8;
    const float r = rsqrtf(st[(size_t)row * 2 + (c >> 9)] * (1.f / 512.f) + EPSV);
    const uint4 v = *(const uint4*)(proj + (size_t)row * 3200 + c);
    const float4 w0 = *(const float4*)(p.ssm_norm_w + c), w1 = *(const float4*)(p.ssm_norm_w + c + 4);
    uint4 o; o.x = pack2(lo2f(v.x) * r * w0.x, hi2f(v.x) * r * w0.y); o.y = pack2(lo2f(v.y) * r * w0.z, hi2f(v.y) * r * w0.w);
    o.z = pack2(lo2f(v.z) * r * w1.x, hi2f(v.z) * r * w1.y); o.w = pack2(lo2f(v.w) * r * w1.z, hi2f(v.w) * r * w1.w);
    *(uint4*)(mix + (size_t)row * 1536 + c) = o;
  }
}


#define XB_TMO      128
#define XB_XCNT(j)  (256  + 64 * (j))
#define XB_XSUB(j)  (1280 + 64 * (j))
#define XB_XGEN(j)  (2304 + 64 * (j))
#define XB_TOP      3328
#define XB_TOPGEN   3392
#define XCD_BAR_WORDS 3456
#define XB_SPIN_CAP (1u << 18)
#define LAS __attribute__((address_space(3)))
__device__ __forceinline__ unsigned xb_ld(unsigned* p)              { return __hip_atomic_load(p, __ATOMIC_RELAXED, __HIP_MEMORY_SCOPE_AGENT); }
__device__ __forceinline__ unsigned xb_add(unsigned* p, unsigned v) { return __hip_atomic_fetch_add(p, v, __ATOMIC_RELAXED, __HIP_MEMORY_SCOPE_AGENT); }
__device__ __forceinline__ unsigned xb_xcc_id() { return (unsigned)__builtin_amdgcn_s_getreg((3 << 11) | 20) & 0xFu; }
#define XB_SPIN(cond, bar) do { unsigned _sp = 0; while (cond) { __builtin_amdgcn_s_sleep(1); \
    if ((++_sp & 255u) == 0u) { if (xb_ld(&(bar)[XB_TMO])) break; if (_sp > XB_SPIN_CAP) { atomicAdd(&(bar)[XB_TMO], 1u); break; } } } } while (0)
struct XcdBarrier { unsigned* bar; unsigned x; volatile LAS unsigned* st; };
__device__ __forceinline__ XcdBarrier xcd_barrier_post(unsigned* bar, volatile LAS unsigned* st, int wvs) {
    XcdBarrier b; b.bar = bar; b.x = xb_xcc_id(); b.st = st;
    if (TIDX(wvs) == 0) (void)xb_add(&bar[XB_XCNT(b.x)], 1u);
    return b;
}
__device__ __forceinline__ void xcd_barrier_complete(unsigned* bar, unsigned x, unsigned& nloc, unsigned& nx) {
    const unsigned G = gridDim.x * gridDim.y * gridDim.z;
    unsigned sum, cnt, mine, sp = 0u;
    for (;;) {
        sum = 0u; cnt = 0u; mine = 0u;
#pragma unroll
        for (unsigned j = 0; j < 16; ++j) { const unsigned c = xb_ld(&bar[XB_XCNT(j)]); sum += c; cnt += (c > 0u) ? 1u : 0u; mine = (j == x) ? c : mine; }
        if (sum == G) break;
        __builtin_amdgcn_s_sleep(1);
        if ((++sp & 255u) == 0u) { if (xb_ld(&bar[XB_TMO])) break; if (sp > XB_SPIN_CAP) { atomicAdd(&bar[XB_TMO], 1u); break; } }
    }
    nloc = mine > 0u ? mine : 1u; nx = cnt > 0u ? cnt : 1u;
}
__device__ __forceinline__ void xcd_barrier(const XcdBarrier& b, int wvs) {
    asm volatile("s_waitcnt vmcnt(0)" ::: "memory");
    __syncthreads();
    if (TIDX(wvs) == 0) {
        unsigned* bar = b.bar;
        __builtin_amdgcn_s_waitcnt(0);
        unsigned nloc = b.st[0], nx = b.st[1];
        if (nloc == 0u) { xcd_barrier_complete(bar, b.x, nloc, nx); b.st[0] = nloc; b.st[1] = nx; }
        const unsigned old = xb_add(&bar[XB_XSUB(b.x)], 1u);
        const unsigned gen = old / nloc;
        if (old + 1u == (gen + 1u) * nloc) {
            __builtin_amdgcn_fence(__ATOMIC_RELEASE, "agent");
            asm volatile("s_waitcnt vmcnt(0)" ::: "memory");
            const unsigned og = xb_add(&bar[XB_TOP], 1u);
            const unsigned tg = og / nx;
            if (og + 1u == (tg + 1u) * nx) xb_add(&bar[XB_TOPGEN], 1u);
            else XB_SPIN(xb_ld(&bar[XB_TOPGEN]) == tg, bar);
            __builtin_amdgcn_fence(__ATOMIC_ACQUIRE, "agent");
            xb_add(&bar[XB_XGEN(b.x)], 1u);
            asm volatile("s_waitcnt vmcnt(0)" ::: "memory");
        } else {
            XB_SPIN(xb_ld(&bar[XB_XGEN(b.x)]) == gen, bar);
            __builtin_amdgcn_fence(__ATOMIC_ACQUIRE, "agent");
            asm volatile("s_waitcnt vmcnt(0)" ::: "memory");
        }
    }
    __syncthreads();
}


__device__ __forceinline__ Params ldp() {
  auto kp = __builtin_amdgcn_kernarg_segment_ptr();
  asm volatile("" : "+s"(kp));
  Params q;
  __builtin_memcpy(&q, (const void*)kp, sizeof(Params));
  return q;
}

__global__ void __launch_bounds__(NTHR, 2) fwd_megakernel(Params p_) {
  extern __shared__ __attribute__((aligned(16))) char smem[];
  cg::grid_group grid = cg::this_grid();
  if (p_.ws == nullptr) grid.sync();
  volatile LAS unsigned* xst = (volatile LAS unsigned*)(smem + 2 * HALF_LDS);
  const int wvs = __builtin_amdgcn_readfirstlane(threadIdx.x >> 6);
  if (TIDX(wvs) == 0) { xst[0] = 0u; xst[1] = 0u; xst[2] = 0u; xst[3] = 0u; }
  __syncthreads();
  const XcdBarrier xb = xcd_barrier_post((unsigned*)(p_.ws + OFF_BAR), xst, wvs);
  const int half = wvs >> 2;
  const int G = gridDim.x * 2, bid = blockIdx.x * 2 + half;
  char* hs = smem + half * HALF_LDS;
#define PH_BEGIN const Params p = ldp(); bf16_t* bufA = (bf16_t*)(p.ws + OFF_A); bf16_t* bufH = (bf16_t*)(p.ws + OFF_H); bf16_t* t0 = (bf16_t*)(p.ws + OFF_ST); \
    float* rowss = (float*)(p.ws + OFF_ROWSS); float* hbuf = p.out; (void)bufA; (void)bufH; (void)t0; (void)rowss; (void)hbuf;

  {
  PH_BEGIN
  prep_tables(p, wvs);
  wconv(p.w_in_even, 1024, 4096, 4096, (bf16_t*)(p.ws + W_IN), hs, wvs);
  wconv(p.w_out_even, 1024, 1024, 1024, (bf16_t*)(p.ws + W_OUT0), hs, wvs);
  wconv(p.w_ffn_up, 1024, 4096, 4096, (bf16_t*)(p.ws + W_UP), hs, wvs);
  wconv(p.w_ffn_down, 4096, 1024, 1024, (bf16_t*)(p.ws + W_DOWN), hs, wvs);
  rowpass_phase(nullptr, nullptr, nullptr, p.x_prompt, p.x_sample, nullptr, p.norm_mix_pre, bufH, wvs);
  }
  xcd_barrier(xb, wvs);
  {
  PH_BEGIN
  { EpiInEven e{bufA, (const float*)(p.ws + OFF_ROPE), (const float*)(p.ws + OFF_LB)};
    for (int rep_ = 0; rep_ < REPG; ++rep_) { gemm_phase(bufH, 1024, (const bf16_t*)(p.ws + W_IN), 1024, 64, 16, 1024, e, smem, wvs); gemm_tail(bufH, 1024, (const bf16_t*)(p.ws + W_IN), 1024, 32, 1024, e, smem, wvs, 64 * 16); } }
  }
  xcd_barrier(xb, wvs);
  {
  PH_BEGIN
  for (int rep_ = 0; rep_ < REPS; ++rep_) {
    if (bid < 256) {
      const int v = bid;
      const int ps = v & 3, m = (v >> 2) & 1, h = (v >> 3) & 3, sq = v >> 5;
      if (m == 0) state_unit<0>(p, sq, h, ps, hs, wvs); else state_unit<1>(p, sq, h, ps, hs, wvs);
    }
    const int nsh = bid < 256 ? 2 : 14, j0 = bid < 256 ? bid : 512 + (bid - 256);
    for (int i = 0; i < nsh; ++i) {
      const int v = j0 + 256 * i;
      const int ps = v & 3, m = (v >> 2) & 1, h = (v >> 3) & 3, sq = 8 + (v >> 5);
      if (m == 0) state_unit<0>(p, sq, h, ps, hs, wvs); else state_unit<1>(p, sq, h, ps, hs, wvs);
    }
  }
  }
  xcd_barrier(xb, wvs);
  {
  PH_BEGIN
  for (int rep_ = 0; rep_ < REPO; ++rep_)
  for (int u = bid; u < 384 * 8; u += G) {
    const int h = u & 3, m = (u >> 2) & 1, c = u >> 3;
    if (m == 0) out_unit<0>(p, c, h, hs, wvs); else out_unit<1>(p, c, h, hs, wvs);
  }
  }
  xcd_barrier(xb, wvs);
  {
  PH_BEGIN
  { EpiOut e{t0, rowss};
    for (int rep_ = 0; rep_ < REPG; ++rep_) { gemm_phase(bufH, 1024, (const bf16_t*)(p.ws + W_OUT0), 1024, 64, 4, 1024, e, smem, wvs); gemm_tail(bufH, 1024, (const bf16_t*)(p.ws + W_OUT0), 1024, 8, 1024, e, smem, wvs, 64 * 4); } }
  }
  xcd_barrier(xb, wvs);
  {
  PH_BEGIN
  for (int rep_ = 0; rep_ < REPR; ++rep_)
  rowpass_phase(t0, rowss, p.norm_mix_post, p.x_prompt, p.x_sample, hbuf, p.norm_ffn_pre, bufH, wvs);
  }
  xcd_barrier(xb, wvs);
  {
  PH_BEGIN
  { EpiUp e{bufA}; for (int rep_ = 0; rep_ < REPG; ++rep_) { gemm_phase(bufH, 1024, (const bf16_t*)(p.ws + W_UP), 1024, 64, 16, 1024, e, smem, wvs); gemm_tail(bufH, 1024, (const bf16_t*)(p.ws + W_UP), 1024, 32, 1024, e, smem, wvs, 64 * 16); } }
  }
  xcd_barrier(xb, wvs);
  {
  PH_BEGIN
  { EpiOut e{t0, rowss + ROWS}; for (int rep_ = 0; rep_ < REPG; ++rep_) { gemm_phase(bufA, 4096, (const bf16_t*)(p.ws + W_DOWN), 4096, 64, 4, 4096, e, smem, wvs); gemm_tail(bufA, 4096, (const bf16_t*)(p.ws + W_DOWN), 4096, 8, 4096, e, smem, wvs, 64 * 4); } }
  }
  xcd_barrier(xb, wvs);
  {
  PH_BEGIN
  rowpass_phase(t0, rowss + ROWS, p.norm_ffn_post, hbuf, hbuf + (size_t)16384 * 1024, hbuf, p.norm_mix_pre + 1024, bufH, wvs);
  wconv(p.w_in_odd, 1024, 3088, 3328, (bf16_t*)(p.ws + W_IN), hs, wvs);
  wconv(p.w_glu, 512, 512, 512, (bf16_t*)(p.ws + W_GLU), hs, wvs);
  wconv(p.w_out_odd, 1536, 1024, 1024, (bf16_t*)(p.ws + W_OUT1), hs, wvs);
  wconv(p.w_ffn_up + (size_t)1024 * 4096, 1024, 4096, 4096, (bf16_t*)(p.ws + W_UP), hs, wvs);
  wconv(p.w_ffn_down + (size_t)4096 * 1024, 4096, 1024, 1024, (bf16_t*)(p.ws + W_DOWN), hs, wvs);
  }
  xcd_barrier(xb, wvs);
  {
  PH_BEGIN
  { EpiInOdd e{bufA, (float*)(p.ws + OFF_DTBUF)};
    for (int rep_ = 0; rep_ < REPG; ++rep_) { gemm_phase(bufH, 1024, (const bf16_t*)(p.ws + W_IN), 1024, 64, 13, 1024, e, smem, wvs); gemm_tail(bufH, 1024, (const bf16_t*)(p.ws + W_IN), 1024, 26, 1024, e, smem, wvs, 64 * 13); } }
  }
  xcd_barrier(xb, wvs);
  {
  PH_BEGIN
  for (int rep_ = 0; rep_ < REPC; ++rep_) {
  conv_phase(p, wvs);
  for (int u = bid; u < 384 * 8; u += G) s5_unit<0>(p, u >> 3, u & 7, hs, wvs);
  }
  }
  xcd_barrier(xb, wvs);
  {
  PH_BEGIN
  for (int rep_ = 0; rep_ < REPS; ++rep_) {
    if (bid < 128) state_unit<2>(p, bid >> 4, bid & 15, 0, hs, wvs);
    for (int j = bid < 128 ? bid : 256 + (bid - 128); j < 3136; j += (bid < 128 ? 128 : 384)) {
      if (bid < 128 && j >= 256) break;
      if (j < 1088) { int tq_ = TIDX(wvs) & 255; asm volatile("" : "+v"(tq_)); s5_prefix(p, j * 256 + tq_); }
      else { const int v = j - 1088; state_unit<2>(p, 8 + (v >> 4), v & 15, 0, hs, wvs); }
    }
  }
  }
  xcd_barrier(xb, wvs);
  {
  PH_BEGIN
  for (int u = bid; u < 384 * 16 + 384 * 8; u += G) {
    if (u < 384 * 16) out_unit<2>(p, u >> 4, u & 15, hs, wvs);
    else { const int v = u - 384 * 16; s5_unit<1>(p, v >> 3, v & 7, hs, wvs); }
  }
  }
  xcd_barrier(xb, wvs);
  {
  PH_BEGIN
  ssdnorm_phase(p, wvs);
  { EpiGlu e{(const bf16_t*)(p.ws + OFF_GBUF), p.b_glu, bufH};
    for (int rep_ = 0; rep_ < REPG; ++rep_) { gemm_phase((const bf16_t*)(p.ws + OFF_GBUF), 512, (const bf16_t*)(p.ws + W_GLU), 512, 64, 2, 512, e, smem, wvs); gemm_tail((const bf16_t*)(p.ws + OFF_GBUF), 512, (const bf16_t*)(p.ws + W_GLU), 512, 4, 512, e, smem, wvs, 64 * 2); } }
  }
  xcd_barrier(xb, wvs);
  {
  PH_BEGIN
  { EpiOut e{t0, rowss + 2 * ROWS}; for (int rep_ = 0; rep_ < REPG; ++rep_) { gemm_phase(bufH, 1536, (const bf16_t*)(p.ws + W_OUT1), 1536, 64, 4, 1536, e, smem, wvs); gemm_tail(bufH, 1536, (const bf16_t*)(p.ws + W_OUT1), 1536, 8, 1536, e, smem, wvs, 64 * 4); } }
  }
  xcd_barrier(xb, wvs);
  {
  PH_BEGIN
  rowpass_phase(t0, rowss + 2 * ROWS, p.norm_mix_post + 1024, hbuf, hbuf + (size_t)16384 * 1024, hbuf, p.norm_ffn_pre + 1024, bufH, wvs);
  }
  xcd_barrier(xb, wvs);
  {
  PH_BEGIN
  { EpiUp e{bufA}; for (int rep_ = 0; rep_ < REPG; ++rep_) { gemm_phase(bufH, 1024, (const bf16_t*)(p.ws + W_UP), 1024, 64, 16, 1024, e, smem, wvs); gemm_tail(bufH, 1024, (const bf16_t*)(p.ws + W_UP), 1024, 32, 1024, e, smem, wvs, 64 * 16); } }
  }
  xcd_barrier(xb, wvs);
  {
  PH_BEGIN
  { EpiOut e{t0, rowss + 3 * ROWS}; for (int rep_ = 0; rep_ < REPG; ++rep_) { gemm_phase(bufA, 4096, (const bf16_t*)(p.ws + W_DOWN), 4096, 64, 4, 4096, e, smem, wvs); gemm_tail(bufA, 4096, (const bf16_t*)(p.ws + W_DOWN), 4096, 8, 4096, e, smem, wvs, 64 * 4); } }
  }
  xcd_barrier(xb, wvs);
  {
  PH_BEGIN
  rowpass_phase(t0, rowss + 3 * ROWS, p.norm_ffn_post + 1024, hbuf, hbuf + (size_t)16384 * 1024, hbuf, nullptr, nullptr, wvs);
  }
}

extern "C" void kernel_launch(void* const* d_in, const int* in_sizes, int n_in, void* d_out, int out_size, void* d_ws, size_t ws_size, hipStream_t stream) {
  constexpr size_t kDynLds = 2 * HALF_LDS + 64;
  static int grid_blocks = 0;
  if (!grid_blocks) {
    int dev = 0, cus = 0, per_cu = 0;
    (void)hipGetDevice(&dev);
    (void)hipDeviceGetAttribute(&cus, hipDeviceAttributeMultiprocessorCount, dev);
    (void)hipFuncSetAttribute((const void*)fwd_megakernel, hipFuncAttributeMaxDynamicSharedMemorySize, (int)kDynLds);
    (void)hipOccupancyMaxActiveBlocksPerMultiprocessor(&per_cu, fwd_megakernel, NTHR, kDynLds);
    if (per_cu > 1) per_cu = 1;
    if (per_cu < 1) per_cu = 1;
    grid_blocks = cus * per_cu;
  }
  Params p{};
  const float** pf = (const float**)&p;
  for (int i = 0; i < 37; ++i) pf[i] = (const float*)d_in[i];
  p.out = (float*)d_out;
  p.ws = (char*)d_ws;
  (void)hipMemsetAsync((char*)d_ws + OFF_BAR, 0, 16384, stream);
  void* args[] = {&p};
  hipError_t e = hipLaunchCooperativeKernel((void*)fwd_megakernel, dim3(grid_blocks), dim3(NTHR), args, kDynLds, stream);
  if (e != hipSuccess) fprintf(stderr, "cooperative launch failed: %s (grid %d)\n", hipGetErrorString(e), grid_blocks);
}
```

```cpp
#include <hip/hip_runtime.h>
#include <hip/hip_cooperative_groups.h>
#include <cstdio>
namespace cg = cooperative_groups;

typedef unsigned short bf16_t;
typedef short bf16x8 __attribute__((ext_vector_type(8)));
typedef float f32x4 __attribute__((ext_vector_type(4)));
typedef unsigned u32x4 __attribute__((ext_vector_type(4)));
typedef float f32x2 __attribute__((ext_vector_type(2)));

#define NTHR 512
#ifndef REPS
#define REPS 1
#endif
#ifndef REPO
#define REPO 1
#endif
#ifndef REPC
#define REPC 1
#endif
#ifndef REPR
#define REPR 1
#endif
#ifndef REPG
#define REPG 1
#endif
#define HALF_LDS 73728
#ifndef REP0
#define REP0 1
#endif
#ifndef REPS
#define REPS 1
#endif
#ifndef REPO
#define REPO 1
#endif
#ifndef REPC
#define REPC 1
#endif
#ifndef REPY
#define REPY 21
#endif
#define ROWS 17408
#define EPSV 1e-6f
#define TIDX(w) ((w) * 64 + (int)__builtin_amdgcn_mbcnt_hi(~0u, __builtin_amdgcn_mbcnt_lo(~0u, 0u)))

constexpr size_t W_IN = 0;
constexpr size_t W_OUT0 = 8388608;
constexpr size_t W_GLU = 6815744;
constexpr size_t W_OUT1 = 7340032;
constexpr size_t W_UP = 10485760;
constexpr size_t W_DOWN = 18874368;
constexpr size_t OFF_A = 29360128;
constexpr size_t OFF_GBUF = OFF_A + 111411200;
constexpr size_t OFF_ST = OFF_A + 142606336;
constexpr size_t OFF_H = OFF_ST + 67108864;
constexpr size_t OFF_SM = OFF_H + 53477376;
constexpr size_t OFF_ROPE = OFF_SM;
constexpr size_t OFF_ROWSS = OFF_SM + 1052672;
constexpr size_t OFF_SSDST = OFF_SM + 1331200;
constexpr size_t OFF_DTBUF = OFF_SM + 1470464;
constexpr size_t OFF_LB = OFF_SM + 2584576;
constexpr size_t OFF_S5TAB = OFF_SM + 2586624;
constexpr size_t OFF_S5E = OFF_SM + 2897920;
constexpr size_t OFF_S5H = OFF_SM + 9189376;
constexpr size_t OFF_BAR = OFF_SM + 15480832;

constexpr size_t O_RET = 17825792, O_HG = 26738688, O_SSM = 35651584, O_CONV = 53477376, O_S5RE = 54104064, O_S5IM = 54382592;

struct Params {
  const float *x_prompt, *x_sample, *state_ret, *state_hgrn, *state_ssm, *state_conv, *state_s5_re, *state_s5_im;
  const float *norm_mix_pre, *norm_mix_post, *norm_ffn_pre, *norm_ffn_post;
  const float *w_in_even, *w_out_even, *ret_norm_w, *hgrn_lb, *hgrn_norm_w, *w_in_odd, *conv_w, *conv_b, *dt_bias, *a_log, *d_ssm, *ssm_norm_w;
  const float *s5_lam_re, *s5_lam_im, *s5_log_step, *s5_b_re, *s5_b_im, *s5_c_re, *s5_c_im, *s5_d, *w_glu, *b_glu, *w_out_odd, *w_ffn_up, *w_ffn_down;
  float* out;
  char* ws;
};

__device__ __forceinline__ bf16_t f2bf(float f) { unsigned r; asm("v_cvt_pk_bf16_f32 %0, %1, %1" : "=v"(r) : "v"(f)); return (bf16_t)(r & 0xffffu); }
__device__ __forceinline__ float bf2f(bf16_t h) { return __uint_as_float(((unsigned)h) << 16); }
__device__ __forceinline__ unsigned pack2(float a, float b) { unsigned r; asm("v_cvt_pk_bf16_f32 %0, %1, %2" : "=v"(r) : "v"(a), "v"(b)); return r; }
__device__ __forceinline__ float lo2f(unsigned u) { return __uint_as_float(u << 16); }
__device__ __forceinline__ float hi2f(unsigned u) { return __uint_as_float(u & 0xffff0000u); }
__device__ __forceinline__ float sigm(float x) { return 1.f / (1.f + __expf(-x)); }
__device__ __forceinline__ float siluf(float x) { return x / (1.f + __expf(-x)); }
__device__ __forceinline__ void store4bf(bf16_t* p, float a, float b, float c, float d) { uint2 v; v.x = pack2(a, b); v.y = pack2(c, d); *(uint2*)p = v; }

__device__ __forceinline__ float shx(float v, int mask) {
  int l = (int)__builtin_amdgcn_mbcnt_hi(~0u, __builtin_amdgcn_mbcnt_lo(~0u, 0u));
  asm volatile("" : "+v"(l));
  return __int_as_float(__builtin_amdgcn_ds_bpermute((l ^ mask) << 2, __float_as_int(v)));
}

template <int MT, int NT>
__device__ __forceinline__ void wmma_sw(f32x4 (&acc)[MT][NT], const bf16_t* A, int lda, const bf16_t* B, int ldb, int K, int lane) {
  const int r = lane & 15, kq = (lane >> 4) * 8;
  for (int k0 = 0; k0 < K; k0 += 32) {
    bf16x8 af[MT], bfr[NT];
#pragma unroll
    for (int mt = 0; mt < MT; ++mt) af[mt] = *(const bf16x8*)(A + (mt * 16 + r) * lda + k0 + kq);
#pragma unroll
    for (int nt = 0; nt < NT; ++nt) bfr[nt] = *(const bf16x8*)(B + (nt * 16 + r) * ldb + k0 + kq);
#pragma unroll
    for (int mt = 0; mt < MT; ++mt)
#pragma unroll
      for (int nt = 0; nt < NT; ++nt) acc[mt][nt] = __builtin_amdgcn_mfma_f32_16x16x32_bf16(bfr[nt], af[mt], acc[mt][nt], 0, 0, 0);
  }
}
template <int MT, int NT>
__device__ __forceinline__ void wmma_ns(f32x4 (&acc)[MT][NT], const bf16_t* A, int lda, const bf16_t* B, int ldb, int K, int lane) {
  const int r = lane & 15, kq = (lane >> 4) * 8;
  for (int k0 = 0; k0 < K; k0 += 32) {
    bf16x8 af[MT], bfr[NT];
#pragma unroll
    for (int mt = 0; mt < MT; ++mt) af[mt] = *(const bf16x8*)(A + (mt * 16 + r) * lda + k0 + kq);
#pragma unroll
    for (int nt = 0; nt < NT; ++nt) bfr[nt] = *(const bf16x8*)(B + (nt * 16 + r) * ldb + k0 + kq);
#pragma unroll
    for (int mt = 0; mt < MT; ++mt)
#pragma unroll
      for (int nt = 0; nt < NT; ++nt) acc[mt][nt] = __builtin_amdgcn_mfma_f32_16x16x32_bf16(af[mt], bfr[nt], acc[mt][nt], 0, 0, 0);
  }
}

__device__ __forceinline__ void gemm_kstep(f32x4 (&acc)[4][8], const char* A, const char* B) {
  bf16x8 af[4], bfr[8];
#pragma unroll
  for (int mt = 0; mt < 4; ++mt) af[mt] = *(const bf16x8*)(A + mt * 2048);
#pragma unroll
  for (int nt = 0; nt < 8; ++nt) bfr[nt] = *(const bf16x8*)(B + nt * 2048);
  __builtin_amdgcn_sched_barrier(0);
#pragma unroll
  for (int nt = 0; nt < 8; ++nt)
#pragma unroll
    for (int mt = 0; mt < 4; ++mt) acc[mt][nt] = __builtin_amdgcn_mfma_f32_16x16x32_bf16(bfr[nt], af[mt], acc[mt][nt], 0, 0, 0);
}

template <class Epi>
__device__ __forceinline__ void gemm_phase(const bf16_t* A, int lda, const bf16_t* Bt, int ldb, int nMt, int nNt, int K, const Epi& epi, char* smem, int wvs) {
  char* As = smem;
  char* Bs = smem + 65536;
  int tid_ = TIDX(wvs); asm volatile("" : "+v"(tid_)); const int tid = tid_, lane = tid & 63, wave = tid >> 6;
  const int wr = wave >> 1, wc = wave & 1;
  const int ntiles = nMt * nNt, nk = K >> 6;
  const int lrow = tid >> 3, lcc = (tid & 7) * 8;
  const int wofs = ((lrow >> 4) * 2 + (lcc >> 5)) * 1024 + ((((lrow & 15) * 64) + (lcc & 31) * 2) ^ ((lrow & 8) << 2));
  const int rofs = (((lane & 15) * 64) + (lane >> 4) * 16) ^ ((lane & 8) << 2);
  const unsigned toffA = (unsigned)(lrow * lda + lcc), toffB = (unsigned)(lrow * ldb + lcc);
  for (int tile = blockIdx.x; tile < ntiles; tile += gridDim.x) {
    const int pn = tile / nMt, pm = tile - pn * nMt;
    const bf16_t* Ab = A + (size_t)(pm * 256) * lda;
    const bf16_t* Bb = Bt + (size_t)(pn * 256) * ldb;
    f32x4 acc[4][8];
#pragma unroll
    for (int i = 0; i < 4; ++i)
#pragma unroll
      for (int j = 0; j < 8; ++j) acc[i][j] = (f32x4){0.f, 0.f, 0.f, 0.f};
    u32x4 rg[4];
#pragma unroll
    for (int i = 0; i < 4; ++i) rg[i] = *(const u32x4*)(Ab + (size_t)(i * 64) * lda + toffA);
#pragma unroll
    for (int i = 0; i < 4; ++i) *(u32x4*)(As + wofs + i * 8192) = rg[i];
#pragma unroll
    for (int i = 0; i < 4; ++i) rg[i] = *(const u32x4*)(Bb + (size_t)(i * 64) * ldb + toffB);
#pragma unroll
    for (int i = 0; i < 4; ++i) *(u32x4*)(Bs + wofs + i * 8192) = rg[i];
    __syncthreads();
#pragma unroll 1
    for (int kt = 0; kt < nk; ++kt) {
      const int cur = kt & 1;
      const int kn = (kt + 1 < nk ? kt + 1 : kt) * 64;
      char* Ad = As + (cur ^ 1) * 32768; char* Bd = Bs + (cur ^ 1) * 32768;
#pragma unroll
      for (int i = 0; i < 4; ++i) rg[i] = *(const u32x4*)(Ab + ((size_t)(i * 64) * lda + kn) + toffA);
      __builtin_amdgcn_sched_barrier(0);
      gemm_kstep(acc, As + cur * 32768 + wr * 8192 + rofs, Bs + cur * 32768 + wc * 16384 + rofs);
      __builtin_amdgcn_sched_barrier(0);
#pragma unroll
      for (int i = 0; i < 4; ++i) *(u32x4*)(Ad + wofs + i * 8192) = rg[i];
#pragma unroll
      for (int i = 0; i < 4; ++i) rg[i] = *(const u32x4*)(Bb + ((size_t)(i * 64) * ldb + kn) + toffB);
      __builtin_amdgcn_sched_barrier(0);
      gemm_kstep(acc, As + cur * 32768 + wr * 8192 + 1024 + rofs, Bs + cur * 32768 + wc * 16384 + 1024 + rofs);
      __builtin_amdgcn_sched_barrier(0);
#pragma unroll
      for (int i = 0; i < 4; ++i) *(u32x4*)(Bd + wofs + i * 8192) = rg[i];
      __syncthreads();
    }
    int er_ = pm * 256 + wr * 64, ec_ = pn * 256 + wc * 128, el_ = lane;
    asm volatile("" : "+v"(er_), "+v"(ec_), "+v"(el_));
    epi(acc, er_, ec_, el_);
  }
}

struct EpiInEven {
  bf16_t* proj; const float* rope; const float* lb;
  template <int MT> __device__ __forceinline__ void operator()(f32x4 (&acc)[MT][8], int rbase, int cbase, int lane) const {
    const int sec = cbase >> 9, head = (cbase >> 7) & 3, r = lane & 15, cq = (lane >> 4) * 4;
#pragma unroll
    for (int mt = 0; mt < MT; ++mt) {
      __builtin_amdgcn_sched_barrier(0);
      const int row = rbase + mt * 16 + r;
      bf16_t* dst = proj + (size_t)row * 4096 + cbase + cq;
      if (sec < 2) {
        const int pidx = row < 16384 ? (row & 2047) : 2048 + ((row - 16384) & 7);
        const float* ct = rope + pidx * 128 + cq;
        const float sc = sec == 1 ? 0.08838834764831845f : 1.f;
#pragma unroll
        for (int nt = 0; nt < 4; ++nt) {
          const float4 c4 = *(const float4*)(ct + nt * 16), s4 = *(const float4*)(ct + 64 + nt * 16);
          const f32x4 x1 = acc[mt][nt], x2 = acc[mt][nt + 4];
          store4bf(dst + nt * 16, (x1[0] * c4.x - x2[0] * s4.x) * sc, (x1[1] * c4.y - x2[1] * s4.y) * sc, (x1[2] * c4.z - x2[2] * s4.z) * sc, (x1[3] * c4.w - x2[3] * s4.w) * sc);
          store4bf(dst + 64 + nt * 16, (x1[0] * s4.x + x2[0] * c4.x) * sc, (x1[1] * s4.y + x2[1] * c4.y) * sc, (x1[2] * s4.z + x2[2] * c4.z) * sc, (x1[3] * s4.w + x2[3] * c4.w) * sc);
        }
      } else if (sec == 5) {
#pragma unroll
        for (int nt = 0; nt < 8; ++nt) {
          const float4 l4 = *(const float4*)(lb + head * 128 + nt * 16 + cq);
          const f32x4 x = acc[mt][nt];
          store4bf(dst + nt * 16, __logf(l4.x + (1.f - l4.x) * sigm(x[0])), __logf(l4.y + (1.f - l4.y) * sigm(x[1])), __logf(l4.z + (1.f - l4.z) * sigm(x[2])), __logf(l4.w + (1.f - l4.w) * sigm(x[3])));
        }
      } else {
#pragma unroll
        for (int nt = 0; nt < 8; ++nt) { const f32x4 x = acc[mt][nt]; store4bf(dst + nt * 16, x[0], x[1], x[2], x[3]); }
      }
    }
  }
};
struct EpiOut {
  bf16_t* t0; float* rowss;
  template <int MT> __device__ __forceinline__ void operator()(f32x4 (&acc)[MT][8], int rbase, int cbase, int lane) const {
    const int r = lane & 15, cq = (lane >> 4) * 4;
#pragma unroll
    for (int mt = 0; mt < MT; ++mt) {
      __builtin_amdgcn_sched_barrier(0);
      const int row = rbase + mt * 16 + r;
      bf16_t* dst = t0 + (size_t)row * 1024 + cbase + cq;
      float ss = 0.f;
#pragma unroll
      for (int nt = 0; nt < 8; ++nt) { const f32x4 x = acc[mt][nt]; ss += x[0] * x[0] + x[1] * x[1] + x[2] * x[2] + x[3] * x[3]; store4bf(dst + nt * 16, x[0], x[1], x[2], x[3]); }
      ss += shx(ss, 16); ss += shx(ss, 32);
      if (lane < 16) atomicAdd(rowss + row, ss * (1.f / REPG));
    }
  }
};
struct EpiUp {
  bf16_t* act;
  template <int MT> __device__ __forceinline__ void operator()(f32x4 (&acc)[MT][8], int rbase, int cbase, int lane) const {
    const int r = lane & 15, cq = (lane >> 4) * 4;
#pragma unroll
    for (int mt = 0; mt < MT; ++mt) {
      __builtin_amdgcn_sched_barrier(0);
      bf16_t* dst = act + (size_t)(rbase + mt * 16 + r) * 4096 + cbase + cq;
#pragma unroll
      for (int nt = 0; nt < 8; ++nt) { f32x4 x = acc[mt][nt];
#pragma unroll
        for (int j = 0; j < 4; ++j) { float v = fmaxf(x[j], 0.f); x[j] = v * v; }
        store4bf(dst + nt * 16, x[0], x[1], x[2], x[3]); }
    }
  }
};
struct EpiInOdd {
  bf16_t* proj; float* dtbuf;
  template <int MT> __device__ __forceinline__ void operator()(f32x4 (&acc)[MT][8], int rbase, int cbase, int lane) const {
    const int r = lane & 15, cq = (lane >> 4) * 4;
#pragma unroll
    for (int mt = 0; mt < MT; ++mt) {
      __builtin_amdgcn_sched_barrier(0);
      const int row = rbase + mt * 16 + r;
      bf16_t* dst = proj + (size_t)row * 3200 + cbase + cq;
#pragma unroll
      for (int nt = 0; nt < 8; ++nt) { const f32x4 x = acc[mt][nt]; if (cbase + nt * 16 < 3200) store4bf(dst + nt * 16, x[0], x[1], x[2], x[3]); }
      if (cbase == 2560) { const f32x4 x = acc[mt][0]; *(float4*)(dtbuf + (size_t)row * 16 + cq) = make_float4(x[0], x[1], x[2], x[3]); }
    }
  }
};
struct EpiGlu {
  const bf16_t* gbuf; const float* bglu; bf16_t* mix;
  template <int MT> __device__ __forceinline__ void operator()(f32x4 (&acc)[MT][8], int rbase, int cbase, int lane) const {
    const int r = lane & 15, cq = (lane >> 4) * 4;
#pragma unroll
    for (int mt = 0; mt < MT; ++mt) {
      __builtin_amdgcn_sched_barrier(0);
      const int row = rbase + mt * 16 + r;
#pragma unroll
      for (int nt = 0; nt < 8; ++nt) {
        const int col = cbase + nt * 16 + cq;
        const f32x4 x = acc[mt][nt];
        const uint2 g2 = *(const uint2*)(gbuf + (size_t)row * 512 + col);
        const float4 b4 = *(const float4*)(bglu + col);
        store4bf(mix + (size_t)row * 1536 + 1024 + col, lo2f(g2.x) * sigm(x[0] + b4.x), hi2f(g2.x) * sigm(x[1] + b4.y), lo2f(g2.y) * sigm(x[2] + b4.z), hi2f(g2.y) * sigm(x[3] + b4.w));
      }
    }
  }
};

template <class Epi>
__device__ __forceinline__ void gemm_tail(const bf16_t* A, int lda, const bf16_t* Bt, int ldb, int nNt128, int K, const Epi& epi, char* smem, int wvs, int nBig) {
  bf16_t* As = (bf16_t*)smem;
  bf16_t* Bs = As + 2 * 128 * 72;
  int tid_ = TIDX(wvs); asm volatile("" : "+v"(tid_)); const int tid = tid_, lane = tid & 63, wave = tid >> 6;
  const int nk = K >> 6, G = gridDim.x;
  const int lrow = tid >> 3, lcc = (tid & 7) * 8;
  const unsigned toffA = (unsigned)(lrow * lda + lcc), toffB = (unsigned)(lrow * ldb + lcc);
  const int rr = nBig % G, nLight = G - rr;
  const int nSmall = 8 * nNt128;
  if ((int)blockIdx.x >= rr) {
    for (int j = (int)blockIdx.x - rr; j < nSmall; j += nLight) {
      const int pm = j / nNt128, pn = j - pm * nNt128;
      const bf16_t* Ab = A + (size_t)(16384 + pm * 128) * lda;
      const bf16_t* Bb = Bt + (size_t)(pn * 128) * ldb;
      f32x4 acc[1][8];
#pragma unroll
      for (int q = 0; q < 8; ++q) acc[0][q] = (f32x4){0.f, 0.f, 0.f, 0.f};
      u32x4 ra[2], rb[2];
#pragma unroll
      for (int i = 0; i < 2; ++i) { ra[i] = *(const u32x4*)(Ab + (size_t)(i * 64) * lda + toffA); rb[i] = *(const u32x4*)(Bb + (size_t)(i * 64) * ldb + toffB); }
#pragma unroll
      for (int i = 0; i < 2; ++i) { *(u32x4*)(As + (lrow + i * 64) * 72 + lcc) = ra[i]; *(u32x4*)(Bs + (lrow + i * 64) * 72 + lcc) = rb[i]; }
      __syncthreads();
#pragma unroll 1
      for (int kt = 0; kt < nk; ++kt) {
        const int cur = kt & 1;
        const int kn = (kt + 1 < nk ? kt + 1 : kt) * 64;
#pragma unroll
        for (int i = 0; i < 2; ++i) { ra[i] = *(const u32x4*)(Ab + ((size_t)(i * 64) * lda + kn) + toffA); rb[i] = *(const u32x4*)(Bb + ((size_t)(i * 64) * ldb + kn) + toffB); }
        __builtin_amdgcn_sched_barrier(0);
        wmma_sw<1, 8>(acc, As + cur * 128 * 72 + wave * 16 * 72, 72, Bs + cur * 128 * 72, 72, 64, lane);
        __builtin_amdgcn_sched_barrier(0);
        bf16_t* Ad = As + (cur ^ 1) * 128 * 72; bf16_t* Bd = Bs + (cur ^ 1) * 128 * 72;
#pragma unroll
        for (int i = 0; i < 2; ++i) { *(u32x4*)(Ad + (lrow + i * 64) * 72 + lcc) = ra[i]; *(u32x4*)(Bd + (lrow + i * 64) * 72 + lcc) = rb[i]; }
        __syncthreads();
      }
      int er_ = 16384 + pm * 128 + wave * 16, ec_ = pn * 128, el_ = lane;
      asm volatile("" : "+v"(er_), "+v"(ec_), "+v"(el_));
      epi(acc, er_, ec_, el_);
    }
  }
}

__device__ __forceinline__ void rowpass_phase(const bf16_t* t0, const float* rowss, const float* wpost, const float* hin_a, const float* hin_b, float* hout, const float* wnext, bf16_t* hn, int wvs) {
  int tq_ = TIDX(wvs); asm volatile("" : "+v"(tq_)); const int lane = tq_ & 63, gw = blockIdx.x * 8 + (tq_ >> 6), nw = gridDim.x * 8;
  for (int row = gw; row < ROWS; row += nw) {
    const float* hin = row < 16384 ? hin_a + (size_t)row * 1024 : hin_b + (size_t)(row - 16384) * 1024;
    float r0 = 0.f;
    if (t0) r0 = rsqrtf(rowss[row] * (1.f / 1024.f) + EPSV);
    float4 v[4]; float ss = 0.f;
#pragma unroll
    for (int i = 0; i < 4; ++i) {
      const int col = (i * 64 + lane) * 4;
      float4 hv = *(const float4*)(hin + col);
      if (t0) {
        const uint2 t2 = *(const uint2*)(t0 + (size_t)row * 1024 + col);
        const float4 w4 = *(const float4*)(wpost + col);
        hv.x += lo2f(t2.x) * r0 * w4.x; hv.y += hi2f(t2.x) * r0 * w4.y; hv.z += lo2f(t2.y) * r0 * w4.z; hv.w += hi2f(t2.y) * r0 * w4.w;
      }
      v[i] = hv; ss += hv.x * hv.x + hv.y * hv.y + hv.z * hv.z + hv.w * hv.w;
      if (hout) *(float4*)(hout + (size_t)row * 1024 + col) = hv;
    }
    if (hn) {
#pragma unroll
      for (int o = 32; o >= 1; o >>= 1) ss += shx(ss, o);
      const float r1 = rsqrtf(ss * (1.f / 1024.f) + EPSV);
#pragma unroll
      for (int i = 0; i < 4; ++i) {
        const int col = (i * 64 + lane) * 4;
        const float4 w4 = *(const float4*)(wnext + col);
        store4bf(hn + (size_t)row * 1024 + col, v[i].x * r1 * w4.x, v[i].y * r1 * w4.y, v[i].z * r1 * w4.z, v[i].w * r1 * w4.w);
      }
    }
  }
}

__device__ __forceinline__ void wconv(const float* __restrict__ W, int K, int N, int Npad, bf16_t* __restrict__ Wt, char* smem, int wvs) {
  float* tile = (float*)smem;
  int tq_ = TIDX(wvs) & 255; asm volatile("" : "+v"(tq_)); const int tid = tq_;
  const int nNt = Npad >> 6, nunits = (K >> 6) * nNt;
  for (int u = blockIdx.x * 2 + (wvs >> 2); u < nunits; u += gridDim.x * 2) {
    const int k0 = (u / nNt) * 64, n0 = (u % nNt) * 64;
#pragma unroll
    for (int ps = 0; ps < 4; ++ps) {
      const int i = ps * 16 + (tid >> 4), j = (tid & 15) * 4, n = n0 + j;
      float4 v = make_float4(0.f, 0.f, 0.f, 0.f);
      if (n < N) v = *(const float4*)(W + (size_t)(k0 + i) * N + n);
      tile[i * 65 + j] = v.x; tile[i * 65 + j + 1] = v.y; tile[i * 65 + j + 2] = v.z; tile[i * 65 + j + 3] = v.w;
    }
    __syncthreads();
    {
      const int n = tid >> 2, kq = (tid & 3) * 16;
      uint4 o0, o1;
      o0.x = pack2(tile[(kq + 0) * 65 + n], tile[(kq + 1) * 65 + n]); o0.y = pack2(tile[(kq + 2) * 65 + n], tile[(kq + 3) * 65 + n]);
      o0.z = pack2(tile[(kq + 4) * 65 + n], tile[(kq + 5) * 65 + n]); o0.w = pack2(tile[(kq + 6) * 65 + n], tile[(kq + 7) * 65 + n]);
      o1.x = pack2(tile[(kq + 8) * 65 + n], tile[(kq + 9) * 65 + n]); o1.y = pack2(tile[(kq + 10) * 65 + n], tile[(kq + 11) * 65 + n]);
      o1.z = pack2(tile[(kq + 12) * 65 + n], tile[(kq + 13) * 65 + n]); o1.w = pack2(tile[(kq + 14) * 65 + n], tile[(kq + 15) * 65 + n]);
      bf16_t* d = Wt + (size_t)(n0 + n) * K + k0 + kq;
      *(uint4*)d = o0; *(uint4*)(d + 8) = o1;
    }
    __syncthreads();
  }
}

__device__ __forceinline__ void prep_tables(const Params& p, int wvs) {
  int tq_ = TIDX(wvs); asm volatile("" : "+v"(tq_)); const int gt = blockIdx.x * NTHR + tq_, nt = gridDim.x * NTHR;
  float* rope = (float*)(p.ws + OFF_ROPE);
  for (int i = gt; i < 2056 * 64; i += nt) {
    const int pi = i >> 6, f = i & 63;
    const double pos = pi < 2048 ? (double)pi : (double)(16384 + pi - 2048);
    const double invf = exp(-(double)f * (9.210340371976184 / 64.0));
    double ang = pos * invf;
    ang -= 6.283185307179586 * floor(ang * 0.15915494309189535);
    const float a = (float)ang;
    rope[pi * 128 + f] = cosf(a); rope[pi * 128 + 64 + f] = sinf(a);
  }
  float* z = (float*)(p.ws + OFF_ROWSS);
  for (int i = gt; i < ROWS * 6; i += nt) z[i] = 0.f;
  float* lb = (float*)(p.ws + OFF_LB);
  for (int i = gt; i < 512; i += nt) lb[i] = 1.f / (1.f + expf(p.hgrn_lb[512 + i] - p.hgrn_lb[i]));
  float* tab = (float*)(p.ws + OFF_S5TAB);
  for (int i = gt; i < 2048; i += nt) {
    const int g = i >> 6;
    const float lr = p.s5_lam_re[i], li = p.s5_lam_im[i], dt = expf(p.s5_log_step[g]);
    const float m1 = expf(lr * dt), br = m1 * cosf(li * dt), bi = m1 * sinf(li * dt);
    tab[i] = br; tab[2048 + i] = bi;
    const float m64 = expf(lr * dt * 64.f); tab[69632 + i] = m64 * cosf(li * dt * 64.f); tab[71680 + i] = m64 * sinf(li * dt * 64.f);
    const float m8 = expf(lr * dt * 8.f); tab[73728 + i] = m8 * cosf(li * dt * 8.f); tab[75776 + i] = m8 * sinf(li * dt * 8.f);
    const float x = br - 1.f, y = bi, den = 1.f / (lr * lr + li * li);
    const float qr = (x * lr + y * li) * den, qi = (y * lr - x * li) * den;
    for (int c = 0; c < 16; ++c) {
      const float b_r = p.s5_b_re[i * 16 + c], b_i = p.s5_b_im[i * 16 + c];
      tab[4096 + i * 16 + c] = qr * b_r - qi * b_i;
      tab[4096 + 32768 + i * 16 + c] = qr * b_i + qi * b_r;
    }
  }
}

__device__ __forceinline__ void chunk_geom(int c, int& row0, int& L) { if (c < 256) { row0 = c * 64; L = 64; } else { row0 = 16384 + (c - 256) * 8; L = 8; } }

template <int MODE>
__device__ __forceinline__ void st_load(uint4 (&kr)[4], uint4 (&vr)[(MODE == 2) ? 2 : 1], float& dtr, const bf16_t* src, const float* dtbuf, int row0, int L, int ld, int kcol, int vcol, int h, int tid) {
  constexpr int PW = (MODE == 2) ? 64 : 32, NVC = PW / 32, VCR = PW / 8;
  const uint4 z4 = make_uint4(0, 0, 0, 0);
#pragma unroll
  for (int i = 0; i < 4; ++i) { const int id = tid + i * 256, s = id >> 4, c8 = id & 15; uint4 t_ = z4; if (s < L) t_ = *(const uint4*)(src + (size_t)(row0 + s) * ld + kcol + c8 * 8); kr[i] = t_; }
#pragma unroll
  for (int i = 0; i < NVC; ++i) { const int id = tid + i * 256, s = id / VCR, c8 = id % VCR; uint4 t_ = z4; if (s < L) t_ = *(const uint4*)(src + (size_t)(row0 + s) * ld + vcol + c8 * 8); vr[i] = t_; }
  if (MODE == 2 && tid < 64) dtr = tid < L ? dtbuf[(size_t)(row0 + tid) * 16 + h] : 0.f;
}

template <int MODE>
__device__ __forceinline__ void state_unit(const Params& p, int sq, int h, int ps, char* smem, int wvs) {
  constexpr int PW = (MODE == 2) ? 64 : 32, NT = PW / 16, PF = (MODE == 2) ? 64 : 128, HH = (MODE == 2) ? 16 : 4, NVC = PW / 32, VCR = PW / 8;
  bf16_t* KT = (bf16_t*)smem;
  bf16_t* VT = KT + 128 * 72;
  bf16_t* KR = VT + 64 * 72;
  float* tot = (float*)(KR + 64 * 136);
  float* dec = tot + 256;
  float* av = dec + 64;
  float* dtv = av + 64;
  int tid_ = TIDX(wvs) & 255; asm volatile("" : "+v"(tid_)); const int tid = tid_, lane = tid & 63, wave = tid >> 6;
  const bool prompt = sq < 8;
  const int nch = prompt ? 32 : 1, L = prompt ? 64 : 8;
  const int ld = (MODE == 2) ? 1536 : 4096;
  const bf16_t* src = (MODE == 2) ? (const bf16_t*)(p.ws + OFF_H) : (const bf16_t*)(p.ws + OFF_A);
  const int kcol = MODE == 0 ? 512 + h * 128 : MODE == 1 ? 2560 + h * 128 : 1024 + (h >> 3) * 128;
  const int vcol = MODE == 0 ? 1024 + h * 128 + ps * 32 : MODE == 1 ? 3072 + h * 128 + ps * 32 : h * 64;
  const float* sin_ = MODE == 0 ? p.state_ret : MODE == 1 ? p.state_hgrn : p.state_ssm;
  float* sout = p.out + (MODE == 0 ? O_RET : MODE == 1 ? O_HG : O_SSM) + (size_t)(sq * HH + h) * 128 * PF;
  bf16_t* stb = (bf16_t*)(p.ws + OFF_ST) + (MODE == 1 ? (size_t)256 * 4 * 128 * 128 : 0);
  const float* dtbuf = (const float*)(p.ws + OFF_DTBUF);
  const float l2g = MODE == 0 ? log2f(1.f - exp2f(-5.f - (float)h)) : 0.f;
  float Ah = 0.f, dtb = 0.f;
  if (MODE == 2) { Ah = -expf(p.a_log[h]); dtb = p.dt_bias[h]; }

  f32x4 acc[2][NT];
  const int nb = wave * 32 + (lane >> 4) * 4, pc = ps * PW + (lane & 15);
#pragma unroll
  for (int mt = 0; mt < 2; ++mt)
#pragma unroll
    for (int nt = 0; nt < NT; ++nt)
#pragma unroll
      for (int j = 0; j < 4; ++j)
        acc[mt][nt][j] = prompt ? 0.f : sin_[((size_t)((sq - 8) * HH + h) * 128 + nb + mt * 16 + j) * PF + pc + nt * 16];

  uint4 kr[4], vr[NVC]; float dtr = 0.f;
  const uint4 z4 = make_uint4(0, 0, 0, 0);
  st_load<MODE>(kr, vr, dtr, src, dtbuf, prompt ? sq * 2048 : 16384 + (sq - 8) * 8, L, ld, kcol, vcol, h, tid);
  for (int n = 0; n < nch; ++n) {
    if (prompt) {
      bf16_t* d = stb + ((size_t)((sq * 32 + n) * HH + h) * PF) * 128;
#pragma unroll
      for (int mt = 0; mt < 2; ++mt)
#pragma unroll
        for (int nt = 0; nt < NT; ++nt) store4bf(d + (size_t)(pc + nt * 16) * 128 + nb + mt * 16, acc[mt][nt][0], acc[mt][nt][1], acc[mt][nt][2], acc[mt][nt][3]);
    }
#pragma unroll
    for (int i = 0; i < 4; ++i) { const int id = tid + i * 256, s = id >> 4, c8 = id & 15; *(uint4*)(KR + s * 136 + c8 * 8) = kr[i]; }
#pragma unroll
    for (int i = 0; i < NVC; ++i) {
      const int id = tid + i * 256, s = id / VCR, c8 = id % VCR; const uint4 v = vr[i];
      bf16_t* d = VT + (c8 * 8) * 72 + s;
      d[0] = (bf16_t)(v.x & 0xffff); d[72] = (bf16_t)(v.x >> 16); d[144] = (bf16_t)(v.y & 0xffff); d[216] = (bf16_t)(v.y >> 16);
      d[288] = (bf16_t)(v.z & 0xffff); d[360] = (bf16_t)(v.z >> 16); d[432] = (bf16_t)(v.w & 0xffff); d[504] = (bf16_t)(v.w >> 16);
    }
    if (MODE == 2 && tid < 64) {
      float dt = 0.f;
      if (tid < L) { const float x = dtr + dtb; dt = x > 20.f ? x : log1pf(__expf(x)); }
      dtv[tid] = dt; av[tid] = dt * Ah;
    }
    if (n + 1 < nch) st_load<MODE>(kr, vr, dtr, src, dtbuf, sq * 2048 + (n + 1) * 64, L, ld, kcol, vcol, h, tid);
    __syncthreads();
    const int kn = tid & 127, half = tid >> 7;
    if (MODE == 1) {
      float s_ = 0.f;
      for (int s = half * 32; s < half * 32 + 32; ++s) s_ += bf2f(KR[s * 136 + kn]);
      tot[half * 128 + kn] = s_;
    }
    if (MODE == 2 && tid < 64) {
      float suf = 0.f;
      for (int r = tid + 1; r < 64; ++r) suf += av[r];
      dec[tid] = __expf(suf) * dtv[tid];
      if (tid == 0) tot[0] = suf + av[0];
    }
    if (MODE != 0) __syncthreads();
    {
      float suf = 0.f;
      if (MODE == 1) suf = half == 0 ? tot[128 + kn] : 0.f;
      for (int g = 3; g >= 0; --g) {
        const int s0 = half * 32 + g * 8;
        float v[8];
#pragma unroll
        for (int e = 7; e >= 0; --e) {
          const int s = s0 + e;
          const float raw = bf2f(KR[s * 136 + kn]);
          if (MODE == 0) v[e] = raw * exp2f((float)(L - 1 - s) * l2g);
          else if (MODE == 1) { v[e] = (1.f - __expf(raw)) * __expf(suf); suf += raw; }
          else v[e] = raw * dec[s];
        }
        uint4 o; o.x = pack2(v[0], v[1]); o.y = pack2(v[2], v[3]); o.z = pack2(v[4], v[5]); o.w = pack2(v[6], v[7]);
        *(uint4*)(KT + kn * 72 + s0) = o;
      }
    }
    __syncthreads();
#pragma unroll
    for (int mt = 0; mt < 2; ++mt) {
      float dk[4];
      if (MODE == 0) { const float d = exp2f((float)L * l2g); dk[0] = dk[1] = dk[2] = dk[3] = d; }
      else if (MODE == 2) { const float d = __expf(tot[0]); dk[0] = dk[1] = dk[2] = dk[3] = d; }
      else {
#pragma unroll
        for (int j = 0; j < 4; ++j) { const int nn = nb + mt * 16 + j; dk[j] = __expf(tot[nn] + tot[128 + nn]); }
      }
#pragma unroll
      for (int nt = 0; nt < NT; ++nt)
#pragma unroll
        for (int j = 0; j < 4; ++j) acc[mt][nt][j] *= dk[j];
    }
    wmma_ns<2, NT>(acc, KT + wave * 32 * 72, 72, VT, 72, 64, lane);
    __syncthreads();
  }
#pragma unroll
  for (int mt = 0; mt < 2; ++mt)
#pragma unroll
    for (int nt = 0; nt < NT; ++nt)
#pragma unroll
      for (int j = 0; j < 4; ++j) sout[(size_t)(nb + mt * 16 + j) * PF + pc + nt * 16] = acc[mt][nt][j];
}

template <int MODE>
__device__ __forceinline__ void out_unit(const Params& p, int c, int h, char* smem, int wvs) {
  constexpr int PF = (MODE == 2) ? 64 : 128, NTP = PF / 16, HH = (MODE == 2) ? 16 : 4, NVC = PF / 32, VCR = PF / 8;
  bf16_t* Q = (bf16_t*)smem;
  bf16_t* Kb = Q + 64 * 136;
  bf16_t* STb = Kb + 128 * 72;
  float* cumv = (float*)(STb + 128 * 136);
  float* dtv = cumv + 64;
  float* av = dtv + 64;
  float* tot = av + 64;
  int tid_ = TIDX(wvs) & 255; asm volatile("" : "+v"(tid_)); const int tid = tid_, lane = tid & 63, wave = tid >> 6;
  int row0, L; chunk_geom(c, row0, L);
  const int ld = (MODE == 2) ? 1536 : 4096;
  const bf16_t* src = (MODE == 2) ? (const bf16_t*)(p.ws + OFF_H) : (const bf16_t*)(p.ws + OFF_A);
  const int qcol = MODE == 0 ? h * 128 : MODE == 1 ? 2048 + h * 128 : 1280 + (h >> 3) * 128;
  const int kcol = MODE == 0 ? 512 + h * 128 : MODE == 1 ? 2560 + h * 128 : 1024 + (h >> 3) * 128;
  const int vcol = MODE == 0 ? 1024 + h * 128 : MODE == 1 ? 3072 + h * 128 : h * 64;
  const float l2g = MODE == 0 ? log2f(1.f - exp2f(-5.f - (float)h)) : 0.f;
  const uint4 z4 = make_uint4(0, 0, 0, 0);
#pragma unroll
  for (int i = 0; i < 4; ++i) {
    const int id = tid + i * 256, s = id >> 4, c8 = id & 15;
    uint4 q4 = z4, k4 = z4;
    if (s < L) { q4 = *(const uint4*)(src + (size_t)(row0 + s) * ld + qcol + c8 * 8); k4 = *(const uint4*)(src + (size_t)(row0 + s) * ld + kcol + c8 * 8); }
    *(uint4*)(Q + s * 136 + c8 * 8) = q4; *(uint4*)(Kb + s * 136 + c8 * 8) = k4;
  }
  uint4 vr[NVC];
#pragma unroll
  for (int i = 0; i < NVC; ++i) { const int id = tid + i * 256, s = id / VCR, c8 = id % VCR; uint4 t_ = z4; if (s < L) t_ = *(const uint4*)(src + (size_t)(row0 + s) * ld + vcol + c8 * 8); vr[i] = t_; }
  if (c < 256) {
    const bf16_t* stg = (const bf16_t*)(p.ws + OFF_ST) + (MODE == 1 ? (size_t)256 * 4 * 128 * 128 : 0) + ((size_t)(c * HH + h) * PF) * 128;
#pragma unroll
    for (int i = 0; i < PF / 16; ++i) { const int id = tid + i * 256, pr = id >> 4, c8 = id & 15; *(uint4*)(STb + pr * 136 + c8 * 8) = *(const uint4*)(stg + (size_t)pr * 128 + c8 * 8); }
  } else {
    const float* sg = (MODE == 0 ? p.state_ret : MODE == 1 ? p.state_hgrn : p.state_ssm) + (size_t)((c - 256) * HH + h) * 128 * PF;
    for (int id = tid; id < 128 * (PF / 4); id += 256) {
      const int n = id / (PF / 4), p4 = (id % (PF / 4)) * 4;
      const float4 v = *(const float4*)(sg + (size_t)n * PF + p4);
      STb[(p4 + 0) * 136 + n] = f2bf(v.x); STb[(p4 + 1) * 136 + n] = f2bf(v.y); STb[(p4 + 2) * 136 + n] = f2bf(v.z); STb[(p4 + 3) * 136 + n] = f2bf(v.w);
    }
  }
  if (MODE == 2 && tid < 64) {
    float dt = 0.f;
    if (tid < L) { const float x = ((const float*)(p.ws + OFF_DTBUF))[(size_t)(row0 + tid) * 16 + h] + p.dt_bias[h]; dt = x > 20.f ? x : log1pf(__expf(x)); }
    dtv[tid] = dt; av[tid] = -expf(p.a_log[h]) * dt;
  }
  __syncthreads();
  if (MODE == 1) {
    const int kn = tid & 127, half = tid >> 7;
    float s_ = 0.f;
    for (int s = half * 32; s < half * 32 + 32; ++s) s_ += bf2f(Kb[s * 136 + kn]);
    tot[half * 128 + kn] = s_;
    __syncthreads();
    float cum = half == 1 ? tot[kn] : 0.f;
    for (int s = half * 32; s < half * 32 + 32; ++s) {
      const float lf = bf2f(Kb[s * 136 + kn]);
      cum += lf;
      Q[s * 136 + kn] = f2bf(bf2f(Q[s * 136 + kn]) * __expf(cum));
      Kb[s * 136 + kn] = f2bf((1.f - __expf(lf)) * __expf(-cum));
    }
    __syncthreads();
  }
  if (MODE == 2) {
    if (tid < 64) { float cs = 0.f; for (int r = 0; r <= tid; ++r) cs += av[r]; cumv[tid] = cs; }
    __syncthreads();
  }
  f32x4 ai[1][NTP], asc[1][4];
#pragma unroll
  for (int j = 0; j < NTP; ++j) ai[0][j] = (f32x4){0.f, 0.f, 0.f, 0.f};
#pragma unroll
  for (int j = 0; j < 4; ++j) asc[0][j] = (f32x4){0.f, 0.f, 0.f, 0.f};
  wmma_sw<1, NTP>(ai, Q + wave * 16 * 136, 136, STb, 136, 128, lane);
  wmma_sw<1, 4>(asc, Q + wave * 16 * 136, 136, Kb, 136, 128, lane);
  const int t = wave * 16 + (lane & 15), sq4 = (lane >> 4) * 4;
  float ct = 0.f;
  if (MODE == 2) ct = cumv[t];
#pragma unroll
  for (int nt = 0; nt < 4; ++nt)
#pragma unroll
    for (int j = 0; j < 4; ++j) {
      const int s = nt * 16 + sq4 + j;
      float v = asc[0][nt][j];
      if (s > t) v = 0.f;
      else if (MODE == 0) v *= exp2f((float)(t - s) * l2g);
      else if (MODE == 2) v *= __expf(ct - cumv[s]) * dtv[s];
      asc[0][nt][j] = v;
    }
  __syncthreads();
  bf16_t* Pb = STb; bf16_t* VT = Kb;
#pragma unroll
  for (int nt = 0; nt < 4; ++nt) store4bf(Pb + t * 72 + nt * 16 + sq4, asc[0][nt][0], asc[0][nt][1], asc[0][nt][2], asc[0][nt][3]);
#pragma unroll
  for (int i = 0; i < NVC; ++i) {
    const int id = tid + i * 256, s = id / VCR, c8 = id % VCR; const uint4 v = vr[i];
    bf16_t* d = VT + (c8 * 8) * 72 + s;
    d[0] = (bf16_t)(v.x & 0xffff); d[72] = (bf16_t)(v.x >> 16); d[144] = (bf16_t)(v.y & 0xffff); d[216] = (bf16_t)(v.y >> 16);
    d[288] = (bf16_t)(v.z & 0xffff); d[360] = (bf16_t)(v.z >> 16); d[432] = (bf16_t)(v.w & 0xffff); d[504] = (bf16_t)(v.w >> 16);
  }
  __syncthreads();
  f32x4 ao[1][NTP];
#pragma unroll
  for (int j = 0; j < NTP; ++j) ao[0][j] = (f32x4){0.f, 0.f, 0.f, 0.f};
  wmma_sw<1, NTP>(ao, Pb + wave * 16 * 72, 72, VT, 72, 64, lane);
  float fi = 1.f;
  if (MODE == 0) fi = exp2f((float)(t + 1) * l2g);
  if (MODE == 2) fi = __expf(ct);
  const int row = row0 + t;
  const bool valid = t < L;
  if (MODE == 0 || MODE == 1) {
    float s1 = 0.f, s2 = 0.f;
#pragma unroll
    for (int nt = 0; nt < NTP; ++nt)
#pragma unroll
      for (int j = 0; j < 4; ++j) { const float o = ao[0][nt][j] + fi * ai[0][nt][j]; ao[0][nt][j] = o; s1 += o; s2 += o * o; }
    s1 += shx(s1, 16); s1 += shx(s1, 32); s2 += shx(s2, 16); s2 += shx(s2, 32);
    float mu = 0.f, rs;
    if (MODE == 0) { mu = s1 * (1.f / 128.f); const float var = fmaxf(s2 * (1.f / 128.f) - mu * mu, 0.f); rs = rsqrtf(var + EPSV); }
    else rs = rsqrtf(s2 * (1.f / 128.f) + EPSV);
    if (valid) {
      const float* nw = (MODE == 0 ? p.ret_norm_w : p.hgrn_norm_w) + h * 128;
      const int gcol = (MODE == 0 ? 1536 : 3584) + h * 128;
      bf16_t* mix = (bf16_t*)(p.ws + OFF_H) + (size_t)row * 1024 + (MODE == 0 ? 0 : 512) + h * 128;
#pragma unroll
      for (int nt = 0; nt < NTP; ++nt) {
        const int pp = nt * 16 + sq4;
        const float4 w4 = *(const float4*)(nw + pp);
        const uint2 g2 = *(const uint2*)(src + (size_t)row * ld + gcol + pp);
        store4bf(mix + pp, (ao[0][nt][0] - mu) * rs * w4.x * siluf(lo2f(g2.x)), (ao[0][nt][1] - mu) * rs * w4.y * siluf(hi2f(g2.x)),
                 (ao[0][nt][2] - mu) * rs * w4.z * siluf(lo2f(g2.y)), (ao[0][nt][3] - mu) * rs * w4.w * siluf(hi2f(g2.y)));
      }
    }
  } else {
    const float Dh = p.d_ssm[h];
    bf16_t* zy = (bf16_t*)(p.ws + OFF_A) + (size_t)row * 3200 + h * 64;
    float s2 = 0.f;
    if (valid) {
#pragma unroll
      for (int nt = 0; nt < NTP; ++nt) {
        const int pp = nt * 16 + sq4;
        const uint2 x2 = *(const uint2*)(src + (size_t)row * ld + vcol + pp);
        const uint2 z2 = *(const uint2*)(zy + pp);
        const float y0 = (ao[0][nt][0] + fi * ai[0][nt][0] + Dh * lo2f(x2.x)) * siluf(lo2f(z2.x));
        const float y1 = (ao[0][nt][1] + fi * ai[0][nt][1] + Dh * hi2f(x2.x)) * siluf(hi2f(z2.x));
        const float y2 = (ao[0][nt][2] + fi * ai[0][nt][2] + Dh * lo2f(x2.y)) * siluf(lo2f(z2.y));
        const float y3 = (ao[0][nt][3] + fi * ai[0][nt][3] + Dh * hi2f(x2.y)) * siluf(hi2f(z2.y));
        s2 += y0 * y0 + y1 * y1 + y2 * y2 + y3 * y3;
        store4bf(zy + pp, y0, y1, y2, y3);
      }
    }
    s2 += shx(s2, 16); s2 += shx(s2, 32);
    if (valid && lane < 16) atomicAdd((float*)(p.ws + OFF_SSDST) + (size_t)row * 2 + (h >> 3), s2);
  }
  __syncthreads();
}

template <int OUT>
__device__ __forceinline__ void s5_unit(const Params& p, int c, int gq, char* smem, int wvs) {
  float* Uf = (float*)smem;
  bf16_t* HSall = (bf16_t*)(smem + 16384);
  bf16_t* CMall = (bf16_t*)(smem + 16384 + 34816);
  int tid_ = TIDX(wvs) & 255; asm volatile("" : "+v"(tid_)); const int tid = tid_, lane = tid & 63, wave = tid >> 6;
  int row0, L; chunk_geom(c, row0, L);
  const bf16_t* proj = (const bf16_t*)(p.ws + OFF_A);
#pragma unroll
  for (int i = 0; i < 2; ++i) {
    const int id = tid + i * 256, s = id >> 3, c8 = id & 7;
    uint4 v = make_uint4(0, 0, 0, 0);
    if (s < L) v = *(const uint4*)(proj + (size_t)(row0 + s) * 3200 + 2576 + gq * 64 + c8 * 8);
    float* d = Uf + s * 64 + c8 * 8;
    d[0] = lo2f(v.x); d[1] = hi2f(v.x); d[2] = lo2f(v.y); d[3] = hi2f(v.y); d[4] = lo2f(v.z); d[5] = hi2f(v.z); d[6] = lo2f(v.w); d[7] = hi2f(v.w);
  }
  const int g = gq * 4 + wave, gp = g * 64 + lane;
  const float* tab = (const float*)(p.ws + OFF_S5TAB);
  const float lr = tab[gp], li = tab[2048 + gp];
  f32x2 bb2[16];
#pragma unroll
  for (int q = 0; q < 4; ++q) {
    const float4 a = *(const float4*)(tab + 4096 + gp * 16 + q * 4), b = *(const float4*)(tab + 4096 + 32768 + gp * 16 + q * 4);
    bb2[q * 4] = (f32x2){a.x, b.x}; bb2[q * 4 + 1] = (f32x2){a.y, b.y}; bb2[q * 4 + 2] = (f32x2){a.z, b.z}; bb2[q * 4 + 3] = (f32x2){a.w, b.w};
  }
  float hr = 0.f, hi = 0.f;
  bf16_t* HS = HSall + wave * 32 * 136; bf16_t* CM = CMall + wave * 16 * 136;
  if (OUT) {
    const float2 h0 = *(const float2*)((const float*)(p.ws + OFF_S5H) + ((size_t)c * 2048 + gp) * 2);
    hr = h0.x; hi = h0.y;
#pragma unroll
    for (int ch = 0; ch < 16; ++ch) { CM[ch * 136 + lane] = f2bf(p.s5_c_re[(g * 16 + ch) * 64 + lane]); CM[ch * 136 + 64 + lane] = f2bf(-p.s5_c_im[(g * 16 + ch) * 64 + lane]); }
  }
  __syncthreads();
  const int nhalf = OUT ? ((L + 31) >> 5) : 1, tl = OUT ? 32 : L;
  for (int hf = 0; hf < nhalf; ++hf) {
#pragma unroll 4
    for (int tt = 0; tt < tl; ++tt) {
      const int t = hf * 32 + tt;
      {
        const float* up = Uf + t * 64 + wave * 16;
        f32x2 b0 = (f32x2){0.f, 0.f}, b1 = (f32x2){0.f, 0.f};
#pragma unroll
        for (int q = 0; q < 4; ++q) {
          const f32x4 u4 = *(const f32x4*)(up + q * 4);
          b0 += bb2[q * 4] * u4[0]; b1 += bb2[q * 4 + 1] * u4[1]; b0 += bb2[q * 4 + 2] * u4[2]; b1 += bb2[q * 4 + 3] * u4[3];
        }
        b0 += b1;
        const float nr = lr * hr - li * hi + b0[0], ni = lr * hi + li * hr + b0[1];
        if (t < L) { hr = nr; hi = ni; }
      }
      if (OUT) { HS[tt * 136 + lane] = f2bf(t < L ? hr : 0.f); HS[tt * 136 + 64 + lane] = f2bf(t < L ? hi : 0.f); }
    }
    if (OUT) {
      __syncthreads();
      f32x4 ay[2][1];
      ay[0][0] = (f32x4){0.f, 0.f, 0.f, 0.f}; ay[1][0] = (f32x4){0.f, 0.f, 0.f, 0.f};
      wmma_sw<2, 1>(ay, HS, 136, CM, 136, 128, lane);
      bf16_t* gbuf = (bf16_t*)(p.ws + OFF_GBUF);
#pragma unroll
      for (int mt = 0; mt < 2; ++mt) {
        const int t = hf * 32 + mt * 16 + (lane & 15), ch0 = (lane >> 4) * 4;
        if (t < L) {
          const float4 u4 = *(const float4*)(Uf + t * 64 + wave * 16 + ch0);
          const float4 d4 = *(const float4*)(p.s5_d + g * 16 + ch0);
          float y[4] = {ay[mt][0][0] + d4.x * u4.x, ay[mt][0][1] + d4.y * u4.y, ay[mt][0][2] + d4.z * u4.z, ay[mt][0][3] + d4.w * u4.w};
#pragma unroll
          for (int j = 0; j < 4; ++j) { const float x = y[j], uu = 0.7978845608028654f * (x + 0.044715f * x * x * x); y[j] = x / (1.f + __expf(-2.f * uu)); }
          store4bf(gbuf + (size_t)(row0 + t) * 512 + g * 16 + ch0, y[0], y[1], y[2], y[3]);
        }
      }
      __syncthreads();
    }
  }
  if (!OUT) { *(float2*)((float*)(p.ws + OFF_S5E) + ((size_t)c * 2048 + gp) * 2) = make_float2(hr, hi); }
  __syncthreads();
}

__device__ __forceinline__ void s5_prefix(const Params& p, int gt) {
  const int sq = gt >> 11, rem = gt & 2047;
  const float* tab = (const float*)(p.ws + OFF_S5TAB);
  const float* e = (const float*)(p.ws + OFF_S5E);
  float* hs = (float*)(p.ws + OFF_S5H);
  float hr = 0.f, hi = 0.f;
  if (sq < 8) {
    const float lr = tab[69632 + rem], li = tab[71680 + rem];
    for (int n = 0; n < 32; ++n) {
      const size_t idx = ((size_t)(sq * 32 + n) * 2048 + rem) * 2;
      *(float2*)(hs + idx) = make_float2(hr, hi);
      const float2 ev = *(const float2*)(e + idx);
      const float nr = lr * hr - li * hi + ev.x, ni = lr * hi + li * hr + ev.y; hr = nr; hi = ni;
    }
  } else {
    const float lr = tab[73728 + rem], li = tab[75776 + rem];
    hr = p.state_s5_re[(size_t)(sq - 8) * 2048 + rem]; hi = p.state_s5_im[(size_t)(sq - 8) * 2048 + rem];
    const size_t idx = ((size_t)(256 + sq - 8) * 2048 + rem) * 2;
    *(float2*)(hs + idx) = make_float2(hr, hi);
    const float2 ev = *(const float2*)(e + idx);
    const float nr = lr * hr - li * hi + ev.x, ni = lr * hi + li * hr + ev.y; hr = nr; hi = ni;
  }
  p.out[O_S5RE + (size_t)sq * 2048 + rem] = hr;
  p.out[O_S5IM + (size_t)sq * 2048 + rem] = hi;
}

__device__ __forceinline__ void conv_phase(const Params& p, int wvs) {
  const bf16_t* proj = (const bf16_t*)(p.ws + OFF_A);
  bf16_t* xc = (bf16_t*)(p.ws + OFF_H);
  int tq_ = TIDX(wvs); asm volatile("" : "+v"(tq_)); const int gt = blockIdx.x * NTHR + tq_, nt = gridDim.x * NTHR;
  for (int task = gt; task < 544 * 192; task += nt) {
    const int seg = task / 192, c = (task - seg * 192) * 8, rowb = seg * 32;
    float w[4][8], bia[8];
#pragma unroll
    for (int j = 0; j < 4; ++j) {
      const float4 w0 = *(const float4*)(p.conv_w + j * 1536 + c), w1 = *(const float4*)(p.conv_w + j * 1536 + c + 4);
      w[j][0] = w0.x; w[j][1] = w0.y; w[j][2] = w0.z; w[j][3] = w0.w; w[j][4] = w1.x; w[j][5] = w1.y; w[j][6] = w1.z; w[j][7] = w1.w;
    }
    { const float4 b0 = *(const float4*)(p.conv_b + c), b1 = *(const float4*)(p.conv_b + c + 4); bia[0] = b0.x; bia[1] = b0.y; bia[2] = b0.z; bia[3] = b0.w; bia[4] = b1.x; bia[5] = b1.y; bia[6] = b1.z; bia[7] = b1.w; }
    float x0[8], x1[8], x2[8];
    if (rowb < 16384 && (rowb & 2047) != 0) {
      const u32x4 v0 = *(const u32x4*)(proj + (size_t)(rowb - 3) * 3200 + 1024 + c), v1 = *(const u32x4*)(proj + (size_t)(rowb - 2) * 3200 + 1024 + c), v2 = *(const u32x4*)(proj + (size_t)(rowb - 1) * 3200 + 1024 + c);
#pragma unroll
      for (int e = 0; e < 4; ++e) { x0[2 * e] = lo2f(v0[e]); x0[2 * e + 1] = hi2f(v0[e]); x1[2 * e] = lo2f(v1[e]); x1[2 * e + 1] = hi2f(v1[e]); x2[2 * e] = lo2f(v2[e]); x2[2 * e + 1] = hi2f(v2[e]); }
    } else {
#pragma unroll
      for (int e = 0; e < 8; ++e) { x0[e] = 0.f; x1[e] = 0.f; x2[e] = 0.f; }
    }
    u32x4 nxt = *(const u32x4*)(proj + (size_t)rowb * 3200 + 1024 + c);
    for (int r = 0; r < 32; ++r) {
      const int row = rowb + r;
      const u32x4 cv = nxt;
      if (r + 1 < 32) nxt = *(const u32x4*)(proj + (size_t)(row + 1) * 3200 + 1024 + c);
      int t, T, sq;
      if (row < 16384) { t = row & 2047; T = 2048; sq = row >> 11; } else { t = (row - 16384) & 7; T = 8; sq = 8 + ((row - 16384) >> 3); }
      if (t == 0) {
        if (sq >= 8) {
          const float* sc = p.state_conv + (size_t)(sq - 8) * 3 * 1536 + c;
          const float4 a0 = *(const float4*)sc, a1 = *(const float4*)(sc + 4), b0 = *(const float4*)(sc + 1536), b1 = *(const float4*)(sc + 1540), c0 = *(const float4*)(sc + 3072), c1 = *(const float4*)(sc + 3076);
          x0[0] = a0.x; x0[1] = a0.y; x0[2] = a0.z; x0[3] = a0.w; x0[4] = a1.x; x0[5] = a1.y; x0[6] = a1.z; x0[7] = a1.w;
          x1[0] = b0.x; x1[1] = b0.y; x1[2] = b0.z; x1[3] = b0.w; x1[4] = b1.x; x1[5] = b1.y; x1[6] = b1.z; x1[7] = b1.w;
          x2[0] = c0.x; x2[1] = c0.y; x2[2] = c0.z; x2[3] = c0.w; x2[4] = c1.x; x2[5] = c1.y; x2[6] = c1.z; x2[7] = c1.w;
        } else {
#pragma unroll
          for (int e = 0; e < 8; ++e) { x0[e] = 0.f; x1[e] = 0.f; x2[e] = 0.f; }
        }
      }
      float cur[8], o[8];
#pragma unroll
      for (int e = 0; e < 4; ++e) { cur[2 * e] = lo2f(cv[e]); cur[2 * e + 1] = hi2f(cv[e]); }
#pragma unroll
      for (int e = 0; e < 8; ++e) { o[e] = siluf(bia[e] + w[0][e] * x0[e] + w[1][e] * x1[e] + w[2][e] * x2[e] + w[3][e] * cur[e]); x0[e] = x1[e]; x1[e] = x2[e]; x2[e] = cur[e]; }
      u32x4 ov; ov[0] = pack2(o[0], o[1]); ov[1] = pack2(o[2], o[3]); ov[2] = pack2(o[4], o[5]); ov[3] = pack2(o[6], o[7]);
      *(u32x4*)(xc + (size_t)row * 1536 + c) = ov;
      if (t >= T - 3) {
        float* d = p.out + O_CONV + ((size_t)sq * 3 + (t - (T - 3))) * 1536 + c;
        *(float4*)d = make_float4(cur[0], cur[1], cur[2], cur[3]); *(float4*)(d + 4) = make_float4(cur[4], cur[5], cur[6], cur[7]);
      }
    }
  }
}

__device__ __forceinline__ void ssdnorm_phase(const Params& p, int wvs) {
  const bf16_t* proj = (const bf16_t*)(p.ws + OFF_A);
  bf16_t* mix = (bf16_t*)(p.ws + OFF_H);
  const float* st = (const float*)(p.ws + OFF_SSDST);
  int tq_ = TIDX(wvs); asm volatile("" : "+v"(tq_)); const int gt = blockIdx.x * NTHR + tq_, nt = gridDim.x * NTHR;
  for (int it = gt; it < ROWS * 128; it += nt) {
    const int row = it >> 7, c = (it & 127) * 8;
    const float r = rsqrtf(st[(size_t)row * 2 + (c >> 9)] * (1.f / 512.f) + EPSV);
    const uint4 v = *(const uint4*)(proj + (size_t)row * 3200 + c);
    const float4 w0 = *(const float4*)(p.ssm_norm_w + c), w1 = *(const float4*)(p.ssm_norm_w + c + 4);
    uint4 o; o.x = pack2(lo2f(v.x) * r * w0.x, hi2f(v.x) * r * w0.y); o.y = pack2(lo2f(v.y) * r * w0.z, hi2f(v.y) * r * w0.w);
    o.z = pack2(lo2f(v.z) * r * w1.x, hi2f(v.z) * r * w1.y); o.w = pack2(lo2f(v.w) * r * w1.z, hi2f(v.w) * r * w1.w);
    *(uint4*)(mix + (size_t)row * 1536 + c) = o;
  }
}


#define XB_TMO      128
#define XB_XCNT(j)  (256  + 64 * (j))
#define XB_XSUB(j)  (1280 + 64 * (j))
#define XB_XGEN(j)  (2304 + 64 * (j))
#define XB_TOP      3328
#define XB_TOPGEN   3392
#define XCD_BAR_WORDS 3456
#define XB_SPIN_CAP (1u << 18)
#define LAS __attribute__((address_space(3)))
__device__ __forceinline__ unsigned xb_ld(unsigned* p)              { return __hip_atomic_load(p, __ATOMIC_RELAXED, __HIP_MEMORY_SCOPE_AGENT); }
__device__ __forceinline__ unsigned xb_add(unsigned* p, unsigned v) { return __hip_atomic_fetch_add(p, v, __ATOMIC_RELAXED, __HIP_MEMORY_SCOPE_AGENT); }
__device__ __forceinline__ unsigned xb_xcc_id() { return (unsigned)__builtin_amdgcn_s_getreg((3 << 11) | 20) & 0xFu; }
#define XB_SPIN(cond, bar) do { unsigned _sp = 0; while (cond) { __builtin_amdgcn_s_sleep(1); \
    if ((++_sp & 255u) == 0u) { if (xb_ld(&(bar)[XB_TMO])) break; if (_sp > XB_SPIN_CAP) { atomicAdd(&(bar)[XB_TMO], 1u); break; } } } } while (0)
struct XcdBarrier { unsigned* bar; unsigned x; volatile LAS unsigned* st; };
__device__ __forceinline__ XcdBarrier xcd_barrier_post(unsigned* bar, volatile LAS unsigned* st, int wvs) {
    XcdBarrier b; b.bar = bar; b.x = xb_xcc_id(); b.st = st;
    if (TIDX(wvs) == 0) (void)xb_add(&bar[XB_XCNT(b.x)], 1u);
    return b;
}
__device__ __forceinline__ void xcd_barrier_complete(unsigned* bar, unsigned x, unsigned& nloc, unsigned& nx) {
    const unsigned G = gridDim.x * gridDim.y * gridDim.z;
    unsigned sum, cnt, mine, sp = 0u;
    for (;;) {
        sum = 0u; cnt = 0u; mine = 0u;
#pragma unroll
        for (unsigned j = 0; j < 16; ++j) { const unsigned c = xb_ld(&bar[XB_XCNT(j)]); sum += c; cnt += (c > 0u) ? 1u : 0u; mine = (j == x) ? c : mine; }
        if (sum == G) break;
        __builtin_amdgcn_s_sleep(1);
        if ((++sp & 255u) == 0u) { if (xb_ld(&bar[XB_TMO])) break; if (sp > XB_SPIN_CAP) { atomicAdd(&bar[XB_TMO], 1u); break; } }
    }
    nloc = mine > 0u ? mine : 1u; nx = cnt > 0u ? cnt : 1u;
}
__device__ __forceinline__ void xcd_barrier(const XcdBarrier& b, int wvs) {
    asm volatile("s_waitcnt vmcnt(0)" ::: "memory");
    __syncthreads();
    if (TIDX(wvs) == 0) {
        unsigned* bar = b.bar;
        __builtin_amdgcn_s_waitcnt(0);
        unsigned nloc = b.st[0], nx = b.st[1];
        if (nloc == 0u) { xcd_barrier_complete(bar, b.x, nloc, nx); b.st[0] = nloc; b.st[1] = nx; }
        const unsigned old = xb_add(&bar[XB_XSUB(b.x)], 1u);
        const unsigned gen = old / nloc;
        if (old + 1u == (gen + 1u) * nloc) {
            __builtin_amdgcn_fence(__ATOMIC_RELEASE, "agent");
            asm volatile("s_waitcnt vmcnt(0)" ::: "memory");
            const unsigned og = xb_add(&bar[XB_TOP], 1u);
            const unsigned tg = og / nx;
            if (og + 1u == (tg + 1u) * nx) xb_add(&bar[XB_TOPGEN], 1u);
            else XB_SPIN(xb_ld(&bar[XB_TOPGEN]) == tg, bar);
            __builtin_amdgcn_fence(__ATOMIC_ACQUIRE, "agent");
            xb_add(&bar[XB_XGEN(b.x)], 1u);
            asm volatile("s_waitcnt vmcnt(0)" ::: "memory");
        } else {
            XB_SPIN(xb_ld(&bar[XB_XGEN(b.x)]) == gen, bar);
            __builtin_amdgcn_fence(__ATOMIC_ACQUIRE, "agent");
            asm volatile("s_waitcnt vmcnt(0)" ::: "memory");
        }
    }
    __syncthreads();
}


__device__ __forceinline__ Params ldp() {
  auto kp = __builtin_amdgcn_kernarg_segment_ptr();
  asm volatile("" : "+s"(kp));
  Params q;
  __builtin_memcpy(&q, (const void*)kp, sizeof(Params));
  return q;
}

__global__ void __launch_bounds__(NTHR, 2) fwd_megakernel(Params p_) {
  extern __shared__ __attribute__((aligned(16))) char smem[];
  cg::grid_group grid = cg::this_grid();
  if (p_.ws == nullptr) grid.sync();
  volatile LAS unsigned* xst = (volatile LAS unsigned*)(smem + 2 * HALF_LDS);
  const int wvs = __builtin_amdgcn_readfirstlane(threadIdx.x >> 6);
  if (TIDX(wvs) == 0) { xst[0] = 0u; xst[1] = 0u; xst[2] = 0u; xst[3] = 0u; }
  __syncthreads();
  const XcdBarrier xb = xcd_barrier_post((unsigned*)(p_.ws + OFF_BAR), xst, wvs);
  const int half = wvs >> 2;
  const int G = gridDim.x * 2, bid = blockIdx.x * 2 + half;
  char* hs = smem + half * HALF_LDS;
#define PH_BEGIN const Params p = ldp(); bf16_t* bufA = (bf16_t*)(p.ws + OFF_A); bf16_t* bufH = (bf16_t*)(p.ws + OFF_H); bf16_t* t0 = (bf16_t*)(p.ws + OFF_ST); \
    float* rowss = (float*)(p.ws + OFF_ROWSS); float* hbuf = p.out; (void)bufA; (void)bufH; (void)t0; (void)rowss; (void)hbuf;

  {
  PH_BEGIN
  prep_tables(p, wvs);
  wconv(p.w_in_even, 1024, 4096, 4096, (bf16_t*)(p.ws + W_IN), hs, wvs);
  wconv(p.w_out_even, 1024, 1024, 1024, (bf16_t*)(p.ws + W_OUT0), hs, wvs);
  wconv(p.w_ffn_up, 1024, 4096, 4096, (bf16_t*)(p.ws + W_UP), hs, wvs);
  wconv(p.w_ffn_down, 4096, 1024, 1024, (bf16_t*)(p.ws + W_DOWN), hs, wvs);
  rowpass_phase(nullptr, nullptr, nullptr, p.x_prompt, p.x_sample, nullptr, p.norm_mix_pre, bufH, wvs);
  }
  xcd_barrier(xb, wvs);
  {
  PH_BEGIN
  { EpiInEven e{bufA, (const float*)(p.ws + OFF_ROPE), (const float*)(p.ws + OFF_LB)};
    for (int rep_ = 0; rep_ < REPG; ++rep_) { gemm_phase(bufH, 1024, (const bf16_t*)(p.ws + W_IN), 1024, 64, 16, 1024, e, smem, wvs); gemm_tail(bufH, 1024, (const bf16_t*)(p.ws + W_IN), 1024, 32, 1024, e, smem, wvs, 64 * 16); } }
  }
  xcd_barrier(xb, wvs);
  {
  PH_BEGIN
  for (int rep_ = 0; rep_ < REPS; ++rep_) {
    if (bid < 256) {
      const int v = bid;
      const int ps = v & 3, m = (v >> 2) & 1, h = (v >> 3) & 3, sq = v >> 5;
      if (m == 0) state_unit<0>(p, sq, h, ps, hs, wvs); else state_unit<1>(p, sq, h, ps, hs, wvs);
    }
    const int nsh = bid < 256 ? 2 : 14, j0 = bid < 256 ? bid : 512 + (bid - 256);
    for (int i = 0; i < nsh; ++i) {
      const int v = j0 + 256 * i;
      const int ps = v & 3, m = (v >> 2) & 1, h = (v >> 3) & 3, sq = 8 + (v >> 5);
      if (m == 0) state_unit<0>(p, sq, h, ps, hs, wvs); else state_unit<1>(p, sq, h, ps, hs, wvs);
    }
  }
  }
  xcd_barrier(xb, wvs);
  {
  PH_BEGIN
  for (int rep_ = 0; rep_ < REPO; ++rep_)
  for (int u = bid; u < 384 * 8; u += G) {
    const int h = u & 3, m = (u >> 2) & 1, c = u >> 3;
    if (m == 0) out_unit<0>(p, c, h, hs, wvs); else out_unit<1>(p, c, h, hs, wvs);
  }
  }
  xcd_barrier(xb, wvs);
  {
  PH_BEGIN
  { EpiOut e{t0, rowss};
    for (int rep_ = 0; rep_ < REPG; ++rep_) { gemm_phase(bufH, 1024, (const bf16_t*)(p.ws + W_OUT0), 1024, 64, 4, 1024, e, smem, wvs); gemm_tail(bufH, 1024, (const bf16_t*)(p.ws + W_OUT0), 1024, 8, 1024, e, smem, wvs, 64 * 4); } }
  }
  xcd_barrier(xb, wvs);
  {
  PH_BEGIN
  for (int rep_ = 0; rep_ < REPR; ++rep_)
  rowpass_phase(t0, rowss, p.norm_mix_post, p.x_prompt, p.x_sample, hbuf, p.norm_ffn_pre, bufH, wvs);
  }
  xcd_barrier(xb, wvs);
  {
  PH_BEGIN
  { EpiUp e{bufA}; for (int rep_ = 0; rep_ < REPG; ++rep_) { gemm_phase(bufH, 1024, (const bf16_t*)(p.ws + W_UP), 1024, 64, 16, 1024, e, smem, wvs); gemm_tail(bufH, 1024, (const bf16_t*)(p.ws + W_UP), 1024, 32, 1024, e, smem, wvs, 64 * 16); } }
  }
  xcd_barrier(xb, wvs);
  {
  PH_BEGIN
  { EpiOut e{t0, rowss + ROWS}; for (int rep_ = 0; rep_ < REPG; ++rep_) { gemm_phase(bufA, 4096, (const bf16_t*)(p.ws + W_DOWN), 4096, 64, 4, 4096, e, smem, wvs); gemm_tail(bufA, 4096, (const bf16_t*)(p.ws + W_DOWN), 4096, 8, 4096, e, smem, wvs, 64 * 4); } }
  }
  xcd_barrier(xb, wvs);
  {
  PH_BEGIN
  rowpass_phase(t0, rowss + ROWS, p.norm_ffn_post, hbuf, hbuf + (size_t)16384 * 1024, hbuf, p.norm_mix_pre + 1024, bufH, wvs);
  wconv(p.w_in_odd, 1024, 3088, 3328, (bf16_t*)(p.ws + W_IN), hs, wvs);
  wconv(p.w_glu, 512, 512, 512, (bf16_t*)(p.ws + W_GLU), hs, wvs);
  wconv(p.w_out_odd, 1536, 1024, 1024, (bf16_t*)(p.ws + W_OUT1), hs, wvs);
  wconv(p.w_ffn_up + (size_t)1024 * 4096, 1024, 4096, 4096, (bf16_t*)(p.ws + W_UP), hs, wvs);
  wconv(p.w_ffn_down + (size_t)4096 * 1024, 4096, 1024, 1024, (bf16_t*)(p.ws + W_DOWN), hs, wvs);
  }
  xcd_barrier(xb, wvs);
  {
  PH_BEGIN
  { EpiInOdd e{bufA, (float*)(p.ws + OFF_DTBUF)};
    for (int rep_ = 0; rep_ < REPG; ++rep_) { gemm_phase(bufH, 1024, (const bf16_t*)(p.ws + W_IN), 1024, 64, 13, 1024, e, smem, wvs); gemm_tail(bufH, 1024, (const bf16_t*)(p.ws + W_IN), 1024, 26, 1024, e, smem, wvs, 64 * 13); } }
  }
  xcd_barrier(xb, wvs);
  {
  PH_BEGIN
  for (int rep_ = 0; rep_ < REPC; ++rep_) {
  conv_phase(p, wvs);
  for (int u = bid; u < 384 * 8; u += G) s5_unit<0>(p, u >> 3, u & 7, hs, wvs);
  }
  }
  xcd_barrier(xb, wvs);
  {
  PH_BEGIN
  for (int rep_ = 0; rep_ < REPS; ++rep_) {
    if (bid < 128) state_unit<2>(p, bid >> 4, bid & 15, 0, hs, wvs);
    for (int j = bid < 128 ? bid : 256 + (bid - 128); j < 3136; j += (bid < 128 ? 128 : 384)) {
      if (bid < 128 && j >= 256) break;
      if (j < 1088) { int tq_ = TIDX(wvs) & 255; asm volatile("" : "+v"(tq_)); s5_prefix(p, j * 256 + tq_); }
      else { const int v = j - 1088; state_unit<2>(p, 8 + (v >> 4), v & 15, 0, hs, wvs); }
    }
  }
  }
  xcd_barrier(xb, wvs);
  {
  PH_BEGIN
  for (int u = bid; u < 384 * 16 + 384 * 8; u += G) {
    if (u < 384 * 16) out_unit<2>(p, u >> 4, u & 15, hs, wvs);
    else { const int v = u - 384 * 16; s5_unit<1>(p, v >> 3, v & 7, hs, wvs); }
  }
  }
  xcd_barrier(xb, wvs);
  {
  PH_BEGIN
  ssdnorm_phase(p, wvs);
  { EpiGlu e{(const bf16_t*)(p.ws + OFF_GBUF), p.b_glu, bufH};
    for (int rep_ = 0; rep_ < REPG; ++rep_) { gemm_phase((const bf16_t*)(p.ws + OFF_GBUF), 512, (const bf16_t*)(p.ws + W_GLU), 512, 64, 2, 512, e, smem, wvs); gemm_tail((const bf16_t*)(p.ws + OFF_GBUF), 512, (const bf16_t*)(p.ws + W_GLU), 512, 4, 512, e, smem, wvs, 64 * 2); } }
  }
  xcd_barrier(xb, wvs);
  {
  PH_BEGIN
  { EpiOut e{t0, rowss + 2 * ROWS}; for (int rep_ = 0; rep_ < REPG; ++rep_) { gemm_phase(bufH, 1536, (const bf16_t*)(p.ws + W_OUT1), 1536, 64, 4, 1536, e, smem, wvs); gemm_tail(bufH, 1536, (const bf16_t*)(p.ws + W_OUT1), 1536, 8, 1536, e, smem, wvs, 64 * 4); } }
  }
  xcd_barrier(xb, wvs);
  {
  PH_BEGIN
  rowpass_phase(t0, rowss + 2 * ROWS, p.norm_mix_post + 1024, hbuf, hbuf + (size_t)16384 * 1024, hbuf, p.norm_ffn_pre + 1024, bufH, wvs);
  }
  xcd_barrier(xb, wvs);
  {
  PH_BEGIN
  { EpiUp e{bufA}; for (int rep_ = 0; rep_ < REPG; ++rep_) { gemm_phase(bufH, 1024, (const bf16_t*)(p.ws + W_UP), 1024, 64, 16, 1024, e, smem, wvs); gemm_tail(bufH, 1024, (const bf16_t*)(p.ws + W_UP), 1024, 32, 1024, e, smem, wvs, 64 * 16); } }
  }
  xcd_barrier(xb, wvs);
  {
  PH_BEGIN
  { EpiOut e{t0, rowss + 3 * ROWS}; for (int rep_ = 0; rep_ < REPG; ++rep_) { gemm_phase(bufA, 4096, (const bf16_t*)(p.ws + W_DOWN), 4096, 64, 4, 4096, e, smem, wvs); gemm_tail(bufA, 4096, (const bf16_t*)(p.ws + W_DOWN), 4096, 8, 4096, e, smem, wvs, 64 * 4); } }
  }
  xcd_barrier(xb, wvs);
  {
  PH_BEGIN
  rowpass_phase(t0, rowss + 3 * ROWS, p.norm_ffn_post + 1024, hbuf, hbuf + (size_t)16384 * 1024, hbuf, nullptr, nullptr, wvs);
  }
}

extern "C" void kernel_launch(void* const* d_in, const int* in_sizes, int n_in, void* d_out, int out_size, void* d_ws, size_t ws_size, hipStream_t stream) {
  constexpr size_t kDynLds = 2 * HALF_LDS + 64;
  static int grid_blocks = 0;
  if (!grid_blocks) {
    int dev = 0, cus = 0, per_cu = 0;
    (void)hipGetDevice(&dev);
    (void)hipDeviceGetAttribute(&cus, hipDeviceAttributeMultiprocessorCount, dev);
    (void)hipFuncSetAttribute((const void*)fwd_megakernel, hipFuncAttributeMaxDynamicSharedMemorySize, (int)kDynLds);
    (void)hipOccupancyMaxActiveBlocksPerMultiprocessor(&per_cu, fwd_megakernel, NTHR, kDynLds);
    if (per_cu > 1) per_cu = 1;
    if (per_cu < 1) per_cu = 1;
    grid_blocks = cus * per_cu;
  }
  Params p{};
  const float** pf = (const float**)&p;
  for (int i = 0; i < 37; ++i) pf[i] = (const float*)d_in[i];
  p.out = (float*)d_out;
  p.ws = (char*)d_ws;
  (void)hipMemsetAsync((char*)d_ws + OFF_BAR, 0, 16384, stream);
  void* args[] = {&p};
  hipError_t e = hipLaunchCooperativeKernel((void*)fwd_megakernel, dim3(grid_blocks), dim3(NTHR), args, kDynLds, stream);
  if (e != hipSuccess) fprintf(stderr, "cooperative launch failed: %s (grid %d)\n", hipGetErrorString(e), grid_blocks);
}
```

```cpp
#include <hip/hip_runtime.h>
#include <hip/hip_cooperative_groups.h>
#include <cstdio>
namespace cg = cooperative_groups;

typedef unsigned short bf16_t;
typedef short bf16x8 __attribute__((ext_vector_type(8)));
typedef float f32x4 __attribute__((ext_vector_type(4)));
typedef unsigned u32x4 __attribute__((ext_vector_type(4)));
typedef float f32x2 __attribute__((ext_vector_type(2)));

#define NTHR 512
#ifndef REPS
#define REPS 1
#endif
#ifndef REPO
#define REPO 1
#endif
#ifndef REPC
#define REPC 1
#endif
#ifndef REPR
#define REPR 1
#endif
#ifndef REPG
#define REPG 1
#endif
#define HALF_LDS 74752
#ifndef REP0
#define REP0 1
#endif
#ifndef REPS
#define REPS 1
#endif
#ifndef REPO
#define REPO 1
#endif
#ifndef REPC
#define REPC 1
#endif
#ifndef REPY
#define REPY 21
#endif
#define ROWS 17408
#define EPSV 1e-6f
#define TIDX(w) ((w) * 64 + (int)__builtin_amdgcn_mbcnt_hi(~0u, __builtin_amdgcn_mbcnt_lo(~0u, 0u)))

constexpr size_t W_IN = 0;
constexpr size_t W_OUT0 = 8388608;
constexpr size_t W_GLU = 6815744;
constexpr size_t W_OUT1 = 7340032;
constexpr size_t W_UP = 10485760;
constexpr size_t W_DOWN = 18874368;
constexpr size_t OFF_A = 29360128;
constexpr size_t OFF_GBUF = OFF_A + 111411200;
constexpr size_t OFF_ST = OFF_A + 142606336;
constexpr size_t OFF_H = OFF_ST + 67108864;
constexpr size_t OFF_SM = OFF_H + 53477376;
constexpr size_t OFF_ROPE = OFF_SM;
constexpr size_t OFF_ROWSS = OFF_SM + 1052672;
constexpr size_t OFF_SSDST = OFF_SM + 1331200;
constexpr size_t OFF_DTBUF = OFF_SM + 1470464;
constexpr size_t OFF_LB = OFF_SM + 2584576;
constexpr size_t OFF_S5TAB = OFF_SM + 2586624;
constexpr size_t OFF_S5E = OFF_SM + 2897920;
constexpr size_t OFF_S5H = OFF_SM + 9189376;
constexpr size_t OFF_BAR = OFF_SM + 15480832;

constexpr size_t O_RET = 17825792, O_HG = 26738688, O_SSM = 35651584, O_CONV = 53477376, O_S5RE = 54104064, O_S5IM = 54382592;

struct Params {
  const float *x_prompt, *x_sample, *state_ret, *state_hgrn, *state_ssm, *state_conv, *state_s5_re, *state_s5_im;
  const float *norm_mix_pre, *norm_mix_post, *norm_ffn_pre, *norm_ffn_post;
  const float *w_in_even, *w_out_even, *ret_norm_w, *hgrn_lb, *hgrn_norm_w, *w_in_odd, *conv_w, *conv_b, *dt_bias, *a_log, *d_ssm, *ssm_norm_w;
  const float *s5_lam_re, *s5_lam_im, *s5_log_step, *s5_b_re, *s5_b_im, *s5_c_re, *s5_c_im, *s5_d, *w_glu, *b_glu, *w_out_odd, *w_ffn_up, *w_ffn_down;
  float* out;
  char* ws;
};

__device__ __forceinline__ bf16_t f2bf(float f) { unsigned r; asm("v_cvt_pk_bf16_f32 %0, %1, %1" : "=v"(r) : "v"(f)); return (bf16_t)(r & 0xffffu); }
__device__ __forceinline__ float bf2f(bf16_t h) { return __uint_as_float(((unsigned)h) << 16); }
__device__ __forceinline__ unsigned pack2(float a, float b) { unsigned r; asm("v_cvt_pk_bf16_f32 %0, %1, %2" : "=v"(r) : "v"(a), "v"(b)); return r; }
__device__ __forceinline__ float lo2f(unsigned u) { return __uint_as_float(u << 16); }
__device__ __forceinline__ float hi2f(unsigned u) { return __uint_as_float(u & 0xffff0000u); }
__device__ __forceinline__ float sigm(float x) { return 1.f / (1.f + __expf(-x)); }
__device__ __forceinline__ float siluf(float x) { return x / (1.f + __expf(-x)); }
__device__ __forceinline__ void store4bf(bf16_t* p, float a, float b, float c, float d) { uint2 v; v.x = pack2(a, b); v.y = pack2(c, d); *(uint2*)p = v; }

__device__ __forceinline__ float shx(float v, int mask) {
  int l = (int)__builtin_amdgcn_mbcnt_hi(~0u, __builtin_amdgcn_mbcnt_lo(~0u, 0u));
  asm volatile("" : "+v"(l));
  return __int_as_float(__builtin_amdgcn_ds_bpermute((l ^ mask) << 2, __float_as_int(v)));
}

template <int MT, int NT>
__device__ __forceinline__ void wmma_sw(f32x4 (&acc)[MT][NT], const bf16_t* A, int lda, const bf16_t* B, int ldb, int K, int lane) {
  const int r = lane & 15, kq = (lane >> 4) * 8;
  for (int k0 = 0; k0 < K; k0 += 32) {
    bf16x8 af[MT], bfr[NT];
#pragma unroll
    for (int mt = 0; mt < MT; ++mt) af[mt] = *(const bf16x8*)(A + (mt * 16 + r) * lda + k0 + kq);
#pragma unroll
    for (int nt = 0; nt < NT; ++nt) bfr[nt] = *(const bf16x8*)(B + (nt * 16 + r) * ldb + k0 + kq);
#pragma unroll
    for (int mt = 0; mt < MT; ++mt)
#pragma unroll
      for (int nt = 0; nt < NT; ++nt) acc[mt][nt] = __builtin_amdgcn_mfma_f32_16x16x32_bf16(bfr[nt], af[mt], acc[mt][nt], 0, 0, 0);
  }
}
template <int MT, int NT>
__device__ __forceinline__ void wmma_ns(f32x4 (&acc)[MT][NT], const bf16_t* A, int lda, const bf16_t* B, int ldb, int K, int lane) {
  const int r = lane & 15, kq = (lane >> 4) * 8;
  for (int k0 = 0; k0 < K; k0 += 32) {
    bf16x8 af[MT], bfr[NT];
#pragma unroll
    for (int mt = 0; mt < MT; ++mt) af[mt] = *(const bf16x8*)(A + (mt * 16 + r) * lda + k0 + kq);
#pragma unroll
    for (int nt = 0; nt < NT; ++nt) bfr[nt] = *(const bf16x8*)(B + (nt * 16 + r) * ldb + k0 + kq);
#pragma unroll
    for (int mt = 0; mt < MT; ++mt)
#pragma unroll
      for (int nt = 0; nt < NT; ++nt) acc[mt][nt] = __builtin_amdgcn_mfma_f32_16x16x32_bf16(af[mt], bfr[nt], acc[mt][nt], 0, 0, 0);
  }
}

__device__ __forceinline__ void gemm_kstep(f32x4 (&acc)[4][8], const char* A, const char* B) {
  bf16x8 af[4], bfr[8];
#pragma unroll
  for (int mt = 0; mt < 4; ++mt) af[mt] = *(const bf16x8*)(A + mt * 2048);
#pragma unroll
  for (int nt = 0; nt < 8; ++nt) bfr[nt] = *(const bf16x8*)(B + nt * 2048);
  __builtin_amdgcn_sched_barrier(0);
#pragma unroll
  for (int nt = 0; nt < 8; ++nt)
#pragma unroll
    for (int mt = 0; mt < 4; ++mt) acc[mt][nt] = __builtin_amdgcn_mfma_f32_16x16x32_bf16(bfr[nt], af[mt], acc[mt][nt], 0, 0, 0);
}

template <class Epi>
__device__ __forceinline__ void gemm_phase(const bf16_t* A, int lda, const bf16_t* Bt, int ldb, int nMt, int nNt, int K, const Epi& epi, char* smem, int wvs) {
  char* As = smem;
  char* Bs = smem + 65536;
  int tid_ = TIDX(wvs); asm volatile("" : "+v"(tid_)); const int tid = tid_, lane = tid & 63, wave = tid >> 6;
  const int wr = wave >> 1, wc = wave & 1;
  const int ntiles = nMt * nNt, nk = K >> 6;
  const int lrow = tid >> 3, lcc = (tid & 7) * 8;
  const int wofs = ((lrow >> 4) * 2 + (lcc >> 5)) * 1024 + ((((lrow & 15) * 64) + (lcc & 31) * 2) ^ ((lrow & 8) << 2));
  const int rofs = (((lane & 15) * 64) + (lane >> 4) * 16) ^ ((lane & 8) << 2);
  const unsigned toffA = (unsigned)(lrow * lda + lcc), toffB = (unsigned)(lrow * ldb + lcc);
  for (int tile = blockIdx.x; tile < ntiles; tile += gridDim.x) {
    const int pn = tile / nMt, pm = tile - pn * nMt;
    const bf16_t* Ab = A + (size_t)(pm * 256) * lda;
    const bf16_t* Bb = Bt + (size_t)(pn * 256) * ldb;
    f32x4 acc[4][8];
#pragma unroll
    for (int i = 0; i < 4; ++i)
#pragma unroll
      for (int j = 0; j < 8; ++j) acc[i][j] = (f32x4){0.f, 0.f, 0.f, 0.f};
    u32x4 rg[4];
#pragma unroll
    for (int i = 0; i < 4; ++i) rg[i] = *(const u32x4*)(Ab + (size_t)(i * 64) * lda + toffA);
#pragma unroll
    for (int i = 0; i < 4; ++i) *(u32x4*)(As + wofs + i * 8192) = rg[i];
#pragma unroll
    for (int i = 0; i < 4; ++i) rg[i] = *(const u32x4*)(Bb + (size_t)(i * 64) * ldb + toffB);
#pragma unroll
    for (int i = 0; i < 4; ++i) *(u32x4*)(Bs + wofs + i * 8192) = rg[i];
    __syncthreads();
#pragma unroll 1
    for (int kt = 0; kt < nk; ++kt) {
      const int cur = kt & 1;
      const int kn = (kt + 1 < nk ? kt + 1 : kt) * 64;
      char* Ad = As + (cur ^ 1) * 32768; char* Bd = Bs + (cur ^ 1) * 32768;
#pragma unroll
      for (int i = 0; i < 4; ++i) rg[i] = *(const u32x4*)(Ab + ((size_t)(i * 64) * lda + kn) + toffA);
      __builtin_amdgcn_sched_barrier(0);
      gemm_kstep(acc, As + cur * 32768 + wr * 8192 + rofs, Bs + cur * 32768 + wc * 16384 + rofs);
      __builtin_amdgcn_sched_barrier(0);
#pragma unroll
      for (int i = 0; i < 4; ++i) *(u32x4*)(Ad + wofs + i * 8192) = rg[i];
#pragma unroll
      for (int i = 0; i < 4; ++i) rg[i] = *(const u32x4*)(Bb + ((size_t)(i * 64) * ldb + kn) + toffB);
      __builtin_amdgcn_sched_barrier(0);
      gemm_kstep(acc, As + cur * 32768 + wr * 8192 + 1024 + rofs, Bs + cur * 32768 + wc * 16384 + 1024 + rofs);
      __builtin_amdgcn_sched_barrier(0);
#pragma unroll
      for (int i = 0; i < 4; ++i) *(u32x4*)(Bd + wofs + i * 8192) = rg[i];
      __syncthreads();
    }
    int er_ = pm * 256 + wr * 64, ec_ = pn * 256 + wc * 128, el_ = lane;
    asm volatile("" : "+v"(er_), "+v"(ec_), "+v"(el_));
    epi(acc, er_, ec_, el_);
  }
}

struct EpiInEven {
  bf16_t* proj; const float* rope; const float* lb;
  template <int MT> __device__ __forceinline__ void operator()(f32x4 (&acc)[MT][8], int rbase, int cbase, int lane) const {
    const int sec = cbase >> 9, head = (cbase >> 7) & 3, r = lane & 15, cq = (lane >> 4) * 4;
#pragma unroll
    for (int mt = 0; mt < MT; ++mt) {
      __builtin_amdgcn_sched_barrier(0);
      const int row = rbase + mt * 16 + r;
      bf16_t* dst = proj + (size_t)row * 4096 + cbase + cq;
      if (sec < 2) {
        const int pidx = row < 16384 ? (row & 2047) : 2048 + ((row - 16384) & 7);
        const float* ct = rope + pidx * 128 + cq;
        const float sc = sec == 1 ? 0.08838834764831845f : 1.f;
#pragma unroll
        for (int nt = 0; nt < 4; ++nt) {
          const float4 c4 = *(const float4*)(ct + nt * 16), s4 = *(const float4*)(ct + 64 + nt * 16);
          const f32x4 x1 = acc[mt][nt], x2 = acc[mt][nt + 4];
          store4bf(dst + nt * 16, (x1[0] * c4.x - x2[0] * s4.x) * sc, (x1[1] * c4.y - x2[1] * s4.y) * sc, (x1[2] * c4.z - x2[2] * s4.z) * sc, (x1[3] * c4.w - x2[3] * s4.w) * sc);
          store4bf(dst + 64 + nt * 16, (x1[0] * s4.x + x2[0] * c4.x) * sc, (x1[1] * s4.y + x2[1] * c4.y) * sc, (x1[2] * s4.z + x2[2] * c4.z) * sc, (x1[3] * s4.w + x2[3] * c4.w) * sc);
        }
      } else if (sec == 5) {
#pragma unroll
        for (int nt = 0; nt < 8; ++nt) {
          const float4 l4 = *(const float4*)(lb + head * 128 + nt * 16 + cq);
          const f32x4 x = acc[mt][nt];
          store4bf(dst + nt * 16, __logf(l4.x + (1.f - l4.x) * sigm(x[0])), __logf(l4.y + (1.f - l4.y) * sigm(x[1])), __logf(l4.z + (1.f - l4.z) * sigm(x[2])), __logf(l4.w + (1.f - l4.w) * sigm(x[3])));
        }
      } else {
#pragma unroll
        for (int nt = 0; nt < 8; ++nt) { const f32x4 x = acc[mt][nt]; store4bf(dst + nt * 16, x[0], x[1], x[2], x[3]); }
      }
    }
  }
};
struct EpiOut {
  bf16_t* t0; float* rowss;
  template <int MT> __device__ __forceinline__ void operator()(f32x4 (&acc)[MT][8], int rbase, int cbase, int lane) const {
    const int r = lane & 15, cq = (lane >> 4) * 4;
#pragma unroll
    for (int mt = 0; mt < MT; ++mt) {
      __builtin_amdgcn_sched_barrier(0);
      const int row = rbase + mt * 16 + r;
      bf16_t* dst = t0 + (size_t)row * 1024 + cbase + cq;
      float ss = 0.f;
#pragma unroll
      for (int nt = 0; nt < 8; ++nt) { const f32x4 x = acc[mt][nt]; ss += x[0] * x[0] + x[1] * x[1] + x[2] * x[2] + x[3] * x[3]; store4bf(dst + nt * 16, x[0], x[1], x[2], x[3]); }
      ss += shx(ss, 16); ss += shx(ss, 32);
      if (lane < 16) atomicAdd(rowss + row, ss * (1.f / REPG));
    }
  }
};
struct EpiUp {
  bf16_t* act;
  template <int MT> __device__ __forceinline__ void operator()(f32x4 (&acc)[MT][8], int rbase, int cbase, int lane) const {
    const int r = lane & 15, cq = (lane >> 4) * 4;
#pragma unroll
    for (int mt = 0; mt < MT; ++mt) {
      __builtin_amdgcn_sched_barrier(0);
      bf16_t* dst = act + (size_t)(rbase + mt * 16 + r) * 4096 + cbase + cq;
#pragma unroll
      for (int nt = 0; nt < 8; ++nt) { f32x4 x = acc[mt][nt];
#pragma unroll
        for (int j = 0; j < 4; ++j) { float v = fmaxf(x[j], 0.f); x[j] = v * v; }
        store4bf(dst + nt * 16, x[0], x[1], x[2], x[3]); }
    }
  }
};
struct EpiInOdd {
  bf16_t* proj; float* dtbuf;
  template <int MT> __device__ __forceinline__ void operator()(f32x4 (&acc)[MT][8], int rbase, int cbase, int lane) const {
    const int r = lane & 15, cq = (lane >> 4) * 4;
#pragma unroll
    for (int mt = 0; mt < MT; ++mt) {
      __builtin_amdgcn_sched_barrier(0);
      const int row = rbase + mt * 16 + r;
      bf16_t* dst = proj + (size_t)row * 3200 + cbase + cq;
#pragma unroll
      for (int nt = 0; nt < 8; ++nt) { const f32x4 x = acc[mt][nt]; if (cbase + nt * 16 < 3200) store4bf(dst + nt * 16, x[0], x[1], x[2], x[3]); }
      if (cbase == 2560) { const f32x4 x = acc[mt][0]; *(float4*)(dtbuf + (size_t)row * 16 + cq) = make_float4(x[0], x[1], x[2], x[3]); }
    }
  }
};
struct EpiGlu {
  const bf16_t* gbuf; const float* bglu; bf16_t* mix;
  template <int MT> __device__ __forceinline__ void operator()(f32x4 (&acc)[MT][8], int rbase, int cbase, int lane) const {
    const int r = lane & 15, cq = (lane >> 4) * 4;
#pragma unroll
    for (int mt = 0; mt < MT; ++mt) {
      __builtin_amdgcn_sched_barrier(0);
      const int row = rbase + mt * 16 + r;
#pragma unroll
      for (int nt = 0; nt < 8; ++nt) {
        const int col = cbase + nt * 16 + cq;
        const f32x4 x = acc[mt][nt];
        const uint2 g2 = *(const uint2*)(gbuf + (size_t)row * 512 + col);
        const float4 b4 = *(const float4*)(bglu + col);
        store4bf(mix + (size_t)row * 1536 + 1024 + col, lo2f(g2.x) * sigm(x[0] + b4.x), hi2f(g2.x) * sigm(x[1] + b4.y), lo2f(g2.y) * sigm(x[2] + b4.z), hi2f(g2.y) * sigm(x[3] + b4.w));
      }
    }
  }
};

template <class Epi>
__device__ __forceinline__ void gemm_tail(const bf16_t* A, int lda, const bf16_t* Bt, int ldb, int nNt128, int K, const Epi& epi, char* smem, int wvs, int nBig) {
  bf16_t* As = (bf16_t*)smem;
  bf16_t* Bs = As + 2 * 128 * 80;
  int tid_ = TIDX(wvs); asm volatile("" : "+v"(tid_)); const int tid = tid_, lane = tid & 63, wave = tid >> 6;
  const int nk = K >> 6, G = gridDim.x;
  const int lrow = tid >> 3, lcc = (tid & 7) * 8;
  const unsigned toffA = (unsigned)(lrow * lda + lcc), toffB = (unsigned)(lrow * ldb + lcc);
  const int rr = nBig % G, nLight = G - rr;
  const int nSmall = 8 * nNt128;
  if ((int)blockIdx.x >= rr) {
    for (int j = (int)blockIdx.x - rr; j < nSmall; j += nLight) {
      const int pm = j / nNt128, pn = j - pm * nNt128;
      const bf16_t* Ab = A + (size_t)(16384 + pm * 128) * lda;
      const bf16_t* Bb = Bt + (size_t)(pn * 128) * ldb;
      f32x4 acc[1][8];
#pragma unroll
      for (int q = 0; q < 8; ++q) acc[0][q] = (f32x4){0.f, 0.f, 0.f, 0.f};
      u32x4 ra[2], rb[2];
#pragma unroll
      for (int i = 0; i < 2; ++i) { ra[i] = *(const u32x4*)(Ab + (size_t)(i * 64) * lda + toffA); rb[i] = *(const u32x4*)(Bb + (size_t)(i * 64) * ldb + toffB); }
#pragma unroll
      for (int i = 0; i < 2; ++i) { *(u32x4*)(As + (lrow + i * 64) * 80 + lcc) = ra[i]; *(u32x4*)(Bs + (lrow + i * 64) * 80 + lcc) = rb[i]; }
      __syncthreads();
#pragma unroll 1
      for (int kt = 0; kt < nk; ++kt) {
        const int cur = kt & 1;
        const int kn = (kt + 1 < nk ? kt + 1 : kt) * 64;
#pragma unroll
        for (int i = 0; i < 2; ++i) { ra[i] = *(const u32x4*)(Ab + ((size_t)(i * 64) * lda + kn) + toffA); rb[i] = *(const u32x4*)(Bb + ((size_t)(i * 64) * ldb + kn) + toffB); }
        __builtin_amdgcn_sched_barrier(0);
        wmma_sw<1, 8>(acc, As + cur * 128 * 80 + wave * 16 * 80, 80, Bs + cur * 128 * 80, 80, 64, lane);
        __builtin_amdgcn_sched_barrier(0);
        bf16_t* Ad = As + (cur ^ 1) * 128 * 80; bf16_t* Bd = Bs + (cur ^ 1) * 128 * 80;
#pragma unroll
        for (int i = 0; i < 2; ++i) { *(u32x4*)(Ad + (lrow + i * 64) * 80 + lcc) = ra[i]; *(u32x4*)(Bd + (lrow + i * 64) * 80 + lcc) = rb[i]; }
        __syncthreads();
      }
      int er_ = 16384 + pm * 128 + wave * 16, ec_ = pn * 128, el_ = lane;
      asm volatile("" : "+v"(er_), "+v"(ec_), "+v"(el_));
      epi(acc, er_, ec_, el_);
    }
  }
}

__device__ __forceinline__ void rowpass_phase(const bf16_t* t0, const float* rowss, const float* wpost, const float* hin_a, const float* hin_b, float* hout, const float* wnext, bf16_t* hn, int wvs) {
  int tq_ = TIDX(wvs); asm volatile("" : "+v"(tq_)); const int lane = tq_ & 63, gw = blockIdx.x * 8 + (tq_ >> 6), nw = gridDim.x * 8;
  for (int row = gw; row < ROWS; row += nw) {
    const float* hin = row < 16384 ? hin_a + (size_t)row * 1024 : hin_b + (size_t)(row - 16384) * 1024;
    float r0 = 0.f;
    if (t0) r0 = rsqrtf(rowss[row] * (1.f / 1024.f) + EPSV);
    float4 v[4]; float ss = 0.f;
#pragma unroll
    for (int i = 0; i < 4; ++i) {
      const int col = (i * 64 + lane) * 4;
      float4 hv = *(const float4*)(hin + col);
      if (t0) {
        const uint2 t2 = *(const uint2*)(t0 + (size_t)row * 1024 + col);
        const float4 w4 = *(const float4*)(wpost + col);
        hv.x += lo2f(t2.x) * r0 * w4.x; hv.y += hi2f(t2.x) * r0 * w4.y; hv.z += lo2f(t2.y) * r0 * w4.z; hv.w += hi2f(t2.y) * r0 * w4.w;
      }
      v[i] = hv; ss += hv.x * hv.x + hv.y * hv.y + hv.z * hv.z + hv.w * hv.w;
      if (hout) *(float4*)(hout + (size_t)row * 1024 + col) = hv;
    }
    if (hn) {
#pragma unroll
      for (int o = 32; o >= 1; o >>= 1) ss += shx(ss, o);
      const float r1 = rsqrtf(ss * (1.f / 1024.f) + EPSV);
#pragma unroll
      for (int i = 0; i < 4; ++i) {
        const int col = (i * 64 + lane) * 4;
        const float4 w4 = *(const float4*)(wnext + col);
        store4bf(hn + (size_t)row * 1024 + col, v[i].x * r1 * w4.x, v[i].y * r1 * w4.y, v[i].z * r1 * w4.z, v[i].w * r1 * w4.w);
      }
    }
  }
}

__device__ __forceinline__ void wconv(const float* __restrict__ W, int K, int N, int Npad, bf16_t* __restrict__ Wt, char* smem, int wvs) {
  float* tile = (float*)smem;
  int tq_ = TIDX(wvs) & 255; asm volatile("" : "+v"(tq_)); const int tid = tq_;
  const int nNt = Npad >> 6, nunits = (K >> 6) * nNt;
  for (int u = blockIdx.x * 2 + (wvs >> 2); u < nunits; u += gridDim.x * 2) {
    const int k0 = (u / nNt) * 64, n0 = (u % nNt) * 64;
#pragma unroll
    for (int ps = 0; ps < 4; ++ps) {
      const int i = ps * 16 + (tid >> 4), j = (tid & 15) * 4, n = n0 + j;
      float4 v = make_float4(0.f, 0.f, 0.f, 0.f);
      if (n < N) v = *(const float4*)(W + (size_t)(k0 + i) * N + n);
      tile[i * 65 + j] = v.x; tile[i * 65 + j + 1] = v.y; tile[i * 65 + j + 2] = v.z; tile[i * 65 + j + 3] = v.w;
    }
    __syncthreads();
    {
      const int n = tid >> 2, kq = (tid & 3) * 16;
      uint4 o0, o1;
      o0.x = pack2(tile[(kq + 0) * 65 + n], tile[(kq + 1) * 65 + n]); o0.y = pack2(tile[(kq + 2) * 65 + n], tile[(kq + 3) * 65 + n]);
      o0.z = pack2(tile[(kq + 4) * 65 + n], tile[(kq + 5) * 65 + n]); o0.w = pack2(tile[(kq + 6) * 65 + n], tile[(kq + 7) * 65 + n]);
      o1.x = pack2(tile[(kq + 8) * 65 + n], tile[(kq + 9) * 65 + n]); o1.y = pack2(tile[(kq + 10) * 65 + n], tile[(kq + 11) * 65 + n]);
      o1.z = pack2(tile[(kq + 12) * 65 + n], tile[(kq + 13) * 65 + n]); o1.w = pack2(tile[(kq + 14) * 65 + n], tile[(kq + 15) * 65 + n]);
      bf16_t* d = Wt + (size_t)(n0 + n) * K + k0 + kq;
      *(uint4*)d = o0; *(uint4*)(d + 8) = o1;
    }
    __syncthreads();
  }
}

__device__ __forceinline__ void prep_tables(const Params& p, int wvs) {
  int tq_ = TIDX(wvs); asm volatile("" : "+v"(tq_)); const int gt = blockIdx.x * NTHR + tq_, nt = gridDim.x * NTHR;
  float* rope = (float*)(p.ws + OFF_ROPE);
  for (int i = gt; i < 2056 * 64; i += nt) {
    const int pi = i >> 6, f = i & 63;
    const double pos = pi < 2048 ? (double)pi : (double)(16384 + pi - 2048);
    const double invf = exp(-(double)f * (9.210340371976184 / 64.0));
    double ang = pos * invf;
    ang -= 6.283185307179586 * floor(ang * 0.15915494309189535);
    const float a = (float)ang;
    rope[pi * 128 + f] = cosf(a); rope[pi * 128 + 64 + f] = sinf(a);
  }
  float* z = (float*)(p.ws + OFF_ROWSS);
  for (int i = gt; i < ROWS * 6; i += nt) z[i] = 0.f;
  float* lb = (float*)(p.ws + OFF_LB);
  for (int i = gt; i < 512; i += nt) lb[i] = 1.f / (1.f + expf(p.hgrn_lb[512 + i] - p.hgrn_lb[i]));
  float* tab = (float*)(p.ws + OFF_S5TAB);
  for (int i = gt; i < 2048; i += nt) {
    const int g = i >> 6;
    const float lr = p.s5_lam_re[i], li = p.s5_lam_im[i], dt = expf(p.s5_log_step[g]);
    const float m1 = expf(lr * dt), br = m1 * cosf(li * dt), bi = m1 * sinf(li * dt);
    tab[i] = br; tab[2048 + i] = bi;
    const float m64 = expf(lr * dt * 64.f); tab[69632 + i] = m64 * cosf(li * dt * 64.f); tab[71680 + i] = m64 * sinf(li * dt * 64.f);
    const float m8 = expf(lr * dt * 8.f); tab[73728 + i] = m8 * cosf(li * dt * 8.f); tab[75776 + i] = m8 * sinf(li * dt * 8.f);
    const float x = br - 1.f, y = bi, den = 1.f / (lr * lr + li * li);
    const float qr = (x * lr + y * li) * den, qi = (y * lr - x * li) * den;
    for (int c = 0; c < 16; ++c) {
      const float b_r = p.s5_b_re[i * 16 + c], b_i = p.s5_b_im[i * 16 + c];
      tab[4096 + i * 16 + c] = qr * b_r - qi * b_i;
      tab[4096 + 32768 + i * 16 + c] = qr * b_i + qi * b_r;
    }
  }
}

__device__ __forceinline__ void chunk_geom(int c, int& row0, int& L) { if (c < 256) { row0 = c * 64; L = 64; } else { row0 = 16384 + (c - 256) * 8; L = 8; } }

template <int MODE>
__device__ __forceinline__ void st_load(uint4 (&kr)[4], uint4 (&vr)[(MODE == 2) ? 2 : 1], float& dtr, const bf16_t* src, const float* dtbuf, int row0, int L, int ld, int kcol, int vcol, int h, int tid) {
  constexpr int PW = (MODE == 2) ? 64 : 32, NVC = PW / 32, VCR = PW / 8;
  const uint4 z4 = make_uint4(0, 0, 0, 0);
#pragma unroll
  for (int i = 0; i < 4; ++i) { const int id = tid + i * 256, s = id >> 4, c8 = id & 15; uint4 t_ = z4; if (s < L) t_ = *(const uint4*)(src + (size_t)(row0 + s) * ld + kcol + c8 * 8); kr[i] = t_; }
#pragma unroll
  for (int i = 0; i < NVC; ++i) { const int id = tid + i * 256, s = id / VCR, c8 = id % VCR; uint4 t_ = z4; if (s < L) t_ = *(const uint4*)(src + (size_t)(row0 + s) * ld + vcol + c8 * 8); vr[i] = t_; }
  if (MODE == 2 && tid < 64) dtr = tid < L ? dtbuf[(size_t)(row0 + tid) * 16 + h] : 0.f;
}

template <int MODE>
__device__ __forceinline__ void state_unit(const Params& p, int sq, int h, int ps, char* smem, int wvs) {
  constexpr int PW = (MODE == 2) ? 64 : 32, NT = PW / 16, PF = (MODE == 2) ? 64 : 128, HH = (MODE == 2) ? 16 : 4, NVC = PW / 32, VCR = PW / 8;
  bf16_t* KT = (bf16_t*)smem;
  bf16_t* VT = KT + 128 * 80;
  bf16_t* KR = VT + 64 * 80;
  float* tot = (float*)(KR + 64 * 136);
  float* dec = tot + 256;
  float* av = dec + 64;
  float* dtv = av + 64;
  int tid_ = TIDX(wvs) & 255; asm volatile("" : "+v"(tid_)); const int tid = tid_, lane = tid & 63, wave = tid >> 6;
  const bool prompt = sq < 8;
  const int nch = prompt ? 32 : 1, L = prompt ? 64 : 8;
  const int ld = (MODE == 2) ? 1536 : 4096;
  const bf16_t* src = (MODE == 2) ? (const bf16_t*)(p.ws + OFF_H) : (const bf16_t*)(p.ws + OFF_A);
  const int kcol = MODE == 0 ? 512 + h * 128 : MODE == 1 ? 2560 + h * 128 : 1024 + (h >> 3) * 128;
  const int vcol = MODE == 0 ? 1024 + h * 128 + ps * 32 : MODE == 1 ? 3072 + h * 128 + ps * 32 : h * 64;
  const float* sin_ = MODE == 0 ? p.state_ret : MODE == 1 ? p.state_hgrn : p.state_ssm;
  float* sout = p.out + (MODE == 0 ? O_RET : MODE == 1 ? O_HG : O_SSM) + (size_t)(sq * HH + h) * 128 * PF;
  bf16_t* stb = (bf16_t*)(p.ws + OFF_ST) + (MODE == 1 ? (size_t)256 * 4 * 128 * 128 : 0);
  const float* dtbuf = (const float*)(p.ws + OFF_DTBUF);
  const float l2g = MODE == 0 ? log2f(1.f - exp2f(-5.f - (float)h)) : 0.f;
  float Ah = 0.f, dtb = 0.f;
  if (MODE == 2) { Ah = -expf(p.a_log[h]); dtb = p.dt_bias[h]; }

  f32x4 acc[2][NT];
  const int nb = wave * 32 + (lane >> 4) * 4, pc = ps * PW + (lane & 15);
#pragma unroll
  for (int mt = 0; mt < 2; ++mt)
#pragma unroll
    for (int nt = 0; nt < NT; ++nt)
#pragma unroll
      for (int j = 0; j < 4; ++j)
        acc[mt][nt][j] = prompt ? 0.f : sin_[((size_t)((sq - 8) * HH + h) * 128 + nb + mt * 16 + j) * PF + pc + nt * 16];

  uint4 kr[4], vr[NVC]; float dtr = 0.f;
  const uint4 z4 = make_uint4(0, 0, 0, 0);
  st_load<MODE>(kr, vr, dtr, src, dtbuf, prompt ? sq * 2048 : 16384 + (sq - 8) * 8, L, ld, kcol, vcol, h, tid);
  for (int n = 0; n < nch; ++n) {
    if (prompt) {
      bf16_t* d = stb + ((size_t)((sq * 32 + n) * HH + h) * PF) * 128;
#pragma unroll
      for (int mt = 0; mt < 2; ++mt)
#pragma unroll
        for (int nt = 0; nt < NT; ++nt) store4bf(d + (size_t)(pc + nt * 16) * 128 + nb + mt * 16, acc[mt][nt][0], acc[mt][nt][1], acc[mt][nt][2], acc[mt][nt][3]);
    }
#pragma unroll
    for (int i = 0; i < 4; ++i) { const int id = tid + i * 256, s = id >> 4, c8 = id & 15; *(uint4*)(KR + s * 136 + c8 * 8) = kr[i]; }
#pragma unroll
    for (int i = 0; i < NVC; ++i) {
      const int id = tid + i * 256, s = id / VCR, c8 = id % VCR; const uint4 v = vr[i];
      bf16_t* d = VT + (c8 * 8) * 80 + s;
      d[0] = (bf16_t)(v.x & 0xffff); d[80] = (bf16_t)(v.x >> 16); d[160] = (bf16_t)(v.y & 0xffff); d[240] = (bf16_t)(v.y >> 16);
      d[320] = (bf16_t)(v.z & 0xffff); d[400] = (bf16_t)(v.z >> 16); d[480] = (bf16_t)(v.w & 0xffff); d[560] = (bf16_t)(v.w >> 16);
    }
    if (MODE == 2 && tid < 64) {
      float dt = 0.f;
      if (tid < L) { const float x = dtr + dtb; dt = x > 20.f ? x : log1pf(__expf(x)); }
      dtv[tid] = dt; av[tid] = dt * Ah;
    }
    if (n + 1 < nch) st_load<MODE>(kr, vr, dtr, src, dtbuf, sq * 2048 + (n + 1) * 64, L, ld, kcol, vcol, h, tid);
    __syncthreads();
    const int kn = tid & 127, half = tid >> 7;
    if (MODE == 1) {
      float s_ = 0.f;
      for (int s = half * 32; s < half * 32 + 32; ++s) s_ += bf2f(KR[s * 136 + kn]);
      tot[half * 128 + kn] = s_;
    }
    if (MODE == 2 && tid < 64) {
      float suf = 0.f;
      for (int r = tid + 1; r < 64; ++r) suf += av[r];
      dec[tid] = __expf(suf) * dtv[tid];
      if (tid == 0) tot[0] = suf + av[0];
    }
    if (MODE != 0) __syncthreads();
    {
      float suf = 0.f;
      if (MODE == 1) suf = half == 0 ? tot[128 + kn] : 0.f;
      for (int g = 3; g >= 0; --g) {
        const int s0 = half * 32 + g * 8;
        float v[8];
#pragma unroll
        for (int e = 7; e >= 0; --e) {
          const int s = s0 + e;
          const float raw = bf2f(KR[s * 136 + kn]);
          if (MODE == 0) v[e] = raw * exp2f((float)(L - 1 - s) * l2g);
          else if (MODE == 1) { v[e] = (1.f - __expf(raw)) * __expf(suf); suf += raw; }
          else v[e] = raw * dec[s];
        }
        uint4 o; o.x = pack2(v[0], v[1]); o.y = pack2(v[2], v[3]); o.z = pack2(v[4], v[5]); o.w = pack2(v[6], v[7]);
        *(uint4*)(KT + kn * 80 + s0) = o;
      }
    }
    __syncthreads();
#pragma unroll
    for (int mt = 0; mt < 2; ++mt) {
      float dk[4];
      if (MODE == 0) { const float d = exp2f((float)L * l2g); dk[0] = dk[1] = dk[2] = dk[3] = d; }
      else if (MODE == 2) { const float d = __expf(tot[0]); dk[0] = dk[1] = dk[2] = dk[3] = d; }
      else {
#pragma unroll
        for (int j = 0; j < 4; ++j) { const int nn = nb + mt * 16 + j; dk[j] = __expf(tot[nn] + tot[128 + nn]); }
      }
#pragma unroll
      for (int nt = 0; nt < NT; ++nt)
#pragma unroll
        for (int j = 0; j < 4; ++j) acc[mt][nt][j] *= dk[j];
    }
    wmma_ns<2, NT>(acc, KT + wave * 32 * 80, 80, VT, 80, 64, lane);
    __syncthreads();
  }
#pragma unroll
  for (int mt = 0; mt < 2; ++mt)
#pragma unroll
    for (int nt = 0; nt < NT; ++nt)
#pragma unroll
      for (int j = 0; j < 4; ++j) sout[(size_t)(nb + mt * 16 + j) * PF + pc + nt * 16] = acc[mt][nt][j];
}

template <int MODE>
__device__ __forceinline__ void out_unit(const Params& p, int c, int h, char* smem, int wvs) {
  constexpr int PF = (MODE == 2) ? 64 : 128, NTP = PF / 16, HH = (MODE == 2) ? 16 : 4, NVC = PF / 32, VCR = PF / 8;
  bf16_t* Q = (bf16_t*)smem;
  bf16_t* Kb = Q + 64 * 136;
  bf16_t* STb = Kb + 128 * 80;
  float* cumv = (float*)(STb + 128 * 136);
  float* dtv = cumv + 64;
  float* av = dtv + 64;
  float* tot = av + 64;
  int tid_ = TIDX(wvs) & 255; asm volatile("" : "+v"(tid_)); const int tid = tid_, lane = tid & 63, wave = tid >> 6;
  int row0, L; chunk_geom(c, row0, L);
  const int ld = (MODE == 2) ? 1536 : 4096;
  const bf16_t* src = (MODE == 2) ? (const bf16_t*)(p.ws + OFF_H) : (const bf16_t*)(p.ws + OFF_A);
  const int qcol = MODE == 0 ? h * 128 : MODE == 1 ? 2048 + h * 128 : 1280 + (h >> 3) * 128;
  const int kcol = MODE == 0 ? 512 + h * 128 : MODE == 1 ? 2560 + h * 128 : 1024 + (h >> 3) * 128;
  const int vcol = MODE == 0 ? 1024 + h * 128 : MODE == 1 ? 3072 + h * 128 : h * 64;
  const float l2g = MODE == 0 ? log2f(1.f - exp2f(-5.f - (float)h)) : 0.f;
  const uint4 z4 = make_uint4(0, 0, 0, 0);
#pragma unroll
  for (int i = 0; i < 4; ++i) {
    const int id = tid + i * 256, s = id >> 4, c8 = id & 15;
    uint4 q4 = z4, k4 = z4;
    if (s < L) { q4 = *(const uint4*)(src + (size_t)(row0 + s) * ld + qcol + c8 * 8); k4 = *(const uint4*)(src + (size_t)(row0 + s) * ld + kcol + c8 * 8); }
    *(uint4*)(Q + s * 136 + c8 * 8) = q4; *(uint4*)(Kb + s * 136 + c8 * 8) = k4;
  }
  uint4 vr[NVC];
#pragma unroll
  for (int i = 0; i < NVC; ++i) { const int id = tid + i * 256, s = id / VCR, c8 = id % VCR; uint4 t_ = z4; if (s < L) t_ = *(const uint4*)(src + (size_t)(row0 + s) * ld + vcol + c8 * 8); vr[i] = t_; }
  if (c < 256) {
    const bf16_t* stg = (const bf16_t*)(p.ws + OFF_ST) + (MODE == 1 ? (size_t)256 * 4 * 128 * 128 : 0) + ((size_t)(c * HH + h) * PF) * 128;
#pragma unroll
    for (int i = 0; i < PF / 16; ++i) { const int id = tid + i * 256, pr = id >> 4, c8 = id & 15; *(uint4*)(STb + pr * 136 + c8 * 8) = *(const uint4*)(stg + (size_t)pr * 128 + c8 * 8); }
  } else {
    const float* sg = (MODE == 0 ? p.state_ret : MODE == 1 ? p.state_hgrn : p.state_ssm) + (size_t)((c - 256) * HH + h) * 128 * PF;
    for (int id = tid; id < 128 * (PF / 4); id += 256) {
      const int n = id / (PF / 4), p4 = (id % (PF / 4)) * 4;
      const float4 v = *(const float4*)(sg + (size_t)n * PF + p4);
      STb[(p4 + 0) * 136 + n] = f2bf(v.x); STb[(p4 + 1) * 136 + n] = f2bf(v.y); STb[(p4 + 2) * 136 + n] = f2bf(v.z); STb[(p4 + 3) * 136 + n] = f2bf(v.w);
    }
  }
  if (MODE == 2 && tid < 64) {
    float dt = 0.f;
    if (tid < L) { const float x = ((const float*)(p.ws + OFF_DTBUF))[(size_t)(row0 + tid) * 16 + h] + p.dt_bias[h]; dt = x > 20.f ? x : log1pf(__expf(x)); }
    dtv[tid] = dt; av[tid] = -expf(p.a_log[h]) * dt;
  }
  __syncthreads();
  if (MODE == 1) {
    const int kn = tid & 127, half = tid >> 7;
    float s_ = 0.f;
    for (int s = half * 32; s < half * 32 + 32; ++s) s_ += bf2f(Kb[s * 136 + kn]);
    tot[half * 128 + kn] = s_;
    __syncthreads();
    float cum = half == 1 ? tot[kn] : 0.f;
    for (int s = half * 32; s < half * 32 + 32; ++s) {
      const float lf = bf2f(Kb[s * 136 + kn]);
      cum += lf;
      Q[s * 136 + kn] = f2bf(bf2f(Q[s * 136 + kn]) * __expf(cum));
      Kb[s * 136 + kn] = f2bf((1.f - __expf(lf)) * __expf(-cum));
    }
    __syncthreads();
  }
  if (MODE == 2) {
    if (tid < 64) { float cs = 0.f; for (int r = 0; r <= tid; ++r) cs += av[r]; cumv[tid] = cs; }
    __syncthreads();
  }
  f32x4 ai[1][NTP], asc[1][4];
#pragma unroll
  for (int j = 0; j < NTP; ++j) ai[0][j] = (f32x4){0.f, 0.f, 0.f, 0.f};
#pragma unroll
  for (int j = 0; j < 4; ++j) asc[0][j] = (f32x4){0.f, 0.f, 0.f, 0.f};
  wmma_sw<1, NTP>(ai, Q + wave * 16 * 136, 136, STb, 136, 128, lane);
  wmma_sw<1, 4>(asc, Q + wave * 16 * 136, 136, Kb, 136, 128, lane);
  const int t = wave * 16 + (lane & 15), sq4 = (lane >> 4) * 4;
  float ct = 0.f;
  if (MODE == 2) ct = cumv[t];
#pragma unroll
  for (int nt = 0; nt < 4; ++nt)
#pragma unroll
    for (int j = 0; j < 4; ++j) {
      const int s = nt * 16 + sq4 + j;
      float v = asc[0][nt][j];
      if (s > t) v = 0.f;
      else if (MODE == 0) v *= exp2f((float)(t - s) * l2g);
      else if (MODE == 2) v *= __expf(ct - cumv[s]) * dtv[s];
      asc[0][nt][j] = v;
    }
  __syncthreads();
  bf16_t* Pb = STb; bf16_t* VT = Kb;
#pragma unroll
  for (int nt = 0; nt < 4; ++nt) store4bf(Pb + t * 80 + nt * 16 + sq4, asc[0][nt][0], asc[0][nt][1], asc[0][nt][2], asc[0][nt][3]);
#pragma unroll
  for (int i = 0; i < NVC; ++i) {
    const int id = tid + i * 256, s = id / VCR, c8 = id % VCR; const uint4 v = vr[i];
    bf16_t* d = VT + (c8 * 8) * 80 + s;
    d[0] = (bf16_t)(v.x & 0xffff); d[80] = (bf16_t)(v.x >> 16); d[160] = (bf16_t)(v.y & 0xffff); d[240] = (bf16_t)(v.y >> 16);
    d[320] = (bf16_t)(v.z & 0xffff); d[400] = (bf16_t)(v.z >> 16); d[480] = (bf16_t)(v.w & 0xffff); d[560] = (bf16_t)(v.w >> 16);
  }
  __syncthreads();
  f32x4 ao[1][NTP];
#pragma unroll
  for (int j = 0; j < NTP; ++j) ao[0][j] = (f32x4){0.f, 0.f, 0.f, 0.f};
  wmma_sw<1, NTP>(ao, Pb + wave * 16 * 80, 80, VT, 80, 64, lane);
  float fi = 1.f;
  if (MODE == 0) fi = exp2f((float)(t + 1) * l2g);
  if (MODE == 2) fi = __expf(ct);
  const int row = row0 + t;
  const bool valid = t < L;
  if (MODE == 0 || MODE == 1) {
    float s1 = 0.f, s2 = 0.f;
#pragma unroll
    for (int nt = 0; nt < NTP; ++nt)
#pragma unroll
      for (int j = 0; j < 4; ++j) { const float o = ao[0][nt][j] + fi * ai[0][nt][j]; ao[0][nt][j] = o; s1 += o; s2 += o * o; }
    s1 += shx(s1, 16); s1 += shx(s1, 32); s2 += shx(s2, 16); s2 += shx(s2, 32);
    float mu = 0.f, rs;
    if (MODE == 0) { mu = s1 * (1.f / 128.f); const float var = fmaxf(s2 * (1.f / 128.f) - mu * mu, 0.f); rs = rsqrtf(var + EPSV); }
    else rs = rsqrtf(s2 * (1.f / 128.f) + EPSV);
    if (valid) {
      const float* nw = (MODE == 0 ? p.ret_norm_w : p.hgrn_norm_w) + h * 128;
      const int gcol = (MODE == 0 ? 1536 : 3584) + h * 128;
      bf16_t* mix = (bf16_t*)(p.ws + OFF_H) + (size_t)row * 1024 + (MODE == 0 ? 0 : 512) + h * 128;
#pragma unroll
      for (int nt = 0; nt < NTP; ++nt) {
        const int pp = nt * 16 + sq4;
        const float4 w4 = *(const float4*)(nw + pp);
        const uint2 g2 = *(const uint2*)(src + (size_t)row * ld + gcol + pp);
        store4bf(mix + pp, (ao[0][nt][0] - mu) * rs * w4.x * siluf(lo2f(g2.x)), (ao[0][nt][1] - mu) * rs * w4.y * siluf(hi2f(g2.x)),
                 (ao[0][nt][2] - mu) * rs * w4.z * siluf(lo2f(g2.y)), (ao[0][nt][3] - mu) * rs * w4.w * siluf(hi2f(g2.y)));
      }
    }
  } else {
    const float Dh = p.d_ssm[h];
    bf16_t* zy = (bf16_t*)(p.ws + OFF_A) + (size_t)row * 3200 + h * 64;
    float s2 = 0.f;
    if (valid) {
#pragma unroll
      for (int nt = 0; nt < NTP; ++nt) {
        const int pp = nt * 16 + sq4;
        const uint2 x2 = *(const uint2*)(src + (size_t)row * ld + vcol + pp);
        const uint2 z2 = *(const uint2*)(zy + pp);
        const float y0 = (ao[0][nt][0] + fi * ai[0][nt][0] + Dh * lo2f(x2.x)) * siluf(lo2f(z2.x));
        const float y1 = (ao[0][nt][1] + fi * ai[0][nt][1] + Dh * hi2f(x2.x)) * siluf(hi2f(z2.x));
        const float y2 = (ao[0][nt][2] + fi * ai[0][nt][2] + Dh * lo2f(x2.y)) * siluf(lo2f(z2.y));
        const float y3 = (ao[0][nt][3] + fi * ai[0][nt][3] + Dh * hi2f(x2.y)) * siluf(hi2f(z2.y));
        s2 += y0 * y0 + y1 * y1 + y2 * y2 + y3 * y3;
        store4bf(zy + pp, y0, y1, y2, y3);
      }
    }
    s2 += shx(s2, 16); s2 += shx(s2, 32);
    if (valid && lane < 16) atomicAdd((float*)(p.ws + OFF_SSDST) + (size_t)row * 2 + (h >> 3), s2);
  }
  __syncthreads();
}

template <int OUT>
__device__ __forceinline__ void s5_unit(const Params& p, int c, int gq, char* smem, int wvs) {
  float* Uf = (float*)smem;
  bf16_t* HSall = (bf16_t*)(smem + 16384);
  bf16_t* CMall = (bf16_t*)(smem + 16384 + 34816);
  int tid_ = TIDX(wvs) & 255; asm volatile("" : "+v"(tid_)); const int tid = tid_, lane = tid & 63, wave = tid >> 6;
  int row0, L; chunk_geom(c, row0, L);
  const bf16_t* proj = (const bf16_t*)(p.ws + OFF_A);
#pragma unroll
  for (int i = 0; i < 2; ++i) {
    const int id = tid + i * 256, s = id >> 3, c8 = id & 7;
    uint4 v = make_uint4(0, 0, 0, 0);
    if (s < L) v = *(const uint4*)(proj + (size_t)(row0 + s) * 3200 + 2576 + gq * 64 + c8 * 8);
    float* d = Uf + s * 64 + c8 * 8;
    d[0] = lo2f(v.x); d[1] = hi2f(v.x); d[2] = lo2f(v.y); d[3] = hi2f(v.y); d[4] = lo2f(v.z); d[5] = hi2f(v.z); d[6] = lo2f(v.w); d[7] = hi2f(v.w);
  }
  const int g = gq * 4 + wave, gp = g * 64 + lane;
  const float* tab = (const float*)(p.ws + OFF_S5TAB);
  const float lr = tab[gp], li = tab[2048 + gp];
  f32x2 bb2[16];
#pragma unroll
  for (int q = 0; q < 4; ++q) {
    const float4 a = *(const float4*)(tab + 4096 + gp * 16 + q * 4), b = *(const float4*)(tab + 4096 + 32768 + gp * 16 + q * 4);
    bb2[q * 4] = (f32x2){a.x, b.x}; bb2[q * 4 + 1] = (f32x2){a.y, b.y}; bb2[q * 4 + 2] = (f32x2){a.z, b.z}; bb2[q * 4 + 3] = (f32x2){a.w, b.w};
  }
  float hr = 0.f, hi = 0.f;
  bf16_t* HS = HSall + wave * 32 * 136; bf16_t* CM = CMall + wave * 16 * 136;
  if (OUT) {
    const float2 h0 = *(const float2*)((const float*)(p.ws + OFF_S5H) + ((size_t)c * 2048 + gp) * 2);
    hr = h0.x; hi = h0.y;
#pragma unroll
    for (int ch = 0; ch < 16; ++ch) { CM[ch * 136 + lane] = f2bf(p.s5_c_re[(g * 16 + ch) * 64 + lane]); CM[ch * 136 + 64 + lane] = f2bf(-p.s5_c_im[(g * 16 + ch) * 64 + lane]); }
  }
  __syncthreads();
  const int nhalf = OUT ? ((L + 31) >> 5) : 1, tl = OUT ? 32 : L;
  for (int hf = 0; hf < nhalf; ++hf) {
#pragma unroll 4
    for (int tt = 0; tt < tl; ++tt) {
      const int t = hf * 32 + tt;
      {
        const float* up = Uf + t * 64 + wave * 16;
        f32x2 b0 = (f32x2){0.f, 0.f}, b1 = (f32x2){0.f, 0.f};
#pragma unroll
        for (int q = 0; q < 4; ++q) {
          const f32x4 u4 = *(const f32x4*)(up + q * 4);
          b0 += bb2[q * 4] * u4[0]; b1 += bb2[q * 4 + 1] * u4[1]; b0 += bb2[q * 4 + 2] * u4[2]; b1 += bb2[q * 4 + 3] * u4[3];
        }
        b0 += b1;
        const float nr = lr * hr - li * hi + b0[0], ni = lr * hi + li * hr + b0[1];
        if (t < L) { hr = nr; hi = ni; }
      }
      if (OUT) { HS[tt * 136 + lane] = f2bf(t < L ? hr : 0.f); HS[tt * 136 + 64 + lane] = f2bf(t < L ? hi : 0.f); }
    }
    if (OUT) {
      __syncthreads();
      f32x4 ay[2][1];
      ay[0][0] = (f32x4){0.f, 0.f, 0.f, 0.f}; ay[1][0] = (f32x4){0.f, 0.f, 0.f, 0.f};
      wmma_sw<2, 1>(ay, HS, 136, CM, 136, 128, lane);
      bf16_t* gbuf = (bf16_t*)(p.ws + OFF_GBUF);
#pragma unroll
      for (int mt = 0; mt < 2; ++mt) {
        const int t = hf * 32 + mt * 16 + (lane & 15), ch0 = (lane >> 4) * 4;
        if (t < L) {
          const float4 u4 = *(const float4*)(Uf + t * 64 + wave * 16 + ch0);
          const float4 d4 = *(const float4*)(p.s5_d + g * 16 + ch0);
          float y[4] = {ay[mt][0][0] + d4.x * u4.x, ay[mt][0][1] + d4.y * u4.y, ay[mt][0][2] + d4.z * u4.z, ay[mt][0][3] + d4.w * u4.w};
#pragma unroll
          for (int j = 0; j < 4; ++j) { const float x = y[j], uu = 0.7978845608028654f * (x + 0.044715f * x * x * x); y[j] = x / (1.f + __expf(-2.f * uu)); }
          store4bf(gbuf + (size_t)(row0 + t) * 512 + g * 16 + ch0, y[0], y[1], y[2], y[3]);
        }
      }
      __syncthreads();
    }
  }
  if (!OUT) { *(float2*)((float*)(p.ws + OFF_S5E) + ((size_t)c * 2048 + gp) * 2) = make_float2(hr, hi); }
  __syncthreads();
}

__device__ __forceinline__ void s5_prefix(const Params& p, int gt) {
  const int sq = gt >> 11, rem = gt & 2047;
  const float* tab = (const float*)(p.ws + OFF_S5TAB);
  const float* e = (const float*)(p.ws + OFF_S5E);
  float* hs = (float*)(p.ws + OFF_S5H);
  float hr = 0.f, hi = 0.f;
  if (sq < 8) {
    const float lr = tab[69632 + rem], li = tab[71680 + rem];
    for (int n = 0; n < 32; ++n) {
      const size_t idx = ((size_t)(sq * 32 + n) * 2048 + rem) * 2;
      *(float2*)(hs + idx) = make_float2(hr, hi);
      const float2 ev = *(const float2*)(e + idx);
      const float nr = lr * hr - li * hi + ev.x, ni = lr * hi + li * hr + ev.y; hr = nr; hi = ni;
    }
  } else {
    const float lr = tab[73728 + rem], li = tab[75776 + rem];
    hr = p.state_s5_re[(size_t)(sq - 8) * 2048 + rem]; hi = p.state_s5_im[(size_t)(sq - 8) * 2048 + rem];
    const size_t idx = ((size_t)(256 + sq - 8) * 2048 + rem) * 2;
    *(float2*)(hs + idx) = make_float2(hr, hi);
    const float2 ev = *(const float2*)(e + idx);
    const float nr = lr * hr - li * hi + ev.x, ni = lr * hi + li * hr + ev.y; hr = nr; hi = ni;
  }
  p.out[O_S5RE + (size_t)sq * 2048 + rem] = hr;
  p.out[O_S5IM + (size_t)sq * 2048 + rem] = hi;
}

__device__ __forceinline__ void conv_phase(const Params& p, int wvs) {
  const bf16_t* proj = (const bf16_t*)(p.ws + OFF_A);
  bf16_t* xc = (bf16_t*)(p.ws + OFF_H);
  int tq_ = TIDX(wvs); asm volatile("" : "+v"(tq_)); const int gt = blockIdx.x * NTHR + tq_, nt = gridDim.x * NTHR;
  for (int task = gt; task < 544 * 192; task += nt) {
    const int seg = task / 192, c = (task - seg * 192) * 8, rowb = seg * 32;
    float w[4][8], bia[8];
#pragma unroll
    for (int j = 0; j < 4; ++j) {
      const float4 w0 = *(const float4*)(p.conv_w + j * 1536 + c), w1 = *(const float4*)(p.conv_w + j * 1536 + c + 4);
      w[j][0] = w0.x; w[j][1] = w0.y; w[j][2] = w0.z; w[j][3] = w0.w; w[j][4] = w1.x; w[j][5] = w1.y; w[j][6] = w1.z; w[j][7] = w1.w;
    }
    { const float4 b0 = *(const float4*)(p.conv_b + c), b1 = *(const float4*)(p.conv_b + c + 4); bia[0] = b0.x; bia[1] = b0.y; bia[2] = b0.z; bia[3] = b0.w; bia[4] = b1.x; bia[5] = b1.y; bia[6] = b1.z; bia[7] = b1.w; }
    float x0[8], x1[8], x2[8];
    if (rowb < 16384 && (rowb & 2047) != 0) {
      const u32x4 v0 = *(const u32x4*)(proj + (size_t)(rowb - 3) * 3200 + 1024 + c), v1 = *(const u32x4*)(proj + (size_t)(rowb - 2) * 3200 + 1024 + c), v2 = *(const u32x4*)(proj + (size_t)(rowb - 1) * 3200 + 1024 + c);
#pragma unroll
      for (int e = 0; e < 4; ++e) { x0[2 * e] = lo2f(v0[e]); x0[2 * e + 1] = hi2f(v0[e]); x1[2 * e] = lo2f(v1[e]); x1[2 * e + 1] = hi2f(v1[e]); x2[2 * e] = lo2f(v2[e]); x2[2 * e + 1] = hi2f(v2[e]); }
    } else {
#pragma unroll
      for (int e = 0; e < 8; ++e) { x0[e] = 0.f; x1[e] = 0.f; x2[e] = 0.f; }
    }
    u32x4 nxt = *(const u32x4*)(proj + (size_t)rowb * 3200 + 1024 + c);
    for (int r = 0; r < 32; ++r) {
      const int row = rowb + r;
      const u32x4 cv = nxt;
      if (r + 1 < 32) nxt = *(const u32x4*)(proj + (size_t)(row + 1) * 3200 + 1024 + c);
      int t, T, sq;
      if (row < 16384) { t = row & 2047; T = 2048; sq = row >> 11; } else { t = (row - 16384) & 7; T = 8; sq = 8 + ((row - 16384) >> 3); }
      if (t == 0) {
        if (sq >= 8) {
          const float* sc = p.state_conv + (size_t)(sq - 8) * 3 * 1536 + c;
          const float4 a0 = *(const float4*)sc, a1 = *(const float4*)(sc + 4), b0 = *(const float4*)(sc + 1536), b1 = *(const float4*)(sc + 1540), c0 = *(const float4*)(sc + 3072), c1 = *(const float4*)(sc + 3076);
          x0[0] = a0.x; x0[1] = a0.y; x0[2] = a0.z; x0[3] = a0.w; x0[4] = a1.x; x0[5] = a1.y; x0[6] = a1.z; x0[7] = a1.w;
          x1[0] = b0.x; x1[1] = b0.y; x1[2] = b0.z; x1[3] = b0.w; x1[4] = b1.x; x1[5] = b1.y; x1[6] = b1.z; x1[7] = b1.w;
          x2[0] = c0.x; x2[1] = c0.y; x2[2] = c0.z; x2[3] = c0.w; x2[4] = c1.x; x2[5] = c1.y; x2[6] = c1.z; x2[7] = c1.w;
        } else {
#pragma unroll
          for (int e = 0; e < 8; ++e) { x0[e] = 0.f; x1[e] = 0.f; x2[e] = 0.f; }
        }
      }
      float cur[8], o[8];
#pragma unroll
      for (int e = 0; e < 4; ++e) { cur[2 * e] = lo2f(cv[e]); cur[2 * e + 1] = hi2f(cv[e]); }
#pragma unroll
      for (int e = 0; e < 8; ++e) { o[e] = siluf(bia[e] + w[0][e] * x0[e] + w[1][e] * x1[e] + w[2][e] * x2[e] + w[3][e] * cur[e]); x0[e] = x1[e]; x1[e] = x2[e]; x2[e] = cur[e]; }
      u32x4 ov; ov[0] = pack2(o[0], o[1]); ov[1] = pack2(o[2], o[3]); ov[2] = pack2(o[4], o[5]); ov[3] = pack2(o[6], o[7]);
      *(u32x4*)(xc + (size_t)row * 1536 + c) = ov;
      if (t >= T - 3) {
        float* d = p.out + O_CONV + ((size_t)sq * 3 + (t - (T - 3))) * 1536 + c;
        *(float4*)d = make_float4(cur[0], cur[1], cur[2], cur[3]); *(float4*)(d + 4) = make_float4(cur[4], cur[5], cur[6], cur[7]);
      }
    }
  }
}

__device__ __forceinline__ void ssdnorm_phase(const Params& p, int wvs) {
  const bf16_t* proj = (const bf16_t*)(p.ws + OFF_A);
  bf16_t* mix = (bf16_t*)(p.ws + OFF_H);
  const float* st = (const float*)(p.ws + OFF_SSDST);
  int tq_ = TIDX(wvs); asm volatile("" : "+v"(tq_)); const int gt = blockIdx.x * NTHR + tq_, nt = gridDim.x * NTHR;
  for (int it = gt; it < ROWS * 128; it += nt) {
    const int row = it >> 7, c = (it & 127) * 8;
    const float r = rsqrtf(st[(size_t)row * 2 + (c >> 9)] * (1.f / 512.f) + EPSV);
    const uint4 v = *(const uint4*)(proj + (size_t)row * 3200 + c);
    const float4 w0 = *(const float4*)(p.ssm_norm_w + c), w1 = *(const float4*)(p.ssm_norm_w + c + 4);
    uint4 o; o.x = pack2(lo2f(v.x) * r * w0.x, hi2f(v.x) * r * w0.y); o.y = pack2(lo2f(v.y) * r * w0.z, hi2f(v.y) * r * w0.w);
    o.z = pack2(lo2f(v.z) * r * w1.x, hi2f(v.z) * r * w1.y); o.w = pack2(lo2f(v.w) * r * w1.z, hi2f(v.w) * r * w1.w);
    *(uint4*)(mix + (size_t)row * 1536 + c) = o;
  }
}


#define XB_TMO      128
#define XB_XCNT(j)  (256  + 64 * (j))
#define XB_XSUB(j)  (1280 + 64 * (j))
#define XB_XGEN(j)  (2304 + 64 * (j))
#define XB_TOP      3328
#define XB_TOPGEN   3392
#define XCD_BAR_WORDS 3456
#define XB_SPIN_CAP (1u << 18)
#define LAS __attribute__((address_space(3)))
__device__ __forceinline__ unsigned xb_ld(unsigned* p)              { return __hip_atomic_load(p, __ATOMIC_RELAXED, __HIP_MEMORY_SCOPE_AGENT); }
__device__ __forceinline__ unsigned xb_add(unsigned* p, unsigned v) { return __hip_atomic_fetch_add(p, v, __ATOMIC_RELAXED, __HIP_MEMORY_SCOPE_AGENT); }
__device__ __forceinline__ unsigned xb_xcc_id() { return (unsigned)__builtin_amdgcn_s_getreg((3 << 11) | 20) & 0xFu; }
#define XB_SPIN(cond, bar) do { unsigned _sp = 0; while (cond) { __builtin_amdgcn_s_sleep(1); \
    if ((++_sp & 255u) == 0u) { if (xb_ld(&(bar)[XB_TMO])) break; if (_sp > XB_SPIN_CAP) { atomicAdd(&(bar)[XB_TMO], 1u); break; } } } } while (0)
struct XcdBarrier { unsigned* bar; unsigned x; volatile LAS unsigned* st; };
__device__ __forceinline__ XcdBarrier xcd_barrier_post(unsigned* bar, volatile LAS unsigned* st, int wvs) {
    XcdBarrier b; b.bar = bar; b.x = xb_xcc_id(); b.st = st;
    if (TIDX(wvs) == 0) (void)xb_add(&bar[XB_XCNT(b.x)], 1u);
    return b;
}
__device__ __forceinline__ void xcd_barrier_complete(unsigned* bar, unsigned x, unsigned& nloc, unsigned& nx) {
    const unsigned G = gridDim.x * gridDim.y * gridDim.z;
    unsigned sum, cnt, mine, sp = 0u;
    for (;;) {
        sum = 0u; cnt = 0u; mine = 0u;
#pragma unroll
        for (unsigned j = 0; j < 16; ++j) { const unsigned c = xb_ld(&bar[XB_XCNT(j)]); sum += c; cnt += (c > 0u) ? 1u : 0u; mine = (j == x) ? c : mine; }
        if (sum == G) break;
        __builtin_amdgcn_s_sleep(1);
        if ((++sp & 255u) == 0u) { if (xb_ld(&bar[XB_TMO])) break; if (sp > XB_SPIN_CAP) { atomicAdd(&bar[XB_TMO], 1u); break; } }
    }
    nloc = mine > 0u ? mine : 1u; nx = cnt > 0u ? cnt : 1u;
}
__device__ __forceinline__ void xcd_barrier(const XcdBarrier& b, int wvs) {
    asm volatile("s_waitcnt vmcnt(0)" ::: "memory");
    __syncthreads();
    if (TIDX(wvs) == 0) {
        unsigned* bar = b.bar;
        __builtin_amdgcn_s_waitcnt(0);
        unsigned nloc = b.st[0], nx = b.st[1];
        if (nloc == 0u) { xcd_barrier_complete(bar, b.x, nloc, nx); b.st[0] = nloc; b.st[1] = nx; }
        const unsigned old = xb_add(&bar[XB_XSUB(b.x)], 1u);
        const unsigned gen = old / nloc;
        if (old + 1u == (gen + 1u) * nloc) {
            __builtin_amdgcn_fence(__ATOMIC_RELEASE, "agent");
            asm volatile("s_waitcnt vmcnt(0)" ::: "memory");
            const unsigned og = xb_add(&bar[XB_TOP], 1u);
            const unsigned tg = og / nx;
            if (og + 1u == (tg + 1u) * nx) xb_add(&bar[XB_TOPGEN], 1u);
            else XB_SPIN(xb_ld(&bar[XB_TOPGEN]) == tg, bar);
            __builtin_amdgcn_fence(__ATOMIC_ACQUIRE, "agent");
            xb_add(&bar[XB_XGEN(b.x)], 1u);
            asm volatile("s_waitcnt vmcnt(0)" ::: "memory");
        } else {
            XB_SPIN(xb_ld(&bar[XB_XGEN(b.x)]) == gen, bar);
            __builtin_amdgcn_fence(__ATOMIC_ACQUIRE, "agent");
            asm volatile("s_waitcnt vmcnt(0)" ::: "memory");
        }
    }
    __syncthreads();
}


__device__ __forceinline__ Params ldp() {
  auto kp = __builtin_amdgcn_kernarg_segment_ptr();
  asm volatile("" : "+s"(kp));
  Params q;
  __builtin_memcpy(&q, (const void*)kp, sizeof(Params));
  return q;
}

__global__ void __launch_bounds__(NTHR, 2) fwd_megakernel(Params p_) {
  extern __shared__ __attribute__((aligned(16))) char smem[];
  cg::grid_group grid = cg::this_grid();
  if (p_.ws == nullptr) grid.sync();
  volatile LAS unsigned* xst = (volatile LAS unsigned*)(smem + 2 * HALF_LDS);
  const int wvs = __builtin_amdgcn_readfirstlane(threadIdx.x >> 6);
  if (TIDX(wvs) == 0) { xst[0] = 0u; xst[1] = 0u; xst[2] = 0u; xst[3] = 0u; }
  __syncthreads();
  const XcdBarrier xb = xcd_barrier_post((unsigned*)(p_.ws + OFF_BAR), xst, wvs);
  const int half = wvs >> 2;
  const int G = gridDim.x * 2, bid = blockIdx.x * 2 + half;
  char* hs = smem + half * HALF_LDS;
#define PH_BEGIN const Params p = ldp(); bf16_t* bufA = (bf16_t*)(p.ws + OFF_A); bf16_t* bufH = (bf16_t*)(p.ws + OFF_H); bf16_t* t0 = (bf16_t*)(p.ws + OFF_ST); \
    float* rowss = (float*)(p.ws + OFF_ROWSS); float* hbuf = p.out; (void)bufA; (void)bufH; (void)t0; (void)rowss; (void)hbuf;

  {
  PH_BEGIN
  prep_tables(p, wvs);
  wconv(p.w_in_even, 1024, 4096, 4096, (bf16_t*)(p.ws + W_IN), hs, wvs);
  wconv(p.w_out_even, 1024, 1024, 1024, (bf16_t*)(p.ws + W_OUT0), hs, wvs);
  wconv(p.w_ffn_up, 1024, 4096, 4096, (bf16_t*)(p.ws + W_UP), hs, wvs);
  wconv(p.w_ffn_down, 4096, 1024, 1024, (bf16_t*)(p.ws + W_DOWN), hs, wvs);
  rowpass_phase(nullptr, nullptr, nullptr, p.x_prompt, p.x_sample, nullptr, p.norm_mix_pre, bufH, wvs);
  }
  xcd_barrier(xb, wvs);
  {
  PH_BEGIN
  { EpiInEven e{bufA, (const float*)(p.ws + OFF_ROPE), (const float*)(p.ws + OFF_LB)};
    for (int rep_ = 0; rep_ < REPG; ++rep_) { gemm_phase(bufH, 1024, (const bf16_t*)(p.ws + W_IN), 1024, 64, 16, 1024, e, smem, wvs); gemm_tail(bufH, 1024, (const bf16_t*)(p.ws + W_IN), 1024, 32, 1024, e, smem, wvs, 64 * 16); } }
  }
  xcd_barrier(xb, wvs);
  {
  PH_BEGIN
  for (int rep_ = 0; rep_ < REPS; ++rep_) {
    if (bid < 256) {
      const int v = bid;
      const int ps = v & 3, m = (v >> 2) & 1, h = (v >> 3) & 3, sq = v >> 5;
      if (m == 0) state_unit<0>(p, sq, h, ps, hs, wvs); else state_unit<1>(p, sq, h, ps, hs, wvs);
    }
    const int nsh = bid < 256 ? 2 : 14, j0 = bid < 256 ? bid : 512 + (bid - 256);
    for (int i = 0; i < nsh; ++i) {
      const int v = j0 + 256 * i;
      const int ps = v & 3, m = (v >> 2) & 1, h = (v >> 3) & 3, sq = 8 + (v >> 5);
      if (m == 0) state_unit<0>(p, sq, h, ps, hs, wvs); else state_unit<1>(p, sq, h, ps, hs, wvs);
    }
  }
  }
  xcd_barrier(xb, wvs);
  {
  PH_BEGIN
  for (int rep_ = 0; rep_ < REPO; ++rep_)
  for (int u = bid; u < 384 * 8; u += G) {
    const int h = u & 3, m = (u >> 2) & 1, c = u >> 3;
    if (m == 0) out_unit<0>(p, c, h, hs, wvs); else out_unit<1>(p, c, h, hs, wvs);
  }
  }
  xcd_barrier(xb, wvs);
  {
  PH_BEGIN
  { EpiOut e{t0, rowss};
    for (int rep_ = 0; rep_ < REPG; ++rep_) { gemm_phase(bufH, 1024, (const bf16_t*)(p.ws + W_OUT0), 1024, 64, 4, 1024, e, smem, wvs); gemm_tail(bufH, 1024, (const bf16_t*)(p.ws + W_OUT0), 1024, 8, 1024, e, smem, wvs, 64 * 4); } }
  }
  xcd_barrier(xb, wvs);
  {
  PH_BEGIN
  for (int rep_ = 0; rep_ < REPR; ++rep_)
  rowpass_phase(t0, rowss, p.norm_mix_post, p.x_prompt, p.x_sample, hbuf, p.norm_ffn_pre, bufH, wvs);
  }
  xcd_barrier(xb, wvs);
  {
  PH_BEGIN
  { EpiUp e{bufA}; for (int rep_ = 0; rep_ < REPG; ++rep_) { gemm_phase(bufH, 1024, (const bf16_t*)(p.ws + W_UP), 1024, 64, 16, 1024, e, smem, wvs); gemm_tail(bufH, 1024, (const bf16_t*)(p.ws + W_UP), 1024, 32, 1024, e, smem, wvs, 64 * 16); } }
  }
  xcd_barrier(xb, wvs);
  {
  PH_BEGIN
  { EpiOut e{t0, rowss + ROWS}; for (int rep_ = 0; rep_ < REPG; ++rep_) { gemm_phase(bufA, 4096, (const bf16_t*)(p.ws + W_DOWN), 4096, 64, 4, 4096, e, smem, wvs); gemm_tail(bufA, 4096, (const bf16_t*)(p.ws + W_DOWN), 4096, 8, 4096, e, smem, wvs, 64 * 4); } }
  }
  xcd_barrier(xb, wvs);
  {
  PH_BEGIN
  rowpass_phase(t0, rowss + ROWS, p.norm_ffn_post, hbuf, hbuf + (size_t)16384 * 1024, hbuf, p.norm_mix_pre + 1024, bufH, wvs);
  wconv(p.w_in_odd, 1024, 3088, 3328, (bf16_t*)(p.ws + W_IN), hs, wvs);
  wconv(p.w_glu, 512, 512, 512, (bf16_t*)(p.ws + W_GLU), hs, wvs);
  wconv(p.w_out_odd, 1536, 1024, 1024, (bf16_t*)(p.ws + W_OUT1), hs, wvs);
  wconv(p.w_ffn_up + (size_t)1024 * 4096, 1024, 4096, 4096, (bf16_t*)(p.ws + W_UP), hs, wvs);
  wconv(p.w_ffn_down + (size_t)4096 * 1024, 4096, 1024, 1024, (bf16_t*)(p.ws + W_DOWN), hs, wvs);
  }
  xcd_barrier(xb, wvs);
  {
  PH_BEGIN
  { EpiInOdd e{bufA, (float*)(p.ws + OFF_DTBUF)};
    for (int rep_ = 0; rep_ < REPG; ++rep_) { gemm_phase(bufH, 1024, (const bf16_t*)(p.ws + W_IN), 1024, 64, 13, 1024, e, smem, wvs); gemm_tail(bufH, 1024, (const bf16_t*)(p.ws + W_IN), 1024, 26, 1024, e, smem, wvs, 64 * 13); } }
  }
  xcd_barrier(xb, wvs);
  {
  PH_BEGIN
  for (int rep_ = 0; rep_ < REPC; ++rep_) {
  conv_phase(p, wvs);
  for (int u = bid; u < 384 * 8; u += G) s5_unit<0>(p, u >> 3, u & 7, hs, wvs);
  }
  }
  xcd_barrier(xb, wvs);
  {
  PH_BEGIN
  for (int rep_ = 0; rep_ < REPS; ++rep_) {
    if (bid < 128) state_unit<2>(p, bid >> 4, bid & 15, 0, hs, wvs);
    for (int j = bid < 128 ? bid : 256 + (bid - 128); j < 3136; j += (bid < 128 ? 128 : 384)) {
      if (bid < 128 && j >= 256) break;
      if (j < 1088) { int tq_ = TIDX(wvs) & 255; asm volatile("" : "+v"(tq_)); s5_prefix(p, j * 256 + tq_); }
      else { const int v = j - 1088; state_unit<2>(p, 8 + (v >> 4), v & 15, 0, hs, wvs); }
    }
  }
  }
  xcd_barrier(xb, wvs);
  {
  PH_BEGIN
  for (int u = bid; u < 384 * 16 + 384 * 8; u += G) {
    if (u < 384 * 16) out_unit<2>(p, u >> 4, u & 15, hs, wvs);
    else { const int v = u - 384 * 16; s5_unit<1>(p, v >> 3, v & 7, hs, wvs); }
  }
  }
  xcd_barrier(xb, wvs);
  {
  PH_BEGIN
  ssdnorm_phase(p, wvs);
  { EpiGlu e{(const bf16_t*)(p.ws + OFF_GBUF), p.b_glu, bufH};
    for (int rep_ = 0; rep_ < REPG; ++rep_) { gemm_phase((const bf16_t*)(p.ws + OFF_GBUF), 512, (const bf16_t*)(p.ws + W_GLU), 512, 64, 2, 512, e, smem, wvs); gemm_tail((const bf16_t*)(p.ws + OFF_GBUF), 512, (const bf16_t*)(p.ws + W_GLU), 512, 4, 512, e, smem, wvs, 64 * 2); } }
  }
  xcd_barrier(xb, wvs);
  {
  PH_BEGIN
  { EpiOut e{t0, rowss + 2 * ROWS}; for (int rep_ = 0; rep_ < REPG; ++rep_) { gemm_phase(bufH, 1536, (const bf16_t*)(p.ws + W_OUT1), 1536, 64, 4, 1536, e, smem, wvs); gemm_tail(bufH, 1536, (const bf16_t*)(p.ws + W_OUT1), 1536, 8, 1536, e, smem, wvs, 64 * 4); } }
  }
  xcd_barrier(xb, wvs);
  {
  PH_BEGIN
  rowpass_phase(t0, rowss + 2 * ROWS, p.norm_mix_post + 1024, hbuf, hbuf + (size_t)16384 * 1024, hbuf, p.norm_ffn_pre + 1024, bufH, wvs);
  }
  xcd_barrier(xb, wvs);
  {
  PH_BEGIN
  { EpiUp e{bufA}; for (int rep_ = 0; rep_ < REPG; ++rep_) { gemm_phase(bufH, 1024, (const bf16_t*)(p.ws + W_UP), 1024, 64, 16, 1024, e, smem, wvs); gemm_tail(bufH, 1024, (const bf16_t*)(p.ws + W_UP), 1024, 32, 1024, e, smem, wvs, 64 * 16); } }
  }
  xcd_barrier(xb, wvs);
  {
  PH_BEGIN
  { EpiOut e{t0, rowss + 3 * ROWS}; for (int rep_ = 0; rep_ < REPG; ++rep_) { gemm_phase(bufA, 4096, (const bf16_t*)(p.ws + W_DOWN), 4096, 64, 4, 4096, e, smem, wvs); gemm_tail(bufA, 4096, (const bf16_t*)(p.ws + W_DOWN), 4096, 8, 4096, e, smem, wvs, 64 * 4); } }
  }
  xcd_barrier(xb, wvs);
  {
  PH_BEGIN
  rowpass_phase(t0, rowss + 3 * ROWS, p.norm_ffn_post + 1024, hbuf, hbuf + (size_t)16384 * 1024, hbuf, nullptr, nullptr, wvs);
  }
}

extern "C" void kernel_launch(void* const* d_in, const int* in_sizes, int n_in, void* d_out, int out_size, void* d_ws, size_t ws_size, hipStream_t stream) {
  constexpr size_t kDynLds = 2 * HALF_LDS + 64;
  static int grid_blocks = 0;
  if (!grid_blocks) {
    int dev = 0, cus = 0, per_cu = 0;
    (void)hipGetDevice(&dev);
    (void)hipDeviceGetAttribute(&cus, hipDeviceAttributeMultiprocessorCount, dev);
    (void)hipFuncSetAttribute((const void*)fwd_megakernel, hipFuncAttributeMaxDynamicSharedMemorySize, (int)kDynLds);
    (void)hipOccupancyMaxActiveBlocksPerMultiprocessor(&per_cu, fwd_megakernel, NTHR, kDynLds);
    if (per_cu > 1) per_cu = 1;
    if (per_cu < 1) per_cu = 1;
    grid_blocks = cus * per_cu;
  }
  Params p{};
  const float** pf = (const float**)&p;
  for (int i = 0; i < 37; ++i) pf[i] = (const float*)d_in[i];
  p.out = (float*)d_out;
  p.ws = (char*)d_ws;
  (void)hipMemsetAsync((char*)d_ws + OFF_BAR, 0, 16384, stream);
  void* args[] = {&p};
  hipError_t e = hipLaunchCooperativeKernel((void*)fwd_megakernel, dim3(grid_blocks), dim3(NTHR), args, kDynLds, stream);
  if (e != hipSuccess) fprintf(stderr, "cooperative launch failed: %s (grid %d)\n", hipGetErrorString(e), grid_blocks);
}
```

```cpp
#include <hip/hip_runtime.h>
#include <hip/hip_cooperative_groups.h>
#include <cstdio>
namespace cg = cooperative_groups;

typedef unsigned short bf16_t;
typedef short bf16x8 __attribute__((ext_vector_type(8)));
typedef float f32x4 __attribute__((ext_vector_type(4)));
typedef unsigned u32x4 __attribute__((ext_vector_type(4)));
typedef float f32x2 __attribute__((ext_vector_type(2)));

#define NTHR 512
#ifndef REPS
#define REPS 1
#endif
#ifndef REPO
#define REPO 1
#endif
#ifndef REPC
#define REPC 1
#endif
#ifndef REPR
#define REPR 1
#endif
#ifndef REPG
#define REPG 1
#endif
#define HALF_LDS 74752
#ifndef REP0
#define REP0 1
#endif
#ifndef REPS
#define REPS 1
#endif
#ifndef REPO
#define REPO 1
#endif
#ifndef REPC
#define REPC 1
#endif
#ifndef REPY
#define REPY 21
#endif
#define ROWS 17408
#define EPSV 1e-6f
#define TIDX(w) ((w) * 64 + (int)__builtin_amdgcn_mbcnt_hi(~0u, __builtin_amdgcn_mbcnt_lo(~0u, 0u)))

constexpr size_t W_IN = 0;
constexpr size_t W_OUT0 = 8388608;
constexpr size_t W_GLU = 6815744;
constexpr size_t W_OUT1 = 7340032;
constexpr size_t W_UP = 10485760;
constexpr size_t W_DOWN = 18874368;
constexpr size_t OFF_A = 29360128;
constexpr size_t OFF_GBUF = OFF_A + 111411200;
constexpr size_t OFF_ST = OFF_A + 142606336;
constexpr size_t OFF_H = OFF_ST + 67108864;
constexpr size_t OFF_SM = OFF_H + 53477376;
constexpr size_t OFF_ROPE = OFF_SM;
constexpr size_t OFF_ROWSS = OFF_SM + 1052672;
constexpr size_t OFF_SSDST = OFF_SM + 1331200;
constexpr size_t OFF_DTBUF = OFF_SM + 1470464;
constexpr size_t OFF_LB = OFF_SM + 2584576;
constexpr size_t OFF_S5TAB = OFF_SM + 2586624;
constexpr size_t OFF_S5E = OFF_SM + 2897920;
constexpr size_t OFF_S5H = OFF_SM + 9189376;
constexpr size_t OFF_BAR = OFF_SM + 15480832;

constexpr size_t O_RET = 17825792, O_HG = 26738688, O_SSM = 35651584, O_CONV = 53477376, O_S5RE = 54104064, O_S5IM = 54382592;

struct Params {
  const float *x_prompt, *x_sample, *state_ret, *state_hgrn, *state_ssm, *state_conv, *state_s5_re, *state_s5_im;
  const float *norm_mix_pre, *norm_mix_post, *norm_ffn_pre, *norm_ffn_post;
  const float *w_in_even, *w_out_even, *ret_norm_w, *hgrn_lb, *hgrn_norm_w, *w_in_odd, *conv_w, *conv_b, *dt_bias, *a_log, *d_ssm, *ssm_norm_w;
  const float *s5_lam_re, *s5_lam_im, *s5_log_step, *s5_b_re, *s5_b_im, *s5_c_re, *s5_c_im, *s5_d, *w_glu, *b_glu, *w_out_odd, *w_ffn_up, *w_ffn_down;
  float* out;
  char* ws;
};

__device__ __forceinline__ bf16_t f2bf(float f) { unsigned r; asm("v_cvt_pk_bf16_f32 %0, %1, %1" : "=v"(r) : "v"(f)); return (bf16_t)(r & 0xffffu); }
__device__ __forceinline__ float bf2f(bf16_t h) { return __uint_as_float(((unsigned)h) << 16); }
__device__ __forceinline__ unsigned pack2(float a, float b) { unsigned r; asm("v_cvt_pk_bf16_f32 %0, %1, %2" : "=v"(r) : "v"(a), "v"(b)); return r; }
__device__ __forceinline__ float lo2f(unsigned u) { return __uint_as_float(u << 16); }
__device__ __forceinline__ float hi2f(unsigned u) { return __uint_as_float(u & 0xffff0000u); }
__device__ __forceinline__ float sigm(float x) { return 1.f / (1.f + __expf(-x)); }
__device__ __forceinline__ float siluf(float x) { return x / (1.f + __expf(-x)); }
__device__ __forceinline__ void store4bf(bf16_t* p, float a, float b, float c, float d) { uint2 v; v.x = pack2(a, b); v.y = pack2(c, d); *(uint2*)p = v; }

__device__ __forceinline__ float shx(float v, int mask) {
  int l = (int)__builtin_amdgcn_mbcnt_hi(~0u, __builtin_amdgcn_mbcnt_lo(~0u, 0u));
  asm volatile("" : "+v"(l));
  return __int_as_float(__builtin_amdgcn_ds_bpermute((l ^ mask) << 2, __float_as_int(v)));
}

template <int MT, int NT>
__device__ __forceinline__ void wmma_sw(f32x4 (&acc)[MT][NT], const bf16_t* A, int lda, const bf16_t* B, int ldb, int K, int lane) {
  const int r = lane & 15, kq = (lane >> 4) * 8;
  for (int k0 = 0; k0 < K; k0 += 32) {
    bf16x8 af[MT], bfr[NT];
#pragma unroll
    for (int mt = 0; mt < MT; ++mt) af[mt] = *(const bf16x8*)(A + (mt * 16 + r) * lda + k0 + kq);
#pragma unroll
    for (int nt = 0; nt < NT; ++nt) bfr[nt] = *(const bf16x8*)(B + (nt * 16 + r) * ldb + k0 + kq);
#pragma unroll
    for (int mt = 0; mt < MT; ++mt)
#pragma unroll
      for (int nt = 0; nt < NT; ++nt) acc[mt][nt] = __builtin_amdgcn_mfma_f32_16x16x32_bf16(bfr[nt], af[mt], acc[mt][nt], 0, 0, 0);
  }
}
template <int MT, int NT>
__device__ __forceinline__ void wmma_ns(f32x4 (&acc)[MT][NT], const bf16_t* A, int lda, const bf16_t* B, int ldb, int K, int lane) {
  const int r = lane & 15, kq = (lane >> 4) * 8;
  for (int k0 = 0; k0 < K; k0 += 32) {
    bf16x8 af[MT], bfr[NT];
#pragma unroll
    for (int mt = 0; mt < MT; ++mt) af[mt] = *(const bf16x8*)(A + (mt * 16 + r) * lda + k0 + kq);
#pragma unroll
    for (int nt = 0; nt < NT; ++nt) bfr[nt] = *(const bf16x8*)(B + (nt * 16 + r) * ldb + k0 + kq);
#pragma unroll
    for (int mt = 0; mt < MT; ++mt)
#pragma unroll
      for (int nt = 0; nt < NT; ++nt) acc[mt][nt] = __builtin_amdgcn_mfma_f32_16x16x32_bf16(af[mt], bfr[nt], acc[mt][nt], 0, 0, 0);
  }
}

__device__ __forceinline__ void gemm_kstep(f32x4 (&acc)[4][8], const char* A, const char* B) {
  bf16x8 af[4], bfr[8];
#pragma unroll
  for (int mt = 0; mt < 4; ++mt) af[mt] = *(const bf16x8*)(A + mt * 2048);
#pragma unroll
  for (int nt = 0; nt < 8; ++nt) bfr[nt] = *(const bf16x8*)(B + nt * 2048);
  __builtin_amdgcn_sched_barrier(0);
#pragma unroll
  for (int nt = 0; nt < 8; ++nt)
#pragma unroll
    for (int mt = 0; mt < 4; ++mt) acc[mt][nt] = __builtin_amdgcn_mfma_f32_16x16x32_bf16(bfr[nt], af[mt], acc[mt][nt], 0, 0, 0);
}

template <class Epi>
__device__ __forceinline__ void gemm_phase(const bf16_t* A, int lda, const bf16_t* Bt, int ldb, int nMt, int nNt, int K, const Epi& epi, char* smem, int wvs) {
  char* As = smem;
  char* Bs = smem + 65536;
  int tid_ = TIDX(wvs); asm volatile("" : "+v"(tid_)); const int tid = tid_, lane = tid & 63, wave = tid >> 6;
  const int wr = wave >> 1, wc = wave & 1;
  const int ntiles = nMt * nNt, nk = K >> 6;
  const int lrow = tid >> 3, lcc = (tid & 7) * 8;
  const int wofs = ((lrow >> 4) * 2 + (lcc >> 5)) * 1024 + ((((lrow & 15) * 64) + (lcc & 31) * 2) ^ ((lrow & 8) << 2));
  const int rofs = (((lane & 15) * 64) + (lane >> 4) * 16) ^ ((lane & 8) << 2);
  const unsigned toffA = (unsigned)(lrow * lda + lcc), toffB = (unsigned)(lrow * ldb + lcc);
  for (int tile = blockIdx.x; tile < ntiles; tile += gridDim.x) {
    const int pn = tile / nMt, pm = tile - pn * nMt;
    const bf16_t* Ab = A + (size_t)(pm * 256) * lda;
    const bf16_t* Bb = Bt + (size_t)(pn * 256) * ldb;
    f32x4 acc[4][8];
#pragma unroll
    for (int i = 0; i < 4; ++i)
#pragma unroll
      for (int j = 0; j < 8; ++j) acc[i][j] = (f32x4){0.f, 0.f, 0.f, 0.f};
    u32x4 rg[4];
#pragma unroll
    for (int i = 0; i < 4; ++i) rg[i] = *(const u32x4*)(Ab + (size_t)(i * 64) * lda + toffA);
#pragma unroll
    for (int i = 0; i < 4; ++i) *(u32x4*)(As + wofs + i * 8192) = rg[i];
#pragma unroll
    for (int i = 0; i < 4; ++i) rg[i] = *(const u32x4*)(Bb + (size_t)(i * 64) * ldb + toffB);
#pragma unroll
    for (int i = 0; i < 4; ++i) *(u32x4*)(Bs + wofs + i * 8192) = rg[i];
    __syncthreads();
#pragma unroll 1
    for (int kt = 0; kt < nk; ++kt) {
      const int cur = kt & 1;
      const int kn = (kt + 1 < nk ? kt + 1 : kt) * 64;
      char* Ad = As + (cur ^ 1) * 32768; char* Bd = Bs + (cur ^ 1) * 32768;
#pragma unroll
      for (int i = 0; i < 4; ++i) rg[i] = *(const u32x4*)(Ab + ((size_t)(i * 64) * lda + kn) + toffA);
      __builtin_amdgcn_sched_barrier(0);
      gemm_kstep(acc, As + cur * 32768 + wr * 8192 + rofs, Bs + cur * 32768 + wc * 16384 + rofs);
      __builtin_amdgcn_sched_barrier(0);
#pragma unroll
      for (int i = 0; i < 4; ++i) *(u32x4*)(Ad + wofs + i * 8192) = rg[i];
#pragma unroll
      for (int i = 0; i < 4; ++i) rg[i] = *(const u32x4*)(Bb + ((size_t)(i * 64) * ldb + kn) + toffB);
      __builtin_amdgcn_sched_barrier(0);
      gemm_kstep(acc, As + cur * 32768 + wr * 8192 + 1024 + rofs, Bs + cur * 32768 + wc * 16384 + 1024 + rofs);
      __builtin_amdgcn_sched_barrier(0);
#pragma unroll
      for (int i = 0; i < 4; ++i) *(u32x4*)(Bd + wofs + i * 8192) = rg[i];
      __syncthreads();
    }
    int er_ = pm * 256 + wr * 64, ec_ = pn * 256 + wc * 128, el_ = lane;
    asm volatile("" : "+v"(er_), "+v"(ec_), "+v"(el_));
    epi(acc, er_, ec_, el_);
  }
}

struct EpiInEven {
  bf16_t* proj; const float* rope; const float* lb;
  template <int MT> __device__ __forceinline__ void operator()(f32x4 (&acc)[MT][8], int rbase, int cbase, int lane) const {
    const int sec = cbase >> 9, head = (cbase >> 7) & 3, r = lane & 15, cq = (lane >> 4) * 4;
#pragma unroll
    for (int mt = 0; mt < MT; ++mt) {
      __builtin_amdgcn_sched_barrier(0);
      const int row = rbase + mt * 16 + r;
      bf16_t* dst = proj + (size_t)row * 4096 + cbase + cq;
      if (sec < 2) {
        const int pidx = row < 16384 ? (row & 2047) : 2048 + ((row - 16384) & 7);
        const float* ct = rope + pidx * 128 + cq;
        const float sc = sec == 1 ? 0.08838834764831845f : 1.f;
#pragma unroll
        for (int nt = 0; nt < 4; ++nt) {
          const float4 c4 = *(const float4*)(ct + nt * 16), s4 = *(const float4*)(ct + 64 + nt * 16);
          const f32x4 x1 = acc[mt][nt], x2 = acc[mt][nt + 4];
          store4bf(dst + nt * 16, (x1[0] * c4.x - x2[0] * s4.x) * sc, (x1[1] * c4.y - x2[1] * s4.y) * sc, (x1[2] * c4.z - x2[2] * s4.z) * sc, (x1[3] * c4.w - x2[3] * s4.w) * sc);
          store4bf(dst + 64 + nt * 16, (x1[0] * s4.x + x2[0] * c4.x) * sc, (x1[1] * s4.y + x2[1] * c4.y) * sc, (x1[2] * s4.z + x2[2] * c4.z) * sc, (x1[3] * s4.w + x2[3] * c4.w) * sc);
        }
      } else if (sec == 5) {
#pragma unroll
        for (int nt = 0; nt < 8; ++nt) {
          const float4 l4 = *(const float4*)(lb + head * 128 + nt * 16 + cq);
          const f32x4 x = acc[mt][nt];
          store4bf(dst + nt * 16, __logf(l4.x + (1.f - l4.x) * sigm(x[0])), __logf(l4.y + (1.f - l4.y) * sigm(x[1])), __logf(l4.z + (1.f - l4.z) * sigm(x[2])), __logf(l4.w + (1.f - l4.w) * sigm(x[3])));
        }
      } else {
#pragma unroll
        for (int nt = 0; nt < 8; ++nt) { const f32x4 x = acc[mt][nt]; store4bf(dst + nt * 16, x[0], x[1], x[2], x[3]); }
      }
    }
  }
};
struct EpiOut {
  bf16_t* t0; float* rowss;
  template <int MT> __device__ __forceinline__ void operator()(f32x4 (&acc)[MT][8], int rbase, int cbase, int lane) const {
    const int r = lane & 15, cq = (lane >> 4) * 4;
#pragma unroll
    for (int mt = 0; mt < MT; ++mt) {
      __builtin_amdgcn_sched_barrier(0);
      const int row = rbase + mt * 16 + r;
      bf16_t* dst = t0 + (size_t)row * 1024 + cbase + cq;
      float ss = 0.f;
#pragma unroll
      for (int nt = 0; nt < 8; ++nt) { const f32x4 x = acc[mt][nt]; ss += x[0] * x[0] + x[1] * x[1] + x[2] * x[2] + x[3] * x[3]; store4bf(dst + nt * 16, x[0], x[1], x[2], x[3]); }
      ss += shx(ss, 16); ss += shx(ss, 32);
      if (lane < 16) atomicAdd(rowss + row, ss * (1.f / REPG));
    }
  }
};
struct EpiUp {
  bf16_t* act;
  template <int MT> __device__ __forceinline__ void operator()(f32x4 (&acc)[MT][8], int rbase, int cbase, int lane) const {
    const int r = lane & 15, cq = (lane >> 4) * 4;
#pragma unroll
    for (int mt = 0; mt < MT; ++mt) {
      __builtin_amdgcn_sched_barrier(0);
      bf16_t* dst = act + (size_t)(rbase + mt * 16 + r) * 4096 + cbase + cq;
#pragma unroll
      for (int nt = 0; nt < 8; ++nt) { f32x4 x = acc[mt][nt];
#pragma unroll
        for (int j = 0; j < 4; ++j) { float v = fmaxf(x[j], 0.f); x[j] = v * v; }
        store4bf(dst + nt * 16, x[0], x[1], x[2], x[3]); }
    }
  }
};
struct EpiInOdd {
  bf16_t* proj; float* dtbuf;
  template <int MT> __device__ __forceinline__ void operator()(f32x4 (&acc)[MT][8], int rbase, int cbase, int lane) const {
    const int r = lane & 15, cq = (lane >> 4) * 4;
#pragma unroll
    for (int mt = 0; mt < MT; ++mt) {
      __builtin_amdgcn_sched_barrier(0);
      const int row = rbase + mt * 16 + r;
      bf16_t* dst = proj + (size_t)row * 3200 + cbase + cq;
#pragma unroll
      for (int nt = 0; nt < 8; ++nt) { const f32x4 x = acc[mt][nt]; if (cbase + nt * 16 < 3200) store4bf(dst + nt * 16, x[0], x[1], x[2], x[3]); }
      if (cbase == 2560) { const f32x4 x = acc[mt][0]; *(float4*)(dtbuf + (size_t)row * 16 + cq) = make_float4(x[0], x[1], x[2], x[3]); }
    }
  }
};
struct EpiGlu {
  const bf16_t* gbuf; const float* bglu; bf16_t* mix;
  template <int MT> __device__ __forceinline__ void operator()(f32x4 (&acc)[MT][8], int rbase, int cbase, int lane) const {
    const int r = lane & 15, cq = (lane >> 4) * 4;
#pragma unroll
    for (int mt = 0; mt < MT; ++mt) {
      __builtin_amdgcn_sched_barrier(0);
      const int row = rbase + mt * 16 + r;
#pragma unroll
      for (int nt = 0; nt < 8; ++nt) {
        const int col = cbase + nt * 16 + cq;
        const f32x4 x = acc[mt][nt];
        const uint2 g2 = *(const uint2*)(gbuf + (size_t)row * 512 + col);
        const float4 b4 = *(const float4*)(bglu + col);
        store4bf(mix + (size_t)row * 1536 + 1024 + col, lo2f(g2.x) * sigm(x[0] + b4.x), hi2f(g2.x) * sigm(x[1] + b4.y), lo2f(g2.y) * sigm(x[2] + b4.z), hi2f(g2.y) * sigm(x[3] + b4.w));
      }
    }
  }
};

template <class Epi>
__device__ __forceinline__ void gemm_tail(const bf16_t* A, int lda, const bf16_t* Bt, int ldb, int nNt128, int K, const Epi& epi, char* smem, int wvs, int nBig) {
  bf16_t* As = (bf16_t*)smem;
  bf16_t* Bs = As + 2 * 128 * 80;
  int tid_ = TIDX(wvs); asm volatile("" : "+v"(tid_)); const int tid = tid_, lane = tid & 63, wave = tid >> 6;
  const int nk = K >> 6, G = gridDim.x;
  const int lrow = tid >> 3, lcc = (tid & 7) * 8;
  const unsigned toffA = (unsigned)(lrow * lda + lcc), toffB = (unsigned)(lrow * ldb + lcc);
  const int rr = nBig % G, nLight = G - rr;
  const int nSmall = 8 * nNt128;
  if ((int)blockIdx.x >= rr) {
    for (int j = (int)blockIdx.x - rr; j < nSmall; j += nLight) {
      const int pm = j / nNt128, pn = j - pm * nNt128;
      const bf16_t* Ab = A + (size_t)(16384 + pm * 128) * lda;
      const bf16_t* Bb = Bt + (size_t)(pn * 128) * ldb;
      f32x4 acc[1][8];
#pragma unroll
      for (int q = 0; q < 8; ++q) acc[0][q] = (f32x4){0.f, 0.f, 0.f, 0.f};
      u32x4 ra[2], rb[2];
#pragma unroll
      for (int i = 0; i < 2; ++i) { ra[i] = *(const u32x4*)(Ab + (size_t)(i * 64) * lda + toffA); rb[i] = *(const u32x4*)(Bb + (size_t)(i * 64) * ldb + toffB); }
#pragma unroll
      for (int i = 0; i < 2; ++i) { *(u32x4*)(As + (lrow + i * 64) * 80 + lcc) = ra[i]; *(u32x4*)(Bs + (lrow + i * 64) * 80 + lcc) = rb[i]; }
      __syncthreads();
#pragma unroll 1
      for (int kt = 0; kt < nk; ++kt) {
        const int cur = kt & 1;
        const int kn = (kt + 1 < nk ? kt + 1 : kt) * 64;
#pragma unroll
        for (int i = 0; i < 2; ++i) { ra[i] = *(const u32x4*)(Ab + ((size_t)(i * 64) * lda + kn) + toffA); rb[i] = *(const u32x4*)(Bb + ((size_t)(i * 64) * ldb + kn) + toffB); }
        __builtin_amdgcn_sched_barrier(0);
        wmma_sw<1, 8>(acc, As + cur * 128 * 80 + wave * 16 * 80, 80, Bs + cur * 128 * 80, 80, 64, lane);
        __builtin_amdgcn_sched_barrier(0);
        bf16_t* Ad = As + (cur ^ 1) * 128 * 80; bf16_t* Bd = Bs + (cur ^ 1) * 128 * 80;
#pragma unroll
        for (int i = 0; i < 2; ++i) { *(u32x4*)(Ad + (lrow + i * 64) * 80 + lcc) = ra[i]; *(u32x4*)(Bd + (lrow + i * 64) * 80 + lcc) = rb[i]; }
        __syncthreads();
      }
      int er_ = 16384 + pm * 128 + wave * 16, ec_ = pn * 128, el_ = lane;
      asm volatile("" : "+v"(er_), "+v"(ec_), "+v"(el_));
      epi(acc, er_, ec_, el_);
    }
  }
}

__device__ __forceinline__ void rowpass_phase(const bf16_t* t0, const float* rowss, const float* wpost, const float* hin_a, const float* hin_b, float* hout, const float* wnext, bf16_t* hn, int wvs) {
  int tq_ = TIDX(wvs); asm volatile("" : "+v"(tq_)); const int lane = tq_ & 63, gw = blockIdx.x * 8 + (tq_ >> 6), nw = gridDim.x * 8;
  for (int row = gw; row < ROWS; row += nw) {
    const float* hin = row < 16384 ? hin_a + (size_t)row * 1024 : hin_b + (size_t)(row - 16384) * 1024;
    float r0 = 0.f;
    if (t0) r0 = rsqrtf(rowss[row] * (1.f / 1024.f) + EPSV);
    float4 v[4]; float ss = 0.f;
    float4 hvv[4], wpv[4], wnv[4]; uint2 tv[4];
#pragma unroll
    for (int i = 0; i < 4; ++i) {
      const int col = (i * 64 + lane) * 4;
      hvv[i] = *(const float4*)(hin + col);
      if (t0) { tv[i] = *(const uint2*)(t0 + (size_t)row * 1024 + col); wpv[i] = *(const float4*)(wpost + col); }
      if (hn) wnv[i] = *(const float4*)(wnext + col);
    }
#pragma unroll
    for (int i = 0; i < 4; ++i) {
      const int col = (i * 64 + lane) * 4;
      float4 hv = hvv[i];
      if (t0) {
        const uint2 t2 = tv[i];
        const float4 w4 = wpv[i];
        hv.x += lo2f(t2.x) * r0 * w4.x; hv.y += hi2f(t2.x) * r0 * w4.y; hv.z += lo2f(t2.y) * r0 * w4.z; hv.w += hi2f(t2.y) * r0 * w4.w;
      }
      v[i] = hv; ss += hv.x * hv.x + hv.y * hv.y + hv.z * hv.z + hv.w * hv.w;
      if (hout) *(float4*)(hout + (size_t)row * 1024 + col) = hv;
    }
    if (hn) {
#pragma unroll
      for (int o = 32; o >= 1; o >>= 1) ss += shx(ss, o);
      const float r1 = rsqrtf(ss * (1.f / 1024.f) + EPSV);
#pragma unroll
      for (int i = 0; i < 4; ++i) {
        const int col = (i * 64 + lane) * 4;
        const float4 w4 = wnv[i];
        store4bf(hn + (size_t)row * 1024 + col, v[i].x * r1 * w4.x, v[i].y * r1 * w4.y, v[i].z * r1 * w4.z, v[i].w * r1 * w4.w);
      }
    }
  }
}

__device__ __forceinline__ void wconv(const float* __restrict__ W, int K, int N, int Npad, bf16_t* __restrict__ Wt, char* smem, int wvs) {
  float* tile = (float*)smem;
  int tq_ = TIDX(wvs) & 255; asm volatile("" : "+v"(tq_)); const int tid = tq_;
  const int nNt = Npad >> 6, nunits = (K >> 6) * nNt;
  for (int u = blockIdx.x * 2 + (wvs >> 2); u < nunits; u += gridDim.x * 2) {
    const int k0 = (u / nNt) * 64, n0 = (u % nNt) * 64;
#pragma unroll
    for (int ps = 0; ps < 4; ++ps) {
      const int i = ps * 16 + (tid >> 4), j = (tid & 15) * 4, n = n0 + j;
      float4 v = make_float4(0.f, 0.f, 0.f, 0.f);
      if (n < N) v = *(const float4*)(W + (size_t)(k0 + i) * N + n);
      tile[i * 65 + j] = v.x; tile[i * 65 + j + 1] = v.y; tile[i * 65 + j + 2] = v.z; tile[i * 65 + j + 3] = v.w;
    }
    __syncthreads();
    {
      const int n = tid >> 2, kq = (tid & 3) * 16;
      uint4 o0, o1;
      o0.x = pack2(tile[(kq + 0) * 65 + n], tile[(kq + 1) * 65 + n]); o0.y = pack2(tile[(kq + 2) * 65 + n], tile[(kq + 3) * 65 + n]);
      o0.z = pack2(tile[(kq + 4) * 65 + n], tile[(kq + 5) * 65 + n]); o0.w = pack2(tile[(kq + 6) * 65 + n], tile[(kq + 7) * 65 + n]);
      o1.x = pack2(tile[(kq + 8) * 65 + n], tile[(kq + 9) * 65 + n]); o1.y = pack2(tile[(kq + 10) * 65 + n], tile[(kq + 11) * 65 + n]);
      o1.z = pack2(tile[(kq + 12) * 65 + n], tile[(kq + 13) * 65 + n]); o1.w = pack2(tile[(kq + 14) * 65 + n], tile[(kq + 15) * 65 + n]);
      bf16_t* d = Wt + (size_t)(n0 + n) * K + k0 + kq;
      *(uint4*)d = o0; *(uint4*)(d + 8) = o1;
    }
    __syncthreads();
  }
}

__device__ __forceinline__ void prep_tables(const Params& p, int wvs) {
  int tq_ = TIDX(wvs); asm volatile("" : "+v"(tq_)); const int gt = blockIdx.x * NTHR + tq_, nt = gridDim.x * NTHR;
  float* rope = (float*)(p.ws + OFF_ROPE);
  for (int i = gt; i < 2056 * 64; i += nt) {
    const int pi = i >> 6, f = i & 63;
    const double pos = pi < 2048 ? (double)pi : (double)(16384 + pi - 2048);
    const double invf = exp(-(double)f * (9.210340371976184 / 64.0));
    double ang = pos * invf;
    ang -= 6.283185307179586 * floor(ang * 0.15915494309189535);
    const float a = (float)ang;
    rope[pi * 128 + f] = cosf(a); rope[pi * 128 + 64 + f] = sinf(a);
  }
  float* z = (float*)(p.ws + OFF_ROWSS);
  for (int i = gt; i < ROWS * 6; i += nt) z[i] = 0.f;
  float* lb = (float*)(p.ws + OFF_LB);
  for (int i = gt; i < 512; i += nt) lb[i] = 1.f / (1.f + expf(p.hgrn_lb[512 + i] - p.hgrn_lb[i]));
  float* tab = (float*)(p.ws + OFF_S5TAB);
  for (int i = gt; i < 2048; i += nt) {
    const int g = i >> 6;
    const float lr = p.s5_lam_re[i], li = p.s5_lam_im[i], dt = expf(p.s5_log_step[g]);
    const float m1 = expf(lr * dt), br = m1 * cosf(li * dt), bi = m1 * sinf(li * dt);
    tab[i] = br; tab[2048 + i] = bi;
    const float m64 = expf(lr * dt * 64.f); tab[69632 + i] = m64 * cosf(li * dt * 64.f); tab[71680 + i] = m64 * sinf(li * dt * 64.f);
    const float m8 = expf(lr * dt * 8.f); tab[73728 + i] = m8 * cosf(li * dt * 8.f); tab[75776 + i] = m8 * sinf(li * dt * 8.f);
    const float x = br - 1.f, y = bi, den = 1.f / (lr * lr + li * li);
    const float qr = (x * lr + y * li) * den, qi = (y * lr - x * li) * den;
    for (int c = 0; c < 16; ++c) {
      const float b_r = p.s5_b_re[i * 16 + c], b_i = p.s5_b_im[i * 16 + c];
      tab[4096 + i * 16 + c] = qr * b_r - qi * b_i;
      tab[4096 + 32768 + i * 16 + c] = qr * b_i + qi * b_r;
    }
  }
}

__device__ __forceinline__ void chunk_geom(int c, int& row0, int& L) { if (c < 256) { row0 = c * 64; L = 64; } else { row0 = 16384 + (c - 256) * 8; L = 8; } }

template <int MODE>
__device__ __forceinline__ void st_load(uint4 (&kr)[4], uint4 (&vr)[(MODE == 2) ? 2 : 1], float& dtr, const bf16_t* src, const float* dtbuf, int row0, int L, int ld, int kcol, int vcol, int h, int tid) {
  constexpr int PW = (MODE == 2) ? 64 : 32, NVC = PW / 32, VCR = PW / 8;
  const uint4 z4 = make_uint4(0, 0, 0, 0);
#pragma unroll
  for (int i = 0; i < 4; ++i) { const int id = tid + i * 256, s = id >> 4, c8 = id & 15; uint4 t_ = z4; if (s < L) t_ = *(const uint4*)(src + (size_t)(row0 + s) * ld + kcol + c8 * 8); kr[i] = t_; }
#pragma unroll
  for (int i = 0; i < NVC; ++i) { const int id = tid + i * 256, s = id / VCR, c8 = id % VCR; uint4 t_ = z4; if (s < L) t_ = *(const uint4*)(src + (size_t)(row0 + s) * ld + vcol + c8 * 8); vr[i] = t_; }
  if (MODE == 2 && tid < 64) dtr = tid < L ? dtbuf[(size_t)(row0 + tid) * 16 + h] : 0.f;
}

template <int MODE>
__device__ __forceinline__ void state_unit(const Params& p, int sq, int h, int ps, char* smem, int wvs) {
  constexpr int PW = (MODE == 2) ? 64 : 32, NT = PW / 16, PF = (MODE == 2) ? 64 : 128, HH = (MODE == 2) ? 16 : 4, NVC = PW / 32, VCR = PW / 8;
  bf16_t* KT = (bf16_t*)smem;
  bf16_t* VT = KT + 128 * 80;
  bf16_t* KR = VT + 64 * 80;
  float* tot = (float*)(KR + 64 * 136);
  float* dec = tot + 256;
  float* av = dec + 64;
  float* dtv = av + 64;
  int tid_ = TIDX(wvs) & 255; asm volatile("" : "+v"(tid_)); const int tid = tid_, lane = tid & 63, wave = tid >> 6;
  const bool prompt = sq < 8;
  const int nch = prompt ? 32 : 1, L = prompt ? 64 : 8;
  const int ld = (MODE == 2) ? 1536 : 4096;
  const bf16_t* src = (MODE == 2) ? (const bf16_t*)(p.ws + OFF_H) : (const bf16_t*)(p.ws + OFF_A);
  const int kcol = MODE == 0 ? 512 + h * 128 : MODE == 1 ? 2560 + h * 128 : 1024 + (h >> 3) * 128;
  const int vcol = MODE == 0 ? 1024 + h * 128 + ps * 32 : MODE == 1 ? 3072 + h * 128 + ps * 32 : h * 64;
  const float* sin_ = MODE == 0 ? p.state_ret : MODE == 1 ? p.state_hgrn : p.state_ssm;
  float* sout = p.out + (MODE == 0 ? O_RET : MODE == 1 ? O_HG : O_SSM) + (size_t)(sq * HH + h) * 128 * PF;
  bf16_t* stb = (bf16_t*)(p.ws + OFF_ST) + (MODE == 1 ? (size_t)256 * 4 * 128 * 128 : 0);
  const float* dtbuf = (const float*)(p.ws + OFF_DTBUF);
  const float l2g = MODE == 0 ? log2f(1.f - exp2f(-5.f - (float)h)) : 0.f;
  float Ah = 0.f, dtb = 0.f;
  if (MODE == 2) { Ah = -expf(p.a_log[h]); dtb = p.dt_bias[h]; }

  f32x4 acc[2][NT];
  const int nb = wave * 32 + (lane >> 4) * 4, pc = ps * PW + (lane & 15);
#pragma unroll
  for (int mt = 0; mt < 2; ++mt)
#pragma unroll
    for (int nt = 0; nt < NT; ++nt)
#pragma unroll
      for (int j = 0; j < 4; ++j)
        acc[mt][nt][j] = prompt ? 0.f : sin_[((size_t)((sq - 8) * HH + h) * 128 + nb + mt * 16 + j) * PF + pc + nt * 16];

  uint4 kr[4], vr[NVC]; float dtr = 0.f;
  const uint4 z4 = make_uint4(0, 0, 0, 0);
  st_load<MODE>(kr, vr, dtr, src, dtbuf, prompt ? sq * 2048 : 16384 + (sq - 8) * 8, L, ld, kcol, vcol, h, tid);
  for (int n = 0; n < nch; ++n) {
    if (prompt) {
      bf16_t* d = stb + ((size_t)((sq * 32 + n) * HH + h) * PF) * 128;
#pragma unroll
      for (int mt = 0; mt < 2; ++mt)
#pragma unroll
        for (int nt = 0; nt < NT; ++nt) store4bf(d + (size_t)(pc + nt * 16) * 128 + nb + mt * 16, acc[mt][nt][0], acc[mt][nt][1], acc[mt][nt][2], acc[mt][nt][3]);
    }
#pragma unroll
    for (int i = 0; i < 4; ++i) { const int id = tid + i * 256, s = id >> 4, c8 = id & 15; *(uint4*)(KR + s * 136 + c8 * 8) = kr[i]; }
#pragma unroll
    for (int i = 0; i < NVC; ++i) {
      const int id = tid + i * 256, s = id / VCR, c8 = id % VCR; const uint4 v = vr[i];
      bf16_t* d = VT + (c8 * 8) * 80 + s;
      d[0] = (bf16_t)(v.x & 0xffff); d[80] = (bf16_t)(v.x >> 16); d[160] = (bf16_t)(v.y & 0xffff); d[240] = (bf16_t)(v.y >> 16);
      d[320] = (bf16_t)(v.z & 0xffff); d[400] = (bf16_t)(v.z >> 16); d[480] = (bf16_t)(v.w & 0xffff); d[560] = (bf16_t)(v.w >> 16);
    }
    if (MODE == 2 && tid < 64) {
      float dt = 0.f;
      if (tid < L) { const float x = dtr + dtb; dt = x > 20.f ? x : log1pf(__expf(x)); }
      dtv[tid] = dt; av[tid] = dt * Ah;
    }
    if (n + 1 < nch) st_load<MODE>(kr, vr, dtr, src, dtbuf, sq * 2048 + (n + 1) * 64, L, ld, kcol, vcol, h, tid);
    __syncthreads();
    const int kn = tid & 127, half = tid >> 7;
    if (MODE == 1) {
      float s_ = 0.f;
      for (int s = half * 32; s < half * 32 + 32; ++s) s_ += bf2f(KR[s * 136 + kn]);
      tot[half * 128 + kn] = s_;
    }
    if (MODE == 2 && tid < 64) {
      float suf = 0.f;
      for (int r = tid + 1; r < 64; ++r) suf += av[r];
      dec[tid] = __expf(suf) * dtv[tid];
      if (tid == 0) tot[0] = suf + av[0];
    }
    if (MODE != 0) __syncthreads();
    {
      float suf = 0.f;
      if (MODE == 1) suf = half == 0 ? tot[128 + kn] : 0.f;
      for (int g = 3; g >= 0; --g) {
        const int s0 = half * 32 + g * 8;
        float v[8];
#pragma unroll
        for (int e = 7; e >= 0; --e) {
          const int s = s0 + e;
          const float raw = bf2f(KR[s * 136 + kn]);
          if (MODE == 0) v[e] = raw * exp2f((float)(L - 1 - s) * l2g);
          else if (MODE == 1) { v[e] = (1.f - __expf(raw)) * __expf(suf); suf += raw; }
          else v[e] = raw * dec[s];
        }
        uint4 o; o.x = pack2(v[0], v[1]); o.y = pack2(v[2], v[3]); o.z = pack2(v[4], v[5]); o.w = pack2(v[6], v[7]);
        *(uint4*)(KT + kn * 80 + s0) = o;
      }
    }
    __syncthreads();
#pragma unroll
    for (int mt = 0; mt < 2; ++mt) {
      float dk[4];
      if (MODE == 0) { const float d = exp2f((float)L * l2g); dk[0] = dk[1] = dk[2] = dk[3] = d; }
      else if (MODE == 2) { const float d = __expf(tot[0]); dk[0] = dk[1] = dk[2] = dk[3] = d; }
      else {
#pragma unroll
        for (int j = 0; j < 4; ++j) { const int nn = nb + mt * 16 + j; dk[j] = __expf(tot[nn] + tot[128 + nn]); }
      }
#pragma unroll
      for (int nt = 0; nt < NT; ++nt)
#pragma unroll
        for (int j = 0; j < 4; ++j) acc[mt][nt][j] *= dk[j];
    }
    wmma_ns<2, NT>(acc, KT + wave * 32 * 80, 80, VT, 80, 64, lane);
    __syncthreads();
  }
#pragma unroll
  for (int mt = 0; mt < 2; ++mt)
#pragma unroll
    for (int nt = 0; nt < NT; ++nt)
#pragma unroll
      for (int j = 0; j < 4; ++j) sout[(size_t)(nb + mt * 16 + j) * PF + pc + nt * 16] = acc[mt][nt][j];
}

template <int MODE>
__device__ __forceinline__ void out_unit(const Params& p, int c, int h, char* smem, int wvs) {
  constexpr int PF = (MODE == 2) ? 64 : 128, NTP = PF / 16, HH = (MODE == 2) ? 16 : 4, NVC = PF / 32, VCR = PF / 8;
  bf16_t* Q = (bf16_t*)smem;
  bf16_t* Kb = Q + 64 * 136;
  bf16_t* STb = Kb + 128 * 80;
  float* cumv = (float*)(STb + 128 * 136);
  float* dtv = cumv + 64;
  float* av = dtv + 64;
  float* tot = av + 64;
  int tid_ = TIDX(wvs) & 255; asm volatile("" : "+v"(tid_)); const int tid = tid_, lane = tid & 63, wave = tid >> 6;
  int row0, L; chunk_geom(c, row0, L);
  const int ld = (MODE == 2) ? 1536 : 4096;
  const bf16_t* src = (MODE == 2) ? (const bf16_t*)(p.ws + OFF_H) : (const bf16_t*)(p.ws + OFF_A);
  const int qcol = MODE == 0 ? h * 128 : MODE == 1 ? 2048 + h * 128 : 1280 + (h >> 3) * 128;
  const int kcol = MODE == 0 ? 512 + h * 128 : MODE == 1 ? 2560 + h * 128 : 1024 + (h >> 3) * 128;
  const int vcol = MODE == 0 ? 1024 + h * 128 : MODE == 1 ? 3072 + h * 128 : h * 64;
  const float l2g = MODE == 0 ? log2f(1.f - exp2f(-5.f - (float)h)) : 0.f;
  const uint4 z4 = make_uint4(0, 0, 0, 0);
#pragma unroll
  for (int i = 0; i < 4; ++i) {
    const int id = tid + i * 256, s = id >> 4, c8 = id & 15;
    uint4 q4 = z4, k4 = z4;
    if (s < L) { q4 = *(const uint4*)(src + (size_t)(row0 + s) * ld + qcol + c8 * 8); k4 = *(const uint4*)(src + (size_t)(row0 + s) * ld + kcol + c8 * 8); }
    *(uint4*)(Q + s * 136 + c8 * 8) = q4; *(uint4*)(Kb + s * 136 + c8 * 8) = k4;
  }
  uint4 vr[NVC];
#pragma unroll
  for (int i = 0; i < NVC; ++i) { const int id = tid + i * 256, s = id / VCR, c8 = id % VCR; uint4 t_ = z4; if (s < L) t_ = *(const uint4*)(src + (size_t)(row0 + s) * ld + vcol + c8 * 8); vr[i] = t_; }
  if (c < 256) {
    const bf16_t* stg = (const bf16_t*)(p.ws + OFF_ST) + (MODE == 1 ? (size_t)256 * 4 * 128 * 128 : 0) + ((size_t)(c * HH + h) * PF) * 128;
#pragma unroll
    for (int i = 0; i < PF / 16; ++i) { const int id = tid + i * 256, pr = id >> 4, c8 = id & 15; *(uint4*)(STb + pr * 136 + c8 * 8) = *(const uint4*)(stg + (size_t)pr * 128 + c8 * 8); }
  } else {
    const float* sg = (MODE == 0 ? p.state_ret : MODE == 1 ? p.state_hgrn : p.state_ssm) + (size_t)((c - 256) * HH + h) * 128 * PF;
    for (int id = tid; id < 128 * (PF / 4); id += 256) {
      const int n = id / (PF / 4), p4 = (id % (PF / 4)) * 4;
      const float4 v = *(const float4*)(sg + (size_t)n * PF + p4);
      STb[(p4 + 0) * 136 + n] = f2bf(v.x); STb[(p4 + 1) * 136 + n] = f2bf(v.y); STb[(p4 + 2) * 136 + n] = f2bf(v.z); STb[(p4 + 3) * 136 + n] = f2bf(v.w);
    }
  }
  if (MODE == 2 && tid < 64) {
    float dt = 0.f;
    if (tid < L) { const float x = ((const float*)(p.ws + OFF_DTBUF))[(size_t)(row0 + tid) * 16 + h] + p.dt_bias[h]; dt = x > 20.f ? x : log1pf(__expf(x)); }
    dtv[tid] = dt; av[tid] = -expf(p.a_log[h]) * dt;
  }
  __syncthreads();
  if (MODE == 1) {
    const int kn = tid & 127, half = tid >> 7;
    float s_ = 0.f;
    for (int s = half * 32; s < half * 32 + 32; ++s) s_ += bf2f(Kb[s * 136 + kn]);
    tot[half * 128 + kn] = s_;
    __syncthreads();
    float cum = half == 1 ? tot[kn] : 0.f;
    for (int s = half * 32; s < half * 32 + 32; ++s) {
      const float lf = bf2f(Kb[s * 136 + kn]);
      cum += lf;
      Q[s * 136 + kn] = f2bf(bf2f(Q[s * 136 + kn]) * __expf(cum));
      Kb[s * 136 + kn] = f2bf((1.f - __expf(lf)) * __expf(-cum));
    }
    __syncthreads();
  }
  if (MODE == 2) {
    if (tid < 64) { float cs = 0.f; for (int r = 0; r <= tid; ++r) cs += av[r]; cumv[tid] = cs; }
    __syncthreads();
  }
  f32x4 ai[1][NTP], asc[1][4];
#pragma unroll
  for (int j = 0; j < NTP; ++j) ai[0][j] = (f32x4){0.f, 0.f, 0.f, 0.f};
#pragma unroll
  for (int j = 0; j < 4; ++j) asc[0][j] = (f32x4){0.f, 0.f, 0.f, 0.f};
  wmma_sw<1, NTP>(ai, Q + wave * 16 * 136, 136, STb, 136, 128, lane);
  wmma_sw<1, 4>(asc, Q + wave * 16 * 136, 136, Kb, 136, 128, lane);
  const int t = wave * 16 + (lane & 15), sq4 = (lane >> 4) * 4;
  float ct = 0.f;
  if (MODE == 2) ct = cumv[t];
#pragma unroll
  for (int nt = 0; nt < 4; ++nt)
#pragma unroll
    for (int j = 0; j < 4; ++j) {
      const int s = nt * 16 + sq4 + j;
      float v = asc[0][nt][j];
      if (s > t) v = 0.f;
      else if (MODE == 0) v *= exp2f((float)(t - s) * l2g);
      else if (MODE == 2) v *= __expf(ct - cumv[s]) * dtv[s];
      asc[0][nt][j] = v;
    }
  __syncthreads();
  bf16_t* Pb = STb; bf16_t* VT = Kb;
#pragma unroll
  for (int nt = 0; nt < 4; ++nt) store4bf(Pb + t * 80 + nt * 16 + sq4, asc[0][nt][0], asc[0][nt][1], asc[0][nt][2], asc[0][nt][3]);
#pragma unroll
  for (int i = 0; i < NVC; ++i) {
    const int id = tid + i * 256, s = id / VCR, c8 = id % VCR; const uint4 v = vr[i];
    bf16_t* d = VT + (c8 * 8) * 80 + s;
    d[0] = (bf16_t)(v.x & 0xffff); d[80] = (bf16_t)(v.x >> 16); d[160] = (bf16_t)(v.y & 0xffff); d[240] = (bf16_t)(v.y >> 16);
    d[320] = (bf16_t)(v.z & 0xffff); d[400] = (bf16_t)(v.z >> 16); d[480] = (bf16_t)(v.w & 0xffff); d[560] = (bf16_t)(v.w >> 16);
  }
  __syncthreads();
  f32x4 ao[1][NTP];
#pragma unroll
  for (int j = 0; j < NTP; ++j) ao[0][j] = (f32x4){0.f, 0.f, 0.f, 0.f};
  wmma_sw<1, NTP>(ao, Pb + wave * 16 * 80, 80, VT, 80, 64, lane);
  float fi = 1.f;
  if (MODE == 0) fi = exp2f((float)(t + 1) * l2g);
  if (MODE == 2) fi = __expf(ct);
  const int row = row0 + t;
  const bool valid = t < L;
  if (MODE == 0 || MODE == 1) {
    float s1 = 0.f, s2 = 0.f;
#pragma unroll
    for (int nt = 0; nt < NTP; ++nt)
#pragma unroll
      for (int j = 0; j < 4; ++j) { const float o = ao[0][nt][j] + fi * ai[0][nt][j]; ao[0][nt][j] = o; s1 += o; s2 += o * o; }
    s1 += shx(s1, 16); s1 += shx(s1, 32); s2 += shx(s2, 16); s2 += shx(s2, 32);
    float mu = 0.f, rs;
    if (MODE == 0) { mu = s1 * (1.f / 128.f); const float var = fmaxf(s2 * (1.f / 128.f) - mu * mu, 0.f); rs = rsqrtf(var + EPSV); }
    else rs = rsqrtf(s2 * (1.f / 128.f) + EPSV);
    if (valid) {
      const float* nw = (MODE == 0 ? p.ret_norm_w : p.hgrn_norm_w) + h * 128;
      const int gcol = (MODE == 0 ? 1536 : 3584) + h * 128;
      bf16_t* mix = (bf16_t*)(p.ws + OFF_H) + (size_t)row * 1024 + (MODE == 0 ? 0 : 512) + h * 128;
#pragma unroll
      for (int nt = 0; nt < NTP; ++nt) {
        const int pp = nt * 16 + sq4;
        const float4 w4 = *(const float4*)(nw + pp);
        const uint2 g2 = *(const uint2*)(src + (size_t)row * ld + gcol + pp);
        store4bf(mix + pp, (ao[0][nt][0] - mu) * rs * w4.x * siluf(lo2f(g2.x)), (ao[0][nt][1] - mu) * rs * w4.y * siluf(hi2f(g2.x)),
                 (ao[0][nt][2] - mu) * rs * w4.z * siluf(lo2f(g2.y)), (ao[0][nt][3] - mu) * rs * w4.w * siluf(hi2f(g2.y)));
      }
    }
  } else {
    const float Dh = p.d_ssm[h];
    bf16_t* zy = (bf16_t*)(p.ws + OFF_A) + (size_t)row * 3200 + h * 64;
    float s2 = 0.f;
    if (valid) {
#pragma unroll
      for (int nt = 0; nt < NTP; ++nt) {
        const int pp = nt * 16 + sq4;
        const uint2 x2 = *(const uint2*)(src + (size_t)row * ld + vcol + pp);
        const uint2 z2 = *(const uint2*)(zy + pp);
        const float y0 = (ao[0][nt][0] + fi * ai[0][nt][0] + Dh * lo2f(x2.x)) * siluf(lo2f(z2.x));
        const float y1 = (ao[0][nt][1] + fi * ai[0][nt][1] + Dh * hi2f(x2.x)) * siluf(hi2f(z2.x));
        const float y2 = (ao[0][nt][2] + fi * ai[0][nt][2] + Dh * lo2f(x2.y)) * siluf(lo2f(z2.y));
        const float y3 = (ao[0][nt][3] + fi * ai[0][nt][3] + Dh * hi2f(x2.y)) * siluf(hi2f(z2.y));
        s2 += y0 * y0 + y1 * y1 + y2 * y2 + y3 * y3;
        store4bf(zy + pp, y0, y1, y2, y3);
      }
    }
    s2 += shx(s2, 16); s2 += shx(s2, 32);
    if (valid && lane < 16) atomicAdd((float*)(p.ws + OFF_SSDST) + (size_t)row * 2 + (h >> 3), s2);
  }
  __syncthreads();
}

template <int OUT>
__device__ __forceinline__ void s5_unit(const Params& p, int c, int gq, char* smem, int wvs) {
  float* Uf = (float*)smem;
  bf16_t* HSall = (bf16_t*)(smem + 16384);
  bf16_t* CMall = (bf16_t*)(smem + 16384 + 34816);
  int tid_ = TIDX(wvs) & 255; asm volatile("" : "+v"(tid_)); const int tid = tid_, lane = tid & 63, wave = tid >> 6;
  int row0, L; chunk_geom(c, row0, L);
  const bf16_t* proj = (const bf16_t*)(p.ws + OFF_A);
#pragma unroll
  for (int i = 0; i < 2; ++i) {
    const int id = tid + i * 256, s = id >> 3, c8 = id & 7;
    uint4 v = make_uint4(0, 0, 0, 0);
    if (s < L) v = *(const uint4*)(proj + (size_t)(row0 + s) * 3200 + 2576 + gq * 64 + c8 * 8);
    float* d = Uf + s * 64 + c8 * 8;
    d[0] = lo2f(v.x); d[1] = hi2f(v.x); d[2] = lo2f(v.y); d[3] = hi2f(v.y); d[4] = lo2f(v.z); d[5] = hi2f(v.z); d[6] = lo2f(v.w); d[7] = hi2f(v.w);
  }
  const int g = gq * 4 + wave, gp = g * 64 + lane;
  const float* tab = (const float*)(p.ws + OFF_S5TAB);
  const float lr = tab[gp], li = tab[2048 + gp];
  f32x2 bb2[16];
#pragma unroll
  for (int q = 0; q < 4; ++q) {
    const float4 a = *(const float4*)(tab + 4096 + gp * 16 + q * 4), b = *(const float4*)(tab + 4096 + 32768 + gp * 16 + q * 4);
    bb2[q * 4] = (f32x2){a.x, b.x}; bb2[q * 4 + 1] = (f32x2){a.y, b.y}; bb2[q * 4 + 2] = (f32x2){a.z, b.z}; bb2[q * 4 + 3] = (f32x2){a.w, b.w};
  }
  float hr = 0.f, hi = 0.f;
  bf16_t* HS = HSall + wave * 32 * 136; bf16_t* CM = CMall + wave * 16 * 136;
  if (OUT) {
    const float2 h0 = *(const float2*)((const float*)(p.ws + OFF_S5H) + ((size_t)c * 2048 + gp) * 2);
    hr = h0.x; hi = h0.y;
#pragma unroll
    for (int ch = 0; ch < 16; ++ch) { CM[ch * 136 + lane] = f2bf(p.s5_c_re[(g * 16 + ch) * 64 + lane]); CM[ch * 136 + 64 + lane] = f2bf(-p.s5_c_im[(g * 16 + ch) * 64 + lane]); }
  }
  __syncthreads();
  const int nhalf = OUT ? ((L + 31) >> 5) : 1, tl = OUT ? 32 : L;
  for (int hf = 0; hf < nhalf; ++hf) {
#pragma unroll 4
    for (int tt = 0; tt < tl; ++tt) {
      const int t = hf * 32 + tt;
      {
        const float* up = Uf + t * 64 + wave * 16;
        f32x2 b0 = (f32x2){0.f, 0.f}, b1 = (f32x2){0.f, 0.f};
#pragma unroll
        for (int q = 0; q < 4; ++q) {
          const f32x4 u4 = *(const f32x4*)(up + q * 4);
          b0 += bb2[q * 4] * u4[0]; b1 += bb2[q * 4 + 1] * u4[1]; b0 += bb2[q * 4 + 2] * u4[2]; b1 += bb2[q * 4 + 3] * u4[3];
        }
        b0 += b1;
        const float nr = lr * hr - li * hi + b0[0], ni = lr * hi + li * hr + b0[1];
        if (t < L) { hr = nr; hi = ni; }
      }
      if (OUT) { HS[tt * 136 + lane] = f2bf(t < L ? hr : 0.f); HS[tt * 136 + 64 + lane] = f2bf(t < L ? hi : 0.f); }
    }
    if (OUT) {
      __syncthreads();
      f32x4 ay[2][1];
      ay[0][0] = (f32x4){0.f, 0.f, 0.f, 0.f}; ay[1][0] = (f32x4){0.f, 0.f, 0.f, 0.f};
      wmma_sw<2, 1>(ay, HS, 136, CM, 136, 128, lane);
      bf16_t* gbuf = (bf16_t*)(p.ws + OFF_GBUF);
#pragma unroll
      for (int mt = 0; mt < 2; ++mt) {
        const int t = hf * 32 + mt * 16 + (lane & 15), ch0 = (lane >> 4) * 4;
        if (t < L) {
          const float4 u4 = *(const float4*)(Uf + t * 64 + wave * 16 + ch0);
          const float4 d4 = *(const float4*)(p.s5_d + g * 16 + ch0);
          float y[4] = {ay[mt][0][0] + d4.x * u4.x, ay[mt][0][1] + d4.y * u4.y, ay[mt][0][2] + d4.z * u4.z, ay[mt][0][3] + d4.w * u4.w};
#pragma unroll
          for (int j = 0; j < 4; ++j) { const float x = y[j], uu = 0.7978845608028654f * (x + 0.044715f * x * x * x); y[j] = x / (1.f + __expf(-2.f * uu)); }
          store4bf(gbuf + (size_t)(row0 + t) * 512 + g * 16 + ch0, y[0], y[1], y[2], y[3]);
        }
      }
      __syncthreads();
    }
  }
  if (!OUT) { *(float2*)((float*)(p.ws + OFF_S5E) + ((size_t)c * 2048 + gp) * 2) = make_float2(hr, hi); }
  __syncthreads();
}

__device__ __forceinline__ void s5_prefix(const Params& p, int gt) {
  const int sq = gt >> 11, rem = gt & 2047;
  const float* tab = (const float*)(p.ws + OFF_S5TAB);
  const float* e = (const float*)(p.ws + OFF_S5E);
  float* hs = (float*)(p.ws + OFF_S5H);
  float hr = 0.f, hi = 0.f;
  if (sq < 8) {
    const float lr = tab[69632 + rem], li = tab[71680 + rem];
    for (int n = 0; n < 32; ++n) {
      const size_t idx = ((size_t)(sq * 32 + n) * 2048 + rem) * 2;
      *(float2*)(hs + idx) = make_float2(hr, hi);
      const float2 ev = *(const float2*)(e + idx);
      const float nr = lr * hr - li * hi + ev.x, ni = lr * hi + li * hr + ev.y; hr = nr; hi = ni;
    }
  } else {
    const float lr = tab[73728 + rem], li = tab[75776 + rem];
    hr = p.state_s5_re[(size_t)(sq - 8) * 2048 + rem]; hi = p.state_s5_im[(size_t)(sq - 8) * 2048 + rem];
    const size_t idx = ((size_t)(256 + sq - 8) * 2048 + rem) * 2;
    *(float2*)(hs + idx) = make_float2(hr, hi);
    const float2 ev = *(const float2*)(e + idx);
    const float nr = lr * hr - li * hi + ev.x, ni = lr * hi + li * hr + ev.y; hr = nr; hi = ni;
  }
  p.out[O_S5RE + (size_t)sq * 2048 + rem] = hr;
  p.out[O_S5IM + (size_t)sq * 2048 + rem] = hi;
}

__device__ __forceinline__ void conv_phase(const Params& p, int wvs) {
  const bf16_t* proj = (const bf16_t*)(p.ws + OFF_A);
  bf16_t* xc = (bf16_t*)(p.ws + OFF_H);
  int tq_ = TIDX(wvs); asm volatile("" : "+v"(tq_)); const int gt = blockIdx.x * NTHR + tq_, nt = gridDim.x * NTHR;
  for (int task = gt; task < 544 * 192; task += nt) {
    const int seg = task / 192, c = (task - seg * 192) * 8, rowb = seg * 32;
    float w[4][8], bia[8];
#pragma unroll
    for (int j = 0; j < 4; ++j) {
      const float4 w0 = *(const float4*)(p.conv_w + j * 1536 + c), w1 = *(const float4*)(p.conv_w + j * 1536 + c + 4);
      w[j][0] = w0.x; w[j][1] = w0.y; w[j][2] = w0.z; w[j][3] = w0.w; w[j][4] = w1.x; w[j][5] = w1.y; w[j][6] = w1.z; w[j][7] = w1.w;
    }
    { const float4 b0 = *(const float4*)(p.conv_b + c), b1 = *(const float4*)(p.conv_b + c + 4); bia[0] = b0.x; bia[1] = b0.y; bia[2] = b0.z; bia[3] = b0.w; bia[4] = b1.x; bia[5] = b1.y; bia[6] = b1.z; bia[7] = b1.w; }
    float x0[8], x1[8], x2[8];
    if (rowb < 16384 && (rowb & 2047) != 0) {
      const u32x4 v0 = *(const u32x4*)(proj + (size_t)(rowb - 3) * 3200 + 1024 + c), v1 = *(const u32x4*)(proj + (size_t)(rowb - 2) * 3200 + 1024 + c), v2 = *(const u32x4*)(proj + (size_t)(rowb - 1) * 3200 + 1024 + c);
#pragma unroll
      for (int e = 0; e < 4; ++e) { x0[2 * e] = lo2f(v0[e]); x0[2 * e + 1] = hi2f(v0[e]); x1[2 * e] = lo2f(v1[e]); x1[2 * e + 1] = hi2f(v1[e]); x2[2 * e] = lo2f(v2[e]); x2[2 * e + 1] = hi2f(v2[e]); }
    } else {
#pragma unroll
      for (int e = 0; e < 8; ++e) { x0[e] = 0.f; x1[e] = 0.f; x2[e] = 0.f; }
    }
    u32x4 nxt = *(const u32x4*)(proj + (size_t)rowb * 3200 + 1024 + c);
    for (int r = 0; r < 32; ++r) {
      const int row = rowb + r;
      const u32x4 cv = nxt;
      if (r + 1 < 32) nxt = *(const u32x4*)(proj + (size_t)(row + 1) * 3200 + 1024 + c);
      int t, T, sq;
      if (row < 16384) { t = row & 2047; T = 2048; sq = row >> 11; } else { t = (row - 16384) & 7; T = 8; sq = 8 + ((row - 16384) >> 3); }
      if (t == 0) {
        if (sq >= 8) {
          const float* sc = p.state_conv + (size_t)(sq - 8) * 3 * 1536 + c;
          const float4 a0 = *(const float4*)sc, a1 = *(const float4*)(sc + 4), b0 = *(const float4*)(sc + 1536), b1 = *(const float4*)(sc + 1540), c0 = *(const float4*)(sc + 3072), c1 = *(const float4*)(sc + 3076);
          x0[0] = a0.x; x0[1] = a0.y; x0[2] = a0.z; x0[3] = a0.w; x0[4] = a1.x; x0[5] = a1.y; x0[6] = a1.z; x0[7] = a1.w;
          x1[0] = b0.x; x1[1] = b0.y; x1[2] = b0.z; x1[3] = b0.w; x1[4] = b1.x; x1[5] = b1.y; x1[6] = b1.z; x1[7] = b1.w;
          x2[0] = c0.x; x2[1] = c0.y; x2[2] = c0.z; x2[3] = c0.w; x2[4] = c1.x; x2[5] = c1.y; x2[6] = c1.z; x2[7] = c1.w;
        } else {
#pragma unroll
          for (int e = 0; e < 8; ++e) { x0[e] = 0.f; x1[e] = 0.f; x2[e] = 0.f; }
        }
      }
      float cur[8], o[8];
#pragma unroll
      for (int e = 0; e < 4; ++e) { cur[2 * e] = lo2f(cv[e]); cur[2 * e + 1] = hi2f(cv[e]); }
#pragma unroll
      for (int e = 0; e < 8; ++e) { o[e] = siluf(bia[e] + w[0][e] * x0[e] + w[1][e] * x1[e] + w[2][e] * x2[e] + w[3][e] * cur[e]); x0[e] = x1[e]; x1[e] = x2[e]; x2[e] = cur[e]; }
      u32x4 ov; ov[0] = pack2(o[0], o[1]); ov[1] = pack2(o[2], o[3]); ov[2] = pack2(o[4], o[5]); ov[3] = pack2(o[6], o[7]);
      *(u32x4*)(xc + (size_t)row * 1536 + c) = ov;
      if (t >= T - 3) {
        float* d = p.out + O_CONV + ((size_t)sq * 3 + (t - (T - 3))) * 1536 + c;
        *(float4*)d = make_float4(cur[0], cur[1], cur[2], cur[3]); *(float4*)(d + 4) = make_float4(cur[4], cur[5], cur[6], cur[7]);
      }
    }
  }
}

__device__ __forceinline__ void ssdnorm_phase(const Params& p, int wvs) {
  const bf16_t* proj = (const bf16_t*)(p.ws + OFF_A);
  bf16_t* mix = (bf16_t*)(p.ws + OFF_H);
  const float* st = (const float*)(p.ws + OFF_SSDST);
  int tq_ = TIDX(wvs); asm volatile("" : "+v"(tq_)); const int gt = blockIdx.x * NTHR + tq_, nt = gridDim.x * NTHR;
  for (int it = gt; it < ROWS * 128; it += nt) {
    const int row = it >> 7, c = (it & 127) * 8;
    const float r = rsqrtf(st[(size_t)row * 2 + (c >> 9)] * (1.f / 512.f) + EPSV);
    const uint4 v = *(const uint4*)(proj + (size_t)row * 3200 + c);
    const float4 w0 = *(const float4*)(p.ssm_norm_w + c), w1 = *(const float4*)(p.ssm_norm_w + c + 4);
    uint4 o; o.x = pack2(lo2f(v.x) * r * w0.x, hi2f(v.x) * r * w0.y); o.y = pack2(lo2f(v.y) * r * w0.z, hi2f(v.y) * r * w0.w);
    o.z = pack2(lo2f(v.z) * r * w1.x, hi2f(v.z) * r * w1.y); o.w = pack2(lo2f(v.w) * r * w1.z, hi2f(v.w) * r * w1.w);
    *(uint4*)(mix + (size_t)row * 1536 + c) = o;
  }
}


#define XB_TMO      128
#define XB_XCNT(j)  (256  + 64 * (j))
#define XB_XSUB(j)  (1280 + 64 * (j))
#define XB_XGEN(j)  (2304 + 64 * (j))
#define XB_TOP      3328
#define XB_TOPGEN   3392
#define XCD_BAR_WORDS 3456
#define XB_SPIN_CAP (1u << 18)
#define LAS __attribute__((address_space(3)))
__device__ __forceinline__ unsigned xb_ld(unsigned* p)              { return __hip_atomic_load(p, __ATOMIC_RELAXED, __HIP_MEMORY_SCOPE_AGENT); }
__device__ __forceinline__ unsigned xb_add(unsigned* p, unsigned v) { return __hip_atomic_fetch_add(p, v, __ATOMIC_RELAXED, __HIP_MEMORY_SCOPE_AGENT); }
__device__ __forceinline__ unsigned xb_xcc_id() { return (unsigned)__builtin_amdgcn_s_getreg((3 << 11) | 20) & 0xFu; }
#define XB_SPIN(cond, bar) do { unsigned _sp = 0; while (cond) { __builtin_amdgcn_s_sleep(1); \
    if ((++_sp & 255u) == 0u) { if (xb_ld(&(bar)[XB_TMO])) break; if (_sp > XB_SPIN_CAP) { atomicAdd(&(bar)[XB_TMO], 1u); break; } } } } while (0)
struct XcdBarrier { unsigned* bar; unsigned x; volatile LAS unsigned* st; };
__device__ __forceinline__ XcdBarrier xcd_barrier_post(unsigned* bar, volatile LAS unsigned* st, int wvs) {
    XcdBarrier b; b.bar = bar; b.x = xb_xcc_id(); b.st = st;
    if (TIDX(wvs) == 0) (void)xb_add(&bar[XB_XCNT(b.x)], 1u);
    return b;
}
__device__ __forceinline__ void xcd_barrier_complete(unsigned* bar, unsigned x, unsigned& nloc, unsigned& nx) {
    const unsigned G = gridDim.x * gridDim.y * gridDim.z;
    unsigned sum, cnt, mine, sp = 0u;
    for (;;) {
        sum = 0u; cnt = 0u; mine = 0u;
#pragma unroll
        for (unsigned j = 0; j < 16; ++j) { const unsigned c = xb_ld(&bar[XB_XCNT(j)]); sum += c; cnt += (c > 0u) ? 1u : 0u; mine = (j == x) ? c : mine; }
        if (sum == G) break;
        __builtin_amdgcn_s_sleep(1);
        if ((++sp & 255u) == 0u) { if (xb_ld(&bar[XB_TMO])) break; if (sp > XB_SPIN_CAP) { atomicAdd(&bar[XB_TMO], 1u); break; } }
    }
    nloc = mine > 0u ? mine : 1u; nx = cnt > 0u ? cnt : 1u;
}
__device__ __forceinline__ void xcd_barrier(const XcdBarrier& b, int wvs) {
    asm volatile("s_waitcnt vmcnt(0)" ::: "memory");
    __syncthreads();
    if (TIDX(wvs) == 0) {
        unsigned* bar = b.bar;
        __builtin_amdgcn_s_waitcnt(0);
        unsigned nloc = b.st[0], nx = b.st[1];
        if (nloc == 0u) { xcd_barrier_complete(bar, b.x, nloc, nx); b.st[0] = nloc; b.st[1] = nx; }
        const unsigned old = xb_add(&bar[XB_XSUB(b.x)], 1u);
        const unsigned gen = old / nloc;
        if (old + 1u == (gen + 1u) * nloc) {
            __builtin_amdgcn_fence(__ATOMIC_RELEASE, "agent");
            asm volatile("s_waitcnt vmcnt(0)" ::: "memory");
            const unsigned og = xb_add(&bar[XB_TOP], 1u);
            const unsigned tg = og / nx;
            if (og + 1u == (tg + 1u) * nx) xb_add(&bar[XB_TOPGEN], 1u);
            else XB_SPIN(xb_ld(&bar[XB_TOPGEN]) == tg, bar);
            __builtin_amdgcn_fence(__ATOMIC_ACQUIRE, "agent");
            xb_add(&bar[XB_XGEN(b.x)], 1u);
            asm volatile("s_waitcnt vmcnt(0)" ::: "memory");
        } else {
            XB_SPIN(xb_ld(&bar[XB_XGEN(b.x)]) == gen, bar);
            __builtin_amdgcn_fence(__ATOMIC_ACQUIRE, "agent");
            asm volatile("s_waitcnt vmcnt(0)" ::: "memory");
        }
    }
    __syncthreads();
}


__device__ __forceinline__ Params ldp() {
  auto kp = __builtin_amdgcn_kernarg_segment_ptr();
  asm volatile("" : "+s"(kp));
  Params q;
  __builtin_memcpy(&q, (const void*)kp, sizeof(Params));
  return q;
}

__global__ void __launch_bounds__(NTHR, 2) fwd_megakernel(Params p_) {
  extern __shared__ __attribute__((aligned(16))) char smem[];
  cg::grid_group grid = cg::this_grid();
  if (p_.ws == nullptr) grid.sync();
  volatile LAS unsigned* xst = (volatile LAS unsigned*)(smem + 2 * HALF_LDS);
  const int wvs = __builtin_amdgcn_readfirstlane(threadIdx.x >> 6);
  if (TIDX(wvs) == 0) { xst[0] = 0u; xst[1] = 0u; xst[2] = 0u; xst[3] = 0u; }
  __syncthreads();
  const XcdBarrier xb = xcd_barrier_post((unsigned*)(p_.ws + OFF_BAR), xst, wvs);
  const int half = wvs >> 2;
  const int G = gridDim.x * 2, bid = blockIdx.x * 2 + half;
  char* hs = smem + half * HALF_LDS;
#define PH_BEGIN const Params p = ldp(); bf16_t* bufA = (bf16_t*)(p.ws + OFF_A); bf16_t* bufH = (bf16_t*)(p.ws + OFF_H); bf16_t* t0 = (bf16_t*)(p.ws + OFF_ST); \
    float* rowss = (float*)(p.ws + OFF_ROWSS); float* hbuf = p.out; (void)bufA; (void)bufH; (void)t0; (void)rowss; (void)hbuf;

  {
  PH_BEGIN
  prep_tables(p, wvs);
  wconv(p.w_in_even, 1024, 4096, 4096, (bf16_t*)(p.ws + W_IN), hs, wvs);
  wconv(p.w_out_even, 1024, 1024, 1024, (bf16_t*)(p.ws + W_OUT0), hs, wvs);
  wconv(p.w_ffn_up, 1024, 4096, 4096, (bf16_t*)(p.ws + W_UP), hs, wvs);
  wconv(p.w_ffn_down, 4096, 1024, 1024, (bf16_t*)(p.ws + W_DOWN), hs, wvs);
  rowpass_phase(nullptr, nullptr, nullptr, p.x_prompt, p.x_sample, nullptr, p.norm_mix_pre, bufH, wvs);
  }
  xcd_barrier(xb, wvs);
  {
  PH_BEGIN
  { EpiInEven e{bufA, (const float*)(p.ws + OFF_ROPE), (const float*)(p.ws + OFF_LB)};
    for (int rep_ = 0; rep_ < REPG; ++rep_) { gemm_phase(bufH, 1024, (const bf16_t*)(p.ws + W_IN), 1024, 64, 16, 1024, e, smem, wvs); gemm_tail(bufH, 1024, (const bf16_t*)(p.ws + W_IN), 1024, 32, 1024, e, smem, wvs, 64 * 16); } }
  }
  xcd_barrier(xb, wvs);
  {
  PH_BEGIN
  for (int rep_ = 0; rep_ < REPS; ++rep_) {
    if (bid < 256) {
      const int v = bid;
      const int ps = v & 3, m = (v >> 2) & 1, h = (v >> 3) & 3, sq = v >> 5;
      if (m == 0) state_unit<0>(p, sq, h, ps, hs, wvs); else state_unit<1>(p, sq, h, ps, hs, wvs);
    }
    const int nsh = bid < 256 ? 2 : 14, j0 = bid < 256 ? bid : 512 + (bid - 256);
    for (int i = 0; i < nsh; ++i) {
      const int v = j0 + 256 * i;
      const int ps = v & 3, m = (v >> 2) & 1, h = (v >> 3) & 3, sq = 8 + (v >> 5);
      if (m == 0) state_unit<0>(p, sq, h, ps, hs, wvs); else state_unit<1>(p, sq, h, ps, hs, wvs);
    }
  }
  }
  xcd_barrier(xb, wvs);
  {
  PH_BEGIN
  for (int rep_ = 0; rep_ < REPO; ++rep_)
  for (int u = bid; u < 384 * 8; u += G) {
    const int h = u & 3, m = (u >> 2) & 1, c = u >> 3;
    if (m == 0) out_unit<0>(p, c, h, hs, wvs); else out_unit<1>(p, c, h, hs, wvs);
  }
  }
  xcd_barrier(xb, wvs);
  {
  PH_BEGIN
  { EpiOut e{t0, rowss};
    for (int rep_ = 0; rep_ < REPG; ++rep_) { gemm_phase(bufH, 1024, (const bf16_t*)(p.ws + W_OUT0), 1024, 64, 4, 1024, e, smem, wvs); gemm_tail(bufH, 1024, (const bf16_t*)(p.ws + W_OUT0), 1024, 8, 1024, e, smem, wvs, 64 * 4); } }
  }
  xcd_barrier(xb, wvs);
  {
  PH_BEGIN
  for (int rep_ = 0; rep_ < REPR; ++rep_)
  rowpass_phase(t0, rowss, p.norm_mix_post, p.x_prompt, p.x_sample, hbuf, p.norm_ffn_pre, bufH, wvs);
  }
  xcd_barrier(xb, wvs);
  {
  PH_BEGIN
  { EpiUp e{bufA}; for (int rep_ = 0; rep_ < REPG; ++rep_) { gemm_phase(bufH, 1024, (const bf16_t*)(p.ws + W_UP), 1024, 64, 16, 1024, e, smem, wvs); gemm_tail(bufH, 1024, (const bf16_t*)(p.ws + W_UP), 1024, 32, 1024, e, smem, wvs, 64 * 16); } }
  }
  xcd_barrier(xb, wvs);
  {
  PH_BEGIN
  { EpiOut e{t0, rowss + ROWS}; for (int rep_ = 0; rep_ < REPG; ++rep_) { gemm_phase(bufA, 4096, (const bf16_t*)(p.ws + W_DOWN), 4096, 64, 4, 4096, e, smem, wvs); gemm_tail(bufA, 4096, (const bf16_t*)(p.ws + W_DOWN), 4096, 8, 4096, e, smem, wvs, 64 * 4); } }
  }
  xcd_barrier(xb, wvs);
  {
  PH_BEGIN
  rowpass_phase(t0, rowss + ROWS, p.norm_ffn_post, hbuf, hbuf + (size_t)16384 * 1024, hbuf, p.norm_mix_pre + 1024, bufH, wvs);
  wconv(p.w_in_odd, 1024, 3088, 3328, (bf16_t*)(p.ws + W_IN), hs, wvs);
  wconv(p.w_glu, 512, 512, 512, (bf16_t*)(p.ws + W_GLU), hs, wvs);
  wconv(p.w_out_odd, 1536, 1024, 1024, (bf16_t*)(p.ws + W_OUT1), hs, wvs);
  wconv(p.w_ffn_up + (size_t)1024 * 4096, 1024, 4096, 4096, (bf16_t*)(p.ws + W_UP), hs, wvs);
  wconv(p.w_ffn_down + (size_t)4096 * 1024, 4096, 1024, 1024, (bf16_t*)(p.ws + W_DOWN), hs, wvs);
  }
  xcd_barrier(xb, wvs);
  {
  PH_BEGIN
  { EpiInOdd e{bufA, (float*)(p.ws + OFF_DTBUF)};
    for (int rep_ = 0; rep_ < REPG; ++rep_) { gemm_phase(bufH, 1024, (const bf16_t*)(p.ws + W_IN), 1024, 64, 13, 1024, e, smem, wvs); gemm_tail(bufH, 1024, (const bf16_t*)(p.ws + W_IN), 1024, 26, 1024, e, smem, wvs, 64 * 13); } }
  }
  xcd_barrier(xb, wvs);
  {
  PH_BEGIN
  for (int rep_ = 0; rep_ < REPC; ++rep_) {
  conv_phase(p, wvs);
  for (int u = bid; u < 384 * 8; u += G) s5_unit<0>(p, u >> 3, u & 7, hs, wvs);
  }
  }
  xcd_barrier(xb, wvs);
  {
  PH_BEGIN
  for (int rep_ = 0; rep_ < REPS; ++rep_) {
    if (bid < 128) state_unit<2>(p, bid >> 4, bid & 15, 0, hs, wvs);
    for (int j = bid < 128 ? bid : 256 + (bid - 128); j < 3136; j += (bid < 128 ? 128 : 384)) {
      if (bid < 128 && j >= 256) break;
      if (j < 1088) { int tq_ = TIDX(wvs) & 255; asm volatile("" : "+v"(tq_)); s5_prefix(p, j * 256 + tq_); }
      else { const int v = j - 1088; state_unit<2>(p, 8 + (v >> 4), v & 15, 0, hs, wvs); }
    }
  }
  }
  xcd_barrier(xb, wvs);
  {
  PH_BEGIN
  for (int u = bid; u < 384 * 16 + 384 * 8; u += G) {
    if (u < 384 * 16) out_unit<2>(p, u >> 4, u & 15, hs, wvs);
    else { const int v = u - 384 * 16; s5_unit<1>(p, v >> 3, v & 7, hs, wvs); }
  }
  }
  xcd_barrier(xb, wvs);
  {
  PH_BEGIN
  ssdnorm_phase(p, wvs);
  { EpiGlu e{(const bf16_t*)(p.ws + OFF_GBUF), p.b_glu, bufH};
    for (int rep_ = 0; rep_ < REPG; ++rep_) { gemm_phase((const bf16_t*)(p.ws + OFF_GBUF), 512, (const bf16_t*)(p.ws + W_GLU), 512, 64, 2, 512, e, smem, wvs); gemm_tail((const bf16_t*)(p.ws + OFF_GBUF), 512, (const bf16_t*)(p.ws + W_GLU), 512, 4, 512, e, smem, wvs, 64 * 2); } }
  }
  xcd_barrier(xb, wvs);
  {
  PH_BEGIN
  { EpiOut e{t0, rowss + 2 * ROWS}; for (int rep_ = 0; rep_ < REPG; ++rep_) { gemm_phase(bufH, 1536, (const bf16_t*)(p.ws + W_OUT1), 1536, 64, 4, 1536, e, smem, wvs); gemm_tail(bufH, 1536, (const bf16_t*)(p.ws + W_OUT1), 1536, 8, 1536, e, smem, wvs, 64 * 4); } }
  }
  xcd_barrier(xb, wvs);
  {
  PH_BEGIN
  rowpass_phase(t0, rowss + 2 * ROWS, p.norm_mix_post + 1024, hbuf, hbuf + (size_t)16384 * 1024, hbuf, p.norm_ffn_pre + 1024, bufH, wvs);
  }
  xcd_barrier(xb, wvs);
  {
  PH_BEGIN
  { EpiUp e{bufA}; for (int rep_ = 0; rep_ < REPG; ++rep_) { gemm_phase(bufH, 1024, (const bf16_t*)(p.ws + W_UP), 1024, 64, 16, 1024, e, smem, wvs); gemm_tail(bufH, 1024, (const bf16_t*)(p.ws + W_UP), 1024, 32, 1024, e, smem, wvs, 64 * 16); } }
  }
  xcd_barrier(xb, wvs);
  {
  PH_BEGIN
  { EpiOut e{t0, rowss + 3 * ROWS}; for (int rep_ = 0; rep_ < REPG; ++rep_) { gemm_phase(bufA, 4096, (const bf16_t*)(p.ws + W_DOWN), 4096, 64, 4, 4096, e, smem, wvs); gemm_tail(bufA, 4096, (const bf16_t*)(p.ws + W_DOWN), 4096, 8, 4096, e, smem, wvs, 64 * 4); } }
  }
  xcd_barrier(xb, wvs);
  {
  PH_BEGIN
  rowpass_phase(t0, rowss + 3 * ROWS, p.norm_ffn_post + 1024, hbuf, hbuf + (size_t)16384 * 1024, hbuf, nullptr, nullptr, wvs);
  }
}

extern "C" void kernel_launch(void* const* d_in, const int* in_sizes, int n_in, void* d_out, int out_size, void* d_ws, size_t ws_size, hipStream_t stream) {
  constexpr size_t kDynLds = 2 * HALF_LDS + 64;
  static int grid_blocks = 0;
  if (!grid_blocks) {
    int dev = 0, cus = 0, per_cu = 0;
    (void)hipGetDevice(&dev);
    (void)hipDeviceGetAttribute(&cus, hipDeviceAttributeMultiprocessorCount, dev);
    (void)hipFuncSetAttribute((const void*)fwd_megakernel, hipFuncAttributeMaxDynamicSharedMemorySize, (int)kDynLds);
    (void)hipOccupancyMaxActiveBlocksPerMultiprocessor(&per_cu, fwd_megakernel, NTHR, kDynLds);
    if (per_cu > 1) per_cu = 1;
    if (per_cu < 1) per_cu = 1;
    grid_blocks = cus * per_cu;
  }
  Params p{};
  const float** pf = (const float**)&p;
  for (int i = 0; i < 37; ++i) pf[i] = (const float*)d_in[i];
  p.out = (float*)d_out;
  p.ws = (char*)d_ws;
  (void)hipMemsetAsync((char*)d_ws + OFF_BAR, 0, 16384, stream);
  void* args[] = {&p};
  hipError_t e = hipLaunchCooperativeKernel((void*)fwd_megakernel, dim3(grid_blocks), dim3(NTHR), args, kDynLds, stream);
  if (e != hipSuccess) fprintf(stderr, "cooperative launch failed: %s (grid %d)\n", hipGetErrorString(e), grid_blocks);
}
```

```cpp
#include <hip/hip_runtime.h>
#include <hip/hip_cooperative_groups.h>
#include <cstdio>
namespace cg = cooperative_groups;

typedef unsigned short bf16_t;
typedef short bf16x8 __attribute__((ext_vector_type(8)));
typedef float f32x4 __attribute__((ext_vector_type(4)));
typedef unsigned u32x4 __attribute__((ext_vector_type(4)));
typedef float f32x2 __attribute__((ext_vector_type(2)));

#define NTHR 512
#ifndef REPS
#define REPS 1
#endif
#ifndef REPO
#define REPO 1
#endif
#ifndef REPC
#define REPC 1
#endif
#ifndef REPR
#define REPR 1
#endif
#ifndef REPG
#define REPG 1
#endif
#define HALF_LDS 74752
#ifndef REP0
#define REP0 1
#endif
#ifndef REPS
#define REPS 1
#endif
#ifndef REPO
#define REPO 1
#endif
#ifndef REPC
#define REPC 1
#endif
#ifndef REPY
#define REPY 21
#endif
#define ROWS 17408
#define EPSV 1e-6f
#define TIDX(w) ((w) * 64 + (int)__builtin_amdgcn_mbcnt_hi(~0u, __builtin_amdgcn_mbcnt_lo(~0u, 0u)))

constexpr size_t W_IN = 0;
constexpr size_t W_OUT0 = 8388608;
constexpr size_t W_GLU = 6815744;
constexpr size_t W_OUT1 = 7340032;
constexpr size_t W_UP = 10485760;
constexpr size_t W_DOWN = 18874368;
constexpr size_t OFF_A = 29360128;
constexpr size_t OFF_GBUF = OFF_A + 111411200;
constexpr size_t OFF_ST = OFF_A + 142606336;
constexpr size_t OFF_H = OFF_ST + 67108864;
constexpr size_t OFF_SM = OFF_H + 53477376;
constexpr size_t OFF_ROPE = OFF_SM;
constexpr size_t OFF_ROWSS = OFF_SM + 1052672;
constexpr size_t OFF_SSDST = OFF_SM + 1331200;
constexpr size_t OFF_DTBUF = OFF_SM + 1470464;
constexpr size_t OFF_LB = OFF_SM + 2584576;
constexpr size_t OFF_S5TAB = OFF_SM + 2586624;
constexpr size_t OFF_S5E = OFF_SM + 2897920;
constexpr size_t OFF_S5H = OFF_SM + 9189376;
constexpr size_t OFF_BAR = OFF_SM + 15480832;

constexpr size_t O_RET = 17825792, O_HG = 26738688, O_SSM = 35651584, O_CONV = 53477376, O_S5RE = 54104064, O_S5IM = 54382592;

struct Params {
  const float *x_prompt, *x_sample, *state_ret, *state_hgrn, *state_ssm, *state_conv, *state_s5_re, *state_s5_im;
  const float *norm_mix_pre, *norm_mix_post, *norm_ffn_pre, *norm_ffn_post;
  const float *w_in_even, *w_out_even, *ret_norm_w, *hgrn_lb, *hgrn_norm_w, *w_in_odd, *conv_w, *conv_b, *dt_bias, *a_log, *d_ssm, *ssm_norm_w;
  const float *s5_lam_re, *s5_lam_im, *s5_log_step, *s5_b_re, *s5_b_im, *s5_c_re, *s5_c_im, *s5_d, *w_glu, *b_glu, *w_out_odd, *w_ffn_up, *w_ffn_down;
  float* out;
  char* ws;
};

__device__ __forceinline__ bf16_t f2bf(float f) { unsigned r; asm("v_cvt_pk_bf16_f32 %0, %1, %1" : "=v"(r) : "v"(f)); return (bf16_t)(r & 0xffffu); }
__device__ __forceinline__ float bf2f(bf16_t h) { return __uint_as_float(((unsigned)h) << 16); }
__device__ __forceinline__ unsigned pack2(float a, float b) { unsigned r; asm("v_cvt_pk_bf16_f32 %0, %1, %2" : "=v"(r) : "v"(a), "v"(b)); return r; }
__device__ __forceinline__ float lo2f(unsigned u) { return __uint_as_float(u << 16); }
__device__ __forceinline__ float hi2f(unsigned u) { return __uint_as_float(u & 0xffff0000u); }
__device__ __forceinline__ float sigm(float x) { return 1.f / (1.f + __expf(-x)); }
__device__ __forceinline__ float siluf(float x) { return x / (1.f + __expf(-x)); }
__device__ __forceinline__ void store4bf(bf16_t* p, float a, float b, float c, float d) { uint2 v; v.x = pack2(a, b); v.y = pack2(c, d); *(uint2*)p = v; }

__device__ __forceinline__ float shx(float v, int mask) {
  int l = (int)__builtin_amdgcn_mbcnt_hi(~0u, __builtin_amdgcn_mbcnt_lo(~0u, 0u));
  asm volatile("" : "+v"(l));
  return __int_as_float(__builtin_amdgcn_ds_bpermute((l ^ mask) << 2, __float_as_int(v)));
}

template <int MT, int NT>
__device__ __forceinline__ void wmma_sw(f32x4 (&acc)[MT][NT], const bf16_t* A, int lda, const bf16_t* B, int ldb, int K, int lane) {
  const int r = lane & 15, kq = (lane >> 4) * 8;
  for (int k0 = 0; k0 < K; k0 += 32) {
    bf16x8 af[MT], bfr[NT];
#pragma unroll
    for (int mt = 0; mt < MT; ++mt) af[mt] = *(const bf16x8*)(A + (mt * 16 + r) * lda + k0 + kq);
#pragma unroll
    for (int nt = 0; nt < NT; ++nt) bfr[nt] = *(const bf16x8*)(B + (nt * 16 + r) * ldb + k0 + kq);
#pragma unroll
    for (int mt = 0; mt < MT; ++mt)
#pragma unroll
      for (int nt = 0; nt < NT; ++nt) acc[mt][nt] = __builtin_amdgcn_mfma_f32_16x16x32_bf16(bfr[nt], af[mt], acc[mt][nt], 0, 0, 0);
  }
}
template <int MT, int NT>
__device__ __forceinline__ void wmma_ns(f32x4 (&acc)[MT][NT], const bf16_t* A, int lda, const bf16_t* B, int ldb, int K, int lane) {
  const int r = lane & 15, kq = (lane >> 4) * 8;
  for (int k0 = 0; k0 < K; k0 += 32) {
    bf16x8 af[MT], bfr[NT];
#pragma unroll
    for (int mt = 0; mt < MT; ++mt) af[mt] = *(const bf16x8*)(A + (mt * 16 + r) * lda + k0 + kq);
#pragma unroll
    for (int nt = 0; nt < NT; ++nt) bfr[nt] = *(const bf16x8*)(B + (nt * 16 + r) * ldb + k0 + kq);
#pragma unroll
    for (int mt = 0; mt < MT; ++mt)
#pragma unroll
      for (int nt = 0; nt < NT; ++nt) acc[mt][nt] = __builtin_amdgcn_mfma_f32_16x16x32_bf16(af[mt], bfr[nt], acc[mt][nt], 0, 0, 0);
  }
}

__device__ __forceinline__ void gemm_kstep(f32x4 (&acc)[4][8], const char* A, const char* B) {
  bf16x8 af[4], bfr[8];
#pragma unroll
  for (int mt = 0; mt < 4; ++mt) af[mt] = *(const bf16x8*)(A + mt * 2048);
#pragma unroll
  for (int nt = 0; nt < 8; ++nt) bfr[nt] = *(const bf16x8*)(B + nt * 2048);
  __builtin_amdgcn_sched_barrier(0);
#pragma unroll
  for (int nt = 0; nt < 8; ++nt)
#pragma unroll
    for (int mt = 0; mt < 4; ++mt) acc[mt][nt] = __builtin_amdgcn_mfma_f32_16x16x32_bf16(bfr[nt], af[mt], acc[mt][nt], 0, 0, 0);
}

template <class Epi>
__device__ __forceinline__ void gemm_phase(const bf16_t* A, int lda, const bf16_t* Bt, int ldb, int nMt, int nNt, int K, const Epi& epi, char* smem, int wvs) {
  char* As = smem;
  char* Bs = smem + 65536;
  int tid_ = TIDX(wvs); asm volatile("" : "+v"(tid_)); const int tid = tid_, lane = tid & 63, wave = tid >> 6;
  const int wr = wave >> 1, wc = wave & 1;
  const int ntiles = nMt * nNt, nk = K >> 6;
  const int lrow = tid >> 3, lcc = (tid & 7) * 8;
  const int wofs = ((lrow >> 4) * 2 + (lcc >> 5)) * 1024 + ((((lrow & 15) * 64) + (lcc & 31) * 2) ^ ((lrow & 8) << 2));
  const int rofs = (((lane & 15) * 64) + (lane >> 4) * 16) ^ ((lane & 8) << 2);
  const unsigned toffA = (unsigned)(lrow * lda + lcc), toffB = (unsigned)(lrow * ldb + lcc);
  for (int tile = blockIdx.x; tile < ntiles; tile += gridDim.x) {
    const int pn = tile / nMt, pm = tile - pn * nMt;
    const bf16_t* Ab = A + (size_t)(pm * 256) * lda;
    const bf16_t* Bb = Bt + (size_t)(pn * 256) * ldb;
    f32x4 acc[4][8];
#pragma unroll
    for (int i = 0; i < 4; ++i)
#pragma unroll
      for (int j = 0; j < 8; ++j) acc[i][j] = (f32x4){0.f, 0.f, 0.f, 0.f};
    u32x4 rg[4];
#pragma unroll
    for (int i = 0; i < 4; ++i) rg[i] = *(const u32x4*)(Ab + (size_t)(i * 64) * lda + toffA);
#pragma unroll
    for (int i = 0; i < 4; ++i) *(u32x4*)(As + wofs + i * 8192) = rg[i];
#pragma unroll
    for (int i = 0; i < 4; ++i) rg[i] = *(const u32x4*)(Bb + (size_t)(i * 64) * ldb + toffB);
#pragma unroll
    for (int i = 0; i < 4; ++i) *(u32x4*)(Bs + wofs + i * 8192) = rg[i];
    __syncthreads();
#pragma unroll 1
    for (int kt = 0; kt < nk; ++kt) {
      const int cur = kt & 1;
      const int kn = (kt + 1 < nk ? kt + 1 : kt) * 64;
      char* Ad = As + (cur ^ 1) * 32768; char* Bd = Bs + (cur ^ 1) * 32768;
#pragma unroll
      for (int i = 0; i < 4; ++i) rg[i] = *(const u32x4*)(Ab + ((size_t)(i * 64) * lda + kn) + toffA);
      __builtin_amdgcn_sched_barrier(0);
      gemm_kstep(acc, As + cur * 32768 + wr * 8192 + rofs, Bs + cur * 32768 + wc * 16384 + rofs);
      __builtin_amdgcn_sched_barrier(0);
#pragma unroll
      for (int i = 0; i < 4; ++i) *(u32x4*)(Ad + wofs + i * 8192) = rg[i];
#pragma unroll
      for (int i = 0; i < 4; ++i) rg[i] = *(const u32x4*)(Bb + ((size_t)(i * 64) * ldb + kn) + toffB);
      __builtin_amdgcn_sched_barrier(0);
      gemm_kstep(acc, As + cur * 32768 + wr * 8192 + 1024 + rofs, Bs + cur * 32768 + wc * 16384 + 1024 + rofs);
      __builtin_amdgcn_sched_barrier(0);
#pragma unroll
      for (int i = 0; i < 4; ++i) *(u32x4*)(Bd + wofs + i * 8192) = rg[i];
      __syncthreads();
    }
    int er_ = pm * 256 + wr * 64, ec_ = pn * 256 + wc * 128, el_ = lane;
    asm volatile("" : "+v"(er_), "+v"(ec_), "+v"(el_));
    epi(acc, er_, ec_, el_);
  }
}

struct EpiInEven {
  bf16_t* proj; const float* rope; const float* lb;
  template <int MT> __device__ __forceinline__ void operator()(f32x4 (&acc)[MT][8], int rbase, int cbase, int lane) const {
    const int sec = cbase >> 9, head = (cbase >> 7) & 3, r = lane & 15, cq = (lane >> 4) * 4;
#pragma unroll
    for (int mt = 0; mt < MT; ++mt) {
      __builtin_amdgcn_sched_barrier(0);
      const int row = rbase + mt * 16 + r;
      bf16_t* dst = proj + (size_t)row * 4096 + cbase + cq;
      if (sec < 2) {
        const int pidx = row < 16384 ? (row & 2047) : 2048 + ((row - 16384) & 7);
        const float* ct = rope + pidx * 128 + cq;
        const float sc = sec == 1 ? 0.08838834764831845f : 1.f;
        float4 cc4[4], ss4[4];
#pragma unroll
        for (int nt = 0; nt < 4; ++nt) { cc4[nt] = *(const float4*)(ct + nt * 16); ss4[nt] = *(const float4*)(ct + 64 + nt * 16); }
#pragma unroll
        for (int nt = 0; nt < 4; ++nt) {
          const float4 c4 = cc4[nt], s4 = ss4[nt];
          const f32x4 x1 = acc[mt][nt], x2 = acc[mt][nt + 4];
          store4bf(dst + nt * 16, (x1[0] * c4.x - x2[0] * s4.x) * sc, (x1[1] * c4.y - x2[1] * s4.y) * sc, (x1[2] * c4.z - x2[2] * s4.z) * sc, (x1[3] * c4.w - x2[3] * s4.w) * sc);
          store4bf(dst + 64 + nt * 16, (x1[0] * s4.x + x2[0] * c4.x) * sc, (x1[1] * s4.y + x2[1] * c4.y) * sc, (x1[2] * s4.z + x2[2] * c4.z) * sc, (x1[3] * s4.w + x2[3] * c4.w) * sc);
        }
      } else if (sec == 5) {
        float4 ll4[8];
#pragma unroll
        for (int nt = 0; nt < 8; ++nt) ll4[nt] = *(const float4*)(lb + head * 128 + nt * 16 + cq);
#pragma unroll
        for (int nt = 0; nt < 8; ++nt) {
          const float4 l4 = ll4[nt];
          const f32x4 x = acc[mt][nt];
          store4bf(dst + nt * 16, __logf(l4.x + (1.f - l4.x) * sigm(x[0])), __logf(l4.y + (1.f - l4.y) * sigm(x[1])), __logf(l4.z + (1.f - l4.z) * sigm(x[2])), __logf(l4.w + (1.f - l4.w) * sigm(x[3])));
        }
      } else {
#pragma unroll
        for (int nt = 0; nt < 8; ++nt) { const f32x4 x = acc[mt][nt]; store4bf(dst + nt * 16, x[0], x[1], x[2], x[3]); }
      }
    }
  }
};
struct EpiOut {
  bf16_t* t0; float* rowss;
  template <int MT> __device__ __forceinline__ void operator()(f32x4 (&acc)[MT][8], int rbase, int cbase, int lane) const {
    const int r = lane & 15, cq = (lane >> 4) * 4;
#pragma unroll
    for (int mt = 0; mt < MT; ++mt) {
      __builtin_amdgcn_sched_barrier(0);
      const int row = rbase + mt * 16 + r;
      bf16_t* dst = t0 + (size_t)row * 1024 + cbase + cq;
      float ss = 0.f;
#pragma unroll
      for (int nt = 0; nt < 8; ++nt) { const f32x4 x = acc[mt][nt]; ss += x[0] * x[0] + x[1] * x[1] + x[2] * x[2] + x[3] * x[3]; store4bf(dst + nt * 16, x[0], x[1], x[2], x[3]); }
      ss += shx(ss, 16); ss += shx(ss, 32);
      if (lane < 16) atomicAdd(rowss + row, ss * (1.f / REPG));
    }
  }
};
struct EpiUp {
  bf16_t* act;
  template <int MT> __device__ __forceinline__ void operator()(f32x4 (&acc)[MT][8], int rbase, int cbase, int lane) const {
    const int r = lane & 15, cq = (lane >> 4) * 4;
#pragma unroll
    for (int mt = 0; mt < MT; ++mt) {
      __builtin_amdgcn_sched_barrier(0);
      bf16_t* dst = act + (size_t)(rbase + mt * 16 + r) * 4096 + cbase + cq;
#pragma unroll
      for (int nt = 0; nt < 8; ++nt) { f32x4 x = acc[mt][nt];
#pragma unroll
        for (int j = 0; j < 4; ++j) { float v = fmaxf(x[j], 0.f); x[j] = v * v; }
        store4bf(dst + nt * 16, x[0], x[1], x[2], x[3]); }
    }
  }
};
struct EpiInOdd {
  bf16_t* proj; float* dtbuf;
  template <int MT> __device__ __forceinline__ void operator()(f32x4 (&acc)[MT][8], int rbase, int cbase, int lane) const {
    const int r = lane & 15, cq = (lane >> 4) * 4;
#pragma unroll
    for (int mt = 0; mt < MT; ++mt) {
      __builtin_amdgcn_sched_barrier(0);
      const int row = rbase + mt * 16 + r;
      bf16_t* dst = proj + (size_t)row * 3200 + cbase + cq;
#pragma unroll
      for (int nt = 0; nt < 8; ++nt) { const f32x4 x = acc[mt][nt]; if (cbase + nt * 16 < 3200) store4bf(dst + nt * 16, x[0], x[1], x[2], x[3]); }
      if (cbase == 2560) { const f32x4 x = acc[mt][0]; *(float4*)(dtbuf + (size_t)row * 16 + cq) = make_float4(x[0], x[1], x[2], x[3]); }
    }
  }
};
struct EpiGlu {
  const bf16_t* gbuf; const float* bglu; bf16_t* mix;
  template <int MT> __device__ __forceinline__ void operator()(f32x4 (&acc)[MT][8], int rbase, int cbase, int lane) const {
    const int r = lane & 15, cq = (lane >> 4) * 4;
#pragma unroll
    for (int mt = 0; mt < MT; ++mt) {
      __builtin_amdgcn_sched_barrier(0);
      const int row = rbase + mt * 16 + r;
      uint2 gg2[8]; float4 bb4[8];
#pragma unroll
      for (int nt = 0; nt < 8; ++nt) { const int col = cbase + nt * 16 + cq; gg2[nt] = *(const uint2*)(gbuf + (size_t)row * 512 + col); bb4[nt] = *(const float4*)(bglu + col); }
#pragma unroll
      for (int nt = 0; nt < 8; ++nt) {
        const int col = cbase + nt * 16 + cq;
        const f32x4 x = acc[mt][nt];
        const uint2 g2 = gg2[nt];
        const float4 b4 = bb4[nt];
        store4bf(mix + (size_t)row * 1536 + 1024 + col, lo2f(g2.x) * sigm(x[0] + b4.x), hi2f(g2.x) * sigm(x[1] + b4.y), lo2f(g2.y) * sigm(x[2] + b4.z), hi2f(g2.y) * sigm(x[3] + b4.w));
      }
    }
  }
};

template <class Epi>
__device__ __forceinline__ void gemm_tail(const bf16_t* A, int lda, const bf16_t* Bt, int ldb, int nNt128, int K, const Epi& epi, char* smem, int wvs, int nBig) {
  bf16_t* As = (bf16_t*)smem;
  bf16_t* Bs = As + 2 * 128 * 80;
  int tid_ = TIDX(wvs); asm volatile("" : "+v"(tid_)); const int tid = tid_, lane = tid & 63, wave = tid >> 6;
  const int nk = K >> 6, G = gridDim.x;
  const int lrow = tid >> 3, lcc = (tid & 7) * 8;
  const unsigned toffA = (unsigned)(lrow * lda + lcc), toffB = (unsigned)(lrow * ldb + lcc);
  const int rr = nBig % G, nLight = G - rr;
  const int nSmall = 8 * nNt128;
  if ((int)blockIdx.x >= rr) {
    for (int j = (int)blockIdx.x - rr; j < nSmall; j += nLight) {
      const int pm = j / nNt128, pn = j - pm * nNt128;
      const bf16_t* Ab = A + (size_t)(16384 + pm * 128) * lda;
      const bf16_t* Bb = Bt + (size_t)(pn * 128) * ldb;
      f32x4 acc[1][8];
#pragma unroll
      for (int q = 0; q < 8; ++q) acc[0][q] = (f32x4){0.f, 0.f, 0.f, 0.f};
      u32x4 ra[2], rb[2];
#pragma unroll
      for (int i = 0; i < 2; ++i) { ra[i] = *(const u32x4*)(Ab + (size_t)(i * 64) * lda + toffA); rb[i] = *(const u32x4*)(Bb + (size_t)(i * 64) * ldb + toffB); }
#pragma unroll
      for (int i = 0; i < 2; ++i) { *(u32x4*)(As + (lrow + i * 64) * 80 + lcc) = ra[i]; *(u32x4*)(Bs + (lrow + i * 64) * 80 + lcc) = rb[i]; }
      __syncthreads();
#pragma unroll 1
      for (int kt = 0; kt < nk; ++kt) {
        const int cur = kt & 1;
        const int kn = (kt + 1 < nk ? kt + 1 : kt) * 64;
#pragma unroll
        for (int i = 0; i < 2; ++i) { ra[i] = *(const u32x4*)(Ab + ((size_t)(i * 64) * lda + kn) + toffA); rb[i] = *(const u32x4*)(Bb + ((size_t)(i * 64) * ldb + kn) + toffB); }
        __builtin_amdgcn_sched_barrier(0);
        wmma_sw<1, 8>(acc, As + cur * 128 * 80 + wave * 16 * 80, 80, Bs + cur * 128 * 80, 80, 64, lane);
        __builtin_amdgcn_sched_barrier(0);
        bf16_t* Ad = As + (cur ^ 1) * 128 * 80; bf16_t* Bd = Bs + (cur ^ 1) * 128 * 80;
#pragma unroll
        for (int i = 0; i < 2; ++i) { *(u32x4*)(Ad + (lrow + i * 64) * 80 + lcc) = ra[i]; *(u32x4*)(Bd + (lrow + i * 64) * 80 + lcc) = rb[i]; }
        __syncthreads();
      }
      int er_ = 16384 + pm * 128 + wave * 16, ec_ = pn * 128, el_ = lane;
      asm volatile("" : "+v"(er_), "+v"(ec_), "+v"(el_));
      epi(acc, er_, ec_, el_);
    }
  }
}

__device__ __forceinline__ void rowpass_phase(const bf16_t* t0, const float* rowss, const float* wpost, const float* hin_a, const float* hin_b, float* hout, const float* wnext, bf16_t* hn, int wvs) {
  int tq_ = TIDX(wvs); asm volatile("" : "+v"(tq_)); const int lane = tq_ & 63, gw = blockIdx.x * 8 + (tq_ >> 6), nw = gridDim.x * 8;
  for (int row = gw; row < ROWS; row += nw) {
    const float* hin = row < 16384 ? hin_a + (size_t)row * 1024 : hin_b + (size_t)(row - 16384) * 1024;
    float r0 = 0.f;
    if (t0) r0 = rsqrtf(rowss[row] * (1.f / 1024.f) + EPSV);
    float4 v[4]; float ss = 0.f;
    float4 hvv[4], wpv[4], wnv[4]; uint2 tv[4];
#pragma unroll
    for (int i = 0; i < 4; ++i) {
      const int col = (i * 64 + lane) * 4;
      hvv[i] = *(const float4*)(hin + col);
      if (t0) { tv[i] = *(const uint2*)(t0 + (size_t)row * 1024 + col); wpv[i] = *(const float4*)(wpost + col); }
      if (hn) wnv[i] = *(const float4*)(wnext + col);
    }
#pragma unroll
    for (int i = 0; i < 4; ++i) {
      const int col = (i * 64 + lane) * 4;
      float4 hv = hvv[i];
      if (t0) {
        const uint2 t2 = tv[i];
        const float4 w4 = wpv[i];
        hv.x += lo2f(t2.x) * r0 * w4.x; hv.y += hi2f(t2.x) * r0 * w4.y; hv.z += lo2f(t2.y) * r0 * w4.z; hv.w += hi2f(t2.y) * r0 * w4.w;
      }
      v[i] = hv; ss += hv.x * hv.x + hv.y * hv.y + hv.z * hv.z + hv.w * hv.w;
      if (hout) *(float4*)(hout + (size_t)row * 1024 + col) = hv;
    }
    if (hn) {
#pragma unroll
      for (int o = 32; o >= 1; o >>= 1) ss += shx(ss, o);
      const float r1 = rsqrtf(ss * (1.f / 1024.f) + EPSV);
#pragma unroll
      for (int i = 0; i < 4; ++i) {
        const int col = (i * 64 + lane) * 4;
        const float4 w4 = wnv[i];
        store4bf(hn + (size_t)row * 1024 + col, v[i].x * r1 * w4.x, v[i].y * r1 * w4.y, v[i].z * r1 * w4.z, v[i].w * r1 * w4.w);
      }
    }
  }
}

__device__ __forceinline__ void wconv(const float* __restrict__ W, int K, int N, int Npad, bf16_t* __restrict__ Wt, char* smem, int wvs) {
  float* tile = (float*)smem;
  int tq_ = TIDX(wvs) & 255; asm volatile("" : "+v"(tq_)); const int tid = tq_;
  const int nNt = Npad >> 6, nunits = (K >> 6) * nNt;
  for (int u = blockIdx.x * 2 + (wvs >> 2); u < nunits; u += gridDim.x * 2) {
    const int k0 = (u / nNt) * 64, n0 = (u % nNt) * 64;
#pragma unroll
    for (int ps = 0; ps < 4; ++ps) {
      const int i = ps * 16 + (tid >> 4), j = (tid & 15) * 4, n = n0 + j;
      float4 v = make_float4(0.f, 0.f, 0.f, 0.f);
      if (n < N) v = *(const float4*)(W + (size_t)(k0 + i) * N + n);
      tile[i * 65 + j] = v.x; tile[i * 65 + j + 1] = v.y; tile[i * 65 + j + 2] = v.z; tile[i * 65 + j + 3] = v.w;
    }
    __syncthreads();
    {
      const int n = tid >> 2, kq = (tid & 3) * 16;
      uint4 o0, o1;
      o0.x = pack2(tile[(kq + 0) * 65 + n], tile[(kq + 1) * 65 + n]); o0.y = pack2(tile[(kq + 2) * 65 + n], tile[(kq + 3) * 65 + n]);
      o0.z = pack2(tile[(kq + 4) * 65 + n], tile[(kq + 5) * 65 + n]); o0.w = pack2(tile[(kq + 6) * 65 + n], tile[(kq + 7) * 65 + n]);
      o1.x = pack2(tile[(kq + 8) * 65 + n], tile[(kq + 9) * 65 + n]); o1.y = pack2(tile[(kq + 10) * 65 + n], tile[(kq + 11) * 65 + n]);
      o1.z = pack2(tile[(kq + 12) * 65 + n], tile[(kq + 13) * 65 + n]); o1.w = pack2(tile[(kq + 14) * 65 + n], tile[(kq + 15) * 65 + n]);
      bf16_t* d = Wt + (size_t)(n0 + n) * K + k0 + kq;
      *(uint4*)d = o0; *(uint4*)(d + 8) = o1;
    }
    __syncthreads();
  }
}

__device__ __forceinline__ void prep_tables(const Params& p, int wvs) {
  int tq_ = TIDX(wvs); asm volatile("" : "+v"(tq_)); const int gt = blockIdx.x * NTHR + tq_, nt = gridDim.x * NTHR;
  float* rope = (float*)(p.ws + OFF_ROPE);
  for (int i = gt; i < 2056 * 64; i += nt) {
    const int pi = i >> 6, f = i & 63;
    const double pos = pi < 2048 ? (double)pi : (double)(16384 + pi - 2048);
    const double invf = exp(-(double)f * (9.210340371976184 / 64.0));
    double ang = pos * invf;
    ang -= 6.283185307179586 * floor(ang * 0.15915494309189535);
    const float a = (float)ang;
    rope[pi * 128 + f] = cosf(a); rope[pi * 128 + 64 + f] = sinf(a);
  }
  float* z = (float*)(p.ws + OFF_ROWSS);
  for (int i = gt; i < ROWS * 6; i += nt) z[i] = 0.f;
  float* lb = (float*)(p.ws + OFF_LB);
  for (int i = gt; i < 512; i += nt) lb[i] = 1.f / (1.f + expf(p.hgrn_lb[512 + i] - p.hgrn_lb[i]));
  float* tab = (float*)(p.ws + OFF_S5TAB);
  for (int i = gt; i < 2048; i += nt) {
    const int g = i >> 6;
    const float lr = p.s5_lam_re[i], li = p.s5_lam_im[i], dt = expf(p.s5_log_step[g]);
    const float m1 = expf(lr * dt), br = m1 * cosf(li * dt), bi = m1 * sinf(li * dt);
    tab[i] = br; tab[2048 + i] = bi;
    const float m64 = expf(lr * dt * 64.f); tab[69632 + i] = m64 * cosf(li * dt * 64.f); tab[71680 + i] = m64 * sinf(li * dt * 64.f);
    const float m8 = expf(lr * dt * 8.f); tab[73728 + i] = m8 * cosf(li * dt * 8.f); tab[75776 + i] = m8 * sinf(li * dt * 8.f);
    const float x = br - 1.f, y = bi, den = 1.f / (lr * lr + li * li);
    const float qr = (x * lr + y * li) * den, qi = (y * lr - x * li) * den;
    for (int c = 0; c < 16; ++c) {
      const float b_r = p.s5_b_re[i * 16 + c], b_i = p.s5_b_im[i * 16 + c];
      tab[4096 + i * 16 + c] = qr * b_r - qi * b_i;
      tab[4096 + 32768 + i * 16 + c] = qr * b_i + qi * b_r;
    }
  }
}

__device__ __forceinline__ void chunk_geom(int c, int& row0, int& L) { if (c < 256) { row0 = c * 64; L = 64; } else { row0 = 16384 + (c - 256) * 8; L = 8; } }

template <int MODE>
__device__ __forceinline__ void st_load(uint4 (&kr)[4], uint4 (&vr)[(MODE == 2) ? 2 : 1], float& dtr, const bf16_t* src, const float* dtbuf, int row0, int L, int ld, int kcol, int vcol, int h, int tid) {
  constexpr int PW = (MODE == 2) ? 64 : 32, NVC = PW / 32, VCR = PW / 8;
  const uint4 z4 = make_uint4(0, 0, 0, 0);
#pragma unroll
  for (int i = 0; i < 4; ++i) { const int id = tid + i * 256, s = id >> 4, c8 = id & 15; uint4 t_ = z4; if (s < L) t_ = *(const uint4*)(src + (size_t)(row0 + s) * ld + kcol + c8 * 8); kr[i] = t_; }
#pragma unroll
  for (int i = 0; i < NVC; ++i) { const int id = tid + i * 256, s = id / VCR, c8 = id % VCR; uint4 t_ = z4; if (s < L) t_ = *(const uint4*)(src + (size_t)(row0 + s) * ld + vcol + c8 * 8); vr[i] = t_; }
  if (MODE == 2 && tid < 64) dtr = tid < L ? dtbuf[(size_t)(row0 + tid) * 16 + h] : 0.f;
}

template <int MODE>
__device__ __forceinline__ void state_unit(const Params& p, int sq, int h, int ps, char* smem, int wvs) {
  constexpr int PW = (MODE == 2) ? 64 : 32, NT = PW / 16, PF = (MODE == 2) ? 64 : 128, HH = (MODE == 2) ? 16 : 4, NVC = PW / 32, VCR = PW / 8;
  bf16_t* KT = (bf16_t*)smem;
  bf16_t* VT = KT + 128 * 80;
  bf16_t* KR = VT + 64 * 80;
  float* tot = (float*)(KR + 64 * 136);
  float* dec = tot + 256;
  float* av = dec + 64;
  float* dtv = av + 64;
  int tid_ = TIDX(wvs) & 255; asm volatile("" : "+v"(tid_)); const int tid = tid_, lane = tid & 63, wave = tid >> 6;
  const bool prompt = sq < 8;
  const int nch = prompt ? 32 : 1, L = prompt ? 64 : 8;
  const int ld = (MODE == 2) ? 1536 : 4096;
  const bf16_t* src = (MODE == 2) ? (const bf16_t*)(p.ws + OFF_H) : (const bf16_t*)(p.ws + OFF_A);
  const int kcol = MODE == 0 ? 512 + h * 128 : MODE == 1 ? 2560 + h * 128 : 1024 + (h >> 3) * 128;
  const int vcol = MODE == 0 ? 1024 + h * 128 + ps * 32 : MODE == 1 ? 3072 + h * 128 + ps * 32 : h * 64;
  const float* sin_ = MODE == 0 ? p.state_ret : MODE == 1 ? p.state_hgrn : p.state_ssm;
  float* sout = p.out + (MODE == 0 ? O_RET : MODE == 1 ? O_HG : O_SSM) + (size_t)(sq * HH + h) * 128 * PF;
  bf16_t* stb = (bf16_t*)(p.ws + OFF_ST) + (MODE == 1 ? (size_t)256 * 4 * 128 * 128 : 0);
  const float* dtbuf = (const float*)(p.ws + OFF_DTBUF);
  const float l2g = MODE == 0 ? log2f(1.f - exp2f(-5.f - (float)h)) : 0.f;
  float Ah = 0.f, dtb = 0.f;
  if (MODE == 2) { Ah = -expf(p.a_log[h]); dtb = p.dt_bias[h]; }

  f32x4 acc[2][NT];
  const int nb = wave * 32 + (lane >> 4) * 4, pc = ps * PW + (lane & 15);
#pragma unroll
  for (int mt = 0; mt < 2; ++mt)
#pragma unroll
    for (int nt = 0; nt < NT; ++nt)
#pragma unroll
      for (int j = 0; j < 4; ++j)
        acc[mt][nt][j] = prompt ? 0.f : sin_[((size_t)((sq - 8) * HH + h) * 128 + nb + mt * 16 + j) * PF + pc + nt * 16];

  uint4 kr[4], vr[NVC]; float dtr = 0.f;
  const uint4 z4 = make_uint4(0, 0, 0, 0);
  st_load<MODE>(kr, vr, dtr, src, dtbuf, prompt ? sq * 2048 : 16384 + (sq - 8) * 8, L, ld, kcol, vcol, h, tid);
  for (int n = 0; n < nch; ++n) {
    if (prompt) {
      bf16_t* d = stb + ((size_t)((sq * 32 + n) * HH + h) * PF) * 128;
#pragma unroll
      for (int mt = 0; mt < 2; ++mt)
#pragma unroll
        for (int nt = 0; nt < NT; ++nt) store4bf(d + (size_t)(pc + nt * 16) * 128 + nb + mt * 16, acc[mt][nt][0], acc[mt][nt][1], acc[mt][nt][2], acc[mt][nt][3]);
    }
#pragma unroll
    for (int i = 0; i < 4; ++i) { const int id = tid + i * 256, s = id >> 4, c8 = id & 15; *(uint4*)(KR + s * 136 + c8 * 8) = kr[i]; }
#pragma unroll
    for (int i = 0; i < NVC; ++i) {
      const int id = tid + i * 256, s = id / VCR, c8 = id % VCR; const uint4 v = vr[i];
      bf16_t* d = VT + (c8 * 8) * 80 + s;
      d[0] = (bf16_t)(v.x & 0xffff); d[80] = (bf16_t)(v.x >> 16); d[160] = (bf16_t)(v.y & 0xffff); d[240] = (bf16_t)(v.y >> 16);
      d[320] = (bf16_t)(v.z & 0xffff); d[400] = (bf16_t)(v.z >> 16); d[480] = (bf16_t)(v.w & 0xffff); d[560] = (bf16_t)(v.w >> 16);
    }
    if (MODE == 2 && tid < 64) {
      float dt = 0.f;
      if (tid < L) { const float x = dtr + dtb; dt = x > 20.f ? x : log1pf(__expf(x)); }
      dtv[tid] = dt; av[tid] = dt * Ah;
    }
    if (n + 1 < nch) st_load<MODE>(kr, vr, dtr, src, dtbuf, sq * 2048 + (n + 1) * 64, L, ld, kcol, vcol, h, tid);
    __syncthreads();
    const int kn = tid & 127, half = tid >> 7;
    if (MODE == 1) {
      float s_ = 0.f;
      for (int s = half * 32; s < half * 32 + 32; ++s) s_ += bf2f(KR[s * 136 + kn]);
      tot[half * 128 + kn] = s_;
    }
    if (MODE == 2 && tid < 64) {
      float suf = 0.f;
      for (int r = tid + 1; r < 64; ++r) suf += av[r];
      dec[tid] = __expf(suf) * dtv[tid];
      if (tid == 0) tot[0] = suf + av[0];
    }
    if (MODE != 0) __syncthreads();
    {
      float suf = 0.f;
      if (MODE == 1) suf = half == 0 ? tot[128 + kn] : 0.f;
      for (int g = 3; g >= 0; --g) {
        const int s0 = half * 32 + g * 8;
        float v[8];
#pragma unroll
        for (int e = 7; e >= 0; --e) {
          const int s = s0 + e;
          const float raw = bf2f(KR[s * 136 + kn]);
          if (MODE == 0) v[e] = raw * exp2f((float)(L - 1 - s) * l2g);
          else if (MODE == 1) { v[e] = (1.f - __expf(raw)) * __expf(suf); suf += raw; }
          else v[e] = raw * dec[s];
        }
        uint4 o; o.x = pack2(v[0], v[1]); o.y = pack2(v[2], v[3]); o.z = pack2(v[4], v[5]); o.w = pack2(v[6], v[7]);
        *(uint4*)(KT + kn * 80 + s0) = o;
      }
    }
    __syncthreads();
#pragma unroll
    for (int mt = 0; mt < 2; ++mt) {
      float dk[4];
      if (MODE == 0) { const float d = exp2f((float)L * l2g); dk[0] = dk[1] = dk[2] = dk[3] = d; }
      else if (MODE == 2) { const float d = __expf(tot[0]); dk[0] = dk[1] = dk[2] = dk[3] = d; }
      else {
#pragma unroll
        for (int j = 0; j < 4; ++j) { const int nn = nb + mt * 16 + j; dk[j] = __expf(tot[nn] + tot[128 + nn]); }
      }
#pragma unroll
      for (int nt = 0; nt < NT; ++nt)
#pragma unroll
        for (int j = 0; j < 4; ++j) acc[mt][nt][j] *= dk[j];
    }
    wmma_ns<2, NT>(acc, KT + wave * 32 * 80, 80, VT, 80, 64, lane);
    __syncthreads();
  }
#pragma unroll
  for (int mt = 0; mt < 2; ++mt)
#pragma unroll
    for (int nt = 0; nt < NT; ++nt)
#pragma unroll
      for (int j = 0; j < 4; ++j) sout[(size_t)(nb + mt * 16 + j) * PF + pc + nt * 16] = acc[mt][nt][j];
}

template <int MODE>
__device__ __forceinline__ void out_unit(const Params& p, int c, int h, char* smem, int wvs) {
  constexpr int PF = (MODE == 2) ? 64 : 128, NTP = PF / 16, HH = (MODE == 2) ? 16 : 4, NVC = PF / 32, VCR = PF / 8;
  bf16_t* Q = (bf16_t*)smem;
  bf16_t* Kb = Q + 64 * 136;
  bf16_t* STb = Kb + 128 * 80;
  float* cumv = (float*)(STb + 128 * 136);
  float* dtv = cumv + 64;
  float* av = dtv + 64;
  float* tot = av + 64;
  int tid_ = TIDX(wvs) & 255; asm volatile("" : "+v"(tid_)); const int tid = tid_, lane = tid & 63, wave = tid >> 6;
  int row0, L; chunk_geom(c, row0, L);
  const int ld = (MODE == 2) ? 1536 : 4096;
  const bf16_t* src = (MODE == 2) ? (const bf16_t*)(p.ws + OFF_H) : (const bf16_t*)(p.ws + OFF_A);
  const int qcol = MODE == 0 ? h * 128 : MODE == 1 ? 2048 + h * 128 : 1280 + (h >> 3) * 128;
  const int kcol = MODE == 0 ? 512 + h * 128 : MODE == 1 ? 2560 + h * 128 : 1024 + (h >> 3) * 128;
  const int vcol = MODE == 0 ? 1024 + h * 128 : MODE == 1 ? 3072 + h * 128 : h * 64;
  const float l2g = MODE == 0 ? log2f(1.f - exp2f(-5.f - (float)h)) : 0.f;
  const uint4 z4 = make_uint4(0, 0, 0, 0);
#pragma unroll
  for (int i = 0; i < 4; ++i) {
    const int id = tid + i * 256, s = id >> 4, c8 = id & 15;
    uint4 q4 = z4, k4 = z4;
    if (s < L) { q4 = *(const uint4*)(src + (size_t)(row0 + s) * ld + qcol + c8 * 8); k4 = *(const uint4*)(src + (size_t)(row0 + s) * ld + kcol + c8 * 8); }
    *(uint4*)(Q + s * 136 + c8 * 8) = q4; *(uint4*)(Kb + s * 136 + c8 * 8) = k4;
  }
  uint4 vr[NVC];
#pragma unroll
  for (int i = 0; i < NVC; ++i) { const int id = tid + i * 256, s = id / VCR, c8 = id % VCR; uint4 t_ = z4; if (s < L) t_ = *(const uint4*)(src + (size_t)(row0 + s) * ld + vcol + c8 * 8); vr[i] = t_; }
  if (c < 256) {
    const bf16_t* stg = (const bf16_t*)(p.ws + OFF_ST) + (MODE == 1 ? (size_t)256 * 4 * 128 * 128 : 0) + ((size_t)(c * HH + h) * PF) * 128;
#pragma unroll
    for (int i = 0; i < PF / 16; ++i) { const int id = tid + i * 256, pr = id >> 4, c8 = id & 15; *(uint4*)(STb + pr * 136 + c8 * 8) = *(const uint4*)(stg + (size_t)pr * 128 + c8 * 8); }
  } else {
    const float* sg = (MODE == 0 ? p.state_ret : MODE == 1 ? p.state_hgrn : p.state_ssm) + (size_t)((c - 256) * HH + h) * 128 * PF;
    for (int id = tid; id < 128 * (PF / 4); id += 256) {
      const int n = id / (PF / 4), p4 = (id % (PF / 4)) * 4;
      const float4 v = *(const float4*)(sg + (size_t)n * PF + p4);
      STb[(p4 + 0) * 136 + n] = f2bf(v.x); STb[(p4 + 1) * 136 + n] = f2bf(v.y); STb[(p4 + 2) * 136 + n] = f2bf(v.z); STb[(p4 + 3) * 136 + n] = f2bf(v.w);
    }
  }
  if (MODE == 2 && tid < 64) {
    float dt = 0.f;
    if (tid < L) { const float x = ((const float*)(p.ws + OFF_DTBUF))[(size_t)(row0 + tid) * 16 + h] + p.dt_bias[h]; dt = x > 20.f ? x : log1pf(__expf(x)); }
    dtv[tid] = dt; av[tid] = -expf(p.a_log[h]) * dt;
  }
  __syncthreads();
  if (MODE == 1) {
    const int kn = tid & 127, half = tid >> 7;
    float s_ = 0.f;
    for (int s = half * 32; s < half * 32 + 32; ++s) s_ += bf2f(Kb[s * 136 + kn]);
    tot[half * 128 + kn] = s_;
    __syncthreads();
    float cum = half == 1 ? tot[kn] : 0.f;
    for (int s = half * 32; s < half * 32 + 32; ++s) {
      const float lf = bf2f(Kb[s * 136 + kn]);
      cum += lf;
      Q[s * 136 + kn] = f2bf(bf2f(Q[s * 136 + kn]) * __expf(cum));
      Kb[s * 136 + kn] = f2bf((1.f - __expf(lf)) * __expf(-cum));
    }
    __syncthreads();
  }
  if (MODE == 2) {
    if (tid < 64) { float cs = 0.f; for (int r = 0; r <= tid; ++r) cs += av[r]; cumv[tid] = cs; }
    __syncthreads();
  }
  f32x4 ai[1][NTP], asc[1][4];
#pragma unroll
  for (int j = 0; j < NTP; ++j) ai[0][j] = (f32x4){0.f, 0.f, 0.f, 0.f};
#pragma unroll
  for (int j = 0; j < 4; ++j) asc[0][j] = (f32x4){0.f, 0.f, 0.f, 0.f};
  wmma_sw<1, NTP>(ai, Q + wave * 16 * 136, 136, STb, 136, 128, lane);
  wmma_sw<1, 4>(asc, Q + wave * 16 * 136, 136, Kb, 136, 128, lane);
  const int t = wave * 16 + (lane & 15), sq4 = (lane >> 4) * 4;
  float ct = 0.f;
  if (MODE == 2) ct = cumv[t];
#pragma unroll
  for (int nt = 0; nt < 4; ++nt)
#pragma unroll
    for (int j = 0; j < 4; ++j) {
      const int s = nt * 16 + sq4 + j;
      float v = asc[0][nt][j];
      if (s > t) v = 0.f;
      else if (MODE == 0) v *= exp2f((float)(t - s) * l2g);
      else if (MODE == 2) v *= __expf(ct - cumv[s]) * dtv[s];
      asc[0][nt][j] = v;
    }
  __syncthreads();
  bf16_t* Pb = STb; bf16_t* VT = Kb;
#pragma unroll
  for (int nt = 0; nt < 4; ++nt) store4bf(Pb + t * 80 + nt * 16 + sq4, asc[0][nt][0], asc[0][nt][1], asc[0][nt][2], asc[0][nt][3]);
#pragma unroll
  for (int i = 0; i < NVC; ++i) {
    const int id = tid + i * 256, s = id / VCR, c8 = id % VCR; const uint4 v = vr[i];
    bf16_t* d = VT + (c8 * 8) * 80 + s;
    d[0] = (bf16_t)(v.x & 0xffff); d[80] = (bf16_t)(v.x >> 16); d[160] = (bf16_t)(v.y & 0xffff); d[240] = (bf16_t)(v.y >> 16);
    d[320] = (bf16_t)(v.z & 0xffff); d[400] = (bf16_t)(v.z >> 16); d[480] = (bf16_t)(v.w & 0xffff); d[560] = (bf16_t)(v.w >> 16);
  }
  __syncthreads();
  f32x4 ao[1][NTP];
#pragma unroll
  for (int j = 0; j < NTP; ++j) ao[0][j] = (f32x4){0.f, 0.f, 0.f, 0.f};
  wmma_sw<1, NTP>(ao, Pb + wave * 16 * 80, 80, VT, 80, 64, lane);
  float fi = 1.f;
  if (MODE == 0) fi = exp2f((float)(t + 1) * l2g);
  if (MODE == 2) fi = __expf(ct);
  const int row = row0 + t;
  const bool valid = t < L;
  if (MODE == 0 || MODE == 1) {
    float s1 = 0.f, s2 = 0.f;
#pragma unroll
    for (int nt = 0; nt < NTP; ++nt)
#pragma unroll
      for (int j = 0; j < 4; ++j) { const float o = ao[0][nt][j] + fi * ai[0][nt][j]; ao[0][nt][j] = o; s1 += o; s2 += o * o; }
    s1 += shx(s1, 16); s1 += shx(s1, 32); s2 += shx(s2, 16); s2 += shx(s2, 32);
    float mu = 0.f, rs;
    if (MODE == 0) { mu = s1 * (1.f / 128.f); const float var = fmaxf(s2 * (1.f / 128.f) - mu * mu, 0.f); rs = rsqrtf(var + EPSV); }
    else rs = rsqrtf(s2 * (1.f / 128.f) + EPSV);
    if (valid) {
      const float* nw = (MODE == 0 ? p.ret_norm_w : p.hgrn_norm_w) + h * 128;
      const int gcol = (MODE == 0 ? 1536 : 3584) + h * 128;
      bf16_t* mix = (bf16_t*)(p.ws + OFF_H) + (size_t)row * 1024 + (MODE == 0 ? 0 : 512) + h * 128;
      float4 ww4[NTP]; uint2 gg2[NTP];
#pragma unroll
      for (int nt = 0; nt < NTP; ++nt) { const int pp = nt * 16 + sq4; ww4[nt] = *(const float4*)(nw + pp); gg2[nt] = *(const uint2*)(src + (size_t)row * ld + gcol + pp); }
#pragma unroll
      for (int nt = 0; nt < NTP; ++nt) {
        const int pp = nt * 16 + sq4;
        const float4 w4 = ww4[nt];
        const uint2 g2 = gg2[nt];
        store4bf(mix + pp, (ao[0][nt][0] - mu) * rs * w4.x * siluf(lo2f(g2.x)), (ao[0][nt][1] - mu) * rs * w4.y * siluf(hi2f(g2.x)),
                 (ao[0][nt][2] - mu) * rs * w4.z * siluf(lo2f(g2.y)), (ao[0][nt][3] - mu) * rs * w4.w * siluf(hi2f(g2.y)));
      }
    }
  } else {
    const float Dh = p.d_ssm[h];
    bf16_t* zy = (bf16_t*)(p.ws + OFF_A) + (size_t)row * 3200 + h * 64;
    float s2 = 0.f;
    if (valid) {
      uint2 xx2[NTP], zz2[NTP];
#pragma unroll
      for (int nt = 0; nt < NTP; ++nt) { const int pp = nt * 16 + sq4; xx2[nt] = *(const uint2*)(src + (size_t)row * ld + vcol + pp); zz2[nt] = *(const uint2*)(zy + pp); }
#pragma unroll
      for (int nt = 0; nt < NTP; ++nt) {
        const int pp = nt * 16 + sq4;
        const uint2 x2 = xx2[nt];
        const uint2 z2 = zz2[nt];
        const float y0 = (ao[0][nt][0] + fi * ai[0][nt][0] + Dh * lo2f(x2.x)) * siluf(lo2f(z2.x));
        const float y1 = (ao[0][nt][1] + fi * ai[0][nt][1] + Dh * hi2f(x2.x)) * siluf(hi2f(z2.x));
        const float y2 = (ao[0][nt][2] + fi * ai[0][nt][2] + Dh * lo2f(x2.y)) * siluf(lo2f(z2.y));
        const float y3 = (ao[0][nt][3] + fi * ai[0][nt][3] + Dh * hi2f(x2.y)) * siluf(hi2f(z2.y));
        s2 += y0 * y0 + y1 * y1 + y2 * y2 + y3 * y3;
        store4bf(zy + pp, y0, y1, y2, y3);
      }
    }
    s2 += shx(s2, 16); s2 += shx(s2, 32);
    if (valid && lane < 16) atomicAdd((float*)(p.ws + OFF_SSDST) + (size_t)row * 2 + (h >> 3), s2);
  }
  __syncthreads();
}

template <int OUT>
__device__ __forceinline__ void s5_unit(const Params& p, int c, int gq, char* smem, int wvs) {
  float* Uf = (float*)smem;
  bf16_t* HSall = (bf16_t*)(smem + 16384);
  bf16_t* CMall = (bf16_t*)(smem + 16384 + 34816);
  int tid_ = TIDX(wvs) & 255; asm volatile("" : "+v"(tid_)); const int tid = tid_, lane = tid & 63, wave = tid >> 6;
  int row0, L; chunk_geom(c, row0, L);
  const bf16_t* proj = (const bf16_t*)(p.ws + OFF_A);
#pragma unroll
  for (int i = 0; i < 2; ++i) {
    const int id = tid + i * 256, s = id >> 3, c8 = id & 7;
    uint4 v = make_uint4(0, 0, 0, 0);
    if (s < L) v = *(const uint4*)(proj + (size_t)(row0 + s) * 3200 + 2576 + gq * 64 + c8 * 8);
    float* d = Uf + s * 64 + c8 * 8;
    d[0] = lo2f(v.x); d[1] = hi2f(v.x); d[2] = lo2f(v.y); d[3] = hi2f(v.y); d[4] = lo2f(v.z); d[5] = hi2f(v.z); d[6] = lo2f(v.w); d[7] = hi2f(v.w);
  }
  const int g = gq * 4 + wave, gp = g * 64 + lane;
  const float* tab = (const float*)(p.ws + OFF_S5TAB);
  const float lr = tab[gp], li = tab[2048 + gp];
  f32x2 bb2[16];
#pragma unroll
  for (int q = 0; q < 4; ++q) {
    const float4 a = *(const float4*)(tab + 4096 + gp * 16 + q * 4), b = *(const float4*)(tab + 4096 + 32768 + gp * 16 + q * 4);
    bb2[q * 4] = (f32x2){a.x, b.x}; bb2[q * 4 + 1] = (f32x2){a.y, b.y}; bb2[q * 4 + 2] = (f32x2){a.z, b.z}; bb2[q * 4 + 3] = (f32x2){a.w, b.w};
  }
  float hr = 0.f, hi = 0.f;
  bf16_t* HS = HSall + wave * 32 * 136; bf16_t* CM = CMall + wave * 16 * 136;
  if (OUT) {
    const float2 h0 = *(const float2*)((const float*)(p.ws + OFF_S5H) + ((size_t)c * 2048 + gp) * 2);
    hr = h0.x; hi = h0.y;
#pragma unroll
    for (int ch = 0; ch < 16; ++ch) { CM[ch * 136 + lane] = f2bf(p.s5_c_re[(g * 16 + ch) * 64 + lane]); CM[ch * 136 + 64 + lane] = f2bf(-p.s5_c_im[(g * 16 + ch) * 64 + lane]); }
  }
  __syncthreads();
  const int nhalf = OUT ? ((L + 31) >> 5) : 1, tl = OUT ? 32 : L;
  for (int hf = 0; hf < nhalf; ++hf) {
#pragma unroll 4
    for (int tt = 0; tt < tl; ++tt) {
      const int t = hf * 32 + tt;
      {
        const float* up = Uf + t * 64 + wave * 16;
        f32x2 b0 = (f32x2){0.f, 0.f}, b1 = (f32x2){0.f, 0.f};
#pragma unroll
        for (int q = 0; q < 4; ++q) {
          const f32x4 u4 = *(const f32x4*)(up + q * 4);
          b0 += bb2[q * 4] * u4[0]; b1 += bb2[q * 4 + 1] * u4[1]; b0 += bb2[q * 4 + 2] * u4[2]; b1 += bb2[q * 4 + 3] * u4[3];
        }
        b0 += b1;
        const float nr = lr * hr - li * hi + b0[0], ni = lr * hi + li * hr + b0[1];
        if (t < L) { hr = nr; hi = ni; }
      }
      if (OUT) { HS[tt * 136 + lane] = f2bf(t < L ? hr : 0.f); HS[tt * 136 + 64 + lane] = f2bf(t < L ? hi : 0.f); }
    }
    if (OUT) {
      __syncthreads();
      f32x4 ay[2][1];
      ay[0][0] = (f32x4){0.f, 0.f, 0.f, 0.f}; ay[1][0] = (f32x4){0.f, 0.f, 0.f, 0.f};
      wmma_sw<2, 1>(ay, HS, 136, CM, 136, 128, lane);
      bf16_t* gbuf = (bf16_t*)(p.ws + OFF_GBUF);
#pragma unroll
      for (int mt = 0; mt < 2; ++mt) {
        const int t = hf * 32 + mt * 16 + (lane & 15), ch0 = (lane >> 4) * 4;
        if (t < L) {
          const float4 u4 = *(const float4*)(Uf + t * 64 + wave * 16 + ch0);
          const float4 d4 = *(const float4*)(p.s5_d + g * 16 + ch0);
          float y[4] = {ay[mt][0][0] + d4.x * u4.x, ay[mt][0][1] + d4.y * u4.y, ay[mt][0][2] + d4.z * u4.z, ay[mt][0][3] + d4.w * u4.w};
#pragma unroll
          for (int j = 0; j < 4; ++j) { const float x = y[j], uu = 0.7978845608028654f * (x + 0.044715f * x * x * x); y[j] = x / (1.f + __expf(-2.f * uu)); }
          store4bf(gbuf + (size_t)(row0 + t) * 512 + g * 16 + ch0, y[0], y[1], y[2], y[3]);
        }
      }
      __syncthreads();
    }
  }
  if (!OUT) { *(float2*)((float*)(p.ws + OFF_S5E) + ((size_t)c * 2048 + gp) * 2) = make_float2(hr, hi); }
  __syncthreads();
}

__device__ __forceinline__ void s5_prefix(const Params& p, int gt) {
  const int sq = gt >> 11, rem = gt & 2047;
  const float* tab = (const float*)(p.ws + OFF_S5TAB);
  const float* e = (const float*)(p.ws + OFF_S5E);
  float* hs = (float*)(p.ws + OFF_S5H);
  float hr = 0.f, hi = 0.f;
  if (sq < 8) {
    const float lr = tab[69632 + rem], li = tab[71680 + rem];
    for (int n = 0; n < 32; ++n) {
      const size_t idx = ((size_t)(sq * 32 + n) * 2048 + rem) * 2;
      *(float2*)(hs + idx) = make_float2(hr, hi);
      const float2 ev = *(const float2*)(e + idx);
      const float nr = lr * hr - li * hi + ev.x, ni = lr * hi + li * hr + ev.y; hr = nr; hi = ni;
    }
  } else {
    const float lr = tab[73728 + rem], li = tab[75776 + rem];
    hr = p.state_s5_re[(size_t)(sq - 8) * 2048 + rem]; hi = p.state_s5_im[(size_t)(sq - 8) * 2048 + rem];
    const size_t idx = ((size_t)(256 + sq - 8) * 2048 + rem) * 2;
    *(float2*)(hs + idx) = make_float2(hr, hi);
    const float2 ev = *(const float2*)(e + idx);
    const float nr = lr * hr - li * hi + ev.x, ni = lr * hi + li * hr + ev.y; hr = nr; hi = ni;
  }
  p.out[O_S5RE + (size_t)sq * 2048 + rem] = hr;
  p.out[O_S5IM + (size_t)sq * 2048 + rem] = hi;
}

__device__ __forceinline__ void conv_phase(const Params& p, int wvs) {
  const bf16_t* proj = (const bf16_t*)(p.ws + OFF_A);
  bf16_t* xc = (bf16_t*)(p.ws + OFF_H);
  int tq_ = TIDX(wvs); asm volatile("" : "+v"(tq_)); const int gt = blockIdx.x * NTHR + tq_, nt = gridDim.x * NTHR;
  for (int task = gt; task < 544 * 192; task += nt) {
    const int seg = task / 192, c = (task - seg * 192) * 8, rowb = seg * 32;
    float w[4][8], bia[8];
#pragma unroll
    for (int j = 0; j < 4; ++j) {
      const float4 w0 = *(const float4*)(p.conv_w + j * 1536 + c), w1 = *(const float4*)(p.conv_w + j * 1536 + c + 4);
      w[j][0] = w0.x; w[j][1] = w0.y; w[j][2] = w0.z; w[j][3] = w0.w; w[j][4] = w1.x; w[j][5] = w1.y; w[j][6] = w1.z; w[j][7] = w1.w;
    }
    { const float4 b0 = *(const float4*)(p.conv_b + c), b1 = *(const float4*)(p.conv_b + c + 4); bia[0] = b0.x; bia[1] = b0.y; bia[2] = b0.z; bia[3] = b0.w; bia[4] = b1.x; bia[5] = b1.y; bia[6] = b1.z; bia[7] = b1.w; }
    float x0[8], x1[8], x2[8];
    if (rowb < 16384 && (rowb & 2047) != 0) {
      const u32x4 v0 = *(const u32x4*)(proj + (size_t)(rowb - 3) * 3200 + 1024 + c), v1 = *(const u32x4*)(proj + (size_t)(rowb - 2) * 3200 + 1024 + c), v2 = *(const u32x4*)(proj + (size_t)(rowb - 1) * 3200 + 1024 + c);
#pragma unroll
      for (int e = 0; e < 4; ++e) { x0[2 * e] = lo2f(v0[e]); x0[2 * e + 1] = hi2f(v0[e]); x1[2 * e] = lo2f(v1[e]); x1[2 * e + 1] = hi2f(v1[e]); x2[2 * e] = lo2f(v2[e]); x2[2 * e + 1] = hi2f(v2[e]); }
    } else {
#pragma unroll
      for (int e = 0; e < 8; ++e) { x0[e] = 0.f; x1[e] = 0.f; x2[e] = 0.f; }
    }
    u32x4 nxt = *(const u32x4*)(proj + (size_t)rowb * 3200 + 1024 + c);
    for (int r = 0; r < 32; ++r) {
      const int row = rowb + r;
      const u32x4 cv = nxt;
      if (r + 1 < 32) nxt = *(const u32x4*)(proj + (size_t)(row + 1) * 3200 + 1024 + c);
      int t, T, sq;
      if (row < 16384) { t = row & 2047; T = 2048; sq = row >> 11; } else { t = (row - 16384) & 7; T = 8; sq = 8 + ((row - 16384) >> 3); }
      if (t == 0) {
        if (sq >= 8) {
          const float* sc = p.state_conv + (size_t)(sq - 8) * 3 * 1536 + c;
          const float4 a0 = *(const float4*)sc, a1 = *(const float4*)(sc + 4), b0 = *(const float4*)(sc + 1536), b1 = *(const float4*)(sc + 1540), c0 = *(const float4*)(sc + 3072), c1 = *(const float4*)(sc + 3076);
          x0[0] = a0.x; x0[1] = a0.y; x0[2] = a0.z; x0[3] = a0.w; x0[4] = a1.x; x0[5] = a1.y; x0[6] = a1.z; x0[7] = a1.w;
          x1[0] = b0.x; x1[1] = b0.y; x1[2] = b0.z; x1[3] = b0.w; x1[4] = b1.x; x1[5] = b1.y; x1[6] = b1.z; x1[7] = b1.w;
          x2[0] = c0.x; x2[1] = c0.y; x2[2] = c0.z; x2[3] = c0.w; x2[4] = c1.x; x2[5] = c1.y; x2[6] = c1.z; x2[7] = c1.w;
        } else {
#pragma unroll
          for (int e = 0; e < 8; ++e) { x0[e] = 0.f; x1[e] = 0.f; x2[e] = 0.f; }
        }
      }
      float cur[8], o[8];
#pragma unroll
      for (int e = 0; e < 4; ++e) { cur[2 * e] = lo2f(cv[e]); cur[2 * e + 1] = hi2f(cv[e]); }
#pragma unroll
      for (int e = 0; e < 8; ++e) { o[e] = siluf(bia[e] + w[0][e] * x0[e] + w[1][e] * x1[e] + w[2][e] * x2[e] + w[3][e] * cur[e]); x0[e] = x1[e]; x1[e] = x2[e]; x2[e] = cur[e]; }
      u32x4 ov; ov[0] = pack2(o[0], o[1]); ov[1] = pack2(o[2], o[3]); ov[2] = pack2(o[4], o[5]); ov[3] = pack2(o[6], o[7]);
      *(u32x4*)(xc + (size_t)row * 1536 + c) = ov;
      if (t >= T - 3) {
        float* d = p.out + O_CONV + ((size_t)sq * 3 + (t - (T - 3))) * 1536 + c;
        *(float4*)d = make_float4(cur[0], cur[1], cur[2], cur[3]); *(float4*)(d + 4) = make_float4(cur[4], cur[5], cur[6], cur[7]);
      }
    }
  }
}

__device__ __forceinline__ void ssdnorm_phase(const Params& p, int wvs) {
  const bf16_t* proj = (const bf16_t*)(p.ws + OFF_A);
  bf16_t* mix = (bf16_t*)(p.ws + OFF_H);
  const float* st = (const float*)(p.ws + OFF_SSDST);
  int tq_ = TIDX(wvs); asm volatile("" : "+v"(tq_)); const int gt = blockIdx.x * NTHR + tq_, nt = gridDim.x * NTHR;
  for (int it = gt; it < ROWS * 128; it += nt) {
    const int row = it >> 7, c = (it & 127) * 8;
    const float r = rsqrtf(st[(size_t)row * 2 + (c >> 9)] * (1.f / 512.f) + EPSV);
    const uint4 v = *(const uint4*)(proj + (size_t)row * 3200 + c);
    const float4 w0 = *(const float4*)(p.ssm_norm_w + c), w1 = *(const float4*)(p.ssm_norm_w + c + 4);
    uint4 o; o.x = pack2(lo2f(v.x) * r * w0.x, hi2f(v.x) * r * w0.y); o.y = pack2(lo2f(v.y) * r * w0.z, hi2f(v.y) * r * w0.w);
    o.z = pack2(lo2f(v.z) * r * w1.x, hi2f(v.z) * r * w1.y); o.w = pack2(lo2f(v.w) * r * w1.z, hi2f(v.w) * r * w1.w);
    *(uint4*)(mix + (size_t)row * 1536 + c) = o;
  }
}


#define XB_TMO      128
#define XB_XCNT(j)  (256  + 64 * (j))
#define XB_XSUB(j)  (1280 + 64 * (j))
#define XB_XGEN(j)  (2304 + 64 * (j))
#define XB_TOP      3328
#define XB_TOPGEN   3392
#define XCD_BAR_WORDS 3456
#define XB_SPIN_CAP (1u << 18)
#define LAS __attribute__((address_space(3)))
__device__ __forceinline__ unsigned xb_ld(unsigned* p)              { return __hip_atomic_load(p, __ATOMIC_RELAXED, __HIP_MEMORY_SCOPE_AGENT); }
__device__ __forceinline__ unsigned xb_add(unsigned* p, unsigned v) { return __hip_atomic_fetch_add(p, v, __ATOMIC_RELAXED, __HIP_MEMORY_SCOPE_AGENT); }
__device__ __forceinline__ unsigned xb_xcc_id() { return (unsigned)__builtin_amdgcn_s_getreg((3 << 11) | 20) & 0xFu; }
#define XB_SPIN(cond, bar) do { unsigned _sp = 0; while (cond) { __builtin_amdgcn_s_sleep(1); \
    if ((++_sp & 255u) == 0u) { if (xb_ld(&(bar)[XB_TMO])) break; if (_sp > XB_SPIN_CAP) { atomicAdd(&(bar)[XB_TMO], 1u); break; } } } } while (0)
struct XcdBarrier { unsigned* bar; unsigned x; volatile LAS unsigned* st; };
__device__ __forceinline__ XcdBarrier xcd_barrier_post(unsigned* bar, volatile LAS unsigned* st, int wvs) {
    XcdBarrier b; b.bar = bar; b.x = xb_xcc_id(); b.st = st;
    if (TIDX(wvs) == 0) (void)xb_add(&bar[XB_XCNT(b.x)], 1u);
    return b;
}
__device__ __forceinline__ void xcd_barrier_complete(unsigned* bar, unsigned x, unsigned& nloc, unsigned& nx) {
    const unsigned G = gridDim.x * gridDim.y * gridDim.z;
    unsigned sum, cnt, mine, sp = 0u;
    for (;;) {
        sum = 0u; cnt = 0u; mine = 0u;
#pragma unroll
        for (unsigned j = 0; j < 16; ++j) { const unsigned c = xb_ld(&bar[XB_XCNT(j)]); sum += c; cnt += (c > 0u) ? 1u : 0u; mine = (j == x) ? c : mine; }
        if (sum == G) break;
        __builtin_amdgcn_s_sleep(1);
        if ((++sp & 255u) == 0u) { if (xb_ld(&bar[XB_TMO])) break; if (sp > XB_SPIN_CAP) { atomicAdd(&bar[XB_TMO], 1u); break; } }
    }
    nloc = mine > 0u ? mine : 1u; nx = cnt > 0u ? cnt : 1u;
}
__device__ __forceinline__ void xcd_barrier(const XcdBarrier& b, int wvs) {
    asm volatile("s_waitcnt vmcnt(0)" ::: "memory");
    __syncthreads();
    if (TIDX(wvs) == 0) {
        unsigned* bar = b.bar;
        __builtin_amdgcn_s_waitcnt(0);
        unsigned nloc = b.st[0], nx = b.st[1];
        if (nloc == 0u) { xcd_barrier_complete(bar, b.x, nloc, nx); b.st[0] = nloc; b.st[1] = nx; }
        const unsigned old = xb_add(&bar[XB_XSUB(b.x)], 1u);
        const unsigned gen = old / nloc;
        if (old + 1u == (gen + 1u) * nloc) {
            __builtin_amdgcn_fence(__ATOMIC_RELEASE, "agent");
            asm volatile("s_waitcnt vmcnt(0)" ::: "memory");
            const unsigned og = xb_add(&bar[XB_TOP], 1u);
            const unsigned tg = og / nx;
            if (og + 1u == (tg + 1u) * nx) xb_add(&bar[XB_TOPGEN], 1u);
            else XB_SPIN(xb_ld(&bar[XB_TOPGEN]) == tg, bar);
            __builtin_amdgcn_fence(__ATOMIC_ACQUIRE, "agent");
            xb_add(&bar[XB_XGEN(b.x)], 1u);
            asm volatile("s_waitcnt vmcnt(0)" ::: "memory");
        } else {
            XB_SPIN(xb_ld(&bar[XB_XGEN(b.x)]) == gen, bar);
            __builtin_amdgcn_fence(__ATOMIC_ACQUIRE, "agent");
            asm volatile("s_waitcnt vmcnt(0)" ::: "memory");
        }
    }
    __syncthreads();
}


__device__ __forceinline__ Params ldp() {
  auto kp = __builtin_amdgcn_kernarg_segment_ptr();
  asm volatile("" : "+s"(kp));
  Params q;
  __builtin_memcpy(&q, (const void*)kp, sizeof(Params));
  return q;
}

__global__ void __launch_bounds__(NTHR, 2) fwd_megakernel(Params p_) {
  extern __shared__ __attribute__((aligned(16))) char smem[];
  cg::grid_group grid = cg::this_grid();
  if (p_.ws == nullptr) grid.sync();
  volatile LAS unsigned* xst = (volatile LAS unsigned*)(smem + 2 * HALF_LDS);
  const int wvs = __builtin_amdgcn_readfirstlane(threadIdx.x >> 6);
  if (TIDX(wvs) == 0) { xst[0] = 0u; xst[1] = 0u; xst[2] = 0u; xst[3] = 0u; }
  __syncthreads();
  const XcdBarrier xb = xcd_barrier_post((unsigned*)(p_.ws + OFF_BAR), xst, wvs);
  const int half = wvs >> 2;
  const int G = gridDim.x * 2, bid = blockIdx.x * 2 + half;
  char* hs = smem + half * HALF_LDS;
#define PH_BEGIN const Params p = ldp(); bf16_t* bufA = (bf16_t*)(p.ws + OFF_A); bf16_t* bufH = (bf16_t*)(p.ws + OFF_H); bf16_t* t0 = (bf16_t*)(p.ws + OFF_ST); \
    float* rowss = (float*)(p.ws + OFF_ROWSS); float* hbuf = p.out; (void)bufA; (void)bufH; (void)t0; (void)rowss; (void)hbuf;

  {
  PH_BEGIN
  prep_tables(p, wvs);
  wconv(p.w_in_even, 1024, 4096, 4096, (bf16_t*)(p.ws + W_IN), hs, wvs);
  wconv(p.w_out_even, 1024, 1024, 1024, (bf16_t*)(p.ws + W_OUT0), hs, wvs);
  wconv(p.w_ffn_up, 1024, 4096, 4096, (bf16_t*)(p.ws + W_UP), hs, wvs);
  wconv(p.w_ffn_down, 4096, 1024, 1024, (bf16_t*)(p.ws + W_DOWN), hs, wvs);
  rowpass_phase(nullptr, nullptr, nullptr, p.x_prompt, p.x_sample, nullptr, p.norm_mix_pre, bufH, wvs);
  }
  xcd_barrier(xb, wvs);
  {
  PH_BEGIN
  { EpiInEven e{bufA, (const float*)(p.ws + OFF_ROPE), (const float*)(p.ws + OFF_LB)};
    for (int rep_ = 0; rep_ < REPG; ++rep_) { gemm_phase(bufH, 1024, (const bf16_t*)(p.ws + W_IN), 1024, 64, 16, 1024, e, smem, wvs); gemm_tail(bufH, 1024, (const bf16_t*)(p.ws + W_IN), 1024, 32, 1024, e, smem, wvs, 64 * 16); } }
  }
  xcd_barrier(xb, wvs);
  {
  PH_BEGIN
  for (int rep_ = 0; rep_ < REPS; ++rep_) {
    if (bid < 256) {
      const int v = bid;
      const int ps = v & 3, m = (v >> 2) & 1, h = (v >> 3) & 3, sq = v >> 5;
      if (m == 0) state_unit<0>(p, sq, h, ps, hs, wvs); else state_unit<1>(p, sq, h, ps, hs, wvs);
    }
    const int nsh = bid < 256 ? 2 : 14, j0 = bid < 256 ? bid : 512 + (bid - 256);
    for (int i = 0; i < nsh; ++i) {
      const int v = j0 + 256 * i;
      const int ps = v & 3, m = (v >> 2) & 1, h = (v >> 3) & 3, sq = 8 + (v >> 5);
      if (m == 0) state_unit<0>(p, sq, h, ps, hs, wvs); else state_unit<1>(p, sq, h, ps, hs, wvs);
    }
  }
  }
  xcd_barrier(xb, wvs);
  {
  PH_BEGIN
  for (int rep_ = 0; rep_ < REPO; ++rep_)
  for (int u = bid; u < 384 * 8; u += G) {
    const int h = u & 3, m = (u >> 2) & 1, c = u >> 3;
    if (m == 0) out_unit<0>(p, c, h, hs, wvs); else out_unit<1>(p, c, h, hs, wvs);
  }
  }
  xcd_barrier(xb, wvs);
  {
  PH_BEGIN
  { EpiOut e{t0, rowss};
    for (int rep_ = 0; rep_ < REPG; ++rep_) { gemm_phase(bufH, 1024, (const bf16_t*)(p.ws + W_OUT0), 1024, 64, 4, 1024, e, smem, wvs); gemm_tail(bufH, 1024, (const bf16_t*)(p.ws + W_OUT0), 1024, 8, 1024, e, smem, wvs, 64 * 4); } }
  }
  xcd_barrier(xb, wvs);
  {
  PH_BEGIN
  for (int rep_ = 0; rep_ < REPR; ++rep_)
  rowpass_phase(t0, rowss, p.norm_mix_post, p.x_prompt, p.x_sample, hbuf, p.norm_ffn_pre, bufH, wvs);
  }
  xcd_barrier(xb, wvs);
  {
  PH_BEGIN
  { EpiUp e{bufA}; for (int rep_ = 0; rep_ < REPG; ++rep_) { gemm_phase(bufH, 1024, (const bf16_t*)(p.ws + W_UP), 1024, 64, 16, 1024, e, smem, wvs); gemm_tail(bufH, 1024, (const bf16_t*)(p.ws + W_UP), 1024, 32, 1024, e, smem, wvs, 64 * 16); } }
  }
  xcd_barrier(xb, wvs);
  {
  PH_BEGIN
  { EpiOut e{t0, rowss + ROWS}; for (int rep_ = 0; rep_ < REPG; ++rep_) { gemm_phase(bufA, 4096, (const bf16_t*)(p.ws + W_DOWN), 4096, 64, 4, 4096, e, smem, wvs); gemm_tail(bufA, 4096, (const bf16_t*)(p.ws + W_DOWN), 4096, 8, 4096, e, smem, wvs, 64 * 4); } }
  }
  xcd_barrier(xb, wvs);
  {
  PH_BEGIN
  rowpass_phase(t0, rowss + ROWS, p.norm_ffn_post, hbuf, hbuf + (size_t)16384 * 1024, hbuf, p.norm_mix_pre + 1024, bufH, wvs);
  wconv(p.w_in_odd, 1024, 3088, 3328, (bf16_t*)(p.ws + W_IN), hs, wvs);
  wconv(p.w_glu, 512, 512, 512, (bf16_t*)(p.ws + W_GLU), hs, wvs);
  wconv(p.w_out_odd, 1536, 1024, 1024, (bf16_t*)(p.ws + W_OUT1), hs, wvs);
  wconv(p.w_ffn_up + (size_t)1024 * 4096, 1024, 4096, 4096, (bf16_t*)(p.ws + W_UP), hs, wvs);
  wconv(p.w_ffn_down + (size_t)4096 * 1024, 4096, 1024, 1024, (bf16_t*)(p.ws + W_DOWN), hs, wvs);
  }
  xcd_barrier(xb, wvs);
  {
  PH_BEGIN
  { EpiInOdd e{bufA, (float*)(p.ws + OFF_DTBUF)};
    for (int rep_ = 0; rep_ < REPG; ++rep_) { gemm_phase(bufH, 1024, (const bf16_t*)(p.ws + W_IN), 1024, 64, 13, 1024, e, smem, wvs); gemm_tail(bufH, 1024, (const bf16_t*)(p.ws + W_IN), 1024, 26, 1024, e, smem, wvs, 64 * 13); } }
  }
  xcd_barrier(xb, wvs);
  {
  PH_BEGIN
  for (int rep_ = 0; rep_ < REPC; ++rep_) {
  conv_phase(p, wvs);
  for (int u = bid; u < 384 * 8; u += G) s5_unit<0>(p, u >> 3, u & 7, hs, wvs);
  }
  }
  xcd_barrier(xb, wvs);
  {
  PH_BEGIN
  for (int rep_ = 0; rep_ < REPS; ++rep_) {
    if (bid < 128) state_unit<2>(p, bid >> 4, bid & 15, 0, hs, wvs);
    for (int j = bid < 128 ? bid : 256 + (bid - 128); j < 3136; j += (bid < 128 ? 128 : 384)) {
      if (bid < 128 && j >= 256) break;
      if (j < 1088) { int tq_ = TIDX(wvs) & 255; asm volatile("" : "+v"(tq_)); s5_prefix(p, j * 256 + tq_); }
      else { const int v = j - 1088; state_unit<2>(p, 8 + (v >> 4), v & 15, 0, hs, wvs); }
    }
  }
  }
  xcd_barrier(xb, wvs);
  {
  PH_BEGIN
  for (int u = bid; u < 384 * 16 + 384 * 8; u += G) {
    if (u < 384 * 16) out_unit<2>(p, u >> 4, u & 15, hs, wvs);
    else { const int v = u - 384 * 16; s5_unit<1>(p, v >> 3, v & 7, hs, wvs); }
  }
  }
  xcd_barrier(xb, wvs);
  {
  PH_BEGIN
  ssdnorm_phase(p, wvs);
  { EpiGlu e{(const bf16_t*)(p.ws + OFF_GBUF), p.b_glu, bufH};
    for (int rep_ = 0; rep_ < REPG; ++rep_) { gemm_phase((const bf16_t*)(p.ws + OFF_GBUF), 512, (const bf16_t*)(p.ws + W_GLU), 512, 64, 2, 512, e, smem, wvs); gemm_tail((const bf16_t*)(p.ws + OFF_GBUF), 512, (const bf16_t*)(p.ws + W_GLU), 512, 4, 512, e, smem, wvs, 64 * 2); } }
  }
  xcd_barrier(xb, wvs);
  {
  PH_BEGIN
  { EpiOut e{t0, rowss + 2 * ROWS}; for (int rep_ = 0; rep_ < REPG; ++rep_) { gemm_phase(bufH, 1536, (const bf16_t*)(p.ws + W_OUT1), 1536, 64, 4, 1536, e, smem, wvs); gemm_tail(bufH, 1536, (const bf16_t*)(p.ws + W_OUT1), 1536, 8, 1536, e, smem, wvs, 64 * 4); } }
  }
  xcd_barrier(xb, wvs);
  {
  PH_BEGIN
  rowpass_phase(t0, rowss + 2 * ROWS, p.norm_mix_post + 1024, hbuf, hbuf + (size_t)16384 * 1024, hbuf, p.norm_ffn_pre + 1024, bufH, wvs);
  }
  xcd_barrier(xb, wvs);
  {
  PH_BEGIN
  { EpiUp e{bufA}; for (int rep_ = 0; rep_ < REPG; ++rep_) { gemm_phase(bufH, 1024, (const bf16_t*)(p.ws + W_UP), 1024, 64, 16, 1024, e, smem, wvs); gemm_tail(bufH, 1024, (const bf16_t*)(p.ws + W_UP), 1024, 32, 1024, e, smem, wvs, 64 * 16); } }
  }
  xcd_barrier(xb, wvs);
  {
  PH_BEGIN
  { EpiOut e{t0, rowss + 3 * ROWS}; for (int rep_ = 0; rep_ < REPG; ++rep_) { gemm_phase(bufA, 4096, (const bf16_t*)(p.ws + W_DOWN), 4096, 64, 4, 4096, e, smem, wvs); gemm_tail(bufA, 4096, (const bf16_t*)(p.ws + W_DOWN), 4096, 8, 4096, e, smem, wvs, 64 * 4); } }
  }
  xcd_barrier(xb, wvs);
  {
  PH_BEGIN
  rowpass_phase(t0, rowss + 3 * ROWS, p.norm_ffn_post + 1024, hbuf, hbuf + (size_t)16384 * 1024, hbuf, nullptr, nullptr, wvs);
  }
}

extern "C" void kernel_launch(void* const* d_in, const int* in_sizes, int n_in, void* d_out, int out_size, void* d_ws, size_t ws_size, hipStream_t stream) {
  constexpr size_t kDynLds = 2 * HALF_LDS + 64;
  static int grid_blocks = 0;
  if (!grid_blocks) {
    int dev = 0, cus = 0, per_cu = 0;
    (void)hipGetDevice(&dev);
    (void)hipDeviceGetAttribute(&cus, hipDeviceAttributeMultiprocessorCount, dev);
    (void)hipFuncSetAttribute((const void*)fwd_megakernel, hipFuncAttributeMaxDynamicSharedMemorySize, (int)kDynLds);
    (void)hipOccupancyMaxActiveBlocksPerMultiprocessor(&per_cu, fwd_megakernel, NTHR, kDynLds);
    if (per_cu > 1) per_cu = 1;
    if (per_cu < 1) per_cu = 1;
    grid_blocks = cus * per_cu;
  }
  Params p{};
  const float** pf = (const float**)&p;
  for (int i = 0; i < 37; ++i) pf[i] = (const float*)d_in[i];
  p.out = (float*)d_out;
  p.ws = (char*)d_ws;
  (void)hipMemsetAsync((char*)d_ws + OFF_BAR, 0, 16384, stream);
  void* args[] = {&p};
  hipError_t e = hipLaunchCooperativeKernel((void*)fwd_megakernel, dim3(grid_blocks), dim3(NTHR), args, kDynLds, stream);
  if (e != hipSuccess) fprintf(stderr, "cooperative launch failed: %s (grid %d)\n", hipGetErrorString(e), grid_blocks);
}
```

```cpp
#include <hip/hip_runtime.h>
#include <hip/hip_cooperative_groups.h>
#include <cstdio>
namespace cg = cooperative_groups;

typedef unsigned short bf16_t;
typedef short bf16x8 __attribute__((ext_vector_type(8)));
typedef float f32x4 __attribute__((ext_vector_type(4)));
typedef unsigned u32x4 __attribute__((ext_vector_type(4)));
typedef float f32x2 __attribute__((ext_vector_type(2)));

#define NTHR 512
#ifndef REPS
#define REPS 1
#endif
#ifndef REPO
#define REPO 1
#endif
#ifndef REPC
#define REPC 1
#endif
#ifndef REPR
#define REPR 1
#endif
#ifndef REPG
#define REPG 1
#endif
#define HALF_LDS 74752
#ifndef REP0
#define REP0 1
#endif
#ifndef REPS
#define REPS 1
#endif
#ifndef REPO
#define REPO 1
#endif
#ifndef REPC
#define REPC 1
#endif
#ifndef REPY
#define REPY 21
#endif
#define ROWS 17408
#define EPSV 1e-6f
#define TIDX(w) ((w) * 64 + (int)__builtin_amdgcn_mbcnt_hi(~0u, __builtin_amdgcn_mbcnt_lo(~0u, 0u)))

constexpr size_t W_IN = 0;
constexpr size_t W_OUT0 = 8388608;
constexpr size_t W_GLU = 6815744;
constexpr size_t W_OUT1 = 7340032;
constexpr size_t W_UP = 10485760;
constexpr size_t W_DOWN = 18874368;
constexpr size_t OFF_A = 29360128;
constexpr size_t OFF_GBUF = OFF_A + 111411200;
constexpr size_t OFF_ST = OFF_A + 142606336;
constexpr size_t OFF_H = OFF_ST + 67108864;
constexpr size_t OFF_SM = OFF_H + 53477376;
constexpr size_t OFF_ROPE = OFF_SM;
constexpr size_t OFF_ROWSS = OFF_SM + 1052672;
constexpr size_t OFF_SSDST = OFF_SM + 1331200;
constexpr size_t OFF_DTBUF = OFF_SM + 1470464;
constexpr size_t OFF_LB = OFF_SM + 2584576;
constexpr size_t OFF_S5TAB = OFF_SM + 2586624;
constexpr size_t OFF_S5E = OFF_SM + 2897920;
constexpr size_t OFF_S5H = OFF_SM + 9189376;
constexpr size_t OFF_BAR = OFF_SM + 15480832;

constexpr size_t O_RET = 17825792, O_HG = 26738688, O_SSM = 35651584, O_CONV = 53477376, O_S5RE = 54104064, O_S5IM = 54382592;

struct Params {
  const float *x_prompt, *x_sample, *state_ret, *state_hgrn, *state_ssm, *state_conv, *state_s5_re, *state_s5_im;
  const float *norm_mix_pre, *norm_mix_post, *norm_ffn_pre, *norm_ffn_post;
  const float *w_in_even, *w_out_even, *ret_norm_w, *hgrn_lb, *hgrn_norm_w, *w_in_odd, *conv_w, *conv_b, *dt_bias, *a_log, *d_ssm, *ssm_norm_w;
  const float *s5_lam_re, *s5_lam_im, *s5_log_step, *s5_b_re, *s5_b_im, *s5_c_re, *s5_c_im, *s5_d, *w_glu, *b_glu, *w_out_odd, *w_ffn_up, *w_ffn_down;
  float* out;
  char* ws;
};

__device__ __forceinline__ bf16_t f2bf(float f) { unsigned r; asm("v_cvt_pk_bf16_f32 %0, %1, %1" : "=v"(r) : "v"(f)); return (bf16_t)(r & 0xffffu); }
__device__ __forceinline__ float bf2f(bf16_t h) { return __uint_as_float(((unsigned)h) << 16); }
__device__ __forceinline__ unsigned pack2(float a, float b) { unsigned r; asm("v_cvt_pk_bf16_f32 %0, %1, %2" : "=v"(r) : "v"(a), "v"(b)); return r; }
__device__ __forceinline__ float lo2f(unsigned u) { return __uint_as_float(u << 16); }
__device__ __forceinline__ float hi2f(unsigned u) { return __uint_as_float(u & 0xffff0000u); }
__device__ __forceinline__ float sigm(float x) { return 1.f / (1.f + __expf(-x)); }
__device__ __forceinline__ float siluf(float x) { return x / (1.f + __expf(-x)); }
__device__ __forceinline__ void store4bf(bf16_t* p, float a, float b, float c, float d) { uint2 v; v.x = pack2(a, b); v.y = pack2(c, d); *(uint2*)p = v; }

__device__ __forceinline__ float shx(float v, int mask) {
  int l = (int)__builtin_amdgcn_mbcnt_hi(~0u, __builtin_amdgcn_mbcnt_lo(~0u, 0u));
  asm volatile("" : "+v"(l));
  return __int_as_float(__builtin_amdgcn_ds_bpermute((l ^ mask) << 2, __float_as_int(v)));
}

template <int MT, int NT>
__device__ __forceinline__ void wmma_sw(f32x4 (&acc)[MT][NT], const bf16_t* A, int lda, const bf16_t* B, int ldb, int K, int lane) {
  const int r = lane & 15, kq = (lane >> 4) * 8;
  for (int k0 = 0; k0 < K; k0 += 32) {
    bf16x8 af[MT], bfr[NT];
#pragma unroll
    for (int mt = 0; mt < MT; ++mt) af[mt] = *(const bf16x8*)(A + (mt * 16 + r) * lda + k0 + kq);
#pragma unroll
    for (int nt = 0; nt < NT; ++nt) bfr[nt] = *(const bf16x8*)(B + (nt * 16 + r) * ldb + k0 + kq);
#pragma unroll
    for (int mt = 0; mt < MT; ++mt)
#pragma unroll
      for (int nt = 0; nt < NT; ++nt) acc[mt][nt] = __builtin_amdgcn_mfma_f32_16x16x32_bf16(bfr[nt], af[mt], acc[mt][nt], 0, 0, 0);
  }
}
template <int MT, int NT>
__device__ __forceinline__ void wmma_ns(f32x4 (&acc)[MT][NT], const bf16_t* A, int lda, const bf16_t* B, int ldb, int K, int lane) {
  const int r = lane & 15, kq = (lane >> 4) * 8;
  for (int k0 = 0; k0 < K; k0 += 32) {
    bf16x8 af[MT], bfr[NT];
#pragma unroll
    for (int mt = 0; mt < MT; ++mt) af[mt] = *(const bf16x8*)(A + (mt * 16 + r) * lda + k0 + kq);
#pragma unroll
    for (int nt = 0; nt < NT; ++nt) bfr[nt] = *(const bf16x8*)(B + (nt * 16 + r) * ldb + k0 + kq);
#pragma unroll
    for (int mt = 0; mt < MT; ++mt)
#pragma unroll
      for (int nt = 0; nt < NT; ++nt) acc[mt][nt] = __builtin_amdgcn_mfma_f32_16x16x32_bf16(af[mt], bfr[nt], acc[mt][nt], 0, 0, 0);
  }
}

__device__ __forceinline__ void gemm_kstep(f32x4 (&acc)[4][8], const char* A, const char* B) {
  bf16x8 af[4], bfr[8];
#pragma unroll
  for (int mt = 0; mt < 4; ++mt) af[mt] = *(const bf16x8*)(A + mt * 2048);
#pragma unroll
  for (int nt = 0; nt < 8; ++nt) bfr[nt] = *(const bf16x8*)(B + nt * 2048);
  __builtin_amdgcn_sched_barrier(0);
#pragma unroll
  for (int nt = 0; nt < 8; ++nt)
#pragma unroll
    for (int mt = 0; mt < 4; ++mt) acc[mt][nt] = __builtin_amdgcn_mfma_f32_16x16x32_bf16(bfr[nt], af[mt], acc[mt][nt], 0, 0, 0);
}

template <class Epi>
__device__ __forceinline__ void gemm_phase(const bf16_t* A, int lda, const bf16_t* Bt, int ldb, int nMt, int nNt, int K, const Epi& epi, char* smem, int wvs) {
  char* As = smem;
  char* Bs = smem + 65536;
  int tid_ = TIDX(wvs); asm volatile("" : "+v"(tid_)); const int tid = tid_, lane = tid & 63, wave = tid >> 6;
  const int wr = wave >> 1, wc = wave & 1;
  const int ntiles = nMt * nNt, nk = K >> 6;
  const int lrow = tid >> 3, lcc = (tid & 7) * 8;
  const int wofs = ((lrow >> 4) * 2 + (lcc >> 5)) * 1024 + ((((lrow & 15) * 64) + (lcc & 31) * 2) ^ ((lrow & 8) << 2));
  const int rofs = (((lane & 15) * 64) + (lane >> 4) * 16) ^ ((lane & 8) << 2);
  const unsigned toffA = (unsigned)(lrow * lda + lcc), toffB = (unsigned)(lrow * ldb + lcc);
  for (int tile = blockIdx.x; tile < ntiles; tile += gridDim.x) {
    const int pn = tile / nMt, pm = tile - pn * nMt;
    const bf16_t* Ab = A + (size_t)(pm * 256) * lda;
    const bf16_t* Bb = Bt + (size_t)(pn * 256) * ldb;
    f32x4 acc[4][8];
#pragma unroll
    for (int i = 0; i < 4; ++i)
#pragma unroll
      for (int j = 0; j < 8; ++j) acc[i][j] = (f32x4){0.f, 0.f, 0.f, 0.f};
    u32x4 rg[4];
#pragma unroll
    for (int i = 0; i < 4; ++i) rg[i] = *(const u32x4*)(Ab + (size_t)(i * 64) * lda + toffA);
#pragma unroll
    for (int i = 0; i < 4; ++i) *(u32x4*)(As + wofs + i * 8192) = rg[i];
#pragma unroll
    for (int i = 0; i < 4; ++i) rg[i] = *(const u32x4*)(Bb + (size_t)(i * 64) * ldb + toffB);
#pragma unroll
    for (int i = 0; i < 4; ++i) *(u32x4*)(Bs + wofs + i * 8192) = rg[i];
    __syncthreads();
#pragma unroll 1
    for (int kt = 0; kt < nk; ++kt) {
      const int cur = kt & 1;
      const int kn = (kt + 1 < nk ? kt + 1 : kt) * 64;
      char* Ad = As + (cur ^ 1) * 32768; char* Bd = Bs + (cur ^ 1) * 32768;
#pragma unroll
      for (int i = 0; i < 4; ++i) rg[i] = *(const u32x4*)(Ab + ((size_t)(i * 64) * lda + kn) + toffA);
      __builtin_amdgcn_sched_barrier(0);
      gemm_kstep(acc, As + cur * 32768 + wr * 8192 + rofs, Bs + cur * 32768 + wc * 16384 + rofs);
      __builtin_amdgcn_sched_barrier(0);
#pragma unroll
      for (int i = 0; i < 4; ++i) *(u32x4*)(Ad + wofs + i * 8192) = rg[i];
#pragma unroll
      for (int i = 0; i < 4; ++i) rg[i] = *(const u32x4*)(Bb + ((size_t)(i * 64) * ldb + kn) + toffB);
      __builtin_amdgcn_sched_barrier(0);
      gemm_kstep(acc, As + cur * 32768 + wr * 8192 + 1024 + rofs, Bs + cur * 32768 + wc * 16384 + 1024 + rofs);
      __builtin_amdgcn_sched_barrier(0);
#pragma unroll
      for (int i = 0; i < 4; ++i) *(u32x4*)(Bd + wofs + i * 8192) = rg[i];
      __syncthreads();
    }
    int er_ = pm * 256 + wr * 64, ec_ = pn * 256 + wc * 128, el_ = lane;
    asm volatile("" : "+v"(er_), "+v"(ec_), "+v"(el_));
    epi(acc, er_, ec_, el_);
  }
}

struct EpiInEven {
  bf16_t* proj; const float* rope; const float* lb;
  template <int MT> __device__ __forceinline__ void operator()(f32x4 (&acc)[MT][8], int rbase, int cbase, int lane) const {
    const int sec = cbase >> 9, head = (cbase >> 7) & 3, r = lane & 15, cq = (lane >> 4) * 4;
#pragma unroll
    for (int mt = 0; mt < MT; ++mt) {
      __builtin_amdgcn_sched_barrier(0);
      const int row = rbase + mt * 16 + r;
      bf16_t* dst = proj + (size_t)row * 4096 + cbase + cq;
      if (sec < 2) {
        const int pidx = row < 16384 ? (row & 2047) : 2048 + ((row - 16384) & 7);
        const float* ct = rope + pidx * 128 + cq;
        const float sc = sec == 1 ? 0.08838834764831845f : 1.f;
        float4 cc4[4], ss4[4];
#pragma unroll
        for (int nt = 0; nt < 4; ++nt) { cc4[nt] = *(const float4*)(ct + nt * 16); ss4[nt] = *(const float4*)(ct + 64 + nt * 16); }
#pragma unroll
        for (int nt = 0; nt < 4; ++nt) {
          const float4 c4 = cc4[nt], s4 = ss4[nt];
          const f32x4 x1 = acc[mt][nt], x2 = acc[mt][nt + 4];
          store4bf(dst + nt * 16, (x1[0] * c4.x - x2[0] * s4.x) * sc, (x1[1] * c4.y - x2[1] * s4.y) * sc, (x1[2] * c4.z - x2[2] * s4.z) * sc, (x1[3] * c4.w - x2[3] * s4.w) * sc);
          store4bf(dst + 64 + nt * 16, (x1[0] * s4.x + x2[0] * c4.x) * sc, (x1[1] * s4.y + x2[1] * c4.y) * sc, (x1[2] * s4.z + x2[2] * c4.z) * sc, (x1[3] * s4.w + x2[3] * c4.w) * sc);
        }
      } else if (sec == 5) {
        float4 ll4[8];
#pragma unroll
        for (int nt = 0; nt < 8; ++nt) ll4[nt] = *(const float4*)(lb + head * 128 + nt * 16 + cq);
#pragma unroll
        for (int nt = 0; nt < 8; ++nt) {
          const float4 l4 = ll4[nt];
          const f32x4 x = acc[mt][nt];
          store4bf(dst + nt * 16, __logf(l4.x + (1.f - l4.x) * sigm(x[0])), __logf(l4.y + (1.f - l4.y) * sigm(x[1])), __logf(l4.z + (1.f - l4.z) * sigm(x[2])), __logf(l4.w + (1.f - l4.w) * sigm(x[3])));
        }
      } else {
#pragma unroll
        for (int nt = 0; nt < 8; ++nt) { const f32x4 x = acc[mt][nt]; store4bf(dst + nt * 16, x[0], x[1], x[2], x[3]); }
      }
    }
  }
};
struct EpiOut {
  bf16_t* t0; float* rowss;
  template <int MT> __device__ __forceinline__ void operator()(f32x4 (&acc)[MT][8], int rbase, int cbase, int lane) const {
    const int r = lane & 15, cq = (lane >> 4) * 4;
#pragma unroll
    for (int mt = 0; mt < MT; ++mt) {
      __builtin_amdgcn_sched_barrier(0);
      const int row = rbase + mt * 16 + r;
      bf16_t* dst = t0 + (size_t)row * 1024 + cbase + cq;
      float ss = 0.f;
#pragma unroll
      for (int nt = 0; nt < 8; ++nt) { const f32x4 x = acc[mt][nt]; ss += x[0] * x[0] + x[1] * x[1] + x[2] * x[2] + x[3] * x[3]; store4bf(dst + nt * 16, x[0], x[1], x[2], x[3]); }
      ss += shx(ss, 16); ss += shx(ss, 32);
      if (lane < 16) atomicAdd(rowss + row, ss * (1.f / REPG));
    }
  }
};
struct EpiUp {
  bf16_t* act;
  template <int MT> __device__ __forceinline__ void operator()(f32x4 (&acc)[MT][8], int rbase, int cbase, int lane) const {
    const int r = lane & 15, cq = (lane >> 4) * 4;
#pragma unroll
    for (int mt = 0; mt < MT; ++mt) {
      __builtin_amdgcn_sched_barrier(0);
      bf16_t* dst = act + (size_t)(rbase + mt * 16 + r) * 4096 + cbase + cq;
#pragma unroll
      for (int nt = 0; nt < 8; ++nt) { f32x4 x = acc[mt][nt];
#pragma unroll
        for (int j = 0; j < 4; ++j) { float v = fmaxf(x[j], 0.f); x[j] = v * v; }
        store4bf(dst + nt * 16, x[0], x[1], x[2], x[3]); }
    }
  }
};
struct EpiInOdd {
  bf16_t* proj; float* dtbuf;
  template <int MT> __device__ __forceinline__ void operator()(f32x4 (&acc)[MT][8], int rbase, int cbase, int lane) const {
    const int r = lane & 15, cq = (lane >> 4) * 4;
#pragma unroll
    for (int mt = 0; mt < MT; ++mt) {
      __builtin_amdgcn_sched_barrier(0);
      const int row = rbase + mt * 16 + r;
      bf16_t* dst = proj + (size_t)row * 3200 + cbase + cq;
#pragma unroll
      for (int nt = 0; nt < 8; ++nt) { const f32x4 x = acc[mt][nt]; if (cbase + nt * 16 < 3200) store4bf(dst + nt * 16, x[0], x[1], x[2], x[3]); }
      if (cbase == 2560) { const f32x4 x = acc[mt][0]; *(float4*)(dtbuf + (size_t)row * 16 + cq) = make_float4(x[0], x[1], x[2], x[3]); }
    }
  }
};
struct EpiGlu {
  const bf16_t* gbuf; const float* bglu; bf16_t* mix;
  template <int MT> __device__ __forceinline__ void operator()(f32x4 (&acc)[MT][8], int rbase, int cbase, int lane) const {
    const int r = lane & 15, cq = (lane >> 4) * 4;
#pragma unroll
    for (int mt = 0; mt < MT; ++mt) {
      __builtin_amdgcn_sched_barrier(0);
      const int row = rbase + mt * 16 + r;
      uint2 gg2[8]; float4 bb4[8];
#pragma unroll
      for (int nt = 0; nt < 8; ++nt) { const int col = cbase + nt * 16 + cq; gg2[nt] = *(const uint2*)(gbuf + (size_t)row * 512 + col); bb4[nt] = *(const float4*)(bglu + col); }
#pragma unroll
      for (int nt = 0; nt < 8; ++nt) {
        const int col = cbase + nt * 16 + cq;
        const f32x4 x = acc[mt][nt];
        const uint2 g2 = gg2[nt];
        const float4 b4 = bb4[nt];
        store4bf(mix + (size_t)row * 1536 + 1024 + col, lo2f(g2.x) * sigm(x[0] + b4.x), hi2f(g2.x) * sigm(x[1] + b4.y), lo2f(g2.y) * sigm(x[2] + b4.z), hi2f(g2.y) * sigm(x[3] + b4.w));
      }
    }
  }
};

template <class Epi>
__device__ __forceinline__ void gemm_tail(const bf16_t* A, int lda, const bf16_t* Bt, int ldb, int nNt128, int K, const Epi& epi, char* smem, int wvs, int nBig) {
  bf16_t* As = (bf16_t*)smem;
  bf16_t* Bs = As + 2 * 128 * 80;
  int tid_ = TIDX(wvs); asm volatile("" : "+v"(tid_)); const int tid = tid_, lane = tid & 63, wave = tid >> 6;
  const int nk = K >> 6, G = gridDim.x;
  const int lrow = tid >> 3, lcc = (tid & 7) * 8;
  const unsigned toffA = (unsigned)(lrow * lda + lcc), toffB = (unsigned)(lrow * ldb + lcc);
  const int rr = nBig % G, nLight = G - rr;
  const int nSmall = 8 * nNt128;
  if ((int)blockIdx.x >= rr) {
    for (int j = (int)blockIdx.x - rr; j < nSmall; j += nLight) {
      const int pm = j / nNt128, pn = j - pm * nNt128;
      const bf16_t* Ab = A + (size_t)(16384 + pm * 128) * lda;
      const bf16_t* Bb = Bt + (size_t)(pn * 128) * ldb;
      f32x4 acc[1][8];
#pragma unroll
      for (int q = 0; q < 8; ++q) acc[0][q] = (f32x4){0.f, 0.f, 0.f, 0.f};
      u32x4 ra[2], rb[2];
#pragma unroll
      for (int i = 0; i < 2; ++i) { ra[i] = *(const u32x4*)(Ab + (size_t)(i * 64) * lda + toffA); rb[i] = *(const u32x4*)(Bb + (size_t)(i * 64) * ldb + toffB); }
#pragma unroll
      for (int i = 0; i < 2; ++i) { *(u32x4*)(As + (lrow + i * 64) * 80 + lcc) = ra[i]; *(u32x4*)(Bs + (lrow + i * 64) * 80 + lcc) = rb[i]; }
      __syncthreads();
#pragma unroll 1
      for (int kt = 0; kt < nk; ++kt) {
        const int cur = kt & 1;
        const int kn = (kt + 1 < nk ? kt + 1 : kt) * 64;
#pragma unroll
        for (int i = 0; i < 2; ++i) { ra[i] = *(const u32x4*)(Ab + ((size_t)(i * 64) * lda + kn) + toffA); rb[i] = *(const u32x4*)(Bb + ((size_t)(i * 64) * ldb + kn) + toffB); }
        __builtin_amdgcn_sched_barrier(0);
        wmma_sw<1, 8>(acc, As + cur * 128 * 80 + wave * 16 * 80, 80, Bs + cur * 128 * 80, 80, 64, lane);
        __builtin_amdgcn_sched_barrier(0);
        bf16_t* Ad = As + (cur ^ 1) * 128 * 80; bf16_t* Bd = Bs + (cur ^ 1) * 128 * 80;
#pragma unroll
        for (int i = 0; i < 2; ++i) { *(u32x4*)(Ad + (lrow + i * 64) * 80 + lcc) = ra[i]; *(u32x4*)(Bd + (lrow + i * 64) * 80 + lcc) = rb[i]; }
        __syncthreads();
      }
      int er_ = 16384 + pm * 128 + wave * 16, ec_ = pn * 128, el_ = lane;
      asm volatile("" : "+v"(er_), "+v"(ec_), "+v"(el_));
      epi(acc, er_, ec_, el_);
    }
  }
}

__device__ __forceinline__ void rowpass_phase(const bf16_t* t0, const float* rowss, const float* wpost, const float* hin_a, const float* hin_b, float* hout, const float* wnext, bf16_t* hn, int wvs) {
  int tq_ = TIDX(wvs); asm volatile("" : "+v"(tq_)); const int lane = tq_ & 63, gw = blockIdx.x * 8 + (tq_ >> 6), nw = gridDim.x * 8;
  for (int row = gw; row < ROWS; row += nw) {
    const float* hin = row < 16384 ? hin_a + (size_t)row * 1024 : hin_b + (size_t)(row - 16384) * 1024;
    float r0 = 0.f;
    if (t0) r0 = rsqrtf(rowss[row] * (1.f / 1024.f) + EPSV);
    float4 v[4]; float ss = 0.f;
    float4 hvv[4], wpv[4], wnv[4]; uint2 tv[4];
#pragma unroll
    for (int i = 0; i < 4; ++i) {
      const int col = (i * 64 + lane) * 4;
      hvv[i] = *(const float4*)(hin + col);
      if (t0) { tv[i] = *(const uint2*)(t0 + (size_t)row * 1024 + col); wpv[i] = *(const float4*)(wpost + col); }
      if (hn) wnv[i] = *(const float4*)(wnext + col);
    }
#pragma unroll
    for (int i = 0; i < 4; ++i) {
      const int col = (i * 64 + lane) * 4;
      float4 hv = hvv[i];
      if (t0) {
        const uint2 t2 = tv[i];
        const float4 w4 = wpv[i];
        hv.x += lo2f(t2.x) * r0 * w4.x; hv.y += hi2f(t2.x) * r0 * w4.y; hv.z += lo2f(t2.y) * r0 * w4.z; hv.w += hi2f(t2.y) * r0 * w4.w;
      }
      v[i] = hv; ss += hv.x * hv.x + hv.y * hv.y + hv.z * hv.z + hv.w * hv.w;
      if (hout) *(float4*)(hout + (size_t)row * 1024 + col) = hv;
    }
    if (hn) {
#pragma unroll
      for (int o = 32; o >= 1; o >>= 1) ss += shx(ss, o);
      const float r1 = rsqrtf(ss * (1.f / 1024.f) + EPSV);
#pragma unroll
      for (int i = 0; i < 4; ++i) {
        const int col = (i * 64 + lane) * 4;
        const float4 w4 = wnv[i];
        store4bf(hn + (size_t)row * 1024 + col, v[i].x * r1 * w4.x, v[i].y * r1 * w4.y, v[i].z * r1 * w4.z, v[i].w * r1 * w4.w);
      }
    }
  }
}

__device__ __forceinline__ void wconv(const float* __restrict__ W, int K, int N, int Npad, bf16_t* __restrict__ Wt, char* smem, int wvs) {
  float* tile = (float*)smem;
  int tq_ = TIDX(wvs) & 255; asm volatile("" : "+v"(tq_)); const int tid = tq_;
  const int nNt = Npad >> 6, nunits = (K >> 6) * nNt;
  for (int u = blockIdx.x * 2 + (wvs >> 2); u < nunits; u += gridDim.x * 2) {
    const int k0 = (u / nNt) * 64, n0 = (u % nNt) * 64;
#pragma unroll
    for (int ps = 0; ps < 4; ++ps) {
      const int i = ps * 16 + (tid >> 4), j = (tid & 15) * 4, n = n0 + j;
      float4 v = make_float4(0.f, 0.f, 0.f, 0.f);
      if (n < N) v = *(const float4*)(W + (size_t)(k0 + i) * N + n);
      tile[i * 65 + j] = v.x; tile[i * 65 + j + 1] = v.y; tile[i * 65 + j + 2] = v.z; tile[i * 65 + j + 3] = v.w;
    }
    __syncthreads();
    {
      const int n = tid >> 2, kq = (tid & 3) * 16;
      uint4 o0, o1;
      o0.x = pack2(tile[(kq + 0) * 65 + n], tile[(kq + 1) * 65 + n]); o0.y = pack2(tile[(kq + 2) * 65 + n], tile[(kq + 3) * 65 + n]);
      o0.z = pack2(tile[(kq + 4) * 65 + n], tile[(kq + 5) * 65 + n]); o0.w = pack2(tile[(kq + 6) * 65 + n], tile[(kq + 7) * 65 + n]);
      o1.x = pack2(tile[(kq + 8) * 65 + n], tile[(kq + 9) * 65 + n]); o1.y = pack2(tile[(kq + 10) * 65 + n], tile[(kq + 11) * 65 + n]);
      o1.z = pack2(tile[(kq + 12) * 65 + n], tile[(kq + 13) * 65 + n]); o1.w = pack2(tile[(kq + 14) * 65 + n], tile[(kq + 15) * 65 + n]);
      bf16_t* d = Wt + (size_t)(n0 + n) * K + k0 + kq;
      *(uint4*)d = o0; *(uint4*)(d + 8) = o1;
    }
    __syncthreads();
  }
}

__device__ __forceinline__ void prep_tables(const Params& p, int wvs) {
  int tq_ = TIDX(wvs); asm volatile("" : "+v"(tq_)); const int gt = blockIdx.x * NTHR + tq_, nt = gridDim.x * NTHR;
  float* rope = (float*)(p.ws + OFF_ROPE);
  for (int i = gt; i < 2056 * 64; i += nt) {
    const int pi = i >> 6, f = i & 63;
    const double pos = pi < 2048 ? (double)pi : (double)(16384 + pi - 2048);
    const double invf = exp(-(double)f * (9.210340371976184 / 64.0));
    double ang = pos * invf;
    ang -= 6.283185307179586 * floor(ang * 0.15915494309189535);
    const float a = (float)ang;
    rope[pi * 128 + f] = cosf(a); rope[pi * 128 + 64 + f] = sinf(a);
  }
  float* z = (float*)(p.ws + OFF_ROWSS);
  for (int i = gt; i < ROWS * 6; i += nt) z[i] = 0.f;
  float* lb = (float*)(p.ws + OFF_LB);
  for (int i = gt; i < 512; i += nt) lb[i] = 1.f / (1.f + expf(p.hgrn_lb[512 + i] - p.hgrn_lb[i]));
  float* tab = (float*)(p.ws + OFF_S5TAB);
  for (int i = gt; i < 2048; i += nt) {
    const int g = i >> 6;
    const float lr = p.s5_lam_re[i], li = p.s5_lam_im[i], dt = expf(p.s5_log_step[g]);
    const float m1 = expf(lr * dt), br = m1 * cosf(li * dt), bi = m1 * sinf(li * dt);
    tab[i] = br; tab[2048 + i] = bi;
    const float m64 = expf(lr * dt * 64.f); tab[69632 + i] = m64 * cosf(li * dt * 64.f); tab[71680 + i] = m64 * sinf(li * dt * 64.f);
    const float m8 = expf(lr * dt * 8.f); tab[73728 + i] = m8 * cosf(li * dt * 8.f); tab[75776 + i] = m8 * sinf(li * dt * 8.f);
    const float x = br - 1.f, y = bi, den = 1.f / (lr * lr + li * li);
    const float qr = (x * lr + y * li) * den, qi = (y * lr - x * li) * den;
    for (int c = 0; c < 16; ++c) {
      const float b_r = p.s5_b_re[i * 16 + c], b_i = p.s5_b_im[i * 16 + c];
      tab[4096 + i * 16 + c] = qr * b_r - qi * b_i;
      tab[4096 + 32768 + i * 16 + c] = qr * b_i + qi * b_r;
    }
  }
}

__device__ __forceinline__ void chunk_geom(int c, int& row0, int& L) { if (c < 256) { row0 = c * 64; L = 64; } else { row0 = 16384 + (c - 256) * 8; L = 8; } }

template <int MODE>
__device__ __forceinline__ void st_load(uint4 (&kr)[4], uint4 (&vr)[(MODE == 2) ? 2 : 1], float& dtr, const bf16_t* src, const float* dtbuf, int row0, int L, int ld, int kcol, int vcol, int h, int tid) {
  constexpr int PW = (MODE == 2) ? 64 : 32, NVC = PW / 32, VCR = PW / 8;
  const uint4 z4 = make_uint4(0, 0, 0, 0);
#pragma unroll
  for (int i = 0; i < 4; ++i) { const int id = tid + i * 256, s = id >> 4, c8 = id & 15; uint4 t_ = z4; if (s < L) t_ = *(const uint4*)(src + (size_t)(row0 + s) * ld + kcol + c8 * 8); kr[i] = t_; }
#pragma unroll
  for (int i = 0; i < NVC; ++i) { const int id = tid + i * 256, s = id / VCR, c8 = id % VCR; uint4 t_ = z4; if (s < L) t_ = *(const uint4*)(src + (size_t)(row0 + s) * ld + vcol + c8 * 8); vr[i] = t_; }
  if (MODE == 2 && tid < 64) dtr = tid < L ? dtbuf[(size_t)(row0 + tid) * 16 + h] : 0.f;
}

template <int MODE>
__device__ __forceinline__ void state_unit(const Params& p, int sq, int h, int ps, char* smem, int wvs) {
  constexpr int PW = (MODE == 2) ? 64 : 32, NT = PW / 16, PF = (MODE == 2) ? 64 : 128, HH = (MODE == 2) ? 16 : 4, NVC = PW / 32, VCR = PW / 8;
  bf16_t* KT = (bf16_t*)smem;
  bf16_t* VT = KT + 128 * 80;
  bf16_t* KR = VT + 64 * 80;
  float* tot = (float*)(KR + 64 * 136);
  float* dec = tot + 256;
  float* av = dec + 64;
  float* dtv = av + 64;
  int tid_ = TIDX(wvs) & 255; asm volatile("" : "+v"(tid_)); const int tid = tid_, lane = tid & 63, wave = tid >> 6;
  const bool prompt = sq < 8;
  const int nch = prompt ? 32 : 1, L = prompt ? 64 : 8;
  const int ld = (MODE == 2) ? 1536 : 4096;
  const bf16_t* src = (MODE == 2) ? (const bf16_t*)(p.ws + OFF_H) : (const bf16_t*)(p.ws + OFF_A);
  const int kcol = MODE == 0 ? 512 + h * 128 : MODE == 1 ? 2560 + h * 128 : 1024 + (h >> 3) * 128;
  const int vcol = MODE == 0 ? 1024 + h * 128 + ps * 32 : MODE == 1 ? 3072 + h * 128 + ps * 32 : h * 64;
  const float* sin_ = MODE == 0 ? p.state_ret : MODE == 1 ? p.state_hgrn : p.state_ssm;
  float* sout = p.out + (MODE == 0 ? O_RET : MODE == 1 ? O_HG : O_SSM) + (size_t)(sq * HH + h) * 128 * PF;
  bf16_t* stb = (bf16_t*)(p.ws + OFF_ST) + (MODE == 1 ? (size_t)256 * 4 * 128 * 128 : 0);
  const float* dtbuf = (const float*)(p.ws + OFF_DTBUF);
  const float l2g = MODE == 0 ? log2f(1.f - exp2f(-5.f - (float)h)) : 0.f;
  float Ah = 0.f, dtb = 0.f;
  if (MODE == 2) { Ah = -expf(p.a_log[h]); dtb = p.dt_bias[h]; }

  f32x4 acc[2][NT];
  const int nb = wave * 32 + (lane >> 4) * 4, pc = ps * PW + (lane & 15);
#pragma unroll
  for (int mt = 0; mt < 2; ++mt)
#pragma unroll
    for (int nt = 0; nt < NT; ++nt)
#pragma unroll
      for (int j = 0; j < 4; ++j)
        acc[mt][nt][j] = prompt ? 0.f : sin_[((size_t)((sq - 8) * HH + h) * 128 + nb + mt * 16 + j) * PF + pc + nt * 16];

  uint4 kr[4], vr[NVC]; float dtr = 0.f;
  const uint4 z4 = make_uint4(0, 0, 0, 0);
  st_load<MODE>(kr, vr, dtr, src, dtbuf, prompt ? sq * 2048 : 16384 + (sq - 8) * 8, L, ld, kcol, vcol, h, tid);
  for (int n = 0; n < nch; ++n) {
    if (prompt) {
      bf16_t* d = stb + ((size_t)((sq * 32 + n) * HH + h) * PF) * 128;
#pragma unroll
      for (int mt = 0; mt < 2; ++mt)
#pragma unroll
        for (int nt = 0; nt < NT; ++nt) store4bf(d + (size_t)(pc + nt * 16) * 128 + nb + mt * 16, acc[mt][nt][0], acc[mt][nt][1], acc[mt][nt][2], acc[mt][nt][3]);
    }
#pragma unroll
    for (int i = 0; i < 4; ++i) { const int id = tid + i * 256, s = id >> 4, c8 = id & 15; *(uint4*)(KR + s * 136 + c8 * 8) = kr[i]; }
#pragma unroll
    for (int i = 0; i < NVC; ++i) {
      const int id = tid + i * 256, s = id / VCR, c8 = id % VCR; const uint4 v = vr[i];
      bf16_t* d = VT + (c8 * 8) * 80 + s;
      d[0] = (bf16_t)(v.x & 0xffff); d[80] = (bf16_t)(v.x >> 16); d[160] = (bf16_t)(v.y & 0xffff); d[240] = (bf16_t)(v.y >> 16);
      d[320] = (bf16_t)(v.z & 0xffff); d[400] = (bf16_t)(v.z >> 16); d[480] = (bf16_t)(v.w & 0xffff); d[560] = (bf16_t)(v.w >> 16);
    }
    if (MODE == 2 && tid < 64) {
      float dt = 0.f;
      if (tid < L) { const float x = dtr + dtb; dt = x > 20.f ? x : log1pf(__expf(x)); }
      dtv[tid] = dt; av[tid] = dt * Ah;
    }
    if (n + 1 < nch) st_load<MODE>(kr, vr, dtr, src, dtbuf, sq * 2048 + (n + 1) * 64, L, ld, kcol, vcol, h, tid);
    __syncthreads();
    const int kn = tid & 127, half = tid >> 7;
    if (MODE == 1) {
      float s_ = 0.f;
      for (int s = half * 32; s < half * 32 + 32; ++s) s_ += bf2f(KR[s * 136 + kn]);
      tot[half * 128 + kn] = s_;
    }
    if (MODE == 2 && tid < 64) {
      float suf = 0.f;
      for (int r = tid + 1; r < 64; ++r) suf += av[r];
      dec[tid] = __expf(suf) * dtv[tid];
      if (tid == 0) tot[0] = suf + av[0];
    }
    if (MODE != 0) __syncthreads();
    {
      float suf = 0.f;
      if (MODE == 1) suf = half == 0 ? tot[128 + kn] : 0.f;
      for (int g = 3; g >= 0; --g) {
        const int s0 = half * 32 + g * 8;
        float v[8];
#pragma unroll
        for (int e = 7; e >= 0; --e) {
          const int s = s0 + e;
          const float raw = bf2f(KR[s * 136 + kn]);
          if (MODE == 0) v[e] = raw * exp2f((float)(L - 1 - s) * l2g);
          else if (MODE == 1) { v[e] = (1.f - __expf(raw)) * __expf(suf); suf += raw; }
          else v[e] = raw * dec[s];
        }
        uint4 o; o.x = pack2(v[0], v[1]); o.y = pack2(v[2], v[3]); o.z = pack2(v[4], v[5]); o.w = pack2(v[6], v[7]);
        *(uint4*)(KT + kn * 80 + s0) = o;
      }
    }
    __syncthreads();
#pragma unroll
    for (int mt = 0; mt < 2; ++mt) {
      float dk[4];
      if (MODE == 0) { const float d = exp2f((float)L * l2g); dk[0] = dk[1] = dk[2] = dk[3] = d; }
      else if (MODE == 2) { const float d = __expf(tot[0]); dk[0] = dk[1] = dk[2] = dk[3] = d; }
      else {
#pragma unroll
        for (int j = 0; j < 4; ++j) { const int nn = nb + mt * 16 + j; dk[j] = __expf(tot[nn] + tot[128 + nn]); }
      }
#pragma unroll
      for (int nt = 0; nt < NT; ++nt)
#pragma unroll
        for (int j = 0; j < 4; ++j) acc[mt][nt][j] *= dk[j];
    }
    wmma_ns<2, NT>(acc, KT + wave * 32 * 80, 80, VT, 80, 64, lane);
    __syncthreads();
  }
#pragma unroll
  for (int mt = 0; mt < 2; ++mt)
#pragma unroll
    for (int nt = 0; nt < NT; ++nt)
#pragma unroll
      for (int j = 0; j < 4; ++j) sout[(size_t)(nb + mt * 16 + j) * PF + pc + nt * 16] = acc[mt][nt][j];
}

template <int MODE>
__device__ __forceinline__ void out_unit(const Params& p, int c, int h, char* smem, int wvs) {
  constexpr int PF = (MODE == 2) ? 64 : 128, NTP = PF / 16, HH = (MODE == 2) ? 16 : 4, NVC = PF / 32, VCR = PF / 8;
  bf16_t* Q = (bf16_t*)smem;
  bf16_t* Kb = Q + 64 * 136;
  bf16_t* STb = Kb + 128 * 80;
  float* cumv = (float*)(STb + 128 * 136);
  float* dtv = cumv + 64;
  float* av = dtv + 64;
  float* tot = av + 64;
  int tid_ = TIDX(wvs) & 255; asm volatile("" : "+v"(tid_)); const int tid = tid_, lane = tid & 63, wave = tid >> 6;
  int row0, L; chunk_geom(c, row0, L);
  const int ld = (MODE == 2) ? 1536 : 4096;
  const bf16_t* src = (MODE == 2) ? (const bf16_t*)(p.ws + OFF_H) : (const bf16_t*)(p.ws + OFF_A);
  const int qcol = MODE == 0 ? h * 128 : MODE == 1 ? 2048 + h * 128 : 1280 + (h >> 3) * 128;
  const int kcol = MODE == 0 ? 512 + h * 128 : MODE == 1 ? 2560 + h * 128 : 1024 + (h >> 3) * 128;
  const int vcol = MODE == 0 ? 1024 + h * 128 : MODE == 1 ? 3072 + h * 128 : h * 64;
  const float l2g = MODE == 0 ? log2f(1.f - exp2f(-5.f - (float)h)) : 0.f;
  const uint4 z4 = make_uint4(0, 0, 0, 0);
#pragma unroll
  for (int i = 0; i < 4; ++i) {
    const int id = tid + i * 256, s = id >> 4, c8 = id & 15;
    uint4 q4 = z4, k4 = z4;
    if (s < L) { q4 = *(const uint4*)(src + (size_t)(row0 + s) * ld + qcol + c8 * 8); k4 = *(const uint4*)(src + (size_t)(row0 + s) * ld + kcol + c8 * 8); }
    *(uint4*)(Q + s * 136 + c8 * 8) = q4; *(uint4*)(Kb + s * 136 + c8 * 8) = k4;
  }
  uint4 vr[NVC];
#pragma unroll
  for (int i = 0; i < NVC; ++i) { const int id = tid + i * 256, s = id / VCR, c8 = id % VCR; uint4 t_ = z4; if (s < L) t_ = *(const uint4*)(src + (size_t)(row0 + s) * ld + vcol + c8 * 8); vr[i] = t_; }
  if (c < 256) {
    const bf16_t* stg = (const bf16_t*)(p.ws + OFF_ST) + (MODE == 1 ? (size_t)256 * 4 * 128 * 128 : 0) + ((size_t)(c * HH + h) * PF) * 128;
#pragma unroll
    for (int i = 0; i < PF / 16; ++i) { const int id = tid + i * 256, pr = id >> 4, c8 = id & 15; *(uint4*)(STb + pr * 136 + c8 * 8) = *(const uint4*)(stg + (size_t)pr * 128 + c8 * 8); }
  } else {
    const float* sg = (MODE == 0 ? p.state_ret : MODE == 1 ? p.state_hgrn : p.state_ssm) + (size_t)((c - 256) * HH + h) * 128 * PF;
    for (int idb = tid; idb < 128 * (PF / 4); idb += 1024) {
      float4 v4[4];
#pragma unroll
      for (int q = 0; q < 4; ++q) { const int id = idb + q * 256, n = id / (PF / 4), p4 = (id % (PF / 4)) * 4; v4[q] = *(const float4*)(sg + (size_t)n * PF + p4); }
#pragma unroll
      for (int q = 0; q < 4; ++q) {
        const int id = idb + q * 256, n = id / (PF / 4), p4 = (id % (PF / 4)) * 4; const float4 v = v4[q];
        STb[(p4 + 0) * 136 + n] = f2bf(v.x); STb[(p4 + 1) * 136 + n] = f2bf(v.y); STb[(p4 + 2) * 136 + n] = f2bf(v.z); STb[(p4 + 3) * 136 + n] = f2bf(v.w);
      }
    }
  }
  if (MODE == 2 && tid < 64) {
    float dt = 0.f;
    if (tid < L) { const float x = ((const float*)(p.ws + OFF_DTBUF))[(size_t)(row0 + tid) * 16 + h] + p.dt_bias[h]; dt = x > 20.f ? x : log1pf(__expf(x)); }
    dtv[tid] = dt; av[tid] = -expf(p.a_log[h]) * dt;
  }
  __syncthreads();
  if (MODE == 1) {
    const int kn = tid & 127, half = tid >> 7;
    float s_ = 0.f;
    for (int s = half * 32; s < half * 32 + 32; ++s) s_ += bf2f(Kb[s * 136 + kn]);
    tot[half * 128 + kn] = s_;
    __syncthreads();
    float cum = half == 1 ? tot[kn] : 0.f;
    for (int s = half * 32; s < half * 32 + 32; ++s) {
      const float lf = bf2f(Kb[s * 136 + kn]);
      cum += lf;
      Q[s * 136 + kn] = f2bf(bf2f(Q[s * 136 + kn]) * __expf(cum));
      Kb[s * 136 + kn] = f2bf((1.f - __expf(lf)) * __expf(-cum));
    }
    __syncthreads();
  }
  if (MODE == 2) {
    if (tid < 64) { float cs = 0.f; for (int r = 0; r <= tid; ++r) cs += av[r]; cumv[tid] = cs; }
    __syncthreads();
  }
  f32x4 ai[1][NTP], asc[1][4];
#pragma unroll
  for (int j = 0; j < NTP; ++j) ai[0][j] = (f32x4){0.f, 0.f, 0.f, 0.f};
#pragma unroll
  for (int j = 0; j < 4; ++j) asc[0][j] = (f32x4){0.f, 0.f, 0.f, 0.f};
  wmma_sw<1, NTP>(ai, Q + wave * 16 * 136, 136, STb, 136, 128, lane);
  wmma_sw<1, 4>(asc, Q + wave * 16 * 136, 136, Kb, 136, 128, lane);
  const int t = wave * 16 + (lane & 15), sq4 = (lane >> 4) * 4;
  float ct = 0.f;
  if (MODE == 2) ct = cumv[t];
#pragma unroll
  for (int nt = 0; nt < 4; ++nt)
#pragma unroll
    for (int j = 0; j < 4; ++j) {
      const int s = nt * 16 + sq4 + j;
      float v = asc[0][nt][j];
      if (s > t) v = 0.f;
      else if (MODE == 0) v *= exp2f((float)(t - s) * l2g);
      else if (MODE == 2) v *= __expf(ct - cumv[s]) * dtv[s];
      asc[0][nt][j] = v;
    }
  __syncthreads();
  bf16_t* Pb = STb; bf16_t* VT = Kb;
#pragma unroll
  for (int nt = 0; nt < 4; ++nt) store4bf(Pb + t * 80 + nt * 16 + sq4, asc[0][nt][0], asc[0][nt][1], asc[0][nt][2], asc[0][nt][3]);
#pragma unroll
  for (int i = 0; i < NVC; ++i) {
    const int id = tid + i * 256, s = id / VCR, c8 = id % VCR; const uint4 v = vr[i];
    bf16_t* d = VT + (c8 * 8) * 80 + s;
    d[0] = (bf16_t)(v.x & 0xffff); d[80] = (bf16_t)(v.x >> 16); d[160] = (bf16_t)(v.y & 0xffff); d[240] = (bf16_t)(v.y >> 16);
    d[320] = (bf16_t)(v.z & 0xffff); d[400] = (bf16_t)(v.z >> 16); d[480] = (bf16_t)(v.w & 0xffff); d[560] = (bf16_t)(v.w >> 16);
  }
  __syncthreads();
  f32x4 ao[1][NTP];
#pragma unroll
  for (int j = 0; j < NTP; ++j) ao[0][j] = (f32x4){0.f, 0.f, 0.f, 0.f};
  wmma_sw<1, NTP>(ao, Pb + wave * 16 * 80, 80, VT, 80, 64, lane);
  float fi = 1.f;
  if (MODE == 0) fi = exp2f((float)(t + 1) * l2g);
  if (MODE == 2) fi = __expf(ct);
  const int row = row0 + t;
  const bool valid = t < L;
  if (MODE == 0 || MODE == 1) {
    float s1 = 0.f, s2 = 0.f;
#pragma unroll
    for (int nt = 0; nt < NTP; ++nt)
#pragma unroll
      for (int j = 0; j < 4; ++j) { const float o = ao[0][nt][j] + fi * ai[0][nt][j]; ao[0][nt][j] = o; s1 += o; s2 += o * o; }
    s1 += shx(s1, 16); s1 += shx(s1, 32); s2 += shx(s2, 16); s2 += shx(s2, 32);
    float mu = 0.f, rs;
    if (MODE == 0) { mu = s1 * (1.f / 128.f); const float var = fmaxf(s2 * (1.f / 128.f) - mu * mu, 0.f); rs = rsqrtf(var + EPSV); }
    else rs = rsqrtf(s2 * (1.f / 128.f) + EPSV);
    if (valid) {
      const float* nw = (MODE == 0 ? p.ret_norm_w : p.hgrn_norm_w) + h * 128;
      const int gcol = (MODE == 0 ? 1536 : 3584) + h * 128;
      bf16_t* mix = (bf16_t*)(p.ws + OFF_H) + (size_t)row * 1024 + (MODE == 0 ? 0 : 512) + h * 128;
      float4 ww4[NTP]; uint2 gg2[NTP];
#pragma unroll
      for (int nt = 0; nt < NTP; ++nt) { const int pp = nt * 16 + sq4; ww4[nt] = *(const float4*)(nw + pp); gg2[nt] = *(const uint2*)(src + (size_t)row * ld + gcol + pp); }
#pragma unroll
      for (int nt = 0; nt < NTP; ++nt) {
        const int pp = nt * 16 + sq4;
        const float4 w4 = ww4[nt];
        const uint2 g2 = gg2[nt];
        store4bf(mix + pp, (ao[0][nt][0] - mu) * rs * w4.x * siluf(lo2f(g2.x)), (ao[0][nt][1] - mu) * rs * w4.y * siluf(hi2f(g2.x)),
                 (ao[0][nt][2] - mu) * rs * w4.z * siluf(lo2f(g2.y)), (ao[0][nt][3] - mu) * rs * w4.w * siluf(hi2f(g2.y)));
      }
    }
  } else {
    const float Dh = p.d_ssm[h];
    bf16_t* zy = (bf16_t*)(p.ws + OFF_A) + (size_t)row * 3200 + h * 64;
    float s2 = 0.f;
    if (valid) {
      uint2 xx2[NTP], zz2[NTP];
#pragma unroll
      for (int nt = 0; nt < NTP; ++nt) { const int pp = nt * 16 + sq4; xx2[nt] = *(const uint2*)(src + (size_t)row * ld + vcol + pp); zz2[nt] = *(const uint2*)(zy + pp); }
#pragma unroll
      for (int nt = 0; nt < NTP; ++nt) {
        const int pp = nt * 16 + sq4;
        const uint2 x2 = xx2[nt];
        const uint2 z2 = zz2[nt];
        const float y0 = (ao[0][nt][0] + fi * ai[0][nt][0] + Dh * lo2f(x2.x)) * siluf(lo2f(z2.x));
        const float y1 = (ao[0][nt][1] + fi * ai[0][nt][1] + Dh * hi2f(x2.x)) * siluf(hi2f(z2.x));
        const float y2 = (ao[0][nt][2] + fi * ai[0][nt][2] + Dh * lo2f(x2.y)) * siluf(lo2f(z2.y));
        const float y3 = (ao[0][nt][3] + fi * ai[0][nt][3] + Dh * hi2f(x2.y)) * siluf(hi2f(z2.y));
        s2 += y0 * y0 + y1 * y1 + y2 * y2 + y3 * y3;
        store4bf(zy + pp, y0, y1, y2, y3);
      }
    }
    s2 += shx(s2, 16); s2 += shx(s2, 32);
    if (valid && lane < 16) atomicAdd((float*)(p.ws + OFF_SSDST) + (size_t)row * 2 + (h >> 3), s2);
  }
  __syncthreads();
}

template <int OUT>
__device__ __forceinline__ void s5_unit(const Params& p, int c, int gq, char* smem, int wvs) {
  float* Uf = (float*)smem;
  bf16_t* HSall = (bf16_t*)(smem + 16384);
  bf16_t* CMall = (bf16_t*)(smem + 16384 + 34816);
  int tid_ = TIDX(wvs) & 255; asm volatile("" : "+v"(tid_)); const int tid = tid_, lane = tid & 63, wave = tid >> 6;
  int row0, L; chunk_geom(c, row0, L);
  const bf16_t* proj = (const bf16_t*)(p.ws + OFF_A);
#pragma unroll
  for (int i = 0; i < 2; ++i) {
    const int id = tid + i * 256, s = id >> 3, c8 = id & 7;
    uint4 v = make_uint4(0, 0, 0, 0);
    if (s < L) v = *(const uint4*)(proj + (size_t)(row0 + s) * 3200 + 2576 + gq * 64 + c8 * 8);
    float* d = Uf + s * 64 + c8 * 8;
    d[0] = lo2f(v.x); d[1] = hi2f(v.x); d[2] = lo2f(v.y); d[3] = hi2f(v.y); d[4] = lo2f(v.z); d[5] = hi2f(v.z); d[6] = lo2f(v.w); d[7] = hi2f(v.w);
  }
  const int g = gq * 4 + wave, gp = g * 64 + lane;
  const float* tab = (const float*)(p.ws + OFF_S5TAB);
  const float lr = tab[gp], li = tab[2048 + gp];
  f32x2 bb2[16];
#pragma unroll
  for (int q = 0; q < 4; ++q) {
    const float4 a = *(const float4*)(tab + 4096 + gp * 16 + q * 4), b = *(const float4*)(tab + 4096 + 32768 + gp * 16 + q * 4);
    bb2[q * 4] = (f32x2){a.x, b.x}; bb2[q * 4 + 1] = (f32x2){a.y, b.y}; bb2[q * 4 + 2] = (f32x2){a.z, b.z}; bb2[q * 4 + 3] = (f32x2){a.w, b.w};
  }
  float hr = 0.f, hi = 0.f;
  bf16_t* HS = HSall + wave * 32 * 136; bf16_t* CM = CMall + wave * 16 * 136;
  if (OUT) {
    const float2 h0 = *(const float2*)((const float*)(p.ws + OFF_S5H) + ((size_t)c * 2048 + gp) * 2);
    hr = h0.x; hi = h0.y;
#pragma unroll
    for (int ch = 0; ch < 16; ++ch) { CM[ch * 136 + lane] = f2bf(p.s5_c_re[(g * 16 + ch) * 64 + lane]); CM[ch * 136 + 64 + lane] = f2bf(-p.s5_c_im[(g * 16 + ch) * 64 + lane]); }
  }
  __syncthreads();
  const int nhalf = OUT ? ((L + 31) >> 5) : 1, tl = OUT ? 32 : L;
  for (int hf = 0; hf < nhalf; ++hf) {
#pragma unroll 4
    for (int tt = 0; tt < tl; ++tt) {
      const int t = hf * 32 + tt;
      {
        const float* up = Uf + t * 64 + wave * 16;
        f32x2 b0 = (f32x2){0.f, 0.f}, b1 = (f32x2){0.f, 0.f};
#pragma unroll
        for (int q = 0; q < 4; ++q) {
          const f32x4 u4 = *(const f32x4*)(up + q * 4);
          b0 += bb2[q * 4] * u4[0]; b1 += bb2[q * 4 + 1] * u4[1]; b0 += bb2[q * 4 + 2] * u4[2]; b1 += bb2[q * 4 + 3] * u4[3];
        }
        b0 += b1;
        const float nr = lr * hr - li * hi + b0[0], ni = lr * hi + li * hr + b0[1];
        if (t < L) { hr = nr; hi = ni; }
      }
      if (OUT) { HS[tt * 136 + lane] = f2bf(t < L ? hr : 0.f); HS[tt * 136 + 64 + lane] = f2bf(t < L ? hi : 0.f); }
    }
    if (OUT) {
      __syncthreads();
      f32x4 ay[2][1];
      ay[0][0] = (f32x4){0.f, 0.f, 0.f, 0.f}; ay[1][0] = (f32x4){0.f, 0.f, 0.f, 0.f};
      wmma_sw<2, 1>(ay, HS, 136, CM, 136, 128, lane);
      bf16_t* gbuf = (bf16_t*)(p.ws + OFF_GBUF);
#pragma unroll
      for (int mt = 0; mt < 2; ++mt) {
        const int t = hf * 32 + mt * 16 + (lane & 15), ch0 = (lane >> 4) * 4;
        if (t < L) {
          const float4 u4 = *(const float4*)(Uf + t * 64 + wave * 16 + ch0);
          const float4 d4 = *(const float4*)(p.s5_d + g * 16 + ch0);
          float y[4] = {ay[mt][0][0] + d4.x * u4.x, ay[mt][0][1] + d4.y * u4.y, ay[mt][0][2] + d4.z * u4.z, ay[mt][0][3] + d4.w * u4.w};
#pragma unroll
          for (int j = 0; j < 4; ++j) { const float x = y[j], uu = 0.7978845608028654f * (x + 0.044715f * x * x * x); y[j] = x / (1.f + __expf(-2.f * uu)); }
          store4bf(gbuf + (size_t)(row0 + t) * 512 + g * 16 + ch0, y[0], y[1], y[2], y[3]);
        }
      }
      __syncthreads();
    }
  }
  if (!OUT) { *(float2*)((float*)(p.ws + OFF_S5E) + ((size_t)c * 2048 + gp) * 2) = make_float2(hr, hi); }
  __syncthreads();
}

__device__ __forceinline__ void s5_prefix(const Params& p, int gt) {
  const int sq = gt >> 11, rem = gt & 2047;
  const float* tab = (const float*)(p.ws + OFF_S5TAB);
  const float* e = (const float*)(p.ws + OFF_S5E);
  float* hs = (float*)(p.ws + OFF_S5H);
  float hr = 0.f, hi = 0.f;
  if (sq < 8) {
    const float lr = tab[69632 + rem], li = tab[71680 + rem];
    for (int n = 0; n < 32; ++n) {
      const size_t idx = ((size_t)(sq * 32 + n) * 2048 + rem) * 2;
      *(float2*)(hs + idx) = make_float2(hr, hi);
      const float2 ev = *(const float2*)(e + idx);
      const float nr = lr * hr - li * hi + ev.x, ni = lr * hi + li * hr + ev.y; hr = nr; hi = ni;
    }
  } else {
    const float lr = tab[73728 + rem], li = tab[75776 + rem];
    hr = p.state_s5_re[(size_t)(sq - 8) * 2048 + rem]; hi = p.state_s5_im[(size_t)(sq - 8) * 2048 + rem];
    const size_t idx = ((size_t)(256 + sq - 8) * 2048 + rem) * 2;
    *(float2*)(hs + idx) = make_float2(hr, hi);
    const float2 ev = *(const float2*)(e + idx);
    const float nr = lr * hr - li * hi + ev.x, ni = lr * hi + li * hr + ev.y; hr = nr; hi = ni;
  }
  p.out[O_S5RE + (size_t)sq * 2048 + rem] = hr;
  p.out[O_S5IM + (size_t)sq * 2048 + rem] = hi;
}

__device__ __forceinline__ void conv_phase(const Params& p, int wvs) {
  const bf16_t* proj = (const bf16_t*)(p.ws + OFF_A);
  bf16_t* xc = (bf16_t*)(p.ws + OFF_H);
  int tq_ = TIDX(wvs); asm volatile("" : "+v"(tq_)); const int gt = blockIdx.x * NTHR + tq_, nt = gridDim.x * NTHR;
  for (int task = gt; task < 544 * 192; task += nt) {
    const int seg = task / 192, c = (task - seg * 192) * 8, rowb = seg * 32;
    float w[4][8], bia[8];
#pragma unroll
    for (int j = 0; j < 4; ++j) {
      const float4 w0 = *(const float4*)(p.conv_w + j * 1536 + c), w1 = *(const float4*)(p.conv_w + j * 1536 + c + 4);
      w[j][0] = w0.x; w[j][1] = w0.y; w[j][2] = w0.z; w[j][3] = w0.w; w[j][4] = w1.x; w[j][5] = w1.y; w[j][6] = w1.z; w[j][7] = w1.w;
    }
    { const float4 b0 = *(const float4*)(p.conv_b + c), b1 = *(const float4*)(p.conv_b + c + 4); bia[0] = b0.x; bia[1] = b0.y; bia[2] = b0.z; bia[3] = b0.w; bia[4] = b1.x; bia[5] = b1.y; bia[6] = b1.z; bia[7] = b1.w; }
    float x0[8], x1[8], x2[8];
    if (rowb < 16384 && (rowb & 2047) != 0) {
      const u32x4 v0 = *(const u32x4*)(proj + (size_t)(rowb - 3) * 3200 + 1024 + c), v1 = *(const u32x4*)(proj + (size_t)(rowb - 2) * 3200 + 1024 + c), v2 = *(const u32x4*)(proj + (size_t)(rowb - 1) * 3200 + 1024 + c);
#pragma unroll
      for (int e = 0; e < 4; ++e) { x0[2 * e] = lo2f(v0[e]); x0[2 * e + 1] = hi2f(v0[e]); x1[2 * e] = lo2f(v1[e]); x1[2 * e + 1] = hi2f(v1[e]); x2[2 * e] = lo2f(v2[e]); x2[2 * e + 1] = hi2f(v2[e]); }
    } else {
#pragma unroll
      for (int e = 0; e < 8; ++e) { x0[e] = 0.f; x1[e] = 0.f; x2[e] = 0.f; }
    }
    u32x4 nx[4];
#pragma unroll
    for (int q = 0; q < 4; ++q) nx[q] = *(const u32x4*)(proj + (size_t)(rowb + q) * 3200 + 1024 + c);
#pragma unroll 4
    for (int r = 0; r < 32; ++r) {
      const int row = rowb + r;
      const u32x4 cv = nx[r & 3];
      if (r + 4 < 32) nx[r & 3] = *(const u32x4*)(proj + (size_t)(row + 4) * 3200 + 1024 + c);
      int t, T, sq;
      if (row < 16384) { t = row & 2047; T = 2048; sq = row >> 11; } else { t = (row - 16384) & 7; T = 8; sq = 8 + ((row - 16384) >> 3); }
      if (t == 0) {
        if (sq >= 8) {
          const float* sc = p.state_conv + (size_t)(sq - 8) * 3 * 1536 + c;
          const float4 a0 = *(const float4*)sc, a1 = *(const float4*)(sc + 4), b0 = *(const float4*)(sc + 1536), b1 = *(const float4*)(sc + 1540), c0 = *(const float4*)(sc + 3072), c1 = *(const float4*)(sc + 3076);
          x0[0] = a0.x; x0[1] = a0.y; x0[2] = a0.z; x0[3] = a0.w; x0[4] = a1.x; x0[5] = a1.y; x0[6] = a1.z; x0[7] = a1.w;
          x1[0] = b0.x; x1[1] = b0.y; x1[2] = b0.z; x1[3] = b0.w; x1[4] = b1.x; x1[5] = b1.y; x1[6] = b1.z; x1[7] = b1.w;
          x2[0] = c0.x; x2[1] = c0.y; x2[2] = c0.z; x2[3] = c0.w; x2[4] = c1.x; x2[5] = c1.y; x2[6] = c1.z; x2[7] = c1.w;
        } else {
#pragma unroll
          for (int e = 0; e < 8; ++e) { x0[e] = 0.f; x1[e] = 0.f; x2[e] = 0.f; }
        }
      }
      float cur[8], o[8];
#pragma unroll
      for (int e = 0; e < 4; ++e) { cur[2 * e] = lo2f(cv[e]); cur[2 * e + 1] = hi2f(cv[e]); }
#pragma unroll
      for (int e = 0; e < 8; ++e) { o[e] = siluf(bia[e] + w[0][e] * x0[e] + w[1][e] * x1[e] + w[2][e] * x2[e] + w[3][e] * cur[e]); x0[e] = x1[e]; x1[e] = x2[e]; x2[e] = cur[e]; }
      u32x4 ov; ov[0] = pack2(o[0], o[1]); ov[1] = pack2(o[2], o[3]); ov[2] = pack2(o[4], o[5]); ov[3] = pack2(o[6], o[7]);
      *(u32x4*)(xc + (size_t)row * 1536 + c) = ov;
      if (t >= T - 3) {
        float* d = p.out + O_CONV + ((size_t)sq * 3 + (t - (T - 3))) * 1536 + c;
        *(float4*)d = make_float4(cur[0], cur[1], cur[2], cur[3]); *(float4*)(d + 4) = make_float4(cur[4], cur[5], cur[6], cur[7]);
      }
    }
  }
}

__device__ __forceinline__ void ssdnorm_phase(const Params& p, int wvs) {
  const bf16_t* proj = (const bf16_t*)(p.ws + OFF_A);
  bf16_t* mix = (bf16_t*)(p.ws + OFF_H);
  const float* st = (const float*)(p.ws + OFF_SSDST);
  int tq_ = TIDX(wvs); asm volatile("" : "+v"(tq_)); const int gt = blockIdx.x * NTHR + tq_, nt = gridDim.x * NTHR;
  for (int it = gt; it < ROWS * 128; it += nt) {
    const int row = it >> 7, c = (it & 127) * 8;
    const float r = rsqrtf(st[(size_t)row * 2 + (c >> 9)] * (1.f / 512.f) + EPSV);
    const uint4 v = *(const uint4*)(proj + (size_t)row * 3200 + c);
    const float4 w0 = *(const float4*)(p.ssm_norm_w + c), w1 = *(const float4*)(p.ssm_norm_w + c + 4);
    uint4 o; o.x = pack2(lo2f(v.x) * r * w0.x, hi2f(v.x) * r * w0.y); o.y = pack2(lo2f(v.y) * r * w0.z, hi2f(v.y) * r * w0.w);
    o.z = pack2(lo2f(v.z) * r * w1.x, hi2f(v.z) * r * w1.y); o.w = pack2(lo2f(v.w) * r * w1.z, hi2f(v.w) * r * w1.w);
    *(uint4*)(mix + (size_t)row * 1536 + c) = o;
  }
}


#define XB_TMO      128
#define XB_XCNT(j)  (256  + 64 * (j))
#define XB_XSUB(j)  (1280 + 64 * (j))
#define XB_XGEN(j)  (2304 + 64 * (j))
#define XB_TOP      3328
#define XB_TOPGEN   3392
#define XCD_BAR_WORDS 3456
#define XB_SPIN_CAP (1u << 18)
#define LAS __attribute__((address_space(3)))
__device__ __forceinline__ unsigned xb_ld(unsigned* p)              { return __hip_atomic_load(p, __ATOMIC_RELAXED, __HIP_MEMORY_SCOPE_AGENT); }
__device__ __forceinline__ unsigned xb_add(unsigned* p, unsigned v) { return __hip_atomic_fetch_add(p, v, __ATOMIC_RELAXED, __HIP_MEMORY_SCOPE_AGENT); }
__device__ __forceinline__ unsigned xb_xcc_id() { return (unsigned)__builtin_amdgcn_s_getreg((3 << 11) | 20) & 0xFu; }
#define XB_SPIN(cond, bar) do { unsigned _sp = 0; while (cond) { __builtin_amdgcn_s_sleep(1); \
    if ((++_sp & 255u) == 0u) { if (xb_ld(&(bar)[XB_TMO])) break; if (_sp > XB_SPIN_CAP) { atomicAdd(&(bar)[XB_TMO], 1u); break; } } } } while (0)
struct XcdBarrier { unsigned* bar; unsigned x; volatile LAS unsigned* st; };
__device__ __forceinline__ XcdBarrier xcd_barrier_post(unsigned* bar, volatile LAS unsigned* st, int wvs) {
    XcdBarrier b; b.bar = bar; b.x = xb_xcc_id(); b.st = st;
    if (TIDX(wvs) == 0) (void)xb_add(&bar[XB_XCNT(b.x)], 1u);
    return b;
}
__device__ __forceinline__ void xcd_barrier_complete(unsigned* bar, unsigned x, unsigned& nloc, unsigned& nx) {
    const unsigned G = gridDim.x * gridDim.y * gridDim.z;
    unsigned sum, cnt, mine, sp = 0u;
    for (;;) {
        sum = 0u; cnt = 0u; mine = 0u;
#pragma unroll
        for (unsigned j = 0; j < 16; ++j) { const unsigned c = xb_ld(&bar[XB_XCNT(j)]); sum += c; cnt += (c > 0u) ? 1u : 0u; mine = (j == x) ? c : mine; }
        if (sum == G) break;
        __builtin_amdgcn_s_sleep(1);
        if ((++sp & 255u) == 0u) { if (xb_ld(&bar[XB_TMO])) break; if (sp > XB_SPIN_CAP) { atomicAdd(&bar[XB_TMO], 1u); break; } }
    }
    nloc = mine > 0u ? mine : 1u; nx = cnt > 0u ? cnt : 1u;
}
__device__ __forceinline__ void xcd_barrier(const XcdBarrier& b, int wvs) {
    asm volatile("s_waitcnt vmcnt(0)" ::: "memory");
    __syncthreads();
    if (TIDX(wvs) == 0) {
        unsigned* bar = b.bar;
        __builtin_amdgcn_s_waitcnt(0);
        unsigned nloc = b.st[0], nx = b.st[1];
        if (nloc == 0u) { xcd_barrier_complete(bar, b.x, nloc, nx); b.st[0] = nloc; b.st[1] = nx; }
        const unsigned old = xb_add(&bar[XB_XSUB(b.x)], 1u);
        const unsigned gen = old / nloc;
        if (old + 1u == (gen + 1u) * nloc) {
            __builtin_amdgcn_fence(__ATOMIC_RELEASE, "agent");
            asm volatile("s_waitcnt vmcnt(0)" ::: "memory");
            const unsigned og = xb_add(&bar[XB_TOP], 1u);
            const unsigned tg = og / nx;
            if (og + 1u == (tg + 1u) * nx) xb_add(&bar[XB_TOPGEN], 1u);
            else XB_SPIN(xb_ld(&bar[XB_TOPGEN]) == tg, bar);
            __builtin_amdgcn_fence(__ATOMIC_ACQUIRE, "agent");
            xb_add(&bar[XB_XGEN(b.x)], 1u);
            asm volatile("s_waitcnt vmcnt(0)" ::: "memory");
        } else {
            XB_SPIN(xb_ld(&bar[XB_XGEN(b.x)]) == gen, bar);
            __builtin_amdgcn_fence(__ATOMIC_ACQUIRE, "agent");
            asm volatile("s_waitcnt vmcnt(0)" ::: "memory");
        }
    }
    __syncthreads();
}


__device__ __forceinline__ Params ldp() {
  auto kp = __builtin_amdgcn_kernarg_segment_ptr();
  asm volatile("" : "+s"(kp));
  Params q;
  __builtin_memcpy(&q, (const void*)kp, sizeof(Params));
  return q;
}

__global__ void __launch_bounds__(NTHR, 2) fwd_megakernel(Params p_) {
  extern __shared__ __attribute__((aligned(16))) char smem[];
  cg::grid_group grid = cg::this_grid();
  if (p_.ws == nullptr) grid.sync();
  volatile LAS unsigned* xst = (volatile LAS unsigned*)(smem + 2 * HALF_LDS);
  const int wvs = __builtin_amdgcn_readfirstlane(threadIdx.x >> 6);
  if (TIDX(wvs) == 0) { xst[0] = 0u; xst[1] = 0u; xst[2] = 0u; xst[3] = 0u; }
  __syncthreads();
  const XcdBarrier xb = xcd_barrier_post((unsigned*)(p_.ws + OFF_BAR), xst, wvs);
  const int half = wvs >> 2;
  const int G = gridDim.x * 2, bid = blockIdx.x * 2 + half;
  char* hs = smem + half * HALF_LDS;
#define PH_BEGIN const Params p = ldp(); bf16_t* bufA = (bf16_t*)(p.ws + OFF_A); bf16_t* bufH = (bf16_t*)(p.ws + OFF_H); bf16_t* t0 = (bf16_t*)(p.ws + OFF_ST); \
    float* rowss = (float*)(p.ws + OFF_ROWSS); float* hbuf = p.out; (void)bufA; (void)bufH; (void)t0; (void)rowss; (void)hbuf;

  {
  PH_BEGIN
  prep_tables(p, wvs);
  wconv(p.w_in_even, 1024, 4096, 4096, (bf16_t*)(p.ws + W_IN), hs, wvs);
  wconv(p.w_out_even, 1024, 1024, 1024, (bf16_t*)(p.ws + W_OUT0), hs, wvs);
  wconv(p.w_ffn_up, 1024, 4096, 4096, (bf16_t*)(p.ws + W_UP), hs, wvs);
  wconv(p.w_ffn_down, 4096, 1024, 1024, (bf16_t*)(p.ws + W_DOWN), hs, wvs);
  rowpass_phase(nullptr, nullptr, nullptr, p.x_prompt, p.x_sample, nullptr, p.norm_mix_pre, bufH, wvs);
  }
  xcd_barrier(xb, wvs);
  {
  PH_BEGIN
  { EpiInEven e{bufA, (const float*)(p.ws + OFF_ROPE), (const float*)(p.ws + OFF_LB)};
    for (int rep_ = 0; rep_ < REPG; ++rep_) { gemm_phase(bufH, 1024, (const bf16_t*)(p.ws + W_IN), 1024, 64, 16, 1024, e, smem, wvs); gemm_tail(bufH, 1024, (const bf16_t*)(p.ws + W_IN), 1024, 32, 1024, e, smem, wvs, 64 * 16); } }
  }
  xcd_barrier(xb, wvs);
  {
  PH_BEGIN
  for (int rep_ = 0; rep_ < REPS; ++rep_) {
    if (bid < 256) {
      const int v = bid;
      const int ps = v & 3, m = (v >> 2) & 1, h = (v >> 3) & 3, sq = v >> 5;
      if (m == 0) state_unit<0>(p, sq, h, ps, hs, wvs); else state_unit<1>(p, sq, h, ps, hs, wvs);
    }
    const int nsh = bid < 256 ? 2 : 14, j0 = bid < 256 ? bid : 512 + (bid - 256);
    for (int i = 0; i < nsh; ++i) {
      const int v = j0 + 256 * i;
      const int ps = v & 3, m = (v >> 2) & 1, h = (v >> 3) & 3, sq = 8 + (v >> 5);
      if (m == 0) state_unit<0>(p, sq, h, ps, hs, wvs); else state_unit<1>(p, sq, h, ps, hs, wvs);
    }
  }
  }
  xcd_barrier(xb, wvs);
  {
  PH_BEGIN
  for (int rep_ = 0; rep_ < REPO; ++rep_)
  for (int u = bid; u < 384 * 8; u += G) {
    const int h = u & 3, m = (u >> 2) & 1, c = u >> 3;
    if (m == 0) out_unit<0>(p, c, h, hs, wvs); else out_unit<1>(p, c, h, hs, wvs);
  }
  }
  xcd_barrier(xb, wvs);
  {
  PH_BEGIN
  { EpiOut e{t0, rowss};
    for (int rep_ = 0; rep_ < REPG; ++rep_) { gemm_phase(bufH, 1024, (const bf16_t*)(p.ws + W_OUT0), 1024, 64, 4, 1024, e, smem, wvs); gemm_tail(bufH, 1024, (const bf16_t*)(p.ws + W_OUT0), 1024, 8, 1024, e, smem, wvs, 64 * 4); } }
  }
  xcd_barrier(xb, wvs);
  {
  PH_BEGIN
  for (int rep_ = 0; rep_ < REPR; ++rep_)
  rowpass_phase(t0, rowss, p.norm_mix_post, p.x_prompt, p.x_sample, hbuf, p.norm_ffn_pre, bufH, wvs);
  }
  xcd_barrier(xb, wvs);
  {
  PH_BEGIN
  { EpiUp e{bufA}; for (int rep_ = 0; rep_ < REPG; ++rep_) { gemm_phase(bufH, 1024, (const bf16_t*)(p.ws + W_UP), 1024, 64, 16, 1024, e, smem, wvs); gemm_tail(bufH, 1024, (const bf16_t*)(p.ws + W_UP), 1024, 32, 1024, e, smem, wvs, 64 * 16); } }
  }
  xcd_barrier(xb, wvs);
  {
  PH_BEGIN
  { EpiOut e{t0, rowss + ROWS}; for (int rep_ = 0; rep_ < REPG; ++rep_) { gemm_phase(bufA, 4096, (const bf16_t*)(p.ws + W_DOWN), 4096, 64, 4, 4096, e, smem, wvs); gemm_tail(bufA, 4096, (const bf16_t*)(p.ws + W_DOWN), 4096, 8, 4096, e, smem, wvs, 64 * 4); } }
  }
  xcd_barrier(xb, wvs);
  {
  PH_BEGIN
  rowpass_phase(t0, rowss + ROWS, p.norm_ffn_post, hbuf, hbuf + (size_t)16384 * 1024, hbuf, p.norm_mix_pre + 1024, bufH, wvs);
  wconv(p.w_in_odd, 1024, 3088, 3328, (bf16_t*)(p.ws + W_IN), hs, wvs);
  wconv(p.w_glu, 512, 512, 512, (bf16_t*)(p.ws + W_GLU), hs, wvs);
  wconv(p.w_out_odd, 1536, 1024, 1024, (bf16_t*)(p.ws + W_OUT1), hs, wvs);
  wconv(p.w_ffn_up + (size_t)1024 * 4096, 1024, 4096, 4096, (bf16_t*)(p.ws + W_UP), hs, wvs);
  wconv(p.w_ffn_down + (size_t)4096 * 1024, 4096, 1024, 1024, (bf16_t*)(p.ws + W_DOWN), hs, wvs);
  }
  xcd_barrier(xb, wvs);
  {
  PH_BEGIN
  { EpiInOdd e{bufA, (float*)(p.ws + OFF_DTBUF)};
    for (int rep_ = 0; rep_ < REPG; ++rep_) { gemm_phase(bufH, 1024, (const bf16_t*)(p.ws + W_IN), 1024, 64, 13, 1024, e, smem, wvs); gemm_tail(bufH, 1024, (const bf16_t*)(p.ws + W_IN), 1024, 26, 1024, e, smem, wvs, 64 * 13); } }
  }
  xcd_barrier(xb, wvs);
  {
  PH_BEGIN
  for (int rep_ = 0; rep_ < REPC; ++rep_) {
  conv_phase(p, wvs);
  for (int u = bid; u < 384 * 8; u += G) s5_unit<0>(p, u >> 3, u & 7, hs, wvs);
  }
  }
  xcd_barrier(xb, wvs);
  {
  PH_BEGIN
  for (int rep_ = 0; rep_ < REPS; ++rep_) {
    if (bid < 128) state_unit<2>(p, bid >> 4, bid & 15, 0, hs, wvs);
    for (int j = bid < 128 ? bid : 256 + (bid - 128); j < 3136; j += (bid < 128 ? 128 : 384)) {
      if (bid < 128 && j >= 256) break;
      if (j < 1088) { int tq_ = TIDX(wvs) & 255; asm volatile("" : "+v"(tq_)); s5_prefix(p, j * 256 + tq_); }
      else { const int v = j - 1088; state_unit<2>(p, 8 + (v >> 4), v & 15, 0, hs, wvs); }
    }
  }
  }
  xcd_barrier(xb, wvs);
  {
  PH_BEGIN
  for (int u = bid; u < 384 * 16 + 384 * 8; u += G) {
    if (u < 384 * 16) out_unit<2>(p, u >> 4, u & 15, hs, wvs);
    else { const int v = u - 384 * 16; s5_unit<1>(p, v >> 3, v & 7, hs, wvs); }
  }
  }
  xcd_barrier(xb, wvs);
  {
  PH_BEGIN
  ssdnorm_phase(p, wvs);
  { EpiGlu e{(const bf16_t*)(p.ws + OFF_GBUF), p.b_glu, bufH};
    for (int rep_ = 0; rep_ < REPG; ++rep_) { gemm_phase((const bf16_t*)(p.ws + OFF_GBUF), 512, (const bf16_t*)(p.ws + W_GLU), 512, 64, 2, 512, e, smem, wvs); gemm_tail((const bf16_t*)(p.ws + OFF_GBUF), 512, (const bf16_t*)(p.ws + W_GLU), 512, 4, 512, e, smem, wvs, 64 * 2); } }
  }
  xcd_barrier(xb, wvs);
  {
  PH_BEGIN
  { EpiOut e{t0, rowss + 2 * ROWS}; for (int rep_ = 0; rep_ < REPG; ++rep_) { gemm_phase(bufH, 1536, (const bf16_t*)(p.ws + W_OUT1), 1536, 64, 4, 1536, e, smem, wvs); gemm_tail(bufH, 1536, (const bf16_t*)(p.ws + W_OUT1), 1536, 8, 1536, e, smem, wvs, 64 * 4); } }
  }
  xcd_barrier(xb, wvs);
  {
  PH_BEGIN
  rowpass_phase(t0, rowss + 2 * ROWS, p.norm_mix_post + 1024, hbuf, hbuf + (size_t)16384 * 1024, hbuf, p.norm_ffn_pre + 1024, bufH, wvs);
  }
  xcd_barrier(xb, wvs);
  {
  PH_BEGIN
  { EpiUp e{bufA}; for (int rep_ = 0; rep_ < REPG; ++rep_) { gemm_phase(bufH, 1024, (const bf16_t*)(p.ws + W_UP), 1024, 64, 16, 1024, e, smem, wvs); gemm_tail(bufH, 1024, (const bf16_t*)(p.ws + W_UP), 1024, 32, 1024, e, smem, wvs, 64 * 16); } }
  }
  xcd_barrier(xb, wvs);
  {
  PH_BEGIN
  { EpiOut e{t0, rowss + 3 * ROWS}; for (int rep_ = 0; rep_ < REPG; ++rep_) { gemm_phase(bufA, 4096, (const bf16_t*)(p.ws + W_DOWN), 4096, 64, 4, 4096, e, smem, wvs); gemm_tail(bufA, 4096, (const bf16_t*)(p.ws + W_DOWN), 4096, 8, 4096, e, smem, wvs, 64 * 4); } }
  }
  xcd_barrier(xb, wvs);
  {
  PH_BEGIN
  rowpass_phase(t0, rowss + 3 * ROWS, p.norm_ffn_post + 1024, hbuf, hbuf + (size_t)16384 * 1024, hbuf, nullptr, nullptr, wvs);
  }
}

extern "C" void kernel_launch(void* const* d_in, const int* in_sizes, int n_in, void* d_out, int out_size, void* d_ws, size_t ws_size, hipStream_t stream) {
  constexpr size_t kDynLds = 2 * HALF_LDS + 64;
  static int grid_blocks = 0;
  if (!grid_blocks) {
    int dev = 0, cus = 0, per_cu = 0;
    (void)hipGetDevice(&dev);
    (void)hipDeviceGetAttribute(&cus, hipDeviceAttributeMultiprocessorCount, dev);
    (void)hipFuncSetAttribute((const void*)fwd_megakernel, hipFuncAttributeMaxDynamicSharedMemorySize, (int)kDynLds);
    (void)hipOccupancyMaxActiveBlocksPerMultiprocessor(&per_cu, fwd_megakernel, NTHR, kDynLds);
    if (per_cu > 1) per_cu = 1;
    if (per_cu < 1) per_cu = 1;
    grid_blocks = cus * per_cu;
  }
  Params p{};
  const float** pf = (const float**)&p;
  for (int i = 0; i < 37; ++i) pf[i] = (const float*)d_in[i];
  p.out = (float*)d_out;
  p.ws = (char*)d_ws;
  (void)hipMemsetAsync((char*)d_ws + OFF_BAR, 0, 16384, stream);
  void* args[] = {&p};
  hipError_t e = hipLaunchCooperativeKernel((void*)fwd_megakernel, dim3(grid_blocks), dim3(NTHR), args, kDynLds, stream);
  if (e != hipSuccess) fprintf(stderr, "cooperative launch failed: %s (grid %d)\n", hipGetErrorString(e), grid_blocks);
}
```

```cpp
#include <hip/hip_runtime.h>
#include <hip/hip_cooperative_groups.h>
#include <cstdio>
namespace cg = cooperative_groups;

typedef unsigned short bf16_t;
typedef short bf16x8 __attribute__((ext_vector_type(8)));
typedef float f32x4 __attribute__((ext_vector_type(4)));
typedef unsigned u32x4 __attribute__((ext_vector_type(4)));
typedef float f32x2 __attribute__((ext_vector_type(2)));

#define NTHR 512
#ifndef REPS
#define REPS 1
#endif
#ifndef REPO
#define REPO 1
#endif
#ifndef REPC
#define REPC 1
#endif
#ifndef REPR
#define REPR 1
#endif
#ifndef REPG
#define REPG 1
#endif
#define HALF_LDS 74752
#ifndef REP0
#define REP0 1
#endif
#ifndef REPS
#define REPS 1
#endif
#ifndef REPO
#define REPO 1
#endif
#ifndef REPC
#define REPC 1
#endif
#ifndef REPY
#define REPY 21
#endif
#define ROWS 17408
#define EPSV 1e-6f
#define TIDX(w) ((w) * 64 + (int)__builtin_amdgcn_mbcnt_hi(~0u, __builtin_amdgcn_mbcnt_lo(~0u, 0u)))

constexpr size_t W_IN = 0;
constexpr size_t W_OUT0 = 8388608;
constexpr size_t W_GLU = 6815744;
constexpr size_t W_OUT1 = 7340032;
constexpr size_t W_UP = 10485760;
constexpr size_t W_DOWN = 18874368;
constexpr size_t OFF_A = 29360128;
constexpr size_t OFF_GBUF = OFF_A + 111411200;
constexpr size_t OFF_ST = OFF_A + 142606336;
constexpr size_t OFF_H = OFF_ST + 67108864;
constexpr size_t OFF_SM = OFF_H + 53477376;
constexpr size_t OFF_ROPE = OFF_SM;
constexpr size_t OFF_ROWSS = OFF_SM + 1052672;
constexpr size_t OFF_SSDST = OFF_SM + 1331200;
constexpr size_t OFF_DTBUF = OFF_SM + 1470464;
constexpr size_t OFF_LB = OFF_SM + 2584576;
constexpr size_t OFF_S5TAB = OFF_SM + 2586624;
constexpr size_t OFF_S5E = OFF_SM + 2897920;
constexpr size_t OFF_S5H = OFF_SM + 9189376;
constexpr size_t OFF_BAR = OFF_SM + 15480832;

constexpr size_t O_RET = 17825792, O_HG = 26738688, O_SSM = 35651584, O_CONV = 53477376, O_S5RE = 54104064, O_S5IM = 54382592;

struct Params {
  const float *x_prompt, *x_sample, *state_ret, *state_hgrn, *state_ssm, *state_conv, *state_s5_re, *state_s5_im;
  const float *norm_mix_pre, *norm_mix_post, *norm_ffn_pre, *norm_ffn_post;
  const float *w_in_even, *w_out_even, *ret_norm_w, *hgrn_lb, *hgrn_norm_w, *w_in_odd, *conv_w, *conv_b, *dt_bias, *a_log, *d_ssm, *ssm_norm_w;
  const float *s5_lam_re, *s5_lam_im, *s5_log_step, *s5_b_re, *s5_b_im, *s5_c_re, *s5_c_im, *s5_d, *w_glu, *b_glu, *w_out_odd, *w_ffn_up, *w_ffn_down;
  float* out;
  char* ws;
};

__device__ __forceinline__ bf16_t f2bf(float f) { unsigned r; asm("v_cvt_pk_bf16_f32 %0, %1, %1" : "=v"(r) : "v"(f)); return (bf16_t)(r & 0xffffu); }
__device__ __forceinline__ float bf2f(bf16_t h) { return __uint_as_float(((unsigned)h) << 16); }
__device__ __forceinline__ unsigned pack2(float a, float b) { unsigned r; asm("v_cvt_pk_bf16_f32 %0, %1, %2" : "=v"(r) : "v"(a), "v"(b)); return r; }
__device__ __forceinline__ float lo2f(unsigned u) { return __uint_as_float(u << 16); }
__device__ __forceinline__ float hi2f(unsigned u) { return __uint_as_float(u & 0xffff0000u); }
__device__ __forceinline__ float sigm(float x) { return 1.f / (1.f + __expf(-x)); }
__device__ __forceinline__ float siluf(float x) { return x / (1.f + __expf(-x)); }
__device__ __forceinline__ void store4bf(bf16_t* p, float a, float b, float c, float d) { uint2 v; v.x = pack2(a, b); v.y = pack2(c, d); *(uint2*)p = v; }

__device__ __forceinline__ float shx(float v, int mask) {
  int l = (int)__builtin_amdgcn_mbcnt_hi(~0u, __builtin_amdgcn_mbcnt_lo(~0u, 0u));
  asm volatile("" : "+v"(l));
  return __int_as_float(__builtin_amdgcn_ds_bpermute((l ^ mask) << 2, __float_as_int(v)));
}

template <int MT, int NT>
__device__ __forceinline__ void wmma_sw(f32x4 (&acc)[MT][NT], const bf16_t* A, int lda, const bf16_t* B, int ldb, int K, int lane) {
  const int r = lane & 15, kq = (lane >> 4) * 8;
  for (int k0 = 0; k0 < K; k0 += 32) {
    bf16x8 af[MT], bfr[NT];
#pragma unroll
    for (int mt = 0; mt < MT; ++mt) af[mt] = *(const bf16x8*)(A + (mt * 16 + r) * lda + k0 + kq);
#pragma unroll
    for (int nt = 0; nt < NT; ++nt) bfr[nt] = *(const bf16x8*)(B + (nt * 16 + r) * ldb + k0 + kq);
#pragma unroll
    for (int mt = 0; mt < MT; ++mt)
#pragma unroll
      for (int nt = 0; nt < NT; ++nt) acc[mt][nt] = __builtin_amdgcn_mfma_f32_16x16x32_bf16(bfr[nt], af[mt], acc[mt][nt], 0, 0, 0);
  }
}
template <int MT, int NT>
__device__ __forceinline__ void wmma_ns(f32x4 (&acc)[MT][NT], const bf16_t* A, int lda, const bf16_t* B, int ldb, int K, int lane) {
  const int r = lane & 15, kq = (lane >> 4) * 8;
  for (int k0 = 0; k0 < K; k0 += 32) {
    bf16x8 af[MT], bfr[NT];
#pragma unroll
    for (int mt = 0; mt < MT; ++mt) af[mt] = *(const bf16x8*)(A + (mt * 16 + r) * lda + k0 + kq);
#pragma unroll
    for (int nt = 0; nt < NT; ++nt) bfr[nt] = *(const bf16x8*)(B + (nt * 16 + r) * ldb + k0 + kq);
#pragma unroll
    for (int mt = 0; mt < MT; ++mt)
#pragma unroll
      for (int nt = 0; nt < NT; ++nt) acc[mt][nt] = __builtin_amdgcn_mfma_f32_16x16x32_bf16(af[mt], bfr[nt], acc[mt][nt], 0, 0, 0);
  }
}

__device__ __forceinline__ void gemm_kstep(f32x4 (&acc)[4][8], const char* A, const char* B) {
  bf16x8 af[4], bfr[8];
#pragma unroll
  for (int mt = 0; mt < 4; ++mt) af[mt] = *(const bf16x8*)(A + mt * 2048);
#pragma unroll
  for (int nt = 0; nt < 8; ++nt) bfr[nt] = *(const bf16x8*)(B + nt * 2048);
  __builtin_amdgcn_sched_barrier(0);
#pragma unroll
  for (int nt = 0; nt < 8; ++nt)
#pragma unroll
    for (int mt = 0; mt < 4; ++mt) acc[mt][nt] = __builtin_amdgcn_mfma_f32_16x16x32_bf16(bfr[nt], af[mt], acc[mt][nt], 0, 0, 0);
}

template <class Epi>
__device__ __forceinline__ void gemm_phase(const bf16_t* A, int lda, const bf16_t* Bt, int ldb, int nMt, int nNt, int K, const Epi& epi, char* smem, int wvs) {
  char* As = smem;
  char* Bs = smem + 65536;
  int tid_ = TIDX(wvs); asm volatile("" : "+v"(tid_)); const int tid = tid_, lane = tid & 63, wave = tid >> 6;
  const int wr = wave >> 1, wc = wave & 1;
  const int ntiles = nMt * nNt, nk = K >> 6;
  const int lrow = tid >> 3, lcc = (tid & 7) * 8;
  const int wofs = ((lrow >> 4) * 2 + (lcc >> 5)) * 1024 + ((((lrow & 15) * 64) + (lcc & 31) * 2) ^ ((lrow & 8) << 2));
  const int rofs = (((lane & 15) * 64) + (lane >> 4) * 16) ^ ((lane & 8) << 2);
  const unsigned toffA = (unsigned)(lrow * lda + lcc), toffB = (unsigned)(lrow * ldb + lcc);
  for (int tile = blockIdx.x; tile < ntiles; tile += gridDim.x) {
    const int pn = tile / nMt, pm = tile - pn * nMt;
    const bf16_t* Ab = A + (size_t)(pm * 256) * lda;
    const bf16_t* Bb = Bt + (size_t)(pn * 256) * ldb;
    f32x4 acc[4][8];
#pragma unroll
    for (int i = 0; i < 4; ++i)
#pragma unroll
      for (int j = 0; j < 8; ++j) acc[i][j] = (f32x4){0.f, 0.f, 0.f, 0.f};
    u32x4 rg[4];
#pragma unroll
    for (int i = 0; i < 4; ++i) rg[i] = *(const u32x4*)(Ab + (size_t)(i * 64) * lda + toffA);
#pragma unroll
    for (int i = 0; i < 4; ++i) *(u32x4*)(As + wofs + i * 8192) = rg[i];
#pragma unroll
    for (int i = 0; i < 4; ++i) rg[i] = *(const u32x4*)(Bb + (size_t)(i * 64) * ldb + toffB);
#pragma unroll
    for (int i = 0; i < 4; ++i) *(u32x4*)(Bs + wofs + i * 8192) = rg[i];
    __syncthreads();
#pragma unroll 1
    for (int kt = 0; kt < nk; ++kt) {
      const int cur = kt & 1;
      const int kn = (kt + 1 < nk ? kt + 1 : kt) * 64;
      char* Ad = As + (cur ^ 1) * 32768; char* Bd = Bs + (cur ^ 1) * 32768;
#pragma unroll
      for (int i = 0; i < 4; ++i) rg[i] = *(const u32x4*)(Ab + ((size_t)(i * 64) * lda + kn) + toffA);
      __builtin_amdgcn_sched_barrier(0);
      gemm_kstep(acc, As + cur * 32768 + wr * 8192 + rofs, Bs + cur * 32768 + wc * 16384 + rofs);
      __builtin_amdgcn_sched_barrier(0);
#pragma unroll
      for (int i = 0; i < 4; ++i) *(u32x4*)(Ad + wofs + i * 8192) = rg[i];
#pragma unroll
      for (int i = 0; i < 4; ++i) rg[i] = *(const u32x4*)(Bb + ((size_t)(i * 64) * ldb + kn) + toffB);
      __builtin_amdgcn_sched_barrier(0);
      gemm_kstep(acc, As + cur * 32768 + wr * 8192 + 1024 + rofs, Bs + cur * 32768 + wc * 16384 + 1024 + rofs);
      __builtin_amdgcn_sched_barrier(0);
#pragma unroll
      for (int i = 0; i < 4; ++i) *(u32x4*)(Bd + wofs + i * 8192) = rg[i];
      __syncthreads();
    }
    int er_ = pm * 256 + wr * 64, ec_ = pn * 256 + wc * 128, el_ = lane;
    asm volatile("" : "+v"(er_), "+v"(ec_), "+v"(el_));
    epi(acc, er_, ec_, el_);
  }
}

struct EpiInEven {
  bf16_t* proj; const float* rope; const float* lb;
  template <int MT> __device__ __forceinline__ void operator()(f32x4 (&acc)[MT][8], int rbase, int cbase, int lane) const {
    const int sec = cbase >> 9, head = (cbase >> 7) & 3, r = lane & 15, cq = (lane >> 4) * 4;
#pragma unroll
    for (int mt = 0; mt < MT; ++mt) {
      __builtin_amdgcn_sched_barrier(0);
      const int row = rbase + mt * 16 + r;
      bf16_t* dst = proj + (size_t)row * 4096 + cbase + cq;
      if (sec < 2) {
        const int pidx = row < 16384 ? (row & 2047) : 2048 + ((row - 16384) & 7);
        const float* ct = rope + pidx * 128 + cq;
        const float sc = sec == 1 ? 0.08838834764831845f : 1.f;
        float4 cc4[4], ss4[4];
#pragma unroll
        for (int nt = 0; nt < 4; ++nt) { cc4[nt] = *(const float4*)(ct + nt * 16); ss4[nt] = *(const float4*)(ct + 64 + nt * 16); }
#pragma unroll
        for (int nt = 0; nt < 4; ++nt) {
          const float4 c4 = cc4[nt], s4 = ss4[nt];
          const f32x4 x1 = acc[mt][nt], x2 = acc[mt][nt + 4];
          store4bf(dst + nt * 16, (x1[0] * c4.x - x2[0] * s4.x) * sc, (x1[1] * c4.y - x2[1] * s4.y) * sc, (x1[2] * c4.z - x2[2] * s4.z) * sc, (x1[3] * c4.w - x2[3] * s4.w) * sc);
          store4bf(dst + 64 + nt * 16, (x1[0] * s4.x + x2[0] * c4.x) * sc, (x1[1] * s4.y + x2[1] * c4.y) * sc, (x1[2] * s4.z + x2[2] * c4.z) * sc, (x1[3] * s4.w + x2[3] * c4.w) * sc);
        }
      } else if (sec == 5) {
        float4 ll4[8];
#pragma unroll
        for (int nt = 0; nt < 8; ++nt) ll4[nt] = *(const float4*)(lb + head * 128 + nt * 16 + cq);
#pragma unroll
        for (int nt = 0; nt < 8; ++nt) {
          const float4 l4 = ll4[nt];
          const f32x4 x = acc[mt][nt];
          store4bf(dst + nt * 16, __logf(l4.x + (1.f - l4.x) * sigm(x[0])), __logf(l4.y + (1.f - l4.y) * sigm(x[1])), __logf(l4.z + (1.f - l4.z) * sigm(x[2])), __logf(l4.w + (1.f - l4.w) * sigm(x[3])));
        }
      } else {
#pragma unroll
        for (int nt = 0; nt < 8; ++nt) { const f32x4 x = acc[mt][nt]; store4bf(dst + nt * 16, x[0], x[1], x[2], x[3]); }
      }
    }
  }
};
struct EpiOut {
  bf16_t* t0; float* rowss;
  template <int MT> __device__ __forceinline__ void operator()(f32x4 (&acc)[MT][8], int rbase, int cbase, int lane) const {
    const int r = lane & 15, cq = (lane >> 4) * 4;
#pragma unroll
    for (int mt = 0; mt < MT; ++mt) {
      __builtin_amdgcn_sched_barrier(0);
      const int row = rbase + mt * 16 + r;
      bf16_t* dst = t0 + (size_t)row * 1024 + cbase + cq;
      float ss = 0.f;
#pragma unroll
      for (int nt = 0; nt < 8; ++nt) { const f32x4 x = acc[mt][nt]; ss += x[0] * x[0] + x[1] * x[1] + x[2] * x[2] + x[3] * x[3]; store4bf(dst + nt * 16, x[0], x[1], x[2], x[3]); }
      ss += shx(ss, 16); ss += shx(ss, 32);
      if (lane < 16) atomicAdd(rowss + row, ss * (1.f / REPG));
    }
  }
};
struct EpiUp {
  bf16_t* act;
  template <int MT> __device__ __forceinline__ void operator()(f32x4 (&acc)[MT][8], int rbase, int cbase, int lane) const {
    const int r = lane & 15, cq = (lane >> 4) * 4;
#pragma unroll
    for (int mt = 0; mt < MT; ++mt) {
      __builtin_amdgcn_sched_barrier(0);
      bf16_t* dst = act + (size_t)(rbase + mt * 16 + r) * 4096 + cbase + cq;
#pragma unroll
      for (int nt = 0; nt < 8; ++nt) { f32x4 x = acc[mt][nt];
#pragma unroll
        for (int j = 0; j < 4; ++j) { float v = fmaxf(x[j], 0.f); x[j] = v * v; }
        store4bf(dst + nt * 16, x[0], x[1], x[2], x[3]); }
    }
  }
};
struct EpiInOdd {
  bf16_t* proj; float* dtbuf;
  template <int MT> __device__ __forceinline__ void operator()(f32x4 (&acc)[MT][8], int rbase, int cbase, int lane) const {
    const int r = lane & 15, cq = (lane >> 4) * 4;
#pragma unroll
    for (int mt = 0; mt < MT; ++mt) {
      __builtin_amdgcn_sched_barrier(0);
      const int row = rbase + mt * 16 + r;
      bf16_t* dst = proj + (size_t)row * 3200 + cbase + cq;
#pragma unroll
      for (int nt = 0; nt < 8; ++nt) { const f32x4 x = acc[mt][nt]; if (cbase + nt * 16 < 3200) store4bf(dst + nt * 16, x[0], x[1], x[2], x[3]); }
      if (cbase == 2560) { const f32x4 x = acc[mt][0]; *(float4*)(dtbuf + (size_t)row * 16 + cq) = make_float4(x[0], x[1], x[2], x[3]); }
    }
  }
};
struct EpiGlu {
  const bf16_t* gbuf; const float* bglu; bf16_t* mix;
  template <int MT> __device__ __forceinline__ void operator()(f32x4 (&acc)[MT][8], int rbase, int cbase, int lane) const {
    const int r = lane & 15, cq = (lane >> 4) * 4;
#pragma unroll
    for (int mt = 0; mt < MT; ++mt) {
      __builtin_amdgcn_sched_barrier(0);
      const int row = rbase + mt * 16 + r;
      uint2 gg2[8]; float4 bb4[8];
#pragma unroll
      for (int nt = 0; nt < 8; ++nt) { const int col = cbase + nt * 16 + cq; gg2[nt] = *(const uint2*)(gbuf + (size_t)row * 512 + col); bb4[nt] = *(const float4*)(bglu + col); }
#pragma unroll
      for (int nt = 0; nt < 8; ++nt) {
        const int col = cbase + nt * 16 + cq;
        const f32x4 x = acc[mt][nt];
        const uint2 g2 = gg2[nt];
        const float4 b4 = bb4[nt];
        store4bf(mix + (size_t)row * 1536 + 1024 + col, lo2f(g2.x) * sigm(x[0] + b4.x), hi2f(g2.x) * sigm(x[1] + b4.y), lo2f(g2.y) * sigm(x[2] + b4.z), hi2f(g2.y) * sigm(x[3] + b4.w));
      }
    }
  }
};

template <class Epi>
__device__ __forceinline__ void gemm_tail(const bf16_t* A, int lda, const bf16_t* Bt, int ldb, int nNt128, int K, const Epi& epi, char* smem, int wvs, int nBig) {
  bf16_t* As = (bf16_t*)smem;
  bf16_t* Bs = As + 2 * 128 * 80;
  int tid_ = TIDX(wvs); asm volatile("" : "+v"(tid_)); const int tid = tid_, lane = tid & 63, wave = tid >> 6;
  const int nk = K >> 6, G = gridDim.x;
  const int lrow = tid >> 3, lcc = (tid & 7) * 8;
  const unsigned toffA = (unsigned)(lrow * lda + lcc), toffB = (unsigned)(lrow * ldb + lcc);
  const int rr = nBig % G, nLight = G - rr;
  const int nSmall = 8 * nNt128;
  if ((int)blockIdx.x >= rr) {
    for (int j = (int)blockIdx.x - rr; j < nSmall; j += nLight) {
      const int pm = j / nNt128, pn = j - pm * nNt128;
      const bf16_t* Ab = A + (size_t)(16384 + pm * 128) * lda;
      const bf16_t* Bb = Bt + (size_t)(pn * 128) * ldb;
      f32x4 acc[1][8];
#pragma unroll
      for (int q = 0; q < 8; ++q) acc[0][q] = (f32x4){0.f, 0.f, 0.f, 0.f};
      u32x4 ra[2], rb[2];
#pragma unroll
      for (int i = 0; i < 2; ++i) { ra[i] = *(const u32x4*)(Ab + (size_t)(i * 64) * lda + toffA); rb[i] = *(const u32x4*)(Bb + (size_t)(i * 64) * ldb + toffB); }
#pragma unroll
      for (int i = 0; i < 2; ++i) { *(u32x4*)(As + (lrow + i * 64) * 80 + lcc) = ra[i]; *(u32x4*)(Bs + (lrow + i * 64) * 80 + lcc) = rb[i]; }
      __syncthreads();
#pragma unroll 1
      for (int kt = 0; kt < nk; ++kt) {
        const int cur = kt & 1;
        const int kn = (kt + 1 < nk ? kt + 1 : kt) * 64;
#pragma unroll
        for (int i = 0; i < 2; ++i) { ra[i] = *(const u32x4*)(Ab + ((size_t)(i * 64) * lda + kn) + toffA); rb[i] = *(const u32x4*)(Bb + ((size_t)(i * 64) * ldb + kn) + toffB); }
        __builtin_amdgcn_sched_barrier(0);
        wmma_sw<1, 8>(acc, As + cur * 128 * 80 + wave * 16 * 80, 80, Bs + cur * 128 * 80, 80, 64, lane);
        __builtin_amdgcn_sched_barrier(0);
        bf16_t* Ad = As + (cur ^ 1) * 128 * 80; bf16_t* Bd = Bs + (cur ^ 1) * 128 * 80;
#pragma unroll
        for (int i = 0; i < 2; ++i) { *(u32x4*)(Ad + (lrow + i * 64) * 80 + lcc) = ra[i]; *(u32x4*)(Bd + (lrow + i * 64) * 80 + lcc) = rb[i]; }
        __syncthreads();
      }
      int er_ = 16384 + pm * 128 + wave * 16, ec_ = pn * 128, el_ = lane;
      asm volatile("" : "+v"(er_), "+v"(ec_), "+v"(el_));
      epi(acc, er_, ec_, el_);
    }
  }
}

__device__ __forceinline__ void rowpass_phase(const bf16_t* t0, const float* rowss, const float* wpost, const float* hin_a, const float* hin_b, float* hout, const float* wnext, bf16_t* hn, int wvs) {
  int tq_ = TIDX(wvs); asm volatile("" : "+v"(tq_)); const int lane = tq_ & 63, gw = blockIdx.x * 8 + (tq_ >> 6), nw = gridDim.x * 8;
  for (int row = gw; row < ROWS; row += nw) {
    const float* hin = row < 16384 ? hin_a + (size_t)row * 1024 : hin_b + (size_t)(row - 16384) * 1024;
    float r0 = 0.f;
    if (t0) r0 = rsqrtf(rowss[row] * (1.f / 1024.f) + EPSV);
    float4 v[4]; float ss = 0.f;
    float4 hvv[4], wpv[4], wnv[4]; uint2 tv[4];
#pragma unroll
    for (int i = 0; i < 4; ++i) {
      const int col = (i * 64 + lane) * 4;
      hvv[i] = *(const float4*)(hin + col);
      if (t0) { tv[i] = *(const uint2*)(t0 + (size_t)row * 1024 + col); wpv[i] = *(const float4*)(wpost + col); }
      if (hn) wnv[i] = *(const float4*)(wnext + col);
    }
#pragma unroll
    for (int i = 0; i < 4; ++i) {
      const int col = (i * 64 + lane) * 4;
      float4 hv = hvv[i];
      if (t0) {
        const uint2 t2 = tv[i];
        const float4 w4 = wpv[i];
        hv.x += lo2f(t2.x) * r0 * w4.x; hv.y += hi2f(t2.x) * r0 * w4.y; hv.z += lo2f(t2.y) * r0 * w4.z; hv.w += hi2f(t2.y) * r0 * w4.w;
      }
      v[i] = hv; ss += hv.x * hv.x + hv.y * hv.y + hv.z * hv.z + hv.w * hv.w;
      if (hout) *(float4*)(hout + (size_t)row * 1024 + col) = hv;
    }
    if (hn) {
#pragma unroll
      for (int o = 32; o >= 1; o >>= 1) ss += shx(ss, o);
      const float r1 = rsqrtf(ss * (1.f / 1024.f) + EPSV);
#pragma unroll
      for (int i = 0; i < 4; ++i) {
        const int col = (i * 64 + lane) * 4;
        const float4 w4 = wnv[i];
        store4bf(hn + (size_t)row * 1024 + col, v[i].x * r1 * w4.x, v[i].y * r1 * w4.y, v[i].z * r1 * w4.z, v[i].w * r1 * w4.w);
      }
    }
  }
}

__device__ __forceinline__ void wconv(const float* __restrict__ W, int K, int N, int Npad, bf16_t* __restrict__ Wt, char* smem, int wvs) {
  float* tile = (float*)smem;
  int tq_ = TIDX(wvs) & 255; asm volatile("" : "+v"(tq_)); const int tid = tq_;
  const int nNt = Npad >> 6, nunits = (K >> 6) * nNt;
  for (int u = blockIdx.x * 2 + (wvs >> 2); u < nunits; u += gridDim.x * 2) {
    const int k0 = (u / nNt) * 64, n0 = (u % nNt) * 64;
#pragma unroll
    for (int ps = 0; ps < 4; ++ps) {
      const int i = ps * 16 + (tid >> 4), j = (tid & 15) * 4, n = n0 + j;
      float4 v = make_float4(0.f, 0.f, 0.f, 0.f);
      if (n < N) v = *(const float4*)(W + (size_t)(k0 + i) * N + n);
      tile[i * 65 + j] = v.x; tile[i * 65 + j + 1] = v.y; tile[i * 65 + j + 2] = v.z; tile[i * 65 + j + 3] = v.w;
    }
    __syncthreads();
    {
      const int n = tid >> 2, kq = (tid & 3) * 16;
      uint4 o0, o1;
      o0.x = pack2(tile[(kq + 0) * 65 + n], tile[(kq + 1) * 65 + n]); o0.y = pack2(tile[(kq + 2) * 65 + n], tile[(kq + 3) * 65 + n]);
      o0.z = pack2(tile[(kq + 4) * 65 + n], tile[(kq + 5) * 65 + n]); o0.w = pack2(tile[(kq + 6) * 65 + n], tile[(kq + 7) * 65 + n]);
      o1.x = pack2(tile[(kq + 8) * 65 + n], tile[(kq + 9) * 65 + n]); o1.y = pack2(tile[(kq + 10) * 65 + n], tile[(kq + 11) * 65 + n]);
      o1.z = pack2(tile[(kq + 12) * 65 + n], tile[(kq + 13) * 65 + n]); o1.w = pack2(tile[(kq + 14) * 65 + n], tile[(kq + 15) * 65 + n]);
      bf16_t* d = Wt + (size_t)(n0 + n) * K + k0 + kq;
      *(uint4*)d = o0; *(uint4*)(d + 8) = o1;
    }
    __syncthreads();
  }
}

__device__ __forceinline__ void prep_tables(const Params& p, int wvs) {
  int tq_ = TIDX(wvs); asm volatile("" : "+v"(tq_)); const int gt = blockIdx.x * NTHR + tq_, nt = gridDim.x * NTHR;
  float* rope = (float*)(p.ws + OFF_ROPE);
  for (int i = gt; i < 2056 * 64; i += nt) {
    const int pi = i >> 6, f = i & 63;
    const double pos = pi < 2048 ? (double)pi : (double)(16384 + pi - 2048);
    const double invf = exp(-(double)f * (9.210340371976184 / 64.0));
    double ang = pos * invf;
    ang -= 6.283185307179586 * floor(ang * 0.15915494309189535);
    const float a = (float)ang;
    rope[pi * 128 + f] = cosf(a); rope[pi * 128 + 64 + f] = sinf(a);
  }
  float* z = (float*)(p.ws + OFF_ROWSS);
  for (int i = gt; i < ROWS * 6; i += nt) z[i] = 0.f;
  float* lb = (float*)(p.ws + OFF_LB);
  for (int i = gt; i < 512; i += nt) lb[i] = 1.f / (1.f + expf(p.hgrn_lb[512 + i] - p.hgrn_lb[i]));
  float* tab = (float*)(p.ws + OFF_S5TAB);
  for (int i = gt; i < 2048; i += nt) {
    const int g = i >> 6;
    const float lr = p.s5_lam_re[i], li = p.s5_lam_im[i], dt = expf(p.s5_log_step[g]);
    const float m1 = expf(lr * dt), br = m1 * cosf(li * dt), bi = m1 * sinf(li * dt);
    tab[i] = br; tab[2048 + i] = bi;
    const float m64 = expf(lr * dt * 64.f); tab[69632 + i] = m64 * cosf(li * dt * 64.f); tab[71680 + i] = m64 * sinf(li * dt * 64.f);
    const float m8 = expf(lr * dt * 8.f); tab[73728 + i] = m8 * cosf(li * dt * 8.f); tab[75776 + i] = m8 * sinf(li * dt * 8.f);
    const float x = br - 1.f, y = bi, den = 1.f / (lr * lr + li * li);
    const float qr = (x * lr + y * li) * den, qi = (y * lr - x * li) * den;
    for (int c = 0; c < 16; ++c) {
      const float b_r = p.s5_b_re[i * 16 + c], b_i = p.s5_b_im[i * 16 + c];
      tab[4096 + i * 16 + c] = qr * b_r - qi * b_i;
      tab[4096 + 32768 + i * 16 + c] = qr * b_i + qi * b_r;
    }
  }
}

__device__ __forceinline__ void chunk_geom(int c, int& row0, int& L) { if (c < 256) { row0 = c * 64; L = 64; } else { row0 = 16384 + (c - 256) * 8; L = 8; } }

template <int MODE>
__device__ __forceinline__ void st_load(uint4 (&kr)[4], uint4 (&vr)[1], float& dtr, const bf16_t* src, const float* dtbuf, int row0, int L, int ld, int kcol, int vcol, int h, int tid) {
  constexpr int PW = 32, NVC = PW / 32, VCR = PW / 8;
  const uint4 z4 = make_uint4(0, 0, 0, 0);
#pragma unroll
  for (int i = 0; i < 4; ++i) { const int id = tid + i * 256, s = id >> 4, c8 = id & 15; uint4 t_ = z4; if (s < L) t_ = *(const uint4*)(src + (size_t)(row0 + s) * ld + kcol + c8 * 8); kr[i] = t_; }
#pragma unroll
  for (int i = 0; i < NVC; ++i) { const int id = tid + i * 256, s = id / VCR, c8 = id % VCR; uint4 t_ = z4; if (s < L) t_ = *(const uint4*)(src + (size_t)(row0 + s) * ld + vcol + c8 * 8); vr[i] = t_; }
  if (MODE == 2 && tid < 64) dtr = tid < L ? dtbuf[(size_t)(row0 + tid) * 16 + h] : 0.f;
}

template <int MODE>
__device__ __forceinline__ void state_unit(const Params& p, int sq, int h, int ps, char* smem, int wvs) {
  constexpr int PW = 32, NT = PW / 16, PF = (MODE == 2) ? 64 : 128, HH = (MODE == 2) ? 16 : 4, NVC = PW / 32, VCR = PW / 8;
  bf16_t* KT = (bf16_t*)smem;
  bf16_t* VT = KT + 128 * 80;
  bf16_t* KR = VT + 64 * 80;
  float* tot = (float*)(KR + 64 * 136);
  float* dec = tot + 256;
  float* av = dec + 64;
  float* dtv = av + 64;
  int tid_ = TIDX(wvs) & 255; asm volatile("" : "+v"(tid_)); const int tid = tid_, lane = tid & 63, wave = tid >> 6;
  const bool prompt = sq < 8;
  const int nch = prompt ? 32 : 1, L = prompt ? 64 : 8;
  const int ld = (MODE == 2) ? 1536 : 4096;
  const bf16_t* src = (MODE == 2) ? (const bf16_t*)(p.ws + OFF_H) : (const bf16_t*)(p.ws + OFF_A);
  const int kcol = MODE == 0 ? 512 + h * 128 : MODE == 1 ? 2560 + h * 128 : 1024 + (h >> 3) * 128;
  const int vcol = MODE == 0 ? 1024 + h * 128 + ps * 32 : MODE == 1 ? 3072 + h * 128 + ps * 32 : h * 64 + ps * 32;
  const float* sin_ = MODE == 0 ? p.state_ret : MODE == 1 ? p.state_hgrn : p.state_ssm;
  float* sout = p.out + (MODE == 0 ? O_RET : MODE == 1 ? O_HG : O_SSM) + (size_t)(sq * HH + h) * 128 * PF;
  bf16_t* stb = (bf16_t*)(p.ws + OFF_ST) + (MODE == 1 ? (size_t)256 * 4 * 128 * 128 : 0);
  const float* dtbuf = (const float*)(p.ws + OFF_DTBUF);
  const float l2g = MODE == 0 ? log2f(1.f - exp2f(-5.f - (float)h)) : 0.f;
  float Ah = 0.f, dtb = 0.f;
  if (MODE == 2) { Ah = -expf(p.a_log[h]); dtb = p.dt_bias[h]; }

  f32x4 acc[2][NT];
  const int nb = wave * 32 + (lane >> 4) * 4, pc = ps * PW + (lane & 15);
#pragma unroll
  for (int mt = 0; mt < 2; ++mt)
#pragma unroll
    for (int nt = 0; nt < NT; ++nt)
#pragma unroll
      for (int j = 0; j < 4; ++j)
        acc[mt][nt][j] = prompt ? 0.f : sin_[((size_t)((sq - 8) * HH + h) * 128 + nb + mt * 16 + j) * PF + pc + nt * 16];

  uint4 kr[4], vr[NVC]; float dtr = 0.f;
  const uint4 z4 = make_uint4(0, 0, 0, 0);
  st_load<MODE>(kr, vr, dtr, src, dtbuf, prompt ? sq * 2048 : 16384 + (sq - 8) * 8, L, ld, kcol, vcol, h, tid);
  for (int n = 0; n < nch; ++n) {
    if (prompt) {
      bf16_t* d = stb + ((size_t)((sq * 32 + n) * HH + h) * PF) * 128;
#pragma unroll
      for (int mt = 0; mt < 2; ++mt)
#pragma unroll
        for (int nt = 0; nt < NT; ++nt) store4bf(d + (size_t)(pc + nt * 16) * 128 + nb + mt * 16, acc[mt][nt][0], acc[mt][nt][1], acc[mt][nt][2], acc[mt][nt][3]);
    }
#pragma unroll
    for (int i = 0; i < 4; ++i) { const int id = tid + i * 256, s = id >> 4, c8 = id & 15; *(uint4*)(KR + s * 136 + c8 * 8) = kr[i]; }
#pragma unroll
    for (int i = 0; i < NVC; ++i) {
      const int id = tid + i * 256, s = id / VCR, c8 = id % VCR; const uint4 v = vr[i];
      bf16_t* d = VT + (c8 * 8) * 80 + s;
      d[0] = (bf16_t)(v.x & 0xffff); d[80] = (bf16_t)(v.x >> 16); d[160] = (bf16_t)(v.y & 0xffff); d[240] = (bf16_t)(v.y >> 16);
      d[320] = (bf16_t)(v.z & 0xffff); d[400] = (bf16_t)(v.z >> 16); d[480] = (bf16_t)(v.w & 0xffff); d[560] = (bf16_t)(v.w >> 16);
    }
    if (MODE == 2 && tid < 64) {
      float dt = 0.f;
      if (tid < L) { const float x = dtr + dtb; dt = x > 20.f ? x : log1pf(__expf(x)); }
      dtv[tid] = dt; av[tid] = dt * Ah;
    }
    if (n + 1 < nch) st_load<MODE>(kr, vr, dtr, src, dtbuf, sq * 2048 + (n + 1) * 64, L, ld, kcol, vcol, h, tid);
    __syncthreads();
    const int kn = tid & 127, half = tid >> 7;
    if (MODE == 1) {
      float s_ = 0.f;
      for (int s = half * 32; s < half * 32 + 32; ++s) s_ += bf2f(KR[s * 136 + kn]);
      tot[half * 128 + kn] = s_;
    }
    if (MODE == 2 && tid < 64) {
      float suf = 0.f;
      for (int r = tid + 1; r < 64; ++r) suf += av[r];
      dec[tid] = __expf(suf) * dtv[tid];
      if (tid == 0) tot[0] = suf + av[0];
    }
    if (MODE != 0) __syncthreads();
    {
      float suf = 0.f;
      if (MODE == 1) suf = half == 0 ? tot[128 + kn] : 0.f;
      for (int g = 3; g >= 0; --g) {
        const int s0 = half * 32 + g * 8;
        float v[8];
#pragma unroll
        for (int e = 7; e >= 0; --e) {
          const int s = s0 + e;
          const float raw = bf2f(KR[s * 136 + kn]);
          if (MODE == 0) v[e] = raw * exp2f((float)(L - 1 - s) * l2g);
          else if (MODE == 1) { v[e] = (1.f - __expf(raw)) * __expf(suf); suf += raw; }
          else v[e] = raw * dec[s];
        }
        uint4 o; o.x = pack2(v[0], v[1]); o.y = pack2(v[2], v[3]); o.z = pack2(v[4], v[5]); o.w = pack2(v[6], v[7]);
        *(uint4*)(KT + kn * 80 + s0) = o;
      }
    }
    __syncthreads();
#pragma unroll
    for (int mt = 0; mt < 2; ++mt) {
      float dk[4];
      if (MODE == 0) { const float d = exp2f((float)L * l2g); dk[0] = dk[1] = dk[2] = dk[3] = d; }
      else if (MODE == 2) { const float d = __expf(tot[0]); dk[0] = dk[1] = dk[2] = dk[3] = d; }
      else {
#pragma unroll
        for (int j = 0; j < 4; ++j) { const int nn = nb + mt * 16 + j; dk[j] = __expf(tot[nn] + tot[128 + nn]); }
      }
#pragma unroll
      for (int nt = 0; nt < NT; ++nt)
#pragma unroll
        for (int j = 0; j < 4; ++j) acc[mt][nt][j] *= dk[j];
    }
    wmma_ns<2, NT>(acc, KT + wave * 32 * 80, 80, VT, 80, 64, lane);
    __syncthreads();
  }
#pragma unroll
  for (int mt = 0; mt < 2; ++mt)
#pragma unroll
    for (int nt = 0; nt < NT; ++nt)
#pragma unroll
      for (int j = 0; j < 4; ++j) sout[(size_t)(nb + mt * 16 + j) * PF + pc + nt * 16] = acc[mt][nt][j];
}

template <int MODE>
__device__ __forceinline__ void out_unit(const Params& p, int c, int h, char* smem, int wvs) {
  constexpr int PF = (MODE == 2) ? 64 : 128, NTP = PF / 16, HH = (MODE == 2) ? 16 : 4, NVC = PF / 32, VCR = PF / 8;
  bf16_t* Q = (bf16_t*)smem;
  bf16_t* Kb = Q + 64 * 136;
  bf16_t* STb = Kb + 128 * 80;
  float* cumv = (float*)(STb + 128 * 136);
  float* dtv = cumv + 64;
  float* av = dtv + 64;
  float* tot = av + 64;
  int tid_ = TIDX(wvs) & 255; asm volatile("" : "+v"(tid_)); const int tid = tid_, lane = tid & 63, wave = tid >> 6;
  int row0, L; chunk_geom(c, row0, L);
  const int ld = (MODE == 2) ? 1536 : 4096;
  const bf16_t* src = (MODE == 2) ? (const bf16_t*)(p.ws + OFF_H) : (const bf16_t*)(p.ws + OFF_A);
  const int qcol = MODE == 0 ? h * 128 : MODE == 1 ? 2048 + h * 128 : 1280 + (h >> 3) * 128;
  const int kcol = MODE == 0 ? 512 + h * 128 : MODE == 1 ? 2560 + h * 128 : 1024 + (h >> 3) * 128;
  const int vcol = MODE == 0 ? 1024 + h * 128 : MODE == 1 ? 3072 + h * 128 : h * 64;
  const float l2g = MODE == 0 ? log2f(1.f - exp2f(-5.f - (float)h)) : 0.f;
  const uint4 z4 = make_uint4(0, 0, 0, 0);
#pragma unroll
  for (int i = 0; i < 4; ++i) {
    const int id = tid + i * 256, s = id >> 4, c8 = id & 15;
    uint4 q4 = z4, k4 = z4;
    if (s < L) { q4 = *(const uint4*)(src + (size_t)(row0 + s) * ld + qcol + c8 * 8); k4 = *(const uint4*)(src + (size_t)(row0 + s) * ld + kcol + c8 * 8); }
    *(uint4*)(Q + s * 136 + c8 * 8) = q4; *(uint4*)(Kb + s * 136 + c8 * 8) = k4;
  }
  uint4 vr[NVC];
#pragma unroll
  for (int i = 0; i < NVC; ++i) { const int id = tid + i * 256, s = id / VCR, c8 = id % VCR; uint4 t_ = z4; if (s < L) t_ = *(const uint4*)(src + (size_t)(row0 + s) * ld + vcol + c8 * 8); vr[i] = t_; }
  if (c < 256) {
    const bf16_t* stg = (const bf16_t*)(p.ws + OFF_ST) + (MODE == 1 ? (size_t)256 * 4 * 128 * 128 : 0) + ((size_t)(c * HH + h) * PF) * 128;
#pragma unroll
    for (int i = 0; i < PF / 16; ++i) { const int id = tid + i * 256, pr = id >> 4, c8 = id & 15; *(uint4*)(STb + pr * 136 + c8 * 8) = *(const uint4*)(stg + (size_t)pr * 128 + c8 * 8); }
  } else {
    const float* sg = (MODE == 0 ? p.state_ret : MODE == 1 ? p.state_hgrn : p.state_ssm) + (size_t)((c - 256) * HH + h) * 128 * PF;
    for (int idb = tid; idb < 128 * (PF / 4); idb += 1024) {
      float4 v4[4];
#pragma unroll
      for (int q = 0; q < 4; ++q) { const int id = idb + q * 256, n = id / (PF / 4), p4 = (id % (PF / 4)) * 4; v4[q] = *(const float4*)(sg + (size_t)n * PF + p4); }
#pragma unroll
      for (int q = 0; q < 4; ++q) {
        const int id = idb + q * 256, n = id / (PF / 4), p4 = (id % (PF / 4)) * 4; const float4 v = v4[q];
        STb[(p4 + 0) * 136 + n] = f2bf(v.x); STb[(p4 + 1) * 136 + n] = f2bf(v.y); STb[(p4 + 2) * 136 + n] = f2bf(v.z); STb[(p4 + 3) * 136 + n] = f2bf(v.w);
      }
    }
  }
  if (MODE == 2 && tid < 64) {
    float dt = 0.f;
    if (tid < L) { const float x = ((const float*)(p.ws + OFF_DTBUF))[(size_t)(row0 + tid) * 16 + h] + p.dt_bias[h]; dt = x > 20.f ? x : log1pf(__expf(x)); }
    dtv[tid] = dt; av[tid] = -expf(p.a_log[h]) * dt;
  }
  __syncthreads();
  if (MODE == 1) {
    const int kn = tid & 127, half = tid >> 7;
    float s_ = 0.f;
    for (int s = half * 32; s < half * 32 + 32; ++s) s_ += bf2f(Kb[s * 136 + kn]);
    tot[half * 128 + kn] = s_;
    __syncthreads();
    float cum = half == 1 ? tot[kn] : 0.f;
    for (int s = half * 32; s < half * 32 + 32; ++s) {
      const float lf = bf2f(Kb[s * 136 + kn]);
      cum += lf;
      Q[s * 136 + kn] = f2bf(bf2f(Q[s * 136 + kn]) * __expf(cum));
      Kb[s * 136 + kn] = f2bf((1.f - __expf(lf)) * __expf(-cum));
    }
    __syncthreads();
  }
  if (MODE == 2) {
    if (tid < 64) { float cs = 0.f; for (int r = 0; r <= tid; ++r) cs += av[r]; cumv[tid] = cs; }
    __syncthreads();
  }
  f32x4 ai[1][NTP], asc[1][4];
#pragma unroll
  for (int j = 0; j < NTP; ++j) ai[0][j] = (f32x4){0.f, 0.f, 0.f, 0.f};
#pragma unroll
  for (int j = 0; j < 4; ++j) asc[0][j] = (f32x4){0.f, 0.f, 0.f, 0.f};
  wmma_sw<1, NTP>(ai, Q + wave * 16 * 136, 136, STb, 136, 128, lane);
  wmma_sw<1, 4>(asc, Q + wave * 16 * 136, 136, Kb, 136, 128, lane);
  const int t = wave * 16 + (lane & 15), sq4 = (lane >> 4) * 4;
  float ct = 0.f;
  if (MODE == 2) ct = cumv[t];
#pragma unroll
  for (int nt = 0; nt < 4; ++nt)
#pragma unroll
    for (int j = 0; j < 4; ++j) {
      const int s = nt * 16 + sq4 + j;
      float v = asc[0][nt][j];
      if (s > t) v = 0.f;
      else if (MODE == 0) v *= exp2f((float)(t - s) * l2g);
      else if (MODE == 2) v *= __expf(ct - cumv[s]) * dtv[s];
      asc[0][nt][j] = v;
    }
  __syncthreads();
  bf16_t* Pb = STb; bf16_t* VT = Kb;
#pragma unroll
  for (int nt = 0; nt < 4; ++nt) store4bf(Pb + t * 80 + nt * 16 + sq4, asc[0][nt][0], asc[0][nt][1], asc[0][nt][2], asc[0][nt][3]);
#pragma unroll
  for (int i = 0; i < NVC; ++i) {
    const int id = tid + i * 256, s = id / VCR, c8 = id % VCR; const uint4 v = vr[i];
    bf16_t* d = VT + (c8 * 8) * 80 + s;
    d[0] = (bf16_t)(v.x & 0xffff); d[80] = (bf16_t)(v.x >> 16); d[160] = (bf16_t)(v.y & 0xffff); d[240] = (bf16_t)(v.y >> 16);
    d[320] = (bf16_t)(v.z & 0xffff); d[400] = (bf16_t)(v.z >> 16); d[480] = (bf16_t)(v.w & 0xffff); d[560] = (bf16_t)(v.w >> 16);
  }
  __syncthreads();
  f32x4 ao[1][NTP];
#pragma unroll
  for (int j = 0; j < NTP; ++j) ao[0][j] = (f32x4){0.f, 0.f, 0.f, 0.f};
  wmma_sw<1, NTP>(ao, Pb + wave * 16 * 80, 80, VT, 80, 64, lane);
  float fi = 1.f;
  if (MODE == 0) fi = exp2f((float)(t + 1) * l2g);
  if (MODE == 2) fi = __expf(ct);
  const int row = row0 + t;
  const bool valid = t < L;
  if (MODE == 0 || MODE == 1) {
    float s1 = 0.f, s2 = 0.f;
#pragma unroll
    for (int nt = 0; nt < NTP; ++nt)
#pragma unroll
      for (int j = 0; j < 4; ++j) { const float o = ao[0][nt][j] + fi * ai[0][nt][j]; ao[0][nt][j] = o; s1 += o; s2 += o * o; }
    s1 += shx(s1, 16); s1 += shx(s1, 32); s2 += shx(s2, 16); s2 += shx(s2, 32);
    float mu = 0.f, rs;
    if (MODE == 0) { mu = s1 * (1.f / 128.f); const float var = fmaxf(s2 * (1.f / 128.f) - mu * mu, 0.f); rs = rsqrtf(var + EPSV); }
    else rs = rsqrtf(s2 * (1.f / 128.f) + EPSV);
    if (valid) {
      const float* nw = (MODE == 0 ? p.ret_norm_w : p.hgrn_norm_w) + h * 128;
      const int gcol = (MODE == 0 ? 1536 : 3584) + h * 128;
      bf16_t* mix = (bf16_t*)(p.ws + OFF_H) + (size_t)row * 1024 + (MODE == 0 ? 0 : 512) + h * 128;
      float4 ww4[NTP]; uint2 gg2[NTP];
#pragma unroll
      for (int nt = 0; nt < NTP; ++nt) { const int pp = nt * 16 + sq4; ww4[nt] = *(const float4*)(nw + pp); gg2[nt] = *(const uint2*)(src + (size_t)row * ld + gcol + pp); }
#pragma unroll
      for (int nt = 0; nt < NTP; ++nt) {
        const int pp = nt * 16 + sq4;
        const float4 w4 = ww4[nt];
        const uint2 g2 = gg2[nt];
        store4bf(mix + pp, (ao[0][nt][0] - mu) * rs * w4.x * siluf(lo2f(g2.x)), (ao[0][nt][1] - mu) * rs * w4.y * siluf(hi2f(g2.x)),
                 (ao[0][nt][2] - mu) * rs * w4.z * siluf(lo2f(g2.y)), (ao[0][nt][3] - mu) * rs * w4.w * siluf(hi2f(g2.y)));
      }
    }
  } else {
    const float Dh = p.d_ssm[h];
    bf16_t* zy = (bf16_t*)(p.ws + OFF_A) + (size_t)row * 3200 + h * 64;
    float s2 = 0.f;
    if (valid) {
      uint2 xx2[NTP], zz2[NTP];
#pragma unroll
      for (int nt = 0; nt < NTP; ++nt) { const int pp = nt * 16 + sq4; xx2[nt] = *(const uint2*)(src + (size_t)row * ld + vcol + pp); zz2[nt] = *(const uint2*)(zy + pp); }
#pragma unroll
      for (int nt = 0; nt < NTP; ++nt) {
        const int pp = nt * 16 + sq4;
        const uint2 x2 = xx2[nt];
        const uint2 z2 = zz2[nt];
        const float y0 = (ao[0][nt][0] + fi * ai[0][nt][0] + Dh * lo2f(x2.x)) * siluf(lo2f(z2.x));
        const float y1 = (ao[0][nt][1] + fi * ai[0][nt][1] + Dh * hi2f(x2.x)) * siluf(hi2f(z2.x));
        const float y2 = (ao[0][nt][2] + fi * ai[0][nt][2] + Dh * lo2f(x2.y)) * siluf(lo2f(z2.y));
        const float y3 = (ao[0][nt][3] + fi * ai[0][nt][3] + Dh * hi2f(x2.y)) * siluf(hi2f(z2.y));
        s2 += y0 * y0 + y1 * y1 + y2 * y2 + y3 * y3;
        store4bf(zy + pp, y0, y1, y2, y3);
      }
    }
    s2 += shx(s2, 16); s2 += shx(s2, 32);
    if (valid && lane < 16) atomicAdd((float*)(p.ws + OFF_SSDST) + (size_t)row * 2 + (h >> 3), s2);
  }
  __syncthreads();
}

template <int OUT>
__device__ __forceinline__ void s5_unit(const Params& p, int c, int gq, char* smem, int wvs) {
  float* Uf = (float*)smem;
  bf16_t* HSall = (bf16_t*)(smem + 16384);
  bf16_t* CMall = (bf16_t*)(smem + 16384 + 34816);
  int tid_ = TIDX(wvs) & 255; asm volatile("" : "+v"(tid_)); const int tid = tid_, lane = tid & 63, wave = tid >> 6;
  int row0, L; chunk_geom(c, row0, L);
  const bf16_t* proj = (const bf16_t*)(p.ws + OFF_A);
#pragma unroll
  for (int i = 0; i < 2; ++i) {
    const int id = tid + i * 256, s = id >> 3, c8 = id & 7;
    uint4 v = make_uint4(0, 0, 0, 0);
    if (s < L) v = *(const uint4*)(proj + (size_t)(row0 + s) * 3200 + 2576 + gq * 64 + c8 * 8);
    float* d = Uf + s * 64 + c8 * 8;
    d[0] = lo2f(v.x); d[1] = hi2f(v.x); d[2] = lo2f(v.y); d[3] = hi2f(v.y); d[4] = lo2f(v.z); d[5] = hi2f(v.z); d[6] = lo2f(v.w); d[7] = hi2f(v.w);
  }
  const int g = gq * 4 + wave, gp = g * 64 + lane;
  const float* tab = (const float*)(p.ws + OFF_S5TAB);
  const float lr = tab[gp], li = tab[2048 + gp];
  f32x2 bb2[16];
#pragma unroll
  for (int q = 0; q < 4; ++q) {
    const float4 a = *(const float4*)(tab + 4096 + gp * 16 + q * 4), b = *(const float4*)(tab + 4096 + 32768 + gp * 16 + q * 4);
    bb2[q * 4] = (f32x2){a.x, b.x}; bb2[q * 4 + 1] = (f32x2){a.y, b.y}; bb2[q * 4 + 2] = (f32x2){a.z, b.z}; bb2[q * 4 + 3] = (f32x2){a.w, b.w};
  }
  float hr = 0.f, hi = 0.f;
  bf16_t* HS = HSall + wave * 32 * 136; bf16_t* CM = CMall + wave * 16 * 136;
  if (OUT) {
    const float2 h0 = *(const float2*)((const float*)(p.ws + OFF_S5H) + ((size_t)c * 2048 + gp) * 2);
    hr = h0.x; hi = h0.y;
#pragma unroll
    for (int ch = 0; ch < 16; ++ch) { CM[ch * 136 + lane] = f2bf(p.s5_c_re[(g * 16 + ch) * 64 + lane]); CM[ch * 136 + 64 + lane] = f2bf(-p.s5_c_im[(g * 16 + ch) * 64 + lane]); }
  }
  __syncthreads();
  const int nhalf = OUT ? ((L + 31) >> 5) : 1, tl = OUT ? 32 : L;
  for (int hf = 0; hf < nhalf; ++hf) {
#pragma unroll 4
    for (int tt = 0; tt < tl; ++tt) {
      const int t = hf * 32 + tt;
      {
        const float* up = Uf + t * 64 + wave * 16;
        f32x2 b0 = (f32x2){0.f, 0.f}, b1 = (f32x2){0.f, 0.f};
#pragma unroll
        for (int q = 0; q < 4; ++q) {
          const f32x4 u4 = *(const f32x4*)(up + q * 4);
          b0 += bb2[q * 4] * u4[0]; b1 += bb2[q * 4 + 1] * u4[1]; b0 += bb2[q * 4 + 2] * u4[2]; b1 += bb2[q * 4 + 3] * u4[3];
        }
        b0 += b1;
        const float nr = lr * hr - li * hi + b0[0], ni = lr * hi + li * hr + b0[1];
        if (t < L) { hr = nr; hi = ni; }
      }
      if (OUT) { HS[tt * 136 + lane] = f2bf(t < L ? hr : 0.f); HS[tt * 136 + 64 + lane] = f2bf(t < L ? hi : 0.f); }
    }
    if (OUT) {
      __syncthreads();
      f32x4 ay[2][1];
      ay[0][0] = (f32x4){0.f, 0.f, 0.f, 0.f}; ay[1][0] = (f32x4){0.f, 0.f, 0.f, 0.f};
      wmma_sw<2, 1>(ay, HS, 136, CM, 136, 128, lane);
      bf16_t* gbuf = (bf16_t*)(p.ws + OFF_GBUF);
#pragma unroll
      for (int mt = 0; mt < 2; ++mt) {
        const int t = hf * 32 + mt * 16 + (lane & 15), ch0 = (lane >> 4) * 4;
        if (t < L) {
          const float4 u4 = *(const float4*)(Uf + t * 64 + wave * 16 + ch0);
          const float4 d4 = *(const float4*)(p.s5_d + g * 16 + ch0);
          float y[4] = {ay[mt][0][0] + d4.x * u4.x, ay[mt][0][1] + d4.y * u4.y, ay[mt][0][2] + d4.z * u4.z, ay[mt][0][3] + d4.w * u4.w};
#pragma unroll
          for (int j = 0; j < 4; ++j) { const float x = y[j], uu = 0.7978845608028654f * (x + 0.044715f * x * x * x); y[j] = x / (1.f + __expf(-2.f * uu)); }
          store4bf(gbuf + (size_t)(row0 + t) * 512 + g * 16 + ch0, y[0], y[1], y[2], y[3]);
        }
      }
      __syncthreads();
    }
  }
  if (!OUT) { *(float2*)((float*)(p.ws + OFF_S5E) + ((size_t)c * 2048 + gp) * 2) = make_float2(hr, hi); }
  __syncthreads();
}

__device__ __forceinline__ void s5_prefix(const Params& p, int gt) {
  const int sq = gt >> 11, rem = gt & 2047;
  const float* tab = (const float*)(p.ws + OFF_S5TAB);
  const float* e = (const float*)(p.ws + OFF_S5E);
  float* hs = (float*)(p.ws + OFF_S5H);
  float hr = 0.f, hi = 0.f;
  if (sq < 8) {
    const float lr = tab[69632 + rem], li = tab[71680 + rem];
    for (int n = 0; n < 32; ++n) {
      const size_t idx = ((size_t)(sq * 32 + n) * 2048 + rem) * 2;
      *(float2*)(hs + idx) = make_float2(hr, hi);
      const float2 ev = *(const float2*)(e + idx);
      const float nr = lr * hr - li * hi + ev.x, ni = lr * hi + li * hr + ev.y; hr = nr; hi = ni;
    }
  } else {
    const float lr = tab[73728 + rem], li = tab[75776 + rem];
    hr = p.state_s5_re[(size_t)(sq - 8) * 2048 + rem]; hi = p.state_s5_im[(size_t)(sq - 8) * 2048 + rem];
    const size_t idx = ((size_t)(256 + sq - 8) * 2048 + rem) * 2;
    *(float2*)(hs + idx) = make_float2(hr, hi);
    const float2 ev = *(const float2*)(e + idx);
    const float nr = lr * hr - li * hi + ev.x, ni = lr * hi + li * hr + ev.y; hr = nr; hi = ni;
  }
  p.out[O_S5RE + (size_t)sq * 2048 + rem] = hr;
  p.out[O_S5IM + (size_t)sq * 2048 + rem] = hi;
}

__device__ __forceinline__ void conv_phase(const Params& p, int wvs) {
  const bf16_t* proj = (const bf16_t*)(p.ws + OFF_A);
  bf16_t* xc = (bf16_t*)(p.ws + OFF_H);
  int tq_ = TIDX(wvs); asm volatile("" : "+v"(tq_)); const int gt = blockIdx.x * NTHR + tq_, nt = gridDim.x * NTHR;
  for (int task = gt; task < 544 * 192; task += nt) {
    const int seg = task / 192, c = (task - seg * 192) * 8, rowb = seg * 32;
    float w[4][8], bia[8];
#pragma unroll
    for (int j = 0; j < 4; ++j) {
      const float4 w0 = *(const float4*)(p.conv_w + j * 1536 + c), w1 = *(const float4*)(p.conv_w + j * 1536 + c + 4);
      w[j][0] = w0.x; w[j][1] = w0.y; w[j][2] = w0.z; w[j][3] = w0.w; w[j][4] = w1.x; w[j][5] = w1.y; w[j][6] = w1.z; w[j][7] = w1.w;
    }
    { const float4 b0 = *(const float4*)(p.conv_b + c), b1 = *(const float4*)(p.conv_b + c + 4); bia[0] = b0.x; bia[1] = b0.y; bia[2] = b0.z; bia[3] = b0.w; bia[4] = b1.x; bia[5] = b1.y; bia[6] = b1.z; bia[7] = b1.w; }
    float x0[8], x1[8], x2[8];
    if (rowb < 16384 && (rowb & 2047) != 0) {
      const u32x4 v0 = *(const u32x4*)(proj + (size_t)(rowb - 3) * 3200 + 1024 + c), v1 = *(const u32x4*)(proj + (size_t)(rowb - 2) * 3200 + 1024 + c), v2 = *(const u32x4*)(proj + (size_t)(rowb - 1) * 3200 + 1024 + c);
#pragma unroll
      for (int e = 0; e < 4; ++e) { x0[2 * e] = lo2f(v0[e]); x0[2 * e + 1] = hi2f(v0[e]); x1[2 * e] = lo2f(v1[e]); x1[2 * e + 1] = hi2f(v1[e]); x2[2 * e] = lo2f(v2[e]); x2[2 * e + 1] = hi2f(v2[e]); }
    } else {
#pragma unroll
      for (int e = 0; e < 8; ++e) { x0[e] = 0.f; x1[e] = 0.f; x2[e] = 0.f; }
    }
    u32x4 nx[4];
#pragma unroll
    for (int q = 0; q < 4; ++q) nx[q] = *(const u32x4*)(proj + (size_t)(rowb + q) * 3200 + 1024 + c);
#pragma unroll 4
    for (int r = 0; r < 32; ++r) {
      const int row = rowb + r;
      const u32x4 cv = nx[r & 3];
      if (r + 4 < 32) nx[r & 3] = *(const u32x4*)(proj + (size_t)(row + 4) * 3200 + 1024 + c);
      int t, T, sq;
      if (row < 16384) { t = row & 2047; T = 2048; sq = row >> 11; } else { t = (row - 16384) & 7; T = 8; sq = 8 + ((row - 16384) >> 3); }
      if (t == 0) {
        if (sq >= 8) {
          const float* sc = p.state_conv + (size_t)(sq - 8) * 3 * 1536 + c;
          const float4 a0 = *(const float4*)sc, a1 = *(const float4*)(sc + 4), b0 = *(const float4*)(sc + 1536), b1 = *(const float4*)(sc + 1540), c0 = *(const float4*)(sc + 3072), c1 = *(const float4*)(sc + 3076);
          x0[0] = a0.x; x0[1] = a0.y; x0[2] = a0.z; x0[3] = a0.w; x0[4] = a1.x; x0[5] = a1.y; x0[6] = a1.z; x0[7] = a1.w;
          x1[0] = b0.x; x1[1] = b0.y; x1[2] = b0.z; x1[3] = b0.w; x1[4] = b1.x; x1[5] = b1.y; x1[6] = b1.z; x1[7] = b1.w;
          x2[0] = c0.x; x2[1] = c0.y; x2[2] = c0.z; x2[3] = c0.w; x2[4] = c1.x; x2[5] = c1.y; x2[6] = c1.z; x2[7] = c1.w;
        } else {
#pragma unroll
          for (int e = 0; e < 8; ++e) { x0[e] = 0.f; x1[e] = 0.f; x2[e] = 0.f; }
        }
      }
      float cur[8], o[8];
#pragma unroll
      for (int e = 0; e < 4; ++e) { cur[2 * e] = lo2f(cv[e]); cur[2 * e + 1] = hi2f(cv[e]); }
#pragma unroll
      for (int e = 0; e < 8; ++e) { o[e] = siluf(bia[e] + w[0][e] * x0[e] + w[1][e] * x1[e] + w[2][e] * x2[e] + w[3][e] * cur[e]); x0[e] = x1[e]; x1[e] = x2[e]; x2[e] = cur[e]; }
      u32x4 ov; ov[0] = pack2(o[0], o[1]); ov[1] = pack2(o[2], o[3]); ov[2] = pack2(o[4], o[5]); ov[3] = pack2(o[6], o[7]);
      *(u32x4*)(xc + (size_t)row * 1536 + c) = ov;
      if (t >= T - 3) {
        float* d = p.out + O_CONV + ((size_t)sq * 3 + (t - (T - 3))) * 1536 + c;
        *(float4*)d = make_float4(cur[0], cur[1], cur[2], cur[3]); *(float4*)(d + 4) = make_float4(cur[4], cur[5], cur[6], cur[7]);
      }
    }
  }
}

__device__ __forceinline__ void ssdnorm_phase(const Params& p, int wvs) {
  const bf16_t* proj = (const bf16_t*)(p.ws + OFF_A);
  bf16_t* mix = (bf16_t*)(p.ws + OFF_H);
  const float* st = (const float*)(p.ws + OFF_SSDST);
  int tq_ = TIDX(wvs); asm volatile("" : "+v"(tq_)); const int gt = blockIdx.x * NTHR + tq_, nt = gridDim.x * NTHR;
  for (int it = gt; it < ROWS * 128; it += nt) {
    const int row = it >> 7, c = (it & 127) * 8;
    const float r = rsqrtf(st[(size_t)row * 2 + (c >> 9)] * (1.f / 512.f) + EPSV);
    const uint4 v = *(const uint4*)(proj + (size_t)row * 3200 + c);
    const float4 w0 = *(const float4*)(p.ssm_norm_w + c), w1 = *(const float4*)(p.ssm_norm_w + c + 4);
    uint4 o; o.x = pack2(lo2f(v.x) * r * w0.x, hi2f(v.x) * r * w0.y); o.y = pack2(lo2f(v.y) * r * w0.z, hi2f(v.y) * r * w0.w);
    o.z = pack2(lo2f(v.z) * r * w1.x, hi2f(v.z) * r * w1.y); o.w = pack2(lo2f(v.w) * r * w1.z, hi2f(v.w) * r * w1.w);
    *(uint4*)(mix + (size_t)row * 1536 + c) = o;
  }
}


#define XB_TMO      128
#define XB_XCNT(j)  (256  + 64 * (j))
#define XB_XSUB(j)  (1280 + 64 * (j))
#define XB_XGEN(j)  (2304 + 64 * (j))
#define XB_TOP      3328
#define XB_TOPGEN   3392
#define XCD_BAR_WORDS 3456
#define XB_SPIN_CAP (1u << 18)
#define LAS __attribute__((address_space(3)))
__device__ __forceinline__ unsigned xb_ld(unsigned* p)              { return __hip_atomic_load(p, __ATOMIC_RELAXED, __HIP_MEMORY_SCOPE_AGENT); }
__device__ __forceinline__ unsigned xb_add(unsigned* p, unsigned v) { return __hip_atomic_fetch_add(p, v, __ATOMIC_RELAXED, __HIP_MEMORY_SCOPE_AGENT); }
__device__ __forceinline__ unsigned xb_xcc_id() { return (unsigned)__builtin_amdgcn_s_getreg((3 << 11) | 20) & 0xFu; }
#define XB_SPIN(cond, bar) do { unsigned _sp = 0; while (cond) { __builtin_amdgcn_s_sleep(1); \
    if ((++_sp & 255u) == 0u) { if (xb_ld(&(bar)[XB_TMO])) break; if (_sp > XB_SPIN_CAP) { atomicAdd(&(bar)[XB_TMO], 1u); break; } } } } while (0)
struct XcdBarrier { unsigned* bar; unsigned x; volatile LAS unsigned* st; };
__device__ __forceinline__ XcdBarrier xcd_barrier_post(unsigned* bar, volatile LAS unsigned* st, int wvs) {
    XcdBarrier b; b.bar = bar; b.x = xb_xcc_id(); b.st = st;
    if (TIDX(wvs) == 0) (void)xb_add(&bar[XB_XCNT(b.x)], 1u);
    return b;
}
__device__ __forceinline__ void xcd_barrier_complete(unsigned* bar, unsigned x, unsigned& nloc, unsigned& nx) {
    const unsigned G = gridDim.x * gridDim.y * gridDim.z;
    unsigned sum, cnt, mine, sp = 0u;
    for (;;) {
        sum = 0u; cnt = 0u; mine = 0u;
#pragma unroll
        for (unsigned j = 0; j < 16; ++j) { const unsigned c = xb_ld(&bar[XB_XCNT(j)]); sum += c; cnt += (c > 0u) ? 1u : 0u; mine = (j == x) ? c : mine; }
        if (sum == G) break;
        __builtin_amdgcn_s_sleep(1);
        if ((++sp & 255u) == 0u) { if (xb_ld(&bar[XB_TMO])) break; if (sp > XB_SPIN_CAP) { atomicAdd(&bar[XB_TMO], 1u); break; } }
    }
    nloc = mine > 0u ? mine : 1u; nx = cnt > 0u ? cnt : 1u;
}
__device__ __forceinline__ void xcd_barrier(const XcdBarrier& b, int wvs) {
    asm volatile("s_waitcnt vmcnt(0)" ::: "memory");
    __syncthreads();
    if (TIDX(wvs) == 0) {
        unsigned* bar = b.bar;
        __builtin_amdgcn_s_waitcnt(0);
        unsigned nloc = b.st[0], nx = b.st[1];
        if (nloc == 0u) { xcd_barrier_complete(bar, b.x, nloc, nx); b.st[0] = nloc; b.st[1] = nx; }
        const unsigned old = xb_add(&bar[XB_XSUB(b.x)], 1u);
        const unsigned gen = old / nloc;
        if (old + 1u == (gen + 1u) * nloc) {
            __builtin_amdgcn_fence(__ATOMIC_RELEASE, "agent");
            asm volatile("s_waitcnt vmcnt(0)" ::: "memory");
            const unsigned og = xb_add(&bar[XB_TOP], 1u);
            const unsigned tg = og / nx;
            if (og + 1u == (tg + 1u) * nx) xb_add(&bar[XB_TOPGEN], 1u);
            else XB_SPIN(xb_ld(&bar[XB_TOPGEN]) == tg, bar);
            __builtin_amdgcn_fence(__ATOMIC_ACQUIRE, "agent");
            xb_add(&bar[XB_XGEN(b.x)], 1u);
            asm volatile("s_waitcnt vmcnt(0)" ::: "memory");
        } else {
            XB_SPIN(xb_ld(&bar[XB_XGEN(b.x)]) == gen, bar);
            __builtin_amdgcn_fence(__ATOMIC_ACQUIRE, "agent");
            asm volatile("s_waitcnt vmcnt(0)" ::: "memory");
        }
    }
    __syncthreads();
}


__device__ __forceinline__ Params ldp() {
  auto kp = __builtin_amdgcn_kernarg_segment_ptr();
  asm volatile("" : "+s"(kp));
  Params q;
  __builtin_memcpy(&q, (const void*)kp, sizeof(Params));
  return q;
}

__global__ void __launch_bounds__(NTHR, 2) fwd_megakernel(Params p_) {
  extern __shared__ __attribute__((aligned(16))) char smem[];
  cg::grid_group grid = cg::this_grid();
  if (p_.ws == nullptr) grid.sync();
  volatile LAS unsigned* xst = (volatile LAS unsigned*)(smem + 2 * HALF_LDS);
  const int wvs = __builtin_amdgcn_readfirstlane(threadIdx.x >> 6);
  if (TIDX(wvs) == 0) { xst[0] = 0u; xst[1] = 0u; xst[2] = 0u; xst[3] = 0u; }
  __syncthreads();
  const XcdBarrier xb = xcd_barrier_post((unsigned*)(p_.ws + OFF_BAR), xst, wvs);
  const int half = wvs >> 2;
  const int G = gridDim.x * 2, bid = blockIdx.x * 2 + half;
  char* hs = smem + half * HALF_LDS;
#define PH_BEGIN const Params p = ldp(); bf16_t* bufA = (bf16_t*)(p.ws + OFF_A); bf16_t* bufH = (bf16_t*)(p.ws + OFF_H); bf16_t* t0 = (bf16_t*)(p.ws + OFF_ST); \
    float* rowss = (float*)(p.ws + OFF_ROWSS); float* hbuf = p.out; (void)bufA; (void)bufH; (void)t0; (void)rowss; (void)hbuf;

  {
  PH_BEGIN
  prep_tables(p, wvs);
  wconv(p.w_in_even, 1024, 4096, 4096, (bf16_t*)(p.ws + W_IN), hs, wvs);
  wconv(p.w_out_even, 1024, 1024, 1024, (bf16_t*)(p.ws + W_OUT0), hs, wvs);
  wconv(p.w_ffn_up, 1024, 4096, 4096, (bf16_t*)(p.ws + W_UP), hs, wvs);
  wconv(p.w_ffn_down, 4096, 1024, 1024, (bf16_t*)(p.ws + W_DOWN), hs, wvs);
  rowpass_phase(nullptr, nullptr, nullptr, p.x_prompt, p.x_sample, nullptr, p.norm_mix_pre, bufH, wvs);
  }
  xcd_barrier(xb, wvs);
  {
  PH_BEGIN
  { EpiInEven e{bufA, (const float*)(p.ws + OFF_ROPE), (const float*)(p.ws + OFF_LB)};
    for (int rep_ = 0; rep_ < REPG; ++rep_) { gemm_phase(bufH, 1024, (const bf16_t*)(p.ws + W_IN), 1024, 64, 16, 1024, e, smem, wvs); gemm_tail(bufH, 1024, (const bf16_t*)(p.ws + W_IN), 1024, 32, 1024, e, smem, wvs, 64 * 16); } }
  }
  xcd_barrier(xb, wvs);
  {
  PH_BEGIN
  for (int rep_ = 0; rep_ < REPS; ++rep_) {
    if (bid < 256) {
      const int v = bid;
      const int ps = v & 3, m = (v >> 2) & 1, h = (v >> 3) & 3, sq = v >> 5;
      if (m == 0) state_unit<0>(p, sq, h, ps, hs, wvs); else state_unit<1>(p, sq, h, ps, hs, wvs);
    }
    const int nsh = bid < 256 ? 0 : 16, j0 = bid - 256;
    for (int i = 0; i < nsh; ++i) {
      const int v = j0 + 256 * i;
      const int ps = v & 3, m = (v >> 2) & 1, h = (v >> 3) & 3, sq = 8 + (v >> 5);
      if (m == 0) state_unit<0>(p, sq, h, ps, hs, wvs); else state_unit<1>(p, sq, h, ps, hs, wvs);
    }
  }
  }
  xcd_barrier(xb, wvs);
  {
  PH_BEGIN
  for (int rep_ = 0; rep_ < REPO; ++rep_)
  for (int u = bid; u < 384 * 8; u += G) {
    const int h = u & 3, m = (u >> 2) & 1, c = u >> 3;
    if (m == 0) out_unit<0>(p, c, h, hs, wvs); else out_unit<1>(p, c, h, hs, wvs);
  }
  }
  xcd_barrier(xb, wvs);
  {
  PH_BEGIN
  { EpiOut e{t0, rowss};
    for (int rep_ = 0; rep_ < REPG; ++rep_) { gemm_phase(bufH, 1024, (const bf16_t*)(p.ws + W_OUT0), 1024, 64, 4, 1024, e, smem, wvs); gemm_tail(bufH, 1024, (const bf16_t*)(p.ws + W_OUT0), 1024, 8, 1024, e, smem, wvs, 64 * 4); } }
  }
  xcd_barrier(xb, wvs);
  {
  PH_BEGIN
  for (int rep_ = 0; rep_ < REPR; ++rep_)
  rowpass_phase(t0, rowss, p.norm_mix_post, p.x_prompt, p.x_sample, hbuf, p.norm_ffn_pre, bufH, wvs);
  }
  xcd_barrier(xb, wvs);
  {
  PH_BEGIN
  { EpiUp e{bufA}; for (int rep_ = 0; rep_ < REPG; ++rep_) { gemm_phase(bufH, 1024, (const bf16_t*)(p.ws + W_UP), 1024, 64, 16, 1024, e, smem, wvs); gemm_tail(bufH, 1024, (const bf16_t*)(p.ws + W_UP), 1024, 32, 1024, e, smem, wvs, 64 * 16); } }
  }
  xcd_barrier(xb, wvs);
  {
  PH_BEGIN
  { EpiOut e{t0, rowss + ROWS}; for (int rep_ = 0; rep_ < REPG; ++rep_) { gemm_phase(bufA, 4096, (const bf16_t*)(p.ws + W_DOWN), 4096, 64, 4, 4096, e, smem, wvs); gemm_tail(bufA, 4096, (const bf16_t*)(p.ws + W_DOWN), 4096, 8, 4096, e, smem, wvs, 64 * 4); } }
  }
  xcd_barrier(xb, wvs);
  {
  PH_BEGIN
  rowpass_phase(t0, rowss + ROWS, p.norm_ffn_post, hbuf, hbuf + (size_t)16384 * 1024, hbuf, p.norm_mix_pre + 1024, bufH, wvs);
  wconv(p.w_in_odd, 1024, 3088, 3328, (bf16_t*)(p.ws + W_IN), hs, wvs);
  wconv(p.w_glu, 512, 512, 512, (bf16_t*)(p.ws + W_GLU), hs, wvs);
  wconv(p.w_out_odd, 1536, 1024, 1024, (bf16_t*)(p.ws + W_OUT1), hs, wvs);
  wconv(p.w_ffn_up + (size_t)1024 * 4096, 1024, 4096, 4096, (bf16_t*)(p.ws + W_UP), hs, wvs);
  wconv(p.w_ffn_down + (size_t)4096 * 1024, 4096, 1024, 1024, (bf16_t*)(p.ws + W_DOWN), hs, wvs);
  }
  xcd_barrier(xb, wvs);
  {
  PH_BEGIN
  { EpiInOdd e{bufA, (float*)(p.ws + OFF_DTBUF)};
    for (int rep_ = 0; rep_ < REPG; ++rep_) { gemm_phase(bufH, 1024, (const bf16_t*)(p.ws + W_IN), 1024, 64, 13, 1024, e, smem, wvs); gemm_tail(bufH, 1024, (const bf16_t*)(p.ws + W_IN), 1024, 26, 1024, e, smem, wvs, 64 * 13); } }
  }
  xcd_barrier(xb, wvs);
  {
  PH_BEGIN
  for (int rep_ = 0; rep_ < REPC; ++rep_) {
  conv_phase(p, wvs);
  for (int u = bid; u < 384 * 8; u += G) s5_unit<0>(p, u >> 3, u & 7, hs, wvs);
  }
  }
  xcd_barrier(xb, wvs);
  {
  PH_BEGIN
  for (int rep_ = 0; rep_ < REPS; ++rep_) {
    if (bid < 256) state_unit<2>(p, bid >> 5, (bid >> 1) & 15, bid & 1, hs, wvs);
    for (int j = bid - 256; j < 5184; j += 256) {
      if (bid < 256) break;
      if (j < 1088) { int tq_ = TIDX(wvs) & 255; asm volatile("" : "+v"(tq_)); s5_prefix(p, j * 256 + tq_); }
      else { const int v = j - 1088; state_unit<2>(p, 8 + (v >> 5), (v >> 1) & 15, v & 1, hs, wvs); }
    }
  }
  }
  xcd_barrier(xb, wvs);
  {
  PH_BEGIN
  for (int u = bid; u < 384 * 16 + 384 * 8; u += G) {
    if (u < 384 * 16) out_unit<2>(p, u >> 4, u & 15, hs, wvs);
    else { const int v = u - 384 * 16; s5_unit<1>(p, v >> 3, v & 7, hs, wvs); }
  }
  }
  xcd_barrier(xb, wvs);
  {
  PH_BEGIN
  ssdnorm_phase(p, wvs);
  { EpiGlu e{(const bf16_t*)(p.ws + OFF_GBUF), p.b_glu, bufH};
    for (int rep_ = 0; rep_ < REPG; ++rep_) { gemm_phase((const bf16_t*)(p.ws + OFF_GBUF), 512, (const bf16_t*)(p.ws + W_GLU), 512, 64, 2, 512, e, smem, wvs); gemm_tail((const bf16_t*)(p.ws + OFF_GBUF), 512, (const bf16_t*)(p.ws + W_GLU), 512, 4, 512, e, smem, wvs, 64 * 2); } }
  }
  xcd_barrier(xb, wvs);
  {
  PH_BEGIN
  { EpiOut e{t0, rowss + 2 * ROWS}; for (int rep_ = 0; rep_ < REPG; ++rep_) { gemm_phase(bufH, 1536, (const bf16_t*)(p.ws + W_OUT1), 1536, 64, 4, 1536, e, smem, wvs); gemm_tail(bufH, 1536, (const bf16_t*)(p.ws + W_OUT1), 1536, 8, 1536, e, smem, wvs, 64 * 4); } }
  }
  xcd_barrier(xb, wvs);
  {
  PH_BEGIN
  rowpass_phase(t0, rowss + 2 * ROWS, p.norm_mix_post + 1024, hbuf, hbuf + (size_t)16384 * 1024, hbuf, p.norm_ffn_pre + 1024, bufH, wvs);
  }
  xcd_barrier(xb, wvs);
  {
  PH_BEGIN
  { EpiUp e{bufA}; for (int rep_ = 0; rep_ < REPG; ++rep_) { gemm_phase(bufH, 1024, (const bf16_t*)(p.ws + W_UP), 1024, 64, 16, 1024, e, smem, wvs); gemm_tail(bufH, 1024, (const bf16_t*)(p.ws + W_UP), 1024, 32, 1024, e, smem, wvs, 64 * 16); } }
  }
  xcd_barrier(xb, wvs);
  {
  PH_BEGIN
  { EpiOut e{t0, rowss + 3 * ROWS}; for (int rep_ = 0; rep_ < REPG; ++rep_) { gemm_phase(bufA, 4096, (const bf16_t*)(p.ws + W_DOWN), 4096, 64, 4, 4096, e, smem, wvs); gemm_tail(bufA, 4096, (const bf16_t*)(p.ws + W_DOWN), 4096, 8, 4096, e, smem, wvs, 64 * 4); } }
  }
  xcd_barrier(xb, wvs);
  {
  PH_BEGIN
  rowpass_phase(t0, rowss + 3 * ROWS, p.norm_ffn_post + 1024, hbuf, hbuf + (size_t)16384 * 1024, hbuf, nullptr, nullptr, wvs);
  }
}

extern "C" void kernel_launch(void* const* d_in, const int* in_sizes, int n_in, void* d_out, int out_size, void* d_ws, size_t ws_size, hipStream_t stream) {
  constexpr size_t kDynLds = 2 * HALF_LDS + 64;
  static int grid_blocks = 0;
  if (!grid_blocks) {
    int dev = 0, cus = 0, per_cu = 0;
    (void)hipGetDevice(&dev);
    (void)hipDeviceGetAttribute(&cus, hipDeviceAttributeMultiprocessorCount, dev);
    (void)hipFuncSetAttribute((const void*)fwd_megakernel, hipFuncAttributeMaxDynamicSharedMemorySize, (int)kDynLds);
    (void)hipOccupancyMaxActiveBlocksPerMultiprocessor(&per_cu, fwd_megakernel, NTHR, kDynLds);
    if (per_cu > 1) per_cu = 1;
    if (per_cu < 1) per_cu = 1;
    grid_blocks = cus * per_cu;
  }
  Params p{};
  const float** pf = (const float**)&p;
  for (int i = 0; i < 37; ++i) pf[i] = (const float*)d_in[i];
  p.out = (float*)d_out;
  p.ws = (char*)d_ws;
  (void)hipMemsetAsync((char*)d_ws + OFF_BAR, 0, 16384, stream);
  void* args[] = {&p};
  hipError_t e = hipLaunchCooperativeKernel((void*)fwd_megakernel, dim3(grid_blocks), dim3(NTHR), args, kDynLds, stream);
  if (e != hipSuccess) fprintf(stderr, "cooperative launch failed: %s (grid %d)\n", hipGetErrorString(e), grid_blocks);
}
```

```cpp
#include <hip/hip_runtime.h>
#include <hip/hip_cooperative_groups.h>
#include <cstdio>
namespace cg = cooperative_groups;

typedef unsigned short bf16_t;
typedef short bf16x8 __attribute__((ext_vector_type(8)));
typedef float f32x4 __attribute__((ext_vector_type(4)));
typedef unsigned u32x4 __attribute__((ext_vector_type(4)));
typedef float f32x2 __attribute__((ext_vector_type(2)));

#define NTHR 512
#ifndef REPS
#define REPS 1
#endif
#ifndef REPO
#define REPO 1
#endif
#ifndef REPC
#define REPC 1
#endif
#ifndef REPR
#define REPR 1
#endif
#ifndef REPG
#define REPG 1
#endif
#define HALF_LDS 74752
#ifndef REP0
#define REP0 1
#endif
#ifndef REPS
#define REPS 1
#endif
#ifndef REPO
#define REPO 1
#endif
#ifndef REPC
#define REPC 1
#endif
#ifndef REPY
#define REPY 21
#endif
#define ROWS 17408
#define EPSV 1e-6f
#define TIDX(w) ((w) * 64 + (int)__builtin_amdgcn_mbcnt_hi(~0u, __builtin_amdgcn_mbcnt_lo(~0u, 0u)))

constexpr size_t W_IN = 0;
constexpr size_t W_OUT0 = 8388608;
constexpr size_t W_GLU = 6815744;
constexpr size_t W_OUT1 = 7340032;
constexpr size_t W_UP = 10485760;
constexpr size_t W_DOWN = 18874368;
constexpr size_t OFF_A = 29360128;
constexpr size_t OFF_GBUF = OFF_A + 111411200;
constexpr size_t OFF_ST = OFF_A + 142606336;
constexpr size_t OFF_H = OFF_ST + 67108864;
constexpr size_t OFF_SM = OFF_H + 53477376;
constexpr size_t OFF_ROPE = OFF_SM;
constexpr size_t OFF_ROWSS = OFF_SM + 1052672;
constexpr size_t OFF_SSDST = OFF_SM + 1331200;
constexpr size_t OFF_DTBUF = OFF_SM + 1470464;
constexpr size_t OFF_LB = OFF_SM + 2584576;
constexpr size_t OFF_S5TAB = OFF_SM + 2586624;
constexpr size_t OFF_S5E = OFF_SM + 2897920;
constexpr size_t OFF_S5H = OFF_SM + 9189376;
constexpr size_t OFF_BAR = OFF_SM + 15480832;

constexpr size_t O_RET = 17825792, O_HG = 26738688, O_SSM = 35651584, O_CONV = 53477376, O_S5RE = 54104064, O_S5IM = 54382592;

struct Params {
  const float *x_prompt, *x_sample, *state_ret, *state_hgrn, *state_ssm, *state_conv, *state_s5_re, *state_s5_im;
  const float *norm_mix_pre, *norm_mix_post, *norm_ffn_pre, *norm_ffn_post;
  const float *w_in_even, *w_out_even, *ret_norm_w, *hgrn_lb, *hgrn_norm_w, *w_in_odd, *conv_w, *conv_b, *dt_bias, *a_log, *d_ssm, *ssm_norm_w;
  const float *s5_lam_re, *s5_lam_im, *s5_log_step, *s5_b_re, *s5_b_im, *s5_c_re, *s5_c_im, *s5_d, *w_glu, *b_glu, *w_out_odd, *w_ffn_up, *w_ffn_down;
  float* out;
  char* ws;
};

__device__ __forceinline__ bf16_t f2bf(float f) { unsigned r; asm("v_cvt_pk_bf16_f32 %0, %1, %1" : "=v"(r) : "v"(f)); return (bf16_t)(r & 0xffffu); }
__device__ __forceinline__ float bf2f(bf16_t h) { return __uint_as_float(((unsigned)h) << 16); }
__device__ __forceinline__ unsigned pack2(float a, float b) { unsigned r; asm("v_cvt_pk_bf16_f32 %0, %1, %2" : "=v"(r) : "v"(a), "v"(b)); return r; }
__device__ __forceinline__ float lo2f(unsigned u) { return __uint_as_float(u << 16); }
__device__ __forceinline__ float hi2f(unsigned u) { return __uint_as_float(u & 0xffff0000u); }
__device__ __forceinline__ float sigm(float x) { return 1.f / (1.f + __expf(-x)); }
__device__ __forceinline__ float siluf(float x) { return x / (1.f + __expf(-x)); }
__device__ __forceinline__ void store4bf(bf16_t* p, float a, float b, float c, float d) { uint2 v; v.x = pack2(a, b); v.y = pack2(c, d); *(uint2*)p = v; }

__device__ __forceinline__ float shx(float v, int mask) {
  int l = (int)__builtin_amdgcn_mbcnt_hi(~0u, __builtin_amdgcn_mbcnt_lo(~0u, 0u));
  asm volatile("" : "+v"(l));
  return __int_as_float(__builtin_amdgcn_ds_bpermute((l ^ mask) << 2, __float_as_int(v)));
}

__device__ __forceinline__ float wave_suffix_incl(float v) {
  int l = (int)__builtin_amdgcn_mbcnt_hi(~0u, __builtin_amdgcn_mbcnt_lo(~0u, 0u));
  asm volatile("" : "+v"(l));
#pragma unroll
  for (int o = 1; o < 64; o <<= 1) { const float t = __int_as_float(__builtin_amdgcn_ds_bpermute(((l + o) & 63) << 2, __float_as_int(v))); if (l + o < 64) v += t; }
  return v;
}
__device__ __forceinline__ float wave_prefix_incl(float v) {
  int l = (int)__builtin_amdgcn_mbcnt_hi(~0u, __builtin_amdgcn_mbcnt_lo(~0u, 0u));
  asm volatile("" : "+v"(l));
#pragma unroll
  for (int o = 1; o < 64; o <<= 1) { const float t = __int_as_float(__builtin_amdgcn_ds_bpermute(((l - o) & 63) << 2, __float_as_int(v))); if (l >= o) v += t; }
  return v;
}

template <int MT, int NT>
__device__ __forceinline__ void wmma_sw(f32x4 (&acc)[MT][NT], const bf16_t* A, int lda, const bf16_t* B, int ldb, int K, int lane) {
  const int r = lane & 15, kq = (lane >> 4) * 8;
  for (int k0 = 0; k0 < K; k0 += 32) {
    bf16x8 af[MT], bfr[NT];
#pragma unroll
    for (int mt = 0; mt < MT; ++mt) af[mt] = *(const bf16x8*)(A + (mt * 16 + r) * lda + k0 + kq);
#pragma unroll
    for (int nt = 0; nt < NT; ++nt) bfr[nt] = *(const bf16x8*)(B + (nt * 16 + r) * ldb + k0 + kq);
#pragma unroll
    for (int mt = 0; mt < MT; ++mt)
#pragma unroll
      for (int nt = 0; nt < NT; ++nt) acc[mt][nt] = __builtin_amdgcn_mfma_f32_16x16x32_bf16(bfr[nt], af[mt], acc[mt][nt], 0, 0, 0);
  }
}
template <int MT, int NT>
__device__ __forceinline__ void wmma_ns(f32x4 (&acc)[MT][NT], const bf16_t* A, int lda, const bf16_t* B, int ldb, int K, int lane) {
  const int r = lane & 15, kq = (lane >> 4) * 8;
  for (int k0 = 0; k0 < K; k0 += 32) {
    bf16x8 af[MT], bfr[NT];
#pragma unroll
    for (int mt = 0; mt < MT; ++mt) af[mt] = *(const bf16x8*)(A + (mt * 16 + r) * lda + k0 + kq);
#pragma unroll
    for (int nt = 0; nt < NT; ++nt) bfr[nt] = *(const bf16x8*)(B + (nt * 16 + r) * ldb + k0 + kq);
#pragma unroll
    for (int mt = 0; mt < MT; ++mt)
#pragma unroll
      for (int nt = 0; nt < NT; ++nt) acc[mt][nt] = __builtin_amdgcn_mfma_f32_16x16x32_bf16(af[mt], bfr[nt], acc[mt][nt], 0, 0, 0);
  }
}

__device__ __forceinline__ void gemm_kstep(f32x4 (&acc)[4][8], const char* A, const char* B) {
  bf16x8 af[4], bfr[8];
#pragma unroll
  for (int mt = 0; mt < 4; ++mt) af[mt] = *(const bf16x8*)(A + mt * 2048);
#pragma unroll
  for (int nt = 0; nt < 8; ++nt) bfr[nt] = *(const bf16x8*)(B + nt * 2048);
  __builtin_amdgcn_sched_barrier(0);
#pragma unroll
  for (int nt = 0; nt < 8; ++nt)
#pragma unroll
    for (int mt = 0; mt < 4; ++mt) acc[mt][nt] = __builtin_amdgcn_mfma_f32_16x16x32_bf16(bfr[nt], af[mt], acc[mt][nt], 0, 0, 0);
}

template <class Epi>
__device__ __forceinline__ void gemm_phase(const bf16_t* A, int lda, const bf16_t* Bt, int ldb, int nMt, int nNt, int K, const Epi& epi, char* smem, int wvs) {
  char* As = smem;
  char* Bs = smem + 65536;
  int tid_ = TIDX(wvs); asm volatile("" : "+v"(tid_)); const int tid = tid_, lane = tid & 63, wave = tid >> 6;
  const int wr = wave >> 1, wc = wave & 1;
  const int ntiles = nMt * nNt, nk = K >> 6;
  const int lrow = tid >> 3, lcc = (tid & 7) * 8;
  const int wofs = ((lrow >> 4) * 2 + (lcc >> 5)) * 1024 + ((((lrow & 15) * 64) + (lcc & 31) * 2) ^ ((lrow & 8) << 2));
  const int rofs = (((lane & 15) * 64) + (lane >> 4) * 16) ^ ((lane & 8) << 2);
  const unsigned toffA = (unsigned)(lrow * lda + lcc), toffB = (unsigned)(lrow * ldb + lcc);
  for (int tile = blockIdx.x; tile < ntiles; tile += gridDim.x) {
    const int pn = tile / nMt, pm = tile - pn * nMt;
    const bf16_t* Ab = A + (size_t)(pm * 256) * lda;
    const bf16_t* Bb = Bt + (size_t)(pn * 256) * ldb;
    f32x4 acc[4][8];
#pragma unroll
    for (int i = 0; i < 4; ++i)
#pragma unroll
      for (int j = 0; j < 8; ++j) acc[i][j] = (f32x4){0.f, 0.f, 0.f, 0.f};
    u32x4 rg[4];
#pragma unroll
    for (int i = 0; i < 4; ++i) rg[i] = *(const u32x4*)(Ab + (size_t)(i * 64) * lda + toffA);
#pragma unroll
    for (int i = 0; i < 4; ++i) *(u32x4*)(As + wofs + i * 8192) = rg[i];
#pragma unroll
    for (int i = 0; i < 4; ++i) rg[i] = *(const u32x4*)(Bb + (size_t)(i * 64) * ldb + toffB);
#pragma unroll
    for (int i = 0; i < 4; ++i) *(u32x4*)(Bs + wofs + i * 8192) = rg[i];
    __syncthreads();
#pragma unroll 1
    for (int kt = 0; kt < nk; ++kt) {
      const int cur = kt & 1;
      const int kn = (kt + 1 < nk ? kt + 1 : kt) * 64;
      char* Ad = As + (cur ^ 1) * 32768; char* Bd = Bs + (cur ^ 1) * 32768;
#pragma unroll
      for (int i = 0; i < 4; ++i) rg[i] = *(const u32x4*)(Ab + ((size_t)(i * 64) * lda + kn) + toffA);
      __builtin_amdgcn_sched_barrier(0);
      gemm_kstep(acc, As + cur * 32768 + wr * 8192 + rofs, Bs + cur * 32768 + wc * 16384 + rofs);
      __builtin_amdgcn_sched_barrier(0);
#pragma unroll
      for (int i = 0; i < 4; ++i) *(u32x4*)(Ad + wofs + i * 8192) = rg[i];
#pragma unroll
      for (int i = 0; i < 4; ++i) rg[i] = *(const u32x4*)(Bb + ((size_t)(i * 64) * ldb + kn) + toffB);
      __builtin_amdgcn_sched_barrier(0);
      gemm_kstep(acc, As + cur * 32768 + wr * 8192 + 1024 + rofs, Bs + cur * 32768 + wc * 16384 + 1024 + rofs);
      __builtin_amdgcn_sched_barrier(0);
#pragma unroll
      for (int i = 0; i < 4; ++i) *(u32x4*)(Bd + wofs + i * 8192) = rg[i];
      __syncthreads();
    }
    int er_ = pm * 256 + wr * 64, ec_ = pn * 256 + wc * 128, el_ = lane;
    asm volatile("" : "+v"(er_), "+v"(ec_), "+v"(el_));
    epi(acc, er_, ec_, el_);
  }
}

struct EpiInEven {
  bf16_t* proj; const float* rope; const float* lb;
  template <int MT> __device__ __forceinline__ void operator()(f32x4 (&acc)[MT][8], int rbase, int cbase, int lane) const {
    const int sec = cbase >> 9, head = (cbase >> 7) & 3, r = lane & 15, cq = (lane >> 4) * 4;
#pragma unroll
    for (int mt = 0; mt < MT; ++mt) {
      __builtin_amdgcn_sched_barrier(0);
      const int row = rbase + mt * 16 + r;
      bf16_t* dst = proj + (size_t)row * 4096 + cbase + cq;
      if (sec < 2) {
        const int pidx = row < 16384 ? (row & 2047) : 2048 + ((row - 16384) & 7);
        const float* ct = rope + pidx * 128 + cq;
        const float sc = sec == 1 ? 0.08838834764831845f : 1.f;
        float4 cc4[4], ss4[4];
#pragma unroll
        for (int nt = 0; nt < 4; ++nt) { cc4[nt] = *(const float4*)(ct + nt * 16); ss4[nt] = *(const float4*)(ct + 64 + nt * 16); }
#pragma unroll
        for (int nt = 0; nt < 4; ++nt) {
          const float4 c4 = cc4[nt], s4 = ss4[nt];
          const f32x4 x1 = acc[mt][nt], x2 = acc[mt][nt + 4];
          store4bf(dst + nt * 16, (x1[0] * c4.x - x2[0] * s4.x) * sc, (x1[1] * c4.y - x2[1] * s4.y) * sc, (x1[2] * c4.z - x2[2] * s4.z) * sc, (x1[3] * c4.w - x2[3] * s4.w) * sc);
          store4bf(dst + 64 + nt * 16, (x1[0] * s4.x + x2[0] * c4.x) * sc, (x1[1] * s4.y + x2[1] * c4.y) * sc, (x1[2] * s4.z + x2[2] * c4.z) * sc, (x1[3] * s4.w + x2[3] * c4.w) * sc);
        }
      } else if (sec == 5) {
        float4 ll4[8];
#pragma unroll
        for (int nt = 0; nt < 8; ++nt) ll4[nt] = *(const float4*)(lb + head * 128 + nt * 16 + cq);
#pragma unroll
        for (int nt = 0; nt < 8; ++nt) {
          const float4 l4 = ll4[nt];
          const f32x4 x = acc[mt][nt];
          store4bf(dst + nt * 16, __logf(l4.x + (1.f - l4.x) * sigm(x[0])), __logf(l4.y + (1.f - l4.y) * sigm(x[1])), __logf(l4.z + (1.f - l4.z) * sigm(x[2])), __logf(l4.w + (1.f - l4.w) * sigm(x[3])));
        }
      } else {
#pragma unroll
        for (int nt = 0; nt < 8; ++nt) { const f32x4 x = acc[mt][nt]; store4bf(dst + nt * 16, x[0], x[1], x[2], x[3]); }
      }
    }
  }
};
struct EpiOut {
  bf16_t* t0; float* rowss;
  template <int MT> __device__ __forceinline__ void operator()(f32x4 (&acc)[MT][8], int rbase, int cbase, int lane) const {
    const int r = lane & 15, cq = (lane >> 4) * 4;
#pragma unroll
    for (int mt = 0; mt < MT; ++mt) {
      __builtin_amdgcn_sched_barrier(0);
      const int row = rbase + mt * 16 + r;
      bf16_t* dst = t0 + (size_t)row * 1024 + cbase + cq;
      float ss = 0.f;
#pragma unroll
      for (int nt = 0; nt < 8; ++nt) { const f32x4 x = acc[mt][nt]; ss += x[0] * x[0] + x[1] * x[1] + x[2] * x[2] + x[3] * x[3]; store4bf(dst + nt * 16, x[0], x[1], x[2], x[3]); }
      ss += shx(ss, 16); ss += shx(ss, 32);
      if (lane < 16) atomicAdd(rowss + row, ss * (1.f / REPG));
    }
  }
};
struct EpiUp {
  bf16_t* act;
  template <int MT> __device__ __forceinline__ void operator()(f32x4 (&acc)[MT][8], int rbase, int cbase, int lane) const {
    const int r = lane & 15, cq = (lane >> 4) * 4;
#pragma unroll
    for (int mt = 0; mt < MT; ++mt) {
      __builtin_amdgcn_sched_barrier(0);
      bf16_t* dst = act + (size_t)(rbase + mt * 16 + r) * 4096 + cbase + cq;
#pragma unroll
      for (int nt = 0; nt < 8; ++nt) { f32x4 x = acc[mt][nt];
#pragma unroll
        for (int j = 0; j < 4; ++j) { float v = fmaxf(x[j], 0.f); x[j] = v * v; }
        store4bf(dst + nt * 16, x[0], x[1], x[2], x[3]); }
    }
  }
};
struct EpiInOdd {
  bf16_t* proj; float* dtbuf;
  template <int MT> __device__ __forceinline__ void operator()(f32x4 (&acc)[MT][8], int rbase, int cbase, int lane) const {
    const int r = lane & 15, cq = (lane >> 4) * 4;
#pragma unroll
    for (int mt = 0; mt < MT; ++mt) {
      __builtin_amdgcn_sched_barrier(0);
      const int row = rbase + mt * 16 + r;
      bf16_t* dst = proj + (size_t)row * 3200 + cbase + cq;
#pragma unroll
      for (int nt = 0; nt < 8; ++nt) { const f32x4 x = acc[mt][nt]; if (cbase + nt * 16 < 3200) store4bf(dst + nt * 16, x[0], x[1], x[2], x[3]); }
      if (cbase == 2560) { const f32x4 x = acc[mt][0]; *(float4*)(dtbuf + (size_t)row * 16 + cq) = make_float4(x[0], x[1], x[2], x[3]); }
    }
  }
};
struct EpiGlu {
  const bf16_t* gbuf; const float* bglu; bf16_t* mix;
  template <int MT> __device__ __forceinline__ void operator()(f32x4 (&acc)[MT][8], int rbase, int cbase, int lane) const {
    const int r = lane & 15, cq = (lane >> 4) * 4;
#pragma unroll
    for (int mt = 0; mt < MT; ++mt) {
      __builtin_amdgcn_sched_barrier(0);
      const int row = rbase + mt * 16 + r;
      uint2 gg2[8]; float4 bb4[8];
#pragma unroll
      for (int nt = 0; nt < 8; ++nt) { const int col = cbase + nt * 16 + cq; gg2[nt] = *(const uint2*)(gbuf + (size_t)row * 512 + col); bb4[nt] = *(const float4*)(bglu + col); }
#pragma unroll
      for (int nt = 0; nt < 8; ++nt) {
        const int col = cbase + nt * 16 + cq;
        const f32x4 x = acc[mt][nt];
        const uint2 g2 = gg2[nt];
        const float4 b4 = bb4[nt];
        store4bf(mix + (size_t)row * 1536 + 1024 + col, lo2f(g2.x) * sigm(x[0] + b4.x), hi2f(g2.x) * sigm(x[1] + b4.y), lo2f(g2.y) * sigm(x[2] + b4.z), hi2f(g2.y) * sigm(x[3] + b4.w));
      }
    }
  }
};

template <class Epi>
__device__ __forceinline__ void gemm_tail(const bf16_t* A, int lda, const bf16_t* Bt, int ldb, int nNt128, int K, const Epi& epi, char* smem, int wvs, int nBig) {
  bf16_t* As = (bf16_t*)smem;
  bf16_t* Bs = As + 2 * 128 * 80;
  int tid_ = TIDX(wvs); asm volatile("" : "+v"(tid_)); const int tid = tid_, lane = tid & 63, wave = tid >> 6;
  const int nk = K >> 6, G = gridDim.x;
  const int lrow = tid >> 3, lcc = (tid & 7) * 8;
  const unsigned toffA = (unsigned)(lrow * lda + lcc), toffB = (unsigned)(lrow * ldb + lcc);
  const int rr = nBig % G, nLight = G - rr;
  const int nSmall = 8 * nNt128;
  if ((int)blockIdx.x >= rr) {
    for (int j = (int)blockIdx.x - rr; j < nSmall; j += nLight) {
      const int pm = j / nNt128, pn = j - pm * nNt128;
      const bf16_t* Ab = A + (size_t)(16384 + pm * 128) * lda;
      const bf16_t* Bb = Bt + (size_t)(pn * 128) * ldb;
      f32x4 acc[1][8];
#pragma unroll
      for (int q = 0; q < 8; ++q) acc[0][q] = (f32x4){0.f, 0.f, 0.f, 0.f};
      u32x4 ra[2], rb[2];
#pragma unroll
      for (int i = 0; i < 2; ++i) { ra[i] = *(const u32x4*)(Ab + (size_t)(i * 64) * lda + toffA); rb[i] = *(const u32x4*)(Bb + (size_t)(i * 64) * ldb + toffB); }
#pragma unroll
      for (int i = 0; i < 2; ++i) { *(u32x4*)(As + (lrow + i * 64) * 80 + lcc) = ra[i]; *(u32x4*)(Bs + (lrow + i * 64) * 80 + lcc) = rb[i]; }
      __syncthreads();
#pragma unroll 1
      for (int kt = 0; kt < nk; ++kt) {
        const int cur = kt & 1;
        const int kn = (kt + 1 < nk ? kt + 1 : kt) * 64;
#pragma unroll
        for (int i = 0; i < 2; ++i) { ra[i] = *(const u32x4*)(Ab + ((size_t)(i * 64) * lda + kn) + toffA); rb[i] = *(const u32x4*)(Bb + ((size_t)(i * 64) * ldb + kn) + toffB); }
        __builtin_amdgcn_sched_barrier(0);
        wmma_sw<1, 8>(acc, As + cur * 128 * 80 + wave * 16 * 80, 80, Bs + cur * 128 * 80, 80, 64, lane);
        __builtin_amdgcn_sched_barrier(0);
        bf16_t* Ad = As + (cur ^ 1) * 128 * 80; bf16_t* Bd = Bs + (cur ^ 1) * 128 * 80;
#pragma unroll
        for (int i = 0; i < 2; ++i) { *(u32x4*)(Ad + (lrow + i * 64) * 80 + lcc) = ra[i]; *(u32x4*)(Bd + (lrow + i * 64) * 80 + lcc) = rb[i]; }
        __syncthreads();
      }
      int er_ = 16384 + pm * 128 + wave * 16, ec_ = pn * 128, el_ = lane;
      asm volatile("" : "+v"(er_), "+v"(ec_), "+v"(el_));
      epi(acc, er_, ec_, el_);
    }
  }
}

__device__ __forceinline__ void rowpass_phase(const bf16_t* t0, const float* rowss, const float* wpost, const float* hin_a, const float* hin_b, float* hout, const float* wnext, bf16_t* hn, int wvs) {
  int tq_ = TIDX(wvs); asm volatile("" : "+v"(tq_)); const int lane = tq_ & 63, gw = blockIdx.x * 8 + (tq_ >> 6), nw = gridDim.x * 8;
  for (int row = gw; row < ROWS; row += nw) {
    const float* hin = row < 16384 ? hin_a + (size_t)row * 1024 : hin_b + (size_t)(row - 16384) * 1024;
    float r0 = 0.f;
    if (t0) r0 = rsqrtf(rowss[row] * (1.f / 1024.f) + EPSV);
    float4 v[4]; float ss = 0.f;
    float4 hvv[4], wpv[4], wnv[4]; uint2 tv[4];
#pragma unroll
    for (int i = 0; i < 4; ++i) {
      const int col = (i * 64 + lane) * 4;
      hvv[i] = *(const float4*)(hin + col);
      if (t0) { tv[i] = *(const uint2*)(t0 + (size_t)row * 1024 + col); wpv[i] = *(const float4*)(wpost + col); }
      if (hn) wnv[i] = *(const float4*)(wnext + col);
    }
#pragma unroll
    for (int i = 0; i < 4; ++i) {
      const int col = (i * 64 + lane) * 4;
      float4 hv = hvv[i];
      if (t0) {
        const uint2 t2 = tv[i];
        const float4 w4 = wpv[i];
        hv.x += lo2f(t2.x) * r0 * w4.x; hv.y += hi2f(t2.x) * r0 * w4.y; hv.z += lo2f(t2.y) * r0 * w4.z; hv.w += hi2f(t2.y) * r0 * w4.w;
      }
      v[i] = hv; ss += hv.x * hv.x + hv.y * hv.y + hv.z * hv.z + hv.w * hv.w;
      if (hout) *(float4*)(hout + (size_t)row * 1024 + col) = hv;
    }
    if (hn) {
#pragma unroll
      for (int o = 32; o >= 1; o >>= 1) ss += shx(ss, o);
      const float r1 = rsqrtf(ss * (1.f / 1024.f) + EPSV);
#pragma unroll
      for (int i = 0; i < 4; ++i) {
        const int col = (i * 64 + lane) * 4;
        const float4 w4 = wnv[i];
        store4bf(hn + (size_t)row * 1024 + col, v[i].x * r1 * w4.x, v[i].y * r1 * w4.y, v[i].z * r1 * w4.z, v[i].w * r1 * w4.w);
      }
    }
  }
}

__device__ __forceinline__ void wconv(const float* __restrict__ W, int K, int N, int Npad, bf16_t* __restrict__ Wt, char* smem, int wvs) {
  float* tile = (float*)smem;
  int tq_ = TIDX(wvs) & 255; asm volatile("" : "+v"(tq_)); const int tid = tq_;
  const int nNt = Npad >> 6, nunits = (K >> 6) * nNt;
  for (int u = blockIdx.x * 2 + (wvs >> 2); u < nunits; u += gridDim.x * 2) {
    const int k0 = (u / nNt) * 64, n0 = (u % nNt) * 64;
#pragma unroll
    for (int ps = 0; ps < 4; ++ps) {
      const int i = ps * 16 + (tid >> 4), j = (tid & 15) * 4, n = n0 + j;
      float4 v = make_float4(0.f, 0.f, 0.f, 0.f);
      if (n < N) v = *(const float4*)(W + (size_t)(k0 + i) * N + n);
      tile[i * 65 + j] = v.x; tile[i * 65 + j + 1] = v.y; tile[i * 65 + j + 2] = v.z; tile[i * 65 + j + 3] = v.w;
    }
    __syncthreads();
    {
      const int n = tid >> 2, kq = (tid & 3) * 16;
      uint4 o0, o1;
      o0.x = pack2(tile[(kq + 0) * 65 + n], tile[(kq + 1) * 65 + n]); o0.y = pack2(tile[(kq + 2) * 65 + n], tile[(kq + 3) * 65 + n]);
      o0.z = pack2(tile[(kq + 4) * 65 + n], tile[(kq + 5) * 65 + n]); o0.w = pack2(tile[(kq + 6) * 65 + n], tile[(kq + 7) * 65 + n]);
      o1.x = pack2(tile[(kq + 8) * 65 + n], tile[(kq + 9) * 65 + n]); o1.y = pack2(tile[(kq + 10) * 65 + n], tile[(kq + 11) * 65 + n]);
      o1.z = pack2(tile[(kq + 12) * 65 + n], tile[(kq + 13) * 65 + n]); o1.w = pack2(tile[(kq + 14) * 65 + n], tile[(kq + 15) * 65 + n]);
      bf16_t* d = Wt + (size_t)(n0 + n) * K + k0 + kq;
      *(uint4*)d = o0; *(uint4*)(d + 8) = o1;
    }
    __syncthreads();
  }
}

__device__ __forceinline__ void prep_tables(const Params& p, int wvs) {
  int tq_ = TIDX(wvs); asm volatile("" : "+v"(tq_)); const int gt = blockIdx.x * NTHR + tq_, nt = gridDim.x * NTHR;
  float* rope = (float*)(p.ws + OFF_ROPE);
  for (int i = gt; i < 2056 * 64; i += nt) {
    const int pi = i >> 6, f = i & 63;
    const double pos = pi < 2048 ? (double)pi : (double)(16384 + pi - 2048);
    const double invf = exp(-(double)f * (9.210340371976184 / 64.0));
    double ang = pos * invf;
    ang -= 6.283185307179586 * floor(ang * 0.15915494309189535);
    const float a = (float)ang;
    rope[pi * 128 + f] = cosf(a); rope[pi * 128 + 64 + f] = sinf(a);
  }
  float* z = (float*)(p.ws + OFF_ROWSS);
  for (int i = gt; i < ROWS * 6; i += nt) z[i] = 0.f;
  float* lb = (float*)(p.ws + OFF_LB);
  for (int i = gt; i < 512; i += nt) lb[i] = 1.f / (1.f + expf(p.hgrn_lb[512 + i] - p.hgrn_lb[i]));
  float* tab = (float*)(p.ws + OFF_S5TAB);
  for (int i = gt; i < 2048; i += nt) {
    const int g = i >> 6;
    const float lr = p.s5_lam_re[i], li = p.s5_lam_im[i], dt = expf(p.s5_log_step[g]);
    const float m1 = expf(lr * dt), br = m1 * cosf(li * dt), bi = m1 * sinf(li * dt);
    tab[i] = br; tab[2048 + i] = bi;
    const float m64 = expf(lr * dt * 64.f); tab[69632 + i] = m64 * cosf(li * dt * 64.f); tab[71680 + i] = m64 * sinf(li * dt * 64.f);
    const float m8 = expf(lr * dt * 8.f); tab[73728 + i] = m8 * cosf(li * dt * 8.f); tab[75776 + i] = m8 * sinf(li * dt * 8.f);
    const float x = br - 1.f, y = bi, den = 1.f / (lr * lr + li * li);
    const float qr = (x * lr + y * li) * den, qi = (y * lr - x * li) * den;
    for (int c = 0; c < 16; ++c) {
      const float b_r = p.s5_b_re[i * 16 + c], b_i = p.s5_b_im[i * 16 + c];
      tab[4096 + i * 16 + c] = qr * b_r - qi * b_i;
      tab[4096 + 32768 + i * 16 + c] = qr * b_i + qi * b_r;
    }
  }
}

__device__ __forceinline__ void chunk_geom(int c, int& row0, int& L) { if (c < 256) { row0 = c * 64; L = 64; } else { row0 = 16384 + (c - 256) * 8; L = 8; } }

template <int MODE>
__device__ __forceinline__ void st_load(uint4 (&kr)[4], uint4 (&vr)[1], float& dtr, const bf16_t* src, const float* dtbuf, int row0, int L, int ld, int kcol, int vcol, int h, int tid) {
  constexpr int PW = 32, NVC = PW / 32, VCR = PW / 8;
  const uint4 z4 = make_uint4(0, 0, 0, 0);
#pragma unroll
  for (int i = 0; i < 4; ++i) { const int id = tid + i * 256, s = id >> 4, c8 = id & 15; uint4 t_ = z4; if (s < L) t_ = *(const uint4*)(src + (size_t)(row0 + s) * ld + kcol + c8 * 8); kr[i] = t_; }
#pragma unroll
  for (int i = 0; i < NVC; ++i) { const int id = tid + i * 256, s = id / VCR, c8 = id % VCR; uint4 t_ = z4; if (s < L) t_ = *(const uint4*)(src + (size_t)(row0 + s) * ld + vcol + c8 * 8); vr[i] = t_; }
  if (MODE == 2 && tid < 64) dtr = tid < L ? dtbuf[(size_t)(row0 + tid) * 16 + h] : 0.f;
}

template <int MODE>
__device__ __forceinline__ void state_unit(const Params& p, int sq, int h, int ps, char* smem, int wvs) {
  constexpr int PW = 32, NT = PW / 16, PF = (MODE == 2) ? 64 : 128, HH = (MODE == 2) ? 16 : 4, NVC = PW / 32, VCR = PW / 8;
  bf16_t* KT = (bf16_t*)smem;
  bf16_t* VT = KT + 128 * 80;
  bf16_t* KR = VT + 64 * 80;
  float* tot = (float*)(KR + 64 * 136);
  float* dec = tot + 256;
  float* av = dec + 64;
  float* dtv = av + 64;
  int tid_ = TIDX(wvs) & 255; asm volatile("" : "+v"(tid_)); const int tid = tid_, lane = tid & 63, wave = tid >> 6;
  const bool prompt = sq < 8;
  const int nch = prompt ? 32 : 1, L = prompt ? 64 : 8;
  const int ld = (MODE == 2) ? 1536 : 4096;
  const bf16_t* src = (MODE == 2) ? (const bf16_t*)(p.ws + OFF_H) : (const bf16_t*)(p.ws + OFF_A);
  const int kcol = MODE == 0 ? 512 + h * 128 : MODE == 1 ? 2560 + h * 128 : 1024 + (h >> 3) * 128;
  const int vcol = MODE == 0 ? 1024 + h * 128 + ps * 32 : MODE == 1 ? 3072 + h * 128 + ps * 32 : h * 64 + ps * 32;
  const float* sin_ = MODE == 0 ? p.state_ret : MODE == 1 ? p.state_hgrn : p.state_ssm;
  float* sout = p.out + (MODE == 0 ? O_RET : MODE == 1 ? O_HG : O_SSM) + (size_t)(sq * HH + h) * 128 * PF;
  bf16_t* stb = (bf16_t*)(p.ws + OFF_ST) + (MODE == 1 ? (size_t)256 * 4 * 128 * 128 : 0);
  const float* dtbuf = (const float*)(p.ws + OFF_DTBUF);
  const float l2g = MODE == 0 ? log2f(1.f - exp2f(-5.f - (float)h)) : 0.f;
  float Ah = 0.f, dtb = 0.f;
  if (MODE == 2) { Ah = -expf(p.a_log[h]); dtb = p.dt_bias[h]; }

  f32x4 acc[2][NT];
  const int nb = wave * 32 + (lane >> 4) * 4, pc = ps * PW + (lane & 15);
#pragma unroll
  for (int mt = 0; mt < 2; ++mt)
#pragma unroll
    for (int nt = 0; nt < NT; ++nt)
#pragma unroll
      for (int j = 0; j < 4; ++j)
        acc[mt][nt][j] = prompt ? 0.f : sin_[((size_t)((sq - 8) * HH + h) * 128 + nb + mt * 16 + j) * PF + pc + nt * 16];

  uint4 kr[4], vr[NVC]; float dtr = 0.f;
  const uint4 z4 = make_uint4(0, 0, 0, 0);
  st_load<MODE>(kr, vr, dtr, src, dtbuf, prompt ? sq * 2048 : 16384 + (sq - 8) * 8, L, ld, kcol, vcol, h, tid);
  for (int n = 0; n < nch; ++n) {
    if (prompt) {
      bf16_t* d = stb + ((size_t)((sq * 32 + n) * HH + h) * PF) * 128;
#pragma unroll
      for (int mt = 0; mt < 2; ++mt)
#pragma unroll
        for (int nt = 0; nt < NT; ++nt) store4bf(d + (size_t)(pc + nt * 16) * 128 + nb + mt * 16, acc[mt][nt][0], acc[mt][nt][1], acc[mt][nt][2], acc[mt][nt][3]);
    }
#pragma unroll
    for (int i = 0; i < 4; ++i) { const int id = tid + i * 256, s = id >> 4, c8 = id & 15; *(uint4*)(KR + s * 136 + c8 * 8) = kr[i]; }
#pragma unroll
    for (int i = 0; i < NVC; ++i) {
      const int id = tid + i * 256, s = id / VCR, c8 = id % VCR; const uint4 v = vr[i];
      bf16_t* d = VT + (c8 * 8) * 80 + s;
      d[0] = (bf16_t)(v.x & 0xffff); d[80] = (bf16_t)(v.x >> 16); d[160] = (bf16_t)(v.y & 0xffff); d[240] = (bf16_t)(v.y >> 16);
      d[320] = (bf16_t)(v.z & 0xffff); d[400] = (bf16_t)(v.z >> 16); d[480] = (bf16_t)(v.w & 0xffff); d[560] = (bf16_t)(v.w >> 16);
    }
    if (MODE == 2 && tid < 64) {
      float dt = 0.f;
      if (tid < L) { const float x = dtr + dtb; dt = x > 20.f ? x : log1pf(__expf(x)); }
      dtv[tid] = dt; av[tid] = dt * Ah;
    }
    if (n + 1 < nch) st_load<MODE>(kr, vr, dtr, src, dtbuf, sq * 2048 + (n + 1) * 64, L, ld, kcol, vcol, h, tid);
    __syncthreads();
    const int kn = tid & 127, half = tid >> 7;
    if (MODE == 1) {
      float s_ = 0.f;
#pragma unroll 8
      for (int s = half * 32; s < half * 32 + 32; ++s) s_ += bf2f(KR[s * 136 + kn]);
      tot[half * 128 + kn] = s_;
    }
    if (MODE == 2 && tid < 64) {
      const float a_ = av[tid];
      const float sinc = wave_suffix_incl(a_);
      dec[tid] = __expf(sinc - a_) * dtv[tid];
      if (tid == 0) tot[0] = sinc;
    }
    if (MODE != 0) __syncthreads();
    {
      float suf = 0.f;
      if (MODE == 1) suf = half == 0 ? tot[128 + kn] : 0.f;
      for (int g = 3; g >= 0; --g) {
        const int s0 = half * 32 + g * 8;
        float v[8];
#pragma unroll
        for (int e = 7; e >= 0; --e) {
          const int s = s0 + e;
          const float raw = bf2f(KR[s * 136 + kn]);
          if (MODE == 0) v[e] = raw * exp2f((float)(L - 1 - s) * l2g);
          else if (MODE == 1) { v[e] = (1.f - __expf(raw)) * __expf(suf); suf += raw; }
          else v[e] = raw * dec[s];
        }
        uint4 o; o.x = pack2(v[0], v[1]); o.y = pack2(v[2], v[3]); o.z = pack2(v[4], v[5]); o.w = pack2(v[6], v[7]);
        *(uint4*)(KT + kn * 80 + s0) = o;
      }
    }
    __syncthreads();
#pragma unroll
    for (int mt = 0; mt < 2; ++mt) {
      float dk[4];
      if (MODE == 0) { const float d = exp2f((float)L * l2g); dk[0] = dk[1] = dk[2] = dk[3] = d; }
      else if (MODE == 2) { const float d = __expf(tot[0]); dk[0] = dk[1] = dk[2] = dk[3] = d; }
      else {
#pragma unroll
        for (int j = 0; j < 4; ++j) { const int nn = nb + mt * 16 + j; dk[j] = __expf(tot[nn] + tot[128 + nn]); }
      }
#pragma unroll
      for (int nt = 0; nt < NT; ++nt)
#pragma unroll
        for (int j = 0; j < 4; ++j) acc[mt][nt][j] *= dk[j];
    }
    wmma_ns<2, NT>(acc, KT + wave * 32 * 80, 80, VT, 80, 64, lane);
    __syncthreads();
  }
#pragma unroll
  for (int mt = 0; mt < 2; ++mt)
#pragma unroll
    for (int nt = 0; nt < NT; ++nt)
#pragma unroll
      for (int j = 0; j < 4; ++j) sout[(size_t)(nb + mt * 16 + j) * PF + pc + nt * 16] = acc[mt][nt][j];
}

template <int MODE>
__device__ __forceinline__ void out_unit(const Params& p, int c, int h, char* smem, int wvs) {
  constexpr int PF = (MODE == 2) ? 64 : 128, NTP = PF / 16, HH = (MODE == 2) ? 16 : 4, NVC = PF / 32, VCR = PF / 8;
  bf16_t* Q = (bf16_t*)smem;
  bf16_t* Kb = Q + 64 * 136;
  bf16_t* STb = Kb + 128 * 80;
  float* cumv = (float*)(STb + 128 * 136);
  float* dtv = cumv + 64;
  float* av = dtv + 64;
  float* tot = av + 64;
  int tid_ = TIDX(wvs) & 255; asm volatile("" : "+v"(tid_)); const int tid = tid_, lane = tid & 63, wave = tid >> 6;
  int row0, L; chunk_geom(c, row0, L);
  const int ld = (MODE == 2) ? 1536 : 4096;
  const bf16_t* src = (MODE == 2) ? (const bf16_t*)(p.ws + OFF_H) : (const bf16_t*)(p.ws + OFF_A);
  const int qcol = MODE == 0 ? h * 128 : MODE == 1 ? 2048 + h * 128 : 1280 + (h >> 3) * 128;
  const int kcol = MODE == 0 ? 512 + h * 128 : MODE == 1 ? 2560 + h * 128 : 1024 + (h >> 3) * 128;
  const int vcol = MODE == 0 ? 1024 + h * 128 : MODE == 1 ? 3072 + h * 128 : h * 64;
  const float l2g = MODE == 0 ? log2f(1.f - exp2f(-5.f - (float)h)) : 0.f;
  const uint4 z4 = make_uint4(0, 0, 0, 0);
#pragma unroll
  for (int i = 0; i < 4; ++i) {
    const int id = tid + i * 256, s = id >> 4, c8 = id & 15;
    uint4 q4 = z4, k4 = z4;
    if (s < L) { q4 = *(const uint4*)(src + (size_t)(row0 + s) * ld + qcol + c8 * 8); k4 = *(const uint4*)(src + (size_t)(row0 + s) * ld + kcol + c8 * 8); }
    *(uint4*)(Q + s * 136 + c8 * 8) = q4; *(uint4*)(Kb + s * 136 + c8 * 8) = k4;
  }
  uint4 vr[NVC];
#pragma unroll
  for (int i = 0; i < NVC; ++i) { const int id = tid + i * 256, s = id / VCR, c8 = id % VCR; uint4 t_ = z4; if (s < L) t_ = *(const uint4*)(src + (size_t)(row0 + s) * ld + vcol + c8 * 8); vr[i] = t_; }
  if (c < 256) {
    const bf16_t* stg = (const bf16_t*)(p.ws + OFF_ST) + (MODE == 1 ? (size_t)256 * 4 * 128 * 128 : 0) + ((size_t)(c * HH + h) * PF) * 128;
#pragma unroll
    for (int i = 0; i < PF / 16; ++i) { const int id = tid + i * 256, pr = id >> 4, c8 = id & 15; *(uint4*)(STb + pr * 136 + c8 * 8) = *(const uint4*)(stg + (size_t)pr * 128 + c8 * 8); }
  } else {
    const float* sg = (MODE == 0 ? p.state_ret : MODE == 1 ? p.state_hgrn : p.state_ssm) + (size_t)((c - 256) * HH + h) * 128 * PF;
    for (int idb = tid; idb < 128 * (PF / 4); idb += 1024) {
      float4 v4[4];
#pragma unroll
      for (int q = 0; q < 4; ++q) { const int id = idb + q * 256, n = id / (PF / 4), p4 = (id % (PF / 4)) * 4; v4[q] = *(const float4*)(sg + (size_t)n * PF + p4); }
#pragma unroll
      for (int q = 0; q < 4; ++q) {
        const int id = idb + q * 256, n = id / (PF / 4), p4 = (id % (PF / 4)) * 4; const float4 v = v4[q];
        STb[(p4 + 0) * 136 + n] = f2bf(v.x); STb[(p4 + 1) * 136 + n] = f2bf(v.y); STb[(p4 + 2) * 136 + n] = f2bf(v.z); STb[(p4 + 3) * 136 + n] = f2bf(v.w);
      }
    }
  }
  if (MODE == 2 && tid < 64) {
    float dt = 0.f;
    if (tid < L) { const float x = ((const float*)(p.ws + OFF_DTBUF))[(size_t)(row0 + tid) * 16 + h] + p.dt_bias[h]; dt = x > 20.f ? x : log1pf(__expf(x)); }
    dtv[tid] = dt; av[tid] = -expf(p.a_log[h]) * dt;
  }
  __syncthreads();
  if (MODE == 1) {
    const int kn = tid & 127, half = tid >> 7;
    float s_ = 0.f;
#pragma unroll 8
    for (int s = half * 32; s < half * 32 + 32; ++s) s_ += bf2f(Kb[s * 136 + kn]);
    tot[half * 128 + kn] = s_;
    __syncthreads();
    float cum = half == 1 ? tot[kn] : 0.f;
    for (int sg = half * 32; sg < half * 32 + 32; sg += 8) {
      float lfv[8], qv[8];
#pragma unroll
      for (int e = 0; e < 8; ++e) { lfv[e] = bf2f(Kb[(sg + e) * 136 + kn]); qv[e] = bf2f(Q[(sg + e) * 136 + kn]); }
#pragma unroll
      for (int e = 0; e < 8; ++e) {
        cum += lfv[e];
        Q[(sg + e) * 136 + kn] = f2bf(qv[e] * __expf(cum));
        Kb[(sg + e) * 136 + kn] = f2bf((1.f - __expf(lfv[e])) * __expf(-cum));
      }
    }
    __syncthreads();
  }
  if (MODE == 2) {
    if (tid < 64) cumv[tid] = wave_prefix_incl(av[tid]);
    __syncthreads();
  }
  f32x4 ai[1][NTP], asc[1][4];
#pragma unroll
  for (int j = 0; j < NTP; ++j) ai[0][j] = (f32x4){0.f, 0.f, 0.f, 0.f};
#pragma unroll
  for (int j = 0; j < 4; ++j) asc[0][j] = (f32x4){0.f, 0.f, 0.f, 0.f};
  wmma_sw<1, NTP>(ai, Q + wave * 16 * 136, 136, STb, 136, 128, lane);
  wmma_sw<1, 4>(asc, Q + wave * 16 * 136, 136, Kb, 136, 128, lane);
  const int t = wave * 16 + (lane & 15), sq4 = (lane >> 4) * 4;
  float ct = 0.f;
  if (MODE == 2) ct = cumv[t];
#pragma unroll
  for (int nt = 0; nt < 4; ++nt)
#pragma unroll
    for (int j = 0; j < 4; ++j) {
      const int s = nt * 16 + sq4 + j;
      float v = asc[0][nt][j];
      if (s > t) v = 0.f;
      else if (MODE == 0) v *= exp2f((float)(t - s) * l2g);
      else if (MODE == 2) v *= __expf(ct - cumv[s]) * dtv[s];
      asc[0][nt][j] = v;
    }
  __syncthreads();
  bf16_t* Pb = STb; bf16_t* VT = Kb;
#pragma unroll
  for (int nt = 0; nt < 4; ++nt) store4bf(Pb + t * 80 + nt * 16 + sq4, asc[0][nt][0], asc[0][nt][1], asc[0][nt][2], asc[0][nt][3]);
#pragma unroll
  for (int i = 0; i < NVC; ++i) {
    const int id = tid + i * 256, s = id / VCR, c8 = id % VCR; const uint4 v = vr[i];
    bf16_t* d = VT + (c8 * 8) * 80 + s;
    d[0] = (bf16_t)(v.x & 0xffff); d[80] = (bf16_t)(v.x >> 16); d[160] = (bf16_t)(v.y & 0xffff); d[240] = (bf16_t)(v.y >> 16);
    d[320] = (bf16_t)(v.z & 0xffff); d[400] = (bf16_t)(v.z >> 16); d[480] = (bf16_t)(v.w & 0xffff); d[560] = (bf16_t)(v.w >> 16);
  }
  __syncthreads();
  f32x4 ao[1][NTP];
#pragma unroll
  for (int j = 0; j < NTP; ++j) ao[0][j] = (f32x4){0.f, 0.f, 0.f, 0.f};
  wmma_sw<1, NTP>(ao, Pb + wave * 16 * 80, 80, VT, 80, 64, lane);
  float fi = 1.f;
  if (MODE == 0) fi = exp2f((float)(t + 1) * l2g);
  if (MODE == 2) fi = __expf(ct);
  const int row = row0 + t;
  const bool valid = t < L;
  if (MODE == 0 || MODE == 1) {
    float s1 = 0.f, s2 = 0.f;
#pragma unroll
    for (int nt = 0; nt < NTP; ++nt)
#pragma unroll
      for (int j = 0; j < 4; ++j) { const float o = ao[0][nt][j] + fi * ai[0][nt][j]; ao[0][nt][j] = o; s1 += o; s2 += o * o; }
    s1 += shx(s1, 16); s1 += shx(s1, 32); s2 += shx(s2, 16); s2 += shx(s2, 32);
    float mu = 0.f, rs;
    if (MODE == 0) { mu = s1 * (1.f / 128.f); const float var = fmaxf(s2 * (1.f / 128.f) - mu * mu, 0.f); rs = rsqrtf(var + EPSV); }
    else rs = rsqrtf(s2 * (1.f / 128.f) + EPSV);
    if (valid) {
      const float* nw = (MODE == 0 ? p.ret_norm_w : p.hgrn_norm_w) + h * 128;
      const int gcol = (MODE == 0 ? 1536 : 3584) + h * 128;
      bf16_t* mix = (bf16_t*)(p.ws + OFF_H) + (size_t)row * 1024 + (MODE == 0 ? 0 : 512) + h * 128;
      float4 ww4[NTP]; uint2 gg2[NTP];
#pragma unroll
      for (int nt = 0; nt < NTP; ++nt) { const int pp = nt * 16 + sq4; ww4[nt] = *(const float4*)(nw + pp); gg2[nt] = *(const uint2*)(src + (size_t)row * ld + gcol + pp); }
#pragma unroll
      for (int nt = 0; nt < NTP; ++nt) {
        const int pp = nt * 16 + sq4;
        const float4 w4 = ww4[nt];
        const uint2 g2 = gg2[nt];
        store4bf(mix + pp, (ao[0][nt][0] - mu) * rs * w4.x * siluf(lo2f(g2.x)), (ao[0][nt][1] - mu) * rs * w4.y * siluf(hi2f(g2.x)),
                 (ao[0][nt][2] - mu) * rs * w4.z * siluf(lo2f(g2.y)), (ao[0][nt][3] - mu) * rs * w4.w * siluf(hi2f(g2.y)));
      }
    }
  } else {
    const float Dh = p.d_ssm[h];
    bf16_t* zy = (bf16_t*)(p.ws + OFF_A) + (size_t)row * 3200 + h * 64;
    float s2 = 0.f;
    if (valid) {
      uint2 xx2[NTP], zz2[NTP];
#pragma unroll
      for (int nt = 0; nt < NTP; ++nt) { const int pp = nt * 16 + sq4; xx2[nt] = *(const uint2*)(src + (size_t)row * ld + vcol + pp); zz2[nt] = *(const uint2*)(zy + pp); }
#pragma unroll
      for (int nt = 0; nt < NTP; ++nt) {
        const int pp = nt * 16 + sq4;
        const uint2 x2 = xx2[nt];
        const uint2 z2 = zz2[nt];
        const float y0 = (ao[0][nt][0] + fi * ai[0][nt][0] + Dh * lo2f(x2.x)) * siluf(lo2f(z2.x));
        const float y1 = (ao[0][nt][1] + fi * ai[0][nt][1] + Dh * hi2f(x2.x)) * siluf(hi2f(z2.x));
        const float y2 = (ao[0][nt][2] + fi * ai[0][nt][2] + Dh * lo2f(x2.y)) * siluf(lo2f(z2.y));
        const float y3 = (ao[0][nt][3] + fi * ai[0][nt][3] + Dh * hi2f(x2.y)) * siluf(hi2f(z2.y));
        s2 += y0 * y0 + y1 * y1 + y2 * y2 + y3 * y3;
        store4bf(zy + pp, y0, y1, y2, y3);
      }
    }
    s2 += shx(s2, 16); s2 += shx(s2, 32);
    if (valid && lane < 16) atomicAdd((float*)(p.ws + OFF_SSDST) + (size_t)row * 2 + (h >> 3), s2);
  }
  __syncthreads();
}

template <int OUT>
__device__ __forceinline__ void s5_unit(const Params& p, int c, int gq, char* smem, int wvs) {
  float* Uf = (float*)smem;
  bf16_t* HSall = (bf16_t*)(smem + 16384);
  bf16_t* CMall = (bf16_t*)(smem + 16384 + 34816);
  int tid_ = TIDX(wvs) & 255; asm volatile("" : "+v"(tid_)); const int tid = tid_, lane = tid & 63, wave = tid >> 6;
  int row0, L; chunk_geom(c, row0, L);
  const bf16_t* proj = (const bf16_t*)(p.ws + OFF_A);
#pragma unroll
  for (int i = 0; i < 2; ++i) {
    const int id = tid + i * 256, s = id >> 3, c8 = id & 7;
    uint4 v = make_uint4(0, 0, 0, 0);
    if (s < L) v = *(const uint4*)(proj + (size_t)(row0 + s) * 3200 + 2576 + gq * 64 + c8 * 8);
    float* d = Uf + s * 64 + c8 * 8;
    d[0] = lo2f(v.x); d[1] = hi2f(v.x); d[2] = lo2f(v.y); d[3] = hi2f(v.y); d[4] = lo2f(v.z); d[5] = hi2f(v.z); d[6] = lo2f(v.w); d[7] = hi2f(v.w);
  }
  const int g = gq * 4 + wave, gp = g * 64 + lane;
  const float* tab = (const float*)(p.ws + OFF_S5TAB);
  const float lr = tab[gp], li = tab[2048 + gp];
  f32x2 bb2[16];
#pragma unroll
  for (int q = 0; q < 4; ++q) {
    const float4 a = *(const float4*)(tab + 4096 + gp * 16 + q * 4), b = *(const float4*)(tab + 4096 + 32768 + gp * 16 + q * 4);
    bb2[q * 4] = (f32x2){a.x, b.x}; bb2[q * 4 + 1] = (f32x2){a.y, b.y}; bb2[q * 4 + 2] = (f32x2){a.z, b.z}; bb2[q * 4 + 3] = (f32x2){a.w, b.w};
  }
  float hr = 0.f, hi = 0.f;
  bf16_t* HS = HSall + wave * 32 * 136; bf16_t* CM = CMall + wave * 16 * 136;
  if (OUT) {
    const float2 h0 = *(const float2*)((const float*)(p.ws + OFF_S5H) + ((size_t)c * 2048 + gp) * 2);
    hr = h0.x; hi = h0.y;
#pragma unroll
    for (int ch = 0; ch < 16; ++ch) { CM[ch * 136 + lane] = f2bf(p.s5_c_re[(g * 16 + ch) * 64 + lane]); CM[ch * 136 + 64 + lane] = f2bf(-p.s5_c_im[(g * 16 + ch) * 64 + lane]); }
  }
  __syncthreads();
  const int nhalf = OUT ? ((L + 31) >> 5) : 1, tl = OUT ? 32 : L;
  for (int hf = 0; hf < nhalf; ++hf) {
#pragma unroll 4
    for (int tt = 0; tt < tl; ++tt) {
      const int t = hf * 32 + tt;
      {
        const float* up = Uf + t * 64 + wave * 16;
        f32x2 b0 = (f32x2){0.f, 0.f}, b1 = (f32x2){0.f, 0.f};
#pragma unroll
        for (int q = 0; q < 4; ++q) {
          const f32x4 u4 = *(const f32x4*)(up + q * 4);
          b0 += bb2[q * 4] * u4[0]; b1 += bb2[q * 4 + 1] * u4[1]; b0 += bb2[q * 4 + 2] * u4[2]; b1 += bb2[q * 4 + 3] * u4[3];
        }
        b0 += b1;
        const float nr = lr * hr - li * hi + b0[0], ni = lr * hi + li * hr + b0[1];
        if (t < L) { hr = nr; hi = ni; }
      }
      if (OUT) { HS[tt * 136 + lane] = f2bf(t < L ? hr : 0.f); HS[tt * 136 + 64 + lane] = f2bf(t < L ? hi : 0.f); }
    }
    if (OUT) {
      __syncthreads();
      f32x4 ay[2][1];
      ay[0][0] = (f32x4){0.f, 0.f, 0.f, 0.f}; ay[1][0] = (f32x4){0.f, 0.f, 0.f, 0.f};
      wmma_sw<2, 1>(ay, HS, 136, CM, 136, 128, lane);
      bf16_t* gbuf = (bf16_t*)(p.ws + OFF_GBUF);
#pragma unroll
      for (int mt = 0; mt < 2; ++mt) {
        const int t = hf * 32 + mt * 16 + (lane & 15), ch0 = (lane >> 4) * 4;
        if (t < L) {
          const float4 u4 = *(const float4*)(Uf + t * 64 + wave * 16 + ch0);
          const float4 d4 = *(const float4*)(p.s5_d + g * 16 + ch0);
          float y[4] = {ay[mt][0][0] + d4.x * u4.x, ay[mt][0][1] + d4.y * u4.y, ay[mt][0][2] + d4.z * u4.z, ay[mt][0][3] + d4.w * u4.w};
#pragma unroll
          for (int j = 0; j < 4; ++j) { const float x = y[j], uu = 0.7978845608028654f * (x + 0.044715f * x * x * x); y[j] = x / (1.f + __expf(-2.f * uu)); }
          store4bf(gbuf + (size_t)(row0 + t) * 512 + g * 16 + ch0, y[0], y[1], y[2], y[3]);
        }
      }
      __syncthreads();
    }
  }
  if (!OUT) { *(float2*)((float*)(p.ws + OFF_S5E) + ((size_t)c * 2048 + gp) * 2) = make_float2(hr, hi); }
  __syncthreads();
}

__device__ __forceinline__ void s5_prefix(const Params& p, int gt) {
  const int sq = gt >> 11, rem = gt & 2047;
  const float* tab = (const float*)(p.ws + OFF_S5TAB);
  const float* e = (const float*)(p.ws + OFF_S5E);
  float* hs = (float*)(p.ws + OFF_S5H);
  float hr = 0.f, hi = 0.f;
  if (sq < 8) {
    const float lr = tab[69632 + rem], li = tab[71680 + rem];
    for (int n = 0; n < 32; ++n) {
      const size_t idx = ((size_t)(sq * 32 + n) * 2048 + rem) * 2;
      *(float2*)(hs + idx) = make_float2(hr, hi);
      const float2 ev = *(const float2*)(e + idx);
      const float nr = lr * hr - li * hi + ev.x, ni = lr * hi + li * hr + ev.y; hr = nr; hi = ni;
    }
  } else {
    const float lr = tab[73728 + rem], li = tab[75776 + rem];
    hr = p.state_s5_re[(size_t)(sq - 8) * 2048 + rem]; hi = p.state_s5_im[(size_t)(sq - 8) * 2048 + rem];
    const size_t idx = ((size_t)(256 + sq - 8) * 2048 + rem) * 2;
    *(float2*)(hs + idx) = make_float2(hr, hi);
    const float2 ev = *(const float2*)(e + idx);
    const float nr = lr * hr - li * hi + ev.x, ni = lr * hi + li * hr + ev.y; hr = nr; hi = ni;
  }
  p.out[O_S5RE + (size_t)sq * 2048 + rem] = hr;
  p.out[O_S5IM + (size_t)sq * 2048 + rem] = hi;
}

__device__ __forceinline__ void conv_phase(const Params& p, int wvs) {
  const bf16_t* proj = (const bf16_t*)(p.ws + OFF_A);
  bf16_t* xc = (bf16_t*)(p.ws + OFF_H);
  int tq_ = TIDX(wvs); asm volatile("" : "+v"(tq_)); const int gt = blockIdx.x * NTHR + tq_, nt = gridDim.x * NTHR;
  for (int task = gt; task < 544 * 192; task += nt) {
    const int seg = task / 192, c = (task - seg * 192) * 8, rowb = seg * 32;
    float w[4][8], bia[8];
#pragma unroll
    for (int j = 0; j < 4; ++j) {
      const float4 w0 = *(const float4*)(p.conv_w + j * 1536 + c), w1 = *(const float4*)(p.conv_w + j * 1536 + c + 4);
      w[j][0] = w0.x; w[j][1] = w0.y; w[j][2] = w0.z; w[j][3] = w0.w; w[j][4] = w1.x; w[j][5] = w1.y; w[j][6] = w1.z; w[j][7] = w1.w;
    }
    { const float4 b0 = *(const float4*)(p.conv_b + c), b1 = *(const float4*)(p.conv_b + c + 4); bia[0] = b0.x; bia[1] = b0.y; bia[2] = b0.z; bia[3] = b0.w; bia[4] = b1.x; bia[5] = b1.y; bia[6] = b1.z; bia[7] = b1.w; }
    float x0[8], x1[8], x2[8];
    if (rowb < 16384 && (rowb & 2047) != 0) {
      const u32x4 v0 = *(const u32x4*)(proj + (size_t)(rowb - 3) * 3200 + 1024 + c), v1 = *(const u32x4*)(proj + (size_t)(rowb - 2) * 3200 + 1024 + c), v2 = *(const u32x4*)(proj + (size_t)(rowb - 1) * 3200 + 1024 + c);
#pragma unroll
      for (int e = 0; e < 4; ++e) { x0[2 * e] = lo2f(v0[e]); x0[2 * e + 1] = hi2f(v0[e]); x1[2 * e] = lo2f(v1[e]); x1[2 * e + 1] = hi2f(v1[e]); x2[2 * e] = lo2f(v2[e]); x2[2 * e + 1] = hi2f(v2[e]); }
    } else {
#pragma unroll
      for (int e = 0; e < 8; ++e) { x0[e] = 0.f; x1[e] = 0.f; x2[e] = 0.f; }
    }
    u32x4 nx[4];
#pragma unroll
    for (int q = 0; q < 4; ++q) nx[q] = *(const u32x4*)(proj + (size_t)(rowb + q) * 3200 + 1024 + c);
#pragma unroll 4
    for (int r = 0; r < 32; ++r) {
      const int row = rowb + r;
      const u32x4 cv = nx[r & 3];
      if (r + 4 < 32) nx[r & 3] = *(const u32x4*)(proj + (size_t)(row + 4) * 3200 + 1024 + c);
      int t, T, sq;
      if (row < 16384) { t = row & 2047; T = 2048; sq = row >> 11; } else { t = (row - 16384) & 7; T = 8; sq = 8 + ((row - 16384) >> 3); }
      if (t == 0) {
        if (sq >= 8) {
          const float* sc = p.state_conv + (size_t)(sq - 8) * 3 * 1536 + c;
          const float4 a0 = *(const float4*)sc, a1 = *(const float4*)(sc + 4), b0 = *(const float4*)(sc + 1536), b1 = *(const float4*)(sc + 1540), c0 = *(const float4*)(sc + 3072), c1 = *(const float4*)(sc + 3076);
          x0[0] = a0.x; x0[1] = a0.y; x0[2] = a0.z; x0[3] = a0.w; x0[4] = a1.x; x0[5] = a1.y; x0[6] = a1.z; x0[7] = a1.w;
          x1[0] = b0.x; x1[1] = b0.y; x1[2] = b0.z; x1[3] = b0.w; x1[4] = b1.x; x1[5] = b1.y; x1[6] = b1.z; x1[7] = b1.w;
          x2[0] = c0.x; x2[1] = c0.y; x2[2] = c0.z; x2[3] = c0.w; x2[4] = c1.x; x2[5] = c1.y; x2[6] = c1.z; x2[7] = c1.w;
        } else {
#pragma unroll
          for (int e = 0; e < 8; ++e) { x0[e] = 0.f; x1[e] = 0.f; x2[e] = 0.f; }
        }
      }
      float cur[8], o[8];
#pragma unroll
      for (int e = 0; e < 4; ++e) { cur[2 * e] = lo2f(cv[e]); cur[2 * e + 1] = hi2f(cv[e]); }
#pragma unroll
      for (int e = 0; e < 8; ++e) { o[e] = siluf(bia[e] + w[0][e] * x0[e] + w[1][e] * x1[e] + w[2][e] * x2[e] + w[3][e] * cur[e]); x0[e] = x1[e]; x1[e] = x2[e]; x2[e] = cur[e]; }
      u32x4 ov; ov[0] = pack2(o[0], o[1]); ov[1] = pack2(o[2], o[3]); ov[2] = pack2(o[4], o[5]); ov[3] = pack2(o[6], o[7]);
      *(u32x4*)(xc + (size_t)row * 1536 + c) = ov;
      if (t >= T - 3) {
        float* d = p.out + O_CONV + ((size_t)sq * 3 + (t - (T - 3))) * 1536 + c;
        *(float4*)d = make_float4(cur[0], cur[1], cur[2], cur[3]); *(float4*)(d + 4) = make_float4(cur[4], cur[5], cur[6], cur[7]);
      }
    }
  }
}

__device__ __forceinline__ void ssdnorm_phase(const Params& p, int wvs) {
  const bf16_t* proj = (const bf16_t*)(p.ws + OFF_A);
  bf16_t* mix = (bf16_t*)(p.ws + OFF_H);
  const float* st = (const float*)(p.ws + OFF_SSDST);
  int tq_ = TIDX(wvs); asm volatile("" : "+v"(tq_)); const int gt = blockIdx.x * NTHR + tq_, nt = gridDim.x * NTHR;
  for (int it = gt; it < ROWS * 128; it += nt) {
    const int row = it >> 7, c = (it & 127) * 8;
    const float r = rsqrtf(st[(size_t)row * 2 + (c >> 9)] * (1.f / 512.f) + EPSV);
    const uint4 v = *(const uint4*)(proj + (size_t)row * 3200 + c);
    const float4 w0 = *(const float4*)(p.ssm_norm_w + c), w1 = *(const float4*)(p.ssm_norm_w + c + 4);
    uint4 o; o.x = pack2(lo2f(v.x) * r * w0.x, hi2f(v.x) * r * w0.y); o.y = pack2(lo2f(v.y) * r * w0.z, hi2f(v.y) * r * w0.w);
    o.z = pack2(lo2f(v.z) * r * w1.x, hi2f(v.z) * r * w1.y); o.w = pack2(lo2f(v.w) * r * w1.z, hi2f(v.w) * r * w1.w);
    *(uint4*)(mix + (size_t)row * 1536 + c) = o;
  }
}


#define XB_TMO      128
#define XB_XCNT(j)  (256  + 64 * (j))
#define XB_XSUB(j)  (1280 + 64 * (j))
#define XB_XGEN(j)  (2304 + 64 * (j))
#define XB_TOP      3328
#define XB_TOPGEN   3392
#define XCD_BAR_WORDS 3456
#define XB_SPIN_CAP (1u << 18)
#define LAS __attribute__((address_space(3)))
__device__ __forceinline__ unsigned xb_ld(unsigned* p)              { return __hip_atomic_load(p, __ATOMIC_RELAXED, __HIP_MEMORY_SCOPE_AGENT); }
__device__ __forceinline__ unsigned xb_add(unsigned* p, unsigned v) { return __hip_atomic_fetch_add(p, v, __ATOMIC_RELAXED, __HIP_MEMORY_SCOPE_AGENT); }
__device__ __forceinline__ unsigned xb_xcc_id() { return (unsigned)__builtin_amdgcn_s_getreg((3 << 11) | 20) & 0xFu; }
#define XB_SPIN(cond, bar) do { unsigned _sp = 0; while (cond) { __builtin_amdgcn_s_sleep(1); \
    if ((++_sp & 255u) == 0u) { if (xb_ld(&(bar)[XB_TMO])) break; if (_sp > XB_SPIN_CAP) { atomicAdd(&(bar)[XB_TMO], 1u); break; } } } } while (0)
struct XcdBarrier { unsigned* bar; unsigned x; volatile LAS unsigned* st; };
__device__ __forceinline__ XcdBarrier xcd_barrier_post(unsigned* bar, volatile LAS unsigned* st, int wvs) {
    XcdBarrier b; b.bar = bar; b.x = xb_xcc_id(); b.st = st;
    if (TIDX(wvs) == 0) (void)xb_add(&bar[XB_XCNT(b.x)], 1u);
    return b;
}
__device__ __forceinline__ void xcd_barrier_complete(unsigned* bar, unsigned x, unsigned& nloc, unsigned& nx) {
    const unsigned G = gridDim.x * gridDim.y * gridDim.z;
    unsigned sum, cnt, mine, sp = 0u;
    for (;;) {
        sum = 0u; cnt = 0u; mine = 0u;
#pragma unroll
        for (unsigned j = 0; j < 16; ++j) { const unsigned c = xb_ld(&bar[XB_XCNT(j)]); sum += c; cnt += (c > 0u) ? 1u : 0u; mine = (j == x) ? c : mine; }
        if (sum == G) break;
        __builtin_amdgcn_s_sleep(1);
        if ((++sp & 255u) == 0u) { if (xb_ld(&bar[XB_TMO])) break; if (sp > XB_SPIN_CAP) { atomicAdd(&bar[XB_TMO], 1u); break; } }
    }
    nloc = mine > 0u ? mine : 1u; nx = cnt > 0u ? cnt : 1u;
}
__device__ __forceinline__ void xcd_barrier(const XcdBarrier& b, int wvs) {
    asm volatile("s_waitcnt vmcnt(0)" ::: "memory");
    __syncthreads();
    if (TIDX(wvs) == 0) {
        unsigned* bar = b.bar;
        __builtin_amdgcn_s_waitcnt(0);
        unsigned nloc = b.st[0], nx = b.st[1];
        if (nloc == 0u) { xcd_barrier_complete(bar, b.x, nloc, nx); b.st[0] = nloc; b.st[1] = nx; }
        const unsigned old = xb_add(&bar[XB_XSUB(b.x)], 1u);
        const unsigned gen = old / nloc;
        if (old + 1u == (gen + 1u) * nloc) {
            __builtin_amdgcn_fence(__ATOMIC_RELEASE, "agent");
            asm volatile("s_waitcnt vmcnt(0)" ::: "memory");
            const unsigned og = xb_add(&bar[XB_TOP], 1u);
            const unsigned tg = og / nx;
            if (og + 1u == (tg + 1u) * nx) xb_add(&bar[XB_TOPGEN], 1u);
            else XB_SPIN(xb_ld(&bar[XB_TOPGEN]) == tg, bar);
            __builtin_amdgcn_fence(__ATOMIC_ACQUIRE, "agent");
            xb_add(&bar[XB_XGEN(b.x)], 1u);
            asm volatile("s_waitcnt vmcnt(0)" ::: "memory");
        } else {
            XB_SPIN(xb_ld(&bar[XB_XGEN(b.x)]) == gen, bar);
            __builtin_amdgcn_fence(__ATOMIC_ACQUIRE, "agent");
            asm volatile("s_waitcnt vmcnt(0)" ::: "memory");
        }
    }
    __syncthreads();
}


__device__ __forceinline__ Params ldp() {
  auto kp = __builtin_amdgcn_kernarg_segment_ptr();
  asm volatile("" : "+s"(kp));
  Params q;
  __builtin_memcpy(&q, (const void*)kp, sizeof(Params));
  return q;
}

__global__ void __launch_bounds__(NTHR, 2) fwd_megakernel(Params p_) {
  extern __shared__ __attribute__((aligned(16))) char smem[];
  cg::grid_group grid = cg::this_grid();
  if (p_.ws == nullptr) grid.sync();
  volatile LAS unsigned* xst = (volatile LAS unsigned*)(smem + 2 * HALF_LDS);
  const int wvs = __builtin_amdgcn_readfirstlane(threadIdx.x >> 6);
  if (TIDX(wvs) == 0) { xst[0] = 0u; xst[1] = 0u; xst[2] = 0u; xst[3] = 0u; }
  __syncthreads();
  const XcdBarrier xb = xcd_barrier_post((unsigned*)(p_.ws + OFF_BAR), xst, wvs);
  const int half = wvs >> 2;
  const int G = gridDim.x * 2, bid = blockIdx.x * 2 + half;
  char* hs = smem + half * HALF_LDS;
#define PH_BEGIN const Params p = ldp(); bf16_t* bufA = (bf16_t*)(p.ws + OFF_A); bf16_t* bufH = (bf16_t*)(p.ws + OFF_H); bf16_t* t0 = (bf16_t*)(p.ws + OFF_ST); \
    float* rowss = (float*)(p.ws + OFF_ROWSS); float* hbuf = p.out; (void)bufA; (void)bufH; (void)t0; (void)rowss; (void)hbuf;

  {
  PH_BEGIN
  prep_tables(p, wvs);
  wconv(p.w_in_even, 1024, 4096, 4096, (bf16_t*)(p.ws + W_IN), hs, wvs);
  wconv(p.w_out_even, 1024, 1024, 1024, (bf16_t*)(p.ws + W_OUT0), hs, wvs);
  wconv(p.w_ffn_up, 1024, 4096, 4096, (bf16_t*)(p.ws + W_UP), hs, wvs);
  wconv(p.w_ffn_down, 4096, 1024, 1024, (bf16_t*)(p.ws + W_DOWN), hs, wvs);
  rowpass_phase(nullptr, nullptr, nullptr, p.x_prompt, p.x_sample, nullptr, p.norm_mix_pre, bufH, wvs);
  }
  xcd_barrier(xb, wvs);
  {
  PH_BEGIN
  { EpiInEven e{bufA, (const float*)(p.ws + OFF_ROPE), (const float*)(p.ws + OFF_LB)};
    for (int rep_ = 0; rep_ < REPG; ++rep_) { gemm_phase(bufH, 1024, (const bf16_t*)(p.ws + W_IN), 1024, 64, 16, 1024, e, smem, wvs); gemm_tail(bufH, 1024, (const bf16_t*)(p.ws + W_IN), 1024, 32, 1024, e, smem, wvs, 64 * 16); } }
  }
  xcd_barrier(xb, wvs);
  {
  PH_BEGIN
  for (int rep_ = 0; rep_ < REPS; ++rep_) {
    if (bid < 256) {
      const int v = bid;
      const int ps = v & 3, m = (v >> 2) & 1, h = (v >> 3) & 3, sq = v >> 5;
      if (m == 0) state_unit<0>(p, sq, h, ps, hs, wvs); else state_unit<1>(p, sq, h, ps, hs, wvs);
    }
    const int nsh = bid < 256 ? 0 : 16, j0 = bid - 256;
    for (int i = 0; i < nsh; ++i) {
      const int v = j0 + 256 * i;
      const int ps = v & 3, m = (v >> 2) & 1, h = (v >> 3) & 3, sq = 8 + (v >> 5);
      if (m == 0) state_unit<0>(p, sq, h, ps, hs, wvs); else state_unit<1>(p, sq, h, ps, hs, wvs);
    }
  }
  }
  xcd_barrier(xb, wvs);
  {
  PH_BEGIN
  for (int rep_ = 0; rep_ < REPO; ++rep_)
  for (int u = bid; u < 384 * 8; u += G) {
    const int h = u & 3, m = (u >> 2) & 1, c = u >> 3;
    if (m == 0) out_unit<0>(p, c, h, hs, wvs); else out_unit<1>(p, c, h, hs, wvs);
  }
  }
  xcd_barrier(xb, wvs);
  {
  PH_BEGIN
  { EpiOut e{t0, rowss};
    for (int rep_ = 0; rep_ < REPG; ++rep_) { gemm_phase(bufH, 1024, (const bf16_t*)(p.ws + W_OUT0), 1024, 64, 4, 1024, e, smem, wvs); gemm_tail(bufH, 1024, (const bf16_t*)(p.ws + W_OUT0), 1024, 8, 1024, e, smem, wvs, 64 * 4); } }
  }
  xcd_barrier(xb, wvs);
  {
  PH_BEGIN
  for (int rep_ = 0; rep_ < REPR; ++rep_)
  rowpass_phase(t0, rowss, p.norm_mix_post, p.x_prompt, p.x_sample, hbuf, p.norm_ffn_pre, bufH, wvs);
  }
  xcd_barrier(xb, wvs);
  {
  PH_BEGIN
  { EpiUp e{bufA}; for (int rep_ = 0; rep_ < REPG; ++rep_) { gemm_phase(bufH, 1024, (const bf16_t*)(p.ws + W_UP), 1024, 64, 16, 1024, e, smem, wvs); gemm_tail(bufH, 1024, (const bf16_t*)(p.ws + W_UP), 1024, 32, 1024, e, smem, wvs, 64 * 16); } }
  }
  xcd_barrier(xb, wvs);
  {
  PH_BEGIN
  { EpiOut e{t0, rowss + ROWS}; for (int rep_ = 0; rep_ < REPG; ++rep_) { gemm_phase(bufA, 4096, (const bf16_t*)(p.ws + W_DOWN), 4096, 64, 4, 4096, e, smem, wvs); gemm_tail(bufA, 4096, (const bf16_t*)(p.ws + W_DOWN), 4096, 8, 4096, e, smem, wvs, 64 * 4); } }
  }
  xcd_barrier(xb, wvs);
  {
  PH_BEGIN
  rowpass_phase(t0, rowss + ROWS, p.norm_ffn_post, hbuf, hbuf + (size_t)16384 * 1024, hbuf, p.norm_mix_pre + 1024, bufH, wvs);
  wconv(p.w_in_odd, 1024, 3088, 3328, (bf16_t*)(p.ws + W_IN), hs, wvs);
  wconv(p.w_glu, 512, 512, 512, (bf16_t*)(p.ws + W_GLU), hs, wvs);
  wconv(p.w_out_odd, 1536, 1024, 1024, (bf16_t*)(p.ws + W_OUT1), hs, wvs);
  wconv(p.w_ffn_up + (size_t)1024 * 4096, 1024, 4096, 4096, (bf16_t*)(p.ws + W_UP), hs, wvs);
  wconv(p.w_ffn_down + (size_t)4096 * 1024, 4096, 1024, 1024, (bf16_t*)(p.ws + W_DOWN), hs, wvs);
  }
  xcd_barrier(xb, wvs);
  {
  PH_BEGIN
  { EpiInOdd e{bufA, (float*)(p.ws + OFF_DTBUF)};
    for (int rep_ = 0; rep_ < REPG; ++rep_) { gemm_phase(bufH, 1024, (const bf16_t*)(p.ws + W_IN), 1024, 64, 13, 1024, e, smem, wvs); gemm_tail(bufH, 1024, (const bf16_t*)(p.ws + W_IN), 1024, 26, 1024, e, smem, wvs, 64 * 13); } }
  }
  xcd_barrier(xb, wvs);
  {
  PH_BEGIN
  for (int rep_ = 0; rep_ < REPC; ++rep_) {
  conv_phase(p, wvs);
  for (int u = bid; u < 384 * 8; u += G) s5_unit<0>(p, u >> 3, u & 7, hs, wvs);
  }
  }
  xcd_barrier(xb, wvs);
  {
  PH_BEGIN
  for (int rep_ = 0; rep_ < REPS; ++rep_) {
    if (bid < 256) state_unit<2>(p, bid >> 5, (bid >> 1) & 15, bid & 1, hs, wvs);
    for (int j = bid - 256; j < 5184; j += 256) {
      if (bid < 256) break;
      if (j < 1088) { int tq_ = TIDX(wvs) & 255; asm volatile("" : "+v"(tq_)); s5_prefix(p, j * 256 + tq_); }
      else { const int v = j - 1088; state_unit<2>(p, 8 + (v >> 5), (v >> 1) & 15, v & 1, hs, wvs); }
    }
  }
  }
  xcd_barrier(xb, wvs);
  {
  PH_BEGIN
  for (int u = bid; u < 384 * 16 + 384 * 8; u += G) {
    if (u < 384 * 16) out_unit<2>(p, u >> 4, u & 15, hs, wvs);
    else { const int v = u - 384 * 16; s5_unit<1>(p, v >> 3, v & 7, hs, wvs); }
  }
  }
  xcd_barrier(xb, wvs);
  {
  PH_BEGIN
  ssdnorm_phase(p, wvs);
  { EpiGlu e{(const bf16_t*)(p.ws + OFF_GBUF), p.b_glu, bufH};
    for (int rep_ = 0; rep_ < REPG; ++rep_) { gemm_phase((const bf16_t*)(p.ws + OFF_GBUF), 512, (const bf16_t*)(p.ws + W_GLU), 512, 64, 2, 512, e, smem, wvs); gemm_tail((const bf16_t*)(p.ws + OFF_GBUF), 512, (const bf16_t*)(p.ws + W_GLU), 512, 4, 512, e, smem, wvs, 64 * 2); } }
  }
  xcd_barrier(xb, wvs);
  {
  PH_BEGIN
  { EpiOut e{t0, rowss + 2 * ROWS}; for (int rep_ = 0; rep_ < REPG; ++rep_) { gemm_phase(bufH, 1536, (const bf16_t*)(p.ws + W_OUT1), 1536, 64, 4, 1536, e, smem, wvs); gemm_tail(bufH, 1536, (const bf16_t*)(p.ws + W_OUT1), 1536, 8, 1536, e, smem, wvs, 64 * 4); } }
  }
  xcd_barrier(xb, wvs);
  {
  PH_BEGIN
  rowpass_phase(t0, rowss + 2 * ROWS, p.norm_mix_post + 1024, hbuf, hbuf + (size_t)16384 * 1024, hbuf, p.norm_ffn_pre + 1024, bufH, wvs);
  }
  xcd_barrier(xb, wvs);
  {
  PH_BEGIN
  { EpiUp e{bufA}; for (int rep_ = 0; rep_ < REPG; ++rep_) { gemm_phase(bufH, 1024, (const bf16_t*)(p.ws + W_UP), 1024, 64, 16, 1024, e, smem, wvs); gemm_tail(bufH, 1024, (const bf16_t*)(p.ws + W_UP), 1024, 32, 1024, e, smem, wvs, 64 * 16); } }
  }
  xcd_barrier(xb, wvs);
  {
  PH_BEGIN
  { EpiOut e{t0, rowss + 3 * ROWS}; for (int rep_ = 0; rep_ < REPG; ++rep_) { gemm_phase(bufA, 4096, (const bf16_t*)(p.ws + W_DOWN), 4096, 64, 4, 4096, e, smem, wvs); gemm_tail(bufA, 4096, (const bf16_t*)(p.ws + W_DOWN), 4096, 8, 4096, e, smem, wvs, 64 * 4); } }
  }
  xcd_barrier(xb, wvs);
  {
  PH_BEGIN
  rowpass_phase(t0, rowss + 3 * ROWS, p.norm_ffn_post + 1024, hbuf, hbuf + (size_t)16384 * 1024, hbuf, nullptr, nullptr, wvs);
  }
}

extern "C" void kernel_launch(void* const* d_in, const int* in_sizes, int n_in, void* d_out, int out_size, void* d_ws, size_t ws_size, hipStream_t stream) {
  constexpr size_t kDynLds = 2 * HALF_LDS + 64;
  static int grid_blocks = 0;
  if (!grid_blocks) {
    int dev = 0, cus = 0, per_cu = 0;
    (void)hipGetDevice(&dev);
    (void)hipDeviceGetAttribute(&cus, hipDeviceAttributeMultiprocessorCount, dev);
    (void)hipFuncSetAttribute((const void*)fwd_megakernel, hipFuncAttributeMaxDynamicSharedMemorySize, (int)kDynLds);
    (void)hipOccupancyMaxActiveBlocksPerMultiprocessor(&per_cu, fwd_megakernel, NTHR, kDynLds);
    if (per_cu > 1) per_cu = 1;
    if (per_cu < 1) per_cu = 1;
    grid_blocks = cus * per_cu;
  }
  Params p{};
  const float** pf = (const float**)&p;
  for (int i = 0; i < 37; ++i) pf[i] = (const float*)d_in[i];
  p.out = (float*)d_out;
  p.ws = (char*)d_ws;
  (void)hipMemsetAsync((char*)d_ws + OFF_BAR, 0, 16384, stream);
  void* args[] = {&p};
  hipError_t e = hipLaunchCooperativeKernel((void*)fwd_megakernel, dim3(grid_blocks), dim3(NTHR), args, kDynLds, stream);
  if (e != hipSuccess) fprintf(stderr, "cooperative launch failed: %s (grid %d)\n", hipGetErrorString(e), grid_blocks);
}
```

```cpp
#include <hip/hip_runtime.h>
#include <hip/hip_cooperative_groups.h>
#include <cstdio>
namespace cg = cooperative_groups;

typedef unsigned short bf16_t;
typedef short bf16x8 __attribute__((ext_vector_type(8)));
typedef float f32x4 __attribute__((ext_vector_type(4)));
typedef unsigned u32x4 __attribute__((ext_vector_type(4)));
typedef float f32x2 __attribute__((ext_vector_type(2)));

#define NTHR 512
#ifndef REPS
#define REPS 1
#endif
#ifndef REPO
#define REPO 1
#endif
#ifndef REPC
#define REPC 1
#endif
#ifndef REPR
#define REPR 1
#endif
#ifndef REPG
#define REPG 1
#endif
#define HALF_LDS 74752
#ifndef REP0
#define REP0 1
#endif
#ifndef REPS
#define REPS 1
#endif
#ifndef REPO
#define REPO 1
#endif
#ifndef REPC
#define REPC 1
#endif
#ifndef REPY
#define REPY 21
#endif
#define ROWS 17408
#define EPSV 1e-6f
#define TIDX(w) ((w) * 64 + (int)__builtin_amdgcn_mbcnt_hi(~0u, __builtin_amdgcn_mbcnt_lo(~0u, 0u)))

constexpr size_t W_IN = 0;
constexpr size_t W_OUT0 = 8388608;
constexpr size_t W_GLU = 6815744;
constexpr size_t W_OUT1 = 7340032;
constexpr size_t W_UP = 10485760;
constexpr size_t W_DOWN = 18874368;
constexpr size_t OFF_A = 29360128;
constexpr size_t OFF_GBUF = OFF_A + 111411200;
constexpr size_t OFF_ST = OFF_A + 142606336;
constexpr size_t OFF_H = OFF_ST + 67108864;
constexpr size_t OFF_SM = OFF_H + 53477376;
constexpr size_t OFF_ROPE = OFF_SM;
constexpr size_t OFF_ROWSS = OFF_SM + 1052672;
constexpr size_t OFF_SSDST = OFF_SM + 1331200;
constexpr size_t OFF_DTBUF = OFF_SM + 1470464;
constexpr size_t OFF_LB = OFF_SM + 2584576;
constexpr size_t OFF_S5TAB = OFF_SM + 2586624;
constexpr size_t OFF_S5E = OFF_SM + 2897920;
constexpr size_t OFF_S5H = OFF_SM + 9189376;
constexpr size_t OFF_BAR = OFF_SM + 15480832;

constexpr size_t O_RET = 17825792, O_HG = 26738688, O_SSM = 35651584, O_CONV = 53477376, O_S5RE = 54104064, O_S5IM = 54382592;

struct Params {
  const float *x_prompt, *x_sample, *state_ret, *state_hgrn, *state_ssm, *state_conv, *state_s5_re, *state_s5_im;
  const float *norm_mix_pre, *norm_mix_post, *norm_ffn_pre, *norm_ffn_post;
  const float *w_in_even, *w_out_even, *ret_norm_w, *hgrn_lb, *hgrn_norm_w, *w_in_odd, *conv_w, *conv_b, *dt_bias, *a_log, *d_ssm, *ssm_norm_w;
  const float *s5_lam_re, *s5_lam_im, *s5_log_step, *s5_b_re, *s5_b_im, *s5_c_re, *s5_c_im, *s5_d, *w_glu, *b_glu, *w_out_odd, *w_ffn_up, *w_ffn_down;
  float* out;
  char* ws;
};

__device__ __forceinline__ bf16_t f2bf(float f) { unsigned r; asm("v_cvt_pk_bf16_f32 %0, %1, %1" : "=v"(r) : "v"(f)); return (bf16_t)(r & 0xffffu); }
__device__ __forceinline__ float bf2f(bf16_t h) { return __uint_as_float(((unsigned)h) << 16); }
__device__ __forceinline__ unsigned pack2(float a, float b) { unsigned r; asm("v_cvt_pk_bf16_f32 %0, %1, %2" : "=v"(r) : "v"(a), "v"(b)); return r; }
__device__ __forceinline__ float lo2f(unsigned u) { return __uint_as_float(u << 16); }
__device__ __forceinline__ float hi2f(unsigned u) { return __uint_as_float(u & 0xffff0000u); }
__device__ __forceinline__ float sigm(float x) { return 1.f / (1.f + __expf(-x)); }
__device__ __forceinline__ float siluf(float x) { return x / (1.f + __expf(-x)); }
__device__ __forceinline__ void store4bf(bf16_t* p, float a, float b, float c, float d) { uint2 v; v.x = pack2(a, b); v.y = pack2(c, d); *(uint2*)p = v; }

__device__ __forceinline__ float shx(float v, int mask) {
  int l = (int)__builtin_amdgcn_mbcnt_hi(~0u, __builtin_amdgcn_mbcnt_lo(~0u, 0u));
  asm volatile("" : "+v"(l));
  return __int_as_float(__builtin_amdgcn_ds_bpermute((l ^ mask) << 2, __float_as_int(v)));
}

__device__ __forceinline__ float wave_suffix_incl(float v) {
  int l = (int)__builtin_amdgcn_mbcnt_hi(~0u, __builtin_amdgcn_mbcnt_lo(~0u, 0u));
  asm volatile("" : "+v"(l));
#pragma unroll
  for (int o = 1; o < 64; o <<= 1) { const float t = __int_as_float(__builtin_amdgcn_ds_bpermute(((l + o) & 63) << 2, __float_as_int(v))); if (l + o < 64) v += t; }
  return v;
}
__device__ __forceinline__ float wave_prefix_incl(float v) {
  int l = (int)__builtin_amdgcn_mbcnt_hi(~0u, __builtin_amdgcn_mbcnt_lo(~0u, 0u));
  asm volatile("" : "+v"(l));
#pragma unroll
  for (int o = 1; o < 64; o <<= 1) { const float t = __int_as_float(__builtin_amdgcn_ds_bpermute(((l - o) & 63) << 2, __float_as_int(v))); if (l >= o) v += t; }
  return v;
}

template <int MT, int NT>
__device__ __forceinline__ void wmma_sw(f32x4 (&acc)[MT][NT], const bf16_t* A, int lda, const bf16_t* B, int ldb, int K, int lane) {
  const int r = lane & 15, kq = (lane >> 4) * 8;
  for (int k0 = 0; k0 < K; k0 += 32) {
    bf16x8 af[MT], bfr[NT];
#pragma unroll
    for (int mt = 0; mt < MT; ++mt) af[mt] = *(const bf16x8*)(A + (mt * 16 + r) * lda + k0 + kq);
#pragma unroll
    for (int nt = 0; nt < NT; ++nt) bfr[nt] = *(const bf16x8*)(B + (nt * 16 + r) * ldb + k0 + kq);
#pragma unroll
    for (int mt = 0; mt < MT; ++mt)
#pragma unroll
      for (int nt = 0; nt < NT; ++nt) acc[mt][nt] = __builtin_amdgcn_mfma_f32_16x16x32_bf16(bfr[nt], af[mt], acc[mt][nt], 0, 0, 0);
  }
}
template <int MT, int NT>
__device__ __forceinline__ void wmma_ns(f32x4 (&acc)[MT][NT], const bf16_t* A, int lda, const bf16_t* B, int ldb, int K, int lane) {
  const int r = lane & 15, kq = (lane >> 4) * 8;
  for (int k0 = 0; k0 < K; k0 += 32) {
    bf16x8 af[MT], bfr[NT];
#pragma unroll
    for (int mt = 0; mt < MT; ++mt) af[mt] = *(const bf16x8*)(A + (mt * 16 + r) * lda + k0 + kq);
#pragma unroll
    for (int nt = 0; nt < NT; ++nt) bfr[nt] = *(const bf16x8*)(B + (nt * 16 + r) * ldb + k0 + kq);
#pragma unroll
    for (int mt = 0; mt < MT; ++mt)
#pragma unroll
      for (int nt = 0; nt < NT; ++nt) acc[mt][nt] = __builtin_amdgcn_mfma_f32_16x16x32_bf16(af[mt], bfr[nt], acc[mt][nt], 0, 0, 0);
  }
}

__device__ __forceinline__ void gemm_kstep(f32x4 (&acc)[4][8], const char* A, const char* B) {
  bf16x8 af[4], bfr[8];
#pragma unroll
  for (int mt = 0; mt < 4; ++mt) af[mt] = *(const bf16x8*)(A + mt * 2048);
#pragma unroll
  for (int nt = 0; nt < 8; ++nt) bfr[nt] = *(const bf16x8*)(B + nt * 2048);
  __builtin_amdgcn_sched_barrier(0);
#pragma unroll
  for (int nt = 0; nt < 8; ++nt)
#pragma unroll
    for (int mt = 0; mt < 4; ++mt) acc[mt][nt] = __builtin_amdgcn_mfma_f32_16x16x32_bf16(bfr[nt], af[mt], acc[mt][nt], 0, 0, 0);
}

template <class Epi>
__device__ __forceinline__ void gemm_phase(const bf16_t* A, int lda, const bf16_t* Bt, int ldb, int nMt, int nNt, int K, const Epi& epi, char* smem, int wvs) {
  char* As = smem;
  char* Bs = smem + 65536;
  int tid_ = TIDX(wvs); asm volatile("" : "+v"(tid_)); const int tid = tid_, lane = tid & 63, wave = tid >> 6;
  const int wr = wave >> 1, wc = wave & 1;
  const int ntiles = nMt * nNt, nk = K >> 6;
  const int lrow = tid >> 3, lcc = (tid & 7) * 8;
  const int wofs = ((lrow >> 4) * 2 + (lcc >> 5)) * 1024 + ((((lrow & 15) * 64) + (lcc & 31) * 2) ^ ((lrow & 8) << 2));
  const int rofs = (((lane & 15) * 64) + (lane >> 4) * 16) ^ ((lane & 8) << 2);
  const unsigned toffA = (unsigned)(lrow * lda + lcc), toffB = (unsigned)(lrow * ldb + lcc);
  for (int tile = blockIdx.x; tile < ntiles; tile += gridDim.x) {
    const int pn = tile / nMt, pm = tile - pn * nMt;
    const bf16_t* Ab = A + (size_t)(pm * 256) * lda;
    const bf16_t* Bb = Bt + (size_t)(pn * 256) * ldb;
    f32x4 acc[4][8];
#pragma unroll
    for (int i = 0; i < 4; ++i)
#pragma unroll
      for (int j = 0; j < 8; ++j) acc[i][j] = (f32x4){0.f, 0.f, 0.f, 0.f};
    u32x4 rg[4];
#pragma unroll
    for (int i = 0; i < 4; ++i) rg[i] = *(const u32x4*)(Ab + (size_t)(i * 64) * lda + toffA);
#pragma unroll
    for (int i = 0; i < 4; ++i) *(u32x4*)(As + wofs + i * 8192) = rg[i];
#pragma unroll
    for (int i = 0; i < 4; ++i) rg[i] = *(const u32x4*)(Bb + (size_t)(i * 64) * ldb + toffB);
#pragma unroll
    for (int i = 0; i < 4; ++i) *(u32x4*)(Bs + wofs + i * 8192) = rg[i];
    __syncthreads();
#pragma unroll 1
    for (int kt = 0; kt < nk; ++kt) {
      const int cur = kt & 1;
      const int kn = (kt + 1 < nk ? kt + 1 : kt) * 64;
      char* Ad = As + (cur ^ 1) * 32768; char* Bd = Bs + (cur ^ 1) * 32768;
#pragma unroll
      for (int i = 0; i < 4; ++i) rg[i] = *(const u32x4*)(Ab + ((size_t)(i * 64) * lda + kn) + toffA);
      __builtin_amdgcn_sched_barrier(0);
      gemm_kstep(acc, As + cur * 32768 + wr * 8192 + rofs, Bs + cur * 32768 + wc * 16384 + rofs);
      __builtin_amdgcn_sched_barrier(0);
#pragma unroll
      for (int i = 0; i < 4; ++i) *(u32x4*)(Ad + wofs + i * 8192) = rg[i];
#pragma unroll
      for (int i = 0; i < 4; ++i) rg[i] = *(const u32x4*)(Bb + ((size_t)(i * 64) * ldb + kn) + toffB);
      __builtin_amdgcn_sched_barrier(0);
      gemm_kstep(acc, As + cur * 32768 + wr * 8192 + 1024 + rofs, Bs + cur * 32768 + wc * 16384 + 1024 + rofs);
      __builtin_amdgcn_sched_barrier(0);
#pragma unroll
      for (int i = 0; i < 4; ++i) *(u32x4*)(Bd + wofs + i * 8192) = rg[i];
      __syncthreads();
    }
    int er_ = pm * 256 + wr * 64, ec_ = pn * 256 + wc * 128, el_ = lane;
    asm volatile("" : "+v"(er_), "+v"(ec_), "+v"(el_));
    epi(acc, er_, ec_, el_);
  }
}

struct EpiInEven {
  bf16_t* proj; const float* rope; const float* lb;
  template <int MT> __device__ __forceinline__ void operator()(f32x4 (&acc)[MT][8], int rbase, int cbase, int lane) const {
    const int sec = cbase >> 9, head = (cbase >> 7) & 3, r = lane & 15, cq = (lane >> 4) * 4;
#pragma unroll
    for (int mt = 0; mt < MT; ++mt) {
      __builtin_amdgcn_sched_barrier(0);
      const int row = rbase + mt * 16 + r;
      bf16_t* dst = proj + (size_t)row * 4096 + cbase + cq;
      if (sec < 2) {
        const int pidx = row < 16384 ? (row & 2047) : 2048 + ((row - 16384) & 7);
        const float* ct = rope + pidx * 128 + cq;
        const float sc = sec == 1 ? 0.08838834764831845f : 1.f;
        float4 cc4[4], ss4[4];
#pragma unroll
        for (int nt = 0; nt < 4; ++nt) { cc4[nt] = *(const float4*)(ct + nt * 16); ss4[nt] = *(const float4*)(ct + 64 + nt * 16); }
#pragma unroll
        for (int nt = 0; nt < 4; ++nt) {
          const float4 c4 = cc4[nt], s4 = ss4[nt];
          const f32x4 x1 = acc[mt][nt], x2 = acc[mt][nt + 4];
          store4bf(dst + nt * 16, (x1[0] * c4.x - x2[0] * s4.x) * sc, (x1[1] * c4.y - x2[1] * s4.y) * sc, (x1[2] * c4.z - x2[2] * s4.z) * sc, (x1[3] * c4.w - x2[3] * s4.w) * sc);
          store4bf(dst + 64 + nt * 16, (x1[0] * s4.x + x2[0] * c4.x) * sc, (x1[1] * s4.y + x2[1] * c4.y) * sc, (x1[2] * s4.z + x2[2] * c4.z) * sc, (x1[3] * s4.w + x2[3] * c4.w) * sc);
        }
      } else if (sec == 5) {
        float4 ll4[8];
#pragma unroll
        for (int nt = 0; nt < 8; ++nt) ll4[nt] = *(const float4*)(lb + head * 128 + nt * 16 + cq);
#pragma unroll
        for (int nt = 0; nt < 8; ++nt) {
          const float4 l4 = ll4[nt];
          const f32x4 x = acc[mt][nt];
          store4bf(dst + nt * 16, __logf(l4.x + (1.f - l4.x) * sigm(x[0])), __logf(l4.y + (1.f - l4.y) * sigm(x[1])), __logf(l4.z + (1.f - l4.z) * sigm(x[2])), __logf(l4.w + (1.f - l4.w) * sigm(x[3])));
        }
      } else {
#pragma unroll
        for (int nt = 0; nt < 8; ++nt) { const f32x4 x = acc[mt][nt]; store4bf(dst + nt * 16, x[0], x[1], x[2], x[3]); }
      }
    }
  }
};
struct EpiOut {
  bf16_t* t0; float* rowss;
  template <int MT> __device__ __forceinline__ void operator()(f32x4 (&acc)[MT][8], int rbase, int cbase, int lane) const {
    const int r = lane & 15, cq = (lane >> 4) * 4;
#pragma unroll
    for (int mt = 0; mt < MT; ++mt) {
      __builtin_amdgcn_sched_barrier(0);
      const int row = rbase + mt * 16 + r;
      bf16_t* dst = t0 + (size_t)row * 1024 + cbase + cq;
      float ss = 0.f;
#pragma unroll
      for (int nt = 0; nt < 8; ++nt) { const f32x4 x = acc[mt][nt]; ss += x[0] * x[0] + x[1] * x[1] + x[2] * x[2] + x[3] * x[3]; store4bf(dst + nt * 16, x[0], x[1], x[2], x[3]); }
      ss += shx(ss, 16); ss += shx(ss, 32);
      if (lane < 16) atomicAdd(rowss + row, ss * (1.f / REPG));
    }
  }
};
struct EpiUp {
  bf16_t* act;
  template <int MT> __device__ __forceinline__ void operator()(f32x4 (&acc)[MT][8], int rbase, int cbase, int lane) const {
    const int r = lane & 15, cq = (lane >> 4) * 4;
#pragma unroll
    for (int mt = 0; mt < MT; ++mt) {
      __builtin_amdgcn_sched_barrier(0);
      bf16_t* dst = act + (size_t)(rbase + mt * 16 + r) * 4096 + cbase + cq;
#pragma unroll
      for (int nt = 0; nt < 8; ++nt) { f32x4 x = acc[mt][nt];
#pragma unroll
        for (int j = 0; j < 4; ++j) { float v = fmaxf(x[j], 0.f); x[j] = v * v; }
        store4bf(dst + nt * 16, x[0], x[1], x[2], x[3]); }
    }
  }
};
struct EpiInOdd {
  bf16_t* proj; float* dtbuf;
  template <int MT> __device__ __forceinline__ void operator()(f32x4 (&acc)[MT][8], int rbase, int cbase, int lane) const {
    const int r = lane & 15, cq = (lane >> 4) * 4;
#pragma unroll
    for (int mt = 0; mt < MT; ++mt) {
      __builtin_amdgcn_sched_barrier(0);
      const int row = rbase + mt * 16 + r;
      bf16_t* dst = proj + (size_t)row * 3200 + cbase + cq;
#pragma unroll
      for (int nt = 0; nt < 8; ++nt) { const f32x4 x = acc[mt][nt]; if (cbase + nt * 16 < 3200) store4bf(dst + nt * 16, x[0], x[1], x[2], x[3]); }
      if (cbase == 2560) { const f32x4 x = acc[mt][0]; *(float4*)(dtbuf + (size_t)row * 16 + cq) = make_float4(x[0], x[1], x[2], x[3]); }
    }
  }
};
struct EpiGlu {
  const bf16_t* gbuf; const float* bglu; bf16_t* mix;
  template <int MT> __device__ __forceinline__ void operator()(f32x4 (&acc)[MT][8], int rbase, int cbase, int lane) const {
    const int r = lane & 15, cq = (lane >> 4) * 4;
#pragma unroll
    for (int mt = 0; mt < MT; ++mt) {
      __builtin_amdgcn_sched_barrier(0);
      const int row = rbase + mt * 16 + r;
      uint2 gg2[8]; float4 bb4[8];
#pragma unroll
      for (int nt = 0; nt < 8; ++nt) { const int col = cbase + nt * 16 + cq; gg2[nt] = *(const uint2*)(gbuf + (size_t)row * 512 + col); bb4[nt] = *(const float4*)(bglu + col); }
#pragma unroll
      for (int nt = 0; nt < 8; ++nt) {
        const int col = cbase + nt * 16 + cq;
        const f32x4 x = acc[mt][nt];
        const uint2 g2 = gg2[nt];
        const float4 b4 = bb4[nt];
        store4bf(mix + (size_t)row * 1536 + 1024 + col, lo2f(g2.x) * sigm(x[0] + b4.x), hi2f(g2.x) * sigm(x[1] + b4.y), lo2f(g2.y) * sigm(x[2] + b4.z), hi2f(g2.y) * sigm(x[3] + b4.w));
      }
    }
  }
};

template <class Epi>
__device__ __forceinline__ void gemm_tail(const bf16_t* A, int lda, const bf16_t* Bt, int ldb, int nNt128, int K, const Epi& epi, char* smem, int wvs, int nBig) {
  bf16_t* As = (bf16_t*)smem;
  bf16_t* Bs = As + 2 * 128 * 80;
  int tid_ = TIDX(wvs); asm volatile("" : "+v"(tid_)); const int tid = tid_, lane = tid & 63, wave = tid >> 6;
  const int nk = K >> 6, G = gridDim.x;
  const int lrow = tid >> 3, lcc = (tid & 7) * 8;
  const unsigned toffA = (unsigned)(lrow * lda + lcc), toffB = (unsigned)(lrow * ldb + lcc);
  const int rr = nBig % G, nLight = G - rr;
  const int nSmall = 8 * nNt128;
  if ((int)blockIdx.x >= rr) {
    for (int j = (int)blockIdx.x - rr; j < nSmall; j += nLight) {
      const int pm = j / nNt128, pn = j - pm * nNt128;
      const bf16_t* Ab = A + (size_t)(16384 + pm * 128) * lda;
      const bf16_t* Bb = Bt + (size_t)(pn * 128) * ldb;
      f32x4 acc[1][8];
#pragma unroll
      for (int q = 0; q < 8; ++q) acc[0][q] = (f32x4){0.f, 0.f, 0.f, 0.f};
      u32x4 ra[2], rb[2];
#pragma unroll
      for (int i = 0; i < 2; ++i) { ra[i] = *(const u32x4*)(Ab + (size_t)(i * 64) * lda + toffA); rb[i] = *(const u32x4*)(Bb + (size_t)(i * 64) * ldb + toffB); }
#pragma unroll
      for (int i = 0; i < 2; ++i) { *(u32x4*)(As + (lrow + i * 64) * 80 + lcc) = ra[i]; *(u32x4*)(Bs + (lrow + i * 64) * 80 + lcc) = rb[i]; }
      __syncthreads();
#pragma unroll 1
      for (int kt = 0; kt < nk; ++kt) {
        const int cur = kt & 1;
        const int kn = (kt + 1 < nk ? kt + 1 : kt) * 64;
#pragma unroll
        for (int i = 0; i < 2; ++i) { ra[i] = *(const u32x4*)(Ab + ((size_t)(i * 64) * lda + kn) + toffA); rb[i] = *(const u32x4*)(Bb + ((size_t)(i * 64) * ldb + kn) + toffB); }
        __builtin_amdgcn_sched_barrier(0);
        wmma_sw<1, 8>(acc, As + cur * 128 * 80 + wave * 16 * 80, 80, Bs + cur * 128 * 80, 80, 64, lane);
        __builtin_amdgcn_sched_barrier(0);
        bf16_t* Ad = As + (cur ^ 1) * 128 * 80; bf16_t* Bd = Bs + (cur ^ 1) * 128 * 80;
#pragma unroll
        for (int i = 0; i < 2; ++i) { *(u32x4*)(Ad + (lrow + i * 64) * 80 + lcc) = ra[i]; *(u32x4*)(Bd + (lrow + i * 64) * 80 + lcc) = rb[i]; }
        __syncthreads();
      }
      int er_ = 16384 + pm * 128 + wave * 16, ec_ = pn * 128, el_ = lane;
      asm volatile("" : "+v"(er_), "+v"(ec_), "+v"(el_));
      epi(acc, er_, ec_, el_);
    }
  }
}

__device__ __forceinline__ void rowpass_phase(const bf16_t* t0, const float* rowss, const float* wpost, const float* hin_a, const float* hin_b, float* hout, const float* wnext, bf16_t* hn, int wvs) {
  int tq_ = TIDX(wvs); asm volatile("" : "+v"(tq_)); const int lane = tq_ & 63, gw = blockIdx.x * 8 + (tq_ >> 6), nw = gridDim.x * 8;
  for (int row = gw; row < ROWS; row += nw) {
    const float* hin = row < 16384 ? hin_a + (size_t)row * 1024 : hin_b + (size_t)(row - 16384) * 1024;
    float r0 = 0.f;
    if (t0) r0 = rsqrtf(rowss[row] * (1.f / 1024.f) + EPSV);
    float4 v[4]; float ss = 0.f;
    float4 hvv[4], wpv[4], wnv[4]; uint2 tv[4];
#pragma unroll
    for (int i = 0; i < 4; ++i) {
      const int col = (i * 64 + lane) * 4;
      hvv[i] = *(const float4*)(hin + col);
      if (t0) { tv[i] = *(const uint2*)(t0 + (size_t)row * 1024 + col); wpv[i] = *(const float4*)(wpost + col); }
      if (hn) wnv[i] = *(const float4*)(wnext + col);
    }
#pragma unroll
    for (int i = 0; i < 4; ++i) {
      const int col = (i * 64 + lane) * 4;
      float4 hv = hvv[i];
      if (t0) {
        const uint2 t2 = tv[i];
        const float4 w4 = wpv[i];
        hv.x += lo2f(t2.x) * r0 * w4.x; hv.y += hi2f(t2.x) * r0 * w4.y; hv.z += lo2f(t2.y) * r0 * w4.z; hv.w += hi2f(t2.y) * r0 * w4.w;
      }
      v[i] = hv; ss += hv.x * hv.x + hv.y * hv.y + hv.z * hv.z + hv.w * hv.w;
      if (hout) *(float4*)(hout + (size_t)row * 1024 + col) = hv;
    }
    if (hn) {
#pragma unroll
      for (int o = 32; o >= 1; o >>= 1) ss += shx(ss, o);
      const float r1 = rsqrtf(ss * (1.f / 1024.f) + EPSV);
#pragma unroll
      for (int i = 0; i < 4; ++i) {
        const int col = (i * 64 + lane) * 4;
        const float4 w4 = wnv[i];
        store4bf(hn + (size_t)row * 1024 + col, v[i].x * r1 * w4.x, v[i].y * r1 * w4.y, v[i].z * r1 * w4.z, v[i].w * r1 * w4.w);
      }
    }
  }
}

__device__ __forceinline__ void wconv(const float* __restrict__ W, int K, int N, int Npad, bf16_t* __restrict__ Wt, char* smem, int wvs) {
  float* tile = (float*)smem;
  int tq_ = TIDX(wvs) & 255; asm volatile("" : "+v"(tq_)); const int tid = tq_;
  const int nNt = Npad >> 6, nunits = (K >> 6) * nNt;
  for (int u = blockIdx.x * 2 + (wvs >> 2); u < nunits; u += gridDim.x * 2) {
    const int k0 = (u / nNt) * 64, n0 = (u % nNt) * 64;
#pragma unroll
    for (int ps = 0; ps < 4; ++ps) {
      const int i = ps * 16 + (tid >> 4), j = (tid & 15) * 4, n = n0 + j;
      float4 v = make_float4(0.f, 0.f, 0.f, 0.f);
      if (n < N) v = *(const float4*)(W + (size_t)(k0 + i) * N + n);
      tile[i * 65 + j] = v.x; tile[i * 65 + j + 1] = v.y; tile[i * 65 + j + 2] = v.z; tile[i * 65 + j + 3] = v.w;
    }
    __syncthreads();
    {
      const int n = tid >> 2, kq = (tid & 3) * 16;
      uint4 o0, o1;
      o0.x = pack2(tile[(kq + 0) * 65 + n], tile[(kq + 1) * 65 + n]); o0.y = pack2(tile[(kq + 2) * 65 + n], tile[(kq + 3) * 65 + n]);
      o0.z = pack2(tile[(kq + 4) * 65 + n], tile[(kq + 5) * 65 + n]); o0.w = pack2(tile[(kq + 6) * 65 + n], tile[(kq + 7) * 65 + n]);
      o1.x = pack2(tile[(kq + 8) * 65 + n], tile[(kq + 9) * 65 + n]); o1.y = pack2(tile[(kq + 10) * 65 + n], tile[(kq + 11) * 65 + n]);
      o1.z = pack2(tile[(kq + 12) * 65 + n], tile[(kq + 13) * 65 + n]); o1.w = pack2(tile[(kq + 14) * 65 + n], tile[(kq + 15) * 65 + n]);
      bf16_t* d = Wt + (size_t)(n0 + n) * K + k0 + kq;
      *(uint4*)d = o0; *(uint4*)(d + 8) = o1;
    }
    __syncthreads();
  }
}

__device__ __forceinline__ void prep_tables(const Params& p, int wvs) {
  int tq_ = TIDX(wvs); asm volatile("" : "+v"(tq_)); const int gt = blockIdx.x * NTHR + tq_, nt = gridDim.x * NTHR;
  float* rope = (float*)(p.ws + OFF_ROPE);
  for (int i = gt; i < 2056 * 64; i += nt) {
    const int pi = i >> 6, f = i & 63;
    const double pos = pi < 2048 ? (double)pi : (double)(16384 + pi - 2048);
    const double invf = exp(-(double)f * (9.210340371976184 / 64.0));
    double ang = pos * invf;
    ang -= 6.283185307179586 * floor(ang * 0.15915494309189535);
    const float a = (float)ang;
    rope[pi * 128 + f] = cosf(a); rope[pi * 128 + 64 + f] = sinf(a);
  }
  float* z = (float*)(p.ws + OFF_ROWSS);
  for (int i = gt; i < ROWS * 6; i += nt) z[i] = 0.f;
  float* lb = (float*)(p.ws + OFF_LB);
  for (int i = gt; i < 512; i += nt) lb[i] = 1.f / (1.f + expf(p.hgrn_lb[512 + i] - p.hgrn_lb[i]));
  float* tab = (float*)(p.ws + OFF_S5TAB);
  for (int i = gt; i < 2048; i += nt) {
    const int g = i >> 6;
    const float lr = p.s5_lam_re[i], li = p.s5_lam_im[i], dt = expf(p.s5_log_step[g]);
    const float m1 = expf(lr * dt), br = m1 * cosf(li * dt), bi = m1 * sinf(li * dt);
    tab[i] = br; tab[2048 + i] = bi;
    const float m64 = expf(lr * dt * 64.f); tab[69632 + i] = m64 * cosf(li * dt * 64.f); tab[71680 + i] = m64 * sinf(li * dt * 64.f);
    const float m8 = expf(lr * dt * 8.f); tab[73728 + i] = m8 * cosf(li * dt * 8.f); tab[75776 + i] = m8 * sinf(li * dt * 8.f);
    const float x = br - 1.f, y = bi, den = 1.f / (lr * lr + li * li);
    const float qr = (x * lr + y * li) * den, qi = (y * lr - x * li) * den;
    for (int c = 0; c < 16; ++c) {
      const float b_r = p.s5_b_re[i * 16 + c], b_i = p.s5_b_im[i * 16 + c];
      tab[4096 + i * 16 + c] = qr * b_r - qi * b_i;
      tab[4096 + 32768 + i * 16 + c] = qr * b_i + qi * b_r;
    }
  }
}

__device__ __forceinline__ void chunk_geom(int c, int& row0, int& L) { if (c < 256) { row0 = c * 64; L = 64; } else { row0 = 16384 + (c - 256) * 8; L = 8; } }

template <int MODE>
__device__ __forceinline__ void st_load(uint4 (&kr)[4], uint4 (&vr)[1], float& dtr, const bf16_t* src, const float* dtbuf, int row0, int L, int ld, int kcol, int vcol, int h, int tid) {
  constexpr int PW = 32, NVC = PW / 32, VCR = PW / 8;
  const uint4 z4 = make_uint4(0, 0, 0, 0);
#pragma unroll
  for (int i = 0; i < 4; ++i) { const int id = tid + i * 256, s = id >> 4, c8 = id & 15; uint4 t_ = z4; if (s < L) t_ = *(const uint4*)(src + (size_t)(row0 + s) * ld + kcol + c8 * 8); kr[i] = t_; }
#pragma unroll
  for (int i = 0; i < NVC; ++i) { const int id = tid + i * 256, s = id / VCR, c8 = id % VCR; uint4 t_ = z4; if (s < L) t_ = *(const uint4*)(src + (size_t)(row0 + s) * ld + vcol + c8 * 8); vr[i] = t_; }
  if (MODE == 2 && tid < 64) dtr = tid < L ? dtbuf[(size_t)(row0 + tid) * 16 + h] : 0.f;
}

template <int MODE>
__device__ __forceinline__ void state_unit(const Params& p, int sq, int h, int ps, char* smem, int wvs) {
  constexpr int PW = 32, NT = PW / 16, PF = (MODE == 2) ? 64 : 128, HH = (MODE == 2) ? 16 : 4, NVC = PW / 32, VCR = PW / 8;
  bf16_t* KT = (bf16_t*)smem;
  bf16_t* VT = KT + 128 * 80;
  bf16_t* KR = VT + 64 * 80;
  float* tot = (float*)(KR + 64 * 136);
  float* dec = tot + 256;
  float* av = dec + 64;
  float* dtv = av + 64;
  int tid_ = TIDX(wvs) & 255; asm volatile("" : "+v"(tid_)); const int tid = tid_, lane = tid & 63, wave = tid >> 6;
  const bool prompt = sq < 8;
  const int nch = prompt ? 32 : 1, L = prompt ? 64 : 8;
  const int ld = (MODE == 2) ? 1536 : 4096;
  const bf16_t* src = (MODE == 2) ? (const bf16_t*)(p.ws + OFF_H) : (const bf16_t*)(p.ws + OFF_A);
  const int kcol = MODE == 0 ? 512 + h * 128 : MODE == 1 ? 2560 + h * 128 : 1024 + (h >> 3) * 128;
  const int vcol = MODE == 0 ? 1024 + h * 128 + ps * 32 : MODE == 1 ? 3072 + h * 128 + ps * 32 : h * 64 + ps * 32;
  const float* sin_ = MODE == 0 ? p.state_ret : MODE == 1 ? p.state_hgrn : p.state_ssm;
  float* sout = p.out + (MODE == 0 ? O_RET : MODE == 1 ? O_HG : O_SSM) + (size_t)(sq * HH + h) * 128 * PF;
  bf16_t* stb = (bf16_t*)(p.ws + OFF_ST) + (MODE == 1 ? (size_t)256 * 4 * 128 * 128 : 0);
  const float* dtbuf = (const float*)(p.ws + OFF_DTBUF);
  const float l2g = MODE == 0 ? log2f(1.f - exp2f(-5.f - (float)h)) : 0.f;
  float Ah = 0.f, dtb = 0.f;
  if (MODE == 2) { Ah = -expf(p.a_log[h]); dtb = p.dt_bias[h]; }

  f32x4 acc[2][NT];
  const int nb = wave * 32 + (lane >> 4) * 4, pc = ps * PW + (lane & 15);
#pragma unroll
  for (int mt = 0; mt < 2; ++mt)
#pragma unroll
    for (int nt = 0; nt < NT; ++nt)
#pragma unroll
      for (int j = 0; j < 4; ++j)
        acc[mt][nt][j] = prompt ? 0.f : sin_[((size_t)((sq - 8) * HH + h) * 128 + nb + mt * 16 + j) * PF + pc + nt * 16];

  uint4 kr[4], vr[NVC]; float dtr = 0.f;
  const uint4 z4 = make_uint4(0, 0, 0, 0);
  st_load<MODE>(kr, vr, dtr, src, dtbuf, prompt ? sq * 2048 : 16384 + (sq - 8) * 8, L, ld, kcol, vcol, h, tid);
  for (int n = 0; n < nch; ++n) {
    if (prompt) {
      bf16_t* d = stb + ((size_t)((sq * 32 + n) * HH + h) * PF) * 128;
#pragma unroll
      for (int mt = 0; mt < 2; ++mt)
#pragma unroll
        for (int nt = 0; nt < NT; ++nt) store4bf(d + (size_t)(pc + nt * 16) * 128 + nb + mt * 16, acc[mt][nt][0], acc[mt][nt][1], acc[mt][nt][2], acc[mt][nt][3]);
    }
#pragma unroll
    for (int i = 0; i < 4; ++i) { const int id = tid + i * 256, s = id >> 4, c8 = id & 15; *(uint4*)(KR + s * 136 + c8 * 8) = kr[i]; }
#pragma unroll
    for (int i = 0; i < NVC; ++i) {
      const int id = tid + i * 256, s = id / VCR, c8 = id % VCR; const uint4 v = vr[i];
      bf16_t* d = VT + (c8 * 8) * 80 + s;
      d[0] = (bf16_t)(v.x & 0xffff); d[80] = (bf16_t)(v.x >> 16); d[160] = (bf16_t)(v.y & 0xffff); d[240] = (bf16_t)(v.y >> 16);
      d[320] = (bf16_t)(v.z & 0xffff); d[400] = (bf16_t)(v.z >> 16); d[480] = (bf16_t)(v.w & 0xffff); d[560] = (bf16_t)(v.w >> 16);
    }
    if (MODE == 2 && tid < 64) {
      float dt = 0.f;
      if (tid < L) { const float x = dtr + dtb; dt = x > 20.f ? x : log1pf(__expf(x)); }
      dtv[tid] = dt; av[tid] = dt * Ah;
    }
    if (n + 1 < nch) st_load<MODE>(kr, vr, dtr, src, dtbuf, sq * 2048 + (n + 1) * 64, L, ld, kcol, vcol, h, tid);
    __syncthreads();
    const int kn = tid & 127, half = tid >> 7;
    if (MODE == 1) {
      float s_ = 0.f;
#pragma unroll 8
      for (int s = half * 32; s < half * 32 + 32; ++s) s_ += bf2f(KR[s * 136 + kn]);
      tot[half * 128 + kn] = s_;
    }
    if (MODE == 2 && tid < 64) {
      const float a_ = av[tid];
      const float sinc = wave_suffix_incl(a_);
      dec[tid] = __expf(sinc - a_) * dtv[tid];
      if (tid == 0) tot[0] = sinc;
    }
    if (MODE != 0) __syncthreads();
    {
      float suf = 0.f;
      if (MODE == 1) suf = half == 0 ? __expf(tot[128 + kn]) : 1.f;
      for (int g = 3; g >= 0; --g) {
        const int s0 = half * 32 + g * 8;
        float v[8];
#pragma unroll
        for (int e = 7; e >= 0; --e) {
          const int s = s0 + e;
          const float raw = bf2f(KR[s * 136 + kn]);
          if (MODE == 0) v[e] = raw * exp2f((float)(L - 1 - s) * l2g);
          else if (MODE == 1) { const float f_ = __expf(raw); v[e] = (1.f - f_) * suf; suf *= f_; }
          else v[e] = raw * dec[s];
        }
        uint4 o; o.x = pack2(v[0], v[1]); o.y = pack2(v[2], v[3]); o.z = pack2(v[4], v[5]); o.w = pack2(v[6], v[7]);
        *(uint4*)(KT + kn * 80 + s0) = o;
      }
    }
    __syncthreads();
#pragma unroll
    for (int mt = 0; mt < 2; ++mt) {
      float dk[4];
      if (MODE == 0) { const float d = exp2f((float)L * l2g); dk[0] = dk[1] = dk[2] = dk[3] = d; }
      else if (MODE == 2) { const float d = __expf(tot[0]); dk[0] = dk[1] = dk[2] = dk[3] = d; }
      else {
#pragma unroll
        for (int j = 0; j < 4; ++j) { const int nn = nb + mt * 16 + j; dk[j] = __expf(tot[nn] + tot[128 + nn]); }
      }
#pragma unroll
      for (int nt = 0; nt < NT; ++nt)
#pragma unroll
        for (int j = 0; j < 4; ++j) acc[mt][nt][j] *= dk[j];
    }
    wmma_ns<2, NT>(acc, KT + wave * 32 * 80, 80, VT, 80, 64, lane);
    __syncthreads();
  }
#pragma unroll
  for (int mt = 0; mt < 2; ++mt)
#pragma unroll
    for (int nt = 0; nt < NT; ++nt)
#pragma unroll
      for (int j = 0; j < 4; ++j) sout[(size_t)(nb + mt * 16 + j) * PF + pc + nt * 16] = acc[mt][nt][j];
}

template <int MODE>
__device__ __forceinline__ void out_unit(const Params& p, int c, int h, char* smem, int wvs) {
  constexpr int PF = (MODE == 2) ? 64 : 128, NTP = PF / 16, HH = (MODE == 2) ? 16 : 4, NVC = PF / 32, VCR = PF / 8;
  bf16_t* Q = (bf16_t*)smem;
  bf16_t* Kb = Q + 64 * 136;
  bf16_t* STb = Kb + 128 * 80;
  float* cumv = (float*)(STb + 128 * 136);
  float* dtv = cumv + 64;
  float* av = dtv + 64;
  float* tot = av + 64;
  int tid_ = TIDX(wvs) & 255; asm volatile("" : "+v"(tid_)); const int tid = tid_, lane = tid & 63, wave = tid >> 6;
  int row0, L; chunk_geom(c, row0, L);
  const int ld = (MODE == 2) ? 1536 : 4096;
  const bf16_t* src = (MODE == 2) ? (const bf16_t*)(p.ws + OFF_H) : (const bf16_t*)(p.ws + OFF_A);
  const int qcol = MODE == 0 ? h * 128 : MODE == 1 ? 2048 + h * 128 : 1280 + (h >> 3) * 128;
  const int kcol = MODE == 0 ? 512 + h * 128 : MODE == 1 ? 2560 + h * 128 : 1024 + (h >> 3) * 128;
  const int vcol = MODE == 0 ? 1024 + h * 128 : MODE == 1 ? 3072 + h * 128 : h * 64;
  const float l2g = MODE == 0 ? log2f(1.f - exp2f(-5.f - (float)h)) : 0.f;
  const uint4 z4 = make_uint4(0, 0, 0, 0);
#pragma unroll
  for (int i = 0; i < 4; ++i) {
    const int id = tid + i * 256, s = id >> 4, c8 = id & 15;
    uint4 q4 = z4, k4 = z4;
    if (s < L) { q4 = *(const uint4*)(src + (size_t)(row0 + s) * ld + qcol + c8 * 8); k4 = *(const uint4*)(src + (size_t)(row0 + s) * ld + kcol + c8 * 8); }
    *(uint4*)(Q + s * 136 + c8 * 8) = q4; *(uint4*)(Kb + s * 136 + c8 * 8) = k4;
  }
  uint4 vr[NVC];
#pragma unroll
  for (int i = 0; i < NVC; ++i) { const int id = tid + i * 256, s = id / VCR, c8 = id % VCR; uint4 t_ = z4; if (s < L) t_ = *(const uint4*)(src + (size_t)(row0 + s) * ld + vcol + c8 * 8); vr[i] = t_; }
  if (c < 256) {
    const bf16_t* stg = (const bf16_t*)(p.ws + OFF_ST) + (MODE == 1 ? (size_t)256 * 4 * 128 * 128 : 0) + ((size_t)(c * HH + h) * PF) * 128;
#pragma unroll
    for (int i = 0; i < PF / 16; ++i) { const int id = tid + i * 256, pr = id >> 4, c8 = id & 15; *(uint4*)(STb + pr * 136 + c8 * 8) = *(const uint4*)(stg + (size_t)pr * 128 + c8 * 8); }
  } else {
    const float* sg = (MODE == 0 ? p.state_ret : MODE == 1 ? p.state_hgrn : p.state_ssm) + (size_t)((c - 256) * HH + h) * 128 * PF;
    for (int idb = tid; idb < 128 * (PF / 4); idb += 1024) {
      float4 v4[4];
#pragma unroll
      for (int q = 0; q < 4; ++q) { const int id = idb + q * 256, n = id / (PF / 4), p4 = (id % (PF / 4)) * 4; v4[q] = *(const float4*)(sg + (size_t)n * PF + p4); }
#pragma unroll
      for (int q = 0; q < 4; ++q) {
        const int id = idb + q * 256, n = id / (PF / 4), p4 = (id % (PF / 4)) * 4; const float4 v = v4[q];
        STb[(p4 + 0) * 136 + n] = f2bf(v.x); STb[(p4 + 1) * 136 + n] = f2bf(v.y); STb[(p4 + 2) * 136 + n] = f2bf(v.z); STb[(p4 + 3) * 136 + n] = f2bf(v.w);
      }
    }
  }
  if (MODE == 2 && tid < 64) {
    float dt = 0.f;
    if (tid < L) { const float x = ((const float*)(p.ws + OFF_DTBUF))[(size_t)(row0 + tid) * 16 + h] + p.dt_bias[h]; dt = x > 20.f ? x : log1pf(__expf(x)); }
    dtv[tid] = dt; av[tid] = -expf(p.a_log[h]) * dt;
  }
  __syncthreads();
  if (MODE == 1) {
    const int kn = tid & 127, half = tid >> 7;
    float s_ = 0.f;
#pragma unroll 8
    for (int s = half * 32; s < half * 32 + 32; ++s) s_ += bf2f(Kb[s * 136 + kn]);
    tot[half * 128 + kn] = s_;
    __syncthreads();
    float cum = half == 1 ? tot[kn] : 0.f;
    for (int sg = half * 32; sg < half * 32 + 32; sg += 8) {
      float lfv[8], qv[8];
#pragma unroll
      for (int e = 0; e < 8; ++e) { lfv[e] = bf2f(Kb[(sg + e) * 136 + kn]); qv[e] = bf2f(Q[(sg + e) * 136 + kn]); }
#pragma unroll
      for (int e = 0; e < 8; ++e) {
        cum += lfv[e];
        Q[(sg + e) * 136 + kn] = f2bf(qv[e] * __expf(cum));
        Kb[(sg + e) * 136 + kn] = f2bf((1.f - __expf(lfv[e])) * __expf(-cum));
      }
    }
    __syncthreads();
  }
  if (MODE == 2) {
    if (tid < 64) cumv[tid] = wave_prefix_incl(av[tid]);
    __syncthreads();
  }
  f32x4 ai[1][NTP], asc[1][4];
#pragma unroll
  for (int j = 0; j < NTP; ++j) ai[0][j] = (f32x4){0.f, 0.f, 0.f, 0.f};
#pragma unroll
  for (int j = 0; j < 4; ++j) asc[0][j] = (f32x4){0.f, 0.f, 0.f, 0.f};
  wmma_sw<1, NTP>(ai, Q + wave * 16 * 136, 136, STb, 136, 128, lane);
  wmma_sw<1, 4>(asc, Q + wave * 16 * 136, 136, Kb, 136, 128, lane);
  const int t = wave * 16 + (lane & 15), sq4 = (lane >> 4) * 4;
  float ct = 0.f;
  if (MODE == 2) ct = cumv[t];
#pragma unroll
  for (int nt = 0; nt < 4; ++nt)
#pragma unroll
    for (int j = 0; j < 4; ++j) {
      const int s = nt * 16 + sq4 + j;
      float v = asc[0][nt][j];
      if (s > t) v = 0.f;
      else if (MODE == 0) v *= exp2f((float)(t - s) * l2g);
      else if (MODE == 2) v *= __expf(ct - cumv[s]) * dtv[s];
      asc[0][nt][j] = v;
    }
  __syncthreads();
  bf16_t* Pb = STb; bf16_t* VT = Kb;
#pragma unroll
  for (int nt = 0; nt < 4; ++nt) store4bf(Pb + t * 80 + nt * 16 + sq4, asc[0][nt][0], asc[0][nt][1], asc[0][nt][2], asc[0][nt][3]);
#pragma unroll
  for (int i = 0; i < NVC; ++i) {
    const int id = tid + i * 256, s = id / VCR, c8 = id % VCR; const uint4 v = vr[i];
    bf16_t* d = VT + (c8 * 8) * 80 + s;
    d[0] = (bf16_t)(v.x & 0xffff); d[80] = (bf16_t)(v.x >> 16); d[160] = (bf16_t)(v.y & 0xffff); d[240] = (bf16_t)(v.y >> 16);
    d[320] = (bf16_t)(v.z & 0xffff); d[400] = (bf16_t)(v.z >> 16); d[480] = (bf16_t)(v.w & 0xffff); d[560] = (bf16_t)(v.w >> 16);
  }
  __syncthreads();
  f32x4 ao[1][NTP];
#pragma unroll
  for (int j = 0; j < NTP; ++j) ao[0][j] = (f32x4){0.f, 0.f, 0.f, 0.f};
  wmma_sw<1, NTP>(ao, Pb + wave * 16 * 80, 80, VT, 80, 64, lane);
  float fi = 1.f;
  if (MODE == 0) fi = exp2f((float)(t + 1) * l2g);
  if (MODE == 2) fi = __expf(ct);
  const int row = row0 + t;
  const bool valid = t < L;
  if (MODE == 0 || MODE == 1) {
    float s1 = 0.f, s2 = 0.f;
#pragma unroll
    for (int nt = 0; nt < NTP; ++nt)
#pragma unroll
      for (int j = 0; j < 4; ++j) { const float o = ao[0][nt][j] + fi * ai[0][nt][j]; ao[0][nt][j] = o; s1 += o; s2 += o * o; }
    s1 += shx(s1, 16); s1 += shx(s1, 32); s2 += shx(s2, 16); s2 += shx(s2, 32);
    float mu = 0.f, rs;
    if (MODE == 0) { mu = s1 * (1.f / 128.f); const float var = fmaxf(s2 * (1.f / 128.f) - mu * mu, 0.f); rs = rsqrtf(var + EPSV); }
    else rs = rsqrtf(s2 * (1.f / 128.f) + EPSV);
    if (valid) {
      const float* nw = (MODE == 0 ? p.ret_norm_w : p.hgrn_norm_w) + h * 128;
      const int gcol = (MODE == 0 ? 1536 : 3584) + h * 128;
      bf16_t* mix = (bf16_t*)(p.ws + OFF_H) + (size_t)row * 1024 + (MODE == 0 ? 0 : 512) + h * 128;
      float4 ww4[NTP]; uint2 gg2[NTP];
#pragma unroll
      for (int nt = 0; nt < NTP; ++nt) { const int pp = nt * 16 + sq4; ww4[nt] = *(const float4*)(nw + pp); gg2[nt] = *(const uint2*)(src + (size_t)row * ld + gcol + pp); }
#pragma unroll
      for (int nt = 0; nt < NTP; ++nt) {
        const int pp = nt * 16 + sq4;
        const float4 w4 = ww4[nt];
        const uint2 g2 = gg2[nt];
        store4bf(mix + pp, (ao[0][nt][0] - mu) * rs * w4.x * siluf(lo2f(g2.x)), (ao[0][nt][1] - mu) * rs * w4.y * siluf(hi2f(g2.x)),
                 (ao[0][nt][2] - mu) * rs * w4.z * siluf(lo2f(g2.y)), (ao[0][nt][3] - mu) * rs * w4.w * siluf(hi2f(g2.y)));
      }
    }
  } else {
    const float Dh = p.d_ssm[h];
    bf16_t* zy = (bf16_t*)(p.ws + OFF_A) + (size_t)row * 3200 + h * 64;
    float s2 = 0.f;
    if (valid) {
      uint2 xx2[NTP], zz2[NTP];
#pragma unroll
      for (int nt = 0; nt < NTP; ++nt) { const int pp = nt * 16 + sq4; xx2[nt] = *(const uint2*)(src + (size_t)row * ld + vcol + pp); zz2[nt] = *(const uint2*)(zy + pp); }
#pragma unroll
      for (int nt = 0; nt < NTP; ++nt) {
        const int pp = nt * 16 + sq4;
        const uint2 x2 = xx2[nt];
        const uint2 z2 = zz2[nt];
        const float y0 = (ao[0][nt][0] + fi * ai[0][nt][0] + Dh * lo2f(x2.x)) * siluf(lo2f(z2.x));
        const float y1 = (ao[0][nt][1] + fi * ai[0][nt][1] + Dh * hi2f(x2.x)) * siluf(hi2f(z2.x));
        const float y2 = (ao[0][nt][2] + fi * ai[0][nt][2] + Dh * lo2f(x2.y)) * siluf(lo2f(z2.y));
        const float y3 = (ao[0][nt][3] + fi * ai[0][nt][3] + Dh * hi2f(x2.y)) * siluf(hi2f(z2.y));
        s2 += y0 * y0 + y1 * y1 + y2 * y2 + y3 * y3;
        store4bf(zy + pp, y0, y1, y2, y3);
      }
    }
    s2 += shx(s2, 16); s2 += shx(s2, 32);
    if (valid && lane < 16) atomicAdd((float*)(p.ws + OFF_SSDST) + (size_t)row * 2 + (h >> 3), s2);
  }
  __syncthreads();
}

template <int OUT>
__device__ __forceinline__ void s5_unit(const Params& p, int c, int gq, char* smem, int wvs) {
  float* Uf = (float*)smem;
  bf16_t* HSall = (bf16_t*)(smem + 16384);
  bf16_t* CMall = (bf16_t*)(smem + 16384 + 34816);
  int tid_ = TIDX(wvs) & 255; asm volatile("" : "+v"(tid_)); const int tid = tid_, lane = tid & 63, wave = tid >> 6;
  int row0, L; chunk_geom(c, row0, L);
  const bf16_t* proj = (const bf16_t*)(p.ws + OFF_A);
#pragma unroll
  for (int i = 0; i < 2; ++i) {
    const int id = tid + i * 256, s = id >> 3, c8 = id & 7;
    uint4 v = make_uint4(0, 0, 0, 0);
    if (s < L) v = *(const uint4*)(proj + (size_t)(row0 + s) * 3200 + 2576 + gq * 64 + c8 * 8);
    float* d = Uf + s * 64 + c8 * 8;
    d[0] = lo2f(v.x); d[1] = hi2f(v.x); d[2] = lo2f(v.y); d[3] = hi2f(v.y); d[4] = lo2f(v.z); d[5] = hi2f(v.z); d[6] = lo2f(v.w); d[7] = hi2f(v.w);
  }
  const int g = gq * 4 + wave, gp = g * 64 + lane;
  const float* tab = (const float*)(p.ws + OFF_S5TAB);
  const float lr = tab[gp], li = tab[2048 + gp];
  f32x2 bb2[16];
#pragma unroll
  for (int q = 0; q < 4; ++q) {
    const float4 a = *(const float4*)(tab + 4096 + gp * 16 + q * 4), b = *(const float4*)(tab + 4096 + 32768 + gp * 16 + q * 4);
    bb2[q * 4] = (f32x2){a.x, b.x}; bb2[q * 4 + 1] = (f32x2){a.y, b.y}; bb2[q * 4 + 2] = (f32x2){a.z, b.z}; bb2[q * 4 + 3] = (f32x2){a.w, b.w};
  }
  float hr = 0.f, hi = 0.f;
  bf16_t* HS = HSall + wave * 32 * 136; bf16_t* CM = CMall + wave * 16 * 136;
  if (OUT) {
    const float2 h0 = *(const float2*)((const float*)(p.ws + OFF_S5H) + ((size_t)c * 2048 + gp) * 2);
    hr = h0.x; hi = h0.y;
#pragma unroll
    for (int ch = 0; ch < 16; ++ch) { CM[ch * 136 + lane] = f2bf(p.s5_c_re[(g * 16 + ch) * 64 + lane]); CM[ch * 136 + 64 + lane] = f2bf(-p.s5_c_im[(g * 16 + ch) * 64 + lane]); }
  }
  __syncthreads();
  const int nhalf = OUT ? ((L + 31) >> 5) : 1, tl = OUT ? 32 : L;
  for (int hf = 0; hf < nhalf; ++hf) {
#pragma unroll 4
    for (int tt = 0; tt < tl; ++tt) {
      const int t = hf * 32 + tt;
      {
        const float* up = Uf + t * 64 + wave * 16;
        f32x2 b0 = (f32x2){0.f, 0.f}, b1 = (f32x2){0.f, 0.f};
#pragma unroll
        for (int q = 0; q < 4; ++q) {
          const f32x4 u4 = *(const f32x4*)(up + q * 4);
          b0 += bb2[q * 4] * u4[0]; b1 += bb2[q * 4 + 1] * u4[1]; b0 += bb2[q * 4 + 2] * u4[2]; b1 += bb2[q * 4 + 3] * u4[3];
        }
        b0 += b1;
        const float nr = lr * hr - li * hi + b0[0], ni = lr * hi + li * hr + b0[1];
        if (t < L) { hr = nr; hi = ni; }
      }
      if (OUT) { HS[tt * 136 + lane] = f2bf(t < L ? hr : 0.f); HS[tt * 136 + 64 + lane] = f2bf(t < L ? hi : 0.f); }
    }
    if (OUT) {
      __syncthreads();
      f32x4 ay[2][1];
      ay[0][0] = (f32x4){0.f, 0.f, 0.f, 0.f}; ay[1][0] = (f32x4){0.f, 0.f, 0.f, 0.f};
      wmma_sw<2, 1>(ay, HS, 136, CM, 136, 128, lane);
      bf16_t* gbuf = (bf16_t*)(p.ws + OFF_GBUF);
#pragma unroll
      for (int mt = 0; mt < 2; ++mt) {
        const int t = hf * 32 + mt * 16 + (lane & 15), ch0 = (lane >> 4) * 4;
        if (t < L) {
          const float4 u4 = *(const float4*)(Uf + t * 64 + wave * 16 + ch0);
          const float4 d4 = *(const float4*)(p.s5_d + g * 16 + ch0);
          float y[4] = {ay[mt][0][0] + d4.x * u4.x, ay[mt][0][1] + d4.y * u4.y, ay[mt][0][2] + d4.z * u4.z, ay[mt][0][3] + d4.w * u4.w};
#pragma unroll
          for (int j = 0; j < 4; ++j) { const float x = y[j], uu = 0.7978845608028654f * (x + 0.044715f * x * x * x); y[j] = x / (1.f + __expf(-2.f * uu)); }
          store4bf(gbuf + (size_t)(row0 + t) * 512 + g * 16 + ch0, y[0], y[1], y[2], y[3]);
        }
      }
      __syncthreads();
    }
  }
  if (!OUT) { *(float2*)((float*)(p.ws + OFF_S5E) + ((size_t)c * 2048 + gp) * 2) = make_float2(hr, hi); }
  __syncthreads();
}

__device__ __forceinline__ void s5_prefix(const Params& p, int gt) {
  const int sq = gt >> 11, rem = gt & 2047;
  const float* tab = (const float*)(p.ws + OFF_S5TAB);
  const float* e = (const float*)(p.ws + OFF_S5E);
  float* hs = (float*)(p.ws + OFF_S5H);
  float hr = 0.f, hi = 0.f;
  if (sq < 8) {
    const float lr = tab[69632 + rem], li = tab[71680 + rem];
    for (int n = 0; n < 32; ++n) {
      const size_t idx = ((size_t)(sq * 32 + n) * 2048 + rem) * 2;
      *(float2*)(hs + idx) = make_float2(hr, hi);
      const float2 ev = *(const float2*)(e + idx);
      const float nr = lr * hr - li * hi + ev.x, ni = lr * hi + li * hr + ev.y; hr = nr; hi = ni;
    }
  } else {
    const float lr = tab[73728 + rem], li = tab[75776 + rem];
    hr = p.state_s5_re[(size_t)(sq - 8) * 2048 + rem]; hi = p.state_s5_im[(size_t)(sq - 8) * 2048 + rem];
    const size_t idx = ((size_t)(256 + sq - 8) * 2048 + rem) * 2;
    *(float2*)(hs + idx) = make_float2(hr, hi);
    const float2 ev = *(const float2*)(e + idx);
    const float nr = lr * hr - li * hi + ev.x, ni = lr * hi + li * hr + ev.y; hr = nr; hi = ni;
  }
  p.out[O_S5RE + (size_t)sq * 2048 + rem] = hr;
  p.out[O_S5IM + (size_t)sq * 2048 + rem] = hi;
}

__device__ __forceinline__ void conv_phase(const Params& p, int wvs) {
  const bf16_t* proj = (const bf16_t*)(p.ws + OFF_A);
  bf16_t* xc = (bf16_t*)(p.ws + OFF_H);
  int tq_ = TIDX(wvs); asm volatile("" : "+v"(tq_)); const int gt = blockIdx.x * NTHR + tq_, nt = gridDim.x * NTHR;
  for (int task = gt; task < 544 * 192; task += nt) {
    const int seg = task / 192, c = (task - seg * 192) * 8, rowb = seg * 32;
    float w[4][8], bia[8];
#pragma unroll
    for (int j = 0; j < 4; ++j) {
      const float4 w0 = *(const float4*)(p.conv_w + j * 1536 + c), w1 = *(const float4*)(p.conv_w + j * 1536 + c + 4);
      w[j][0] = w0.x; w[j][1] = w0.y; w[j][2] = w0.z; w[j][3] = w0.w; w[j][4] = w1.x; w[j][5] = w1.y; w[j][6] = w1.z; w[j][7] = w1.w;
    }
    { const float4 b0 = *(const float4*)(p.conv_b + c), b1 = *(const float4*)(p.conv_b + c + 4); bia[0] = b0.x; bia[1] = b0.y; bia[2] = b0.z; bia[3] = b0.w; bia[4] = b1.x; bia[5] = b1.y; bia[6] = b1.z; bia[7] = b1.w; }
    float x0[8], x1[8], x2[8];
    if (rowb < 16384 && (rowb & 2047) != 0) {
      const u32x4 v0 = *(const u32x4*)(proj + (size_t)(rowb - 3) * 3200 + 1024 + c), v1 = *(const u32x4*)(proj + (size_t)(rowb - 2) * 3200 + 1024 + c), v2 = *(const u32x4*)(proj + (size_t)(rowb - 1) * 3200 + 1024 + c);
#pragma unroll
      for (int e = 0; e < 4; ++e) { x0[2 * e] = lo2f(v0[e]); x0[2 * e + 1] = hi2f(v0[e]); x1[2 * e] = lo2f(v1[e]); x1[2 * e + 1] = hi2f(v1[e]); x2[2 * e] = lo2f(v2[e]); x2[2 * e + 1] = hi2f(v2[e]); }
    } else {
#pragma unroll
      for (int e = 0; e < 8; ++e) { x0[e] = 0.f; x1[e] = 0.f; x2[e] = 0.f; }
    }
    u32x4 nx[4];
#pragma unroll
    for (int q = 0; q < 4; ++q) nx[q] = *(const u32x4*)(proj + (size_t)(rowb + q) * 3200 + 1024 + c);
#pragma unroll 4
    for (int r = 0; r < 32; ++r) {
      const int row = rowb + r;
      const u32x4 cv = nx[r & 3];
      if (r + 4 < 32) nx[r & 3] = *(const u32x4*)(proj + (size_t)(row + 4) * 3200 + 1024 + c);
      int t, T, sq;
      if (row < 16384) { t = row & 2047; T = 2048; sq = row >> 11; } else { t = (row - 16384) & 7; T = 8; sq = 8 + ((row - 16384) >> 3); }
      if (t == 0) {
        if (sq >= 8) {
          const float* sc = p.state_conv + (size_t)(sq - 8) * 3 * 1536 + c;
          const float4 a0 = *(const float4*)sc, a1 = *(const float4*)(sc + 4), b0 = *(const float4*)(sc + 1536), b1 = *(const float4*)(sc + 1540), c0 = *(const float4*)(sc + 3072), c1 = *(const float4*)(sc + 3076);
          x0[0] = a0.x; x0[1] = a0.y; x0[2] = a0.z; x0[3] = a0.w; x0[4] = a1.x; x0[5] = a1.y; x0[6] = a1.z; x0[7] = a1.w;
          x1[0] = b0.x; x1[1] = b0.y; x1[2] = b0.z; x1[3] = b0.w; x1[4] = b1.x; x1[5] = b1.y; x1[6] = b1.z; x1[7] = b1.w;
          x2[0] = c0.x; x2[1] = c0.y; x2[2] = c0.z; x2[3] = c0.w; x2[4] = c1.x; x2[5] = c1.y; x2[6] = c1.z; x2[7] = c1.w;
        } else {
#pragma unroll
          for (int e = 0; e < 8; ++e) { x0[e] = 0.f; x1[e] = 0.f; x2[e] = 0.f; }
        }
      }
      float cur[8], o[8];
#pragma unroll
      for (int e = 0; e < 4; ++e) { cur[2 * e] = lo2f(cv[e]); cur[2 * e + 1] = hi2f(cv[e]); }
#pragma unroll
      for (int e = 0; e < 8; ++e) { o[e] = siluf(bia[e] + w[0][e] * x0[e] + w[1][e] * x1[e] + w[2][e] * x2[e] + w[3][e] * cur[e]); x0[e] = x1[e]; x1[e] = x2[e]; x2[e] = cur[e]; }
      u32x4 ov; ov[0] = pack2(o[0], o[1]); ov[1] = pack2(o[2], o[3]); ov[2] = pack2(o[4], o[5]); ov[3] = pack2(o[6], o[7]);
      *(u32x4*)(xc + (size_t)row * 1536 + c) = ov;
      if (t >= T - 3) {
        float* d = p.out + O_CONV + ((size_t)sq * 3 + (t - (T - 3))) * 1536 + c;
        *(float4*)d = make_float4(cur[0], cur[1], cur[2], cur[3]); *(float4*)(d + 4) = make_float4(cur[4], cur[5], cur[6], cur[7]);
      }
    }
  }
}

__device__ __forceinline__ void ssdnorm_phase(const Params& p, int wvs) {
  const bf16_t* proj = (const bf16_t*)(p.ws + OFF_A);
  bf16_t* mix = (bf16_t*)(p.ws + OFF_H);
  const float* st = (const float*)(p.ws + OFF_SSDST);
  int tq_ = TIDX(wvs); asm volatile("" : "+v"(tq_)); const int gt = blockIdx.x * NTHR + tq_, nt = gridDim.x * NTHR;
  for (int it = gt; it < ROWS * 128; it += nt) {
    const int row = it >> 7, c = (it & 127) * 8;
    const float r = rsqrtf(st[(size_t)row * 2 + (c >> 9)] * (1.f / 512.f) + EPSV);
    const uint4 v = *(const uint4*)(proj + (size_t)row * 3200 + c);
    const float4 w0 = *(const float4*)(p.ssm_norm_w + c), w1 = *(const float4*)(p.ssm_norm_w + c + 4);
    uint4 o; o.x = pack2(lo2f(v.x) * r * w0.x, hi2f(v.x) * r * w0.y); o.y = pack2(lo2f(v.y) * r * w0.z, hi2f(v.y) * r * w0.w);
    o.z = pack2(lo2f(v.z) * r * w1.x, hi2f(v.z) * r * w1.y); o.w = pack2(lo2f(v.w) * r * w1.z, hi2f(v.w) * r * w1.w);
    *(uint4*)(mix + (size_t)row * 1536 + c) = o;
  }
}


#define XB_TMO      128
#define XB_XCNT(j)  (256  + 64 * (j))
#define XB_XSUB(j)  (1280 + 64 * (j))
#define XB_XGEN(j)  (2304 + 64 * (j))
#define XB_TOP      3328
#define XB_TOPGEN   3392
#define XCD_BAR_WORDS 3456
#define XB_SPIN_CAP (1u << 18)
#define LAS __attribute__((address_space(3)))
__device__ __forceinline__ unsigned xb_ld(unsigned* p)              { return __hip_atomic_load(p, __ATOMIC_RELAXED, __HIP_MEMORY_SCOPE_AGENT); }
__device__ __forceinline__ unsigned xb_add(unsigned* p, unsigned v) { return __hip_atomic_fetch_add(p, v, __ATOMIC_RELAXED, __HIP_MEMORY_SCOPE_AGENT); }
__device__ __forceinline__ unsigned xb_xcc_id() { return (unsigned)__builtin_amdgcn_s_getreg((3 << 11) | 20) & 0xFu; }
#define XB_SPIN(cond, bar) do { unsigned _sp = 0; while (cond) { __builtin_amdgcn_s_sleep(1); \
    if ((++_sp & 255u) == 0u) { if (xb_ld(&(bar)[XB_TMO])) break; if (_sp > XB_SPIN_CAP) { atomicAdd(&(bar)[XB_TMO], 1u); break; } } } } while (0)
struct XcdBarrier { unsigned* bar; unsigned x; volatile LAS unsigned* st; };
__device__ __forceinline__ XcdBarrier xcd_barrier_post(unsigned* bar, volatile LAS unsigned* st, int wvs) {
    XcdBarrier b; b.bar = bar; b.x = xb_xcc_id(); b.st = st;
    if (TIDX(wvs) == 0) (void)xb_add(&bar[XB_XCNT(b.x)], 1u);
    return b;
}
__device__ __forceinline__ void xcd_barrier_complete(unsigned* bar, unsigned x, unsigned& nloc, unsigned& nx) {
    const unsigned G = gridDim.x * gridDim.y * gridDim.z;
    unsigned sum, cnt, mine, sp = 0u;
    for (;;) {
        sum = 0u; cnt = 0u; mine = 0u;
#pragma unroll
        for (unsigned j = 0; j < 16; ++j) { const unsigned c = xb_ld(&bar[XB_XCNT(j)]); sum += c; cnt += (c > 0u) ? 1u : 0u; mine = (j == x) ? c : mine; }
        if (sum == G) break;
        __builtin_amdgcn_s_sleep(1);
        if ((++sp & 255u) == 0u) { if (xb_ld(&bar[XB_TMO])) break; if (sp > XB_SPIN_CAP) { atomicAdd(&bar[XB_TMO], 1u); break; } }
    }
    nloc = mine > 0u ? mine : 1u; nx = cnt > 0u ? cnt : 1u;
}
__device__ __forceinline__ void xcd_barrier(const XcdBarrier& b, int wvs) {
    asm volatile("s_waitcnt vmcnt(0)" ::: "memory");
    __syncthreads();
    if (TIDX(wvs) == 0) {
        unsigned* bar = b.bar;
        __builtin_amdgcn_s_waitcnt(0);
        unsigned nloc = b.st[0], nx = b.st[1];
        if (nloc == 0u) { xcd_barrier_complete(bar, b.x, nloc, nx); b.st[0] = nloc; b.st[1] = nx; }
        const unsigned old = xb_add(&bar[XB_XSUB(b.x)], 1u);
        const unsigned gen = old / nloc;
        if (old + 1u == (gen + 1u) * nloc) {
            __builtin_amdgcn_fence(__ATOMIC_RELEASE, "agent");
            asm volatile("s_waitcnt vmcnt(0)" ::: "memory");
            const unsigned og = xb_add(&bar[XB_TOP], 1u);
            const unsigned tg = og / nx;
            if (og + 1u == (tg + 1u) * nx) xb_add(&bar[XB_TOPGEN], 1u);
            else XB_SPIN(xb_ld(&bar[XB_TOPGEN]) == tg, bar);
            __builtin_amdgcn_fence(__ATOMIC_ACQUIRE, "agent");
            xb_add(&bar[XB_XGEN(b.x)], 1u);
            asm volatile("s_waitcnt vmcnt(0)" ::: "memory");
        } else {
            XB_SPIN(xb_ld(&bar[XB_XGEN(b.x)]) == gen, bar);
            __builtin_amdgcn_fence(__ATOMIC_ACQUIRE, "agent");
            asm volatile("s_waitcnt vmcnt(0)" ::: "memory");
        }
    }
    __syncthreads();
}


__device__ __forceinline__ Params ldp() {
  auto kp = __builtin_amdgcn_kernarg_segment_ptr();
  asm volatile("" : "+s"(kp));
  Params q;
  __builtin_memcpy(&q, (const void*)kp, sizeof(Params));
  return q;
}

__global__ void __launch_bounds__(NTHR, 2) fwd_megakernel(Params p_) {
  extern __shared__ __attribute__((aligned(16))) char smem[];
  cg::grid_group grid = cg::this_grid();
  if (p_.ws == nullptr) grid.sync();
  volatile LAS unsigned* xst = (volatile LAS unsigned*)(smem + 2 * HALF_LDS);
  const int wvs = __builtin_amdgcn_readfirstlane(threadIdx.x >> 6);
  if (TIDX(wvs) == 0) { xst[0] = 0u; xst[1] = 0u; xst[2] = 0u; xst[3] = 0u; }
  __syncthreads();
  const XcdBarrier xb = xcd_barrier_post((unsigned*)(p_.ws + OFF_BAR), xst, wvs);
  const int half = wvs >> 2;
  const int G = gridDim.x * 2, bid = blockIdx.x * 2 + half;
  char* hs = smem + half * HALF_LDS;
#define PH_BEGIN const Params p = ldp(); bf16_t* bufA = (bf16_t*)(p.ws + OFF_A); bf16_t* bufH = (bf16_t*)(p.ws + OFF_H); bf16_t* t0 = (bf16_t*)(p.ws + OFF_ST); \
    float* rowss = (float*)(p.ws + OFF_ROWSS); float* hbuf = p.out; (void)bufA; (void)bufH; (void)t0; (void)rowss; (void)hbuf;

  {
  PH_BEGIN
  prep_tables(p, wvs);
  wconv(p.w_in_even, 1024, 4096, 4096, (bf16_t*)(p.ws + W_IN), hs, wvs);
  wconv(p.w_out_even, 1024, 1024, 1024, (bf16_t*)(p.ws + W_OUT0), hs, wvs);
  wconv(p.w_ffn_up, 1024, 4096, 4096, (bf16_t*)(p.ws + W_UP), hs, wvs);
  wconv(p.w_ffn_down, 4096, 1024, 1024, (bf16_t*)(p.ws + W_DOWN), hs, wvs);
  rowpass_phase(nullptr, nullptr, nullptr, p.x_prompt, p.x_sample, nullptr, p.norm_mix_pre, bufH, wvs);
  }
  xcd_barrier(xb, wvs);
  {
  PH_BEGIN
  { EpiInEven e{bufA, (const float*)(p.ws + OFF_ROPE), (const float*)(p.ws + OFF_LB)};
    for (int rep_ = 0; rep_ < REPG; ++rep_) { gemm_phase(bufH, 1024, (const bf16_t*)(p.ws + W_IN), 1024, 64, 16, 1024, e, smem, wvs); gemm_tail(bufH, 1024, (const bf16_t*)(p.ws + W_IN), 1024, 32, 1024, e, smem, wvs, 64 * 16); } }
  }
  xcd_barrier(xb, wvs);
  {
  PH_BEGIN
  for (int rep_ = 0; rep_ < REPS; ++rep_) {
    if (bid < 256) {
      const int v = bid;
      const int ps = v & 3, m = (v >> 2) & 1, h = (v >> 3) & 3, sq = v >> 5;
      if (m == 0) state_unit<0>(p, sq, h, ps, hs, wvs); else state_unit<1>(p, sq, h, ps, hs, wvs);
    }
    const int nsh = bid < 256 ? 0 : 16, j0 = bid - 256;
    for (int i = 0; i < nsh; ++i) {
      const int v = j0 + 256 * i;
      const int ps = v & 3, m = (v >> 2) & 1, h = (v >> 3) & 3, sq = 8 + (v >> 5);
      if (m == 0) state_unit<0>(p, sq, h, ps, hs, wvs); else state_unit<1>(p, sq, h, ps, hs, wvs);
    }
  }
  }
  xcd_barrier(xb, wvs);
  {
  PH_BEGIN
  for (int rep_ = 0; rep_ < REPO; ++rep_)
  for (int u = bid; u < 384 * 8; u += G) {
    const int h = u & 3, m = (u >> 2) & 1, c = u >> 3;
    if (m == 0) out_unit<0>(p, c, h, hs, wvs); else out_unit<1>(p, c, h, hs, wvs);
  }
  }
  xcd_barrier(xb, wvs);
  {
  PH_BEGIN
  { EpiOut e{t0, rowss};
    for (int rep_ = 0; rep_ < REPG; ++rep_) { gemm_phase(bufH, 1024, (const bf16_t*)(p.ws + W_OUT0), 1024, 64, 4, 1024, e, smem, wvs); gemm_tail(bufH, 1024, (const bf16_t*)(p.ws + W_OUT0), 1024, 8, 1024, e, smem, wvs, 64 * 4); } }
  }
  xcd_barrier(xb, wvs);
  {
  PH_BEGIN
  for (int rep_ = 0; rep_ < REPR; ++rep_)
  rowpass_phase(t0, rowss, p.norm_mix_post, p.x_prompt, p.x_sample, hbuf, p.norm_ffn_pre, bufH, wvs);
  }
  xcd_barrier(xb, wvs);
  {
  PH_BEGIN
  { EpiUp e{bufA}; for (int rep_ = 0; rep_ < REPG; ++rep_) { gemm_phase(bufH, 1024, (const bf16_t*)(p.ws + W_UP), 1024, 64, 16, 1024, e, smem, wvs); gemm_tail(bufH, 1024, (const bf16_t*)(p.ws + W_UP), 1024, 32, 1024, e, smem, wvs, 64 * 16); } }
  }
  xcd_barrier(xb, wvs);
  {
  PH_BEGIN
  { EpiOut e{t0, rowss + ROWS}; for (int rep_ = 0; rep_ < REPG; ++rep_) { gemm_phase(bufA, 4096, (const bf16_t*)(p.ws + W_DOWN), 4096, 64, 4, 4096, e, smem, wvs); gemm_tail(bufA, 4096, (const bf16_t*)(p.ws + W_DOWN), 4096, 8, 4096, e, smem, wvs, 64 * 4); } }
  }
  xcd_barrier(xb, wvs);
  {
  PH_BEGIN
  rowpass_phase(t0, rowss + ROWS, p.norm_ffn_post, hbuf, hbuf + (size_t)16384 * 1024, hbuf, p.norm_mix_pre + 1024, bufH, wvs);
  wconv(p.w_in_odd, 1024, 3088, 3328, (bf16_t*)(p.ws + W_IN), hs, wvs);
  wconv(p.w_glu, 512, 512, 512, (bf16_t*)(p.ws + W_GLU), hs, wvs);
  wconv(p.w_out_odd, 1536, 1024, 1024, (bf16_t*)(p.ws + W_OUT1), hs, wvs);
  wconv(p.w_ffn_up + (size_t)1024 * 4096, 1024, 4096, 4096, (bf16_t*)(p.ws + W_UP), hs, wvs);
  wconv(p.w_ffn_down + (size_t)4096 * 1024, 4096, 1024, 1024, (bf16_t*)(p.ws + W_DOWN), hs, wvs);
  }
  xcd_barrier(xb, wvs);
  {
  PH_BEGIN
  { EpiInOdd e{bufA, (float*)(p.ws + OFF_DTBUF)};
    for (int rep_ = 0; rep_ < REPG; ++rep_) { gemm_phase(bufH, 1024, (const bf16_t*)(p.ws + W_IN), 1024, 64, 13, 1024, e, smem, wvs); gemm_tail(bufH, 1024, (const bf16_t*)(p.ws + W_IN), 1024, 26, 1024, e, smem, wvs, 64 * 13); } }
  }
  xcd_barrier(xb, wvs);
  {
  PH_BEGIN
  for (int rep_ = 0; rep_ < REPC; ++rep_) {
  conv_phase(p, wvs);
  for (int u = bid; u < 384 * 8; u += G) s5_unit<0>(p, u >> 3, u & 7, hs, wvs);
  }
  }
  xcd_barrier(xb, wvs);
  {
  PH_BEGIN
  for (int rep_ = 0; rep_ < REPS; ++rep_) {
    if (bid < 256) state_unit<2>(p, bid >> 5, (bid >> 1) & 15, bid & 1, hs, wvs);
    for (int j = bid - 256; j < 5184; j += 256) {
      if (bid < 256) break;
      if (j < 1088) { int tq_ = TIDX(wvs) & 255; asm volatile("" : "+v"(tq_)); s5_prefix(p, j * 256 + tq_); }
      else { const int v = j - 1088; state_unit<2>(p, 8 + (v >> 5), (v >> 1) & 15, v & 1, hs, wvs); }
    }
  }
  }
  xcd_barrier(xb, wvs);
  {
  PH_BEGIN
  for (int u = bid; u < 384 * 16 + 384 * 8; u += G) {
    if (u < 384 * 16) out_unit<2>(p, u >> 4, u & 15, hs, wvs);
    else { const int v = u - 384 * 16; s5_unit<1>(p, v >> 3, v & 7, hs, wvs); }
  }
  }
  xcd_barrier(xb, wvs);
  {
  PH_BEGIN
  ssdnorm_phase(p, wvs);
  { EpiGlu e{(const bf16_t*)(p.ws + OFF_GBUF), p.b_glu, bufH};
    for (int rep_ = 0; rep_ < REPG; ++rep_) { gemm_phase((const bf16_t*)(p.ws + OFF_GBUF), 512, (const bf16_t*)(p.ws + W_GLU), 512, 64, 2, 512, e, smem, wvs); gemm_tail((const bf16_t*)(p.ws + OFF_GBUF), 512, (const bf16_t*)(p.ws + W_GLU), 512, 4, 512, e, smem, wvs, 64 * 2); } }
  }
  xcd_barrier(xb, wvs);
  {
  PH_BEGIN
  { EpiOut e{t0, rowss + 2 * ROWS}; for (int rep_ = 0; rep_ < REPG; ++rep_) { gemm_phase(bufH, 1536, (const bf16_t*)(p.ws + W_OUT1), 1536, 64, 4, 1536, e, smem, wvs); gemm_tail(bufH, 1536, (const bf16_t*)(p.ws + W_OUT1), 1536, 8, 1536, e, smem, wvs, 64 * 4); } }
  }
  xcd_barrier(xb, wvs);
  {
  PH_BEGIN
  rowpass_phase(t0, rowss + 2 * ROWS, p.norm_mix_post + 1024, hbuf, hbuf + (size_t)16384 * 1024, hbuf, p.norm_ffn_pre + 1024, bufH, wvs);
  }
  xcd_barrier(xb, wvs);
  {
  PH_BEGIN
  { EpiUp e{bufA}; for (int rep_ = 0; rep_ < REPG; ++rep_) { gemm_phase(bufH, 1024, (const bf16_t*)(p.ws + W_UP), 1024, 64, 16, 1024, e, smem, wvs); gemm_tail(bufH, 1024, (const bf16_t*)(p.ws + W_UP), 1024, 32, 1024, e, smem, wvs, 64 * 16); } }
  }
  xcd_barrier(xb, wvs);
  {
  PH_BEGIN
  { EpiOut e{t0, rowss + 3 * ROWS}; for (int rep_ = 0; rep_ < REPG; ++rep_) { gemm_phase(bufA, 4096, (const bf16_t*)(p.ws + W_DOWN), 4096, 64, 4, 4096, e, smem, wvs); gemm_tail(bufA, 4096, (const bf16_t*)(p.ws + W_DOWN), 4096, 8, 4096, e, smem, wvs, 64 * 4); } }
  }
  xcd_barrier(xb, wvs);
  {
  PH_BEGIN
  rowpass_phase(t0, rowss + 3 * ROWS, p.norm_ffn_post + 1024, hbuf, hbuf + (size_t)16384 * 1024, hbuf, nullptr, nullptr, wvs);
  }
}

extern "C" void kernel_launch(void* const* d_in, const int* in_sizes, int n_in, void* d_out, int out_size, void* d_ws, size_t ws_size, hipStream_t stream) {
  constexpr size_t kDynLds = 2 * HALF_LDS + 64;
  static int grid_blocks = 0;
  if (!grid_blocks) {
    int dev = 0, cus = 0, per_cu = 0;
    (void)hipGetDevice(&dev);
    (void)hipDeviceGetAttribute(&cus, hipDeviceAttributeMultiprocessorCount, dev);
    (void)hipFuncSetAttribute((const void*)fwd_megakernel, hipFuncAttributeMaxDynamicSharedMemorySize, (int)kDynLds);
    (void)hipOccupancyMaxActiveBlocksPerMultiprocessor(&per_cu, fwd_megakernel, NTHR, kDynLds);
    if (per_cu > 1) per_cu = 1;
    if (per_cu < 1) per_cu = 1;
    grid_blocks = cus * per_cu;
  }
  Params p{};
  const float** pf = (const float**)&p;
  for (int i = 0; i < 37; ++i) pf[i] = (const float*)d_in[i];
  p.out = (float*)d_out;
  p.ws = (char*)d_ws;
  (void)hipMemsetAsync((char*)d_ws + OFF_BAR, 0, 16384, stream);
  void* args[] = {&p};
  hipError_t e = hipLaunchCooperativeKernel((void*)fwd_megakernel, dim3(grid_blocks), dim3(NTHR), args, kDynLds, stream);
  if (e != hipSuccess) fprintf(stderr, "cooperative launch failed: %s (grid %d)\n", hipGetErrorString(e), grid_blocks);
}
```
